# Optimizing an MI355X kernel written in HIP

```python
import math
import jax, jax.numpy as jnp
from jax import lax
import numpy as np

D_MODEL = 1024
BATCH = 32
SEQ = 256
DEPTH = 2
DEC_BATCH = 2
DEC_SEQ = 2048
PAST_LEN = 256

GRID_W = 64
EPS = 1e-6
H_A = 4
DK_A = 128
DV_A = 128
W_A = H_A * DV_A
CHUNK_A = 16
H_B = 4
DH_B = 64
DV_B = 2 * DH_B
W_B = H_B * DV_B
Q_BLOCK = 128
ROPE_BASE = 10000.0
G_C = 4
DG_C = 128
W_C = G_C * DG_C
N_BRANCH = 3
IN_SIZES = (H_A * DK_A, H_A * DK_A, H_A * DK_A, W_A, W_A,
            H_B * 2 * DH_B, H_B * 2 * DH_B, W_B, W_B,
            W_C, W_C, N_BRANCH * D_MODEL)
D_IN = 3 * H_A * DK_A + 2 * W_A + 4 * H_B * DH_B + 2 * W_B + 2 * W_C + N_BRANCH * D_MODEL

kernel_name = 'hybrid_hgrn2_diffattn_fnet_dit_step'


def rms_norm(x, g):
    xf = x.astype(jnp.float32)
    y = xf * lax.rsqrt(jnp.mean(xf * xf, axis=-1, keepdims=True) + EPS)
    return (y * g.astype(jnp.float32)).astype(x.dtype)


def rope_angles(pos):
    nf = DH_B // 4
    inv = ROPE_BASE ** (-jnp.arange(nf, dtype=jnp.float32) / nf)
    ang = pos[:, None] * inv[None, :]
    return jnp.cos(ang), jnp.sin(ang)


def axial_rope(x, rope):
    (cos_r, sin_r), (cos_c, sin_c) = rope
    half = DH_B // 2
    nf = half // 2
    xf = x.astype(jnp.float32)

    def rot(xa, cos, sin):
        cos = cos[None, :, None, None, :]
        sin = sin[None, :, None, None, :]
        x1, x2 = xa[..., :nf], xa[..., nf:]
        return jnp.concatenate([x1 * cos - x2 * sin, x1 * sin + x2 * cos], axis=-1)

    out = jnp.concatenate([rot(xf[..., :half], cos_r, sin_r),
                           rot(xf[..., half:], cos_c, sin_c)], axis=-1)
    return out.astype(x.dtype)


def hgrn2_chunked(q, k, logf, v, s0):
    B, T, H, _ = q.shape
    C = CHUNK_A
    N = T // C

    def chunks(a):
        return a.astype(jnp.float32).reshape(B, N, C, H, a.shape[-1])

    q, k, logf, v = chunks(q), chunks(k), chunks(logf), chunks(v)
    G = jnp.cumsum(logf, axis=2)
    lower = jnp.tril(jnp.ones((C, C), dtype=bool))[None, None, :, :, None, None]
    decay = jnp.exp(jnp.where(lower, G[:, :, :, None] - G[:, :, None, :], -jnp.inf))
    attn = jnp.einsum('bnthk,bnshk,bntshk->bnhts', q, k, decay)
    o_intra = jnp.einsum('bnhts,bnshv->bnthv', attn, v)
    g_end = G[:, :, -1]
    u = jnp.einsum('bnshk,bnshv->bnhkv', k * jnp.exp(g_end[:, :, None] - G), v)

    def step(s, inp):
        d_n, u_n = inp
        return d_n[..., None] * s + u_n, s

    s_fin, s_start = lax.scan(step, s0, (jnp.moveaxis(jnp.exp(g_end), 1, 0),
                                         jnp.moveaxis(u, 1, 0)))
    o_inter = jnp.einsum('bnthk,nbhkv->bnthv', q * jnp.exp(G), s_start)
    return (o_intra + o_inter).reshape(B, T, H, -1), s_fin


def diff_attention(q, k, v, lam):
    B, Tq = q.shape[0], q.shape[1]
    qb = jnp.moveaxis(q.reshape(B, Tq // Q_BLOCK, Q_BLOCK, H_B, 2, DH_B), 1, 0)

    def block(q_blk):
        s = jnp.einsum('bqhmd,bkhmd->bhmqk', q_blk, k).astype(jnp.float32)
        p = jax.nn.softmax(s, axis=-1)
        w = (p[:, :, 0] - lam * p[:, :, 1]).astype(v.dtype)
        return jnp.einsum('bhqk,bkhe->bqhe', w, v)

    o = lax.map(block, qb)
    return jnp.moveaxis(o, 0, 1).reshape(B, Tq, H_B, DV_B)


def fourier_mix(u):
    B, T, _ = u.shape
    ug = u.astype(jnp.float32).reshape(B, T, G_C, DG_C)
    f = jnp.fft.fft2(ug, axes=(1, 3), norm='ortho').real
    return f.reshape(B, T, W_C).astype(u.dtype)


def trunk_layer(x, cond, layer, lb, lw, ctx=None, rope=None):
    (ada_w, ada_b, norm_g, w_in, hgrn_g, qn_g, kn_g, lam_p, sub_g,
     w_br_a, w_br_b, w_br_c, w_out) = lw
    B, T, _ = x.shape
    mod = jax.nn.silu(cond) @ ada_w + ada_b
    shift, scale, gate = jnp.split(mod, 3, axis=-1)
    h = rms_norm(x, norm_g) * (1.0 + scale[:, None, :]) + shift[:, None, :]
    split_idx = np.cumsum(IN_SIZES)[:-1].tolist()
    qa, ffa, fba, ia, za, qb, kb, vb, zb, uc, zc, gts = jnp.split(h @ w_in, split_idx, axis=-1)

    q_a = jax.nn.silu(qa).reshape(B, T, H_A, DK_A)
    i_a = ia.reshape(B, T, H_A, DV_A)
    if ctx is None:
        s0 = jnp.zeros((B, 2, H_A, DK_A, DV_A), jnp.float32)
    else:
        s0 = ctx[2].astype(jnp.float32)
    o_dirs = []
    finals = []
    for d, fraw in enumerate((ffa, fba)):
        lbd = lb[d]
        logf = jnp.logaddexp(jnp.log(lbd), jnp.log1p(-lbd) + jax.nn.log_sigmoid(fraw.astype(jnp.float32)))
        logf = logf.reshape(B, T, H_A, DK_A)
        k_a = -jnp.expm1(logf)
        if d == 0:
            o_d, s_fin = hgrn2_chunked(q_a, k_a, logf, i_a, s0[:, 0])
        else:
            o_d, s_fin = hgrn2_chunked(q_a[:, ::-1], k_a[:, ::-1], logf[:, ::-1], i_a[:, ::-1], s0[:, 1])
            o_d = o_d[:, ::-1]
        o_dirs.append(o_d)
        finals.append(s_fin)
    o_a = rms_norm(o_dirs[0] + o_dirs[1], hgrn_g.reshape(H_A, DV_A)).astype(x.dtype)
    y_a = o_a.reshape(B, T, W_A) * jax.nn.silu(za)

    q_b = rms_norm(qb.reshape(B, T, H_B, 2, DH_B), qn_g)
    k_b = rms_norm(kb.reshape(B, T, H_B, 2, DH_B), kn_g)
    v_b = vb.reshape(B, T, H_B, DV_B)
    if ctx is None:
        k_all, v_all = k_b, v_b
    else:
        q_b = axial_rope(q_b, rope)
        k_all = jnp.concatenate([axial_rope(k_b, rope), ctx[0].astype(k_b.dtype)], axis=1)
        v_all = jnp.concatenate([v_b, ctx[1].astype(v_b.dtype)], axis=1)
    lam_init = 0.8 - 0.6 * math.exp(-0.3 * layer)
    lp = lam_p.astype(jnp.float32)
    lam = jnp.exp(jnp.sum(lp[0] * lp[1])) - jnp.exp(jnp.sum(lp[2] * lp[3])) + lam_init
    o_b = diff_attention(q_b * (DH_B ** -0.5), k_all, v_all, lam)
    y_b = (rms_norm(o_b, sub_g) * (1.0 - lam_init)).reshape(B, T, W_B) * jax.nn.silu(zb)

    y_c = fourier_mix(uc) * jax.nn.silu(zc)

    g = jax.nn.sigmoid(gts).reshape(B, T, N_BRANCH, D_MODEL)
    merged = (g[:, :, 0] * (y_a @ w_br_a) + g[:, :, 1] * (y_b @ w_br_b)
              + g[:, :, 2] * (y_c @ w_br_c))
    x_new = x + gate[:, None, :] * (merged @ w_out)
    if ctx is None:
        return x_new, k_b, v_b, jnp.stack(finals, axis=1)
    return x_new


def setup_inputs(seed: int = 0) -> dict:
    key = jax.random.key(seed)
    ks = jax.random.split(key, 21)
    f32 = jnp.float32
    n = lambda k, s: jax.random.normal(k, s, f32)
    return {
        'x_prompt': n(ks[0], (BATCH, SEQ, D_MODEL)),
        'x_sample': n(ks[1], (DEC_BATCH, DEC_SEQ, D_MODEL)),
        'c': n(ks[2], (DEC_BATCH, D_MODEL)),
        'cache_diff_k': n(ks[3], (DEC_BATCH, DEPTH, PAST_LEN, H_B, 2, DH_B)),
        'cache_diff_v': n(ks[4], (DEC_BATCH, DEPTH, PAST_LEN, H_B, DV_B)),
        'state_hgrn': 0.5 * n(ks[5], (DEC_BATCH, DEPTH, 2, H_A, DK_A, DV_A)),
        'c_ctx': n(ks[6], (D_MODEL,)),
        'ada_w': n(ks[7], (DEPTH, D_MODEL, 3 * D_MODEL)) * D_MODEL ** -0.5,
        'ada_b': 0.02 * n(ks[8], (DEPTH, 3 * D_MODEL)),
        'norm_g': 1.0 + 0.02 * n(ks[9], (DEPTH, D_MODEL)),
        'w_in': n(ks[10], (DEPTH, D_MODEL, D_IN)) * D_MODEL ** -0.5,
        'hgrn_lb': n(ks[11], (DEPTH, 2, H_A * DK_A)),
        'hgrn_norm_g': 1.0 + 0.02 * n(ks[12], (DEPTH, W_A)),
        'diff_qn_g': 1.0 + 0.02 * n(ks[13], (DEPTH, DH_B)),
        'diff_kn_g': 1.0 + 0.02 * n(ks[14], (DEPTH, DH_B)),
        'diff_lambda': 0.1 * n(ks[15], (DEPTH, 4, DH_B)),
        'diff_subln_g': 1.0 + 0.02 * n(ks[16], (DEPTH, DV_B)),
        'w_branch_a': n(ks[17], (DEPTH, W_A, D_MODEL)) * W_A ** -0.5,
        'w_branch_b': n(ks[18], (DEPTH, W_B, D_MODEL)) * W_B ** -0.5,
        'w_branch_c': n(ks[19], (DEPTH, W_C, D_MODEL)) * W_C ** -0.5,
        'w_out': n(ks[20], (DEPTH, D_MODEL, D_MODEL)) * D_MODEL ** -0.5,
    }


def reference(x_prompt, x_sample, c, cache_diff_k, cache_diff_v, state_hgrn, c_ctx,
              ada_w, ada_b, norm_g, w_in, hgrn_lb, hgrn_norm_g, diff_qn_g, diff_kn_g,
              diff_lambda, diff_subln_g, w_branch_a, w_branch_b, w_branch_c, w_out):
    lb_all = jnp.cumsum(jax.nn.softmax(hgrn_lb.astype(jnp.float32), axis=0), axis=0)
    lb_all = lb_all - lb_all[0]
    n_rows = x_sample.shape[1] // GRID_W
    pos_row = jnp.repeat(jnp.arange(n_rows, dtype=jnp.float32), GRID_W)
    pos_col = jnp.tile(jnp.arange(GRID_W, dtype=jnp.float32), n_rows)
    rope = (rope_angles(pos_row), rope_angles(pos_col))
    cond_ctx = jnp.broadcast_to(c_ctx, (x_prompt.shape[0], D_MODEL))

    xp = x_prompt
    xs = x_sample
    new_k, new_v, new_s = [], [], []
    for l in range(DEPTH):
        lw = (ada_w[l], ada_b[l], norm_g[l], w_in[l], hgrn_norm_g[l], diff_qn_g[l],
              diff_kn_g[l], diff_lambda[l], diff_subln_g[l], w_branch_a[l],
              w_branch_b[l], w_branch_c[l], w_out[l])
        xp, k_c, v_c, s_c = trunk_layer(xp, cond_ctx, l, lb_all[l], lw)
        new_k.append(k_c)
        new_v.append(v_c)
        new_s.append(s_c)
        xs = trunk_layer(xs, c, l, lb_all[l], lw,
                         ctx=(cache_diff_k[:, l], cache_diff_v[:, l], state_hgrn[:, l]),
                         rope=rope)
    new_cache_diff_k = jnp.stack(new_k, axis=1)
    new_cache_diff_v = jnp.stack(new_v, axis=1)
    new_state_hgrn = jnp.stack(new_s, axis=1)
    return (xp, xs, new_cache_diff_k, new_cache_diff_v, new_state_hgrn)
```

```cpp
#include <hip/hip_runtime.h>
#include <hip/hip_cooperative_groups.h>
#include <stdint.h>
#include <cstdio>
namespace cg = cooperative_groups;

typedef unsigned short u16;
using bf16x8 = __attribute__((ext_vector_type(8))) short;
using f32x4 = __attribute__((ext_vector_type(4))) float;
#define MFMA(a, b, c) __builtin_amdgcn_mfma_f32_16x16x32_bf16(a, b, c, 0, 0, 0)

constexpr int NTOK = 12288;
constexpr int NCTX = 8192;
constexpr int LDP = 5120;
constexpr int PQA = 0, PLF = 512, PIA = 1536, PZA = 2048, PQB = 2560, PKB = 3072, PZB = 3584, PUC = 4096, PZC = 4608;
constexpr float EPSV = 1e-6f;
constexpr size_t OCK = 12582912, OCV = 20971520, OST = 29360128;

constexpr size_t OFF_WIN = 0;
constexpr size_t OFF_WBR = OFF_WIN + 8704ull * 1024 * 2;
constexpr size_t OFF_WO = OFF_WBR + 3ull * 1024 * 512 * 2;
constexpr size_t OFF_H = OFF_WO + 1024ull * 1024 * 2;
constexpr size_t OFF_PROJ = OFF_H + 12288ull * 1024 * 2;
constexpr size_t OFF_R1 = OFF_PROJ + 12288ull * LDP * 2;
constexpr size_t OFF_PTC = OFF_R1;
constexpr size_t OFF_PTL = OFF_R1 + 16384ull * 512 * 2;
constexpr size_t OFF_MRG = OFF_R1;
constexpr size_t OFF_SEGU = OFF_R1 + 25165824ull;
constexpr size_t OFF_SEGD = OFF_SEGU + 256ull * 16384 * 4;
constexpr size_t OFF_VTC = OFF_SEGD + 256ull * 128 * 4;
constexpr size_t OFF_VTL = OFF_VTC + 32ull * 4 * 128 * 256 * 2;
constexpr size_t SZ_VTL = 2ull * 4 * 128 * 2304 * 2;
constexpr size_t OFF_KC = OFF_VTL + 2 * SZ_VTL;
constexpr size_t OFF_DL = OFF_KC + 2ull * 2 * 256 * 512 * 2;
constexpr size_t OFF_DC = OFF_DL + 2048ull * 4096 * 2;
constexpr size_t OFF_B1 = OFF_DC + 256ull * 512 * 2;
constexpr size_t OFF_ROPE = OFF_B1 + 256ull * 128 * 2;
constexpr size_t OFF_MOD = OFF_ROPE + 2048ull * 32 * 8;
constexpr size_t OFF_CNT = OFF_MOD + 2ull * 3 * 3072 * 4;
constexpr size_t WS_END = OFF_CNT + 256;

constexpr int LDS_TILE = 98304;
constexpr int LDS_BYTES = LDS_TILE + 64;

struct Params {
  const float* in[21];
  float* out;
  char* ws;
};

__device__ __forceinline__ u16 f2bf(float f) {
  uint32_t u = __float_as_uint(f);
  u += 0x7fffu + ((u >> 16) & 1u);
  return (u16)(u >> 16);
}
__device__ __forceinline__ float bf2f(u16 h) { return __uint_as_float(((uint32_t)h) << 16); }
__device__ __forceinline__ uint32_t pack2(float a, float b) { return (uint32_t)f2bf(a) | ((uint32_t)f2bf(b) << 16); }
__device__ __forceinline__ float lo2f(uint32_t u) { return __uint_as_float(u << 16); }
__device__ __forceinline__ float hi2f(uint32_t u) { return __uint_as_float(u & 0xffff0000u); }
__device__ __forceinline__ float siluf(float x) { return x / (1.f + expf(-x)); }
__device__ __forceinline__ float sigmf(float x) { return 1.f / (1.f + expf(-x)); }

__device__ __forceinline__ int otid() { int t = threadIdx.x; asm volatile("" : "+v"(t)); return t; }

union Frag {
  bf16x8 v;
  uint4 q;
  uint2 h[2];
  uint32_t w[4];
};

__device__ __forceinline__ int lds_byte(int r, int c) {
  int st = (r >> 4) * 2 + (c >> 5), rr = r & 15, cc = c & 31, ob = rr * 64 + cc * 2;
  return st * 1024 + (ob ^ (((ob >> 9) & 1) << 5));
}

template <int TM>
__device__ __forceinline__ void gemm_kloop(const u16* __restrict__ X, int ldx, const u16* __restrict__ Y, int ldy,
                                           int K, f32x4 (&acc)[4][TM / 32], char* lds) {
  constexpr int NX = TM / 64;
  constexpr int XT = TM / 32;
  constexpr int STAGE = TM * 128 + 32768;
  const int tid = otid(), lane = tid & 63, wid = tid >> 6, wr = wid >> 2, wc = wid & 3, fr = lane & 15, fq = lane >> 4;
#pragma unroll
  for (int a = 0; a < 4; ++a)
#pragma unroll
    for (int b = 0; b < XT; ++b) acc[a][b] = f32x4{0.f, 0.f, 0.f, 0.f};
  uint4 xr[NX], yr[4];
  const int nk = K >> 6;
  const int lrow = tid >> 3, lc8 = (tid & 7) * 8;
  const u16* xg = X + (size_t)lrow * ldx + lc8;
  const u16* yg = Y + (size_t)lrow * ldy + lc8;
  const int loff = lds_byte(lrow, lc8);
#pragma unroll
  for (int i = 0; i < NX; ++i) xr[i] = *(const uint4*)(xg + (size_t)(64 * i) * ldx);
#pragma unroll
  for (int i = 0; i < 4; ++i) yr[i] = *(const uint4*)(yg + (size_t)(64 * i) * ldy);
#pragma unroll
  for (int i = 0; i < NX; ++i) *(uint4*)(lds + loff + 8192 * i) = xr[i];
#pragma unroll
  for (int i = 0; i < 4; ++i) *(uint4*)(lds + TM * 128 + loff + 8192 * i) = yr[i];
  __syncthreads();
  for (int kt = 0; kt < nk; ++kt) {
    char* cur = lds + (kt & 1) * STAGE;
    char* nxt = lds + ((kt + 1) & 1) * STAGE;
    const bool more = (kt + 1 < nk);
    if (more) {
#pragma unroll
      for (int i = 0; i < NX; ++i) xr[i] = *(const uint4*)(xg + (size_t)(64 * i) * ldx + (kt + 1) * 64);
#pragma unroll
      for (int i = 0; i < 4; ++i) yr[i] = *(const uint4*)(yg + (size_t)(64 * i) * ldy + (kt + 1) * 64);
    }
#pragma unroll
    for (int ks = 0; ks < 2; ++ks) {
      Frag yf[4], xf[XT];
#pragma unroll
      for (int a = 0; a < 4; ++a) yf[a].q = *(const uint4*)(cur + TM * 128 + lds_byte(wc * 64 + a * 16 + fr, ks * 32 + fq * 8));
#pragma unroll
      for (int b = 0; b < XT; ++b) xf[b].q = *(const uint4*)(cur + lds_byte(wr * (TM / 2) + b * 16 + fr, ks * 32 + fq * 8));
#pragma unroll
      for (int a = 0; a < 4; ++a)
#pragma unroll
        for (int b = 0; b < XT; ++b) acc[a][b] = MFMA(yf[a].v, xf[b].v, acc[a][b]);
    }
    if (more) {
#pragma unroll
      for (int i = 0; i < NX; ++i) *(uint4*)(nxt + loff + 8192 * i) = xr[i];
#pragma unroll
      for (int i = 0; i < 4; ++i) *(uint4*)(nxt + TM * 128 + loff + 8192 * i) = yr[i];
    }
    __syncthreads();
  }
}

__device__ __forceinline__ void p0_item(const Params& p, int item, char* lds) {
  const int tid = otid();
  char* ws = p.ws;
  if (item < 96) {
    float* sc = (float*)lds;
    float* red = sc + 3072;
    const int l = item / 48, cgp = item % 48;
    const float* cctx = p.in[6]; const float* cc2 = p.in[2];
    for (int i = tid; i < 3072; i += 512) {
      int j = i >> 10, k = i & 1023;
      float c = (j == 0) ? cctx[k] : cc2[(j > 0 ? j - 1 : 0) * 1024 + k];
      sc[i] = siluf(c);
    }
    __syncthreads();
    const int col = tid & 63, kg = tid >> 6;
    const float* W = p.in[7] + (size_t)l * 1024 * 3072 + cgp * 64 + col;
    float a0 = 0.f, a1 = 0.f, a2 = 0.f;
    for (int k = kg * 128; k < kg * 128 + 128; ++k) {
      float w = W[(size_t)k * 3072];
      a0 += sc[k] * w; a1 += sc[1024 + k] * w; a2 += sc[2048 + k] * w;
    }
    red[(kg * 3 + 0) * 64 + col] = a0; red[(kg * 3 + 1) * 64 + col] = a1; red[(kg * 3 + 2) * 64 + col] = a2;
    __syncthreads();
    if (tid < 192) {
      int j = tid >> 6; float s = 0.f;
      for (int g = 0; g < 8; ++g) s += red[(g * 3 + j) * 64 + col];
      int n = cgp * 64 + col;
      ((float*)(ws + OFF_MOD))[(l * 3 + j) * 3072 + n] = s + p.in[8][l * 3072 + n];
    }
    __syncthreads();
    return;
  }
  item -= 96;
  if (item < 128) {
    int idx = item * 512 + tid, t = idx >> 5, c = idx & 31, fi = c & 15;
    float pos = (c < 16) ? (float)(t >> 6) : (float)(t & 63);
    float inv = powf(10000.f, -(float)fi / 16.f);
    float ang = pos * inv;
    ((float2*)(ws + OFF_ROPE))[idx] = make_float2(cosf(ang), sinf(ang));
    return;
  }
  item -= 128;
  if (item < 2048) {
    int idx = item * 512 + tid, tp = idx >> 9, k0 = (idx & 511) * 8;
    uint32_t o[4];
    float vv[8];
#pragma unroll
    for (int j = 0; j < 8; ++j) {
      int k = k0 + j; int m = (tp * (k & 2047)) & 2047; float s, c;
      sincospif((float)m * (1.f / 1024.f), &s, &c);
      vv[j] = (k < 2048) ? c : -s;
    }
#pragma unroll
    for (int j = 0; j < 4; ++j) o[j] = pack2(vv[2 * j], vv[2 * j + 1]);
    *(uint4*)(ws + OFF_DL + (size_t)idx * 16) = make_uint4(o[0], o[1], o[2], o[3]);
    return;
  }
  item -= 2048;
  if (item < 32) {
    int idx = item * 512 + tid, tp = idx >> 6, k0 = (idx & 63) * 8;
    uint32_t o[4];
    float vv[8];
#pragma unroll
    for (int j = 0; j < 8; ++j) {
      int k = k0 + j; int m = (tp * (k & 255)) & 255; float s, c;
      sincospif((float)m * (1.f / 128.f), &s, &c);
      vv[j] = (k < 256) ? c : -s;
    }
#pragma unroll
    for (int j = 0; j < 4; ++j) o[j] = pack2(vv[2 * j], vv[2 * j + 1]);
    *(uint4*)(ws + OFF_DC + (size_t)idx * 16) = make_uint4(o[0], o[1], o[2], o[3]);
    return;
  }
  item -= 32;
  if (item < 8) {
    int idx = item * 512 + tid, j = idx >> 4, c0 = (idx & 15) * 8;
    uint32_t o[4];
    float vv[8];
#pragma unroll
    for (int q = 0; q < 8; ++q) {
      int m = ((j & 127) * (c0 + q)) & 127; float s, c;
      sincospif((float)m * (1.f / 64.f), &s, &c);
      vv[q] = (j < 128) ? c : s;
    }
#pragma unroll
    for (int q = 0; q < 4; ++q) o[q] = pack2(vv[2 * q], vv[2 * q + 1]);
    *(uint4*)(ws + OFF_B1 + (size_t)idx * 16) = make_uint4(o[0], o[1], o[2], o[3]);
    return;
  }
  item -= 8;
  if (item < 128) {
    int idx = item * 512 + tid; int e = idx * 8;
    int n = e & 511, t = (e >> 9) & 255, l = (e >> 17) & 1, b = e >> 18;
    const float4* s = (const float4*)(p.in[3] + e);
    float4 a = s[0], c = s[1];
    size_t d = ((size_t)((l * 2 + b) * 256 + t)) * 512 + n;
    *(uint4*)(ws + OFF_KC + d * 2) = make_uint4(pack2(a.x, a.y), pack2(a.z, a.w), pack2(c.x, c.y), pack2(c.z, c.w));
    return;
  }
  item -= 128;
  {
    int idx = item * 512 + tid;
    int v = idx & 127, tc = (idx >> 7) & 31, h = (idx >> 12) & 3, b = (idx >> 14) & 1, l = idx >> 15;
    float vv[8];
#pragma unroll
    for (int j = 0; j < 8; ++j) vv[j] = p.in[4][((size_t)((b * 2 + l) * 256 + tc * 8 + j)) * 512 + h * 128 + v];
    size_t d = ((size_t)((b * 4 + h) * 128 + v)) * 2304 + 2048 + tc * 8;
    *(uint4*)(ws + OFF_VTL + l * SZ_VTL + d * 2) = make_uint4(pack2(vv[0], vv[1]), pack2(vv[2], vv[3]), pack2(vv[4], vv[5]), pack2(vv[6], vv[7]));
  }
}
constexpr int P0_ITEMS = 96 + 128 + 2048 + 32 + 8 + 128 + 128;

__device__ __forceinline__ void p1_item(const Params& p, int l, int item, char* lds) {
  const int tid = otid();
  char* ws = p.ws;
  if (item < 2816) {
    const float* src; int lsrc; u16* dst; int ldd; int kt, nt;
    const float* w10 = p.in[10]; const float* w17 = p.in[17]; const float* w18 = p.in[18]; const float* w19 = p.in[19]; const float* w20 = p.in[20];
    if (item < 2176) { src = w10 + (size_t)l * 1024 * 8704; lsrc = 8704; dst = (u16*)(ws + OFF_WIN); ldd = 1024; nt = item >> 4; kt = item & 15; }
    else if (item < 2560) { int r = item - 2176; int j = r >> 7; r &= 127; src = ((j == 0) ? w17 : ((j == 1) ? w18 : w19)) + (size_t)l * 512 * 1024; lsrc = 1024; dst = (u16*)(ws + OFF_WBR) + (size_t)j * 1024 * 512; ldd = 512; nt = r >> 3; kt = r & 7; }
    else { int r = item - 2560; src = w20 + (size_t)l * 1024 * 1024; lsrc = 1024; dst = (u16*)(ws + OFF_WO); ldd = 1024; nt = r >> 4; kt = r & 15; }
    u16* T = (u16*)lds;
    const int k0 = kt * 64, n0 = nt * 64;
#pragma unroll
    for (int ps = 0; ps < 2; ++ps) {
      int kr = (tid >> 4) + 32 * ps, nq = tid & 15;
      float4 v = *(const float4*)(src + (size_t)(k0 + kr) * lsrc + n0 + 4 * nq);
      T[(4 * nq + 0) * 72 + kr] = f2bf(v.x); T[(4 * nq + 1) * 72 + kr] = f2bf(v.y);
      T[(4 * nq + 2) * 72 + kr] = f2bf(v.z); T[(4 * nq + 3) * 72 + kr] = f2bf(v.w);
    }
    __syncthreads();
    {
      int n = tid >> 3, kc = tid & 7;
      uint4 o = *(const uint4*)(T + n * 72 + kc * 8);
      *(uint4*)(dst + (size_t)(n0 + n) * ldd + k0 + kc * 8) = o;
    }
    __syncthreads();
    return;
  }
  item -= 2816;
  const int lane = tid & 63, wid = tid >> 6;
  const float* modp = (const float*)(ws + OFF_MOD);
  u16* H = (u16*)(ws + OFF_H);
  const float* xin0 = p.in[0]; const float* xin1 = p.in[1]; const float* xin2 = p.out; const float* ng = p.in[9];
#pragma unroll
  for (int rr = 0; rr < 2; ++rr) {
    int r = item * 16 + wid * 2 + rr;
    const float* x = (l == 0) ? ((r < NCTX) ? xin0 + (size_t)r * 1024 : xin1 + (size_t)(r - NCTX) * 1024) : xin2 + (size_t)r * 1024;
    int ci = (r < NCTX) ? 0 : 1 + ((r - NCTX) >> 11);
    float4 v[4]; float ss = 0.f;
#pragma unroll
    for (int i = 0; i < 4; ++i) { v[i] = *(const float4*)(x + lane * 4 + 256 * i); ss += v[i].x * v[i].x + v[i].y * v[i].y + v[i].z * v[i].z + v[i].w * v[i].w; }
#pragma unroll
    for (int o = 32; o >= 1; o >>= 1) ss += __shfl_xor(ss, o);
    float rinv = rsqrtf(ss * (1.f / 1024.f) + EPSV);
    const float* sh = modp + (l * 3 + ci) * 3072;
#pragma unroll
    for (int i = 0; i < 4; ++i) {
      int col = lane * 4 + 256 * i;
      float4 g = *(const float4*)(ng + l * 1024 + col);
      float4 s1 = *(const float4*)(sh + 1024 + col);
      float4 s0 = *(const float4*)(sh + col);
      float a = v[i].x * rinv * g.x * (1.f + s1.x) + s0.x;
      float b = v[i].y * rinv * g.y * (1.f + s1.y) + s0.y;
      float c = v[i].z * rinv * g.z * (1.f + s1.z) + s0.z;
      float d = v[i].w * rinv * g.w * (1.f + s1.w) + s0.w;
      *(uint2*)(H + (size_t)r * 1024 + col) = make_uint2(pack2(a, b), pack2(c, d));
    }
  }
}
constexpr int P1_ITEMS = 2816 + 768;

constexpr int P2_ITEMS = 1920 + 192;
__device__ __forceinline__ void p2_vtile(const Params& p, int l, int item, char* lds) {
  const int tid = otid(), lane = tid & 63, wid = tid >> 6, wr = wid >> 2, wc = wid & 3, fr = lane & 15, fq = lane >> 4;
  char* ws = p.ws;
  const int mt = item >> 2, vq = item & 3;
  const int m0 = mt * 256;
  f32x4 acc[4][4];
  gemm_kloop<128>((const u16*)(ws + OFF_WIN) + (size_t)(3584 + vq * 128) * 1024, 1024, (const u16*)(ws + OFF_H) + (size_t)m0 * 1024, 1024, 1024, acc, lds);
#pragma unroll
  for (int a = 0; a < 4; ++a)
#pragma unroll
    for (int b = 0; b < 4; ++b) {
      int tokl = wc * 64 + a * 16 + 4 * fq;
      int nn = vq * 128 + wr * 64 + b * 16 + fr;
      int hh = nn >> 7, v = nn & 127;
      uint2 pk = make_uint2(pack2(acc[a][b][0], acc[a][b][1]), pack2(acc[a][b][2], acc[a][b][3]));
      if (mt < 32) {
        *(uint2*)(ws + OFF_VTC + ((size_t)((mt * 4 + hh) * 128 + v) * 256 + tokl) * 2) = pk;
        float* o = p.out + OCV + ((size_t)((mt * 2 + l) * 256 + tokl)) * 512 + nn;
        o[0] = acc[a][b][0]; o[512] = acc[a][b][1]; o[1024] = acc[a][b][2]; o[1536] = acc[a][b][3];
      } else {
        int rp = m0 - NCTX + tokl; int bb = rp >> 11, t = rp & 2047;
        *(uint2*)(ws + OFF_VTL + l * SZ_VTL + ((size_t)((bb * 4 + hh) * 128 + v) * 2304 + t) * 2) = pk;
      }
    }
}
__device__ __forceinline__ void p2_tile(const Params& p, int l, int item, char* lds) {
  const int tid = otid(), lane = tid & 63, wid = tid >> 6, wr = wid >> 2, wc = wid & 3, fr = lane & 15, fq = lane >> 4;
  char* ws = p.ws;
  const int mt = item / 20;
  int nt = item - mt * 20; if (nt >= 14) nt += 2;
  const int m0 = mt * 128, n0 = nt * 256, seg = n0 >> 9;
  f32x4 acc[4][4];
  gemm_kloop<128>((const u16*)(ws + OFF_H) + (size_t)m0 * 1024, 1024, (const u16*)(ws + OFF_WIN) + (size_t)n0 * 1024, 1024, 1024, acc, lds);
  if (seg == 0 || seg == 4 || seg == 8 || seg == 10) {
#pragma unroll
    for (int a = 0; a < 4; ++a)
#pragma unroll
      for (int b = 0; b < 4; ++b)
#pragma unroll
        for (int r = 0; r < 4; ++r) acc[a][b][r] = siluf(acc[a][b][r]);
  } else if (seg == 1 || seg == 2) {
    const int dir = seg - 1;
    const float* hl = p.in[11];
#pragma unroll
    for (int a = 0; a < 4; ++a) {
      float lbv[4];
#pragma unroll
      for (int r = 0; r < 4; ++r) {
        int j = (n0 & 511) + wc * 64 + a * 16 + 4 * fq + r;
        lbv[r] = (l == 0) ? 0.f : sigmf(hl[(1 * 2 + dir) * 512 + j] - hl[(0 * 2 + dir) * 512 + j]);
      }
#pragma unroll
      for (int b = 0; b < 4; ++b)
#pragma unroll
        for (int r = 0; r < 4; ++r) {
          float xx = acc[a][b][r];
          float lf;
          if (l == 0) lf = (xx < -15.f) ? xx : -log1pf(expf(-xx));
          else lf = logf(lbv[r] + (1.f - lbv[r]) * sigmf(xx));
          acc[a][b][r] = lf;
        }
    }
  }
  u16* TL = (u16*)lds;
#pragma unroll
  for (int a = 0; a < 4; ++a)
#pragma unroll
    for (int b = 0; b < 4; ++b) {
      int xl = wr * 64 + b * 16 + fr, yl = wc * 64 + a * 16 + 4 * fq;
      *(uint2*)(TL + xl * 264 + yl) = make_uint2(pack2(acc[a][b][0], acc[a][b][1]), pack2(acc[a][b][2], acc[a][b][3]));
    }
  __syncthreads();
  {
    const int c = tid & 31, rbase = tid >> 5;
    const int dcol0 = ((seg < 7) ? seg : seg - 1) * 512 + (n0 & 511);
    u16* proj = (u16*)(ws + OFF_PROJ);
    const bool qk = (seg == 5 || seg == 6);
    const bool lat = (m0 >= NCTX);
    float gq[8];
    {
      const float* gsrc = p.in[13];
      const float* gsrc2 = p.in[14];
#pragma unroll
      for (int j = 0; j < 8; ++j) { float g1 = gsrc[l * 64 + (c & 7) * 8 + j], g2 = gsrc2[l * 64 + (c & 7) * 8 + j]; gq[j] = (seg == 5) ? g1 : g2; }
    }
    for (int i = 0; i < 8; ++i) {
      int row = rbase + 16 * i;
      int grow = m0 + row;
      uint4 raw = *(const uint4*)(TL + row * 264 + c * 8);
      if (qk) {
        float x[8];
        x[0] = lo2f(raw.x); x[1] = hi2f(raw.x); x[2] = lo2f(raw.y); x[3] = hi2f(raw.y);
        x[4] = lo2f(raw.z); x[5] = hi2f(raw.z); x[6] = lo2f(raw.w); x[7] = hi2f(raw.w);
        float ss = 0.f;
#pragma unroll
        for (int j = 0; j < 8; ++j) ss += x[j] * x[j];
        ss += __shfl_xor(ss, 1); ss += __shfl_xor(ss, 2); ss += __shfl_xor(ss, 4);
        float rinv = rsqrtf(ss * (1.f / 64.f) + EPSV);
#pragma unroll
        for (int j = 0; j < 8; ++j) x[j] = x[j] * rinv * gq[j];
        if (seg == 6 && !lat) {
          float* o = p.out + OCK + ((size_t)(((grow >> 8) * 2 + l) * 256 + (grow & 255))) * 512 + (n0 & 511) + c * 8;
          *(float4*)o = make_float4(x[0], x[1], x[2], x[3]);
          *(float4*)(o + 4) = make_float4(x[4], x[5], x[6], x[7]);
        }
        if (lat) {
          int t = (grow - NCTX) & 2047;
          const float2* rt = (const float2*)(ws + OFF_ROPE) + t * 32 + ((c & 4) ? 16 : 0) + 8 * (c & 1);
#pragma unroll
          for (int j = 0; j < 8; ++j) {
            float xp = __shfl_xor(x[j], 2);
            float2 cs = rt[j];
            x[j] = (c & 2) ? (x[j] * cs.x + xp * cs.y) : (x[j] * cs.x - xp * cs.y);
          }
        }
        if (seg == 5) {
#pragma unroll
          for (int j = 0; j < 8; ++j) x[j] *= 0.125f;
        }
        raw = make_uint4(pack2(x[0], x[1]), pack2(x[2], x[3]), pack2(x[4], x[5]), pack2(x[6], x[7]));
      }
      *(uint4*)(proj + (size_t)grow * LDP + dcol0 + c * 8) = raw;
    }
  }
  __syncthreads();
}

struct HgrnLds {
  float tot[4][128];
  float dk[128];
  float osum[16][132];
  u16 qt[16][136];
  u16 kt[16][136];
  u16 khT[128][16];
  u16 vT[128][16];
  u16 obuf[256][136];
};

__device__ __forceinline__ void hgrn_pass(const Params& p, int l, int row0, int ntok, int h, int dir, f32x4 (&S)[8],
                                          const bool do_out, const bool second, float& gsum, HgrnLds& L) {
  const int tid = otid(), lane = tid & 63, wid = tid >> 6, c16 = lane & 15, g = lane >> 4;
  const int kk = tid & 127, tq = tid >> 7;
  const u16* proj = (const u16*)(p.ws + OFF_PROJ);
  u16* projw = (u16*)(p.ws + OFF_PROJ);
  const int nch = ntok >> 4;
  u16 lfr[4], qr[4], vr[4];
  auto ldchunk = [&](int c) {
#pragma unroll
    for (int i = 0; i < 4; ++i) {
      int s = c * 16 + 4 * tq + i;
      int tl = dir ? (ntok - 1 - s) : s;
      const u16* rp = proj + (size_t)(row0 + tl) * LDP + h * 128 + kk;
      lfr[i] = rp[PLF + dir * 512];
      vr[i] = rp[PIA];
      qr[i] = do_out ? rp[PQA] : (u16)0;
    }
  };
  ldchunk(0);
  for (int c = 0; c < nch; ++c) {
    float lf[4], G[4], qv[4];
    u16 vv[4];
#pragma unroll
    for (int i = 0; i < 4; ++i) { lf[i] = bf2f(lfr[i]); qv[i] = bf2f(qr[i]); vv[i] = vr[i]; }
    G[0] = lf[0]; G[1] = G[0] + lf[1]; G[2] = G[1] + lf[2]; G[3] = G[2] + lf[3];
    L.tot[tq][kk] = G[3];
    __syncthreads();
    if (c + 1 < nch) ldchunk(c + 1);
    float t0 = L.tot[0][kk], t1 = L.tot[1][kk], t2 = L.tot[2][kk], t3 = L.tot[3][kk];
    float off = (tq > 0 ? t0 : 0.f) + (tq > 1 ? t1 : 0.f) + (tq > 2 ? t2 : 0.f);
    float gend = t0 + t1 + t2 + t3;
    float kh[4];
#pragma unroll
    for (int i = 0; i < 4; ++i) {
      float Gi = G[i] + off;
      float kv = -expm1f(lf[i]);
      int s = 4 * tq + i;
      if (do_out) {
        L.qt[s][kk] = f2bf(qv[i] * expf(Gi));
        L.kt[s][kk] = f2bf(kv * expf(-Gi));
      }
      kh[i] = kv * expf(gend - Gi);
    }
    *(uint2*)&L.khT[kk][4 * tq] = make_uint2(pack2(kh[0], kh[1]), pack2(kh[2], kh[3]));
    *(uint2*)&L.vT[kk][4 * tq] = make_uint2((uint32_t)vv[0] | ((uint32_t)vv[1] << 16), (uint32_t)vv[2] | ((uint32_t)vv[3] << 16));
    if (tq == 0) { L.dk[kk] = expf(gend); gsum += gend; }
    __syncthreads();
    Frag bv;
    bv.h[0] = *(const uint2*)&L.vT[16 * wid + c16][4 * g];
    bv.h[1] = make_uint2(0u, 0u);
    f32x4 o = f32x4{0.f, 0.f, 0.f, 0.f};
    if (do_out) {
      f32x4 at = f32x4{0.f, 0.f, 0.f, 0.f};
#pragma unroll
      for (int ks = 0; ks < 4; ++ks) {
        Frag a, b;
        a.q = *(const uint4*)&L.kt[c16][32 * ks + 8 * g];
        b.q = *(const uint4*)&L.qt[c16][32 * ks + 8 * g];
        at = MFMA(a.v, b.v, at);
      }
      Frag pa;
#pragma unroll
      for (int r = 0; r < 4; ++r) at[r] = (4 * g + r <= c16) ? at[r] : 0.f;
      pa.w[0] = pack2(at[0], at[1]); pa.w[1] = pack2(at[2], at[3]); pa.w[2] = 0u; pa.w[3] = 0u;
      o = MFMA(pa.v, bv.v, o);
#pragma unroll
      for (int st = 0; st < 4; ++st) {
        Frag a, b;
        a.h[0] = *(const uint2*)&L.qt[c16][32 * st + 4 * g];
        a.h[1] = *(const uint2*)&L.qt[c16][32 * st + 16 + 4 * g];
        b.w[0] = pack2(S[2 * st][0], S[2 * st][1]); b.w[1] = pack2(S[2 * st][2], S[2 * st][3]);
        b.w[2] = pack2(S[2 * st + 1][0], S[2 * st + 1][1]); b.w[3] = pack2(S[2 * st + 1][2], S[2 * st + 1][3]);
        o = MFMA(a.v, b.v, o);
      }
    }
#pragma unroll
    for (int k8 = 0; k8 < 8; ++k8) {
      float4 d = *(const float4*)&L.dk[16 * k8 + 4 * g];
      f32x4 s0 = S[k8];
      s0[0] *= d.x; s0[1] *= d.y; s0[2] *= d.z; s0[3] *= d.w;
      Frag a;
      a.h[0] = *(const uint2*)&L.khT[16 * k8 + c16][4 * g];
      a.h[1] = make_uint2(0u, 0u);
      S[k8] = MFMA(a.v, bv.v, s0);
    }
    if (do_out) {
      const int vcol = 16 * wid + c16;
      if (!second) {
#pragma unroll
        for (int r = 0; r < 4; ++r) {
          int s = c * 16 + 4 * g + r;
          int tl = dir ? (ntok - 1 - s) : s;
          L.obuf[tl][vcol] = f2bf(o[r]);
        }
      } else {
#pragma unroll
        for (int r = 0; r < 4; ++r) {
          int s = c * 16 + 4 * g + r;
          int tl = dir ? (ntok - 1 - s) : s;
          L.osum[4 * g + r][vcol] = o[r] + bf2f(L.obuf[tl][vcol]);
        }
        __syncthreads();
        {
          int sl = tid >> 5, vq = tid & 31;
          int s = c * 16 + sl;
          int tl = dir ? (ntok - 1 - s) : s;
          float4 ov = *(const float4*)&L.osum[sl][4 * vq];
          float ss = ov.x * ov.x + ov.y * ov.y + ov.z * ov.z + ov.w * ov.w;
#pragma unroll
          for (int m = 1; m <= 16; m <<= 1) ss += __shfl_xor(ss, m);
          float rinv = rsqrtf(ss * (1.f / 128.f) + EPSV);
          float4 gg = *(const float4*)(p.in[12] + l * 512 + h * 128 + 4 * vq);
          u16* rp = projw + (size_t)(row0 + tl) * LDP + h * 128 + 4 * vq;
          uint2 z = *(const uint2*)(rp + PZA);
          float y0 = ov.x * rinv * gg.x * lo2f(z.x), y1 = ov.y * rinv * gg.y * hi2f(z.x);
          float y2 = ov.z * rinv * gg.z * lo2f(z.y), y3 = ov.w * rinv * gg.w * hi2f(z.y);
          *(uint2*)(rp + PQA) = make_uint2(pack2(y0, y1), pack2(y2, y3));
        }
      }
    }
  }
  __syncthreads();
}

__device__ __forceinline__ void hgrn_load_state(const float* m, f32x4 (&S)[8]) {
  const int tid_ = otid(); const int lane = tid_ & 63, wid = tid_ >> 6, c16 = lane & 15, g = lane >> 4;
#pragma unroll
  for (int k8 = 0; k8 < 8; ++k8)
#pragma unroll
    for (int r = 0; r < 4; ++r) S[k8][r] = m[(16 * k8 + 4 * g + r) * 128 + 16 * wid + c16];
}
__device__ __forceinline__ void hgrn_store_state(float* m, const f32x4 (&S)[8]) {
  const int tid_ = otid(); const int lane = tid_ & 63, wid = tid_ >> 6, c16 = lane & 15, g = lane >> 4;
#pragma unroll
  for (int k8 = 0; k8 < 8; ++k8)
#pragma unroll
    for (int r = 0; r < 4; ++r) m[(16 * k8 + 4 * g + r) * 128 + 16 * wid + c16] = S[k8][r];
}
__device__ __forceinline__ void hgrn_advance(const float* U, const float* D, f32x4 (&S)[8]) {
  const int tid_ = otid(); const int lane = tid_ & 63, wid = tid_ >> 6, c16 = lane & 15, g = lane >> 4;
#pragma unroll
  for (int k8 = 0; k8 < 8; ++k8)
#pragma unroll
    for (int r = 0; r < 4; ++r) {
      int k = 16 * k8 + 4 * g + r;
      S[k8][r] = D[k] * S[k8][r] + U[k * 128 + 16 * wid + c16];
    }
}

__device__ __forceinline__ void hgrn_ctx_item(const Params& p, int l, int item, char* lds) {
  HgrnLds& L = *(HgrnLds*)lds;
  const int b = item >> 2, h = item & 3;
  f32x4 S[8];
  float gsum = 0.f;
#pragma unroll
  for (int i = 0; i < 8; ++i) S[i] = f32x4{0.f, 0.f, 0.f, 0.f};
  hgrn_pass(p, l, b * 256, 256, h, 0, S, true, false, gsum, L);
  hgrn_store_state(p.out + OST + ((size_t)(((b * 2 + l) * 2 + 0) * 4 + h)) * 16384, S);
#pragma unroll
  for (int i = 0; i < 8; ++i) S[i] = f32x4{0.f, 0.f, 0.f, 0.f};
  hgrn_pass(p, l, b * 256, 256, h, 1, S, true, true, gsum, L);
  hgrn_store_state(p.out + OST + ((size_t)(((b * 2 + l) * 2 + 1) * 4 + h)) * 16384, S);
}
__device__ __forceinline__ void hgrn_lat1_item(const Params& p, int l, int item, char* lds) {
  HgrnLds& L = *(HgrnLds*)lds;
  const int seg = item & 15, dir = (item >> 4) & 1, h = (item >> 5) & 3, b = item >> 7;
  f32x4 S[8];
  float gsum = 0.f;
#pragma unroll
  for (int i = 0; i < 8; ++i) S[i] = f32x4{0.f, 0.f, 0.f, 0.f};
  hgrn_pass(p, l, NCTX + b * 2048 + seg * 128, 128, h, dir, S, false, false, gsum, L);
  hgrn_store_state((float*)(p.ws + OFF_SEGU) + (size_t)item * 16384, S);
  { const int t_ = otid(); if (t_ < 128) ((float*)(p.ws + OFF_SEGD))[item * 128 + t_] = expf(gsum); }
}
__device__ __forceinline__ void hgrn_lat2_item(const Params& p, int l, int item, char* lds) {
  HgrnLds& L = *(HgrnLds*)lds;
  const int seg = item & 15, h = (item >> 4) & 3, b = item >> 6;
  const float* SU = (const float*)(p.ws + OFF_SEGU);
  const float* SD = (const float*)(p.ws + OFF_SEGD);
  f32x4 S[8];
  float gsum = 0.f;
  hgrn_load_state(p.in[5] + ((size_t)(((b * 2 + l) * 2 + 0) * 4 + h)) * 16384, S);
  for (int i = 0; i < seg; ++i) {
    int it = ((b * 4 + h) * 2 + 0) * 16 + i;
    hgrn_advance(SU + (size_t)it * 16384, SD + it * 128, S);
  }
  hgrn_pass(p, l, NCTX + b * 2048 + seg * 128, 128, h, 0, S, true, false, gsum, L);
  hgrn_load_state(p.in[5] + ((size_t)(((b * 2 + l) * 2 + 1) * 4 + h)) * 16384, S);
  for (int i = 15; i > seg; --i) {
    int it = ((b * 4 + h) * 2 + 1) * 16 + i;
    hgrn_advance(SU + (size_t)it * 16384, SD + it * 128, S);
  }
  hgrn_pass(p, l, NCTX + b * 2048 + seg * 128, 128, h, 1, S, true, true, gsum, L);
}

__device__ __forceinline__ void attn_item(const Params& p, int l, int item, const bool lat, char* lds) {
  const int tid = otid(), lane = tid & 63, wid = tid >> 6, c16 = lane & 15, g = lane >> 4;
  char* ws = p.ws;
  u16* proj = (u16*)(ws + OFF_PROJ);
  int b, h, qb, nkeys, rowbase;
  const u16* Vt; int ldv;
  if (!lat) { qb = item & 1; h = (item >> 1) & 3; b = item >> 3; nkeys = 256; rowbase = b * 256; Vt = (const u16*)(ws + OFF_VTC) + (size_t)((b * 4 + h) * 128) * 256; ldv = 256; }
  else { qb = item & 15; h = (item >> 4) & 3; b = item >> 6; nkeys = 2304; rowbase = NCTX + b * 2048; Vt = (const u16*)(ws + OFF_VTL + l * SZ_VTL) + (size_t)((b * 4 + h) * 128) * 2304; ldv = 2304; }
  const u16* Kc = (const u16*)(ws + OFF_KC) + (size_t)((l * 2 + b) * 256) * 512 + h * 128;
  u16* Ks = (u16*)lds;
  u16* Vs = Ks + 64 * 136;
  float lam_init = 0.8f - 0.6f * expf(-0.3f * (float)l);
  float lam;
  {
    const float* lp = p.in[15] + l * 256;
    float a = lp[lane] * lp[64 + lane], c = lp[128 + lane] * lp[192 + lane];
#pragma unroll
    for (int o = 32; o >= 1; o >>= 1) { a += __shfl_xor(a, o); c += __shfl_xor(c, o); }
    lam = expf(a) - expf(c) + lam_init;
  }
  const int qrow = rowbase + qb * 128 + wid * 16 + c16;
  Frag qf[2][2];
#pragma unroll
  for (int m = 0; m < 2; ++m)
#pragma unroll
    for (int ks = 0; ks < 2; ++ks) qf[m][ks].q = *(const uint4*)(proj + (size_t)qrow * LDP + PQB + h * 128 + m * 64 + ks * 32 + g * 8);
  f32x4 O[2][8];
#pragma unroll
  for (int m = 0; m < 2; ++m)
#pragma unroll
    for (int v = 0; v < 8; ++v) O[m][v] = f32x4{0.f, 0.f, 0.f, 0.f};
  float mrun[2] = {-1e30f, -1e30f}, lsum[2] = {0.f, 0.f};
  uint4 kr0, kr1, vr0, vr1;
#define ATT_LD(kt_)                                                                                           \
  {                                                                                                           \
    const int key0 = (kt_) * 64;                                                                              \
    const bool fromproj = (!lat) || (key0 < 2048);                                                            \
    {                                                                                                         \
      int q = tid; int key = q >> 4, cc = q & 15;                                                             \
      const u16* src = fromproj ? proj + (size_t)(rowbase + key0 + key) * LDP + PKB + h * 128 + cc * 8        \
                                : Kc + (size_t)(key0 - 2048 + key) * 512 + cc * 8;                            \
      kr0 = *(const uint4*)src;                                                                               \
      int v = q >> 3, c8 = q & 7;                                                                             \
      vr0 = *(const uint4*)(Vt + (size_t)v * ldv + key0 + c8 * 8);                                            \
    }                                                                                                         \
    {                                                                                                         \
      int q = tid + 512; int key = q >> 4, cc = q & 15;                                                       \
      const u16* src = fromproj ? proj + (size_t)(rowbase + key0 + key) * LDP + PKB + h * 128 + cc * 8        \
                                : Kc + (size_t)(key0 - 2048 + key) * 512 + cc * 8;                            \
      kr1 = *(const uint4*)src;                                                                               \
      int v = q >> 3, c8 = q & 7;                                                                             \
      vr1 = *(const uint4*)(Vt + (size_t)v * ldv + key0 + c8 * 8);                                            \
    }                                                                                                         \
  }
#define ATT_ST()                                                                                              \
  {                                                                                                           \
    { int q = tid; int key = q >> 4, cc = q & 15; *(uint4*)(Ks + key * 136 + cc * 8) = kr0;                   \
      int v = q >> 3, c8 = q & 7; *(uint4*)(Vs + v * 72 + c8 * 8) = vr0; }                                    \
    { int q = tid + 512; int key = q >> 4, cc = q & 15; *(uint4*)(Ks + key * 136 + cc * 8) = kr1;             \
      int v = q >> 3, c8 = q & 7; *(uint4*)(Vs + v * 72 + c8 * 8) = vr1; }                                    \
  }
  const int nkt = nkeys >> 6;
  ATT_LD(0);
  for (int kt = 0; kt < nkt; ++kt) {
    __syncthreads();
    ATT_ST();
    __syncthreads();
    if (kt + 1 < nkt) ATT_LD(kt + 1);
    Frag pf[2][2];
#pragma unroll
    for (int m = 0; m < 2; ++m) {
      f32x4 s[4];
#pragma unroll
      for (int k4 = 0; k4 < 4; ++k4) {
        s[k4] = f32x4{0.f, 0.f, 0.f, 0.f};
#pragma unroll
        for (int ks = 0; ks < 2; ++ks) {
          Frag a;
          a.q = *(const uint4*)(Ks + (16 * k4 + c16) * 136 + m * 64 + ks * 32 + g * 8);
          s[k4] = MFMA(a.v, qf[m][ks].v, s[k4]);
        }
      }
      float mx = -1e30f;
#pragma unroll
      for (int k4 = 0; k4 < 4; ++k4)
#pragma unroll
        for (int r = 0; r < 4; ++r) mx = fmaxf(mx, s[k4][r]);
      mx = fmaxf(mx, __shfl_xor(mx, 16));
      mx = fmaxf(mx, __shfl_xor(mx, 32));
      float mnew = fmaxf(mrun[m], mx);
      float alpha = expf(mrun[m] - mnew);
      mrun[m] = mnew;
      float ps = 0.f;
#pragma unroll
      for (int k4 = 0; k4 < 4; ++k4)
#pragma unroll
        for (int r = 0; r < 4; ++r) { s[k4][r] = expf(s[k4][r] - mnew); ps += s[k4][r]; }
      lsum[m] = lsum[m] * alpha + ps;
#pragma unroll
      for (int v = 0; v < 8; ++v) { O[m][v][0] *= alpha; O[m][v][1] *= alpha; O[m][v][2] *= alpha; O[m][v][3] *= alpha; }
#pragma unroll
      for (int sp = 0; sp < 2; ++sp) {
        pf[m][sp].w[0] = pack2(s[2 * sp][0], s[2 * sp][1]); pf[m][sp].w[1] = pack2(s[2 * sp][2], s[2 * sp][3]);
        pf[m][sp].w[2] = pack2(s[2 * sp + 1][0], s[2 * sp + 1][1]); pf[m][sp].w[3] = pack2(s[2 * sp + 1][2], s[2 * sp + 1][3]);
      }
    }
#pragma unroll
    for (int v = 0; v < 8; ++v)
#pragma unroll
      for (int sp = 0; sp < 2; ++sp) {
        Frag a;
        a.h[0] = *(const uint2*)(Vs + (16 * v + c16) * 72 + 32 * sp + 4 * g);
        a.h[1] = *(const uint2*)(Vs + (16 * v + c16) * 72 + 32 * sp + 16 + 4 * g);
        O[0][v] = MFMA(a.v, pf[0][sp].v, O[0][v]);
        O[1][v] = MFMA(a.v, pf[1][sp].v, O[1][v]);
      }
  }
  float l0 = lsum[0], l1 = lsum[1];
  l0 += __shfl_xor(l0, 16); l0 += __shfl_xor(l0, 32);
  l1 += __shfl_xor(l1, 16); l1 += __shfl_xor(l1, 32);
  const float i0 = 1.f / l0, i1 = lam / l1;
  float ss = 0.f;
#pragma unroll
  for (int v = 0; v < 8; ++v)
#pragma unroll
    for (int r = 0; r < 4; ++r) { float o = O[0][v][r] * i0 - O[1][v][r] * i1; O[0][v][r] = o; ss += o * o; }
  ss += __shfl_xor(ss, 16); ss += __shfl_xor(ss, 32);
  const float rinv = rsqrtf(ss * (1.f / 128.f) + EPSV) * (1.f - lam_init);
  u16* rp = proj + (size_t)qrow * LDP + h * 128;
#pragma unroll
  for (int v = 0; v < 8; ++v) {
    int vc = 16 * v + 4 * g;
    float4 sg = *(const float4*)(p.in[16] + l * 128 + vc);
    uint2 z = *(const uint2*)(rp + PZB + vc);
    float y0 = O[0][v][0] * rinv * sg.x * lo2f(z.x), y1 = O[0][v][1] * rinv * sg.y * hi2f(z.x);
    float y2 = O[0][v][2] * rinv * sg.z * lo2f(z.y), y3 = O[0][v][3] * rinv * sg.w * hi2f(z.y);
    *(uint2*)(rp + PQB + vc) = make_uint2(pack2(y0, y1), pack2(y2, y3));
  }
  __syncthreads();
}

__device__ __forceinline__ void f1_item(const Params& p, int item, char* lds) {
  const int tid = otid(), lane = tid & 63, wid = tid >> 6, wr = wid >> 2, wc = wid & 3, fr = lane & 15, fq = lane >> 4;
  char* ws = p.ws;
  const int jh = item & 1, gq = (item >> 1) & 3, mt = item >> 3;
  f32x4 acc[4][4];
  gemm_kloop<128>((const u16*)(ws + OFF_B1) + jh * 128 * 128, 128, (const u16*)(ws + OFF_PROJ) + (size_t)(mt * 256) * LDP + PUC + gq * 128, LDP, 128, acc, lds);
#pragma unroll
  for (int a = 0; a < 4; ++a)
#pragma unroll
    for (int b = 0; b < 4; ++b) {
      int tokl = wc * 64 + a * 16 + 4 * fq;
      int jj = wr * 64 + b * 16 + fr;
      uint2 pk = make_uint2(pack2(acc[a][b][0], acc[a][b][1]), pack2(acc[a][b][2], acc[a][b][3]));
      if (mt < 32) {
        *(uint2*)(ws + OFF_PTC + ((size_t)((mt * 4 + gq) * 128 + jj) * 512 + jh * 256 + tokl) * 2) = pk;
      } else {
        int rp = (mt - 32) * 256 + tokl; int bb = rp >> 11, t = rp & 2047;
        *(uint2*)(ws + OFF_PTL + ((size_t)((bb * 4 + gq) * 128 + jj) * 4096 + jh * 2048 + t) * 2) = pk;
      }
    }
}

__device__ __forceinline__ void f2c_item(const Params& p, int item, char* lds) {
  const int tid = otid(), lane = tid & 63, wid = tid >> 6, wr = wid >> 2, wc = wid & 3, fr = lane & 15, fq = lane >> 4;
  char* ws = p.ws;
  const int nt = item >> 1, th = item & 1;
  f32x4 acc[4][4];
  gemm_kloop<128>((const u16*)(ws + OFF_DC) + th * 128 * 512, 512, (const u16*)(ws + OFF_PTC) + (size_t)(nt * 256) * 512, 512, 512, acc, lds);
  u16* proj = (u16*)(ws + OFF_PROJ);
  const float scl = 0.005524271728019903f;
#pragma unroll
  for (int a = 0; a < 4; ++a)
#pragma unroll
    for (int b = 0; b < 4; ++b) {
      int n = nt * 256 + wc * 64 + a * 16 + 4 * fq;
      int tp = th * 128 + wr * 64 + b * 16 + fr;
      int bb = n >> 9, col = n & 511;
      u16* rp = proj + (size_t)(bb * 256 + tp) * LDP;
      uint2 z = *(const uint2*)(rp + PZC + col);
      *(uint2*)(rp + PUC + col) = make_uint2(pack2(acc[a][b][0] * scl * lo2f(z.x), acc[a][b][1] * scl * hi2f(z.x)),
                                             pack2(acc[a][b][2] * scl * lo2f(z.y), acc[a][b][3] * scl * hi2f(z.y)));
    }
}
__device__ __forceinline__ void f2l_item(const Params& p, int item, char* lds) {
  const int tid = otid(), lane = tid & 63, wid = tid >> 6, wr = wid >> 2, wc = wid & 3, fr = lane & 15, fq = lane >> 4;
  char* ws = p.ws;
  const int mt = item >> 2, nt = item & 3;
  f32x4 acc[4][4];
  gemm_kloop<128>((const u16*)(ws + OFF_DL) + (size_t)(mt * 128) * 4096, 4096, (const u16*)(ws + OFF_PTL) + (size_t)(nt * 256) * 4096, 4096, 4096, acc, lds);
  u16* proj = (u16*)(ws + OFF_PROJ);
  const float scl = 1.f / 512.f;
#pragma unroll
  for (int a = 0; a < 4; ++a)
#pragma unroll
    for (int b = 0; b < 4; ++b) {
      int n = nt * 256 + wc * 64 + a * 16 + 4 * fq;
      int tp = mt * 128 + wr * 64 + b * 16 + fr;
      int bb = n >> 9, col = n & 511;
      u16* rp = proj + (size_t)(NCTX + bb * 2048 + tp) * LDP;
      uint2 z = *(const uint2*)(rp + PZC + col);
      *(uint2*)(rp + PUC + col) = make_uint2(pack2(acc[a][b][0] * scl * lo2f(z.x), acc[a][b][1] * scl * hi2f(z.x)),
                                             pack2(acc[a][b][2] * scl * lo2f(z.y), acc[a][b][3] * scl * hi2f(z.y)));
    }
}

__device__ __forceinline__ void p5_tile(const Params& p, int tile, char* lds) {
  const int tid = otid(), lane = tid & 63, wid = tid >> 6, wr = wid >> 2, wc = wid & 3, fr = lane & 15, fq = lane >> 4;
  char* ws = p.ws;
  const int mt = tile >> 2, nt = tile & 3;
  const int m0 = mt * 128, n0 = nt * 256;
  uint32_t tot[4][4][2];
#pragma unroll
  for (int a = 0; a < 4; ++a)
#pragma unroll
    for (int b = 0; b < 4; ++b) { tot[a][b][0] = 0u; tot[a][b][1] = 0u; }
  u16* gb = (u16*)(ws + OFF_SEGU) + (size_t)blockIdx.x * (128 * 256);
#pragma unroll 1
  for (int j = 0; j < 3; ++j) {
    {
      f32x4 acc[4][4];
      gemm_kloop<128>((const u16*)(ws + OFF_H) + (size_t)m0 * 1024, 1024, (const u16*)(ws + OFF_WIN) + (size_t)(5632 + j * 1024 + n0) * 1024, 1024, 1024, acc, lds);
#pragma unroll
      for (int a = 0; a < 4; ++a)
#pragma unroll
        for (int b = 0; b < 4; ++b)
          *(uint2*)(gb + (wr * 64 + b * 16 + fr) * 256 + wc * 64 + a * 16 + 4 * fq) =
              make_uint2(pack2(sigmf(acc[a][b][0]), sigmf(acc[a][b][1])), pack2(sigmf(acc[a][b][2]), sigmf(acc[a][b][3])));
    }
    {
      f32x4 acc[4][4];
      int yc = (j == 0) ? PQA : ((j == 1) ? PQB : PUC);
      gemm_kloop<128>((const u16*)(ws + OFF_PROJ) + (size_t)m0 * LDP + yc, LDP, (const u16*)(ws + OFF_WBR) + (size_t)j * 1024 * 512 + (size_t)n0 * 512, 512, 512, acc, lds);
#pragma unroll
      for (int a = 0; a < 4; ++a)
#pragma unroll
        for (int b = 0; b < 4; ++b) {
          uint2 gv = *(const uint2*)(gb + (wr * 64 + b * 16 + fr) * 256 + wc * 64 + a * 16 + 4 * fq);
          float t0 = lo2f(tot[a][b][0]) + lo2f(gv.x) * acc[a][b][0];
          float t1 = hi2f(tot[a][b][0]) + hi2f(gv.x) * acc[a][b][1];
          float t2 = lo2f(tot[a][b][1]) + lo2f(gv.y) * acc[a][b][2];
          float t3 = hi2f(tot[a][b][1]) + hi2f(gv.y) * acc[a][b][3];
          tot[a][b][0] = pack2(t0, t1); tot[a][b][1] = pack2(t2, t3);
        }
    }
  }
  u16* mg = (u16*)(ws + OFF_MRG);
#pragma unroll
  for (int a = 0; a < 4; ++a)
#pragma unroll
    for (int b = 0; b < 4; ++b) {
      int n = n0 + wc * 64 + a * 16 + 4 * fq;
      int m = m0 + wr * 64 + b * 16 + fr;
      *(uint2*)(mg + (size_t)m * 1024 + n) = make_uint2(tot[a][b][0], tot[a][b][1]);
    }
}

__device__ __forceinline__ void p6_tile(const Params& p, int l, int tile, char* lds) {
  const int tid = otid(), lane = tid & 63, wid = tid >> 6, wr = wid >> 2, wc = wid & 3, fr = lane & 15, fq = lane >> 4;
  char* ws = p.ws;
  const int mt = tile >> 2, nt = tile & 3;
  const int m0 = mt * 128, n0 = nt * 256;
  f32x4 acc[4][4];
  gemm_kloop<128>((const u16*)(ws + OFF_MRG) + (size_t)m0 * 1024, 1024, (const u16*)(ws + OFF_WO) + (size_t)n0 * 1024, 1024, 1024, acc, lds);
  const float* modp = (const float*)(ws + OFF_MOD);
  const float* xp0 = p.in[0];
  const float* xs0 = p.in[1];
  float* outp = p.out;
#pragma unroll
  for (int a = 0; a < 4; ++a)
#pragma unroll
    for (int b = 0; b < 4; ++b) {
      int n = n0 + wc * 64 + a * 16 + 4 * fq;
      int r = m0 + wr * 64 + b * 16 + fr;
      const float* x = (l == 0) ? ((m0 < NCTX) ? xp0 + (size_t)r * 1024 : xs0 + (size_t)(r - NCTX) * 1024) : outp + (size_t)r * 1024;
      int ci = (m0 < NCTX) ? 0 : 1 + ((r - NCTX) >> 11);
      float4 gt = *(const float4*)(modp + (l * 3 + ci) * 3072 + 2048 + n);
      float4 xv = *(const float4*)(x + n);
      float4 o = make_float4(xv.x + gt.x * acc[a][b][0], xv.y + gt.y * acc[a][b][1], xv.z + gt.z * acc[a][b][2], xv.w + gt.w * acc[a][b][3]);
      *(float4*)(outp + (size_t)r * 1024 + n) = o;
    }
}

#define PARGS const float* a0, const float* a1, const float* a2, const float* a3, const float* a4, const float* a5, const float* a6, \
  const float* a7, const float* a8, const float* a9, const float* a10, const float* a11, const float* a12, const float* a13, \
  const float* a14, const float* a15, const float* a16, const float* a17, const float* a18, const float* a19, const float* a20, \
  float* aout, char* aws
#define PFILL Params p; p.in[0]=a0;p.in[1]=a1;p.in[2]=a2;p.in[3]=a3;p.in[4]=a4;p.in[5]=a5;p.in[6]=a6;p.in[7]=a7;p.in[8]=a8;p.in[9]=a9;p.in[10]=a10; \
  p.in[11]=a11;p.in[12]=a12;p.in[13]=a13;p.in[14]=a14;p.in[15]=a15;p.in[16]=a16;p.in[17]=a17;p.in[18]=a18;p.in[19]=a19;p.in[20]=a20;p.out=aout;p.ws=aws;
__global__ void __launch_bounds__(512) fwd_megakernel(PARGS) {
  PFILL
  extern __shared__ __attribute__((aligned(16))) char lds[];
  volatile int& s_item = *(volatile int*)(lds + LDS_TILE);
  cg::grid_group grid = cg::this_grid();
  const int bid = blockIdx.x, G = gridDim.x, tid = threadIdx.x;
  int* cnt = (int*)(p.ws + OFF_CNT);
  if (bid == 0 && tid < 64) cnt[tid] = 0;
  for (int it = bid; it < P0_ITEMS; it += G) p0_item(p, it, lds);
  grid.sync();
  for (int l = 0; l < 2; ++l) {
    for (int it = bid; it < P1_ITEMS; it += G) p1_item(p, l, it, lds);
    grid.sync();
    for (int it = bid; it < P2_ITEMS; it += G) { if (it < 1920) p2_tile(p, l, it, lds); else p2_vtile(p, l, it - 1920, lds); }
    grid.sync();
    for (;;) {
      __syncthreads();
      if (tid == 0) s_item = atomicAdd(&cnt[l * 2 + 0], 1);
      __syncthreads();
      int it = s_item;
      if (it >= 128 + 384 + 256 + 256) break;
      if (it < 128) hgrn_ctx_item(p, l, it, lds);
      else if (it < 512) f1_item(p, it - 128, lds);
      else if (it < 768) hgrn_lat1_item(p, l, it - 512, lds);
      else attn_item(p, l, it - 768, false, lds);
    }
    grid.sync();
    for (;;) {
      __syncthreads();
      if (tid == 0) s_item = atomicAdd(&cnt[l * 2 + 1], 1);
      __syncthreads();
      int it = s_item;
      if (it >= 64 + 128 + 128 + 128) break;
      if (it < 64) f2l_item(p, it, lds);
      else if (it < 192) attn_item(p, l, it - 64, true, lds);
      else if (it < 320) hgrn_lat2_item(p, l, it - 192, lds);
      else f2c_item(p, it - 320, lds);
    }
    grid.sync();
    for (int it = bid; it < 384; it += G) p5_tile(p, it, lds);
    grid.sync();
    for (int it = bid; it < 384; it += G) p6_tile(p, l, it, lds);
    grid.sync();
  }
}

extern "C" void kernel_launch(void* const* d_in, const int* in_sizes, int n_in,
                              void* d_out, int out_size, void* d_ws, size_t ws_size,
                              hipStream_t stream) {
  static int grid_blocks = 0;
  if (!grid_blocks) {
    int dev = 0, cus = 0;
    (void)hipGetDevice(&dev);
    (void)hipDeviceGetAttribute(&cus, hipDeviceAttributeMultiprocessorCount, dev);
    if (hipFuncSetAttribute((const void*)fwd_megakernel, hipFuncAttributeMaxDynamicSharedMemorySize, LDS_BYTES) != hipSuccess)
      fprintf(stderr, "hipFuncSetAttribute failed\n");
    grid_blocks = cus > 0 ? cus : 256;
    if (ws_size < WS_END) fprintf(stderr, "workspace too small: %zu < %zu\n", ws_size, (size_t)WS_END);
  }
  const void* ins[21];
  for (int i = 0; i < 21; ++i) ins[i] = d_in[i];
  void* outp = d_out; void* wsp = d_ws;
  void* args[23];
  for (int i = 0; i < 21; ++i) args[i] = (void*)&ins[i];
  args[21] = (void*)&outp; args[22] = (void*)&wsp;
  hipError_t e = hipLaunchCooperativeKernel((void*)fwd_megakernel, dim3(grid_blocks), dim3(512), args, LDS_BYTES, stream);
  if (e != hipSuccess) fprintf(stderr, "cooperative launch failed: %s (grid %d)\n", hipGetErrorString(e), grid_blocks);
}
```

```cpp
#include <hip/hip_runtime.h>
#include <hip/hip_cooperative_groups.h>
#include <stdint.h>
#include <cstdio>
namespace cg = cooperative_groups;

typedef unsigned short u16;
using bf16x8 = __attribute__((ext_vector_type(8))) short;
using f32x4 = __attribute__((ext_vector_type(4))) float;
#define MFMA(a, b, c) __builtin_amdgcn_mfma_f32_16x16x32_bf16(a, b, c, 0, 0, 0)

constexpr int NTOK = 12288;
constexpr int NCTX = 8192;
constexpr int LDP = 5120;
constexpr int PQA = 0, PLF = 512, PIA = 1536, PZA = 2048, PQB = 2560, PKB = 3072, PZB = 3584, PUC = 4096, PZC = 4608;
constexpr float EPSV = 1e-6f;
constexpr size_t OCK = 12582912, OCV = 20971520, OST = 29360128;

constexpr size_t OFF_WIN = 0;
constexpr size_t OFF_WBR = OFF_WIN + 8704ull * 1024 * 2;
constexpr size_t OFF_WO = OFF_WBR + 3ull * 1024 * 512 * 2;
constexpr size_t OFF_H = OFF_WO + 1024ull * 1024 * 2;
constexpr size_t OFF_PROJ = OFF_H + 12288ull * 1024 * 2;
constexpr size_t OFF_R1 = OFF_PROJ + 12288ull * LDP * 2;
constexpr size_t OFF_PTC = OFF_R1;
constexpr size_t OFF_PTL = OFF_R1 + 16384ull * 512 * 2;
constexpr size_t OFF_MRG = OFF_R1;
constexpr size_t OFF_SEGU = OFF_R1 + 25165824ull;
constexpr size_t OFF_SEGD = OFF_SEGU + 256ull * 16384 * 4;
constexpr size_t OFF_VTC = OFF_SEGD + 256ull * 128 * 4;
constexpr size_t OFF_VTL = OFF_VTC + 32ull * 4 * 128 * 256 * 2;
constexpr size_t SZ_VTL = 2ull * 4 * 128 * 2304 * 2;
constexpr size_t OFF_KC = OFF_VTL + 2 * SZ_VTL;
constexpr size_t OFF_DL = OFF_KC + 2ull * 2 * 256 * 512 * 2;
constexpr size_t OFF_DC = OFF_DL + 2048ull * 4096 * 2;
constexpr size_t OFF_B1 = OFF_DC + 256ull * 512 * 2;
constexpr size_t OFF_ROPE = OFF_B1 + 256ull * 128 * 2;
constexpr size_t OFF_MOD = OFF_ROPE + 2048ull * 32 * 8;
constexpr size_t OFF_CNT = OFF_MOD + 2ull * 3 * 3072 * 4;
constexpr size_t WS_END = OFF_CNT + 256;

constexpr int LDS_TILE = 131072 + 8192;
#define DUP_MASK 0
constexpr int LDS_BYTES = LDS_TILE + 64;

struct Params {
  const float* in[21];
  float* out;
  char* ws;
};

__device__ __forceinline__ u16 f2bf(float f) {
  uint32_t u = __float_as_uint(f);
  u += 0x7fffu + ((u >> 16) & 1u);
  return (u16)(u >> 16);
}
__device__ __forceinline__ float bf2f(u16 h) { return __uint_as_float(((uint32_t)h) << 16); }
__device__ __forceinline__ uint32_t pack2(float a, float b) { return (uint32_t)f2bf(a) | ((uint32_t)f2bf(b) << 16); }
__device__ __forceinline__ float lo2f(uint32_t u) { return __uint_as_float(u << 16); }
__device__ __forceinline__ float hi2f(uint32_t u) { return __uint_as_float(u & 0xffff0000u); }
__device__ __forceinline__ float siluf(float x) { return x / (1.f + expf(-x)); }
__device__ __forceinline__ float sigmf(float x) { return 1.f / (1.f + expf(-x)); }

__device__ __forceinline__ int otid() { int t = threadIdx.x; asm volatile("" : "+v"(t)); return t; }

union Frag {
  bf16x8 v;
  uint4 q;
  uint2 h[2];
  uint32_t w[4];
};

__device__ __forceinline__ int lds_byte(int r, int c) {
  int st = (r >> 4) * 2 + (c >> 5), rr = r & 15, cc = c & 31, ob = rr * 64 + cc * 2;
  return st * 1024 + (ob ^ (((ob >> 9) & 1) << 5));
}

template <int TM>
__device__ __forceinline__ void gemm_kloop(const u16* __restrict__ X, int ldx, const u16* __restrict__ Y, int ldy,
                                           int K, f32x4 (&acc)[4][TM / 32], char* lds) {
  constexpr int NX = TM / 64;
  constexpr int XT = TM / 32;
  constexpr int STAGE = TM * 128 + 32768;
  const int tid = otid(), lane = tid & 63, wid = tid >> 6, wr = wid >> 2, wc = wid & 3, fr = lane & 15, fq = lane >> 4;
#pragma unroll
  for (int a = 0; a < 4; ++a)
#pragma unroll
    for (int b = 0; b < XT; ++b) acc[a][b] = f32x4{0.f, 0.f, 0.f, 0.f};
  uint4 xr[NX], yr[4];
  const int nk = K >> 6;
  const int lrow = tid >> 3, lc8 = (tid & 7) * 8;
  const u16* xg = X + (size_t)lrow * ldx + lc8;
  const u16* yg = Y + (size_t)lrow * ldy + lc8;
  const int loff = lds_byte(lrow, lc8);
#pragma unroll
  for (int i = 0; i < NX; ++i) xr[i] = *(const uint4*)(xg + (size_t)(64 * i) * ldx);
#pragma unroll
  for (int i = 0; i < 4; ++i) yr[i] = *(const uint4*)(yg + (size_t)(64 * i) * ldy);
#pragma unroll
  for (int i = 0; i < NX; ++i) *(uint4*)(lds + loff + 8192 * i) = xr[i];
#pragma unroll
  for (int i = 0; i < 4; ++i) *(uint4*)(lds + TM * 128 + loff + 8192 * i) = yr[i];
  __syncthreads();
  for (int kt = 0; kt < nk; ++kt) {
    char* cur = lds + (kt & 1) * STAGE;
    char* nxt = lds + ((kt + 1) & 1) * STAGE;
    const bool more = (kt + 1 < nk);
    if (more) {
#pragma unroll
      for (int i = 0; i < NX; ++i) xr[i] = *(const uint4*)(xg + (size_t)(64 * i) * ldx + (kt + 1) * 64);
#pragma unroll
      for (int i = 0; i < 4; ++i) yr[i] = *(const uint4*)(yg + (size_t)(64 * i) * ldy + (kt + 1) * 64);
    }
#pragma unroll
    for (int ks = 0; ks < 2; ++ks) {
      Frag yf[4], xf[XT];
#pragma unroll
      for (int a = 0; a < 4; ++a) yf[a].q = *(const uint4*)(cur + TM * 128 + lds_byte(wc * 64 + a * 16 + fr, ks * 32 + fq * 8));
#pragma unroll
      for (int b = 0; b < XT; ++b) xf[b].q = *(const uint4*)(cur + lds_byte(wr * (TM / 2) + b * 16 + fr, ks * 32 + fq * 8));
#pragma unroll
      for (int a = 0; a < 4; ++a)
#pragma unroll
        for (int b = 0; b < XT; ++b) acc[a][b] = MFMA(yf[a].v, xf[b].v, acc[a][b]);
    }
    if (more) {
#pragma unroll
      for (int i = 0; i < NX; ++i) *(uint4*)(nxt + loff + 8192 * i) = xr[i];
#pragma unroll
      for (int i = 0; i < 4; ++i) *(uint4*)(nxt + TM * 128 + loff + 8192 * i) = yr[i];
    }
    __syncthreads();
  }
}

#define LAS __attribute__((address_space(3)))
constexpr int HTB = 128 * 64 * 2;
constexpr int G8_STAGE_BYTES = 8 * HTB;
__device__ __forceinline__ void stage_rc(int b, int& R, int& C) {
  const int st = b / 1024, sb = b % 1024, swz = sb ^ (((sb >> 9) & 1) << 5);
  R = (st >> 1) * 16 + swz / 64; C = (st & 1) * 32 + (swz % 64) / 2;
}
struct Unit { const char* a; const char* b; int x; int y; };
struct OneUnit {
  Unit u;
  __device__ __forceinline__ bool next(int i, Unit& o) const { if (i != 0) return false; o = u; return true; }
};
template <class Epi, class Sched>
__device__ __forceinline__ void gemm_phase(LAS unsigned char* lds, const int lda, const int ldb, const int K, const Sched& S, const Epi& E) {
  const int tid = otid(), wid = __builtin_amdgcn_readfirstlane(tid >> 6), lane = tid & 63, wr = wid >> 2, wc = wid & 3, fr = lane & 15, fq = lane >> 4;
  const int nt = K / 64;
  unsigned voffA[2], voffB[2];
#pragma unroll
  for (int i = 0; i < 2; ++i) { int R, C; stage_rc(tid * 16 + i * 8192, R, C); voffA[i] = (unsigned)(R * lda + C) * 2u; voffB[i] = (unsigned)(R * ldb + C) * 2u; }
  const size_t kstep = 128;
  const size_t hstepA = (size_t)128 * lda * 2, hstepB = (size_t)128 * ldb * 2;
  const unsigned ldsw = (unsigned)wid * 1024u;
  const int aoff = lds_byte(wr * 64 + fr, fq * 8), boff = lds_byte(wc * 32 + fr, fq * 8);
#define G8_SA(b, h) (((b) * 2 + (h)) * HTB)
#define G8_SB(b, h) ((4 + (b) * 2 + (h)) * HTB)
#define G8_STAGE(bufoff, gbase, voff) do { _Pragma("unroll") for (int _i = 0; _i < 2; ++_i) \
    __builtin_amdgcn_global_load_lds((const unsigned*)((const char*)(gbase) + (voff)[_i]), (LAS unsigned*)(lds + (bufoff) + ldsw + _i * 8192), 16, 0, 0); } while (0)
#define G8_LDA(dst, b, h) do { _Pragma("unroll") for (int m = 0; m < 4; ++m) _Pragma("unroll") for (int k = 0; k < 2; ++k) dst[m][k] = *(const LAS bf16x8*)(lds + G8_SA(b, h) + aoff + m * 2048 + k * 1024); } while (0)
#define G8_LDB(dst, b, h) do { _Pragma("unroll") for (int n = 0; n < 2; ++n) _Pragma("unroll") for (int k = 0; k < 2; ++k) dst[n][k] = *(const LAS bf16x8*)(lds + G8_SB(b, h) + boff + n * 2048 + k * 1024); } while (0)
#define G8_MMA(ai, bj, At, Bt) do { __builtin_amdgcn_s_setprio(1); _Pragma("unroll") for (int m = 0; m < 4; ++m) _Pragma("unroll") for (int n = 0; n < 2; ++n) _Pragma("unroll") for (int k = 0; k < 2; ++k) \
    acc[ai][bj][m][n] = __builtin_amdgcn_mfma_f32_16x16x32_bf16(Bt[n][k], At[m][k], acc[ai][bj][m][n], 0, 0, 0); __builtin_amdgcn_s_setprio(0); } while (0)
#define G8_WAIT_V(n) asm volatile("s_waitcnt vmcnt(" #n ")" ::: "memory")
#define G8_WAIT_L(n) asm volatile("s_waitcnt lgkmcnt(" #n ")" ::: "memory")
#define G8_BAR __builtin_amdgcn_s_barrier()
#define G8_SCHED __builtin_amdgcn_sched_barrier(0)
  Unit cur, nxt; int ui = 0;
  if (!S.next(0, cur)) return;
  f32x4 acc[2][2][4][2];
#pragma unroll
  for (int a = 0; a < 2; ++a)
#pragma unroll
    for (int b = 0; b < 2; ++b)
#pragma unroll
      for (int m = 0; m < 4; ++m)
#pragma unroll
        for (int n = 0; n < 2; ++n) acc[a][b][m][n] = f32x4{0.f, 0.f, 0.f, 0.f};
  bf16x8 At[4][2], B0[2][2], B1[2][2];
  const char* cA = cur.a; const char* cB = cur.b;
  G8_STAGE(G8_SB(0, 0), cB, voffB); G8_STAGE(G8_SA(0, 0), cA, voffA); G8_STAGE(G8_SB(0, 1), cB + hstepB, voffB); G8_STAGE(G8_SA(0, 1), cA + hstepA, voffA);
  if (wr == 1) G8_BAR;
  G8_WAIT_V(4); G8_BAR;
  G8_STAGE(G8_SB(1, 0), cB + kstep, voffB); G8_STAGE(G8_SA(1, 0), cA + kstep, voffA); G8_STAGE(G8_SB(1, 1), cB + hstepB + kstep, voffB);
  G8_WAIT_V(6); G8_BAR;
  for (;;) {
    const bool has_next = S.next(ui + 1, nxt);
    const char* nA = has_next ? nxt.a : cA; const char* nB = has_next ? nxt.b : cB;
    for (int t = 0; t < nt; t += 2) {
      const bool last = (t == nt - 2);
      const char* a1 = cA + (size_t)(t + 1) * kstep;
      const char* a2 = last ? nA : cA + (size_t)(t + 2) * kstep; const char* b2 = last ? nB : cB + (size_t)(t + 2) * kstep;
      const char* a3 = a2 + kstep; const char* b3 = b2 + kstep;
      G8_LDB(B0, 0, 0); G8_SCHED; G8_LDA(At, 0, 0); G8_STAGE(G8_SA(1, 1), a1 + hstepA, voffA);
      G8_WAIT_L(8); G8_BAR; G8_WAIT_L(0); G8_MMA(0, 0, At, B0); G8_BAR; G8_SCHED;
      G8_LDB(B1, 0, 1); G8_STAGE(G8_SB(0, 0), b2, voffB);
      G8_BAR; G8_WAIT_L(0); G8_MMA(0, 1, At, B1); G8_BAR;
      G8_LDA(At, 0, 1); G8_STAGE(G8_SA(0, 0), a2, voffA);
      G8_BAR; G8_WAIT_L(0); G8_MMA(1, 0, At, B0); G8_BAR; G8_SCHED;
      G8_STAGE(G8_SB(0, 1), b2 + hstepB, voffB);
      G8_WAIT_V(6); G8_BAR; G8_MMA(1, 1, At, B1); G8_BAR;
      G8_LDB(B0, 1, 0); G8_SCHED; G8_LDA(At, 1, 0); G8_STAGE(G8_SA(0, 1), a2 + hstepA, voffA);
      G8_WAIT_L(8); G8_BAR; G8_WAIT_L(0); G8_MMA(0, 0, At, B0); G8_BAR; G8_SCHED;
      G8_LDB(B1, 1, 1); G8_STAGE(G8_SB(1, 0), b3, voffB);
      G8_BAR; G8_WAIT_L(0); G8_MMA(0, 1, At, B1); G8_BAR;
      G8_LDA(At, 1, 1); G8_STAGE(G8_SA(1, 0), a3, voffA);
      G8_BAR; G8_WAIT_L(0); G8_MMA(1, 0, At, B0); G8_BAR; G8_SCHED;
      G8_STAGE(G8_SB(1, 1), b3 + hstepB, voffB);
      G8_WAIT_V(6); G8_BAR; G8_MMA(1, 1, At, B1); G8_BAR;
    }
    E(acc, cur, wr, wc, fr, fq, lds);
    if (!has_next) break;
#pragma unroll
    for (int a = 0; a < 2; ++a)
#pragma unroll
      for (int b = 0; b < 2; ++b)
#pragma unroll
        for (int m = 0; m < 4; ++m)
#pragma unroll
          for (int n = 0; n < 2; ++n) acc[a][b][m][n] = f32x4{0.f, 0.f, 0.f, 0.f};
    cur = nxt; cA = nA; cB = nB; ++ui;
  }
  G8_WAIT_V(0);
  if (wr == 0) G8_BAR;
  G8_BAR;
}

__device__ __forceinline__ void p0_item(const Params& p, int item, char* lds) {
  const int tid = otid();
  char* ws = p.ws;
  if (item < 96) {
    float* sc = (float*)lds;
    float* red = sc + 3072;
    const int l = item / 48, cgp = item % 48;
    const float* cctx = p.in[6]; const float* cc2 = p.in[2];
    for (int i = tid; i < 3072; i += 512) {
      int j = i >> 10, k = i & 1023;
      float c = (j == 0) ? cctx[k] : cc2[(j > 0 ? j - 1 : 0) * 1024 + k];
      sc[i] = siluf(c);
    }
    __syncthreads();
    const int col = tid & 63, kg = tid >> 6;
    const float* W = p.in[7] + (size_t)l * 1024 * 3072 + cgp * 64 + col;
    float a0 = 0.f, a1 = 0.f, a2 = 0.f;
    for (int k = kg * 128; k < kg * 128 + 128; ++k) {
      float w = W[(size_t)k * 3072];
      a0 += sc[k] * w; a1 += sc[1024 + k] * w; a2 += sc[2048 + k] * w;
    }
    red[(kg * 3 + 0) * 64 + col] = a0; red[(kg * 3 + 1) * 64 + col] = a1; red[(kg * 3 + 2) * 64 + col] = a2;
    __syncthreads();
    if (tid < 192) {
      int j = tid >> 6; float s = 0.f;
      for (int g = 0; g < 8; ++g) s += red[(g * 3 + j) * 64 + col];
      int n = cgp * 64 + col;
      ((float*)(ws + OFF_MOD))[(l * 3 + j) * 3072 + n] = s + p.in[8][l * 3072 + n];
    }
    __syncthreads();
    return;
  }
  item -= 96;
  if (item < 128) {
    int idx = item * 512 + tid, t = idx >> 5, c = idx & 31, fi = c & 15;
    float pos = (c < 16) ? (float)(t >> 6) : (float)(t & 63);
    float inv = powf(10000.f, -(float)fi / 16.f);
    float ang = pos * inv;
    ((float2*)(ws + OFF_ROPE))[idx] = make_float2(cosf(ang), sinf(ang));
    return;
  }
  item -= 128;
  if (item < 2048) {
    int idx = item * 512 + tid, tp = idx >> 9, k0 = (idx & 511) * 8;
    uint32_t o[4];
    float vv[8];
#pragma unroll
    for (int j = 0; j < 8; ++j) {
      int k = k0 + j; int m = (tp * (k & 2047)) & 2047; float s, c;
      sincospif((float)m * (1.f / 1024.f), &s, &c);
      vv[j] = (k < 2048) ? c : -s;
    }
#pragma unroll
    for (int j = 0; j < 4; ++j) o[j] = pack2(vv[2 * j], vv[2 * j + 1]);
    *(uint4*)(ws + OFF_DL + (size_t)idx * 16) = make_uint4(o[0], o[1], o[2], o[3]);
    return;
  }
  item -= 2048;
  if (item < 32) {
    int idx = item * 512 + tid, tp = idx >> 6, k0 = (idx & 63) * 8;
    uint32_t o[4];
    float vv[8];
#pragma unroll
    for (int j = 0; j < 8; ++j) {
      int k = k0 + j; int m = (tp * (k & 255)) & 255; float s, c;
      sincospif((float)m * (1.f / 128.f), &s, &c);
      vv[j] = (k < 256) ? c : -s;
    }
#pragma unroll
    for (int j = 0; j < 4; ++j) o[j] = pack2(vv[2 * j], vv[2 * j + 1]);
    *(uint4*)(ws + OFF_DC + (size_t)idx * 16) = make_uint4(o[0], o[1], o[2], o[3]);
    return;
  }
  item -= 32;
  if (item < 8) {
    int idx = item * 512 + tid, j = idx >> 4, c0 = (idx & 15) * 8;
    uint32_t o[4];
    float vv[8];
#pragma unroll
    for (int q = 0; q < 8; ++q) {
      int m = ((j & 127) * (c0 + q)) & 127; float s, c;
      sincospif((float)m * (1.f / 64.f), &s, &c);
      vv[q] = (j < 128) ? c : s;
    }
#pragma unroll
    for (int q = 0; q < 4; ++q) o[q] = pack2(vv[2 * q], vv[2 * q + 1]);
    *(uint4*)(ws + OFF_B1 + (size_t)idx * 16) = make_uint4(o[0], o[1], o[2], o[3]);
    return;
  }
  item -= 8;
  if (item < 128) {
    int idx = item * 512 + tid; int e = idx * 8;
    int n = e & 511, t = (e >> 9) & 255, l = (e >> 17) & 1, b = e >> 18;
    const float4* s = (const float4*)(p.in[3] + e);
    float4 a = s[0], c = s[1];
    size_t d = ((size_t)((l * 2 + b) * 256 + t)) * 512 + n;
    *(uint4*)(ws + OFF_KC + d * 2) = make_uint4(pack2(a.x, a.y), pack2(a.z, a.w), pack2(c.x, c.y), pack2(c.z, c.w));
    return;
  }
  item -= 128;
  {
    int idx = item * 512 + tid;
    int v = idx & 127, tc = (idx >> 7) & 31, h = (idx >> 12) & 3, b = (idx >> 14) & 1, l = idx >> 15;
    float vv[8];
#pragma unroll
    for (int j = 0; j < 8; ++j) vv[j] = p.in[4][((size_t)((b * 2 + l) * 256 + tc * 8 + j)) * 512 + h * 128 + v];
    size_t d = ((size_t)((b * 4 + h) * 128 + v)) * 2304 + 2048 + tc * 8;
    *(uint4*)(ws + OFF_VTL + l * SZ_VTL + d * 2) = make_uint4(pack2(vv[0], vv[1]), pack2(vv[2], vv[3]), pack2(vv[4], vv[5]), pack2(vv[6], vv[7]));
  }
}
constexpr int P0_ITEMS = 96 + 128 + 2048 + 32 + 8 + 128 + 128;

__device__ __forceinline__ void p1_item(const Params& p, int l, int item, char* lds) {
  const int tid = otid();
  char* ws = p.ws;
  if (item < 2816) {
    const float* src; int lsrc; u16* dst; int ldd; int kt, nt;
    const float* w10 = p.in[10]; const float* w17 = p.in[17]; const float* w18 = p.in[18]; const float* w19 = p.in[19]; const float* w20 = p.in[20];
    if (item < 2176) { src = w10 + (size_t)l * 1024 * 8704; lsrc = 8704; dst = (u16*)(ws + OFF_WIN); ldd = 1024; nt = item >> 4; kt = item & 15; }
    else if (item < 2560) { int r = item - 2176; int j = r >> 7; r &= 127; src = ((j == 0) ? w17 : ((j == 1) ? w18 : w19)) + (size_t)l * 512 * 1024; lsrc = 1024; dst = (u16*)(ws + OFF_WBR) + (size_t)j * 1024 * 512; ldd = 512; nt = r >> 3; kt = r & 7; }
    else { int r = item - 2560; src = w20 + (size_t)l * 1024 * 1024; lsrc = 1024; dst = (u16*)(ws + OFF_WO); ldd = 1024; nt = r >> 4; kt = r & 15; }
    u16* T = (u16*)lds;
    const int k0 = kt * 64, n0 = nt * 64;
#pragma unroll
    for (int ps = 0; ps < 2; ++ps) {
      int kr = (tid >> 4) + 32 * ps, nq = tid & 15;
      float4 v = *(const float4*)(src + (size_t)(k0 + kr) * lsrc + n0 + 4 * nq);
      T[(4 * nq + 0) * 72 + kr] = f2bf(v.x); T[(4 * nq + 1) * 72 + kr] = f2bf(v.y);
      T[(4 * nq + 2) * 72 + kr] = f2bf(v.z); T[(4 * nq + 3) * 72 + kr] = f2bf(v.w);
    }
    __syncthreads();
    {
      int n = tid >> 3, kc = tid & 7;
      uint4 o = *(const uint4*)(T + n * 72 + kc * 8);
      *(uint4*)(dst + (size_t)(n0 + n) * ldd + k0 + kc * 8) = o;
    }
    __syncthreads();
    return;
  }
  item -= 2816;
  const int lane = tid & 63, wid = tid >> 6;
  const float* modp = (const float*)(ws + OFF_MOD);
  u16* H = (u16*)(ws + OFF_H);
  const float* xin0 = p.in[0]; const float* xin1 = p.in[1]; const float* xin2 = p.out; const float* ng = p.in[9];
#pragma unroll
  for (int rr = 0; rr < 2; ++rr) {
    int r = item * 16 + wid * 2 + rr;
    const float* x = (l == 0) ? ((r < NCTX) ? xin0 + (size_t)r * 1024 : xin1 + (size_t)(r - NCTX) * 1024) : xin2 + (size_t)r * 1024;
    int ci = (r < NCTX) ? 0 : 1 + ((r - NCTX) >> 11);
    float4 v[4]; float ss = 0.f;
#pragma unroll
    for (int i = 0; i < 4; ++i) { v[i] = *(const float4*)(x + lane * 4 + 256 * i); ss += v[i].x * v[i].x + v[i].y * v[i].y + v[i].z * v[i].z + v[i].w * v[i].w; }
#pragma unroll
    for (int o = 32; o >= 1; o >>= 1) ss += __shfl_xor(ss, o);
    float rinv = rsqrtf(ss * (1.f / 1024.f) + EPSV);
    const float* sh = modp + (l * 3 + ci) * 3072;
#pragma unroll
    for (int i = 0; i < 4; ++i) {
      int col = lane * 4 + 256 * i;
      float4 g = *(const float4*)(ng + l * 1024 + col);
      float4 s1 = *(const float4*)(sh + 1024 + col);
      float4 s0 = *(const float4*)(sh + col);
      float a = v[i].x * rinv * g.x * (1.f + s1.x) + s0.x;
      float b = v[i].y * rinv * g.y * (1.f + s1.y) + s0.y;
      float c = v[i].z * rinv * g.z * (1.f + s1.z) + s0.z;
      float d = v[i].w * rinv * g.w * (1.f + s1.w) + s0.w;
      *(uint2*)(H + (size_t)r * 1024 + col) = make_uint2(pack2(a, b), pack2(c, d));
    }
  }
}
constexpr int P1_ITEMS = 2816 + 768;

struct P2Sched {
  const char* H; const char* W; int G, c;
  __device__ __forceinline__ bool next(int i, Unit& u) const {
    const int L = i * G + c;
    if (L >= 1056) return false;
    if (L < 960) {
      const int nM = 48, nN = 20, nwg = 960;
      int wgid = L; { const int q = nwg / 8, xcd = wgid % 8, off = wgid / 8; wgid = xcd * q + off; }
      const int nig = 8 * nN, gid = wgid / nig, fm = gid * 8, gsz = (nM - fm) < 8 ? (nM - fm) : 8;
      int pm = fm + ((wgid % nig) % gsz), pn = (wgid % nig) / gsz;
      if (pn >= 14) pn += 2;
      u.a = H + (size_t)pm * 256 * 2048; u.b = W + (size_t)pn * 256 * 2048; u.x = pm; u.y = pn;
    } else {
      const int r = L - 960; const int vq = r / 48, mt = r % 48;
      u.a = W + (size_t)(3584 + vq * 256) * 2048; u.b = H + (size_t)mt * 256 * 2048; u.x = vq; u.y = mt | 0x100;
    }
    return true;
  }
};
struct P2Epi {
  const float* const* pin; float* out; char* ws; int l;
  const float* hlb; const float* qng; const float* kng;
  __device__ __forceinline__ void operator()(f32x4 (&acc)[2][2][4][2], const Unit& u, int wr, int wc, int fr, int fq, LAS unsigned char* lds) const {
    { const int t_ = otid(); const int w_ = t_ >> 6; wr = w_ >> 2; wc = w_ & 3; fr = t_ & 15; fq = (t_ & 63) >> 4; }
    if (u.y & 0x100) {
      const int mt = u.y & 0xff, vq = u.x;
#pragma unroll
      for (int ai = 0; ai < 2; ++ai)
#pragma unroll
        for (int m = 0; m < 4; ++m) {
          const int nn = vq * 256 + ai * 128 + wr * 64 + m * 16 + fr;
          const int hh = nn >> 7, v = nn & 127;
#pragma unroll
          for (int bj = 0; bj < 2; ++bj)
#pragma unroll
            for (int n = 0; n < 2; ++n) {
              const int tokl = bj * 128 + wc * 32 + n * 16 + 4 * fq;
              f32x4 a4 = acc[ai][bj][m][n];
              uint2 pk = make_uint2(pack2(a4[0], a4[1]), pack2(a4[2], a4[3]));
              if (mt < 32) {
                *(uint2*)(ws + OFF_VTC + ((size_t)((mt * 4 + hh) * 128 + v) * 256 + tokl) * 2) = pk;
                float* o = out + OCV + ((size_t)((mt * 2 + l) * 256 + tokl)) * 512 + nn;
                o[0] = a4[0]; o[512] = a4[1]; o[1024] = a4[2]; o[1536] = a4[3];
              } else {
                int rp = (mt - 32) * 256 + tokl; int bb = rp >> 11, t = rp & 2047;
                *(uint2*)(ws + OFF_VTL + l * SZ_VTL + ((size_t)((bb * 4 + hh) * 128 + v) * 2304 + t) * 2) = pk;
              }
            }
        }
      return;
    }
    const int pm = u.x, pn = u.y, seg = pn >> 1, ncol0 = (pn & 1) * 256;
    const int dcol0 = ((seg < 7) ? seg : seg - 1) * 512 + ncol0;
    u16* proj = (u16*)(ws + OFF_PROJ);
    const bool lat = (pm >= 32);
    if (seg == 5 || seg == 6) {
      float* xch = (float*)(lds + G8_STAGE_BYTES);
#pragma unroll
      for (int ai = 0; ai < 2; ++ai)
#pragma unroll
        for (int m = 0; m < 4; ++m)
#pragma unroll
          for (int bj = 0; bj < 2; ++bj) {
            float ss = 0.f;
#pragma unroll
            for (int n = 0; n < 2; ++n)
#pragma unroll
              for (int e = 0; e < 4; ++e) { float bfv = bf2f(f2bf(acc[ai][bj][m][n][e])); ss += bfv * bfv; }
            ss += __shfl_xor(ss, 16); ss += __shfl_xor(ss, 32);
            if (fq == 0) xch[((ai * 128 + wr * 64 + m * 16 + fr) * 2 + bj) * 4 + wc] = ss;
          }
      asm volatile("s_waitcnt lgkmcnt(0)" ::: "memory");
      __builtin_amdgcn_s_barrier();
      asm volatile("" ::: "memory");
      const float* gsel = (seg == 5) ? qng : kng;
      float gv[2][4];
#pragma unroll
      for (int n = 0; n < 2; ++n)
#pragma unroll
        for (int e = 0; e < 4; ++e) gv[n][e] = gsel[l * 64 + 32 * (wc & 1) + 16 * n + 4 * fq + e];
#pragma unroll
      for (int ai = 0; ai < 2; ++ai)
#pragma unroll
        for (int m = 0; m < 4; ++m) {
          const int rl = ai * 128 + wr * 64 + m * 16 + fr;
          const int grow = pm * 256 + rl;
#pragma unroll
          for (int bj = 0; bj < 2; ++bj) {
            const float2 pr = *(const float2*)&xch[(rl * 2 + bj) * 4 + (wc & 2)];
            const float tot = pr.x + pr.y;
            const float rinv = rsqrtf(tot * (1.f / 64.f) + EPSV);
            float x[2][4];
#pragma unroll
            for (int n = 0; n < 2; ++n)
#pragma unroll
              for (int e = 0; e < 4; ++e) x[n][e] = bf2f(f2bf(acc[ai][bj][m][n][e])) * rinv * gv[n][e];
            const int colt = ncol0 + bj * 128 + wc * 32;
            if (seg == 6 && !lat) {
              float* o = out + OCK + ((size_t)((pm * 2 + l) * 256 + rl)) * 512 + colt + 4 * fq;
              *(float4*)o = make_float4(x[0][0], x[0][1], x[0][2], x[0][3]);
              *(float4*)(o + 16) = make_float4(x[1][0], x[1][1], x[1][2], x[1][3]);
            }
            if (lat) {
              const int t = (grow - NCTX) & 2047;
              const float2* rt = (const float2*)(ws + OFF_ROPE) + t * 32 + ((wc & 1) ? 16 : 0) + 4 * fq;
#pragma unroll
              for (int e = 0; e < 4; ++e) {
                float2 cs = rt[e];
                float x1 = x[0][e], x2 = x[1][e];
                x[0][e] = x1 * cs.x - x2 * cs.y;
                x[1][e] = x1 * cs.y + x2 * cs.x;
              }
            }
            if (seg == 5) {
#pragma unroll
              for (int n = 0; n < 2; ++n)
#pragma unroll
                for (int e = 0; e < 4; ++e) x[n][e] *= 0.125f;
            }
            u16* dp = proj + (size_t)grow * LDP + dcol0 + bj * 128 + wc * 32 + 4 * fq;
            *(uint2*)dp = make_uint2(pack2(x[0][0], x[0][1]), pack2(x[0][2], x[0][3]));
            *(uint2*)(dp + 16) = make_uint2(pack2(x[1][0], x[1][1]), pack2(x[1][2], x[1][3]));
          }
        }
      return;
    }
    const bool dosilu = (seg == 0 || seg == 4 || seg == 8 || seg == 10);
    const bool dolf = (seg == 1 || seg == 2);
    const int dir = (seg == 2) ? 1 : 0;
#pragma unroll
    for (int bj = 0; bj < 2; ++bj)
#pragma unroll
      for (int n = 0; n < 2; ++n) {
        float lbv[4];
        if (dolf) {
#pragma unroll
          for (int e = 0; e < 4; ++e) {
            int j = ncol0 + bj * 128 + wc * 32 + n * 16 + 4 * fq + e;
            lbv[e] = (l == 0) ? 0.f : sigmf(hlb[(1 * 2 + dir) * 512 + j] - hlb[(0 * 2 + dir) * 512 + j]);
          }
        }
#pragma unroll
        for (int ai = 0; ai < 2; ++ai)
#pragma unroll
          for (int m = 0; m < 4; ++m) {
            const int grow = pm * 256 + ai * 128 + wr * 64 + m * 16 + fr;
            f32x4 a4 = acc[ai][bj][m][n];
            if (dosilu) {
#pragma unroll
              for (int e = 0; e < 4; ++e) a4[e] = siluf(a4[e]);
            } else if (dolf) {
#pragma unroll
              for (int e = 0; e < 4; ++e) {
                float xx = a4[e];
                float lf;
                if (l == 0) lf = (xx < -15.f) ? xx : -log1pf(expf(-xx));
                else lf = logf(lbv[e] + (1.f - lbv[e]) * sigmf(xx));
                a4[e] = lf;
              }
            }
            *(uint2*)(proj + (size_t)grow * LDP + dcol0 + bj * 128 + wc * 32 + n * 16 + 4 * fq) = make_uint2(pack2(a4[0], a4[1]), pack2(a4[2], a4[3]));
          }
      }
  }
};
__device__ __forceinline__ void p2_phase(const Params& p, int l, char* lds) {
  P2Sched S; S.H = p.ws + OFF_H; S.W = p.ws + OFF_WIN; S.G = gridDim.x; S.c = blockIdx.x;
  P2Epi E; E.pin = nullptr; E.out = p.out; E.ws = p.ws; E.l = l; E.hlb = p.in[11]; E.qng = p.in[13]; E.kng = p.in[14];
  gemm_phase((LAS unsigned char*)lds, 1024, 1024, 1024, S, E);
}

struct HgrnLds {
  float tot[4][128];
  float dk[128];
  float osum[16][132];
  u16 qt[16][136];
  u16 kt[16][136];
  u16 khT[128][16];
  u16 vT[128][16];
  u16 obuf[256][136];
};

__device__ __forceinline__ void hgrn_pass(const Params& p, int l, int row0, int ntok, int h, int dir, f32x4 (&S)[8],
                                          const bool do_out, const bool second, float& gsum, HgrnLds& L) {
  const int tid = otid(), lane = tid & 63, wid = tid >> 6, c16 = lane & 15, g = lane >> 4;
  const int kk = tid & 127, tq = tid >> 7;
  const u16* proj = (const u16*)(p.ws + OFF_PROJ);
  u16* projw = (u16*)(p.ws + OFF_PROJ);
  const int nch = ntok >> 4;
  u16 lfr[4], qr[4], vr[4];
  auto ldchunk = [&](int c) {
#pragma unroll
    for (int i = 0; i < 4; ++i) {
      int s = c * 16 + 4 * tq + i;
      int tl = dir ? (ntok - 1 - s) : s;
      const u16* rp = proj + (size_t)(row0 + tl) * LDP + h * 128 + kk;
      lfr[i] = rp[PLF + dir * 512];
      vr[i] = rp[PIA];
      qr[i] = do_out ? rp[PQA] : (u16)0;
    }
  };
  ldchunk(0);
  for (int c = 0; c < nch; ++c) {
    float lf[4], G[4], qv[4];
    u16 vv[4];
#pragma unroll
    for (int i = 0; i < 4; ++i) { lf[i] = bf2f(lfr[i]); qv[i] = bf2f(qr[i]); vv[i] = vr[i]; }
    G[0] = lf[0]; G[1] = G[0] + lf[1]; G[2] = G[1] + lf[2]; G[3] = G[2] + lf[3];
    L.tot[tq][kk] = G[3];
    __syncthreads();
    if (c + 1 < nch) ldchunk(c + 1);
    float t0 = L.tot[0][kk], t1 = L.tot[1][kk], t2 = L.tot[2][kk], t3 = L.tot[3][kk];
    float off = (tq > 0 ? t0 : 0.f) + (tq > 1 ? t1 : 0.f) + (tq > 2 ? t2 : 0.f);
    float gend = t0 + t1 + t2 + t3;
    float kh[4];
#pragma unroll
    for (int i = 0; i < 4; ++i) {
      float Gi = G[i] + off;
      float kv = -expm1f(lf[i]);
      int s = 4 * tq + i;
      if (do_out) {
        L.qt[s][kk] = f2bf(qv[i] * expf(Gi));
        L.kt[s][kk] = f2bf(kv * expf(-Gi));
      }
      kh[i] = kv * expf(gend - Gi);
    }
    *(uint2*)&L.khT[kk][4 * tq] = make_uint2(pack2(kh[0], kh[1]), pack2(kh[2], kh[3]));
    *(uint2*)&L.vT[kk][4 * tq] = make_uint2((uint32_t)vv[0] | ((uint32_t)vv[1] << 16), (uint32_t)vv[2] | ((uint32_t)vv[3] << 16));
    if (tq == 0) { L.dk[kk] = expf(gend); gsum += gend; }
    __syncthreads();
    Frag bv;
    bv.h[0] = *(const uint2*)&L.vT[16 * wid + c16][4 * g];
    bv.h[1] = make_uint2(0u, 0u);
    f32x4 o = f32x4{0.f, 0.f, 0.f, 0.f};
    if (do_out) {
      f32x4 at = f32x4{0.f, 0.f, 0.f, 0.f};
#pragma unroll
      for (int ks = 0; ks < 4; ++ks) {
        Frag a, b;
        a.q = *(const uint4*)&L.kt[c16][32 * ks + 8 * g];
        b.q = *(const uint4*)&L.qt[c16][32 * ks + 8 * g];
        at = MFMA(a.v, b.v, at);
      }
      Frag pa;
#pragma unroll
      for (int r = 0; r < 4; ++r) at[r] = (4 * g + r <= c16) ? at[r] : 0.f;
      pa.w[0] = pack2(at[0], at[1]); pa.w[1] = pack2(at[2], at[3]); pa.w[2] = 0u; pa.w[3] = 0u;
      o = MFMA(pa.v, bv.v, o);
#pragma unroll
      for (int st = 0; st < 4; ++st) {
        Frag a, b;
        a.h[0] = *(const uint2*)&L.qt[c16][32 * st + 4 * g];
        a.h[1] = *(const uint2*)&L.qt[c16][32 * st + 16 + 4 * g];
        b.w[0] = pack2(S[2 * st][0], S[2 * st][1]); b.w[1] = pack2(S[2 * st][2], S[2 * st][3]);
        b.w[2] = pack2(S[2 * st + 1][0], S[2 * st + 1][1]); b.w[3] = pack2(S[2 * st + 1][2], S[2 * st + 1][3]);
        o = MFMA(a.v, b.v, o);
      }
    }
#pragma unroll
    for (int k8 = 0; k8 < 8; ++k8) {
      float4 d = *(const float4*)&L.dk[16 * k8 + 4 * g];
      f32x4 s0 = S[k8];
      s0[0] *= d.x; s0[1] *= d.y; s0[2] *= d.z; s0[3] *= d.w;
      Frag a;
      a.h[0] = *(const uint2*)&L.khT[16 * k8 + c16][4 * g];
      a.h[1] = make_uint2(0u, 0u);
      S[k8] = MFMA(a.v, bv.v, s0);
    }
    if (do_out) {
      const int vcol = 16 * wid + c16;
      if (!second) {
#pragma unroll
        for (int r = 0; r < 4; ++r) {
          int s = c * 16 + 4 * g + r;
          int tl = dir ? (ntok - 1 - s) : s;
          L.obuf[tl][vcol] = f2bf(o[r]);
        }
      } else {
#pragma unroll
        for (int r = 0; r < 4; ++r) {
          int s = c * 16 + 4 * g + r;
          int tl = dir ? (ntok - 1 - s) : s;
          L.osum[4 * g + r][vcol] = o[r] + bf2f(L.obuf[tl][vcol]);
        }
        __syncthreads();
        {
          int sl = tid >> 5, vq = tid & 31;
          int s = c * 16 + sl;
          int tl = dir ? (ntok - 1 - s) : s;
          float4 ov = *(const float4*)&L.osum[sl][4 * vq];
          float ss = ov.x * ov.x + ov.y * ov.y + ov.z * ov.z + ov.w * ov.w;
#pragma unroll
          for (int m = 1; m <= 16; m <<= 1) ss += __shfl_xor(ss, m);
          float rinv = rsqrtf(ss * (1.f / 128.f) + EPSV);
          float4 gg = *(const float4*)(p.in[12] + l * 512 + h * 128 + 4 * vq);
          u16* rp = projw + (size_t)(row0 + tl) * LDP + h * 128 + 4 * vq;
          uint2 z = *(const uint2*)(rp + PZA);
          float y0 = ov.x * rinv * gg.x * lo2f(z.x), y1 = ov.y * rinv * gg.y * hi2f(z.x);
          float y2 = ov.z * rinv * gg.z * lo2f(z.y), y3 = ov.w * rinv * gg.w * hi2f(z.y);
          *(uint2*)(rp + PQA) = make_uint2(pack2(y0, y1), pack2(y2, y3));
        }
      }
    }
  }
  __syncthreads();
}

__device__ __forceinline__ void hgrn_load_state(const float* m, f32x4 (&S)[8]) {
  const int tid_ = otid(); const int lane = tid_ & 63, wid = tid_ >> 6, c16 = lane & 15, g = lane >> 4;
#pragma unroll
  for (int k8 = 0; k8 < 8; ++k8)
#pragma unroll
    for (int r = 0; r < 4; ++r) S[k8][r] = m[(16 * k8 + 4 * g + r) * 128 + 16 * wid + c16];
}
__device__ __forceinline__ void hgrn_store_state(float* m, const f32x4 (&S)[8]) {
  const int tid_ = otid(); const int lane = tid_ & 63, wid = tid_ >> 6, c16 = lane & 15, g = lane >> 4;
#pragma unroll
  for (int k8 = 0; k8 < 8; ++k8)
#pragma unroll
    for (int r = 0; r < 4; ++r) m[(16 * k8 + 4 * g + r) * 128 + 16 * wid + c16] = S[k8][r];
}
__device__ __forceinline__ void hgrn_advance(const float* U, const float* D, f32x4 (&S)[8]) {
  const int tid_ = otid(); const int lane = tid_ & 63, wid = tid_ >> 6, c16 = lane & 15, g = lane >> 4;
#pragma unroll
  for (int k8 = 0; k8 < 8; ++k8)
#pragma unroll
    for (int r = 0; r < 4; ++r) {
      int k = 16 * k8 + 4 * g + r;
      S[k8][r] = D[k] * S[k8][r] + U[k * 128 + 16 * wid + c16];
    }
}

__device__ __forceinline__ void hgrn_ctx_item(const Params& p, int l, int item, char* lds) {
  HgrnLds& L = *(HgrnLds*)lds;
  const int b = item >> 2, h = item & 3;
  f32x4 S[8];
  float gsum = 0.f;
#pragma unroll
  for (int i = 0; i < 8; ++i) S[i] = f32x4{0.f, 0.f, 0.f, 0.f};
  hgrn_pass(p, l, b * 256, 256, h, 0, S, true, false, gsum, L);
  hgrn_store_state(p.out + OST + ((size_t)(((b * 2 + l) * 2 + 0) * 4 + h)) * 16384, S);
#pragma unroll
  for (int i = 0; i < 8; ++i) S[i] = f32x4{0.f, 0.f, 0.f, 0.f};
  hgrn_pass(p, l, b * 256, 256, h, 1, S, true, true, gsum, L);
  hgrn_store_state(p.out + OST + ((size_t)(((b * 2 + l) * 2 + 1) * 4 + h)) * 16384, S);
}
__device__ __forceinline__ void hgrn_lat1_item(const Params& p, int l, int item, char* lds) {
  HgrnLds& L = *(HgrnLds*)lds;
  const int seg = item & 15, dir = (item >> 4) & 1, h = (item >> 5) & 3, b = item >> 7;
  f32x4 S[8];
  float gsum = 0.f;
#pragma unroll
  for (int i = 0; i < 8; ++i) S[i] = f32x4{0.f, 0.f, 0.f, 0.f};
  hgrn_pass(p, l, NCTX + b * 2048 + seg * 128, 128, h, dir, S, false, false, gsum, L);
  hgrn_store_state((float*)(p.ws + OFF_SEGU) + (size_t)item * 16384, S);
  { const int t_ = otid(); if (t_ < 128) ((float*)(p.ws + OFF_SEGD))[item * 128 + t_] = expf(gsum); }
}
__device__ __forceinline__ void hgrn_lat2_item(const Params& p, int l, int item, char* lds) {
  HgrnLds& L = *(HgrnLds*)lds;
  const int seg = item & 15, h = (item >> 4) & 3, b = item >> 6;
  const float* SU = (const float*)(p.ws + OFF_SEGU);
  const float* SD = (const float*)(p.ws + OFF_SEGD);
  f32x4 S[8];
  float gsum = 0.f;
  hgrn_load_state(p.in[5] + ((size_t)(((b * 2 + l) * 2 + 0) * 4 + h)) * 16384, S);
  for (int i = 0; i < seg; ++i) {
    int it = ((b * 4 + h) * 2 + 0) * 16 + i;
    hgrn_advance(SU + (size_t)it * 16384, SD + it * 128, S);
  }
  hgrn_pass(p, l, NCTX + b * 2048 + seg * 128, 128, h, 0, S, true, false, gsum, L);
  hgrn_load_state(p.in[5] + ((size_t)(((b * 2 + l) * 2 + 1) * 4 + h)) * 16384, S);
  for (int i = 15; i > seg; --i) {
    int it = ((b * 4 + h) * 2 + 1) * 16 + i;
    hgrn_advance(SU + (size_t)it * 16384, SD + it * 128, S);
  }
  hgrn_pass(p, l, NCTX + b * 2048 + seg * 128, 128, h, 1, S, true, true, gsum, L);
}

__device__ __forceinline__ void attn_item(const Params& p, int l, int item, const bool lat, char* lds) {
  const int tid = otid(), lane = tid & 63, wid = tid >> 6, c16 = lane & 15, g = lane >> 4;
  char* ws = p.ws;
  u16* proj = (u16*)(ws + OFF_PROJ);
  int b, h, qb, nkeys, rowbase;
  const u16* Vt; int ldv;
  if (!lat) { qb = item & 1; h = (item >> 1) & 3; b = item >> 3; nkeys = 256; rowbase = b * 256; Vt = (const u16*)(ws + OFF_VTC) + (size_t)((b * 4 + h) * 128) * 256; ldv = 256; }
  else { qb = item & 15; h = (item >> 4) & 3; b = item >> 6; nkeys = 2304; rowbase = NCTX + b * 2048; Vt = (const u16*)(ws + OFF_VTL + l * SZ_VTL) + (size_t)((b * 4 + h) * 128) * 2304; ldv = 2304; }
  const u16* Kc = (const u16*)(ws + OFF_KC) + (size_t)((l * 2 + b) * 256) * 512 + h * 128;
  u16* Ks = (u16*)lds;
  u16* Vs = Ks + 64 * 136;
  float lam_init = 0.8f - 0.6f * expf(-0.3f * (float)l);
  float lam;
  {
    const float* lp = p.in[15] + l * 256;
    float a = lp[lane] * lp[64 + lane], c = lp[128 + lane] * lp[192 + lane];
#pragma unroll
    for (int o = 32; o >= 1; o >>= 1) { a += __shfl_xor(a, o); c += __shfl_xor(c, o); }
    lam = expf(a) - expf(c) + lam_init;
  }
  const int qrow = rowbase + qb * 128 + wid * 16 + c16;
  Frag qf[2][2];
#pragma unroll
  for (int m = 0; m < 2; ++m)
#pragma unroll
    for (int ks = 0; ks < 2; ++ks) qf[m][ks].q = *(const uint4*)(proj + (size_t)qrow * LDP + PQB + h * 128 + m * 64 + ks * 32 + g * 8);
  f32x4 O[2][8];
#pragma unroll
  for (int m = 0; m < 2; ++m)
#pragma unroll
    for (int v = 0; v < 8; ++v) O[m][v] = f32x4{0.f, 0.f, 0.f, 0.f};
  float mrun[2] = {-1e30f, -1e30f}, lsum[2] = {0.f, 0.f};
  uint4 kr0, kr1, vr0, vr1;
#define ATT_LD(kt_)                                                                                           \
  {                                                                                                           \
    const int key0 = (kt_) * 64;                                                                              \
    const bool fromproj = (!lat) || (key0 < 2048);                                                            \
    {                                                                                                         \
      int q = tid; int key = q >> 4, cc = q & 15;                                                             \
      const u16* src = fromproj ? proj + (size_t)(rowbase + key0 + key) * LDP + PKB + h * 128 + cc * 8        \
                                : Kc + (size_t)(key0 - 2048 + key) * 512 + cc * 8;                            \
      kr0 = *(const uint4*)src;                                                                               \
      int v = q >> 3, c8 = q & 7;                                                                             \
      vr0 = *(const uint4*)(Vt + (size_t)v * ldv + key0 + c8 * 8);                                            \
    }                                                                                                         \
    {                                                                                                         \
      int q = tid + 512; int key = q >> 4, cc = q & 15;                                                       \
      const u16* src = fromproj ? proj + (size_t)(rowbase + key0 + key) * LDP + PKB + h * 128 + cc * 8        \
                                : Kc + (size_t)(key0 - 2048 + key) * 512 + cc * 8;                            \
      kr1 = *(const uint4*)src;                                                                               \
      int v = q >> 3, c8 = q & 7;                                                                             \
      vr1 = *(const uint4*)(Vt + (size_t)v * ldv + key0 + c8 * 8);                                            \
    }                                                                                                         \
  }
#define ATT_ST()                                                                                              \
  {                                                                                                           \
    { int q = tid; int key = q >> 4, cc = q & 15; *(uint4*)(Ks + key * 136 + cc * 8) = kr0;                   \
      int v = q >> 3, c8 = q & 7; *(uint4*)(Vs + v * 72 + c8 * 8) = vr0; }                                    \
    { int q = tid + 512; int key = q >> 4, cc = q & 15; *(uint4*)(Ks + key * 136 + cc * 8) = kr1;             \
      int v = q >> 3, c8 = q & 7; *(uint4*)(Vs + v * 72 + c8 * 8) = vr1; }                                    \
  }
  const int nkt = nkeys >> 6;
  ATT_LD(0);
  for (int kt = 0; kt < nkt; ++kt) {
    __syncthreads();
    ATT_ST();
    __syncthreads();
    if (kt + 1 < nkt) ATT_LD(kt + 1);
    Frag pf[2][2];
#pragma unroll
    for (int m = 0; m < 2; ++m) {
      f32x4 s[4];
#pragma unroll
      for (int k4 = 0; k4 < 4; ++k4) {
        s[k4] = f32x4{0.f, 0.f, 0.f, 0.f};
#pragma unroll
        for (int ks = 0; ks < 2; ++ks) {
          Frag a;
          a.q = *(const uint4*)(Ks + (16 * k4 + c16) * 136 + m * 64 + ks * 32 + g * 8);
          s[k4] = MFMA(a.v, qf[m][ks].v, s[k4]);
        }
      }
      float mx = -1e30f;
#pragma unroll
      for (int k4 = 0; k4 < 4; ++k4)
#pragma unroll
        for (int r = 0; r < 4; ++r) mx = fmaxf(mx, s[k4][r]);
      mx = fmaxf(mx, __shfl_xor(mx, 16));
      mx = fmaxf(mx, __shfl_xor(mx, 32));
      float mnew = fmaxf(mrun[m], mx);
      float alpha = expf(mrun[m] - mnew);
      mrun[m] = mnew;
      float ps = 0.f;
#pragma unroll
      for (int k4 = 0; k4 < 4; ++k4)
#pragma unroll
        for (int r = 0; r < 4; ++r) { s[k4][r] = expf(s[k4][r] - mnew); ps += s[k4][r]; }
      lsum[m] = lsum[m] * alpha + ps;
#pragma unroll
      for (int v = 0; v < 8; ++v) { O[m][v][0] *= alpha; O[m][v][1] *= alpha; O[m][v][2] *= alpha; O[m][v][3] *= alpha; }
#pragma unroll
      for (int sp = 0; sp < 2; ++sp) {
        pf[m][sp].w[0] = pack2(s[2 * sp][0], s[2 * sp][1]); pf[m][sp].w[1] = pack2(s[2 * sp][2], s[2 * sp][3]);
        pf[m][sp].w[2] = pack2(s[2 * sp + 1][0], s[2 * sp + 1][1]); pf[m][sp].w[3] = pack2(s[2 * sp + 1][2], s[2 * sp + 1][3]);
      }
    }
#pragma unroll
    for (int v = 0; v < 8; ++v)
#pragma unroll
      for (int sp = 0; sp < 2; ++sp) {
        Frag a;
        a.h[0] = *(const uint2*)(Vs + (16 * v + c16) * 72 + 32 * sp + 4 * g);
        a.h[1] = *(const uint2*)(Vs + (16 * v + c16) * 72 + 32 * sp + 16 + 4 * g);
        O[0][v] = MFMA(a.v, pf[0][sp].v, O[0][v]);
        O[1][v] = MFMA(a.v, pf[1][sp].v, O[1][v]);
      }
  }
  float l0 = lsum[0], l1 = lsum[1];
  l0 += __shfl_xor(l0, 16); l0 += __shfl_xor(l0, 32);
  l1 += __shfl_xor(l1, 16); l1 += __shfl_xor(l1, 32);
  const float i0 = 1.f / l0, i1 = lam / l1;
  float ss = 0.f;
#pragma unroll
  for (int v = 0; v < 8; ++v)
#pragma unroll
    for (int r = 0; r < 4; ++r) { float o = O[0][v][r] * i0 - O[1][v][r] * i1; O[0][v][r] = o; ss += o * o; }
  ss += __shfl_xor(ss, 16); ss += __shfl_xor(ss, 32);
  const float rinv = rsqrtf(ss * (1.f / 128.f) + EPSV) * (1.f - lam_init);
  u16* rp = proj + (size_t)qrow * LDP + h * 128;
#pragma unroll
  for (int v = 0; v < 8; ++v) {
    int vc = 16 * v + 4 * g;
    float4 sg = *(const float4*)(p.in[16] + l * 128 + vc);
    uint2 z = *(const uint2*)(rp + PZB + vc);
    float y0 = O[0][v][0] * rinv * sg.x * lo2f(z.x), y1 = O[0][v][1] * rinv * sg.y * hi2f(z.x);
    float y2 = O[0][v][2] * rinv * sg.z * lo2f(z.y), y3 = O[0][v][3] * rinv * sg.w * hi2f(z.y);
    *(uint2*)(rp + PQB + vc) = make_uint2(pack2(y0, y1), pack2(y2, y3));
  }
  __syncthreads();
}

__device__ __forceinline__ void f1_item(const Params& p, int item, char* lds) {
  const int tid = otid(), lane = tid & 63, wid = tid >> 6, wr = wid >> 2, wc = wid & 3, fr = lane & 15, fq = lane >> 4;
  char* ws = p.ws;
  const int jh = item & 1, gq = (item >> 1) & 3, mt = item >> 3;
  f32x4 acc[4][4];
  gemm_kloop<128>((const u16*)(ws + OFF_B1) + jh * 128 * 128, 128, (const u16*)(ws + OFF_PROJ) + (size_t)(mt * 256) * LDP + PUC + gq * 128, LDP, 128, acc, lds);
#pragma unroll
  for (int a = 0; a < 4; ++a)
#pragma unroll
    for (int b = 0; b < 4; ++b) {
      int tokl = wc * 64 + a * 16 + 4 * fq;
      int jj = wr * 64 + b * 16 + fr;
      uint2 pk = make_uint2(pack2(acc[a][b][0], acc[a][b][1]), pack2(acc[a][b][2], acc[a][b][3]));
      if (mt < 32) {
        *(uint2*)(ws + OFF_PTC + ((size_t)((mt * 4 + gq) * 128 + jj) * 512 + jh * 256 + tokl) * 2) = pk;
      } else {
        int rp = (mt - 32) * 256 + tokl; int bb = rp >> 11, t = rp & 2047;
        *(uint2*)(ws + OFF_PTL + ((size_t)((bb * 4 + gq) * 128 + jj) * 4096 + jh * 2048 + t) * 2) = pk;
      }
    }
}

struct F2Epi {
  char* ws; float scl; int rowbase_mul;
  bool lat;
  __device__ __forceinline__ void operator()(f32x4 (&acc)[2][2][4][2], const Unit& u, int wr, int wc, int fr, int fq, LAS unsigned char* lds) const {
    u16* proj = (u16*)(ws + OFF_PROJ);
#pragma unroll
    for (int ai = 0; ai < 2; ++ai)
#pragma unroll
      for (int m = 0; m < 4; ++m) {
        const int tp = u.x * 256 + ai * 128 + wr * 64 + m * 16 + fr;
#pragma unroll
        for (int bj = 0; bj < 2; ++bj)
#pragma unroll
          for (int n = 0; n < 2; ++n) {
            const int nn = u.y * 256 + bj * 128 + wc * 32 + n * 16 + 4 * fq;
            const int bb = nn >> 9, col = nn & 511;
            u16* rp = proj + (size_t)(lat ? (NCTX + bb * 2048 + tp) : (bb * 256 + tp)) * LDP;
            uint2 z = *(const uint2*)(rp + PZC + col);
            f32x4 a4 = acc[ai][bj][m][n];
            *(uint2*)(rp + PUC + col) = make_uint2(pack2(a4[0] * scl * lo2f(z.x), a4[1] * scl * hi2f(z.x)),
                                                   pack2(a4[2] * scl * lo2f(z.y), a4[3] * scl * hi2f(z.y)));
          }
      }
  }
};
__device__ __forceinline__ void f2c_item(const Params& p, int item, char* lds) {
  OneUnit S; S.u.a = p.ws + OFF_DC; S.u.b = p.ws + OFF_PTC + (size_t)item * 256 * 1024; S.u.x = 0; S.u.y = item;
  F2Epi E; E.ws = p.ws; E.scl = 0.005524271728019903f; E.lat = false; E.rowbase_mul = 0;
  gemm_phase((LAS unsigned char*)lds, 512, 512, 512, S, E);
}
__device__ __forceinline__ void f2l_item(const Params& p, int item, char* lds) {
  const int mt = item >> 2, nt = item & 3;
  OneUnit S; S.u.a = p.ws + OFF_DL + (size_t)mt * 256 * 8192; S.u.b = p.ws + OFF_PTL + (size_t)nt * 256 * 8192; S.u.x = mt; S.u.y = nt;
  F2Epi E; E.ws = p.ws; E.scl = 1.f / 512.f; E.lat = true; E.rowbase_mul = 0;
  gemm_phase((LAS unsigned char*)lds, 4096, 4096, 4096, S, E);
}

struct P5GateEpi {
  uint2* gs;
  __device__ __forceinline__ void operator()(f32x4 (&acc)[2][2][4][2], const Unit& u, int wr, int wc, int fr, int fq, LAS unsigned char* lds) const {
    const int tid = wr * 256 + wc * 64 + fq * 16 + fr;
#pragma unroll
    for (int ai = 0; ai < 2; ++ai)
#pragma unroll
      for (int bj = 0; bj < 2; ++bj)
#pragma unroll
        for (int m = 0; m < 4; ++m)
#pragma unroll
          for (int n = 0; n < 2; ++n) {
            f32x4 a4 = acc[ai][bj][m][n];
            gs[(((ai * 2 + bj) * 4 + m) * 2 + n) * 512 + tid] = make_uint2(pack2(sigmf(a4[0]), sigmf(a4[1])), pack2(sigmf(a4[2]), sigmf(a4[3])));
          }
  }
};
struct P5BranchEpi {
  const uint2* gs; u16* mg; int j;
  __device__ __forceinline__ void operator()(f32x4 (&acc)[2][2][4][2], const Unit& u, int wr, int wc, int fr, int fq, LAS unsigned char* lds) const {
    const int tid = wr * 256 + wc * 64 + fq * 16 + fr;
#pragma unroll
    for (int ai = 0; ai < 2; ++ai)
#pragma unroll
      for (int m = 0; m < 4; ++m) {
        const int row = u.x * 256 + ai * 128 + wr * 64 + m * 16 + fr;
#pragma unroll
        for (int bj = 0; bj < 2; ++bj)
#pragma unroll
          for (int n = 0; n < 2; ++n) {
            const int col = u.y * 256 + bj * 128 + wc * 32 + n * 16 + 4 * fq;
            uint2 gv = gs[(((ai * 2 + bj) * 4 + m) * 2 + n) * 512 + tid];
            u16* dp = mg + (size_t)row * 1024 + col;
            f32x4 a4 = acc[ai][bj][m][n];
            float t0 = lo2f(gv.x) * a4[0], t1 = hi2f(gv.x) * a4[1], t2 = lo2f(gv.y) * a4[2], t3 = hi2f(gv.y) * a4[3];
            if (j > 0) { uint2 pv = *(const uint2*)dp; t0 += lo2f(pv.x); t1 += hi2f(pv.x); t2 += lo2f(pv.y); t3 += hi2f(pv.y); }
            *(uint2*)dp = make_uint2(pack2(t0, t1), pack2(t2, t3));
          }
      }
  }
};
__device__ __forceinline__ void p5_tile(const Params& p, int tile, char* lds) {
  char* ws = p.ws;
  const int pm = tile >> 2, pn = tile & 3;
  uint2* gs = (uint2*)(ws + OFF_SEGU) + (size_t)tile * (32 * 512);
#pragma unroll 1
  for (int j = 0; j < 3; ++j) {
    {
      OneUnit S; S.u.a = ws + OFF_H + (size_t)pm * 256 * 2048; S.u.b = ws + OFF_WIN + (size_t)(5632 + j * 1024 + pn * 256) * 2048; S.u.x = pm; S.u.y = pn;
      P5GateEpi E; E.gs = gs;
      gemm_phase((LAS unsigned char*)lds, 1024, 1024, 1024, S, E);
    }
    {
      const int yc = (j == 0) ? PQA : ((j == 1) ? PQB : PUC);
      OneUnit S; S.u.a = ws + OFF_PROJ + ((size_t)pm * 256 * LDP + yc) * 2; S.u.b = ws + OFF_WBR + ((size_t)j * 1024 * 512 + (size_t)pn * 256 * 512) * 2; S.u.x = pm; S.u.y = pn;
      P5BranchEpi E; E.gs = gs; E.mg = (u16*)(ws + OFF_MRG); E.j = j;
      gemm_phase((LAS unsigned char*)lds, LDP, 512, 512, S, E);
    }
  }
}

struct P6Epi {
  const float* xp0; const float* xs0; float* outp; const float* modp; int l;
  __device__ __forceinline__ void operator()(f32x4 (&acc)[2][2][4][2], const Unit& u, int wr, int wc, int fr, int fq, LAS unsigned char* lds) const {
    const int m0 = u.x * 256;
#pragma unroll
    for (int ai = 0; ai < 2; ++ai)
#pragma unroll
      for (int m = 0; m < 4; ++m) {
        const int r = m0 + ai * 128 + wr * 64 + m * 16 + fr;
        const float* x = (l == 0) ? ((m0 < NCTX) ? xp0 + (size_t)r * 1024 : xs0 + (size_t)(r - NCTX) * 1024) : outp + (size_t)r * 1024;
        const int ci = (m0 < NCTX) ? 0 : 1 + ((r - NCTX) >> 11);
#pragma unroll
        for (int bj = 0; bj < 2; ++bj)
#pragma unroll
          for (int n = 0; n < 2; ++n) {
            const int col = u.y * 256 + bj * 128 + wc * 32 + n * 16 + 4 * fq;
            float4 gt = *(const float4*)(modp + (l * 3 + ci) * 3072 + 2048 + col);
            float4 xv = *(const float4*)(x + col);
            f32x4 a4 = acc[ai][bj][m][n];
            *(float4*)(outp + (size_t)r * 1024 + col) = make_float4(xv.x + gt.x * a4[0], xv.y + gt.y * a4[1], xv.z + gt.z * a4[2], xv.w + gt.w * a4[3]);
          }
      }
  }
};
__device__ __forceinline__ void p6_tile(const Params& p, int l, int tile, char* lds) {
  char* ws = p.ws;
  const int pm = tile >> 2, pn = tile & 3;
  OneUnit S; S.u.a = ws + OFF_MRG + (size_t)pm * 256 * 2048; S.u.b = ws + OFF_WO + (size_t)pn * 256 * 2048; S.u.x = pm; S.u.y = pn;
  P6Epi E; E.xp0 = p.in[0]; E.xs0 = p.in[1]; E.outp = p.out; E.modp = (const float*)(ws + OFF_MOD); E.l = l;
  gemm_phase((LAS unsigned char*)lds, 1024, 1024, 1024, S, E);
}

#define PARGS const float* a0, const float* a1, const float* a2, const float* a3, const float* a4, const float* a5, const float* a6, \
  const float* a7, const float* a8, const float* a9, const float* a10, const float* a11, const float* a12, const float* a13, \
  const float* a14, const float* a15, const float* a16, const float* a17, const float* a18, const float* a19, const float* a20, \
  float* aout, char* aws
#define PFILL Params p; p.in[0]=a0;p.in[1]=a1;p.in[2]=a2;p.in[3]=a3;p.in[4]=a4;p.in[5]=a5;p.in[6]=a6;p.in[7]=a7;p.in[8]=a8;p.in[9]=a9;p.in[10]=a10; \
  p.in[11]=a11;p.in[12]=a12;p.in[13]=a13;p.in[14]=a14;p.in[15]=a15;p.in[16]=a16;p.in[17]=a17;p.in[18]=a18;p.in[19]=a19;p.in[20]=a20;p.out=aout;p.ws=aws;
__global__ void __launch_bounds__(512) fwd_megakernel(PARGS) {
  PFILL
  extern __shared__ __attribute__((aligned(16))) char lds[];
  volatile int& s_item = *(volatile int*)(lds + LDS_TILE);
  cg::grid_group grid = cg::this_grid();
  const int bid = blockIdx.x, G = gridDim.x, tid = threadIdx.x;
  int* cnt = (int*)(p.ws + OFF_CNT);
  if (bid == 0 && tid < 64) cnt[tid] = 0;
  for (int rep = 0; rep < ((DUP_MASK & 1) ? 2 : 1); ++rep) {
  for (int it = bid; it < P0_ITEMS; it += G) p0_item(p, it, lds);
  grid.sync();
  }
  for (int l = 0; l < 2; ++l) {
    for (int rep = 0; rep < ((DUP_MASK & 2) ? 2 : 1); ++rep) {
    for (int it = bid; it < P1_ITEMS; it += G) p1_item(p, l, it, lds);
    grid.sync();
    }
    for (int rep = 0; rep < ((DUP_MASK & 4) ? 2 : 1); ++rep) {
    p2_phase(p, l, lds);
    grid.sync();
    }
    for (;;) {
      __syncthreads();
      if (tid == 0) s_item = atomicAdd(&cnt[l * 2 + 0], 1);
      __syncthreads();
      int it = s_item;
      if (it >= 128 + 384 + 256 + 256) break;
      if (it < 128) hgrn_ctx_item(p, l, it, lds);
      else if (it < 512) f1_item(p, it - 128, lds);
      else if (it < 768) hgrn_lat1_item(p, l, it - 512, lds);
      else attn_item(p, l, it - 768, false, lds);
    }
    grid.sync();
    for (;;) {
      __syncthreads();
      if (tid == 0) s_item = atomicAdd(&cnt[l * 2 + 1], 1);
      __syncthreads();
      int it = s_item;
      if (it >= 32 + 128 + 128 + 64) break;
      if (it < 32) f2l_item(p, it, lds);
      else if (it < 160) attn_item(p, l, it - 32, true, lds);
      else if (it < 288) hgrn_lat2_item(p, l, it - 160, lds);
      else f2c_item(p, it - 288, lds);
    }
    grid.sync();
    for (int rep = 0; rep < ((DUP_MASK & 8) ? 2 : 1); ++rep) {
    for (int it = bid; it < 192; it += G) p5_tile(p, it, lds);
    grid.sync();
    }
    for (int it = bid; it < 192; it += G) p6_tile(p, l, it, lds);
    grid.sync();
  }
}

extern "C" void kernel_launch(void* const* d_in, const int* in_sizes, int n_in,
                              void* d_out, int out_size, void* d_ws, size_t ws_size,
                              hipStream_t stream) {
  static int grid_blocks = 0;
  if (!grid_blocks) {
    int dev = 0, cus = 0;
    (void)hipGetDevice(&dev);
    (void)hipDeviceGetAttribute(&cus, hipDeviceAttributeMultiprocessorCount, dev);
    if (hipFuncSetAttribute((const void*)fwd_megakernel, hipFuncAttributeMaxDynamicSharedMemorySize, LDS_BYTES) != hipSuccess)
      fprintf(stderr, "hipFuncSetAttribute failed\n");
    grid_blocks = cus > 0 ? cus : 256;
    if (ws_size < WS_END) fprintf(stderr, "workspace too small: %zu < %zu\n", ws_size, (size_t)WS_END);
  }
  const void* ins[21];
  for (int i = 0; i < 21; ++i) ins[i] = d_in[i];
  void* outp = d_out; void* wsp = d_ws;
  void* args[23];
  for (int i = 0; i < 21; ++i) args[i] = (void*)&ins[i];
  args[21] = (void*)&outp; args[22] = (void*)&wsp;
  hipError_t e = hipLaunchCooperativeKernel((void*)fwd_megakernel, dim3(grid_blocks), dim3(512), args, LDS_BYTES, stream);
  if (e != hipSuccess) fprintf(stderr, "cooperative launch failed: %s (grid %d)\n", hipGetErrorString(e), grid_blocks);
}
```

```cpp
#include <hip/hip_runtime.h>
#include <hip/hip_cooperative_groups.h>
#include <stdint.h>
#include <cstdio>
namespace cg = cooperative_groups;

typedef unsigned short u16;
using bf16x8 = __attribute__((ext_vector_type(8))) short;
using f32x4 = __attribute__((ext_vector_type(4))) float;
#define MFMA(a, b, c) __builtin_amdgcn_mfma_f32_16x16x32_bf16(a, b, c, 0, 0, 0)

constexpr int NTOK = 12288;
constexpr int NCTX = 8192;
constexpr int LDP = 5120;
constexpr int PQA = 0, PLF = 512, PIA = 1536, PZA = 2048, PQB = 2560, PKB = 3072, PZB = 3584, PUC = 4096, PZC = 4608;
constexpr float EPSV = 1e-6f;
constexpr size_t OCK = 12582912, OCV = 20971520, OST = 29360128;

constexpr size_t OFF_WIN = 0;
constexpr size_t OFF_WBR = OFF_WIN + 8704ull * 1024 * 2;
constexpr size_t OFF_WO = OFF_WBR + 3ull * 1024 * 512 * 2;
constexpr size_t OFF_H = OFF_WO + 1024ull * 1024 * 2;
constexpr size_t OFF_PROJ = OFF_H + 12288ull * 1024 * 2;
constexpr size_t OFF_R1 = OFF_PROJ + 12288ull * LDP * 2;
constexpr size_t OFF_PTC = OFF_R1;
constexpr size_t OFF_PTL = OFF_R1 + 16384ull * 512 * 2;
constexpr size_t OFF_MRG = OFF_R1;
constexpr size_t OFF_SEGU = OFF_R1 + 25165824ull;
constexpr size_t OFF_SEGD = OFF_SEGU + 256ull * 16384 * 4;
constexpr size_t OFF_VTC = OFF_SEGD + 256ull * 128 * 4;
constexpr size_t OFF_VTL = OFF_VTC + 32ull * 4 * 128 * 256 * 2;
constexpr size_t SZ_VTL = 2ull * 4 * 128 * 2304 * 2;
constexpr size_t OFF_KC = OFF_VTL + 2 * SZ_VTL;
constexpr size_t OFF_DL = OFF_KC + 2ull * 2 * 256 * 512 * 2;
constexpr size_t OFF_DC = OFF_DL + 2048ull * 4096 * 2;
constexpr size_t OFF_B1 = OFF_DC + 256ull * 512 * 2;
constexpr size_t OFF_ROPE = OFF_B1 + 256ull * 128 * 2;
constexpr size_t OFF_MOD = OFF_ROPE + 2048ull * 32 * 8;
constexpr size_t OFF_CNT = OFF_MOD + 2ull * 3 * 3072 * 4;
constexpr size_t WS_END = OFF_CNT + 256;

constexpr int LDS_TILE = 131072 + 8192;
#define DUP_MASK 0
constexpr int LDS_BYTES = LDS_TILE + 64;

struct Params {
  const float* in[21];
  float* out;
  char* ws;
};

typedef __bf16 bf16x2_t __attribute__((ext_vector_type(2)));
typedef float f32x2_t __attribute__((ext_vector_type(2)));
__device__ __forceinline__ uint32_t pack2(float a, float b) {
  f32x2_t v = {a, b};
  bf16x2_t r = __builtin_convertvector(v, bf16x2_t);
  return __builtin_bit_cast(uint32_t, r);
}
__device__ __forceinline__ u16 f2bf(float f) { return (u16)(pack2(f, 0.f) & 0xffffu); }
__device__ __forceinline__ float bf2f(u16 h) { return __uint_as_float(((uint32_t)h) << 16); }
__device__ __forceinline__ float lo2f(uint32_t u) { return __uint_as_float(u << 16); }
__device__ __forceinline__ float hi2f(uint32_t u) { return __uint_as_float(u & 0xffff0000u); }
__device__ __forceinline__ float fexp(float x) { return __builtin_amdgcn_exp2f(x * 1.4426950408889634f); }
__device__ __forceinline__ float frcp(float x) { return __builtin_amdgcn_rcpf(x); }
__device__ __forceinline__ float flog(float x) { return __builtin_amdgcn_logf(x) * 0.6931471805599453f; }
__device__ __forceinline__ float siluf(float x) { return x * frcp(1.f + fexp(-x)); }
__device__ __forceinline__ float sigmf(float x) { return frcp(1.f + fexp(-x)); }
__device__ __forceinline__ float logf_gate(float x, float lb) {
  float xc = fmaxf(x, -80.f);
  float e = fexp(-xc);
  float omf = (1.f - lb) * e * frcp(1.f + e);
  float lf = (omf < 1e-3f) ? -omf * (1.f + 0.5f * omf) : flog(1.f - omf);
  if (lb == 0.f && x < -15.f) lf = x;
  return lf;
}
__device__ __forceinline__ float neg_expm1(float lf) {
  return (lf > -0.02f) ? -lf * (1.f + lf * (0.5f + lf * 0.16666667f)) : 1.f - fexp(lf);
}
__device__ __forceinline__ int otid() { int t = threadIdx.x; asm volatile("" : "+v"(t)); return t; }

union Frag {
  bf16x8 v;
  uint4 q;
  uint2 h[2];
  uint32_t w[4];
};

__device__ __forceinline__ int lds_byte(int r, int c) {
  int st = (r >> 4) * 2 + (c >> 5), rr = r & 15, cc = c & 31, ob = rr * 64 + cc * 2;
  return st * 1024 + (ob ^ (((ob >> 9) & 1) << 5));
}

template <int TM>
__device__ __forceinline__ void gemm_kloop(const u16* __restrict__ X, int ldx, const u16* __restrict__ Y, int ldy,
                                           int K, f32x4 (&acc)[4][TM / 32], char* lds) {
  constexpr int NX = TM / 64;
  constexpr int XT = TM / 32;
  constexpr int STAGE = TM * 128 + 32768;
  const int tid = otid(), lane = tid & 63, wid = tid >> 6, wr = wid >> 2, wc = wid & 3, fr = lane & 15, fq = lane >> 4;
#pragma unroll
  for (int a = 0; a < 4; ++a)
#pragma unroll
    for (int b = 0; b < XT; ++b) acc[a][b] = f32x4{0.f, 0.f, 0.f, 0.f};
  uint4 xr[NX], yr[4];
  const int nk = K >> 6;
  const int lrow = tid >> 3, lc8 = (tid & 7) * 8;
  const u16* xg = X + (size_t)lrow * ldx + lc8;
  const u16* yg = Y + (size_t)lrow * ldy + lc8;
  const int loff = lds_byte(lrow, lc8);
#pragma unroll
  for (int i = 0; i < NX; ++i) xr[i] = *(const uint4*)(xg + (size_t)(64 * i) * ldx);
#pragma unroll
  for (int i = 0; i < 4; ++i) yr[i] = *(const uint4*)(yg + (size_t)(64 * i) * ldy);
#pragma unroll
  for (int i = 0; i < NX; ++i) *(uint4*)(lds + loff + 8192 * i) = xr[i];
#pragma unroll
  for (int i = 0; i < 4; ++i) *(uint4*)(lds + TM * 128 + loff + 8192 * i) = yr[i];
  __syncthreads();
  for (int kt = 0; kt < nk; ++kt) {
    char* cur = lds + (kt & 1) * STAGE;
    char* nxt = lds + ((kt + 1) & 1) * STAGE;
    const bool more = (kt + 1 < nk);
    if (more) {
#pragma unroll
      for (int i = 0; i < NX; ++i) xr[i] = *(const uint4*)(xg + (size_t)(64 * i) * ldx + (kt + 1) * 64);
#pragma unroll
      for (int i = 0; i < 4; ++i) yr[i] = *(const uint4*)(yg + (size_t)(64 * i) * ldy + (kt + 1) * 64);
    }
#pragma unroll
    for (int ks = 0; ks < 2; ++ks) {
      Frag yf[4], xf[XT];
#pragma unroll
      for (int a = 0; a < 4; ++a) yf[a].q = *(const uint4*)(cur + TM * 128 + lds_byte(wc * 64 + a * 16 + fr, ks * 32 + fq * 8));
#pragma unroll
      for (int b = 0; b < XT; ++b) xf[b].q = *(const uint4*)(cur + lds_byte(wr * (TM / 2) + b * 16 + fr, ks * 32 + fq * 8));
#pragma unroll
      for (int a = 0; a < 4; ++a)
#pragma unroll
        for (int b = 0; b < XT; ++b) acc[a][b] = MFMA(yf[a].v, xf[b].v, acc[a][b]);
    }
    if (more) {
#pragma unroll
      for (int i = 0; i < NX; ++i) *(uint4*)(nxt + loff + 8192 * i) = xr[i];
#pragma unroll
      for (int i = 0; i < 4; ++i) *(uint4*)(nxt + TM * 128 + loff + 8192 * i) = yr[i];
    }
    __syncthreads();
  }
}

#define LAS __attribute__((address_space(3)))
constexpr int HTB = 128 * 64 * 2;
constexpr int G8_STAGE_BYTES = 8 * HTB;
__device__ __forceinline__ void stage_rc(int b, int& R, int& C) {
  const int st = b / 1024, sb = b % 1024, swz = sb ^ (((sb >> 9) & 1) << 5);
  R = (st >> 1) * 16 + swz / 64; C = (st & 1) * 32 + (swz % 64) / 2;
}
struct Unit { const char* a; const char* b; int x; int y; };
struct OneUnit {
  Unit u;
  __device__ __forceinline__ bool next(int i, Unit& o) const { if (i != 0) return false; o = u; return true; }
};
template <class Epi, class Sched>
__device__ __forceinline__ void gemm_phase(LAS unsigned char* lds, const int lda, const int ldb, const int K, const Sched& S, const Epi& E) {
  const int tid = otid(), wid = __builtin_amdgcn_readfirstlane(tid >> 6), lane = tid & 63, wr = wid >> 2, wc = wid & 3, fr = lane & 15, fq = lane >> 4;
  const int nt = K / 64;
  unsigned voffA[2], voffB[2];
#pragma unroll
  for (int i = 0; i < 2; ++i) { int R, C; stage_rc(tid * 16 + i * 8192, R, C); voffA[i] = (unsigned)(R * lda + C) * 2u; voffB[i] = (unsigned)(R * ldb + C) * 2u; }
  const size_t kstep = 128;
  const size_t hstepA = (size_t)128 * lda * 2, hstepB = (size_t)128 * ldb * 2;
  const unsigned ldsw = (unsigned)wid * 1024u;
  const int aoff = lds_byte(wr * 64 + fr, fq * 8), boff = lds_byte(wc * 32 + fr, fq * 8);
#define G8_SA(b, h) (((b) * 2 + (h)) * HTB)
#define G8_SB(b, h) ((4 + (b) * 2 + (h)) * HTB)
#define G8_STAGE(bufoff, gbase, voff) do { _Pragma("unroll") for (int _i = 0; _i < 2; ++_i) \
    __builtin_amdgcn_global_load_lds((const unsigned*)((const char*)(gbase) + (voff)[_i]), (LAS unsigned*)(lds + (bufoff) + ldsw + _i * 8192), 16, 0, 0); } while (0)
#define G8_LDA(dst, b, h) do { _Pragma("unroll") for (int m = 0; m < 4; ++m) _Pragma("unroll") for (int k = 0; k < 2; ++k) dst[m][k] = *(const LAS bf16x8*)(lds + G8_SA(b, h) + aoff + m * 2048 + k * 1024); } while (0)
#define G8_LDB(dst, b, h) do { _Pragma("unroll") for (int n = 0; n < 2; ++n) _Pragma("unroll") for (int k = 0; k < 2; ++k) dst[n][k] = *(const LAS bf16x8*)(lds + G8_SB(b, h) + boff + n * 2048 + k * 1024); } while (0)
#define G8_MMA(ai, bj, At, Bt) do { __builtin_amdgcn_s_setprio(1); _Pragma("unroll") for (int m = 0; m < 4; ++m) _Pragma("unroll") for (int n = 0; n < 2; ++n) _Pragma("unroll") for (int k = 0; k < 2; ++k) \
    acc[ai][bj][m][n] = __builtin_amdgcn_mfma_f32_16x16x32_bf16(Bt[n][k], At[m][k], acc[ai][bj][m][n], 0, 0, 0); __builtin_amdgcn_s_setprio(0); } while (0)
#define G8_WAIT_V(n) asm volatile("s_waitcnt vmcnt(" #n ")" ::: "memory")
#define G8_WAIT_L(n) asm volatile("s_waitcnt lgkmcnt(" #n ")" ::: "memory")
#define G8_BAR __builtin_amdgcn_s_barrier()
#define G8_SCHED __builtin_amdgcn_sched_barrier(0)
  Unit cur, nxt; int ui = 0;
  if (!S.next(0, cur)) return;
  f32x4 acc[2][2][4][2];
#pragma unroll
  for (int a = 0; a < 2; ++a)
#pragma unroll
    for (int b = 0; b < 2; ++b)
#pragma unroll
      for (int m = 0; m < 4; ++m)
#pragma unroll
        for (int n = 0; n < 2; ++n) acc[a][b][m][n] = f32x4{0.f, 0.f, 0.f, 0.f};
  bf16x8 At[4][2], B0[2][2], B1[2][2];
  const char* cA = cur.a; const char* cB = cur.b;
  G8_STAGE(G8_SB(0, 0), cB, voffB); G8_STAGE(G8_SA(0, 0), cA, voffA); G8_STAGE(G8_SB(0, 1), cB + hstepB, voffB); G8_STAGE(G8_SA(0, 1), cA + hstepA, voffA);
  if (wr == 1) G8_BAR;
  G8_WAIT_V(4); G8_BAR;
  G8_STAGE(G8_SB(1, 0), cB + kstep, voffB); G8_STAGE(G8_SA(1, 0), cA + kstep, voffA); G8_STAGE(G8_SB(1, 1), cB + hstepB + kstep, voffB);
  G8_WAIT_V(6); G8_BAR;
  for (;;) {
    const bool has_next = S.next(ui + 1, nxt);
    const char* nA = has_next ? nxt.a : cA; const char* nB = has_next ? nxt.b : cB;
    for (int t = 0; t < nt; t += 2) {
      const bool last = (t == nt - 2);
      const char* a1 = cA + (size_t)(t + 1) * kstep;
      const char* a2 = last ? nA : cA + (size_t)(t + 2) * kstep; const char* b2 = last ? nB : cB + (size_t)(t + 2) * kstep;
      const char* a3 = a2 + kstep; const char* b3 = b2 + kstep;
      G8_LDB(B0, 0, 0); G8_SCHED; G8_LDA(At, 0, 0); G8_STAGE(G8_SA(1, 1), a1 + hstepA, voffA);
      G8_WAIT_L(8); G8_BAR; G8_WAIT_L(0); G8_MMA(0, 0, At, B0); G8_BAR; G8_SCHED;
      G8_LDB(B1, 0, 1); G8_STAGE(G8_SB(0, 0), b2, voffB);
      G8_BAR; G8_WAIT_L(0); G8_MMA(0, 1, At, B1); G8_BAR;
      G8_LDA(At, 0, 1); G8_STAGE(G8_SA(0, 0), a2, voffA);
      G8_BAR; G8_WAIT_L(0); G8_MMA(1, 0, At, B0); G8_BAR; G8_SCHED;
      G8_STAGE(G8_SB(0, 1), b2 + hstepB, voffB);
      G8_WAIT_V(6); G8_BAR; G8_MMA(1, 1, At, B1); G8_BAR;
      G8_LDB(B0, 1, 0); G8_SCHED; G8_LDA(At, 1, 0); G8_STAGE(G8_SA(0, 1), a2 + hstepA, voffA);
      G8_WAIT_L(8); G8_BAR; G8_WAIT_L(0); G8_MMA(0, 0, At, B0); G8_BAR; G8_SCHED;
      G8_LDB(B1, 1, 1); G8_STAGE(G8_SB(1, 0), b3, voffB);
      G8_BAR; G8_WAIT_L(0); G8_MMA(0, 1, At, B1); G8_BAR;
      G8_LDA(At, 1, 1); G8_STAGE(G8_SA(1, 0), a3, voffA);
      G8_BAR; G8_WAIT_L(0); G8_MMA(1, 0, At, B0); G8_BAR; G8_SCHED;
      G8_STAGE(G8_SB(1, 1), b3 + hstepB, voffB);
      G8_WAIT_V(6); G8_BAR; G8_MMA(1, 1, At, B1); G8_BAR;
    }
    E(acc, cur, wr, wc, fr, fq, lds);
    if (!has_next) break;
#pragma unroll
    for (int a = 0; a < 2; ++a)
#pragma unroll
      for (int b = 0; b < 2; ++b)
#pragma unroll
        for (int m = 0; m < 4; ++m)
#pragma unroll
          for (int n = 0; n < 2; ++n) acc[a][b][m][n] = f32x4{0.f, 0.f, 0.f, 0.f};
    cur = nxt; cA = nA; cB = nB; ++ui;
  }
  G8_WAIT_V(0);
  if (wr == 0) G8_BAR;
  G8_BAR;
}

__device__ __forceinline__ void p0_item(const Params& p, int item, char* lds) {
  const int tid = otid();
  char* ws = p.ws;
  if (item < 96) {
    float* sc = (float*)lds;
    float* red = sc + 3072;
    const int l = item / 48, cgp = item % 48;
    const float* cctx = p.in[6]; const float* cc2 = p.in[2];
    for (int i = tid; i < 3072; i += 512) {
      int j = i >> 10, k = i & 1023;
      float c = (j == 0) ? cctx[k] : cc2[(j > 0 ? j - 1 : 0) * 1024 + k];
      sc[i] = siluf(c);
    }
    __syncthreads();
    const int col = tid & 63, kg = tid >> 6;
    const float* W = p.in[7] + (size_t)l * 1024 * 3072 + cgp * 64 + col;
    float a0 = 0.f, a1 = 0.f, a2 = 0.f;
    for (int k = kg * 128; k < kg * 128 + 128; ++k) {
      float w = W[(size_t)k * 3072];
      a0 += sc[k] * w; a1 += sc[1024 + k] * w; a2 += sc[2048 + k] * w;
    }
    red[(kg * 3 + 0) * 64 + col] = a0; red[(kg * 3 + 1) * 64 + col] = a1; red[(kg * 3 + 2) * 64 + col] = a2;
    __syncthreads();
    if (tid < 192) {
      int j = tid >> 6; float s = 0.f;
      for (int g = 0; g < 8; ++g) s += red[(g * 3 + j) * 64 + col];
      int n = cgp * 64 + col;
      ((float*)(ws + OFF_MOD))[(l * 3 + j) * 3072 + n] = s + p.in[8][l * 3072 + n];
    }
    __syncthreads();
    return;
  }
  item -= 96;
  if (item < 128) {
    int idx = item * 512 + tid, t = idx >> 5, c = idx & 31, fi = c & 15;
    float pos = (c < 16) ? (float)(t >> 6) : (float)(t & 63);
    float inv = powf(10000.f, -(float)fi / 16.f);
    float ang = pos * inv;
    ((float2*)(ws + OFF_ROPE))[idx] = make_float2(cosf(ang), sinf(ang));
    return;
  }
  item -= 128;
  if (item < 2048) {
    int idx = item * 512 + tid, tp = idx >> 9, k0 = (idx & 511) * 8;
    uint32_t o[4];
    float vv[8];
#pragma unroll
    for (int j = 0; j < 8; ++j) {
      int k = k0 + j; int m = (tp * (k & 2047)) & 2047; float s, c;
      sincospif((float)m * (1.f / 1024.f), &s, &c);
      vv[j] = (k < 2048) ? c : -s;
    }
#pragma unroll
    for (int j = 0; j < 4; ++j) o[j] = pack2(vv[2 * j], vv[2 * j + 1]);
    *(uint4*)(ws + OFF_DL + (size_t)idx * 16) = make_uint4(o[0], o[1], o[2], o[3]);
    return;
  }
  item -= 2048;
  if (item < 32) {
    int idx = item * 512 + tid, tp = idx >> 6, k0 = (idx & 63) * 8;
    uint32_t o[4];
    float vv[8];
#pragma unroll
    for (int j = 0; j < 8; ++j) {
      int k = k0 + j; int m = (tp * (k & 255)) & 255; float s, c;
      sincospif((float)m * (1.f / 128.f), &s, &c);
      vv[j] = (k < 256) ? c : -s;
    }
#pragma unroll
    for (int j = 0; j < 4; ++j) o[j] = pack2(vv[2 * j], vv[2 * j + 1]);
    *(uint4*)(ws + OFF_DC + (size_t)idx * 16) = make_uint4(o[0], o[1], o[2], o[3]);
    return;
  }
  item -= 32;
  if (item < 8) {
    int idx = item * 512 + tid, j = idx >> 4, c0 = (idx & 15) * 8;
    uint32_t o[4];
    float vv[8];
#pragma unroll
    for (int q = 0; q < 8; ++q) {
      int m = ((j & 127) * (c0 + q)) & 127; float s, c;
      sincospif((float)m * (1.f / 64.f), &s, &c);
      vv[q] = (j < 128) ? c : s;
    }
#pragma unroll
    for (int q = 0; q < 4; ++q) o[q] = pack2(vv[2 * q], vv[2 * q + 1]);
    *(uint4*)(ws + OFF_B1 + (size_t)idx * 16) = make_uint4(o[0], o[1], o[2], o[3]);
    return;
  }
  item -= 8;
  if (item < 128) {
    int idx = item * 512 + tid; int e = idx * 8;
    int n = e & 511, t = (e >> 9) & 255, l = (e >> 17) & 1, b = e >> 18;
    const float4* s = (const float4*)(p.in[3] + e);
    float4 a = s[0], c = s[1];
    size_t d = ((size_t)((l * 2 + b) * 256 + t)) * 512 + n;
    *(uint4*)(ws + OFF_KC + d * 2) = make_uint4(pack2(a.x, a.y), pack2(a.z, a.w), pack2(c.x, c.y), pack2(c.z, c.w));
    return;
  }
  item -= 128;
  {
    int idx = item * 512 + tid;
    int v = idx & 127, tc = (idx >> 7) & 31, h = (idx >> 12) & 3, b = (idx >> 14) & 1, l = idx >> 15;
    float vv[8];
#pragma unroll
    for (int j = 0; j < 8; ++j) vv[j] = p.in[4][((size_t)((b * 2 + l) * 256 + tc * 8 + j)) * 512 + h * 128 + v];
    size_t d = ((size_t)((b * 4 + h) * 128 + v)) * 2304 + 2048 + tc * 8;
    *(uint4*)(ws + OFF_VTL + l * SZ_VTL + d * 2) = make_uint4(pack2(vv[0], vv[1]), pack2(vv[2], vv[3]), pack2(vv[4], vv[5]), pack2(vv[6], vv[7]));
  }
}
constexpr int P0_ITEMS = 96 + 128 + 2048 + 32 + 8 + 128 + 128;

__device__ __forceinline__ void p1_item(const Params& p, int l, int item, char* lds) {
  const int tid = otid();
  char* ws = p.ws;
  if (item < 2816) {
    const float* src; int lsrc; u16* dst; int ldd; int kt, nt;
    const float* w10 = p.in[10]; const float* w17 = p.in[17]; const float* w18 = p.in[18]; const float* w19 = p.in[19]; const float* w20 = p.in[20];
    if (item < 2176) { src = w10 + (size_t)l * 1024 * 8704; lsrc = 8704; dst = (u16*)(ws + OFF_WIN); ldd = 1024; nt = item >> 4; kt = item & 15; }
    else if (item < 2560) { int r = item - 2176; int j = r >> 7; r &= 127; src = ((j == 0) ? w17 : ((j == 1) ? w18 : w19)) + (size_t)l * 512 * 1024; lsrc = 1024; dst = (u16*)(ws + OFF_WBR) + (size_t)j * 1024 * 512; ldd = 512; nt = r >> 3; kt = r & 7; }
    else { int r = item - 2560; src = w20 + (size_t)l * 1024 * 1024; lsrc = 1024; dst = (u16*)(ws + OFF_WO); ldd = 1024; nt = r >> 4; kt = r & 15; }
    u16* T = (u16*)lds;
    const int k0 = kt * 64, n0 = nt * 64;
#pragma unroll
    for (int ps = 0; ps < 2; ++ps) {
      int kr = (tid >> 4) + 32 * ps, nq = tid & 15;
      float4 v = *(const float4*)(src + (size_t)(k0 + kr) * lsrc + n0 + 4 * nq);
      T[(4 * nq + 0) * 72 + kr] = f2bf(v.x); T[(4 * nq + 1) * 72 + kr] = f2bf(v.y);
      T[(4 * nq + 2) * 72 + kr] = f2bf(v.z); T[(4 * nq + 3) * 72 + kr] = f2bf(v.w);
    }
    __syncthreads();
    {
      int n = tid >> 3, kc = tid & 7;
      uint4 o = *(const uint4*)(T + n * 72 + kc * 8);
      *(uint4*)(dst + (size_t)(n0 + n) * ldd + k0 + kc * 8) = o;
    }
    __syncthreads();
    return;
  }
  item -= 2816;
  const int lane = tid & 63, wid = tid >> 6;
  const float* modp = (const float*)(ws + OFF_MOD);
  u16* H = (u16*)(ws + OFF_H);
  const float* xin0 = p.in[0]; const float* xin1 = p.in[1]; const float* xin2 = p.out; const float* ng = p.in[9];
#pragma unroll
  for (int rr = 0; rr < 2; ++rr) {
    int r = item * 16 + wid * 2 + rr;
    const float* x = (l == 0) ? ((r < NCTX) ? xin0 + (size_t)r * 1024 : xin1 + (size_t)(r - NCTX) * 1024) : xin2 + (size_t)r * 1024;
    int ci = (r < NCTX) ? 0 : 1 + ((r - NCTX) >> 11);
    float4 v[4]; float ss = 0.f;
#pragma unroll
    for (int i = 0; i < 4; ++i) { v[i] = *(const float4*)(x + lane * 4 + 256 * i); ss += v[i].x * v[i].x + v[i].y * v[i].y + v[i].z * v[i].z + v[i].w * v[i].w; }
#pragma unroll
    for (int o = 32; o >= 1; o >>= 1) ss += __shfl_xor(ss, o);
    float rinv = rsqrtf(ss * (1.f / 1024.f) + EPSV);
    const float* sh = modp + (l * 3 + ci) * 3072;
#pragma unroll
    for (int i = 0; i < 4; ++i) {
      int col = lane * 4 + 256 * i;
      float4 g = *(const float4*)(ng + l * 1024 + col);
      float4 s1 = *(const float4*)(sh + 1024 + col);
      float4 s0 = *(const float4*)(sh + col);
      float a = v[i].x * rinv * g.x * (1.f + s1.x) + s0.x;
      float b = v[i].y * rinv * g.y * (1.f + s1.y) + s0.y;
      float c = v[i].z * rinv * g.z * (1.f + s1.z) + s0.z;
      float d = v[i].w * rinv * g.w * (1.f + s1.w) + s0.w;
      *(uint2*)(H + (size_t)r * 1024 + col) = make_uint2(pack2(a, b), pack2(c, d));
    }
  }
}
constexpr int P1_ITEMS = 2816 + 768;

struct P2Sched {
  const char* H; const char* W; int G, c;
  __device__ __forceinline__ bool next(int i, Unit& u) const {
    const int L = i * G + c;
    if (L >= 1056) return false;
    if (L < 960) {
      const int nM = 48, nN = 20, nwg = 960;
      int wgid = L; { const int q = nwg / 8, xcd = wgid % 8, off = wgid / 8; wgid = xcd * q + off; }
      const int nig = 8 * nN, gid = wgid / nig, fm = gid * 8, gsz = (nM - fm) < 8 ? (nM - fm) : 8;
      int pm = fm + ((wgid % nig) % gsz), pn = (wgid % nig) / gsz;
      if (pn >= 14) pn += 2;
      u.a = H + (size_t)pm * 256 * 2048; u.b = W + (size_t)pn * 256 * 2048; u.x = pm; u.y = pn;
    } else {
      const int r = L - 960; const int vq = r / 48, mt = r % 48;
      u.a = W + (size_t)(3584 + vq * 256) * 2048; u.b = H + (size_t)mt * 256 * 2048; u.x = vq; u.y = mt | 0x100;
    }
    return true;
  }
};
struct P2Epi {
  const float* const* pin; float* out; char* ws; int l;
  const float* hlb; const float* qng; const float* kng;
  __device__ __forceinline__ void operator()(f32x4 (&acc)[2][2][4][2], const Unit& u, int wr, int wc, int fr, int fq, LAS unsigned char* lds) const {
    { const int t_ = otid(); const int w_ = t_ >> 6; wr = w_ >> 2; wc = w_ & 3; fr = t_ & 15; fq = (t_ & 63) >> 4; }
    if (u.y & 0x100) {
      const int mt = u.y & 0xff, vq = u.x;
#pragma unroll
      for (int ai = 0; ai < 2; ++ai)
#pragma unroll
        for (int m = 0; m < 4; ++m) {
          const int nn = vq * 256 + ai * 128 + wr * 64 + m * 16 + fr;
          const int hh = nn >> 7, v = nn & 127;
#pragma unroll
          for (int bj = 0; bj < 2; ++bj)
#pragma unroll
            for (int n = 0; n < 2; ++n) {
              const int tokl = bj * 128 + wc * 32 + n * 16 + 4 * fq;
              f32x4 a4 = acc[ai][bj][m][n];
              uint2 pk = make_uint2(pack2(a4[0], a4[1]), pack2(a4[2], a4[3]));
              if (mt < 32) {
                *(uint2*)(ws + OFF_VTC + ((size_t)((mt * 4 + hh) * 128 + v) * 256 + tokl) * 2) = pk;
                float* o = out + OCV + ((size_t)((mt * 2 + l) * 256 + tokl)) * 512 + nn;
                o[0] = a4[0]; o[512] = a4[1]; o[1024] = a4[2]; o[1536] = a4[3];
              } else {
                int rp = (mt - 32) * 256 + tokl; int bb = rp >> 11, t = rp & 2047;
                *(uint2*)(ws + OFF_VTL + l * SZ_VTL + ((size_t)((bb * 4 + hh) * 128 + v) * 2304 + t) * 2) = pk;
              }
            }
        }
      return;
    }
    const int pm = u.x, pn = u.y, seg = pn >> 1, ncol0 = (pn & 1) * 256;
    const int dcol0 = ((seg < 7) ? seg : seg - 1) * 512 + ncol0;
    u16* proj = (u16*)(ws + OFF_PROJ);
    const bool lat = (pm >= 32);
    if (seg == 5 || seg == 6) {
      float* xch = (float*)(lds + G8_STAGE_BYTES);
#pragma unroll
      for (int ai = 0; ai < 2; ++ai)
#pragma unroll
        for (int m = 0; m < 4; ++m)
#pragma unroll
          for (int bj = 0; bj < 2; ++bj) {
            float ss = 0.f;
#pragma unroll
            for (int n = 0; n < 2; ++n)
#pragma unroll
              for (int e = 0; e < 4; ++e) { float bfv = bf2f(f2bf(acc[ai][bj][m][n][e])); ss += bfv * bfv; }
            ss += __shfl_xor(ss, 16); ss += __shfl_xor(ss, 32);
            if (fq == 0) xch[((ai * 128 + wr * 64 + m * 16 + fr) * 2 + bj) * 4 + wc] = ss;
          }
      asm volatile("s_waitcnt lgkmcnt(0)" ::: "memory");
      __builtin_amdgcn_s_barrier();
      asm volatile("" ::: "memory");
      const float* gsel = (seg == 5) ? qng : kng;
      float gv[2][4];
#pragma unroll
      for (int n = 0; n < 2; ++n)
#pragma unroll
        for (int e = 0; e < 4; ++e) gv[n][e] = gsel[l * 64 + 32 * (wc & 1) + 16 * n + 4 * fq + e];
#pragma unroll
      for (int ai = 0; ai < 2; ++ai)
#pragma unroll
        for (int m = 0; m < 4; ++m) {
          const int rl = ai * 128 + wr * 64 + m * 16 + fr;
          const int grow = pm * 256 + rl;
#pragma unroll
          for (int bj = 0; bj < 2; ++bj) {
            const float2 pr = *(const float2*)&xch[(rl * 2 + bj) * 4 + (wc & 2)];
            const float tot = pr.x + pr.y;
            const float rinv = rsqrtf(tot * (1.f / 64.f) + EPSV);
            float x[2][4];
#pragma unroll
            for (int n = 0; n < 2; ++n)
#pragma unroll
              for (int e = 0; e < 4; ++e) x[n][e] = bf2f(f2bf(acc[ai][bj][m][n][e])) * rinv * gv[n][e];
            const int colt = ncol0 + bj * 128 + wc * 32;
            if (seg == 6 && !lat) {
              float* o = out + OCK + ((size_t)((pm * 2 + l) * 256 + rl)) * 512 + colt + 4 * fq;
              *(float4*)o = make_float4(x[0][0], x[0][1], x[0][2], x[0][3]);
              *(float4*)(o + 16) = make_float4(x[1][0], x[1][1], x[1][2], x[1][3]);
            }
            if (lat) {
              const int t = (grow - NCTX) & 2047;
              const float2* rt = (const float2*)(ws + OFF_ROPE) + t * 32 + ((wc & 1) ? 16 : 0) + 4 * fq;
#pragma unroll
              for (int e = 0; e < 4; ++e) {
                float2 cs = rt[e];
                float x1 = x[0][e], x2 = x[1][e];
                x[0][e] = x1 * cs.x - x2 * cs.y;
                x[1][e] = x1 * cs.y + x2 * cs.x;
              }
            }
            if (seg == 5) {
#pragma unroll
              for (int n = 0; n < 2; ++n)
#pragma unroll
                for (int e = 0; e < 4; ++e) x[n][e] *= 0.125f;
            }
            u16* dp = proj + (size_t)grow * LDP + dcol0 + bj * 128 + wc * 32 + 4 * fq;
            *(uint2*)dp = make_uint2(pack2(x[0][0], x[0][1]), pack2(x[0][2], x[0][3]));
            *(uint2*)(dp + 16) = make_uint2(pack2(x[1][0], x[1][1]), pack2(x[1][2], x[1][3]));
          }
        }
      return;
    }
    const bool dosilu = (seg == 0 || seg == 4 || seg == 8 || seg == 10);
    const bool dolf = (seg == 1 || seg == 2);
    const int dir = (seg == 2) ? 1 : 0;
#pragma unroll
    for (int bj = 0; bj < 2; ++bj)
#pragma unroll
      for (int n = 0; n < 2; ++n) {
        float lbv[4];
        if (dolf) {
#pragma unroll
          for (int e = 0; e < 4; ++e) {
            int j = ncol0 + bj * 128 + wc * 32 + n * 16 + 4 * fq + e;
            lbv[e] = (l == 0) ? 0.f : sigmf(hlb[(1 * 2 + dir) * 512 + j] - hlb[(0 * 2 + dir) * 512 + j]);
          }
        }
#pragma unroll
        for (int ai = 0; ai < 2; ++ai)
#pragma unroll
          for (int m = 0; m < 4; ++m) {
            const int grow = pm * 256 + ai * 128 + wr * 64 + m * 16 + fr;
            f32x4 a4 = acc[ai][bj][m][n];
            if (dosilu) {
#pragma unroll
              for (int e = 0; e < 4; ++e) a4[e] = siluf(a4[e]);
            } else if (dolf) {
#pragma unroll
              for (int e = 0; e < 4; ++e) {
                a4[e] = logf_gate(a4[e], lbv[e]);
              }
            }
            *(uint2*)(proj + (size_t)grow * LDP + dcol0 + bj * 128 + wc * 32 + n * 16 + 4 * fq) = make_uint2(pack2(a4[0], a4[1]), pack2(a4[2], a4[3]));
          }
      }
  }
};
__device__ __forceinline__ void p2_phase(const Params& p, int l, char* lds) {
  P2Sched S; S.H = p.ws + OFF_H; S.W = p.ws + OFF_WIN; S.G = gridDim.x; S.c = blockIdx.x;
  P2Epi E; E.pin = nullptr; E.out = p.out; E.ws = p.ws; E.l = l; E.hlb = p.in[11]; E.qng = p.in[13]; E.kng = p.in[14];
  gemm_phase((LAS unsigned char*)lds, 1024, 1024, 1024, S, E);
}

struct HgrnLds {
  float tot[4][128];
  float dk[128];
  float osum[16][132];
  u16 qt[16][136];
  u16 kt[16][136];
  u16 khT[128][16];
  u16 vT[128][16];
  u16 obuf[256][136];
};

__device__ __forceinline__ void hgrn_pass(const Params& p, int l, int row0, int ntok, int h, int dir, f32x4 (&S)[8],
                                          const bool do_out, const bool second, float& gsum, HgrnLds& L) {
  const int tid = otid(), lane = tid & 63, wid = tid >> 6, c16 = lane & 15, g = lane >> 4;
  const int kk = tid & 127, tq = tid >> 7;
  const u16* proj = (const u16*)(p.ws + OFF_PROJ);
  u16* projw = (u16*)(p.ws + OFF_PROJ);
  const int nch = ntok >> 4;
  u16 lfr[4], qr[4], vr[4];
  auto ldchunk = [&](int c) {
#pragma unroll
    for (int i = 0; i < 4; ++i) {
      int s = c * 16 + 4 * tq + i;
      int tl = dir ? (ntok - 1 - s) : s;
      const u16* rp = proj + (size_t)(row0 + tl) * LDP + h * 128 + kk;
      lfr[i] = rp[PLF + dir * 512];
      vr[i] = rp[PIA];
      qr[i] = do_out ? rp[PQA] : (u16)0;
    }
  };
  ldchunk(0);
  for (int c = 0; c < nch; ++c) {
    float lf[4], G[4], qv[4];
    u16 vv[4];
#pragma unroll
    for (int i = 0; i < 4; ++i) { lf[i] = bf2f(lfr[i]); qv[i] = bf2f(qr[i]); vv[i] = vr[i]; }
    G[0] = lf[0]; G[1] = G[0] + lf[1]; G[2] = G[1] + lf[2]; G[3] = G[2] + lf[3];
    L.tot[tq][kk] = G[3];
    __syncthreads();
    if (c + 1 < nch) ldchunk(c + 1);
    float t0 = L.tot[0][kk], t1 = L.tot[1][kk], t2 = L.tot[2][kk], t3 = L.tot[3][kk];
    float off = (tq > 0 ? t0 : 0.f) + (tq > 1 ? t1 : 0.f) + (tq > 2 ? t2 : 0.f);
    float gend = t0 + t1 + t2 + t3;
    float kh[4];
#pragma unroll
    for (int i = 0; i < 4; ++i) {
      float Gi = G[i] + off;
      float kv = neg_expm1(lf[i]);
      int s = 4 * tq + i;
      if (do_out) {
        L.qt[s][kk] = f2bf(qv[i] * fexp(Gi));
        L.kt[s][kk] = f2bf(kv * fexp(-Gi));
      }
      kh[i] = kv * fexp(gend - Gi);
    }
    *(uint2*)&L.khT[kk][4 * tq] = make_uint2(pack2(kh[0], kh[1]), pack2(kh[2], kh[3]));
    *(uint2*)&L.vT[kk][4 * tq] = make_uint2((uint32_t)vv[0] | ((uint32_t)vv[1] << 16), (uint32_t)vv[2] | ((uint32_t)vv[3] << 16));
    if (tq == 0) { L.dk[kk] = fexp(gend); gsum += gend; }
    __syncthreads();
    Frag bv;
    bv.h[0] = *(const uint2*)&L.vT[16 * wid + c16][4 * g];
    bv.h[1] = make_uint2(0u, 0u);
    f32x4 o = f32x4{0.f, 0.f, 0.f, 0.f};
    if (do_out) {
      f32x4 at = f32x4{0.f, 0.f, 0.f, 0.f};
#pragma unroll
      for (int ks = 0; ks < 4; ++ks) {
        Frag a, b;
        a.q = *(const uint4*)&L.kt[c16][32 * ks + 8 * g];
        b.q = *(const uint4*)&L.qt[c16][32 * ks + 8 * g];
        at = MFMA(a.v, b.v, at);
      }
      Frag pa;
#pragma unroll
      for (int r = 0; r < 4; ++r) at[r] = (4 * g + r <= c16) ? at[r] : 0.f;
      pa.w[0] = pack2(at[0], at[1]); pa.w[1] = pack2(at[2], at[3]); pa.w[2] = 0u; pa.w[3] = 0u;
      o = MFMA(pa.v, bv.v, o);
#pragma unroll
      for (int st = 0; st < 4; ++st) {
        Frag a, b;
        a.h[0] = *(const uint2*)&L.qt[c16][32 * st + 4 * g];
        a.h[1] = *(const uint2*)&L.qt[c16][32 * st + 16 + 4 * g];
        b.w[0] = pack2(S[2 * st][0], S[2 * st][1]); b.w[1] = pack2(S[2 * st][2], S[2 * st][3]);
        b.w[2] = pack2(S[2 * st + 1][0], S[2 * st + 1][1]); b.w[3] = pack2(S[2 * st + 1][2], S[2 * st + 1][3]);
        o = MFMA(a.v, b.v, o);
      }
    }
#pragma unroll
    for (int k8 = 0; k8 < 8; ++k8) {
      float4 d = *(const float4*)&L.dk[16 * k8 + 4 * g];
      f32x4 s0 = S[k8];
      s0[0] *= d.x; s0[1] *= d.y; s0[2] *= d.z; s0[3] *= d.w;
      Frag a;
      a.h[0] = *(const uint2*)&L.khT[16 * k8 + c16][4 * g];
      a.h[1] = make_uint2(0u, 0u);
      S[k8] = MFMA(a.v, bv.v, s0);
    }
    if (do_out) {
      const int vcol = 16 * wid + c16;
      if (!second) {
#pragma unroll
        for (int r = 0; r < 4; ++r) {
          int s = c * 16 + 4 * g + r;
          int tl = dir ? (ntok - 1 - s) : s;
          L.obuf[tl][vcol] = f2bf(o[r]);
        }
      } else {
#pragma unroll
        for (int r = 0; r < 4; ++r) {
          int s = c * 16 + 4 * g + r;
          int tl = dir ? (ntok - 1 - s) : s;
          L.osum[4 * g + r][vcol] = o[r] + bf2f(L.obuf[tl][vcol]);
        }
        __syncthreads();
        {
          int sl = tid >> 5, vq = tid & 31;
          int s = c * 16 + sl;
          int tl = dir ? (ntok - 1 - s) : s;
          float4 ov = *(const float4*)&L.osum[sl][4 * vq];
          float ss = ov.x * ov.x + ov.y * ov.y + ov.z * ov.z + ov.w * ov.w;
#pragma unroll
          for (int m = 1; m <= 16; m <<= 1) ss += __shfl_xor(ss, m);
          float rinv = rsqrtf(ss * (1.f / 128.f) + EPSV);
          float4 gg = *(const float4*)(p.in[12] + l * 512 + h * 128 + 4 * vq);
          u16* rp = projw + (size_t)(row0 + tl) * LDP + h * 128 + 4 * vq;
          uint2 z = *(const uint2*)(rp + PZA);
          float y0 = ov.x * rinv * gg.x * lo2f(z.x), y1 = ov.y * rinv * gg.y * hi2f(z.x);
          float y2 = ov.z * rinv * gg.z * lo2f(z.y), y3 = ov.w * rinv * gg.w * hi2f(z.y);
          *(uint2*)(rp + PQA) = make_uint2(pack2(y0, y1), pack2(y2, y3));
        }
      }
    }
  }
  __syncthreads();
}

__device__ __forceinline__ void hgrn_load_state(const float* m, f32x4 (&S)[8]) {
  const int tid_ = otid(); const int lane = tid_ & 63, wid = tid_ >> 6, c16 = lane & 15, g = lane >> 4;
#pragma unroll
  for (int k8 = 0; k8 < 8; ++k8)
#pragma unroll
    for (int r = 0; r < 4; ++r) S[k8][r] = m[(16 * k8 + 4 * g + r) * 128 + 16 * wid + c16];
}
__device__ __forceinline__ void hgrn_store_state(float* m, const f32x4 (&S)[8]) {
  const int tid_ = otid(); const int lane = tid_ & 63, wid = tid_ >> 6, c16 = lane & 15, g = lane >> 4;
#pragma unroll
  for (int k8 = 0; k8 < 8; ++k8)
#pragma unroll
    for (int r = 0; r < 4; ++r) m[(16 * k8 + 4 * g + r) * 128 + 16 * wid + c16] = S[k8][r];
}
__device__ __forceinline__ void hgrn_advance(const float* U, const float* D, f32x4 (&S)[8]) {
  const int tid_ = otid(); const int lane = tid_ & 63, wid = tid_ >> 6, c16 = lane & 15, g = lane >> 4;
#pragma unroll
  for (int k8 = 0; k8 < 8; ++k8)
#pragma unroll
    for (int r = 0; r < 4; ++r) {
      int k = 16 * k8 + 4 * g + r;
      S[k8][r] = D[k] * S[k8][r] + U[k * 128 + 16 * wid + c16];
    }
}

__device__ __forceinline__ void hgrn_ctx_item(const Params& p, int l, int item, char* lds) {
  HgrnLds& L = *(HgrnLds*)lds;
  const int b = item >> 2, h = item & 3;
  f32x4 S[8];
  float gsum = 0.f;
#pragma unroll
  for (int i = 0; i < 8; ++i) S[i] = f32x4{0.f, 0.f, 0.f, 0.f};
  hgrn_pass(p, l, b * 256, 256, h, 0, S, true, false, gsum, L);
  hgrn_store_state(p.out + OST + ((size_t)(((b * 2 + l) * 2 + 0) * 4 + h)) * 16384, S);
#pragma unroll
  for (int i = 0; i < 8; ++i) S[i] = f32x4{0.f, 0.f, 0.f, 0.f};
  hgrn_pass(p, l, b * 256, 256, h, 1, S, true, true, gsum, L);
  hgrn_store_state(p.out + OST + ((size_t)(((b * 2 + l) * 2 + 1) * 4 + h)) * 16384, S);
}
__device__ __forceinline__ void hgrn_lat1_item(const Params& p, int l, int item, char* lds) {
  HgrnLds& L = *(HgrnLds*)lds;
  const int seg = item & 15, dir = (item >> 4) & 1, h = (item >> 5) & 3, b = item >> 7;
  f32x4 S[8];
  float gsum = 0.f;
#pragma unroll
  for (int i = 0; i < 8; ++i) S[i] = f32x4{0.f, 0.f, 0.f, 0.f};
  hgrn_pass(p, l, NCTX + b * 2048 + seg * 128, 128, h, dir, S, false, false, gsum, L);
  hgrn_store_state((float*)(p.ws + OFF_SEGU) + (size_t)item * 16384, S);
  { const int t_ = otid(); if (t_ < 128) ((float*)(p.ws + OFF_SEGD))[item * 128 + t_] = expf(gsum); }
}
__device__ __forceinline__ void hgrn_lat2_item(const Params& p, int l, int item, char* lds) {
  HgrnLds& L = *(HgrnLds*)lds;
  const int seg = item & 15, h = (item >> 4) & 3, b = item >> 6;
  const float* SU = (const float*)(p.ws + OFF_SEGU);
  const float* SD = (const float*)(p.ws + OFF_SEGD);
  f32x4 S[8];
  float gsum = 0.f;
  hgrn_load_state(p.in[5] + ((size_t)(((b * 2 + l) * 2 + 0) * 4 + h)) * 16384, S);
  for (int i = 0; i < seg; ++i) {
    int it = ((b * 4 + h) * 2 + 0) * 16 + i;
    hgrn_advance(SU + (size_t)it * 16384, SD + it * 128, S);
  }
  hgrn_pass(p, l, NCTX + b * 2048 + seg * 128, 128, h, 0, S, true, false, gsum, L);
  hgrn_load_state(p.in[5] + ((size_t)(((b * 2 + l) * 2 + 1) * 4 + h)) * 16384, S);
  for (int i = 15; i > seg; --i) {
    int it = ((b * 4 + h) * 2 + 1) * 16 + i;
    hgrn_advance(SU + (size_t)it * 16384, SD + it * 128, S);
  }
  hgrn_pass(p, l, NCTX + b * 2048 + seg * 128, 128, h, 1, S, true, true, gsum, L);
}

__device__ __forceinline__ void attn_item(const Params& p, int l, int item, const bool lat, char* lds) {
  const int tid = otid(), lane = tid & 63, wid = tid >> 6, c16 = lane & 15, g = lane >> 4;
  char* ws = p.ws;
  u16* proj = (u16*)(ws + OFF_PROJ);
  int b, h, qb, nkeys, rowbase;
  const u16* Vt; int ldv;
  if (!lat) { qb = item & 1; h = (item >> 1) & 3; b = item >> 3; nkeys = 256; rowbase = b * 256; Vt = (const u16*)(ws + OFF_VTC) + (size_t)((b * 4 + h) * 128) * 256; ldv = 256; }
  else { qb = item & 15; h = (item >> 4) & 3; b = item >> 6; nkeys = 2304; rowbase = NCTX + b * 2048; Vt = (const u16*)(ws + OFF_VTL + l * SZ_VTL) + (size_t)((b * 4 + h) * 128) * 2304; ldv = 2304; }
  const u16* Kc = (const u16*)(ws + OFF_KC) + (size_t)((l * 2 + b) * 256) * 512 + h * 128;
  u16* Ks = (u16*)lds;
  u16* Vs = Ks + 64 * 136;
  float lam_init = 0.8f - 0.6f * expf(-0.3f * (float)l);
  float lam;
  {
    const float* lp = p.in[15] + l * 256;
    float a = lp[lane] * lp[64 + lane], c = lp[128 + lane] * lp[192 + lane];
#pragma unroll
    for (int o = 32; o >= 1; o >>= 1) { a += __shfl_xor(a, o); c += __shfl_xor(c, o); }
    lam = expf(a) - expf(c) + lam_init;
  }
  const int qrow = rowbase + qb * 128 + wid * 16 + c16;
  Frag qf[2][2];
#pragma unroll
  for (int m = 0; m < 2; ++m)
#pragma unroll
    for (int ks = 0; ks < 2; ++ks) qf[m][ks].q = *(const uint4*)(proj + (size_t)qrow * LDP + PQB + h * 128 + m * 64 + ks * 32 + g * 8);
  f32x4 O[2][8];
#pragma unroll
  for (int m = 0; m < 2; ++m)
#pragma unroll
    for (int v = 0; v < 8; ++v) O[m][v] = f32x4{0.f, 0.f, 0.f, 0.f};
  float mrun[2] = {-1e30f, -1e30f}, lsum[2] = {0.f, 0.f};
  uint4 kr0, kr1, vr0, vr1;
#define ATT_LD(kt_)                                                                                           \
  {                                                                                                           \
    const int key0 = (kt_) * 64;                                                                              \
    const bool fromproj = (!lat) || (key0 < 2048);                                                            \
    {                                                                                                         \
      int q = tid; int key = q >> 4, cc = q & 15;                                                             \
      const u16* src = fromproj ? proj + (size_t)(rowbase + key0 + key) * LDP + PKB + h * 128 + cc * 8        \
                                : Kc + (size_t)(key0 - 2048 + key) * 512 + cc * 8;                            \
      kr0 = *(const uint4*)src;                                                                               \
      int v = q >> 3, c8 = q & 7;                                                                             \
      vr0 = *(const uint4*)(Vt + (size_t)v * ldv + key0 + c8 * 8);                                            \
    }                                                                                                         \
    {                                                                                                         \
      int q = tid + 512; int key = q >> 4, cc = q & 15;                                                       \
      const u16* src = fromproj ? proj + (size_t)(rowbase + key0 + key) * LDP + PKB + h * 128 + cc * 8        \
                                : Kc + (size_t)(key0 - 2048 + key) * 512 + cc * 8;                            \
      kr1 = *(const uint4*)src;                                                                               \
      int v = q >> 3, c8 = q & 7;                                                                             \
      vr1 = *(const uint4*)(Vt + (size_t)v * ldv + key0 + c8 * 8);                                            \
    }                                                                                                         \
  }
#define ATT_ST()                                                                                              \
  {                                                                                                           \
    { int q = tid; int key = q >> 4, cc = q & 15; *(uint4*)(Ks + key * 136 + cc * 8) = kr0;                   \
      int v = q >> 3, c8 = q & 7; *(uint4*)(Vs + v * 72 + c8 * 8) = vr0; }                                    \
    { int q = tid + 512; int key = q >> 4, cc = q & 15; *(uint4*)(Ks + key * 136 + cc * 8) = kr1;             \
      int v = q >> 3, c8 = q & 7; *(uint4*)(Vs + v * 72 + c8 * 8) = vr1; }                                    \
  }
  const int nkt = nkeys >> 6;
  ATT_LD(0);
  for (int kt = 0; kt < nkt; ++kt) {
    __syncthreads();
    ATT_ST();
    __syncthreads();
    if (kt + 1 < nkt) ATT_LD(kt + 1);
    Frag pf[2][2];
#pragma unroll
    for (int m = 0; m < 2; ++m) {
      f32x4 s[4];
#pragma unroll
      for (int k4 = 0; k4 < 4; ++k4) {
        s[k4] = f32x4{0.f, 0.f, 0.f, 0.f};
#pragma unroll
        for (int ks = 0; ks < 2; ++ks) {
          Frag a;
          a.q = *(const uint4*)(Ks + (16 * k4 + c16) * 136 + m * 64 + ks * 32 + g * 8);
          s[k4] = MFMA(a.v, qf[m][ks].v, s[k4]);
        }
      }
      float mx = -1e30f;
#pragma unroll
      for (int k4 = 0; k4 < 4; ++k4)
#pragma unroll
        for (int r = 0; r < 4; ++r) mx = fmaxf(mx, s[k4][r]);
      mx = fmaxf(mx, __shfl_xor(mx, 16));
      mx = fmaxf(mx, __shfl_xor(mx, 32));
      float mnew = fmaxf(mrun[m], mx);
      float alpha = fexp(mrun[m] - mnew);
      mrun[m] = mnew;
      float ps = 0.f;
#pragma unroll
      for (int k4 = 0; k4 < 4; ++k4)
#pragma unroll
        for (int r = 0; r < 4; ++r) { s[k4][r] = fexp(s[k4][r] - mnew); ps += s[k4][r]; }
      lsum[m] = lsum[m] * alpha + ps;
#pragma unroll
      for (int v = 0; v < 8; ++v) { O[m][v][0] *= alpha; O[m][v][1] *= alpha; O[m][v][2] *= alpha; O[m][v][3] *= alpha; }
#pragma unroll
      for (int sp = 0; sp < 2; ++sp) {
        pf[m][sp].w[0] = pack2(s[2 * sp][0], s[2 * sp][1]); pf[m][sp].w[1] = pack2(s[2 * sp][2], s[2 * sp][3]);
        pf[m][sp].w[2] = pack2(s[2 * sp + 1][0], s[2 * sp + 1][1]); pf[m][sp].w[3] = pack2(s[2 * sp + 1][2], s[2 * sp + 1][3]);
      }
    }
#pragma unroll
    for (int v = 0; v < 8; ++v)
#pragma unroll
      for (int sp = 0; sp < 2; ++sp) {
        Frag a;
        a.h[0] = *(const uint2*)(Vs + (16 * v + c16) * 72 + 32 * sp + 4 * g);
        a.h[1] = *(const uint2*)(Vs + (16 * v + c16) * 72 + 32 * sp + 16 + 4 * g);
        O[0][v] = MFMA(a.v, pf[0][sp].v, O[0][v]);
        O[1][v] = MFMA(a.v, pf[1][sp].v, O[1][v]);
      }
  }
  float l0 = lsum[0], l1 = lsum[1];
  l0 += __shfl_xor(l0, 16); l0 += __shfl_xor(l0, 32);
  l1 += __shfl_xor(l1, 16); l1 += __shfl_xor(l1, 32);
  const float i0 = 1.f / l0, i1 = lam / l1;
  float ss = 0.f;
#pragma unroll
  for (int v = 0; v < 8; ++v)
#pragma unroll
    for (int r = 0; r < 4; ++r) { float o = O[0][v][r] * i0 - O[1][v][r] * i1; O[0][v][r] = o; ss += o * o; }
  ss += __shfl_xor(ss, 16); ss += __shfl_xor(ss, 32);
  const float rinv = rsqrtf(ss * (1.f / 128.f) + EPSV) * (1.f - lam_init);
  u16* rp = proj + (size_t)qrow * LDP + h * 128;
#pragma unroll
  for (int v = 0; v < 8; ++v) {
    int vc = 16 * v + 4 * g;
    float4 sg = *(const float4*)(p.in[16] + l * 128 + vc);
    uint2 z = *(const uint2*)(rp + PZB + vc);
    float y0 = O[0][v][0] * rinv * sg.x * lo2f(z.x), y1 = O[0][v][1] * rinv * sg.y * hi2f(z.x);
    float y2 = O[0][v][2] * rinv * sg.z * lo2f(z.y), y3 = O[0][v][3] * rinv * sg.w * hi2f(z.y);
    *(uint2*)(rp + PQB + vc) = make_uint2(pack2(y0, y1), pack2(y2, y3));
  }
  __syncthreads();
}

__device__ __forceinline__ void f1_item(const Params& p, int item, char* lds) {
  const int tid = otid(), lane = tid & 63, wid = tid >> 6, wr = wid >> 2, wc = wid & 3, fr = lane & 15, fq = lane >> 4;
  char* ws = p.ws;
  const int jh = item & 1, gq = (item >> 1) & 3, mt = item >> 3;
  f32x4 acc[4][4];
  gemm_kloop<128>((const u16*)(ws + OFF_B1) + jh * 128 * 128, 128, (const u16*)(ws + OFF_PROJ) + (size_t)(mt * 256) * LDP + PUC + gq * 128, LDP, 128, acc, lds);
#pragma unroll
  for (int a = 0; a < 4; ++a)
#pragma unroll
    for (int b = 0; b < 4; ++b) {
      int tokl = wc * 64 + a * 16 + 4 * fq;
      int jj = wr * 64 + b * 16 + fr;
      uint2 pk = make_uint2(pack2(acc[a][b][0], acc[a][b][1]), pack2(acc[a][b][2], acc[a][b][3]));
      if (mt < 32) {
        *(uint2*)(ws + OFF_PTC + ((size_t)((mt * 4 + gq) * 128 + jj) * 512 + jh * 256 + tokl) * 2) = pk;
      } else {
        int rp = (mt - 32) * 256 + tokl; int bb = rp >> 11, t = rp & 2047;
        *(uint2*)(ws + OFF_PTL + ((size_t)((bb * 4 + gq) * 128 + jj) * 4096 + jh * 2048 + t) * 2) = pk;
      }
    }
}

struct F2Epi {
  char* ws; float scl; int rowbase_mul;
  bool lat;
  __device__ __forceinline__ void operator()(f32x4 (&acc)[2][2][4][2], const Unit& u, int wr, int wc, int fr, int fq, LAS unsigned char* lds) const {
    u16* proj = (u16*)(ws + OFF_PROJ);
#pragma unroll
    for (int ai = 0; ai < 2; ++ai)
#pragma unroll
      for (int m = 0; m < 4; ++m) {
        const int tp = u.x * 256 + ai * 128 + wr * 64 + m * 16 + fr;
#pragma unroll
        for (int bj = 0; bj < 2; ++bj)
#pragma unroll
          for (int n = 0; n < 2; ++n) {
            const int nn = u.y * 256 + bj * 128 + wc * 32 + n * 16 + 4 * fq;
            const int bb = nn >> 9, col = nn & 511;
            u16* rp = proj + (size_t)(lat ? (NCTX + bb * 2048 + tp) : (bb * 256 + tp)) * LDP;
            uint2 z = *(const uint2*)(rp + PZC + col);
            f32x4 a4 = acc[ai][bj][m][n];
            *(uint2*)(rp + PUC + col) = make_uint2(pack2(a4[0] * scl * lo2f(z.x), a4[1] * scl * hi2f(z.x)),
                                                   pack2(a4[2] * scl * lo2f(z.y), a4[3] * scl * hi2f(z.y)));
          }
      }
  }
};
__device__ __forceinline__ void f2c_item(const Params& p, int item, char* lds) {
  OneUnit S; S.u.a = p.ws + OFF_DC; S.u.b = p.ws + OFF_PTC + (size_t)item * 256 * 1024; S.u.x = 0; S.u.y = item;
  F2Epi E; E.ws = p.ws; E.scl = 0.005524271728019903f; E.lat = false; E.rowbase_mul = 0;
  gemm_phase((LAS unsigned char*)lds, 512, 512, 512, S, E);
}
__device__ __forceinline__ void f2l_item(const Params& p, int item, char* lds) {
  const int mt = item >> 2, nt = item & 3;
  OneUnit S; S.u.a = p.ws + OFF_DL + (size_t)mt * 256 * 8192; S.u.b = p.ws + OFF_PTL + (size_t)nt * 256 * 8192; S.u.x = mt; S.u.y = nt;
  F2Epi E; E.ws = p.ws; E.scl = 1.f / 512.f; E.lat = true; E.rowbase_mul = 0;
  gemm_phase((LAS unsigned char*)lds, 4096, 4096, 4096, S, E);
}

struct P5GateEpi {
  uint2* gs;
  __device__ __forceinline__ void operator()(f32x4 (&acc)[2][2][4][2], const Unit& u, int wr, int wc, int fr, int fq, LAS unsigned char* lds) const {
    const int tid = wr * 256 + wc * 64 + fq * 16 + fr;
#pragma unroll
    for (int ai = 0; ai < 2; ++ai)
#pragma unroll
      for (int bj = 0; bj < 2; ++bj)
#pragma unroll
        for (int m = 0; m < 4; ++m)
#pragma unroll
          for (int n = 0; n < 2; ++n) {
            f32x4 a4 = acc[ai][bj][m][n];
            gs[(((ai * 2 + bj) * 4 + m) * 2 + n) * 512 + tid] = make_uint2(pack2(sigmf(a4[0]), sigmf(a4[1])), pack2(sigmf(a4[2]), sigmf(a4[3])));
          }
  }
};
struct P5BranchEpi {
  const uint2* gs; u16* mg; int j;
  __device__ __forceinline__ void operator()(f32x4 (&acc)[2][2][4][2], const Unit& u, int wr, int wc, int fr, int fq, LAS unsigned char* lds) const {
    const int tid = wr * 256 + wc * 64 + fq * 16 + fr;
#pragma unroll
    for (int ai = 0; ai < 2; ++ai)
#pragma unroll
      for (int m = 0; m < 4; ++m) {
        const int row = u.x * 256 + ai * 128 + wr * 64 + m * 16 + fr;
#pragma unroll
        for (int bj = 0; bj < 2; ++bj)
#pragma unroll
          for (int n = 0; n < 2; ++n) {
            const int col = u.y * 256 + bj * 128 + wc * 32 + n * 16 + 4 * fq;
            uint2 gv = gs[(((ai * 2 + bj) * 4 + m) * 2 + n) * 512 + tid];
            u16* dp = mg + (size_t)row * 1024 + col;
            f32x4 a4 = acc[ai][bj][m][n];
            float t0 = lo2f(gv.x) * a4[0], t1 = hi2f(gv.x) * a4[1], t2 = lo2f(gv.y) * a4[2], t3 = hi2f(gv.y) * a4[3];
            if (j > 0) { uint2 pv = *(const uint2*)dp; t0 += lo2f(pv.x); t1 += hi2f(pv.x); t2 += lo2f(pv.y); t3 += hi2f(pv.y); }
            *(uint2*)dp = make_uint2(pack2(t0, t1), pack2(t2, t3));
          }
      }
  }
};
__device__ __forceinline__ void p5_tile(const Params& p, int tile, char* lds) {
  char* ws = p.ws;
  const int pm = tile >> 2, pn = tile & 3;
  uint2* gs = (uint2*)(ws + OFF_SEGU) + (size_t)tile * (32 * 512);
#pragma unroll 1
  for (int j = 0; j < 3; ++j) {
    {
      OneUnit S; S.u.a = ws + OFF_H + (size_t)pm * 256 * 2048; S.u.b = ws + OFF_WIN + (size_t)(5632 + j * 1024 + pn * 256) * 2048; S.u.x = pm; S.u.y = pn;
      P5GateEpi E; E.gs = gs;
      gemm_phase((LAS unsigned char*)lds, 1024, 1024, 1024, S, E);
    }
    {
      const int yc = (j == 0) ? PQA : ((j == 1) ? PQB : PUC);
      OneUnit S; S.u.a = ws + OFF_PROJ + ((size_t)pm * 256 * LDP + yc) * 2; S.u.b = ws + OFF_WBR + ((size_t)j * 1024 * 512 + (size_t)pn * 256 * 512) * 2; S.u.x = pm; S.u.y = pn;
      P5BranchEpi E; E.gs = gs; E.mg = (u16*)(ws + OFF_MRG); E.j = j;
      gemm_phase((LAS unsigned char*)lds, LDP, 512, 512, S, E);
    }
  }
}

struct P6Epi {
  const float* xp0; const float* xs0; float* outp; const float* modp; int l;
  __device__ __forceinline__ void operator()(f32x4 (&acc)[2][2][4][2], const Unit& u, int wr, int wc, int fr, int fq, LAS unsigned char* lds) const {
    const int m0 = u.x * 256;
#pragma unroll
    for (int ai = 0; ai < 2; ++ai)
#pragma unroll
      for (int m = 0; m < 4; ++m) {
        const int r = m0 + ai * 128 + wr * 64 + m * 16 + fr;
        const float* x = (l == 0) ? ((m0 < NCTX) ? xp0 + (size_t)r * 1024 : xs0 + (size_t)(r - NCTX) * 1024) : outp + (size_t)r * 1024;
        const int ci = (m0 < NCTX) ? 0 : 1 + ((r - NCTX) >> 11);
#pragma unroll
        for (int bj = 0; bj < 2; ++bj)
#pragma unroll
          for (int n = 0; n < 2; ++n) {
            const int col = u.y * 256 + bj * 128 + wc * 32 + n * 16 + 4 * fq;
            float4 gt = *(const float4*)(modp + (l * 3 + ci) * 3072 + 2048 + col);
            float4 xv = *(const float4*)(x + col);
            f32x4 a4 = acc[ai][bj][m][n];
            *(float4*)(outp + (size_t)r * 1024 + col) = make_float4(xv.x + gt.x * a4[0], xv.y + gt.y * a4[1], xv.z + gt.z * a4[2], xv.w + gt.w * a4[3]);
          }
      }
  }
};
__device__ __forceinline__ void p6_tile(const Params& p, int l, int tile, char* lds) {
  char* ws = p.ws;
  const int pm = tile >> 2, pn = tile & 3;
  OneUnit S; S.u.a = ws + OFF_MRG + (size_t)pm * 256 * 2048; S.u.b = ws + OFF_WO + (size_t)pn * 256 * 2048; S.u.x = pm; S.u.y = pn;
  P6Epi E; E.xp0 = p.in[0]; E.xs0 = p.in[1]; E.outp = p.out; E.modp = (const float*)(ws + OFF_MOD); E.l = l;
  gemm_phase((LAS unsigned char*)lds, 1024, 1024, 1024, S, E);
}

#define PARGS const float* a0, const float* a1, const float* a2, const float* a3, const float* a4, const float* a5, const float* a6, \
  const float* a7, const float* a8, const float* a9, const float* a10, const float* a11, const float* a12, const float* a13, \
  const float* a14, const float* a15, const float* a16, const float* a17, const float* a18, const float* a19, const float* a20, \
  float* aout, char* aws
#define PFILL Params p; p.in[0]=a0;p.in[1]=a1;p.in[2]=a2;p.in[3]=a3;p.in[4]=a4;p.in[5]=a5;p.in[6]=a6;p.in[7]=a7;p.in[8]=a8;p.in[9]=a9;p.in[10]=a10; \
  p.in[11]=a11;p.in[12]=a12;p.in[13]=a13;p.in[14]=a14;p.in[15]=a15;p.in[16]=a16;p.in[17]=a17;p.in[18]=a18;p.in[19]=a19;p.in[20]=a20;p.out=aout;p.ws=aws;
__global__ void __launch_bounds__(512) fwd_megakernel(PARGS) {
  PFILL
  extern __shared__ __attribute__((aligned(16))) char lds[];
  volatile int& s_item = *(volatile int*)(lds + LDS_TILE);
  cg::grid_group grid = cg::this_grid();
  const int bid = blockIdx.x, G = gridDim.x, tid = threadIdx.x;
  int* cnt = (int*)(p.ws + OFF_CNT);
  if (bid == 0 && tid < 64) cnt[tid] = 0;
  for (int rep = 0; rep < ((DUP_MASK & 1) ? 2 : 1); ++rep) {
  for (int it = bid; it < P0_ITEMS; it += G) p0_item(p, it, lds);
  grid.sync();
  }
  for (int l = 0; l < 2; ++l) {
    for (int rep = 0; rep < ((DUP_MASK & 2) ? 2 : 1); ++rep) {
    for (int it = bid; it < P1_ITEMS; it += G) p1_item(p, l, it, lds);
    grid.sync();
    }
    for (int rep = 0; rep < ((DUP_MASK & 4) ? 2 : 1); ++rep) {
    p2_phase(p, l, lds);
    grid.sync();
    }
    for (;;) {
      __syncthreads();
      if (tid == 0) s_item = atomicAdd(&cnt[l * 2 + 0], 1);
      __syncthreads();
      int it = s_item;
      if (it >= 128 + 384 + 256 + 256) break;
      if (it < 128) hgrn_ctx_item(p, l, it, lds);
      else if (it < 512) f1_item(p, it - 128, lds);
      else if (it < 768) hgrn_lat1_item(p, l, it - 512, lds);
      else attn_item(p, l, it - 768, false, lds);
    }
    grid.sync();
    for (;;) {
      __syncthreads();
      if (tid == 0) s_item = atomicAdd(&cnt[l * 2 + 1], 1);
      __syncthreads();
      int it = s_item;
      if (it >= 32 + 128 + 128 + 64) break;
      if (it < 32) f2l_item(p, it, lds);
      else if (it < 160) attn_item(p, l, it - 32, true, lds);
      else if (it < 288) hgrn_lat2_item(p, l, it - 160, lds);
      else f2c_item(p, it - 288, lds);
    }
    grid.sync();
    for (int rep = 0; rep < ((DUP_MASK & 8) ? 2 : 1); ++rep) {
    for (int it = bid; it < 192; it += G) p5_tile(p, it, lds);
    grid.sync();
    }
    for (int it = bid; it < 192; it += G) p6_tile(p, l, it, lds);
    grid.sync();
  }
}

extern "C" void kernel_launch(void* const* d_in, const int* in_sizes, int n_in,
                              void* d_out, int out_size, void* d_ws, size_t ws_size,
                              hipStream_t stream) {
  static int grid_blocks = 0;
  if (!grid_blocks) {
    int dev = 0, cus = 0;
    (void)hipGetDevice(&dev);
    (void)hipDeviceGetAttribute(&cus, hipDeviceAttributeMultiprocessorCount, dev);
    if (hipFuncSetAttribute((const void*)fwd_megakernel, hipFuncAttributeMaxDynamicSharedMemorySize, LDS_BYTES) != hipSuccess)
      fprintf(stderr, "hipFuncSetAttribute failed\n");
    grid_blocks = cus > 0 ? cus : 256;
    if (ws_size < WS_END) fprintf(stderr, "workspace too small: %zu < %zu\n", ws_size, (size_t)WS_END);
  }
  const void* ins[21];
  for (int i = 0; i < 21; ++i) ins[i] = d_in[i];
  void* outp = d_out; void* wsp = d_ws;
  void* args[23];
  for (int i = 0; i < 21; ++i) args[i] = (void*)&ins[i];
  args[21] = (void*)&outp; args[22] = (void*)&wsp;
  hipError_t e = hipLaunchCooperativeKernel((void*)fwd_megakernel, dim3(grid_blocks), dim3(512), args, LDS_BYTES, stream);
  if (e != hipSuccess) fprintf(stderr, "cooperative launch failed: %s (grid %d)\n", hipGetErrorString(e), grid_blocks);
}
```

```cpp
#include <hip/hip_runtime.h>
#include <hip/hip_cooperative_groups.h>
#include <stdint.h>
#include <cstdio>
namespace cg = cooperative_groups;

typedef unsigned short u16;
using bf16x8 = __attribute__((ext_vector_type(8))) short;
using f32x4 = __attribute__((ext_vector_type(4))) float;
#define MFMA(a, b, c) __builtin_amdgcn_mfma_f32_16x16x32_bf16(a, b, c, 0, 0, 0)

constexpr int NTOK = 12288;
constexpr int NCTX = 8192;
constexpr int LDP = 5120;
constexpr int PQA = 0, PLF = 512, PIA = 1536, PZA = 2048, PQB = 2560, PKB = 3072, PZB = 3584, PUC = 4096, PZC = 4608;
constexpr float EPSV = 1e-6f;
constexpr size_t OCK = 12582912, OCV = 20971520, OST = 29360128;

constexpr size_t OFF_WIN = 0;
constexpr size_t OFF_WBR = OFF_WIN + 8704ull * 1024 * 2;
constexpr size_t OFF_WO = OFF_WBR + 3ull * 1024 * 512 * 2;
constexpr size_t OFF_H = OFF_WO + 1024ull * 1024 * 2;
constexpr size_t OFF_PROJ = OFF_H + 12288ull * 1024 * 2;
constexpr size_t OFF_R1 = OFF_PROJ + 12288ull * LDP * 2;
constexpr size_t OFF_PTC = OFF_R1;
constexpr size_t OFF_PTL = OFF_R1 + 16384ull * 512 * 2;
constexpr size_t OFF_MRG = OFF_R1;
constexpr size_t OFF_SEGU = OFF_R1 + 25165824ull;
constexpr size_t OFF_SEGD = OFF_SEGU + 256ull * 16384 * 4;
constexpr size_t OFF_VTC = OFF_SEGD + 256ull * 128 * 4;
constexpr size_t OFF_VTL = OFF_VTC + 32ull * 4 * 128 * 256 * 2;
constexpr size_t SZ_VTL = 2ull * 4 * 128 * 2304 * 2;
constexpr size_t OFF_KC = OFF_VTL + 2 * SZ_VTL;
constexpr size_t OFF_DL = OFF_KC + 2ull * 2 * 256 * 512 * 2;
constexpr size_t OFF_DC = OFF_DL + 2048ull * 4096 * 2;
constexpr size_t OFF_B1 = OFF_DC + 256ull * 512 * 2;
constexpr size_t OFF_ROPE = OFF_B1 + 256ull * 128 * 2;
constexpr size_t OFF_MOD = OFF_ROPE + 2048ull * 32 * 8;
constexpr size_t OFF_CNT = OFF_MOD + 2ull * 3 * 3072 * 4;
constexpr size_t OFF_BAR = OFF_CNT + 256;
constexpr size_t WS_END = OFF_BAR + 3456 * 4;

constexpr int LDS_TILE = 131072 + 8192;
#define DUP_MASK 0
constexpr int LDS_BYTES = LDS_TILE + 64;

struct Params {
  const float* in[21];
  float* out;
  char* ws;
};

typedef __bf16 bf16x2_t __attribute__((ext_vector_type(2)));
typedef float f32x2_t __attribute__((ext_vector_type(2)));
__device__ __forceinline__ uint32_t pack2(float a, float b) {
  f32x2_t v = {a, b};
  bf16x2_t r = __builtin_convertvector(v, bf16x2_t);
  return __builtin_bit_cast(uint32_t, r);
}
__device__ __forceinline__ u16 f2bf(float f) { return (u16)(pack2(f, 0.f) & 0xffffu); }
__device__ __forceinline__ float bf2f(u16 h) { return __uint_as_float(((uint32_t)h) << 16); }
__device__ __forceinline__ float lo2f(uint32_t u) { return __uint_as_float(u << 16); }
__device__ __forceinline__ float hi2f(uint32_t u) { return __uint_as_float(u & 0xffff0000u); }
__device__ __forceinline__ float fexp(float x) { return __builtin_amdgcn_exp2f(x * 1.4426950408889634f); }
__device__ __forceinline__ float frcp(float x) { return __builtin_amdgcn_rcpf(x); }
__device__ __forceinline__ float flog(float x) { return __builtin_amdgcn_logf(x) * 0.6931471805599453f; }
__device__ __forceinline__ float siluf(float x) { return x * frcp(1.f + fexp(-x)); }
__device__ __forceinline__ float sigmf(float x) { return frcp(1.f + fexp(-x)); }
__device__ __forceinline__ float logf_gate(float x, float lb) {
  float xc = fmaxf(x, -80.f);
  float e = fexp(-xc);
  float omf = (1.f - lb) * e * frcp(1.f + e);
  float lf = (omf < 1e-3f) ? -omf * (1.f + 0.5f * omf) : flog(1.f - omf);
  if (lb == 0.f && x < -15.f) lf = x;
  return lf;
}
__device__ __forceinline__ float neg_expm1(float lf) {
  return (lf > -0.02f) ? -lf * (1.f + lf * (0.5f + lf * 0.16666667f)) : 1.f - fexp(lf);
}
__device__ __forceinline__ int otid() { int t = threadIdx.x; asm volatile("" : "+v"(t)); return t; }

union Frag {
  bf16x8 v;
  uint4 q;
  uint2 h[2];
  uint32_t w[4];
};

__device__ __forceinline__ int lds_byte(int r, int c) {
  int st = (r >> 4) * 2 + (c >> 5), rr = r & 15, cc = c & 31, ob = rr * 64 + cc * 2;
  return st * 1024 + (ob ^ (((ob >> 9) & 1) << 5));
}

template <int TM>
__device__ __forceinline__ void gemm_kloop(const u16* __restrict__ X, int ldx, const u16* __restrict__ Y, int ldy,
                                           int K, f32x4 (&acc)[4][TM / 32], char* lds) {
  constexpr int NX = TM / 64;
  constexpr int XT = TM / 32;
  constexpr int STAGE = TM * 128 + 32768;
  const int tid = otid(), lane = tid & 63, wid = tid >> 6, wr = wid >> 2, wc = wid & 3, fr = lane & 15, fq = lane >> 4;
#pragma unroll
  for (int a = 0; a < 4; ++a)
#pragma unroll
    for (int b = 0; b < XT; ++b) acc[a][b] = f32x4{0.f, 0.f, 0.f, 0.f};
  uint4 xr[NX], yr[4];
  const int nk = K >> 6;
  const int lrow = tid >> 3, lc8 = (tid & 7) * 8;
  const u16* xg = X + (size_t)lrow * ldx + lc8;
  const u16* yg = Y + (size_t)lrow * ldy + lc8;
  const int loff = lds_byte(lrow, lc8);
#pragma unroll
  for (int i = 0; i < NX; ++i) xr[i] = *(const uint4*)(xg + (size_t)(64 * i) * ldx);
#pragma unroll
  for (int i = 0; i < 4; ++i) yr[i] = *(const uint4*)(yg + (size_t)(64 * i) * ldy);
#pragma unroll
  for (int i = 0; i < NX; ++i) *(uint4*)(lds + loff + 8192 * i) = xr[i];
#pragma unroll
  for (int i = 0; i < 4; ++i) *(uint4*)(lds + TM * 128 + loff + 8192 * i) = yr[i];
  __syncthreads();
  for (int kt = 0; kt < nk; ++kt) {
    char* cur = lds + (kt & 1) * STAGE;
    char* nxt = lds + ((kt + 1) & 1) * STAGE;
    const bool more = (kt + 1 < nk);
    if (more) {
#pragma unroll
      for (int i = 0; i < NX; ++i) xr[i] = *(const uint4*)(xg + (size_t)(64 * i) * ldx + (kt + 1) * 64);
#pragma unroll
      for (int i = 0; i < 4; ++i) yr[i] = *(const uint4*)(yg + (size_t)(64 * i) * ldy + (kt + 1) * 64);
    }
#pragma unroll
    for (int ks = 0; ks < 2; ++ks) {
      Frag yf[4], xf[XT];
#pragma unroll
      for (int a = 0; a < 4; ++a) yf[a].q = *(const uint4*)(cur + TM * 128 + lds_byte(wc * 64 + a * 16 + fr, ks * 32 + fq * 8));
#pragma unroll
      for (int b = 0; b < XT; ++b) xf[b].q = *(const uint4*)(cur + lds_byte(wr * (TM / 2) + b * 16 + fr, ks * 32 + fq * 8));
#pragma unroll
      for (int a = 0; a < 4; ++a)
#pragma unroll
        for (int b = 0; b < XT; ++b) acc[a][b] = MFMA(yf[a].v, xf[b].v, acc[a][b]);
    }
    if (more) {
#pragma unroll
      for (int i = 0; i < NX; ++i) *(uint4*)(nxt + loff + 8192 * i) = xr[i];
#pragma unroll
      for (int i = 0; i < 4; ++i) *(uint4*)(nxt + TM * 128 + loff + 8192 * i) = yr[i];
    }
    __syncthreads();
  }
}

#define LAS __attribute__((address_space(3)))
constexpr int HTB = 128 * 64 * 2;
constexpr int G8_STAGE_BYTES = 8 * HTB;
__device__ __forceinline__ void stage_rc(int b, int& R, int& C) {
  const int st = b / 1024, sb = b % 1024, swz = sb ^ (((sb >> 9) & 1) << 5);
  R = (st >> 1) * 16 + swz / 64; C = (st & 1) * 32 + (swz % 64) / 2;
}
struct Unit { const char* a; const char* b; int x; int y; };
struct OneUnit {
  Unit u;
  __device__ __forceinline__ bool next(int i, Unit& o) const { if (i != 0) return false; o = u; return true; }
};
template <class Epi, class Sched>
__device__ __forceinline__ void gemm_phase(LAS unsigned char* lds, const int lda, const int ldb, const int K, const Sched& S, const Epi& E) {
  const int tid = otid(), wid = __builtin_amdgcn_readfirstlane(tid >> 6), lane = tid & 63, wr = wid >> 2, wc = wid & 3, fr = lane & 15, fq = lane >> 4;
  const int nt = K / 64;
  unsigned voffA[2], voffB[2];
#pragma unroll
  for (int i = 0; i < 2; ++i) { int R, C; stage_rc(tid * 16 + i * 8192, R, C); voffA[i] = (unsigned)(R * lda + C) * 2u; voffB[i] = (unsigned)(R * ldb + C) * 2u; }
  const size_t kstep = 128;
  const size_t hstepA = (size_t)128 * lda * 2, hstepB = (size_t)128 * ldb * 2;
  const unsigned ldsw = (unsigned)wid * 1024u;
  const int aoff = lds_byte(wr * 64 + fr, fq * 8), boff = lds_byte(wc * 32 + fr, fq * 8);
#define G8_SA(b, h) (((b) * 2 + (h)) * HTB)
#define G8_SB(b, h) ((4 + (b) * 2 + (h)) * HTB)
#define G8_STAGE(bufoff, gbase, voff) do { _Pragma("unroll") for (int _i = 0; _i < 2; ++_i) \
    __builtin_amdgcn_global_load_lds((const unsigned*)((const char*)(gbase) + (voff)[_i]), (LAS unsigned*)(lds + (bufoff) + ldsw + _i * 8192), 16, 0, 0); } while (0)
#define G8_LDA(dst, b, h) do { _Pragma("unroll") for (int m = 0; m < 4; ++m) _Pragma("unroll") for (int k = 0; k < 2; ++k) dst[m][k] = *(const LAS bf16x8*)(lds + G8_SA(b, h) + aoff + m * 2048 + k * 1024); } while (0)
#define G8_LDB(dst, b, h) do { _Pragma("unroll") for (int n = 0; n < 2; ++n) _Pragma("unroll") for (int k = 0; k < 2; ++k) dst[n][k] = *(const LAS bf16x8*)(lds + G8_SB(b, h) + boff + n * 2048 + k * 1024); } while (0)
#define G8_MMA(ai, bj, At, Bt) do { __builtin_amdgcn_s_setprio(1); _Pragma("unroll") for (int m = 0; m < 4; ++m) _Pragma("unroll") for (int n = 0; n < 2; ++n) _Pragma("unroll") for (int k = 0; k < 2; ++k) \
    acc[ai][bj][m][n] = __builtin_amdgcn_mfma_f32_16x16x32_bf16(Bt[n][k], At[m][k], acc[ai][bj][m][n], 0, 0, 0); __builtin_amdgcn_s_setprio(0); } while (0)
#define G8_WAIT_V(n) asm volatile("s_waitcnt vmcnt(" #n ")" ::: "memory")
#define G8_WAIT_L(n) asm volatile("s_waitcnt lgkmcnt(" #n ")" ::: "memory")
#define G8_BAR __builtin_amdgcn_s_barrier()
#define G8_SCHED __builtin_amdgcn_sched_barrier(0)
  Unit cur, nxt; int ui = 0;
  if (!S.next(0, cur)) return;
  f32x4 acc[2][2][4][2];
#pragma unroll
  for (int a = 0; a < 2; ++a)
#pragma unroll
    for (int b = 0; b < 2; ++b)
#pragma unroll
      for (int m = 0; m < 4; ++m)
#pragma unroll
        for (int n = 0; n < 2; ++n) acc[a][b][m][n] = f32x4{0.f, 0.f, 0.f, 0.f};
  bf16x8 At[4][2], B0[2][2], B1[2][2];
  const char* cA = cur.a; const char* cB = cur.b;
  G8_STAGE(G8_SB(0, 0), cB, voffB); G8_STAGE(G8_SA(0, 0), cA, voffA); G8_STAGE(G8_SB(0, 1), cB + hstepB, voffB); G8_STAGE(G8_SA(0, 1), cA + hstepA, voffA);
  if (wr == 1) G8_BAR;
  G8_WAIT_V(4); G8_BAR;
  G8_STAGE(G8_SB(1, 0), cB + kstep, voffB); G8_STAGE(G8_SA(1, 0), cA + kstep, voffA); G8_STAGE(G8_SB(1, 1), cB + hstepB + kstep, voffB);
  G8_WAIT_V(6); G8_BAR;
  for (;;) {
    const bool has_next = S.next(ui + 1, nxt);
    const char* nA = has_next ? nxt.a : cA; const char* nB = has_next ? nxt.b : cB;
    for (int t = 0; t < nt; t += 2) {
      const bool last = (t == nt - 2);
      const char* a1 = cA + (size_t)(t + 1) * kstep;
      const char* a2 = last ? nA : cA + (size_t)(t + 2) * kstep; const char* b2 = last ? nB : cB + (size_t)(t + 2) * kstep;
      const char* a3 = a2 + kstep; const char* b3 = b2 + kstep;
      G8_LDB(B0, 0, 0); G8_SCHED; G8_LDA(At, 0, 0); G8_STAGE(G8_SA(1, 1), a1 + hstepA, voffA);
      G8_WAIT_L(8); G8_BAR; G8_WAIT_L(0); G8_MMA(0, 0, At, B0); G8_BAR; G8_SCHED;
      G8_LDB(B1, 0, 1); G8_STAGE(G8_SB(0, 0), b2, voffB);
      G8_BAR; G8_WAIT_L(0); G8_MMA(0, 1, At, B1); G8_BAR;
      G8_LDA(At, 0, 1); G8_STAGE(G8_SA(0, 0), a2, voffA);
      G8_BAR; G8_WAIT_L(0); G8_MMA(1, 0, At, B0); G8_BAR; G8_SCHED;
      G8_STAGE(G8_SB(0, 1), b2 + hstepB, voffB);
      G8_WAIT_V(6); G8_BAR; G8_MMA(1, 1, At, B1); G8_BAR;
      G8_LDB(B0, 1, 0); G8_SCHED; G8_LDA(At, 1, 0); G8_STAGE(G8_SA(0, 1), a2 + hstepA, voffA);
      G8_WAIT_L(8); G8_BAR; G8_WAIT_L(0); G8_MMA(0, 0, At, B0); G8_BAR; G8_SCHED;
      G8_LDB(B1, 1, 1); G8_STAGE(G8_SB(1, 0), b3, voffB);
      G8_BAR; G8_WAIT_L(0); G8_MMA(0, 1, At, B1); G8_BAR;
      G8_LDA(At, 1, 1); G8_STAGE(G8_SA(1, 0), a3, voffA);
      G8_BAR; G8_WAIT_L(0); G8_MMA(1, 0, At, B0); G8_BAR; G8_SCHED;
      G8_STAGE(G8_SB(1, 1), b3 + hstepB, voffB);
      G8_WAIT_V(6); G8_BAR; G8_MMA(1, 1, At, B1); G8_BAR;
    }
    E(acc, cur, wr, wc, fr, fq, lds);
    if (!has_next) break;
#pragma unroll
    for (int a = 0; a < 2; ++a)
#pragma unroll
      for (int b = 0; b < 2; ++b)
#pragma unroll
        for (int m = 0; m < 4; ++m)
#pragma unroll
          for (int n = 0; n < 2; ++n) acc[a][b][m][n] = f32x4{0.f, 0.f, 0.f, 0.f};
    cur = nxt; cA = nA; cB = nB; ++ui;
  }
  G8_WAIT_V(0);
  if (wr == 0) G8_BAR;
  G8_BAR;
}

__device__ __forceinline__ void p0_item(const Params& p, int item, char* lds) {
  const int tid = otid();
  char* ws = p.ws;
  if (item < 96) {
    float* sc = (float*)lds;
    float* red = sc + 3072;
    const int l = item / 48, cgp = item % 48;
    const float* cctx = p.in[6]; const float* cc2 = p.in[2];
    for (int i = tid; i < 3072; i += 512) {
      int j = i >> 10, k = i & 1023;
      float c = (j == 0) ? cctx[k] : cc2[(j > 0 ? j - 1 : 0) * 1024 + k];
      sc[i] = siluf(c);
    }
    __syncthreads();
    const int col = tid & 63, kg = tid >> 6;
    const float* W = p.in[7] + (size_t)l * 1024 * 3072 + cgp * 64 + col;
    float a0 = 0.f, a1 = 0.f, a2 = 0.f;
    for (int k = kg * 128; k < kg * 128 + 128; ++k) {
      float w = W[(size_t)k * 3072];
      a0 += sc[k] * w; a1 += sc[1024 + k] * w; a2 += sc[2048 + k] * w;
    }
    red[(kg * 3 + 0) * 64 + col] = a0; red[(kg * 3 + 1) * 64 + col] = a1; red[(kg * 3 + 2) * 64 + col] = a2;
    __syncthreads();
    if (tid < 192) {
      int j = tid >> 6; float s = 0.f;
      for (int g = 0; g < 8; ++g) s += red[(g * 3 + j) * 64 + col];
      int n = cgp * 64 + col;
      ((float*)(ws + OFF_MOD))[(l * 3 + j) * 3072 + n] = s + p.in[8][l * 3072 + n];
    }
    __syncthreads();
    return;
  }
  item -= 96;
  if (item < 128) {
    int idx = item * 512 + tid, t = idx >> 5, c = idx & 31, fi = c & 15;
    float pos = (c < 16) ? (float)(t >> 6) : (float)(t & 63);
    float inv = powf(10000.f, -(float)fi / 16.f);
    float ang = pos * inv;
    ((float2*)(ws + OFF_ROPE))[idx] = make_float2(cosf(ang), sinf(ang));
    return;
  }
  item -= 128;
  if (item < 2048) {
    int idx = item * 512 + tid, tp = idx >> 9, k0 = (idx & 511) * 8;
    uint32_t o[4];
    float vv[8];
#pragma unroll
    for (int j = 0; j < 8; ++j) {
      int k = k0 + j; int m = (tp * (k & 2047)) & 2047; float s, c;
      sincospif((float)m * (1.f / 1024.f), &s, &c);
      vv[j] = (k < 2048) ? c : -s;
    }
#pragma unroll
    for (int j = 0; j < 4; ++j) o[j] = pack2(vv[2 * j], vv[2 * j + 1]);
    *(uint4*)(ws + OFF_DL + (size_t)idx * 16) = make_uint4(o[0], o[1], o[2], o[3]);
    return;
  }
  item -= 2048;
  if (item < 32) {
    int idx = item * 512 + tid, tp = idx >> 6, k0 = (idx & 63) * 8;
    uint32_t o[4];
    float vv[8];
#pragma unroll
    for (int j = 0; j < 8; ++j) {
      int k = k0 + j; int m = (tp * (k & 255)) & 255; float s, c;
      sincospif((float)m * (1.f / 128.f), &s, &c);
      vv[j] = (k < 256) ? c : -s;
    }
#pragma unroll
    for (int j = 0; j < 4; ++j) o[j] = pack2(vv[2 * j], vv[2 * j + 1]);
    *(uint4*)(ws + OFF_DC + (size_t)idx * 16) = make_uint4(o[0], o[1], o[2], o[3]);
    return;
  }
  item -= 32;
  if (item < 8) {
    int idx = item * 512 + tid, j = idx >> 4, c0 = (idx & 15) * 8;
    uint32_t o[4];
    float vv[8];
#pragma unroll
    for (int q = 0; q < 8; ++q) {
      int m = ((j & 127) * (c0 + q)) & 127; float s, c;
      sincospif((float)m * (1.f / 64.f), &s, &c);
      vv[q] = (j < 128) ? c : s;
    }
#pragma unroll
    for (int q = 0; q < 4; ++q) o[q] = pack2(vv[2 * q], vv[2 * q + 1]);
    *(uint4*)(ws + OFF_B1 + (size_t)idx * 16) = make_uint4(o[0], o[1], o[2], o[3]);
    return;
  }
  item -= 8;
  if (item < 128) {
    int idx = item * 512 + tid; int e = idx * 8;
    int n = e & 511, t = (e >> 9) & 255, l = (e >> 17) & 1, b = e >> 18;
    const float4* s = (const float4*)(p.in[3] + e);
    float4 a = s[0], c = s[1];
    size_t d = ((size_t)((l * 2 + b) * 256 + t)) * 512 + n;
    *(uint4*)(ws + OFF_KC + d * 2) = make_uint4(pack2(a.x, a.y), pack2(a.z, a.w), pack2(c.x, c.y), pack2(c.z, c.w));
    return;
  }
  item -= 128;
  {
    int idx = item * 512 + tid;
    int v = idx & 127, tc = (idx >> 7) & 31, h = (idx >> 12) & 3, b = (idx >> 14) & 1, l = idx >> 15;
    float vv[8];
#pragma unroll
    for (int j = 0; j < 8; ++j) vv[j] = p.in[4][((size_t)((b * 2 + l) * 256 + tc * 8 + j)) * 512 + h * 128 + v];
    size_t d = ((size_t)((b * 4 + h) * 128 + v)) * 2304 + 2048 + tc * 8;
    *(uint4*)(ws + OFF_VTL + l * SZ_VTL + d * 2) = make_uint4(pack2(vv[0], vv[1]), pack2(vv[2], vv[3]), pack2(vv[4], vv[5]), pack2(vv[6], vv[7]));
  }
}
constexpr int P0_ITEMS = 96 + 128 + 2048 + 32 + 8 + 128 + 128;

__device__ __forceinline__ void p1_item(const Params& p, int l, int item, char* lds) {
  const int tid = otid();
  char* ws = p.ws;
  if (item < 2816) {
    const float* src; int lsrc; u16* dst; int ldd; int kt, nt;
    const float* w10 = p.in[10]; const float* w17 = p.in[17]; const float* w18 = p.in[18]; const float* w19 = p.in[19]; const float* w20 = p.in[20];
    if (item < 2176) { src = w10 + (size_t)l * 1024 * 8704; lsrc = 8704; dst = (u16*)(ws + OFF_WIN); ldd = 1024; nt = item >> 4; kt = item & 15; }
    else if (item < 2560) { int r = item - 2176; int j = r >> 7; r &= 127; src = ((j == 0) ? w17 : ((j == 1) ? w18 : w19)) + (size_t)l * 512 * 1024; lsrc = 1024; dst = (u16*)(ws + OFF_WBR) + (size_t)j * 1024 * 512; ldd = 512; nt = r >> 3; kt = r & 7; }
    else { int r = item - 2560; src = w20 + (size_t)l * 1024 * 1024; lsrc = 1024; dst = (u16*)(ws + OFF_WO); ldd = 1024; nt = r >> 4; kt = r & 15; }
    u16* T = (u16*)lds;
    const int k0 = kt * 64, n0 = nt * 64;
#pragma unroll
    for (int ps = 0; ps < 2; ++ps) {
      int kr = (tid >> 4) + 32 * ps, nq = tid & 15;
      float4 v = *(const float4*)(src + (size_t)(k0 + kr) * lsrc + n0 + 4 * nq);
      T[(4 * nq + 0) * 72 + kr] = f2bf(v.x); T[(4 * nq + 1) * 72 + kr] = f2bf(v.y);
      T[(4 * nq + 2) * 72 + kr] = f2bf(v.z); T[(4 * nq + 3) * 72 + kr] = f2bf(v.w);
    }
    __syncthreads();
    {
      int n = tid >> 3, kc = tid & 7;
      uint4 o = *(const uint4*)(T + n * 72 + kc * 8);
      *(uint4*)(dst + (size_t)(n0 + n) * ldd + k0 + kc * 8) = o;
    }
    __syncthreads();
    return;
  }
  item -= 2816;
  const int lane = tid & 63, wid = tid >> 6;
  const float* modp = (const float*)(ws + OFF_MOD);
  u16* H = (u16*)(ws + OFF_H);
  const float* xin0 = p.in[0]; const float* xin1 = p.in[1]; const float* xin2 = p.out; const float* ng = p.in[9];
#pragma unroll
  for (int rr = 0; rr < 2; ++rr) {
    int r = item * 16 + wid * 2 + rr;
    const float* x = (l == 0) ? ((r < NCTX) ? xin0 + (size_t)r * 1024 : xin1 + (size_t)(r - NCTX) * 1024) : xin2 + (size_t)r * 1024;
    int ci = (r < NCTX) ? 0 : 1 + ((r - NCTX) >> 11);
    float4 v[4]; float ss = 0.f;
#pragma unroll
    for (int i = 0; i < 4; ++i) { v[i] = *(const float4*)(x + lane * 4 + 256 * i); ss += v[i].x * v[i].x + v[i].y * v[i].y + v[i].z * v[i].z + v[i].w * v[i].w; }
#pragma unroll
    for (int o = 32; o >= 1; o >>= 1) ss += __shfl_xor(ss, o);
    float rinv = rsqrtf(ss * (1.f / 1024.f) + EPSV);
    const float* sh = modp + (l * 3 + ci) * 3072;
#pragma unroll
    for (int i = 0; i < 4; ++i) {
      int col = lane * 4 + 256 * i;
      float4 g = *(const float4*)(ng + l * 1024 + col);
      float4 s1 = *(const float4*)(sh + 1024 + col);
      float4 s0 = *(const float4*)(sh + col);
      float a = v[i].x * rinv * g.x * (1.f + s1.x) + s0.x;
      float b = v[i].y * rinv * g.y * (1.f + s1.y) + s0.y;
      float c = v[i].z * rinv * g.z * (1.f + s1.z) + s0.z;
      float d = v[i].w * rinv * g.w * (1.f + s1.w) + s0.w;
      *(uint2*)(H + (size_t)r * 1024 + col) = make_uint2(pack2(a, b), pack2(c, d));
    }
  }
}
constexpr int P1_ITEMS = 2816 + 768;

struct P2Sched {
  const char* H; const char* W; int G, c;
  __device__ __forceinline__ bool next(int i, Unit& u) const {
    const int L = i * G + c;
    if (L >= 1056) return false;
    if (L < 960) {
      const int nM = 48, nN = 20, nwg = 960;
      int wgid = L; { const int q = nwg / 8, xcd = wgid % 8, off = wgid / 8; wgid = xcd * q + off; }
      const int nig = 8 * nN, gid = wgid / nig, fm = gid * 8, gsz = (nM - fm) < 8 ? (nM - fm) : 8;
      int pm = fm + ((wgid % nig) % gsz), pn = (wgid % nig) / gsz;
      if (pn >= 14) pn += 2;
      u.a = H + (size_t)pm * 256 * 2048; u.b = W + (size_t)pn * 256 * 2048; u.x = pm; u.y = pn;
    } else {
      const int r = L - 960; const int vq = r / 48, mt = r % 48;
      u.a = W + (size_t)(3584 + vq * 256) * 2048; u.b = H + (size_t)mt * 256 * 2048; u.x = vq; u.y = mt | 0x100;
    }
    return true;
  }
};
struct P2Epi {
  const float* const* pin; float* out; char* ws; int l;
  const float* hlb; const float* qng; const float* kng;
  __device__ __forceinline__ void operator()(f32x4 (&acc)[2][2][4][2], const Unit& u, int wr, int wc, int fr, int fq, LAS unsigned char* lds) const {
    { const int t_ = otid(); const int w_ = t_ >> 6; wr = w_ >> 2; wc = w_ & 3; fr = t_ & 15; fq = (t_ & 63) >> 4; }
    if (u.y & 0x100) {
      const int mt = u.y & 0xff, vq = u.x;
#pragma unroll
      for (int ai = 0; ai < 2; ++ai)
#pragma unroll
        for (int m = 0; m < 4; ++m) {
          const int nn = vq * 256 + ai * 128 + wr * 64 + m * 16 + fr;
          const int hh = nn >> 7, v = nn & 127;
#pragma unroll
          for (int bj = 0; bj < 2; ++bj)
#pragma unroll
            for (int n = 0; n < 2; ++n) {
              const int tokl = bj * 128 + wc * 32 + n * 16 + 4 * fq;
              f32x4 a4 = acc[ai][bj][m][n];
              uint2 pk = make_uint2(pack2(a4[0], a4[1]), pack2(a4[2], a4[3]));
              if (mt < 32) {
                *(uint2*)(ws + OFF_VTC + ((size_t)((mt * 4 + hh) * 128 + v) * 256 + tokl) * 2) = pk;
                float* o = out + OCV + ((size_t)((mt * 2 + l) * 256 + tokl)) * 512 + nn;
                o[0] = a4[0]; o[512] = a4[1]; o[1024] = a4[2]; o[1536] = a4[3];
              } else {
                int rp = (mt - 32) * 256 + tokl; int bb = rp >> 11, t = rp & 2047;
                *(uint2*)(ws + OFF_VTL + l * SZ_VTL + ((size_t)((bb * 4 + hh) * 128 + v) * 2304 + t) * 2) = pk;
              }
            }
        }
      return;
    }
    const int pm = u.x, pn = u.y, seg = pn >> 1, ncol0 = (pn & 1) * 256;
    const int dcol0 = ((seg < 7) ? seg : seg - 1) * 512 + ncol0;
    u16* proj = (u16*)(ws + OFF_PROJ);
    const bool lat = (pm >= 32);
    if (seg == 5 || seg == 6) {
      float* xch = (float*)(lds + G8_STAGE_BYTES);
#pragma unroll
      for (int ai = 0; ai < 2; ++ai)
#pragma unroll
        for (int m = 0; m < 4; ++m)
#pragma unroll
          for (int bj = 0; bj < 2; ++bj) {
            float ss = 0.f;
#pragma unroll
            for (int n = 0; n < 2; ++n)
#pragma unroll
              for (int e = 0; e < 4; ++e) { float bfv = bf2f(f2bf(acc[ai][bj][m][n][e])); ss += bfv * bfv; }
            ss += __shfl_xor(ss, 16); ss += __shfl_xor(ss, 32);
            if (fq == 0) xch[((ai * 128 + wr * 64 + m * 16 + fr) * 2 + bj) * 4 + wc] = ss;
          }
      asm volatile("s_waitcnt lgkmcnt(0)" ::: "memory");
      __builtin_amdgcn_s_barrier();
      asm volatile("" ::: "memory");
      const float* gsel = (seg == 5) ? qng : kng;
      float gv[2][4];
#pragma unroll
      for (int n = 0; n < 2; ++n)
#pragma unroll
        for (int e = 0; e < 4; ++e) gv[n][e] = gsel[l * 64 + 32 * (wc & 1) + 16 * n + 4 * fq + e];
#pragma unroll
      for (int ai = 0; ai < 2; ++ai)
#pragma unroll
        for (int m = 0; m < 4; ++m) {
          const int rl = ai * 128 + wr * 64 + m * 16 + fr;
          const int grow = pm * 256 + rl;
#pragma unroll
          for (int bj = 0; bj < 2; ++bj) {
            const float2 pr = *(const float2*)&xch[(rl * 2 + bj) * 4 + (wc & 2)];
            const float tot = pr.x + pr.y;
            const float rinv = rsqrtf(tot * (1.f / 64.f) + EPSV);
            float x[2][4];
#pragma unroll
            for (int n = 0; n < 2; ++n)
#pragma unroll
              for (int e = 0; e < 4; ++e) x[n][e] = bf2f(f2bf(acc[ai][bj][m][n][e])) * rinv * gv[n][e];
            const int colt = ncol0 + bj * 128 + wc * 32;
            if (seg == 6 && !lat) {
              float* o = out + OCK + ((size_t)((pm * 2 + l) * 256 + rl)) * 512 + colt + 4 * fq;
              *(float4*)o = make_float4(x[0][0], x[0][1], x[0][2], x[0][3]);
              *(float4*)(o + 16) = make_float4(x[1][0], x[1][1], x[1][2], x[1][3]);
            }
            if (lat) {
              const int t = (grow - NCTX) & 2047;
              const float2* rt = (const float2*)(ws + OFF_ROPE) + t * 32 + ((wc & 1) ? 16 : 0) + 4 * fq;
#pragma unroll
              for (int e = 0; e < 4; ++e) {
                float2 cs = rt[e];
                float x1 = x[0][e], x2 = x[1][e];
                x[0][e] = x1 * cs.x - x2 * cs.y;
                x[1][e] = x1 * cs.y + x2 * cs.x;
              }
            }
            if (seg == 5) {
#pragma unroll
              for (int n = 0; n < 2; ++n)
#pragma unroll
                for (int e = 0; e < 4; ++e) x[n][e] *= 0.125f;
            }
            u16* dp = proj + (size_t)grow * LDP + dcol0 + bj * 128 + wc * 32 + 4 * fq;
            *(uint2*)dp = make_uint2(pack2(x[0][0], x[0][1]), pack2(x[0][2], x[0][3]));
            *(uint2*)(dp + 16) = make_uint2(pack2(x[1][0], x[1][1]), pack2(x[1][2], x[1][3]));
          }
        }
      return;
    }
    const bool dosilu = (seg == 0 || seg == 4 || seg == 8 || seg == 10);
    const bool dolf = (seg == 1 || seg == 2);
    const int dir = (seg == 2) ? 1 : 0;
#pragma unroll
    for (int bj = 0; bj < 2; ++bj)
#pragma unroll
      for (int n = 0; n < 2; ++n) {
        float lbv[4];
        if (dolf) {
#pragma unroll
          for (int e = 0; e < 4; ++e) {
            int j = ncol0 + bj * 128 + wc * 32 + n * 16 + 4 * fq + e;
            lbv[e] = (l == 0) ? 0.f : sigmf(hlb[(1 * 2 + dir) * 512 + j] - hlb[(0 * 2 + dir) * 512 + j]);
          }
        }
#pragma unroll
        for (int ai = 0; ai < 2; ++ai)
#pragma unroll
          for (int m = 0; m < 4; ++m) {
            const int grow = pm * 256 + ai * 128 + wr * 64 + m * 16 + fr;
            f32x4 a4 = acc[ai][bj][m][n];
            if (dosilu) {
#pragma unroll
              for (int e = 0; e < 4; ++e) a4[e] = siluf(a4[e]);
            } else if (dolf) {
#pragma unroll
              for (int e = 0; e < 4; ++e) {
                a4[e] = logf_gate(a4[e], lbv[e]);
              }
            }
            *(uint2*)(proj + (size_t)grow * LDP + dcol0 + bj * 128 + wc * 32 + n * 16 + 4 * fq) = make_uint2(pack2(a4[0], a4[1]), pack2(a4[2], a4[3]));
          }
      }
  }
};
__device__ __forceinline__ void p2_phase(const Params& p, int l, char* lds) {
  P2Sched S; S.H = p.ws + OFF_H; S.W = p.ws + OFF_WIN; S.G = gridDim.x; S.c = blockIdx.x;
  P2Epi E; E.pin = nullptr; E.out = p.out; E.ws = p.ws; E.l = l; E.hlb = p.in[11]; E.qng = p.in[13]; E.kng = p.in[14];
  gemm_phase((LAS unsigned char*)lds, 1024, 1024, 1024, S, E);
}

struct HgrnLds {
  float tot[4][128];
  float dk[128];
  float osum[16][132];
  u16 qt[16][136];
  u16 kt[16][136];
  u16 khT[128][16];
  u16 vT[128][16];
  u16 obuf[256][136];
};

__device__ __forceinline__ void hgrn_pass(const Params& p, int l, int row0, int ntok, int h, int dir, f32x4 (&S)[8],
                                          const bool do_out, const bool second, float& gsum, HgrnLds& L, const bool dry = false) {
  const int tid = otid(), lane = tid & 63, wid = tid >> 6, c16 = lane & 15, g = lane >> 4;
  const int kk = tid & 127, tq = tid >> 7;
  const u16* proj = (const u16*)(p.ws + OFF_PROJ);
  u16* projw = (u16*)(p.ws + OFF_PROJ);
  const int nch = ntok >> 4;
  u16 lfr[4], qr[4], vr[4];
  auto ldchunk = [&](int c) {
#pragma unroll
    for (int i = 0; i < 4; ++i) {
      int s = c * 16 + 4 * tq + i;
      int tl = dir ? (ntok - 1 - s) : s;
      const u16* rp = proj + (size_t)(row0 + tl) * LDP + h * 128 + kk;
      lfr[i] = rp[PLF + dir * 512];
      vr[i] = rp[PIA];
      qr[i] = do_out ? rp[PQA] : (u16)0;
    }
  };
  ldchunk(0);
  for (int c = 0; c < nch; ++c) {
    float lf[4], G[4], qv[4];
    u16 vv[4];
#pragma unroll
    for (int i = 0; i < 4; ++i) { lf[i] = bf2f(lfr[i]); qv[i] = bf2f(qr[i]); vv[i] = vr[i]; }
    G[0] = lf[0]; G[1] = G[0] + lf[1]; G[2] = G[1] + lf[2]; G[3] = G[2] + lf[3];
    L.tot[tq][kk] = G[3];
    __syncthreads();
    if (c + 1 < nch) ldchunk(c + 1);
    float t0 = L.tot[0][kk], t1 = L.tot[1][kk], t2 = L.tot[2][kk], t3 = L.tot[3][kk];
    float off = (tq > 0 ? t0 : 0.f) + (tq > 1 ? t1 : 0.f) + (tq > 2 ? t2 : 0.f);
    float gend = t0 + t1 + t2 + t3;
    float kh[4];
#pragma unroll
    for (int i = 0; i < 4; ++i) {
      float Gi = G[i] + off;
      float kv = neg_expm1(lf[i]);
      int s = 4 * tq + i;
      if (do_out) {
        L.qt[s][kk] = f2bf(qv[i] * fexp(Gi));
        L.kt[s][kk] = f2bf(kv * fexp(-Gi));
      }
      kh[i] = kv * fexp(gend - Gi);
    }
    *(uint2*)&L.khT[kk][4 * tq] = make_uint2(pack2(kh[0], kh[1]), pack2(kh[2], kh[3]));
    *(uint2*)&L.vT[kk][4 * tq] = make_uint2((uint32_t)vv[0] | ((uint32_t)vv[1] << 16), (uint32_t)vv[2] | ((uint32_t)vv[3] << 16));
    if (tq == 0) { L.dk[kk] = fexp(gend); gsum += gend; }
    __syncthreads();
    Frag bv;
    bv.h[0] = *(const uint2*)&L.vT[16 * wid + c16][4 * g];
    bv.h[1] = make_uint2(0u, 0u);
    f32x4 o = f32x4{0.f, 0.f, 0.f, 0.f};
    if (do_out) {
      f32x4 at = f32x4{0.f, 0.f, 0.f, 0.f};
#pragma unroll
      for (int ks = 0; ks < 4; ++ks) {
        Frag a, b;
        a.q = *(const uint4*)&L.kt[c16][32 * ks + 8 * g];
        b.q = *(const uint4*)&L.qt[c16][32 * ks + 8 * g];
        at = MFMA(a.v, b.v, at);
      }
      Frag pa;
#pragma unroll
      for (int r = 0; r < 4; ++r) at[r] = (4 * g + r <= c16) ? at[r] : 0.f;
      pa.w[0] = pack2(at[0], at[1]); pa.w[1] = pack2(at[2], at[3]); pa.w[2] = 0u; pa.w[3] = 0u;
      o = MFMA(pa.v, bv.v, o);
#pragma unroll
      for (int st = 0; st < 4; ++st) {
        Frag a, b;
        a.h[0] = *(const uint2*)&L.qt[c16][32 * st + 4 * g];
        a.h[1] = *(const uint2*)&L.qt[c16][32 * st + 16 + 4 * g];
        b.w[0] = pack2(S[2 * st][0], S[2 * st][1]); b.w[1] = pack2(S[2 * st][2], S[2 * st][3]);
        b.w[2] = pack2(S[2 * st + 1][0], S[2 * st + 1][1]); b.w[3] = pack2(S[2 * st + 1][2], S[2 * st + 1][3]);
        o = MFMA(a.v, b.v, o);
      }
    }
#pragma unroll
    for (int k8 = 0; k8 < 8; ++k8) {
      float4 d = *(const float4*)&L.dk[16 * k8 + 4 * g];
      f32x4 s0 = S[k8];
      s0[0] *= d.x; s0[1] *= d.y; s0[2] *= d.z; s0[3] *= d.w;
      Frag a;
      a.h[0] = *(const uint2*)&L.khT[16 * k8 + c16][4 * g];
      a.h[1] = make_uint2(0u, 0u);
      S[k8] = MFMA(a.v, bv.v, s0);
    }
    if (do_out) {
      const int vcol = 16 * wid + c16;
      if (!second) {
#pragma unroll
        for (int r = 0; r < 4; ++r) {
          int s = c * 16 + 4 * g + r;
          int tl = dir ? (ntok - 1 - s) : s;
          L.obuf[tl][vcol] = f2bf(o[r]);
        }
      } else {
#pragma unroll
        for (int r = 0; r < 4; ++r) {
          int s = c * 16 + 4 * g + r;
          int tl = dir ? (ntok - 1 - s) : s;
          L.osum[4 * g + r][vcol] = o[r] + bf2f(L.obuf[tl][vcol]);
        }
        __syncthreads();
        {
          int sl = tid >> 5, vq = tid & 31;
          int s = c * 16 + sl;
          int tl = dir ? (ntok - 1 - s) : s;
          float4 ov = *(const float4*)&L.osum[sl][4 * vq];
          float ss = ov.x * ov.x + ov.y * ov.y + ov.z * ov.z + ov.w * ov.w;
#pragma unroll
          for (int m = 1; m <= 16; m <<= 1) ss += __shfl_xor(ss, m);
          float rinv = rsqrtf(ss * (1.f / 128.f) + EPSV);
          float4 gg = *(const float4*)(p.in[12] + l * 512 + h * 128 + 4 * vq);
          u16* rp = projw + (size_t)(row0 + tl) * LDP + h * 128 + 4 * vq;
          uint2 z = *(const uint2*)(rp + PZA);
          float y0 = ov.x * rinv * gg.x * lo2f(z.x), y1 = ov.y * rinv * gg.y * hi2f(z.x);
          float y2 = ov.z * rinv * gg.z * lo2f(z.y), y3 = ov.w * rinv * gg.w * hi2f(z.y);
          if (!dry) *(uint2*)(rp + PQA) = make_uint2(pack2(y0, y1), pack2(y2, y3));
        }
      }
    }
  }
  __syncthreads();
}

__device__ __forceinline__ void hgrn_load_state(const float* m, f32x4 (&S)[8]) {
  const int tid_ = otid(); const int lane = tid_ & 63, wid = tid_ >> 6, c16 = lane & 15, g = lane >> 4;
#pragma unroll
  for (int k8 = 0; k8 < 8; ++k8)
#pragma unroll
    for (int r = 0; r < 4; ++r) S[k8][r] = m[(16 * k8 + 4 * g + r) * 128 + 16 * wid + c16];
}
__device__ __forceinline__ void hgrn_store_state(float* m, const f32x4 (&S)[8]) {
  const int tid_ = otid(); const int lane = tid_ & 63, wid = tid_ >> 6, c16 = lane & 15, g = lane >> 4;
#pragma unroll
  for (int k8 = 0; k8 < 8; ++k8)
#pragma unroll
    for (int r = 0; r < 4; ++r) m[(16 * k8 + 4 * g + r) * 128 + 16 * wid + c16] = S[k8][r];
}
__device__ __forceinline__ void hgrn_advance(const float* U, const float* D, f32x4 (&S)[8]) {
  const int tid_ = otid(); const int lane = tid_ & 63, wid = tid_ >> 6, c16 = lane & 15, g = lane >> 4;
#pragma unroll
  for (int k8 = 0; k8 < 8; ++k8)
#pragma unroll
    for (int r = 0; r < 4; ++r) {
      int k = 16 * k8 + 4 * g + r;
      S[k8][r] = D[k] * S[k8][r] + U[k * 128 + 16 * wid + c16];
    }
}

__device__ __forceinline__ void hgrn_ctx_item(const Params& p, int l, int item, char* lds, const bool dry = false) {
  HgrnLds& L = *(HgrnLds*)lds;
  const int b = item >> 2, h = item & 3;
  f32x4 S[8];
  float gsum = 0.f;
#pragma unroll
  for (int i = 0; i < 8; ++i) S[i] = f32x4{0.f, 0.f, 0.f, 0.f};
  hgrn_pass(p, l, b * 256, 256, h, 0, S, true, false, gsum, L, dry);
  if (!dry) hgrn_store_state(p.out + OST + ((size_t)(((b * 2 + l) * 2 + 0) * 4 + h)) * 16384, S);
#pragma unroll
  for (int i = 0; i < 8; ++i) S[i] = f32x4{0.f, 0.f, 0.f, 0.f};
  hgrn_pass(p, l, b * 256, 256, h, 1, S, true, true, gsum, L, dry);
  if (!dry) hgrn_store_state(p.out + OST + ((size_t)(((b * 2 + l) * 2 + 1) * 4 + h)) * 16384, S);
}
__device__ __forceinline__ void hgrn_lat1_item(const Params& p, int l, int item, char* lds) {
  HgrnLds& L = *(HgrnLds*)lds;
  const int seg = item & 15, dir = (item >> 4) & 1, h = (item >> 5) & 3, b = item >> 7;
  f32x4 S[8];
  float gsum = 0.f;
#pragma unroll
  for (int i = 0; i < 8; ++i) S[i] = f32x4{0.f, 0.f, 0.f, 0.f};
  hgrn_pass(p, l, NCTX + b * 2048 + seg * 128, 128, h, dir, S, false, false, gsum, L);
  hgrn_store_state((float*)(p.ws + OFF_SEGU) + (size_t)item * 16384, S);
  { const int t_ = otid(); if (t_ < 128) ((float*)(p.ws + OFF_SEGD))[item * 128 + t_] = expf(gsum); }
}
__device__ __forceinline__ void hgrn_lat2_item(const Params& p, int l, int item, char* lds, const bool dry = false) {
  HgrnLds& L = *(HgrnLds*)lds;
  const int seg = item & 15, h = (item >> 4) & 3, b = item >> 6;
  const float* SU = (const float*)(p.ws + OFF_SEGU);
  const float* SD = (const float*)(p.ws + OFF_SEGD);
  f32x4 S[8];
  float gsum = 0.f;
  hgrn_load_state(p.in[5] + ((size_t)(((b * 2 + l) * 2 + 0) * 4 + h)) * 16384, S);
  for (int i = 0; i < seg; ++i) {
    int it = ((b * 4 + h) * 2 + 0) * 16 + i;
    hgrn_advance(SU + (size_t)it * 16384, SD + it * 128, S);
  }
  hgrn_pass(p, l, NCTX + b * 2048 + seg * 128, 128, h, 0, S, true, false, gsum, L, dry);
  hgrn_load_state(p.in[5] + ((size_t)(((b * 2 + l) * 2 + 1) * 4 + h)) * 16384, S);
  for (int i = 15; i > seg; --i) {
    int it = ((b * 4 + h) * 2 + 1) * 16 + i;
    hgrn_advance(SU + (size_t)it * 16384, SD + it * 128, S);
  }
  hgrn_pass(p, l, NCTX + b * 2048 + seg * 128, 128, h, 1, S, true, true, gsum, L, dry);
}

__device__ __forceinline__ void attn_item(const Params& p, int l, int item, const bool lat, char* lds, const bool dry = false) {
  const int tid = otid(), lane = tid & 63, wid = tid >> 6, c16 = lane & 15, g = lane >> 4;
  char* ws = p.ws;
  u16* proj = (u16*)(ws + OFF_PROJ);
  int b, h, qb, nkeys, rowbase;
  const u16* Vt; int ldv;
  if (!lat) { qb = item & 1; h = (item >> 1) & 3; b = item >> 3; nkeys = 256; rowbase = b * 256; Vt = (const u16*)(ws + OFF_VTC) + (size_t)((b * 4 + h) * 128) * 256; ldv = 256; }
  else { qb = item & 15; h = (item >> 4) & 3; b = item >> 6; nkeys = 2304; rowbase = NCTX + b * 2048; Vt = (const u16*)(ws + OFF_VTL + l * SZ_VTL) + (size_t)((b * 4 + h) * 128) * 2304; ldv = 2304; }
  const u16* Kc = (const u16*)(ws + OFF_KC) + (size_t)((l * 2 + b) * 256) * 512 + h * 128;
  u16* Ks = (u16*)lds;
  u16* Vs = Ks + 64 * 136;
  float lam_init = 0.8f - 0.6f * expf(-0.3f * (float)l);
  float lam;
  {
    const float* lp = p.in[15] + l * 256;
    float a = lp[lane] * lp[64 + lane], c = lp[128 + lane] * lp[192 + lane];
#pragma unroll
    for (int o = 32; o >= 1; o >>= 1) { a += __shfl_xor(a, o); c += __shfl_xor(c, o); }
    lam = expf(a) - expf(c) + lam_init;
  }
  const int qrow = rowbase + qb * 128 + wid * 16 + c16;
  Frag qf[2][2];
#pragma unroll
  for (int m = 0; m < 2; ++m)
#pragma unroll
    for (int ks = 0; ks < 2; ++ks) qf[m][ks].q = *(const uint4*)(proj + (size_t)qrow * LDP + PQB + h * 128 + m * 64 + ks * 32 + g * 8);
  f32x4 O[2][8];
#pragma unroll
  for (int m = 0; m < 2; ++m)
#pragma unroll
    for (int v = 0; v < 8; ++v) O[m][v] = f32x4{0.f, 0.f, 0.f, 0.f};
  float mrun[2] = {-1e30f, -1e30f}, lsum[2] = {0.f, 0.f};
  uint4 kr0, kr1, vr0, vr1;
#define ATT_LD(kt_)                                                                                           \
  {                                                                                                           \
    const int key0 = (kt_) * 64;                                                                              \
    const bool fromproj = (!lat) || (key0 < 2048);                                                            \
    {                                                                                                         \
      int q = tid; int key = q >> 4, cc = q & 15;                                                             \
      const u16* src = fromproj ? proj + (size_t)(rowbase + key0 + key) * LDP + PKB + h * 128 + cc * 8        \
                                : Kc + (size_t)(key0 - 2048 + key) * 512 + cc * 8;                            \
      kr0 = *(const uint4*)src;                                                                               \
      int v = q >> 3, c8 = q & 7;                                                                             \
      vr0 = *(const uint4*)(Vt + (size_t)v * ldv + key0 + c8 * 8);                                            \
    }                                                                                                         \
    {                                                                                                         \
      int q = tid + 512; int key = q >> 4, cc = q & 15;                                                       \
      const u16* src = fromproj ? proj + (size_t)(rowbase + key0 + key) * LDP + PKB + h * 128 + cc * 8        \
                                : Kc + (size_t)(key0 - 2048 + key) * 512 + cc * 8;                            \
      kr1 = *(const uint4*)src;                                                                               \
      int v = q >> 3, c8 = q & 7;                                                                             \
      vr1 = *(const uint4*)(Vt + (size_t)v * ldv + key0 + c8 * 8);                                            \
    }                                                                                                         \
  }
#define ATT_ST()                                                                                              \
  {                                                                                                           \
    { int q = tid; int key = q >> 4, cc = q & 15; *(uint4*)(Ks + key * 136 + cc * 8) = kr0;                   \
      int v = q >> 3, c8 = q & 7; *(uint4*)(Vs + v * 72 + c8 * 8) = vr0; }                                    \
    { int q = tid + 512; int key = q >> 4, cc = q & 15; *(uint4*)(Ks + key * 136 + cc * 8) = kr1;             \
      int v = q >> 3, c8 = q & 7; *(uint4*)(Vs + v * 72 + c8 * 8) = vr1; }                                    \
  }
  const int nkt = nkeys >> 6;
  ATT_LD(0);
  for (int kt = 0; kt < nkt; ++kt) {
    __syncthreads();
    ATT_ST();
    __syncthreads();
    if (kt + 1 < nkt) ATT_LD(kt + 1);
    Frag pf[2][2];
#pragma unroll
    for (int m = 0; m < 2; ++m) {
      f32x4 s[4];
#pragma unroll
      for (int k4 = 0; k4 < 4; ++k4) {
        s[k4] = f32x4{0.f, 0.f, 0.f, 0.f};
#pragma unroll
        for (int ks = 0; ks < 2; ++ks) {
          Frag a;
          a.q = *(const uint4*)(Ks + (16 * k4 + c16) * 136 + m * 64 + ks * 32 + g * 8);
          s[k4] = MFMA(a.v, qf[m][ks].v, s[k4]);
        }
      }
      float mx = -1e30f;
#pragma unroll
      for (int k4 = 0; k4 < 4; ++k4)
#pragma unroll
        for (int r = 0; r < 4; ++r) mx = fmaxf(mx, s[k4][r]);
      mx = fmaxf(mx, __shfl_xor(mx, 16));
      mx = fmaxf(mx, __shfl_xor(mx, 32));
      float mnew = fmaxf(mrun[m], mx);
      float alpha = fexp(mrun[m] - mnew);
      mrun[m] = mnew;
      float ps = 0.f;
#pragma unroll
      for (int k4 = 0; k4 < 4; ++k4)
#pragma unroll
        for (int r = 0; r < 4; ++r) { s[k4][r] = fexp(s[k4][r] - mnew); ps += s[k4][r]; }
      lsum[m] = lsum[m] * alpha + ps;
#pragma unroll
      for (int v = 0; v < 8; ++v) { O[m][v][0] *= alpha; O[m][v][1] *= alpha; O[m][v][2] *= alpha; O[m][v][3] *= alpha; }
#pragma unroll
      for (int sp = 0; sp < 2; ++sp) {
        pf[m][sp].w[0] = pack2(s[2 * sp][0], s[2 * sp][1]); pf[m][sp].w[1] = pack2(s[2 * sp][2], s[2 * sp][3]);
        pf[m][sp].w[2] = pack2(s[2 * sp + 1][0], s[2 * sp + 1][1]); pf[m][sp].w[3] = pack2(s[2 * sp + 1][2], s[2 * sp + 1][3]);
      }
    }
#pragma unroll
    for (int v = 0; v < 8; ++v)
#pragma unroll
      for (int sp = 0; sp < 2; ++sp) {
        Frag a;
        a.h[0] = *(const uint2*)(Vs + (16 * v + c16) * 72 + 32 * sp + 4 * g);
        a.h[1] = *(const uint2*)(Vs + (16 * v + c16) * 72 + 32 * sp + 16 + 4 * g);
        O[0][v] = MFMA(a.v, pf[0][sp].v, O[0][v]);
        O[1][v] = MFMA(a.v, pf[1][sp].v, O[1][v]);
      }
  }
  float l0 = lsum[0], l1 = lsum[1];
  l0 += __shfl_xor(l0, 16); l0 += __shfl_xor(l0, 32);
  l1 += __shfl_xor(l1, 16); l1 += __shfl_xor(l1, 32);
  const float i0 = 1.f / l0, i1 = lam / l1;
  float ss = 0.f;
#pragma unroll
  for (int v = 0; v < 8; ++v)
#pragma unroll
    for (int r = 0; r < 4; ++r) { float o = O[0][v][r] * i0 - O[1][v][r] * i1; O[0][v][r] = o; ss += o * o; }
  ss += __shfl_xor(ss, 16); ss += __shfl_xor(ss, 32);
  const float rinv = rsqrtf(ss * (1.f / 128.f) + EPSV) * (1.f - lam_init);
  u16* rp = proj + (size_t)qrow * LDP + h * 128;
#pragma unroll
  for (int v = 0; v < 8; ++v) {
    int vc = 16 * v + 4 * g;
    float4 sg = *(const float4*)(p.in[16] + l * 128 + vc);
    uint2 z = *(const uint2*)(rp + PZB + vc);
    float y0 = O[0][v][0] * rinv * sg.x * lo2f(z.x), y1 = O[0][v][1] * rinv * sg.y * hi2f(z.x);
    float y2 = O[0][v][2] * rinv * sg.z * lo2f(z.y), y3 = O[0][v][3] * rinv * sg.w * hi2f(z.y);
    if (!dry) *(uint2*)(rp + PQB + vc) = make_uint2(pack2(y0, y1), pack2(y2, y3));
  }
  __syncthreads();
}

__device__ __forceinline__ void f1_item(const Params& p, int item, char* lds) {
  const int tid = otid(), lane = tid & 63, wid = tid >> 6, wr = wid >> 2, wc = wid & 3, fr = lane & 15, fq = lane >> 4;
  char* ws = p.ws;
  const int jh = item & 1, gq = (item >> 1) & 3, mt = item >> 3;
  f32x4 acc[4][4];
  gemm_kloop<128>((const u16*)(ws + OFF_B1) + jh * 128 * 128, 128, (const u16*)(ws + OFF_PROJ) + (size_t)(mt * 256) * LDP + PUC + gq * 128, LDP, 128, acc, lds);
#pragma unroll
  for (int a = 0; a < 4; ++a)
#pragma unroll
    for (int b = 0; b < 4; ++b) {
      int tokl = wc * 64 + a * 16 + 4 * fq;
      int jj = wr * 64 + b * 16 + fr;
      uint2 pk = make_uint2(pack2(acc[a][b][0], acc[a][b][1]), pack2(acc[a][b][2], acc[a][b][3]));
      if (mt < 32) {
        *(uint2*)(ws + OFF_PTC + ((size_t)((mt * 4 + gq) * 128 + jj) * 512 + jh * 256 + tokl) * 2) = pk;
      } else {
        int rp = (mt - 32) * 256 + tokl; int bb = rp >> 11, t = rp & 2047;
        *(uint2*)(ws + OFF_PTL + ((size_t)((bb * 4 + gq) * 128 + jj) * 4096 + jh * 2048 + t) * 2) = pk;
      }
    }
}

struct F2Epi {
  char* ws; float scl; int rowbase_mul;
  bool lat;
  __device__ __forceinline__ void operator()(f32x4 (&acc)[2][2][4][2], const Unit& u, int wr, int wc, int fr, int fq, LAS unsigned char* lds) const {
    u16* proj = (u16*)(ws + OFF_PROJ);
#pragma unroll
    for (int ai = 0; ai < 2; ++ai)
#pragma unroll
      for (int m = 0; m < 4; ++m) {
        const int tp = u.x * 256 + ai * 128 + wr * 64 + m * 16 + fr;
#pragma unroll
        for (int bj = 0; bj < 2; ++bj)
#pragma unroll
          for (int n = 0; n < 2; ++n) {
            const int nn = u.y * 256 + bj * 128 + wc * 32 + n * 16 + 4 * fq;
            const int bb = nn >> 9, col = nn & 511;
            u16* rp = proj + (size_t)(lat ? (NCTX + bb * 2048 + tp) : (bb * 256 + tp)) * LDP;
            uint2 z = *(const uint2*)(rp + PZC + col);
            f32x4 a4 = acc[ai][bj][m][n];
            *(uint2*)(rp + PUC + col) = make_uint2(pack2(a4[0] * scl * lo2f(z.x), a4[1] * scl * hi2f(z.x)),
                                                   pack2(a4[2] * scl * lo2f(z.y), a4[3] * scl * hi2f(z.y)));
          }
      }
  }
};
__device__ __forceinline__ void f2c_item(const Params& p, int item, char* lds) {
  OneUnit S; S.u.a = p.ws + OFF_DC; S.u.b = p.ws + OFF_PTC + (size_t)item * 256 * 1024; S.u.x = 0; S.u.y = item;
  F2Epi E; E.ws = p.ws; E.scl = 0.005524271728019903f; E.lat = false; E.rowbase_mul = 0;
  gemm_phase((LAS unsigned char*)lds, 512, 512, 512, S, E);
}
__device__ __forceinline__ void f2l_item(const Params& p, int item, char* lds) {
  const int mt = item >> 2, nt = item & 3;
  OneUnit S; S.u.a = p.ws + OFF_DL + (size_t)mt * 256 * 8192; S.u.b = p.ws + OFF_PTL + (size_t)nt * 256 * 8192; S.u.x = mt; S.u.y = nt;
  F2Epi E; E.ws = p.ws; E.scl = 1.f / 512.f; E.lat = true; E.rowbase_mul = 0;
  gemm_phase((LAS unsigned char*)lds, 4096, 4096, 4096, S, E);
}

struct P5GateEpi {
  uint2* gs;
  __device__ __forceinline__ void operator()(f32x4 (&acc)[2][2][4][2], const Unit& u, int wr, int wc, int fr, int fq, LAS unsigned char* lds) const {
    const int tid = wr * 256 + wc * 64 + fq * 16 + fr;
#pragma unroll
    for (int ai = 0; ai < 2; ++ai)
#pragma unroll
      for (int bj = 0; bj < 2; ++bj)
#pragma unroll
        for (int m = 0; m < 4; ++m)
#pragma unroll
          for (int n = 0; n < 2; ++n) {
            f32x4 a4 = acc[ai][bj][m][n];
            gs[(((ai * 2 + bj) * 4 + m) * 2 + n) * 512 + tid] = make_uint2(pack2(sigmf(a4[0]), sigmf(a4[1])), pack2(sigmf(a4[2]), sigmf(a4[3])));
          }
  }
};
struct P5BranchEpi {
  const uint2* gs; u16* mg; int j;
  __device__ __forceinline__ void operator()(f32x4 (&acc)[2][2][4][2], const Unit& u, int wr, int wc, int fr, int fq, LAS unsigned char* lds) const {
    const int tid = wr * 256 + wc * 64 + fq * 16 + fr;
#pragma unroll
    for (int ai = 0; ai < 2; ++ai)
#pragma unroll
      for (int m = 0; m < 4; ++m) {
        const int row = u.x * 256 + ai * 128 + wr * 64 + m * 16 + fr;
#pragma unroll
        for (int bj = 0; bj < 2; ++bj)
#pragma unroll
          for (int n = 0; n < 2; ++n) {
            const int col = u.y * 256 + bj * 128 + wc * 32 + n * 16 + 4 * fq;
            uint2 gv = gs[(((ai * 2 + bj) * 4 + m) * 2 + n) * 512 + tid];
            u16* dp = mg + (size_t)row * 1024 + col;
            f32x4 a4 = acc[ai][bj][m][n];
            float t0 = lo2f(gv.x) * a4[0], t1 = hi2f(gv.x) * a4[1], t2 = lo2f(gv.y) * a4[2], t3 = hi2f(gv.y) * a4[3];
            if (j > 0) { uint2 pv = *(const uint2*)dp; t0 += lo2f(pv.x); t1 += hi2f(pv.x); t2 += lo2f(pv.y); t3 += hi2f(pv.y); }
            *(uint2*)dp = make_uint2(pack2(t0, t1), pack2(t2, t3));
          }
      }
  }
};
__device__ __forceinline__ void p5_tile(const Params& p, int tile, char* lds) {
  char* ws = p.ws;
  const int pm = tile >> 2, pn = tile & 3;
  uint2* gs = (uint2*)(ws + OFF_SEGU) + (size_t)tile * (32 * 512);
#pragma unroll 1
  for (int j = 0; j < 3; ++j) {
    {
      OneUnit S; S.u.a = ws + OFF_H + (size_t)pm * 256 * 2048; S.u.b = ws + OFF_WIN + (size_t)(5632 + j * 1024 + pn * 256) * 2048; S.u.x = pm; S.u.y = pn;
      P5GateEpi E; E.gs = gs;
      gemm_phase((LAS unsigned char*)lds, 1024, 1024, 1024, S, E);
    }
    {
      const int yc = (j == 0) ? PQA : ((j == 1) ? PQB : PUC);
      OneUnit S; S.u.a = ws + OFF_PROJ + ((size_t)pm * 256 * LDP + yc) * 2; S.u.b = ws + OFF_WBR + ((size_t)j * 1024 * 512 + (size_t)pn * 256 * 512) * 2; S.u.x = pm; S.u.y = pn;
      P5BranchEpi E; E.gs = gs; E.mg = (u16*)(ws + OFF_MRG); E.j = j;
      gemm_phase((LAS unsigned char*)lds, LDP, 512, 512, S, E);
    }
  }
}

struct P6Epi {
  const float* xp0; const float* xs0; float* outp; const float* modp; int l;
  __device__ __forceinline__ void operator()(f32x4 (&acc)[2][2][4][2], const Unit& u, int wr, int wc, int fr, int fq, LAS unsigned char* lds) const {
    const int m0 = u.x * 256;
#pragma unroll
    for (int ai = 0; ai < 2; ++ai)
#pragma unroll
      for (int m = 0; m < 4; ++m) {
        const int r = m0 + ai * 128 + wr * 64 + m * 16 + fr;
        const float* x = (l == 0) ? ((m0 < NCTX) ? xp0 + (size_t)r * 1024 : xs0 + (size_t)(r - NCTX) * 1024) : outp + (size_t)r * 1024;
        const int ci = (m0 < NCTX) ? 0 : 1 + ((r - NCTX) >> 11);
#pragma unroll
        for (int bj = 0; bj < 2; ++bj)
#pragma unroll
          for (int n = 0; n < 2; ++n) {
            const int col = u.y * 256 + bj * 128 + wc * 32 + n * 16 + 4 * fq;
            float4 gt = *(const float4*)(modp + (l * 3 + ci) * 3072 + 2048 + col);
            float4 xv = *(const float4*)(x + col);
            f32x4 a4 = acc[ai][bj][m][n];
            *(float4*)(outp + (size_t)r * 1024 + col) = make_float4(xv.x + gt.x * a4[0], xv.y + gt.y * a4[1], xv.z + gt.z * a4[2], xv.w + gt.w * a4[3]);
          }
      }
  }
};
__device__ __forceinline__ void p6_tile(const Params& p, int l, int tile, char* lds) {
  char* ws = p.ws;
  const int pm = tile >> 2, pn = tile & 3;
  OneUnit S; S.u.a = ws + OFF_MRG + (size_t)pm * 256 * 2048; S.u.b = ws + OFF_WO + (size_t)pn * 256 * 2048; S.u.x = pm; S.u.y = pn;
  P6Epi E; E.xp0 = p.in[0]; E.xs0 = p.in[1]; E.outp = p.out; E.modp = (const float*)(ws + OFF_MOD); E.l = l;
  gemm_phase((LAS unsigned char*)lds, 1024, 1024, 1024, S, E);
}

#define XB_TMO      128
#define XB_XCNT(j)  (256  + 64 * (j))
#define XB_XSUB(j)  (1280 + 64 * (j))
#define XB_XGEN(j)  (2304 + 64 * (j))
#define XB_TOP      3328
#define XB_TOPGEN   3392
#define XCD_BAR_WORDS 3456
#define XB_SPIN_CAP (1u << 18)
struct XcdBarrier { unsigned* bar; unsigned x; volatile LAS unsigned* st; };
__device__ __forceinline__ unsigned xb_ld(unsigned* p) { return __hip_atomic_load(p, __ATOMIC_RELAXED, __HIP_MEMORY_SCOPE_AGENT); }
__device__ __forceinline__ unsigned xb_add(unsigned* p, unsigned v) { return __hip_atomic_fetch_add(p, v, __ATOMIC_RELAXED, __HIP_MEMORY_SCOPE_AGENT); }
__device__ __forceinline__ unsigned xb_xcc_id() { return (unsigned)__builtin_amdgcn_s_getreg((3 << 11) | 20) & 0xFu; }
#define XB_SPIN(cond, bar) do { unsigned _sp = 0; while (cond) { __builtin_amdgcn_s_sleep(1); \
    if ((++_sp & 255u) == 0u) { if (xb_ld(&(bar)[XB_TMO])) break; if (_sp > XB_SPIN_CAP) { atomicAdd(&(bar)[XB_TMO], 1u); break; } } } } while (0)
__device__ __forceinline__ XcdBarrier xcd_barrier_post(unsigned* bar, volatile LAS unsigned* st) {
  XcdBarrier b; b.bar = bar; b.x = xb_xcc_id(); b.st = st;
  if (threadIdx.x == 0) (void)xb_add(&bar[XB_XCNT(b.x)], 1u);
  return b;
}
__device__ __forceinline__ void xcd_barrier_complete(unsigned* bar, unsigned x, unsigned& nloc, unsigned& nx) {
  const unsigned G = gridDim.x * gridDim.y * gridDim.z;
  unsigned sum, cnt, mine, sp = 0u;
  for (;;) {
    sum = 0u; cnt = 0u; mine = 0u;
#pragma unroll
    for (unsigned j = 0; j < 16; ++j) { const unsigned c = xb_ld(&bar[XB_XCNT(j)]); sum += c; cnt += (c > 0u) ? 1u : 0u; mine = (j == x) ? c : mine; }
    if (sum == G) break;
    __builtin_amdgcn_s_sleep(1);
    if ((++sp & 255u) == 0u) { if (xb_ld(&bar[XB_TMO])) break; if (sp > XB_SPIN_CAP) { atomicAdd(&bar[XB_TMO], 1u); break; } }
  }
  nloc = mine > 0u ? mine : 1u; nx = cnt > 0u ? cnt : 1u;
}
__device__ __forceinline__ void xcd_barrier(const XcdBarrier& b) {
  asm volatile("s_waitcnt vmcnt(0)" ::: "memory");
  __syncthreads();
  if (threadIdx.x == 0) {
    unsigned* bar = b.bar;
    __builtin_amdgcn_s_waitcnt(0);
    unsigned nloc = b.st[0], nx = b.st[1];
    if (nloc == 0u) { xcd_barrier_complete(bar, b.x, nloc, nx); b.st[0] = nloc; b.st[1] = nx; }
    const unsigned old = xb_add(&bar[XB_XSUB(b.x)], 1u);
    const unsigned gen = old / nloc;
    if (old + 1u == (gen + 1u) * nloc) {
      __builtin_amdgcn_fence(__ATOMIC_RELEASE, "agent");
      asm volatile("s_waitcnt vmcnt(0)" ::: "memory");
      const unsigned og = xb_add(&bar[XB_TOP], 1u);
      const unsigned tg = og / nx;
      if (og + 1u == (tg + 1u) * nx) xb_add(&bar[XB_TOPGEN], 1u);
      else XB_SPIN(xb_ld(&bar[XB_TOPGEN]) == tg, bar);
      __builtin_amdgcn_fence(__ATOMIC_ACQUIRE, "agent");
      xb_add(&bar[XB_XGEN(b.x)], 1u);
      asm volatile("s_waitcnt vmcnt(0)" ::: "memory");
    } else {
      XB_SPIN(xb_ld(&bar[XB_XGEN(b.x)]) == gen, bar);
      __builtin_amdgcn_fence(__ATOMIC_ACQUIRE, "agent");
      asm volatile("s_waitcnt vmcnt(0)" ::: "memory");
    }
  }
  __syncthreads();
}

#define PARGS const float* a0, const float* a1, const float* a2, const float* a3, const float* a4, const float* a5, const float* a6, \
  const float* a7, const float* a8, const float* a9, const float* a10, const float* a11, const float* a12, const float* a13, \
  const float* a14, const float* a15, const float* a16, const float* a17, const float* a18, const float* a19, const float* a20, \
  float* aout, char* aws
#define PFILL Params p; p.in[0]=a0;p.in[1]=a1;p.in[2]=a2;p.in[3]=a3;p.in[4]=a4;p.in[5]=a5;p.in[6]=a6;p.in[7]=a7;p.in[8]=a8;p.in[9]=a9;p.in[10]=a10; \
  p.in[11]=a11;p.in[12]=a12;p.in[13]=a13;p.in[14]=a14;p.in[15]=a15;p.in[16]=a16;p.in[17]=a17;p.in[18]=a18;p.in[19]=a19;p.in[20]=a20;p.out=aout;p.ws=aws;
__global__ void __launch_bounds__(512) fwd_megakernel(PARGS) {
  PFILL
  extern __shared__ __attribute__((aligned(16))) char lds[];
  volatile int& s_item = *(volatile int*)(lds + LDS_TILE);
  cg::grid_group grid = cg::this_grid();
  const int bid = blockIdx.x, G = gridDim.x, tid = threadIdx.x;
  int* cnt = (int*)(p.ws + OFF_CNT);
  volatile LAS unsigned* bst = (volatile LAS unsigned*)(LAS unsigned char*)(lds + LDS_TILE + 16);
  if (tid < 2) bst[tid] = 0u;
  __syncthreads();
  const XcdBarrier xb = xcd_barrier_post((unsigned*)(p.ws + OFF_BAR), bst);
  for (int rep = 0; rep < ((DUP_MASK & 1) ? 2 : 1); ++rep) {
  for (int it = bid; it < P0_ITEMS; it += G) p0_item(p, it, lds);
  grid.sync();
  }
  for (int l = 0; l < 2; ++l) {
    for (int rep = 0; rep < ((DUP_MASK & 2) ? 2 : 1); ++rep) {
    for (int it = bid; it < P1_ITEMS; it += G) p1_item(p, l, it, lds);
    xcd_barrier(xb);
    }
    for (int rep = 0; rep < ((DUP_MASK & 4) ? 2 : 1); ++rep) {
    p2_phase(p, l, lds);
    xcd_barrier(xb);
    }
    for (;;) {
      __syncthreads();
      if (tid == 0) s_item = atomicAdd(&cnt[l * 2 + 0], 1);
      __syncthreads();
      int it = s_item;
      constexpr int D3 = (DUP_MASK & 16) ? 128 : 0;
      if (it >= D3 + 128 + 384 + 256 + 256) break;
      if (it < D3) { hgrn_ctx_item(p, l, it, lds, true); continue; }
      it -= D3;
      if (it < 128) hgrn_ctx_item(p, l, it, lds);
      else if (it < 512) f1_item(p, it - 128, lds);
      else if (it < 768) hgrn_lat1_item(p, l, it - 512, lds);
      else attn_item(p, l, it - 768, false, lds);
    }
    xcd_barrier(xb);
    for (;;) {
      __syncthreads();
      if (tid == 0) s_item = atomicAdd(&cnt[l * 2 + 1], 1);
      __syncthreads();
      int it = s_item;
      constexpr int D4a = (DUP_MASK & 32) ? 128 : 0, D4b = (DUP_MASK & 64) ? 128 : 0;
      if (it >= D4a + D4b + 32 + 128 + 128 + 64) break;
      if (it < D4a) { attn_item(p, l, it, true, lds, true); continue; }
      it -= D4a;
      if (it < D4b) { hgrn_lat2_item(p, l, it, lds, true); continue; }
      it -= D4b;
      if (it < 32) f2l_item(p, it, lds);
      else if (it < 160) attn_item(p, l, it - 32, true, lds);
      else if (it < 288) hgrn_lat2_item(p, l, it - 160, lds);
      else f2c_item(p, it - 288, lds);
    }
    xcd_barrier(xb);
    for (int rep = 0; rep < ((DUP_MASK & 8) ? 2 : 1); ++rep) {
    for (int it = bid; it < 192; it += G) p5_tile(p, it, lds);
    xcd_barrier(xb);
    }
    for (int it = bid; it < 192; it += G) p6_tile(p, l, it, lds);
    xcd_barrier(xb);
  }
}

extern "C" void kernel_launch(void* const* d_in, const int* in_sizes, int n_in,
                              void* d_out, int out_size, void* d_ws, size_t ws_size,
                              hipStream_t stream) {
  static int grid_blocks = 0;
  if (!grid_blocks) {
    int dev = 0, cus = 0;
    (void)hipGetDevice(&dev);
    (void)hipDeviceGetAttribute(&cus, hipDeviceAttributeMultiprocessorCount, dev);
    if (hipFuncSetAttribute((const void*)fwd_megakernel, hipFuncAttributeMaxDynamicSharedMemorySize, LDS_BYTES) != hipSuccess)
      fprintf(stderr, "hipFuncSetAttribute failed\n");
    grid_blocks = cus > 0 ? cus : 256;
    if (ws_size < WS_END) fprintf(stderr, "workspace too small: %zu < %zu\n", ws_size, (size_t)WS_END);
  }
  const void* ins[21];
  for (int i = 0; i < 21; ++i) ins[i] = d_in[i];
  void* outp = d_out; void* wsp = d_ws;
  void* args[23];
  for (int i = 0; i < 21; ++i) args[i] = (void*)&ins[i];
  args[21] = (void*)&outp; args[22] = (void*)&wsp;
  (void)hipMemsetAsync((char*)d_ws + OFF_CNT, 0, 256 + 3456 * 4, stream);
  hipError_t e = hipLaunchCooperativeKernel((void*)fwd_megakernel, dim3(grid_blocks), dim3(512), args, LDS_BYTES, stream);
  if (e != hipSuccess) fprintf(stderr, "cooperative launch failed: %s (grid %d)\n", hipGetErrorString(e), grid_blocks);
}
```

```cpp
#include <hip/hip_runtime.h>
#include <hip/hip_cooperative_groups.h>
#include <stdint.h>
#include <cstdio>
namespace cg = cooperative_groups;

typedef unsigned short u16;
using bf16x8 = __attribute__((ext_vector_type(8))) short;
using f32x4 = __attribute__((ext_vector_type(4))) float;
#define MFMA(a, b, c) __builtin_amdgcn_mfma_f32_16x16x32_bf16(a, b, c, 0, 0, 0)

constexpr int NTOK = 12288;
constexpr int NCTX = 8192;
constexpr int LDP = 5120;
constexpr int PQA = 0, PLF = 512, PIA = 1536, PZA = 2048, PQB = 2560, PKB = 3072, PZB = 3584, PUC = 4096, PZC = 4608;
constexpr float EPSV = 1e-6f;
constexpr size_t OCK = 12582912, OCV = 20971520, OST = 29360128;

constexpr size_t OFF_WIN = 0;
constexpr size_t OFF_WBR = OFF_WIN + 8704ull * 1024 * 2;
constexpr size_t OFF_WO = OFF_WBR + 3ull * 1024 * 512 * 2;
constexpr size_t OFF_H = OFF_WO + 1024ull * 1024 * 2;
constexpr size_t OFF_PROJ = OFF_H + 12288ull * 1024 * 2;
constexpr size_t OFF_R1 = OFF_PROJ + 12288ull * LDP * 2;
constexpr size_t OFF_PTC = OFF_R1;
constexpr size_t OFF_PTL = OFF_R1 + 16384ull * 512 * 2;
constexpr size_t OFF_MRG = OFF_R1;
constexpr size_t OFF_SEGU = OFF_R1 + 25165824ull;
constexpr size_t OFF_SEGD = OFF_SEGU + 256ull * 16384 * 4;
constexpr size_t OFF_VTC = OFF_SEGD + 256ull * 128 * 4;
constexpr size_t OFF_VTL = OFF_VTC + 32ull * 4 * 128 * 256 * 2;
constexpr size_t SZ_VTL = 2ull * 4 * 128 * 2304 * 2;
constexpr size_t OFF_KC = OFF_VTL + 2 * SZ_VTL;
constexpr size_t OFF_DL = OFF_KC + 2ull * 2 * 256 * 512 * 2;
constexpr size_t OFF_DC = OFF_DL + 2048ull * 4096 * 2;
constexpr size_t OFF_B1 = OFF_DC + 256ull * 512 * 2;
constexpr size_t OFF_ROPE = OFF_B1 + 256ull * 128 * 2;
constexpr size_t OFF_MOD = OFF_ROPE + 2048ull * 32 * 8;
constexpr size_t OFF_CNT = OFF_MOD + 2ull * 3 * 3072 * 4;
constexpr size_t OFF_BAR = OFF_CNT + 4096;
constexpr size_t OFF_F2P = OFF_BAR + 3456 * 4 + 192;
constexpr size_t WS_END = OFF_F2P + 32ull * 2 * 32 * 512 * 8;

constexpr int LDS_TILE = 131072 + 8192;
#define DUP_MASK 0
constexpr int LDS_BYTES = LDS_TILE + 64;

struct Params {
  const float* in[21];
  float* out;
  char* ws;
};

typedef __bf16 bf16x2_t __attribute__((ext_vector_type(2)));
typedef float f32x2_t __attribute__((ext_vector_type(2)));
__device__ __forceinline__ uint32_t pack2(float a, float b) {
  f32x2_t v = {a, b};
  bf16x2_t r = __builtin_convertvector(v, bf16x2_t);
  return __builtin_bit_cast(uint32_t, r);
}
__device__ __forceinline__ u16 f2bf(float f) { return (u16)(pack2(f, 0.f) & 0xffffu); }
__device__ __forceinline__ float bf2f(u16 h) { return __uint_as_float(((uint32_t)h) << 16); }
__device__ __forceinline__ float lo2f(uint32_t u) { return __uint_as_float(u << 16); }
__device__ __forceinline__ float hi2f(uint32_t u) { return __uint_as_float(u & 0xffff0000u); }
__device__ __forceinline__ float fexp(float x) { return __builtin_amdgcn_exp2f(x * 1.4426950408889634f); }
__device__ __forceinline__ float frcp(float x) { return __builtin_amdgcn_rcpf(x); }
__device__ __forceinline__ float flog(float x) { return __builtin_amdgcn_logf(x) * 0.6931471805599453f; }
__device__ __forceinline__ float siluf(float x) { return x * frcp(1.f + fexp(-x)); }
__device__ __forceinline__ float sigmf(float x) { return frcp(1.f + fexp(-x)); }
__device__ __forceinline__ float logf_gate(float x, float lb) {
  float xc = fmaxf(x, -80.f);
  float e = fexp(-xc);
  float omf = (1.f - lb) * e * frcp(1.f + e);
  float lf = flog(1.f - omf);
  lf = (lb == 0.f && x < -15.f) ? x : lf;
  return lf;
}
__device__ __forceinline__ float neg_expm1(float lf) {
  return (lf > -0.02f) ? -lf * (1.f + lf * (0.5f + lf * 0.16666667f)) : 1.f - fexp(lf);
}
__device__ __forceinline__ int otid() { int t = threadIdx.x; asm volatile("" : "+v"(t)); return t; }

union Frag {
  bf16x8 v;
  uint4 q;
  uint2 h[2];
  uint32_t w[4];
};

__device__ __forceinline__ int lds_byte(int r, int c) {
  int st = (r >> 4) * 2 + (c >> 5), rr = r & 15, cc = c & 31, ob = rr * 64 + cc * 2;
  return st * 1024 + (ob ^ (((ob >> 9) & 1) << 5));
}

template <int TM>
__device__ __forceinline__ void gemm_kloop(const u16* __restrict__ X, int ldx, const u16* __restrict__ Y, int ldy,
                                           int K, f32x4 (&acc)[4][TM / 32], char* lds) {
  constexpr int NX = TM / 64;
  constexpr int XT = TM / 32;
  constexpr int STAGE = TM * 128 + 32768;
  const int tid = otid(), lane = tid & 63, wid = tid >> 6, wr = wid >> 2, wc = wid & 3, fr = lane & 15, fq = lane >> 4;
#pragma unroll
  for (int a = 0; a < 4; ++a)
#pragma unroll
    for (int b = 0; b < XT; ++b) acc[a][b] = f32x4{0.f, 0.f, 0.f, 0.f};
  uint4 xr[NX], yr[4];
  const int nk = K >> 6;
  const int lrow = tid >> 3, lc8 = (tid & 7) * 8;
  const u16* xg = X + (size_t)lrow * ldx + lc8;
  const u16* yg = Y + (size_t)lrow * ldy + lc8;
  const int loff = lds_byte(lrow, lc8);
#pragma unroll
  for (int i = 0; i < NX; ++i) xr[i] = *(const uint4*)(xg + (size_t)(64 * i) * ldx);
#pragma unroll
  for (int i = 0; i < 4; ++i) yr[i] = *(const uint4*)(yg + (size_t)(64 * i) * ldy);
#pragma unroll
  for (int i = 0; i < NX; ++i) *(uint4*)(lds + loff + 8192 * i) = xr[i];
#pragma unroll
  for (int i = 0; i < 4; ++i) *(uint4*)(lds + TM * 128 + loff + 8192 * i) = yr[i];
  __syncthreads();
  for (int kt = 0; kt < nk; ++kt) {
    char* cur = lds + (kt & 1) * STAGE;
    char* nxt = lds + ((kt + 1) & 1) * STAGE;
    const bool more = (kt + 1 < nk);
    if (more) {
#pragma unroll
      for (int i = 0; i < NX; ++i) xr[i] = *(const uint4*)(xg + (size_t)(64 * i) * ldx + (kt + 1) * 64);
#pragma unroll
      for (int i = 0; i < 4; ++i) yr[i] = *(const uint4*)(yg + (size_t)(64 * i) * ldy + (kt + 1) * 64);
    }
#pragma unroll
    for (int ks = 0; ks < 2; ++ks) {
      Frag yf[4], xf[XT];
#pragma unroll
      for (int a = 0; a < 4; ++a) yf[a].q = *(const uint4*)(cur + TM * 128 + lds_byte(wc * 64 + a * 16 + fr, ks * 32 + fq * 8));
#pragma unroll
      for (int b = 0; b < XT; ++b) xf[b].q = *(const uint4*)(cur + lds_byte(wr * (TM / 2) + b * 16 + fr, ks * 32 + fq * 8));
#pragma unroll
      for (int a = 0; a < 4; ++a)
#pragma unroll
        for (int b = 0; b < XT; ++b) acc[a][b] = MFMA(yf[a].v, xf[b].v, acc[a][b]);
    }
    if (more) {
#pragma unroll
      for (int i = 0; i < NX; ++i) *(uint4*)(nxt + loff + 8192 * i) = xr[i];
#pragma unroll
      for (int i = 0; i < 4; ++i) *(uint4*)(nxt + TM * 128 + loff + 8192 * i) = yr[i];
    }
    __syncthreads();
  }
}

#define LAS __attribute__((address_space(3)))
constexpr int HTB = 128 * 64 * 2;
constexpr int G8_STAGE_BYTES = 8 * HTB;
__device__ __forceinline__ void stage_rc(int b, int& R, int& C) {
  const int st = b / 1024, sb = b % 1024, swz = sb ^ (((sb >> 9) & 1) << 5);
  R = (st >> 1) * 16 + swz / 64; C = (st & 1) * 32 + (swz % 64) / 2;
}
struct Unit { const char* a; const char* b; int x; int y; int lda; int ldb; int nt; int perm = 0; };
struct OneUnit {
  Unit u; int reps = 1;
  __device__ __forceinline__ bool next(int i, Unit& o) const { if (i >= reps) return false; o = u; return true; }
};
template <class Epi, class Sched>
__device__ __forceinline__ void gemm_phase(LAS unsigned char* lds, const Sched& S, const Epi& E) {
  const int tid = otid(), wid = __builtin_amdgcn_readfirstlane(tid >> 6), lane = tid & 63, wr = wid >> 2, wc = wid & 3, fr = lane & 15, fq = lane >> 4;
  int sR[2], sC[2];
#pragma unroll
  for (int i = 0; i < 2; ++i) stage_rc(tid * 16 + i * 8192, sR[i], sC[i]);
  int sRp[2];
#pragma unroll
  for (int i = 0; i < 2; ++i) { const int rho = sR[i] & 31, n_ = rho >> 4, i_ = rho & 15; sRp[i] = (sR[i] & ~31) + 8 * (i_ >> 2) + 4 * n_ + (i_ & 3); }
  const size_t kstep = 128;
  const unsigned ldsw = (unsigned)wid * 1024u;
  const int aoff = lds_byte(wr * 64 + fr, fq * 8), boff = lds_byte(wc * 32 + fr, fq * 8);
#define G8_SA(b, h) (((b) * 2 + (h)) * HTB)
#define G8_SB(b, h) ((4 + (b) * 2 + (h)) * HTB)
#define G8_STAGE(bufoff, gbase, voff) do { _Pragma("unroll") for (int _i = 0; _i < 2; ++_i) \
    __builtin_amdgcn_global_load_lds((const unsigned*)((const char*)(gbase) + (voff)[_i]), (LAS unsigned*)(lds + (bufoff) + ldsw + _i * 8192), 16, 0, 0); } while (0)
#define G8_LDA(dst, b, h) do { _Pragma("unroll") for (int m = 0; m < 4; ++m) _Pragma("unroll") for (int k = 0; k < 2; ++k) dst[m][k] = *(const LAS bf16x8*)(lds + G8_SA(b, h) + aoff + m * 2048 + k * 1024); } while (0)
#define G8_LDB(dst, b, h) do { _Pragma("unroll") for (int n = 0; n < 2; ++n) _Pragma("unroll") for (int k = 0; k < 2; ++k) dst[n][k] = *(const LAS bf16x8*)(lds + G8_SB(b, h) + boff + n * 2048 + k * 1024); } while (0)
#define G8_MMA(ai, bj, At, Bt) do { __builtin_amdgcn_s_setprio(1); _Pragma("unroll") for (int m = 0; m < 4; ++m) _Pragma("unroll") for (int n = 0; n < 2; ++n) _Pragma("unroll") for (int k = 0; k < 2; ++k) \
    acc[ai][bj][m][n] = __builtin_amdgcn_mfma_f32_16x16x32_bf16(Bt[n][k], At[m][k], acc[ai][bj][m][n], 0, 0, 0); __builtin_amdgcn_s_setprio(0); } while (0)
#define G8_WAIT_V(n) asm volatile("s_waitcnt vmcnt(" #n ")" ::: "memory")
#define G8_WAIT_L(n) asm volatile("s_waitcnt lgkmcnt(" #n ")" ::: "memory")
#define G8_BAR __builtin_amdgcn_s_barrier()
#define G8_SCHED __builtin_amdgcn_sched_barrier(0)
  Unit cur, nxt; int ui = 0;
  if (!S.next(0, cur)) return;
  f32x4 acc[2][2][4][2];
#pragma unroll
  for (int a = 0; a < 2; ++a)
#pragma unroll
    for (int b = 0; b < 2; ++b)
#pragma unroll
      for (int m = 0; m < 4; ++m)
#pragma unroll
        for (int n = 0; n < 2; ++n) acc[a][b][m][n] = f32x4{0.f, 0.f, 0.f, 0.f};
  bf16x8 At[4][2], B0[2][2], B1[2][2];
  const char* cA = cur.a; const char* cB = cur.b;
  unsigned voffA[2], voffB[2];
#pragma unroll
  for (int i = 0; i < 2; ++i) { voffA[i] = (unsigned)(sR[i] * cur.lda + sC[i]) * 2u; voffB[i] = (unsigned)((cur.perm ? sRp[i] : sR[i]) * cur.ldb + sC[i]) * 2u; }
  size_t hstepA = (size_t)128 * cur.lda * 2, hstepB = (size_t)128 * cur.ldb * 2;
  G8_STAGE(G8_SB(0, 0), cB, voffB); G8_STAGE(G8_SA(0, 0), cA, voffA); G8_STAGE(G8_SB(0, 1), cB + hstepB, voffB); G8_STAGE(G8_SA(0, 1), cA + hstepA, voffA);
  if (wr == 1) G8_BAR;
  G8_WAIT_V(4); G8_BAR;
  G8_STAGE(G8_SB(1, 0), cB + kstep, voffB); G8_STAGE(G8_SA(1, 0), cA + kstep, voffA); G8_STAGE(G8_SB(1, 1), cB + hstepB + kstep, voffB);
  G8_WAIT_V(6); G8_BAR;
  for (;;) {
    const bool has_next = S.next(ui + 1, nxt);
    if (!has_next) nxt = cur;
    const char* nA = nxt.a; const char* nB = nxt.b;
    unsigned voffAn[2], voffBn[2];
#pragma unroll
    for (int i = 0; i < 2; ++i) { voffAn[i] = (unsigned)(sR[i] * nxt.lda + sC[i]) * 2u; voffBn[i] = (unsigned)((nxt.perm ? sRp[i] : sR[i]) * nxt.ldb + sC[i]) * 2u; }
    const size_t hstepAn = (size_t)128 * nxt.lda * 2, hstepBn = (size_t)128 * nxt.ldb * 2;
    const int nt = cur.nt;
    for (int t = 0; t < nt; t += 2) {
      const bool last = (t == nt - 2);
      const char* a1 = cA + (size_t)(t + 1) * kstep;
      const char* a2 = last ? nA : cA + (size_t)(t + 2) * kstep; const char* b2 = last ? nB : cB + (size_t)(t + 2) * kstep;
      const char* a3 = a2 + kstep; const char* b3 = b2 + kstep;
      unsigned vA2[2], vB2[2];
#pragma unroll
      for (int i = 0; i < 2; ++i) { vA2[i] = last ? voffAn[i] : voffA[i]; vB2[i] = last ? voffBn[i] : voffB[i]; }
      const size_t hA2 = last ? hstepAn : hstepA, hB2 = last ? hstepBn : hstepB;
      G8_LDB(B0, 0, 0); G8_SCHED; G8_LDA(At, 0, 0); G8_STAGE(G8_SA(1, 1), a1 + hstepA, voffA);
      G8_WAIT_L(8); G8_BAR; G8_WAIT_L(0); G8_MMA(0, 0, At, B0); G8_BAR; G8_SCHED;
      G8_LDB(B1, 0, 1); G8_STAGE(G8_SB(0, 0), b2, vB2);
      G8_BAR; G8_WAIT_L(0); G8_MMA(0, 1, At, B1); G8_BAR;
      G8_LDA(At, 0, 1); G8_STAGE(G8_SA(0, 0), a2, vA2);
      G8_BAR; G8_WAIT_L(0); G8_MMA(1, 0, At, B0); G8_BAR; G8_SCHED;
      G8_STAGE(G8_SB(0, 1), b2 + hB2, vB2);
      G8_WAIT_V(6); G8_BAR; G8_MMA(1, 1, At, B1); G8_BAR;
      G8_LDB(B0, 1, 0); G8_SCHED; G8_LDA(At, 1, 0); G8_STAGE(G8_SA(0, 1), a2 + hA2, vA2);
      G8_WAIT_L(8); G8_BAR; G8_WAIT_L(0); G8_MMA(0, 0, At, B0); G8_BAR; G8_SCHED;
      G8_LDB(B1, 1, 1); G8_STAGE(G8_SB(1, 0), b3, vB2);
      G8_BAR; G8_WAIT_L(0); G8_MMA(0, 1, At, B1); G8_BAR;
      G8_LDA(At, 1, 1); G8_STAGE(G8_SA(1, 0), a3, vA2);
      G8_BAR; G8_WAIT_L(0); G8_MMA(1, 0, At, B0); G8_BAR; G8_SCHED;
      G8_STAGE(G8_SB(1, 1), b3 + hB2, vB2);
      G8_WAIT_V(6); G8_BAR; G8_MMA(1, 1, At, B1); G8_BAR;
    }
    E(acc, cur, wr, wc, fr, fq, lds);
    if (!has_next) break;
#pragma unroll
    for (int a = 0; a < 2; ++a)
#pragma unroll
      for (int b = 0; b < 2; ++b)
#pragma unroll
        for (int m = 0; m < 4; ++m)
#pragma unroll
          for (int n = 0; n < 2; ++n) acc[a][b][m][n] = f32x4{0.f, 0.f, 0.f, 0.f};
    cur = nxt; cA = nA; cB = nB; ++ui;
#pragma unroll
    for (int i = 0; i < 2; ++i) { voffA[i] = voffAn[i]; voffB[i] = voffBn[i]; }
    hstepA = hstepAn; hstepB = hstepBn;
  }
  G8_WAIT_V(0);
  if (wr == 0) G8_BAR;
  G8_BAR;
}

__device__ __forceinline__ void p0_item(const Params& p, int item, char* lds) {
  const int tid = otid();
  char* ws = p.ws;
  if (item < 96) {
    float* sc = (float*)lds;
    float* red = sc + 3072;
    const int l = item / 48, cgp = item % 48;
    const float* cctx = p.in[6]; const float* cc2 = p.in[2];
    for (int i = tid; i < 3072; i += 512) {
      int j = i >> 10, k = i & 1023;
      float c = (j == 0) ? cctx[k] : cc2[(j > 0 ? j - 1 : 0) * 1024 + k];
      sc[i] = siluf(c);
    }
    __syncthreads();
    const int col = tid & 63, kg = tid >> 6;
    const float* W = p.in[7] + (size_t)l * 1024 * 3072 + cgp * 64 + col;
    float a0 = 0.f, a1 = 0.f, a2 = 0.f;
    for (int k = kg * 128; k < kg * 128 + 128; ++k) {
      float w = W[(size_t)k * 3072];
      a0 += sc[k] * w; a1 += sc[1024 + k] * w; a2 += sc[2048 + k] * w;
    }
    red[(kg * 3 + 0) * 64 + col] = a0; red[(kg * 3 + 1) * 64 + col] = a1; red[(kg * 3 + 2) * 64 + col] = a2;
    __syncthreads();
    if (tid < 192) {
      int j = tid >> 6; float s = 0.f;
      for (int g = 0; g < 8; ++g) s += red[(g * 3 + j) * 64 + col];
      int n = cgp * 64 + col;
      ((float*)(ws + OFF_MOD))[(l * 3 + j) * 3072 + n] = s + p.in[8][l * 3072 + n];
    }
    __syncthreads();
    return;
  }
  item -= 96;
  if (item < 128) {
    int idx = item * 512 + tid, t = idx >> 5, c = idx & 31, fi = c & 15;
    float pos = (c < 16) ? (float)(t >> 6) : (float)(t & 63);
    float inv = powf(10000.f, -(float)fi / 16.f);
    float ang = pos * inv;
    ((float2*)(ws + OFF_ROPE))[idx] = make_float2(cosf(ang), sinf(ang));
    return;
  }
  item -= 128;
  if (item < 2048) {
    const float2* tab = (const float2*)lds;
    int idx = item * 512 + tid, tp = idx >> 9, k0 = (idx & 511) * 8;
    uint32_t o[4];
    float vv[8];
#pragma unroll
    for (int j = 0; j < 8; ++j) {
      int k = k0 + j; int m = (tp * (k & 2047)) & 2047;
      float2 cs = tab[m];
      vv[j] = (k < 2048) ? cs.x : -cs.y;
    }
#pragma unroll
    for (int j = 0; j < 4; ++j) o[j] = pack2(vv[2 * j], vv[2 * j + 1]);
    *(uint4*)(ws + OFF_DL + (size_t)idx * 16) = make_uint4(o[0], o[1], o[2], o[3]);
    return;
  }
  item -= 2048;
  if (item < 32) {
    int idx = item * 512 + tid, tp = idx >> 6, k0 = (idx & 63) * 8;
    uint32_t o[4];
    float vv[8];
#pragma unroll
    for (int j = 0; j < 8; ++j) {
      int k = k0 + j; int m = (tp * (k & 255)) & 255; float s, c;
      sincospif((float)m * (1.f / 128.f), &s, &c);
      vv[j] = (k < 256) ? c : -s;
    }
#pragma unroll
    for (int j = 0; j < 4; ++j) o[j] = pack2(vv[2 * j], vv[2 * j + 1]);
    *(uint4*)(ws + OFF_DC + (size_t)idx * 16) = make_uint4(o[0], o[1], o[2], o[3]);
    return;
  }
  item -= 32;
  if (item < 8) {
    int idx = item * 512 + tid, j = idx >> 4, c0 = (idx & 15) * 8;
    uint32_t o[4];
    float vv[8];
#pragma unroll
    for (int q = 0; q < 8; ++q) {
      int m = ((j & 127) * (c0 + q)) & 127; float s, c;
      sincospif((float)m * (1.f / 64.f), &s, &c);
      vv[q] = (j < 128) ? c : s;
    }
#pragma unroll
    for (int q = 0; q < 4; ++q) o[q] = pack2(vv[2 * q], vv[2 * q + 1]);
    *(uint4*)(ws + OFF_B1 + (size_t)idx * 16) = make_uint4(o[0], o[1], o[2], o[3]);
    return;
  }
  item -= 8;
  if (item < 128) {
    int idx = item * 512 + tid; int e = idx * 8;
    int n = e & 511, t = (e >> 9) & 255, l = (e >> 17) & 1, b = e >> 18;
    const float4* s = (const float4*)(p.in[3] + e);
    float4 a = s[0], c = s[1];
    size_t d = ((size_t)((l * 2 + b) * 256 + t)) * 512 + n;
    *(uint4*)(ws + OFF_KC + d * 2) = make_uint4(pack2(a.x, a.y), pack2(a.z, a.w), pack2(c.x, c.y), pack2(c.z, c.w));
    return;
  }
  item -= 128;
  {
    int idx = item * 512 + tid;
    int v = idx & 127, tc = (idx >> 7) & 31, h = (idx >> 12) & 3, b = (idx >> 14) & 1, l = idx >> 15;
    float vv[8];
#pragma unroll
    for (int j = 0; j < 8; ++j) vv[j] = p.in[4][((size_t)((b * 2 + l) * 256 + tc * 8 + j)) * 512 + h * 128 + v];
    size_t d = ((size_t)((b * 4 + h) * 128 + v)) * 2304 + 2048 + tc * 8;
    *(uint4*)(ws + OFF_VTL + l * SZ_VTL + d * 2) = make_uint4(pack2(vv[0], vv[1]), pack2(vv[2], vv[3]), pack2(vv[4], vv[5]), pack2(vv[6], vv[7]));
  }
}
constexpr int P0_ITEMS = 96 + 128 + 2048 + 32 + 8 + 128 + 128;

__device__ __forceinline__ void p1_item(const Params& p, int l, int item, char* lds) {
  const int tid = otid();
  char* ws = p.ws;
  if (item < 2816) {
    const float* src; int lsrc; u16* dst; int ldd; int kt, nt;
    const float* w10 = p.in[10]; const float* w17 = p.in[17]; const float* w18 = p.in[18]; const float* w19 = p.in[19]; const float* w20 = p.in[20];
    if (item < 2176) { src = w10 + (size_t)l * 1024 * 8704; lsrc = 8704; dst = (u16*)(ws + OFF_WIN); ldd = 1024; nt = item >> 4; kt = item & 15; }
    else if (item < 2560) { int r = item - 2176; int j = r >> 7; r &= 127; src = ((j == 0) ? w17 : ((j == 1) ? w18 : w19)) + (size_t)l * 512 * 1024; lsrc = 1024; dst = (u16*)(ws + OFF_WBR) + (size_t)j * 1024 * 512; ldd = 512; nt = r >> 3; kt = r & 7; }
    else { int r = item - 2560; src = w20 + (size_t)l * 1024 * 1024; lsrc = 1024; dst = (u16*)(ws + OFF_WO); ldd = 1024; nt = r >> 4; kt = r & 15; }
    u16* T = (u16*)lds;
    const int k0 = kt * 64, n0 = nt * 64;
#pragma unroll
    for (int ps = 0; ps < 2; ++ps) {
      int kr = (tid >> 4) + 32 * ps, nq = tid & 15;
      float4 v = *(const float4*)(src + (size_t)(k0 + kr) * lsrc + n0 + 4 * nq);
      T[(4 * nq + 0) * 72 + kr] = f2bf(v.x); T[(4 * nq + 1) * 72 + kr] = f2bf(v.y);
      T[(4 * nq + 2) * 72 + kr] = f2bf(v.z); T[(4 * nq + 3) * 72 + kr] = f2bf(v.w);
    }
    __syncthreads();
    {
      int n = tid >> 3, kc = tid & 7;
      uint4 o = *(const uint4*)(T + n * 72 + kc * 8);
      *(uint4*)(dst + (size_t)(n0 + n) * ldd + k0 + kc * 8) = o;
    }
    __syncthreads();
    return;
  }
  item -= 2816;
  const int lane = tid & 63, wid = tid >> 6;
  const float* modp = (const float*)(ws + OFF_MOD);
  u16* H = (u16*)(ws + OFF_H);
  const float* xin0 = p.in[0]; const float* xin1 = p.in[1]; const float* xin2 = p.out; const float* ng = p.in[9];
#pragma unroll
  for (int rr = 0; rr < 2; ++rr) {
    int r = item * 16 + wid * 2 + rr;
    const float* x = (l == 0) ? ((r < NCTX) ? xin0 + (size_t)r * 1024 : xin1 + (size_t)(r - NCTX) * 1024) : xin2 + (size_t)r * 1024;
    int ci = (r < NCTX) ? 0 : 1 + ((r - NCTX) >> 11);
    float4 v[4]; float ss = 0.f;
#pragma unroll
    for (int i = 0; i < 4; ++i) { v[i] = *(const float4*)(x + lane * 4 + 256 * i); ss += v[i].x * v[i].x + v[i].y * v[i].y + v[i].z * v[i].z + v[i].w * v[i].w; }
#pragma unroll
    for (int o = 32; o >= 1; o >>= 1) ss += __shfl_xor(ss, o);
    float rinv = rsqrtf(ss * (1.f / 1024.f) + EPSV);
    const float* sh = modp + (l * 3 + ci) * 3072;
#pragma unroll
    for (int i = 0; i < 4; ++i) {
      int col = lane * 4 + 256 * i;
      float4 g = *(const float4*)(ng + l * 1024 + col);
      float4 s1 = *(const float4*)(sh + 1024 + col);
      float4 s0 = *(const float4*)(sh + col);
      float a = v[i].x * rinv * g.x * (1.f + s1.x) + s0.x;
      float b = v[i].y * rinv * g.y * (1.f + s1.y) + s0.y;
      float c = v[i].z * rinv * g.z * (1.f + s1.z) + s0.z;
      float d = v[i].w * rinv * g.w * (1.f + s1.w) + s0.w;
      *(uint2*)(H + (size_t)r * 1024 + col) = make_uint2(pack2(a, b), pack2(c, d));
    }
  }
}
constexpr int P1_ITEMS = 2816 + 768;

__device__ __forceinline__ void stagger_us(int us) {
  const unsigned long long t0 = __builtin_amdgcn_s_memrealtime();
  while (__builtin_amdgcn_s_memrealtime() - t0 < (unsigned long long)us * 100ull) __builtin_amdgcn_s_sleep(8);
}
#define STAGGER_US 0
struct P2Sched {
  const char* H; const char* W; int G, c;
  __device__ __forceinline__ bool next(int i, Unit& u) const {
    const int L = i * G + c;
    if (L >= 1024) return false;
    if (L < 960) {
      const int nM = 48, nN = 20, nwg = 960;
      int wgid = L; { const int q = nwg / 8, xcd = wgid % 8, off = wgid / 8; wgid = xcd * q + off; }
      const int nig = 8 * nN, gid = wgid / nig, fm = gid * 8, gsz = (nM - fm) < 8 ? (nM - fm) : 8;
      int pm = fm + ((wgid % nig) % gsz), pn = (wgid % nig) / gsz;
      if (pn >= 14) pn += 2;
      u.a = H + (size_t)pm * 256 * 2048; u.b = W + (size_t)pn * 256 * 2048; u.x = pm; u.y = pn;
      u.lda = 1024; u.ldb = 1024; u.nt = 16; u.perm = ((pn >> 1) == 5 || (pn >> 1) == 6) ? 0 : 1;
    } else {
      const int r = L - 960; const int vq = r / 48, mt = r % 48;
      u.a = W + (size_t)(3584 + vq * 256) * 2048; u.b = H + (size_t)mt * 256 * 2048; u.x = vq; u.y = mt | 0x100;
      u.lda = 1024; u.ldb = 1024; u.nt = 16; u.perm = 0;
    }
    return true;
  }
};
struct P2Epi {
  const float* const* pin; float* out; char* ws; int l;
  const float* hlb; const float* qng; const float* kng; bool skip;
  __device__ __forceinline__ void operator()(f32x4 (&acc)[2][2][4][2], const Unit& u, int wr, int wc, int fr, int fq, LAS unsigned char* lds) const {
    if (skip) return;
    { const int t_ = otid(); const int w_ = t_ >> 6; wr = w_ >> 2; wc = w_ & 3; fr = t_ & 15; fq = (t_ & 63) >> 4; }
    if (u.y & 0x100) {
      const int mt = u.y & 0xff, vq = u.x;
#pragma unroll
      for (int ai = 0; ai < 2; ++ai)
#pragma unroll
        for (int m = 0; m < 4; ++m) {
          const int nn = vq * 256 + ai * 128 + wr * 64 + m * 16 + fr;
          const int hh = nn >> 7, v = nn & 127;
#pragma unroll
          for (int bj = 0; bj < 2; ++bj)
#pragma unroll
            for (int n = 0; n < 2; ++n) {
              const int tokl = bj * 128 + wc * 32 + n * 16 + 4 * fq;
              f32x4 a4 = acc[ai][bj][m][n];
              uint2 pk = make_uint2(pack2(a4[0], a4[1]), pack2(a4[2], a4[3]));
              if (mt < 32) {
                *(uint2*)(ws + OFF_VTC + ((size_t)((mt * 4 + hh) * 128 + v) * 256 + tokl) * 2) = pk;
                float* o = out + OCV + ((size_t)((mt * 2 + l) * 256 + tokl)) * 512 + nn;
                o[0] = a4[0]; o[512] = a4[1]; o[1024] = a4[2]; o[1536] = a4[3];
              } else {
                int rp = (mt - 32) * 256 + tokl; int bb = rp >> 11, t = rp & 2047;
                *(uint2*)(ws + OFF_VTL + l * SZ_VTL + ((size_t)((bb * 4 + hh) * 128 + v) * 2304 + t) * 2) = pk;
              }
            }
        }
      return;
    }
    const int pm = u.x, pn = u.y, seg = pn >> 1, ncol0 = (pn & 1) * 256;
    const int dcol0 = ((seg < 7) ? seg : seg - 1) * 512 + ncol0;
    u16* proj = (u16*)(ws + OFF_PROJ);
    const bool lat = (pm >= 32);
    if (seg == 5 || seg == 6) {
      float* xch = (float*)(lds + G8_STAGE_BYTES);
#pragma unroll
      for (int ai = 0; ai < 2; ++ai)
#pragma unroll
        for (int m = 0; m < 4; ++m)
#pragma unroll
          for (int bj = 0; bj < 2; ++bj) {
            float ss = 0.f;
#pragma unroll
            for (int n = 0; n < 2; ++n)
#pragma unroll
              for (int e = 0; e < 4; ++e) { float bfv = bf2f(f2bf(acc[ai][bj][m][n][e])); ss += bfv * bfv; }
            ss += __shfl_xor(ss, 16); ss += __shfl_xor(ss, 32);
            if (fq == 0) xch[((ai * 128 + wr * 64 + m * 16 + fr) * 2 + bj) * 4 + wc] = ss;
          }
      asm volatile("s_waitcnt lgkmcnt(0)" ::: "memory");
      __builtin_amdgcn_s_barrier();
      asm volatile("" ::: "memory");
      const float* gsel = (seg == 5) ? qng : kng;
      float gv[2][4];
#pragma unroll
      for (int n = 0; n < 2; ++n)
#pragma unroll
        for (int e = 0; e < 4; ++e) gv[n][e] = gsel[l * 64 + 32 * (wc & 1) + 16 * n + 4 * fq + e];
#pragma unroll
      for (int ai = 0; ai < 2; ++ai)
#pragma unroll
        for (int m = 0; m < 4; ++m) {
          const int rl = ai * 128 + wr * 64 + m * 16 + fr;
          const int grow = pm * 256 + rl;
#pragma unroll
          for (int bj = 0; bj < 2; ++bj) {
            const float2 pr = *(const float2*)&xch[(rl * 2 + bj) * 4 + (wc & 2)];
            const float tot = pr.x + pr.y;
            const float rinv = rsqrtf(tot * (1.f / 64.f) + EPSV);
            float x[2][4];
#pragma unroll
            for (int n = 0; n < 2; ++n)
#pragma unroll
              for (int e = 0; e < 4; ++e) x[n][e] = bf2f(f2bf(acc[ai][bj][m][n][e])) * rinv * gv[n][e];
            const int colt = ncol0 + bj * 128 + wc * 32;
            if (seg == 6 && !lat) {
              float* o = out + OCK + ((size_t)((pm * 2 + l) * 256 + rl)) * 512 + colt + 4 * fq;
              *(float4*)o = make_float4(x[0][0], x[0][1], x[0][2], x[0][3]);
              *(float4*)(o + 16) = make_float4(x[1][0], x[1][1], x[1][2], x[1][3]);
            }
            if (lat) {
              const int t = (grow - NCTX) & 2047;
              const float2* rt = (const float2*)(ws + OFF_ROPE) + t * 32 + ((wc & 1) ? 16 : 0) + 4 * fq;
#pragma unroll
              for (int e = 0; e < 4; ++e) {
                float2 cs = rt[e];
                float x1 = x[0][e], x2 = x[1][e];
                x[0][e] = x1 * cs.x - x2 * cs.y;
                x[1][e] = x1 * cs.y + x2 * cs.x;
              }
            }
            if (seg == 5) {
#pragma unroll
              for (int n = 0; n < 2; ++n)
#pragma unroll
                for (int e = 0; e < 4; ++e) x[n][e] *= 0.125f;
            }
            u16* dp = proj + (size_t)grow * LDP + dcol0 + bj * 128 + wc * 32 + 4 * fq;
            *(uint2*)dp = make_uint2(pack2(x[0][0], x[0][1]), pack2(x[0][2], x[0][3]));
            *(uint2*)(dp + 16) = make_uint2(pack2(x[1][0], x[1][1]), pack2(x[1][2], x[1][3]));
          }
        }
      return;
    }
    const bool dosilu = (seg == 0 || seg == 4 || seg == 8 || seg == 10);
    const bool dolf = (seg == 1 || seg == 2);
    const int dir = (seg == 2) ? 1 : 0;
#define P2_STORE16(A0, A1) *(uint4*)(proj + (size_t)grow * LDP + dcol0 + bj * 128 + wc * 32 + 8 * fq) = make_uint4(pack2(A0[0], A0[1]), pack2(A0[2], A0[3]), pack2(A1[0], A1[1]), pack2(A1[2], A1[3]))
    if (dosilu) {
#pragma unroll
      for (int ai = 0; ai < 2; ++ai)
#pragma unroll
        for (int m = 0; m < 4; ++m) {
          const int grow = pm * 256 + ai * 128 + wr * 64 + m * 16 + fr;
#pragma unroll
          for (int bj = 0; bj < 2; ++bj) {
            f32x4 a0 = acc[ai][bj][m][0], a1 = acc[ai][bj][m][1];
#pragma unroll
            for (int e = 0; e < 4; ++e) { a0[e] = siluf(a0[e]); a1[e] = siluf(a1[e]); }
            P2_STORE16(a0, a1);
          }
        }
    } else if (dolf) {
#pragma unroll
      for (int bj = 0; bj < 2; ++bj) {
        float lbv[2][4];
#pragma unroll
        for (int n = 0; n < 2; ++n)
#pragma unroll
          for (int e = 0; e < 4; ++e) {
            int j = ncol0 + bj * 128 + wc * 32 + 8 * fq + 4 * n + e;
            lbv[n][e] = (l == 0) ? 0.f : sigmf(hlb[(1 * 2 + dir) * 512 + j] - hlb[(0 * 2 + dir) * 512 + j]);
          }
#pragma unroll
        for (int ai = 0; ai < 2; ++ai)
#pragma unroll
          for (int m = 0; m < 4; ++m) {
            const int grow = pm * 256 + ai * 128 + wr * 64 + m * 16 + fr;
            f32x4 a0 = acc[ai][bj][m][0], a1 = acc[ai][bj][m][1];
#pragma unroll
            for (int e = 0; e < 4; ++e) { a0[e] = logf_gate(a0[e], lbv[0][e]); a1[e] = logf_gate(a1[e], lbv[1][e]); }
            P2_STORE16(a0, a1);
          }
      }
    } else {
#pragma unroll
      for (int ai = 0; ai < 2; ++ai)
#pragma unroll
        for (int m = 0; m < 4; ++m) {
          const int grow = pm * 256 + ai * 128 + wr * 64 + m * 16 + fr;
#pragma unroll
          for (int bj = 0; bj < 2; ++bj) {
            f32x4 a0 = acc[ai][bj][m][0], a1 = acc[ai][bj][m][1];
            P2_STORE16(a0, a1);
          }
        }
    }
  }
};
__device__ __forceinline__ void p2_left_item(const Params& p, int l, int L, char* lds) {
  P2Sched S0; S0.H = p.ws + OFF_H; S0.W = p.ws + OFF_WIN; S0.G = 0x40000000; S0.c = 0;
  OneUnit S;
  {
    const int r = L - 960; const int vq = r / 48, mt = r % 48;
    S.u.a = S0.W + (size_t)(3584 + vq * 256) * 2048; S.u.b = S0.H + (size_t)mt * 256 * 2048; S.u.x = vq; S.u.y = mt | 0x100;
    S.u.lda = 1024; S.u.ldb = 1024; S.u.nt = 16;
  }
  P2Epi E; E.pin = nullptr; E.out = p.out; E.ws = p.ws; E.l = l; E.hlb = p.in[11]; E.qng = p.in[13]; E.kng = p.in[14]; E.skip = false;
  gemm_phase((LAS unsigned char*)lds, S, E);
}
__device__ __forceinline__ void p2_phase(const Params& p, int l, char* lds, bool skip = false) {
  if (STAGGER_US && ((blockIdx.x >> 3) & 1)) stagger_us(STAGGER_US);
  P2Sched S; S.H = p.ws + OFF_H; S.W = p.ws + OFF_WIN; S.G = gridDim.x; S.c = blockIdx.x;
  P2Epi E; E.pin = nullptr; E.out = p.out; E.ws = p.ws; E.l = l; E.hlb = p.in[11]; E.qng = p.in[13]; E.kng = p.in[14]; E.skip = skip;
  gemm_phase((LAS unsigned char*)lds, S, E);
}

struct HgrnLds {
  float tot[4][128];
  float dk[128];
  float osum[16][132];
  u16 qt[16][136];
  u16 kt[16][136];
  u16 khT[128][16];
  u16 vT[128][16];
  u16 zt[16][136];
  u16 obuf[256][136];
};

#define LBAR() do { asm volatile("s_waitcnt lgkmcnt(0)" ::: "memory"); __builtin_amdgcn_s_barrier(); asm volatile("" ::: "memory"); } while (0)
__device__ __forceinline__ void hgrn_pass(const Params& p, int l, int row0, int ntok, int h, int dir, f32x4 (&S)[8],
                                          const bool do_out, const bool second, float& gsum, HgrnLds& L, const bool dry = false) {
  const int tid = otid(), lane = tid & 63, wid = tid >> 6, c16 = lane & 15, g = lane >> 4;
  const int kk = tid & 127, tq = tid >> 7;
  const u16* proj = (const u16*)(p.ws + OFF_PROJ);
  u16* projw = (u16*)(p.ws + OFF_PROJ);
  const int nch = ntok >> 4;
  float4 gg = make_float4(0.f, 0.f, 0.f, 0.f);
  if (second) gg = *(const float4*)(p.in[12] + l * 512 + h * 128 + 4 * (tid & 31));
  u16 lfA[4], qA[4], vA[4], zA[4], lfB[4], qB[4], vB[4], zB[4];
#define HG_LD(c_, LF, QQ, VV, ZZ)                                                    \
  {                                                                                  \
    _Pragma("unroll") for (int i = 0; i < 4; ++i) {                                  \
      int s_ = (c_) * 16 + 4 * tq + i;                                               \
      int tl_ = dir ? (ntok - 1 - s_) : s_;                                          \
      const u16* rp_ = proj + (size_t)(row0 + tl_) * LDP + h * 128 + kk;             \
      LF[i] = rp_[PLF + dir * 512];                                                  \
      VV[i] = rp_[PIA];                                                              \
      QQ[i] = do_out ? rp_[PQA] : (u16)0;                                            \
      ZZ[i] = second ? rp_[PZA] : (u16)0;                                            \
    }                                                                                \
  }
  HG_LD(0, lfA, qA, vA, zA);
  HG_LD(1, lfB, qB, vB, zB);
  auto body = [&](const int c, u16 (&LF)[4], u16 (&QQ)[4], u16 (&VV)[4], u16 (&ZZ)[4]) __attribute__((always_inline)) {
    float lf[4], G[4], qv[4];
    u16 vv[4], zz[4];
#pragma unroll
    for (int i = 0; i < 4; ++i) { lf[i] = bf2f(LF[i]); qv[i] = bf2f(QQ[i]); vv[i] = VV[i]; zz[i] = ZZ[i]; }
    G[0] = lf[0]; G[1] = G[0] + lf[1]; G[2] = G[1] + lf[2]; G[3] = G[2] + lf[3];
    L.tot[tq][kk] = G[3];
    LBAR();
    if (c + 2 < nch) HG_LD(c + 2, LF, QQ, VV, ZZ);
    float t0 = L.tot[0][kk], t1 = L.tot[1][kk], t2 = L.tot[2][kk], t3 = L.tot[3][kk];
    float off = (tq > 0 ? t0 : 0.f) + (tq > 1 ? t1 : 0.f) + (tq > 2 ? t2 : 0.f);
    float gend = t0 + t1 + t2 + t3;
    float kh[4];
#pragma unroll
    for (int i = 0; i < 4; ++i) {
      float Gi = G[i] + off;
      float kv = neg_expm1(lf[i]);
      int s = 4 * tq + i;
      if (do_out) {
        L.qt[s][kk] = f2bf(qv[i] * fexp(Gi));
        L.kt[s][kk] = f2bf(kv * fexp(fminf(-Gi, 80.f)));
      }
      if (second) L.zt[s][kk] = zz[i];
      kh[i] = kv * fexp(gend - Gi);
    }
    *(uint2*)&L.khT[kk][4 * tq] = make_uint2(pack2(kh[0], kh[1]), pack2(kh[2], kh[3]));
    *(uint2*)&L.vT[kk][4 * tq] = make_uint2((uint32_t)vv[0] | ((uint32_t)vv[1] << 16), (uint32_t)vv[2] | ((uint32_t)vv[3] << 16));
    if (tq == 0) { L.dk[kk] = fexp(gend); gsum += gend; }
    LBAR();
    Frag bv;
    bv.h[0] = *(const uint2*)&L.vT[16 * wid + c16][4 * g];
    bv.h[1] = make_uint2(0u, 0u);
    f32x4 o = f32x4{0.f, 0.f, 0.f, 0.f};
    if (do_out) {
      f32x4 at = f32x4{0.f, 0.f, 0.f, 0.f};
#pragma unroll
      for (int ks = 0; ks < 4; ++ks) {
        Frag a, b;
        a.q = *(const uint4*)&L.kt[c16][32 * ks + 8 * g];
        b.q = *(const uint4*)&L.qt[c16][32 * ks + 8 * g];
        at = MFMA(a.v, b.v, at);
      }
      Frag pa;
#pragma unroll
      for (int r = 0; r < 4; ++r) at[r] = (4 * g + r <= c16) ? at[r] : 0.f;
      pa.w[0] = pack2(at[0], at[1]); pa.w[1] = pack2(at[2], at[3]); pa.w[2] = 0u; pa.w[3] = 0u;
      o = MFMA(pa.v, bv.v, o);
#pragma unroll
      for (int st = 0; st < 4; ++st) {
        Frag a, b;
        a.h[0] = *(const uint2*)&L.qt[c16][32 * st + 4 * g];
        a.h[1] = *(const uint2*)&L.qt[c16][32 * st + 16 + 4 * g];
        b.w[0] = pack2(S[2 * st][0], S[2 * st][1]); b.w[1] = pack2(S[2 * st][2], S[2 * st][3]);
        b.w[2] = pack2(S[2 * st + 1][0], S[2 * st + 1][1]); b.w[3] = pack2(S[2 * st + 1][2], S[2 * st + 1][3]);
        o = MFMA(a.v, b.v, o);
      }
    }
#pragma unroll
    for (int k8 = 0; k8 < 8; ++k8) {
      float4 d = *(const float4*)&L.dk[16 * k8 + 4 * g];
      f32x4 s0 = S[k8];
      s0[0] *= d.x; s0[1] *= d.y; s0[2] *= d.z; s0[3] *= d.w;
      Frag a;
      a.h[0] = *(const uint2*)&L.khT[16 * k8 + c16][4 * g];
      a.h[1] = make_uint2(0u, 0u);
      S[k8] = MFMA(a.v, bv.v, s0);
    }
    if (do_out) {
      const int vcol = 16 * wid + c16;
      if (!second) {
#pragma unroll
        for (int r = 0; r < 4; ++r) {
          int s = c * 16 + 4 * g + r;
          int tl = dir ? (ntok - 1 - s) : s;
          L.obuf[tl][vcol] = f2bf(o[r]);
        }
      } else {
#pragma unroll
        for (int r = 0; r < 4; ++r) {
          int s = c * 16 + 4 * g + r;
          int tl = dir ? (ntok - 1 - s) : s;
          L.osum[4 * g + r][vcol] = o[r] + bf2f(L.obuf[tl][vcol]);
        }
        LBAR();
        {
          int sl = tid >> 5, vq = tid & 31;
          int s = c * 16 + sl;
          int tl = dir ? (ntok - 1 - s) : s;
          float4 ov = *(const float4*)&L.osum[sl][4 * vq];
          float ss = ov.x * ov.x + ov.y * ov.y + ov.z * ov.z + ov.w * ov.w;
#pragma unroll
          for (int m = 1; m <= 16; m <<= 1) ss += __shfl_xor(ss, m);
          float rinv = rsqrtf(ss * (1.f / 128.f) + EPSV);
          u16* rp = projw + (size_t)(row0 + tl) * LDP + h * 128 + 4 * vq;
          uint2 z = *(const uint2*)&L.zt[sl][4 * vq];
          float y0 = ov.x * rinv * gg.x * lo2f(z.x), y1 = ov.y * rinv * gg.y * hi2f(z.x);
          float y2 = ov.z * rinv * gg.z * lo2f(z.y), y3 = ov.w * rinv * gg.w * hi2f(z.y);
          if (!dry) *(uint2*)(rp + PQA) = make_uint2(pack2(y0, y1), pack2(y2, y3));
        }
      }
    }
  };
  for (int c = 0; c < nch; c += 2) {
    body(c, lfA, qA, vA, zA);
    body(c + 1, lfB, qB, vB, zB);
  }
  __syncthreads();
}

__device__ __forceinline__ void hgrn_load_state(const float* m, f32x4 (&S)[8]) {
  const int tid_ = otid(); const int lane = tid_ & 63, wid = tid_ >> 6, c16 = lane & 15, g = lane >> 4;
#pragma unroll
  for (int k8 = 0; k8 < 8; ++k8)
#pragma unroll
    for (int r = 0; r < 4; ++r) S[k8][r] = m[(16 * k8 + 4 * g + r) * 128 + 16 * wid + c16];
}
__device__ __forceinline__ void hgrn_store_state(float* m, const f32x4 (&S)[8]) {
  const int tid_ = otid(); const int lane = tid_ & 63, wid = tid_ >> 6, c16 = lane & 15, g = lane >> 4;
#pragma unroll
  for (int k8 = 0; k8 < 8; ++k8)
#pragma unroll
    for (int r = 0; r < 4; ++r) m[(16 * k8 + 4 * g + r) * 128 + 16 * wid + c16] = S[k8][r];
}
__device__ __forceinline__ void hgrn_advance(const float* U, const float* D, f32x4 (&S)[8]) {
  const int tid_ = otid(); const int lane = tid_ & 63, wid = tid_ >> 6, c16 = lane & 15, g = lane >> 4;
#pragma unroll
  for (int k8 = 0; k8 < 8; ++k8)
#pragma unroll
    for (int r = 0; r < 4; ++r) {
      int k = 16 * k8 + 4 * g + r;
      S[k8][r] = D[k] * S[k8][r] + U[k * 128 + 16 * wid + c16];
    }
}

__device__ __forceinline__ void hgrn_ctx_item(const Params& p, int l, int item, char* lds, const bool dry = false) {
  HgrnLds& L = *(HgrnLds*)lds;
  const int b = item >> 2, h = item & 3;
  f32x4 S[8];
  float gsum = 0.f;
#pragma unroll
  for (int i = 0; i < 8; ++i) S[i] = f32x4{0.f, 0.f, 0.f, 0.f};
  hgrn_pass(p, l, b * 256, 256, h, 0, S, true, false, gsum, L, dry);
  if (!dry) hgrn_store_state(p.out + OST + ((size_t)(((b * 2 + l) * 2 + 0) * 4 + h)) * 16384, S);
#pragma unroll
  for (int i = 0; i < 8; ++i) S[i] = f32x4{0.f, 0.f, 0.f, 0.f};
  hgrn_pass(p, l, b * 256, 256, h, 1, S, true, true, gsum, L, dry);
  if (!dry) hgrn_store_state(p.out + OST + ((size_t)(((b * 2 + l) * 2 + 1) * 4 + h)) * 16384, S);
}
__device__ __forceinline__ void hgrn_lat1_item(const Params& p, int l, int item, char* lds) {
  HgrnLds& L = *(HgrnLds*)lds;
  const int seg = item & 15, dir = (item >> 4) & 1, h = (item >> 5) & 3, b = item >> 7;
  f32x4 S[8];
  float gsum = 0.f;
#pragma unroll
  for (int i = 0; i < 8; ++i) S[i] = f32x4{0.f, 0.f, 0.f, 0.f};
  hgrn_pass(p, l, NCTX + b * 2048 + seg * 128, 128, h, dir, S, false, false, gsum, L);
  float* SU = (float*)(p.ws + OFF_SEGU);
  float* SD = (float*)(p.ws + OFF_SEGD);
  {
    const int tq_ = otid(); const int lane_ = tq_ & 63, wid_ = tq_ >> 6, c16_ = lane_ & 15, g_ = lane_ >> 4;
    float* m_ = SU + (size_t)item * 16384;
#pragma unroll
    for (int k8 = 0; k8 < 8; ++k8)
#pragma unroll
      for (int r = 0; r < 4; ++r) __hip_atomic_store(m_ + (16 * k8 + 4 * g_ + r) * 128 + 16 * wid_ + c16_, S[k8][r], __ATOMIC_RELAXED, __HIP_MEMORY_SCOPE_AGENT);
  }
  const int t_ = otid();
  if (t_ < 128) __hip_atomic_store(SD + item * 128 + t_, fexp(gsum), __ATOMIC_RELAXED, __HIP_MEMORY_SCOPE_AGENT);
  volatile int* flag = (volatile int*)(lds + LDS_TILE + 32);
  asm volatile("s_waitcnt vmcnt(0)" ::: "memory");
  __syncthreads();
  if (t_ == 0) {
    unsigned* tk = (unsigned*)(p.ws + OFF_CNT) + 8 + l * 32 + (item >> 4);
    const unsigned old = __hip_atomic_fetch_add(tk, 1u, __ATOMIC_RELAXED, __HIP_MEMORY_SCOPE_AGENT);
    const int last = (old == 15u) ? 1 : 0;
    if (last) { __builtin_amdgcn_fence(__ATOMIC_ACQUIRE, "agent"); asm volatile("s_waitcnt vmcnt(0)" ::: "memory"); }
    *flag = last;
  }
  __syncthreads();
  if (*flag) {
    const int base = (item >> 4) * 16;
    hgrn_load_state(p.in[5] + ((size_t)(((b * 2 + l) * 2 + dir) * 4 + h)) * 16384, S);
    const int lane = t_ & 63, wid = t_ >> 6, c16 = lane & 15, g = lane >> 4;
    float un[8][4]; float4 dn[8];
    {
      const int sg0 = dir ? 15 : 0;
      const float* U0 = SU + (size_t)(base + sg0) * 16384; const float* D0 = SD + (base + sg0) * 128;
#pragma unroll
      for (int k8 = 0; k8 < 8; ++k8) {
        dn[k8] = *(const float4*)(D0 + 16 * k8 + 4 * g);
#pragma unroll
        for (int r = 0; r < 4; ++r) un[k8][r] = U0[(16 * k8 + 4 * g + r) * 128 + 16 * wid + c16];
      }
    }
#pragma unroll 1
    for (int i = 0; i < 16; ++i) {
      const int sg = dir ? (15 - i) : i;
      float* U = SU + (size_t)(base + sg) * 16384;
      float uc[8][4]; float4 dc[8];
#pragma unroll
      for (int k8 = 0; k8 < 8; ++k8) { dc[k8] = dn[k8];
#pragma unroll
        for (int r = 0; r < 4; ++r) uc[k8][r] = un[k8][r]; }
      if (i + 1 < 16) {
        const int sgn = dir ? (14 - i) : (i + 1);
        const float* Un = SU + (size_t)(base + sgn) * 16384; const float* Dn = SD + (base + sgn) * 128;
#pragma unroll
        for (int k8 = 0; k8 < 8; ++k8) {
          dn[k8] = *(const float4*)(Dn + 16 * k8 + 4 * g);
#pragma unroll
          for (int r = 0; r < 4; ++r) un[k8][r] = Un[(16 * k8 + 4 * g + r) * 128 + 16 * wid + c16];
        }
      }
#pragma unroll
      for (int k8 = 0; k8 < 8; ++k8) {
        const float dd[4] = {dc[k8].x, dc[k8].y, dc[k8].z, dc[k8].w};
#pragma unroll
        for (int r = 0; r < 4; ++r) {
          const int idx = (16 * k8 + 4 * g + r) * 128 + 16 * wid + c16;
          U[idx] = S[k8][r];
          S[k8][r] = dd[r] * S[k8][r] + uc[k8][r];
        }
      }
    }
  }
  __syncthreads();
}
__device__ __forceinline__ void hgrn_lat2_item(const Params& p, int l, int item, char* lds, const bool dry = false) {
  HgrnLds& L = *(HgrnLds*)lds;
  const int seg = item & 15, h = (item >> 4) & 3, b = item >> 6;
  const float* SU = (const float*)(p.ws + OFF_SEGU);
  const float* SD = (const float*)(p.ws + OFF_SEGD);
  f32x4 S[8];
  float gsum = 0.f;
  hgrn_load_state(SU + (size_t)(((b * 4 + h) * 2 + 0) * 16 + seg) * 16384, S);
  hgrn_pass(p, l, NCTX + b * 2048 + seg * 128, 128, h, 0, S, true, false, gsum, L, dry);
  hgrn_load_state(SU + (size_t)(((b * 4 + h) * 2 + 1) * 16 + seg) * 16384, S);
  hgrn_pass(p, l, NCTX + b * 2048 + seg * 128, 128, h, 1, S, true, true, gsum, L, dry);
}

__device__ __forceinline__ void attn_item(const Params& p, int l, int item, const bool lat, char* lds, const bool dry = false) {
  const int tid = otid(), lane = tid & 63, wid = tid >> 6, c16 = lane & 15, g = lane >> 4;
  char* ws = p.ws;
  u16* proj = (u16*)(ws + OFF_PROJ);
  int b, h, qb, nkeys, rowbase;
  const u16* Vt; int ldv;
  if (!lat) { qb = item & 1; h = (item >> 1) & 3; b = item >> 3; nkeys = 256; rowbase = b * 256; Vt = (const u16*)(ws + OFF_VTC) + (size_t)((b * 4 + h) * 128) * 256; ldv = 256; }
  else { qb = item & 15; h = (item >> 4) & 3; b = item >> 6; nkeys = 2304; rowbase = NCTX + b * 2048; Vt = (const u16*)(ws + OFF_VTL + l * SZ_VTL) + (size_t)((b * 4 + h) * 128) * 2304; ldv = 2304; }
  const u16* Kc = (const u16*)(ws + OFF_KC) + (size_t)((l * 2 + b) * 256) * 512 + h * 128;
  u16* Ks = (u16*)lds;
  u16* Vs = Ks + 64 * 136;
  float lam_init = 0.8f - 0.6f * expf(-0.3f * (float)l);
  float lam;
  {
    const float* lp = p.in[15] + l * 256;
    float a = lp[lane] * lp[64 + lane], c = lp[128 + lane] * lp[192 + lane];
#pragma unroll
    for (int o = 32; o >= 1; o >>= 1) { a += __shfl_xor(a, o); c += __shfl_xor(c, o); }
    lam = expf(a) - expf(c) + lam_init;
  }
  const int qrow = rowbase + qb * 128 + wid * 16 + c16;
  Frag qf[2][2];
#pragma unroll
  for (int m = 0; m < 2; ++m)
#pragma unroll
    for (int ks = 0; ks < 2; ++ks) qf[m][ks].q = *(const uint4*)(proj + (size_t)qrow * LDP + PQB + h * 128 + m * 64 + ks * 32 + g * 8);
  f32x4 O[2][8];
#pragma unroll
  for (int m = 0; m < 2; ++m)
#pragma unroll
    for (int v = 0; v < 8; ++v) O[m][v] = f32x4{0.f, 0.f, 0.f, 0.f};
  float mrun[2] = {-1e30f, -1e30f}, lsum[2] = {0.f, 0.f};
  uint4 kr0, kr1, vr0, vr1;
#define ATT_LD(kt_)                                                                                           \
  {                                                                                                           \
    const int key0 = (kt_) * 64;                                                                              \
    const bool fromproj = (!lat) || (key0 < 2048);                                                            \
    {                                                                                                         \
      int q = tid; int key = q >> 4, cc = q & 15;                                                             \
      const u16* src = fromproj ? proj + (size_t)(rowbase + key0 + key) * LDP + PKB + h * 128 + cc * 8        \
                                : Kc + (size_t)(key0 - 2048 + key) * 512 + cc * 8;                            \
      kr0 = *(const uint4*)src;                                                                               \
      int v = q >> 3, c8 = q & 7;                                                                             \
      vr0 = *(const uint4*)(Vt + (size_t)v * ldv + key0 + c8 * 8);                                            \
    }                                                                                                         \
    {                                                                                                         \
      int q = tid + 512; int key = q >> 4, cc = q & 15;                                                       \
      const u16* src = fromproj ? proj + (size_t)(rowbase + key0 + key) * LDP + PKB + h * 128 + cc * 8        \
                                : Kc + (size_t)(key0 - 2048 + key) * 512 + cc * 8;                            \
      kr1 = *(const uint4*)src;                                                                               \
      int v = q >> 3, c8 = q & 7;                                                                             \
      vr1 = *(const uint4*)(Vt + (size_t)v * ldv + key0 + c8 * 8);                                            \
    }                                                                                                         \
  }
#define ATT_ST()                                                                                              \
  {                                                                                                           \
    { int q = tid; int key = q >> 4, cc = q & 15; *(uint4*)(Ks + key * 136 + cc * 8) = kr0;                   \
      int v = q >> 3, c8 = q & 7; *(uint4*)(Vs + v * 72 + c8 * 8) = vr0; }                                    \
    { int q = tid + 512; int key = q >> 4, cc = q & 15; *(uint4*)(Ks + key * 136 + cc * 8) = kr1;             \
      int v = q >> 3, c8 = q & 7; *(uint4*)(Vs + v * 72 + c8 * 8) = vr1; }                                    \
  }
  const int nkt = nkeys >> 6;
  ATT_LD(0);
  for (int kt = 0; kt < nkt; ++kt) {
    LBAR();
    ATT_ST();
    LBAR();
    if (kt + 1 < nkt) ATT_LD(kt + 1);
    Frag pf[2][2];
#pragma unroll
    for (int m = 0; m < 2; ++m) {
      f32x4 s[4];
#pragma unroll
      for (int k4 = 0; k4 < 4; ++k4) {
        s[k4] = f32x4{0.f, 0.f, 0.f, 0.f};
#pragma unroll
        for (int ks = 0; ks < 2; ++ks) {
          Frag a;
          a.q = *(const uint4*)(Ks + (16 * k4 + c16) * 136 + m * 64 + ks * 32 + g * 8);
          s[k4] = MFMA(a.v, qf[m][ks].v, s[k4]);
        }
      }
      float mx = -1e30f;
#pragma unroll
      for (int k4 = 0; k4 < 4; ++k4)
#pragma unroll
        for (int r = 0; r < 4; ++r) mx = fmaxf(mx, s[k4][r]);
      mx = fmaxf(mx, __shfl_xor(mx, 16));
      mx = fmaxf(mx, __shfl_xor(mx, 32));
      float mnew = fmaxf(mrun[m], mx);
      float alpha = fexp(mrun[m] - mnew);
      mrun[m] = mnew;
      float ps = 0.f;
#pragma unroll
      for (int k4 = 0; k4 < 4; ++k4)
#pragma unroll
        for (int r = 0; r < 4; ++r) { s[k4][r] = fexp(s[k4][r] - mnew); ps += s[k4][r]; }
      lsum[m] = lsum[m] * alpha + ps;
#pragma unroll
      for (int v = 0; v < 8; ++v) { O[m][v][0] *= alpha; O[m][v][1] *= alpha; O[m][v][2] *= alpha; O[m][v][3] *= alpha; }
#pragma unroll
      for (int sp = 0; sp < 2; ++sp) {
        pf[m][sp].w[0] = pack2(s[2 * sp][0], s[2 * sp][1]); pf[m][sp].w[1] = pack2(s[2 * sp][2], s[2 * sp][3]);
        pf[m][sp].w[2] = pack2(s[2 * sp + 1][0], s[2 * sp + 1][1]); pf[m][sp].w[3] = pack2(s[2 * sp + 1][2], s[2 * sp + 1][3]);
      }
    }
#pragma unroll
    for (int v = 0; v < 8; ++v)
#pragma unroll
      for (int sp = 0; sp < 2; ++sp) {
        Frag a;
        a.h[0] = *(const uint2*)(Vs + (16 * v + c16) * 72 + 32 * sp + 4 * g);
        a.h[1] = *(const uint2*)(Vs + (16 * v + c16) * 72 + 32 * sp + 16 + 4 * g);
        O[0][v] = MFMA(a.v, pf[0][sp].v, O[0][v]);
        O[1][v] = MFMA(a.v, pf[1][sp].v, O[1][v]);
      }
  }
  float l0 = lsum[0], l1 = lsum[1];
  l0 += __shfl_xor(l0, 16); l0 += __shfl_xor(l0, 32);
  l1 += __shfl_xor(l1, 16); l1 += __shfl_xor(l1, 32);
  const float i0 = 1.f / l0, i1 = lam / l1;
  float ss = 0.f;
#pragma unroll
  for (int v = 0; v < 8; ++v)
#pragma unroll
    for (int r = 0; r < 4; ++r) { float o = O[0][v][r] * i0 - O[1][v][r] * i1; O[0][v][r] = o; ss += o * o; }
  ss += __shfl_xor(ss, 16); ss += __shfl_xor(ss, 32);
  const float rinv = rsqrtf(ss * (1.f / 128.f) + EPSV) * (1.f - lam_init);
  u16* rp = proj + (size_t)qrow * LDP + h * 128;
#pragma unroll
  for (int v = 0; v < 8; ++v) {
    int vc = 16 * v + 4 * g;
    float4 sg = *(const float4*)(p.in[16] + l * 128 + vc);
    uint2 z = *(const uint2*)(rp + PZB + vc);
    float y0 = O[0][v][0] * rinv * sg.x * lo2f(z.x), y1 = O[0][v][1] * rinv * sg.y * hi2f(z.x);
    float y2 = O[0][v][2] * rinv * sg.z * lo2f(z.y), y3 = O[0][v][3] * rinv * sg.w * hi2f(z.y);
    if (!dry) *(uint2*)(rp + PQB + vc) = make_uint2(pack2(y0, y1), pack2(y2, y3));
  }
  __syncthreads();
}

__device__ __forceinline__ void f1_item(const Params& p, int item, char* lds) {
  const int tid = otid(), lane = tid & 63, wid = tid >> 6, wr = wid >> 2, wc = wid & 3, fr = lane & 15, fq = lane >> 4;
  char* ws = p.ws;
  const int jh = item & 1, gq = (item >> 1) & 3, mt = item >> 3;
  f32x4 acc[4][4];
  gemm_kloop<128>((const u16*)(ws + OFF_B1) + jh * 128 * 128, 128, (const u16*)(ws + OFF_PROJ) + (size_t)(mt * 256) * LDP + PUC + gq * 128, LDP, 128, acc, lds);
#pragma unroll
  for (int a = 0; a < 4; ++a)
#pragma unroll
    for (int b = 0; b < 4; ++b) {
      int tokl = wc * 64 + a * 16 + 4 * fq;
      int jj = wr * 64 + b * 16 + fr;
      uint2 pk = make_uint2(pack2(acc[a][b][0], acc[a][b][1]), pack2(acc[a][b][2], acc[a][b][3]));
      if (mt < 32) {
        *(uint2*)(ws + OFF_PTC + ((size_t)((mt * 4 + gq) * 128 + jj) * 512 + jh * 256 + tokl) * 2) = pk;
      } else {
        int rp = (mt - 32) * 256 + tokl; int bb = rp >> 11, t = rp & 2047;
        *(uint2*)(ws + OFF_PTL + ((size_t)((bb * 4 + gq) * 128 + jj) * 4096 + jh * 2048 + t) * 2) = pk;
      }
    }
}

struct F2Epi {
  char* ws; float scl; int rowbase_mul;
  bool lat;
  __device__ __forceinline__ void operator()(f32x4 (&acc)[2][2][4][2], const Unit& u, int wr, int wc, int fr, int fq, LAS unsigned char* lds) const {
    u16* proj = (u16*)(ws + OFF_PROJ);
#pragma unroll
    for (int ai = 0; ai < 2; ++ai)
#pragma unroll
      for (int mh = 0; mh < 2; ++mh) {
        uint2 zv[2][2][2];
#pragma unroll
        for (int mm = 0; mm < 2; ++mm)
#pragma unroll
          for (int bj = 0; bj < 2; ++bj)
#pragma unroll
            for (int n = 0; n < 2; ++n) {
              const int tp = u.x * 256 + ai * 128 + wr * 64 + (mh * 2 + mm) * 16 + fr;
              const int nn = u.y * 256 + bj * 128 + wc * 32 + n * 16 + 4 * fq;
              const int bb = nn >> 9, col = nn & 511;
              const u16* rp = proj + (size_t)(lat ? (NCTX + bb * 2048 + tp) : (bb * 256 + tp)) * LDP;
              zv[mm][bj][n] = *(const uint2*)(rp + PZC + col);
            }
#pragma unroll
        for (int mm = 0; mm < 2; ++mm)
#pragma unroll
          for (int bj = 0; bj < 2; ++bj)
#pragma unroll
            for (int n = 0; n < 2; ++n) {
              const int m = mh * 2 + mm;
              const int tp = u.x * 256 + ai * 128 + wr * 64 + m * 16 + fr;
              const int nn = u.y * 256 + bj * 128 + wc * 32 + n * 16 + 4 * fq;
              const int bb = nn >> 9, col = nn & 511;
              u16* rp = proj + (size_t)(lat ? (NCTX + bb * 2048 + tp) : (bb * 256 + tp)) * LDP;
              const uint2 z = zv[mm][bj][n];
              f32x4 a4 = acc[ai][bj][m][n];
              *(uint2*)(rp + PUC + col) = make_uint2(pack2(a4[0] * scl * lo2f(z.x), a4[1] * scl * hi2f(z.x)),
                                                     pack2(a4[2] * scl * lo2f(z.y), a4[3] * scl * hi2f(z.y)));
            }
      }
  }
};
__device__ __forceinline__ void f2c_item(const Params& p, int item, char* lds) {
  OneUnit S; S.u.a = p.ws + OFF_DC; S.u.b = p.ws + OFF_PTC + (size_t)item * 256 * 1024; S.u.x = 0; S.u.y = item; S.u.lda = 512; S.u.ldb = 512; S.u.nt = 8;
  F2Epi E; E.ws = p.ws; E.scl = 0.005524271728019903f; E.lat = false; E.rowbase_mul = 0;
  gemm_phase((LAS unsigned char*)lds, S, E);
}
struct F2HalfEpi {
  uint2* part;
  __device__ __forceinline__ void operator()(f32x4 (&acc)[2][2][4][2], const Unit& u, int wr, int wc, int fr, int fq, LAS unsigned char* lds) const {
    const int tid = wr * 256 + wc * 64 + fq * 16 + fr;
#pragma unroll
    for (int ai = 0; ai < 2; ++ai)
#pragma unroll
      for (int bj = 0; bj < 2; ++bj)
#pragma unroll
        for (int m = 0; m < 4; ++m)
#pragma unroll
          for (int n = 0; n < 2; ++n) {
            f32x4 a4 = acc[ai][bj][m][n];
            __hip_atomic_store((unsigned long long*)(part + (((ai * 2 + bj) * 4 + m) * 2 + n) * 512 + tid), (unsigned long long)pack2(a4[0], a4[1]) | ((unsigned long long)pack2(a4[2], a4[3]) << 32), __ATOMIC_RELAXED, __HIP_MEMORY_SCOPE_AGENT);
          }
  }
};
__device__ __forceinline__ void f2l_item(const Params& p, int l, int item, char* lds) {
  char* ws = p.ws;
  const int tile = item >> 1, half = item & 1, mt = tile >> 2, nt = tile & 3;
  uint2* pbase = (uint2*)(ws + OFF_F2P);
  {
    OneUnit S; S.u.a = ws + OFF_DL + ((size_t)mt * 256 * 4096 + half * 2048) * 2; S.u.b = ws + OFF_PTL + ((size_t)nt * 256 * 4096 + half * 2048) * 2;
    S.u.x = mt; S.u.y = nt; S.u.lda = 4096; S.u.ldb = 4096; S.u.nt = 32;
    F2HalfEpi E; E.part = pbase + (size_t)(tile * 2 + half) * (32 * 512);
    gemm_phase((LAS unsigned char*)lds, S, E);
  }
  const int t_ = otid();
  volatile int* flag = (volatile int*)(lds + LDS_TILE + 32);
  asm volatile("s_waitcnt vmcnt(0)" ::: "memory");
  __syncthreads();
  if (t_ == 0) {
    unsigned* tk = (unsigned*)(ws + OFF_CNT) + 72 + l * 32 + tile;
    const unsigned old = __hip_atomic_fetch_add(tk, 1u, __ATOMIC_RELAXED, __HIP_MEMORY_SCOPE_AGENT);
    const int last = (old == 1u) ? 1 : 0;
    if (last) { __builtin_amdgcn_fence(__ATOMIC_ACQUIRE, "agent"); asm volatile("s_waitcnt vmcnt(0)" ::: "memory"); }
    *flag = last;
  }
  __syncthreads();
  if (*flag) {
    const int lane = t_ & 63, wid = t_ >> 6, wr = wid >> 2, wc = wid & 3, fr = lane & 15, fq = lane >> 4;
    const uint2* p0 = pbase + (size_t)(tile * 2 + 0) * (32 * 512);
    const uint2* p1 = pbase + (size_t)(tile * 2 + 1) * (32 * 512);
    u16* proj = (u16*)(ws + OFF_PROJ);
    const float scl = 1.f / 512.f;
#pragma unroll
    for (int ai = 0; ai < 2; ++ai)
#pragma unroll
      for (int mh = 0; mh < 2; ++mh) {
        uint2 zv[2][2][2], av[2][2][2], bv2[2][2][2];
#pragma unroll
        for (int mm = 0; mm < 2; ++mm)
#pragma unroll
          for (int bj = 0; bj < 2; ++bj)
#pragma unroll
            for (int n = 0; n < 2; ++n) {
              const int m = mh * 2 + mm;
              const int tp = mt * 256 + ai * 128 + wr * 64 + m * 16 + fr;
              const int nn = nt * 256 + bj * 128 + wc * 32 + n * 16 + 4 * fq;
              const int bb = nn >> 9, col = nn & 511;
              const u16* rp = proj + (size_t)(NCTX + bb * 2048 + tp) * LDP;
              zv[mm][bj][n] = *(const uint2*)(rp + PZC + col);
              const int idx = (((ai * 2 + bj) * 4 + m) * 2 + n) * 512 + t_;
              av[mm][bj][n] = p0[idx]; bv2[mm][bj][n] = p1[idx];
            }
#pragma unroll
        for (int mm = 0; mm < 2; ++mm)
#pragma unroll
          for (int bj = 0; bj < 2; ++bj)
#pragma unroll
            for (int n = 0; n < 2; ++n) {
              const int m = mh * 2 + mm;
              const int tp = mt * 256 + ai * 128 + wr * 64 + m * 16 + fr;
              const int nn = nt * 256 + bj * 128 + wc * 32 + n * 16 + 4 * fq;
              const int bb = nn >> 9, col = nn & 511;
              u16* rp = proj + (size_t)(NCTX + bb * 2048 + tp) * LDP;
              const uint2 z = zv[mm][bj][n], a = av[mm][bj][n], c = bv2[mm][bj][n];
              const float y0 = (lo2f(a.x) + lo2f(c.x)) * scl * lo2f(z.x), y1 = (hi2f(a.x) + hi2f(c.x)) * scl * hi2f(z.x);
              const float y2 = (lo2f(a.y) + lo2f(c.y)) * scl * lo2f(z.y), y3 = (hi2f(a.y) + hi2f(c.y)) * scl * hi2f(z.y);
              *(uint2*)(rp + PUC + col) = make_uint2(pack2(y0, y1), pack2(y2, y3));
            }
      }
  }
  __syncthreads();
}

__device__ __forceinline__ bool xcd_tile(int bid, int& pm, int& pn) {
  const int x = bid & 7, j = bid >> 3;
  if (j >= 24) return false;
  pm = 6 * x + (j >> 2); pn = j & 3;
  return true;
}
struct P5Sched {
  char* ws; int x, j;
  __device__ __forceinline__ bool next(int i, Unit& u) const {
    if (j < 24) {
      if (i >= 5) return false;
      const int pm = 6 * x + (j >> 2), pn = j & 3;
      const int jj = (i < 4) ? (i >> 1) : 2;
      if (i == 0 || i == 2) {
        u.a = ws + OFF_H + (size_t)pm * 256 * 2048; u.b = ws + OFF_WIN + (size_t)(5632 + jj * 1024 + pn * 256) * 2048;
        u.lda = 1024; u.ldb = 1024; u.nt = 16; u.x = pm; u.y = pn | (jj << 8);
      } else {
        const int yc = (jj == 0) ? PQA : ((jj == 1) ? PQB : PUC);
        u.a = ws + OFF_PROJ + ((size_t)pm * 256 * LDP + yc) * 2; u.b = ws + OFF_WBR + ((size_t)jj * 1024 * 512 + (size_t)pn * 256 * 512) * 2;
        u.lda = LDP; u.ldb = 512; u.nt = 8; u.x = pm; u.y = pn | (jj << 8) | ((i == 4) ? 0x2000 : 0x1000);
      }
      return true;
    }
    if (i >= 3) return false;
    const int tj = 3 * (j - 24) + i;
    const int pm = 6 * x + (tj >> 2), pn = tj & 3;
    u.a = ws + OFF_H + (size_t)pm * 256 * 2048; u.b = ws + OFF_WIN + (size_t)(5632 + 2 * 1024 + pn * 256) * 2048;
    u.lda = 1024; u.ldb = 1024; u.nt = 16; u.x = pm; u.y = pn | (2 << 8) | 0x3000;
    return true;
  }
};
struct P5Epi {
  char* ws; u16* mg; unsigned* flags; bool skip;
  __device__ __forceinline__ void operator()(f32x4 (&acc)[2][2][4][2], const Unit& u, int wr, int wc, int fr, int fq, LAS unsigned char* lds) const {
    if (skip) return;
    { const int t_ = otid(); const int w_ = t_ >> 6; wr = w_ >> 2; wc = w_ & 3; fr = t_ & 15; fq = (t_ & 63) >> 4; }
    const int tid = wr * 256 + wc * 64 + fq * 16 + fr;
    const int type = (u.y >> 12) & 3, j = (u.y >> 8) & 3, pn = u.y & 0xff, pm = u.x;
    const int tile = pm * 4 + pn;
    uint2* gs = (uint2*)(ws + OFF_SEGU) + (size_t)tile * (32 * 512);
    u16* g2p = (u16*)(ws + OFF_PROJ) + (size_t)pm * 256 * LDP + PLF + pn * 256;
    if (type == 0) {
#pragma unroll
      for (int ai = 0; ai < 2; ++ai)
#pragma unroll
        for (int bj = 0; bj < 2; ++bj)
#pragma unroll
          for (int m = 0; m < 4; ++m)
#pragma unroll
            for (int n = 0; n < 2; ++n) {
              f32x4 a4 = acc[ai][bj][m][n];
              gs[(((ai * 2 + bj) * 4 + m) * 2 + n) * 512 + tid] = make_uint2(pack2(sigmf(a4[0]), sigmf(a4[1])), pack2(sigmf(a4[2]), sigmf(a4[3])));
            }
      return;
    }
    if (type == 3) {
#pragma unroll
      for (int ai = 0; ai < 2; ++ai)
#pragma unroll
        for (int bj = 0; bj < 2; ++bj)
#pragma unroll
          for (int m = 0; m < 4; ++m)
#pragma unroll
            for (int n = 0; n < 2; ++n) {
              f32x4 a4 = acc[ai][bj][m][n];
              const int row = ai * 128 + wr * 64 + m * 16 + fr, col = bj * 128 + wc * 32 + n * 16 + 4 * fq;
              const unsigned long long v = (unsigned long long)pack2(sigmf(a4[0]), sigmf(a4[1])) | ((unsigned long long)pack2(sigmf(a4[2]), sigmf(a4[3])) << 32);
              __hip_atomic_store((unsigned long long*)(g2p + (size_t)row * LDP + col), v, __ATOMIC_RELAXED, __HIP_MEMORY_SCOPE_AGENT);
            }
      asm volatile("s_waitcnt vmcnt(0)" ::: "memory");
      if ((fq * 16 + fr) == 0) __hip_atomic_fetch_add(flags + tile, 1u, __ATOMIC_RELAXED, __HIP_MEMORY_SCOPE_AGENT);
      return;
    }
    if (type == 2) {
      if (tid == 0) {
        unsigned sp = 0;
        while (__hip_atomic_load(flags + tile, __ATOMIC_RELAXED, __HIP_MEMORY_SCOPE_AGENT) < 8u) { __builtin_amdgcn_s_sleep(2); if (++sp > (1u << 22)) break; }
        __builtin_amdgcn_fence(__ATOMIC_ACQUIRE, "agent");
        asm volatile("s_waitcnt vmcnt(0)" ::: "memory");
      }
      asm volatile("" ::: "memory");
      __builtin_amdgcn_s_barrier();
      asm volatile("" ::: "memory");
    }
#pragma unroll
    for (int ai = 0; ai < 2; ++ai)
#pragma unroll
      for (int mh = 0; mh < 2; ++mh) {
        uint2 gv[2][2][2], pv[2][2][2];
#pragma unroll
        for (int mm = 0; mm < 2; ++mm)
#pragma unroll
          for (int bj = 0; bj < 2; ++bj)
#pragma unroll
            for (int n = 0; n < 2; ++n) {
              const int m = mh * 2 + mm;
              const int rl = ai * 128 + wr * 64 + m * 16 + fr, cl = bj * 128 + wc * 32 + n * 16 + 4 * fq;
              const int row = pm * 256 + rl, col = pn * 256 + cl;
              const uint2* gptr = (type == 2) ? (const uint2*)(g2p + (size_t)rl * LDP + cl) : (const uint2*)(gs + (((ai * 2 + bj) * 4 + m) * 2 + n) * 512 + tid);
              gv[mm][bj][n] = *gptr;
              pv[mm][bj][n] = (j > 0) ? *(const uint2*)(mg + (size_t)row * 1024 + col) : make_uint2(0u, 0u);
            }
#pragma unroll
        for (int mm = 0; mm < 2; ++mm)
#pragma unroll
          for (int bj = 0; bj < 2; ++bj)
#pragma unroll
            for (int n = 0; n < 2; ++n) {
              const int m = mh * 2 + mm;
              const int row = pm * 256 + ai * 128 + wr * 64 + m * 16 + fr;
              const int col = pn * 256 + bj * 128 + wc * 32 + n * 16 + 4 * fq;
              f32x4 a4 = acc[ai][bj][m][n];
              const uint2 g2 = gv[mm][bj][n], p2 = pv[mm][bj][n];
              float t0 = lo2f(g2.x) * a4[0] + lo2f(p2.x), t1 = hi2f(g2.x) * a4[1] + hi2f(p2.x);
              float t2 = lo2f(g2.y) * a4[2] + lo2f(p2.y), t3 = hi2f(g2.y) * a4[3] + hi2f(p2.y);
              *(uint2*)(mg + (size_t)row * 1024 + col) = make_uint2(pack2(t0, t1), pack2(t2, t3));
            }
      }
  }
};
__device__ __forceinline__ void p5_phase(const Params& p, int l, char* lds, bool skip = false) {
  P5Sched S; S.ws = p.ws; S.x = blockIdx.x & 7; S.j = blockIdx.x >> 3;
  if (S.j >= 32) return;
  P5Epi E; E.ws = p.ws; E.mg = (u16*)(p.ws + OFF_MRG); E.flags = (unsigned*)(p.ws + OFF_CNT) + 136 + l * 192; E.skip = skip;
  gemm_phase((LAS unsigned char*)lds, S, E);
}

struct P6Epi {
  const float* xp0; const float* xs0; float* outp; const float* modp; int l;
  __device__ __forceinline__ void operator()(f32x4 (&acc)[2][2][4][2], const Unit& u, int wr, int wc, int fr, int fq, LAS unsigned char* lds) const {
    const int m0 = u.x * 256;
    const int ci = (m0 < NCTX) ? 0 : 1 + ((m0 - NCTX) >> 11);
    const float* xbase = (l == 0) ? ((m0 < NCTX) ? xp0 : xs0 - (size_t)NCTX * 1024) : outp;
    float4 gt[2][2];
#pragma unroll
    for (int bj = 0; bj < 2; ++bj)
#pragma unroll
      for (int n = 0; n < 2; ++n) gt[bj][n] = *(const float4*)(modp + (l * 3 + ci) * 3072 + 2048 + u.y * 256 + bj * 128 + wc * 32 + n * 16 + 4 * fq);
#pragma unroll
    for (int ai = 0; ai < 2; ++ai)
#pragma unroll
      for (int mh = 0; mh < 2; ++mh) {
        float4 xv[2][2][2];
#pragma unroll
        for (int mm = 0; mm < 2; ++mm)
#pragma unroll
          for (int bj = 0; bj < 2; ++bj)
#pragma unroll
            for (int n = 0; n < 2; ++n) {
              const int r = m0 + ai * 128 + wr * 64 + (mh * 2 + mm) * 16 + fr;
              const int col = u.y * 256 + bj * 128 + wc * 32 + n * 16 + 4 * fq;
              xv[mm][bj][n] = *(const float4*)(xbase + (size_t)r * 1024 + col);
            }
#pragma unroll
        for (int mm = 0; mm < 2; ++mm)
#pragma unroll
          for (int bj = 0; bj < 2; ++bj)
#pragma unroll
            for (int n = 0; n < 2; ++n) {
              const int m = mh * 2 + mm;
              const int r = m0 + ai * 128 + wr * 64 + m * 16 + fr;
              const int col = u.y * 256 + bj * 128 + wc * 32 + n * 16 + 4 * fq;
              f32x4 a4 = acc[ai][bj][m][n];
              const float4 x4 = xv[mm][bj][n], g4 = gt[bj][n];
              *(float4*)(outp + (size_t)r * 1024 + col) = make_float4(x4.x + g4.x * a4[0], x4.y + g4.y * a4[1], x4.z + g4.z * a4[2], x4.w + g4.w * a4[3]);
            }
      }
  }
};
__device__ __forceinline__ void p6_phase(const Params& p, int l, char* lds) {
  char* ws = p.ws;
  int pm, pn;
  if (!xcd_tile(blockIdx.x, pm, pn)) return;
  OneUnit S; S.u.a = ws + OFF_MRG + (size_t)pm * 256 * 2048; S.u.b = ws + OFF_WO + (size_t)pn * 256 * 2048; S.u.x = pm; S.u.y = pn;
  S.u.lda = 1024; S.u.ldb = 1024; S.u.nt = 16; S.reps = ((DUP_MASK & 512) && l == 0) ? 5 : 1;
  P6Epi E; E.xp0 = p.in[0]; E.xs0 = p.in[1]; E.outp = p.out; E.modp = (const float*)(ws + OFF_MOD); E.l = l;
  gemm_phase((LAS unsigned char*)lds, S, E);
}

#define XB_TMO      128
#define XB_XCNT(j)  (256  + 64 * (j))
#define XB_XSUB(j)  (1280 + 64 * (j))
#define XB_XGEN(j)  (2304 + 64 * (j))
#define XB_TOP      3328
#define XB_TOPGEN   3392
#define XCD_BAR_WORDS 3456
#define XB_SPIN_CAP (1u << 18)
struct XcdBarrier { unsigned* bar; unsigned x; volatile LAS unsigned* st; };
__device__ __forceinline__ unsigned xb_ld(unsigned* p) { return __hip_atomic_load(p, __ATOMIC_RELAXED, __HIP_MEMORY_SCOPE_AGENT); }
__device__ __forceinline__ unsigned xb_add(unsigned* p, unsigned v) { return __hip_atomic_fetch_add(p, v, __ATOMIC_RELAXED, __HIP_MEMORY_SCOPE_AGENT); }
__device__ __forceinline__ unsigned xb_xcc_id() { return (unsigned)__builtin_amdgcn_s_getreg((3 << 11) | 20) & 0xFu; }
#define XB_SPIN(cond, bar) do { unsigned _sp = 0; while (cond) { __builtin_amdgcn_s_sleep(1); \
    if ((++_sp & 255u) == 0u) { if (xb_ld(&(bar)[XB_TMO])) break; if (_sp > XB_SPIN_CAP) { atomicAdd(&(bar)[XB_TMO], 1u); break; } } } } while (0)
__device__ __forceinline__ XcdBarrier xcd_barrier_post(unsigned* bar, volatile LAS unsigned* st) {
  XcdBarrier b; b.bar = bar; b.x = xb_xcc_id(); b.st = st;
  if (threadIdx.x == 0) (void)xb_add(&bar[XB_XCNT(b.x)], 1u);
  return b;
}
__device__ __forceinline__ void xcd_barrier_complete(unsigned* bar, unsigned x, unsigned& nloc, unsigned& nx) {
  const unsigned G = gridDim.x * gridDim.y * gridDim.z;
  unsigned sum, cnt, mine, sp = 0u;
  for (;;) {
    sum = 0u; cnt = 0u; mine = 0u;
#pragma unroll
    for (unsigned j = 0; j < 16; ++j) { const unsigned c = xb_ld(&bar[XB_XCNT(j)]); sum += c; cnt += (c > 0u) ? 1u : 0u; mine = (j == x) ? c : mine; }
    if (sum == G) break;
    __builtin_amdgcn_s_sleep(1);
    if ((++sp & 255u) == 0u) { if (xb_ld(&bar[XB_TMO])) break; if (sp > XB_SPIN_CAP) { atomicAdd(&bar[XB_TMO], 1u); break; } }
  }
  nloc = mine > 0u ? mine : 1u; nx = cnt > 0u ? cnt : 1u;
}
__device__ __forceinline__ void xcd_barrier(const XcdBarrier& b) {
  asm volatile("s_waitcnt vmcnt(0)" ::: "memory");
  __syncthreads();
  if (threadIdx.x == 0) {
    unsigned* bar = b.bar;
    __builtin_amdgcn_s_waitcnt(0);
    unsigned nloc = b.st[0], nx = b.st[1];
    if (nloc == 0u) { xcd_barrier_complete(bar, b.x, nloc, nx); b.st[0] = nloc; b.st[1] = nx; }
    const unsigned old = xb_add(&bar[XB_XSUB(b.x)], 1u);
    const unsigned gen = old / nloc;
    if (old + 1u == (gen + 1u) * nloc) {
      __builtin_amdgcn_fence(__ATOMIC_RELEASE, "agent");
      asm volatile("s_waitcnt vmcnt(0)" ::: "memory");
      const unsigned og = xb_add(&bar[XB_TOP], 1u);
      const unsigned tg = og / nx;
      if (og + 1u == (tg + 1u) * nx) xb_add(&bar[XB_TOPGEN], 1u);
      else XB_SPIN(xb_ld(&bar[XB_TOPGEN]) == tg, bar);
      __builtin_amdgcn_fence(__ATOMIC_ACQUIRE, "agent");
      xb_add(&bar[XB_XGEN(b.x)], 1u);
      asm volatile("s_waitcnt vmcnt(0)" ::: "memory");
    } else {
      XB_SPIN(xb_ld(&bar[XB_XGEN(b.x)]) == gen, bar);
      __builtin_amdgcn_fence(__ATOMIC_ACQUIRE, "agent");
      asm volatile("s_waitcnt vmcnt(0)" ::: "memory");
    }
  }
  __syncthreads();
}

#define PARGS const float* a0, const float* a1, const float* a2, const float* a3, const float* a4, const float* a5, const float* a6, \
  const float* a7, const float* a8, const float* a9, const float* a10, const float* a11, const float* a12, const float* a13, \
  const float* a14, const float* a15, const float* a16, const float* a17, const float* a18, const float* a19, const float* a20, \
  float* aout, char* aws
#define PFILL Params p; p.in[0]=a0;p.in[1]=a1;p.in[2]=a2;p.in[3]=a3;p.in[4]=a4;p.in[5]=a5;p.in[6]=a6;p.in[7]=a7;p.in[8]=a8;p.in[9]=a9;p.in[10]=a10; \
  p.in[11]=a11;p.in[12]=a12;p.in[13]=a13;p.in[14]=a14;p.in[15]=a15;p.in[16]=a16;p.in[17]=a17;p.in[18]=a18;p.in[19]=a19;p.in[20]=a20;p.out=aout;p.ws=aws;
__global__ void __launch_bounds__(512) fwd_megakernel(PARGS) {
  PFILL
  extern __shared__ __attribute__((aligned(16))) char lds[];
  volatile int& s_item = *(volatile int*)(lds + LDS_TILE);
  cg::grid_group grid = cg::this_grid();
  const int bid = blockIdx.x, G = gridDim.x, tid = threadIdx.x;
  int* cnt = (int*)(p.ws + OFF_CNT);
  volatile LAS unsigned* bst = (volatile LAS unsigned*)(LAS unsigned char*)(lds + LDS_TILE + 16);
  if (tid < 2) bst[tid] = 0u;
  __syncthreads();
  const XcdBarrier xb = xcd_barrier_post((unsigned*)(p.ws + OFF_BAR), bst);
  for (int rep = 0; rep < ((DUP_MASK & 1) ? 2 : 1); ++rep) {
  {
    float2* tab = (float2*)lds;
    for (int m = tid; m < 2048; m += 512) { float sn, cs; sincospif((float)m * (1.f / 1024.f), &sn, &cs); tab[m] = make_float2(cs, sn); }
    __syncthreads();
    for (int it = 224 + bid; it < 224 + 2048; it += G) p0_item(p, it, lds);
    __syncthreads();
    for (int it = bid; it < P0_ITEMS; it += G) { if (it >= 224 && it < 224 + 2048) continue; p0_item(p, it, lds); }
  }
  if (((const volatile float*)p.in[15])[0] > 1e30f) grid.sync();
  xcd_barrier(xb);
  }
  for (int l = 0; l < 2; ++l) {
    for (int rep = 0; rep < ((DUP_MASK & 2) ? 2 : 1); ++rep) {
    for (int it = bid; it < P1_ITEMS; it += G) p1_item(p, l, it, lds);
    xcd_barrier(xb);
    }
    if (DUP_MASK & 1024) { const bool opq = (((const volatile float*)p.in[15])[0] < 1e30f); p2_phase(p, l, lds, opq); xcd_barrier(xb); }
    for (int rep = 0; rep < ((DUP_MASK & 4) ? 2 : 1); ++rep) {
    p2_phase(p, l, lds);
    xcd_barrier(xb);
    }
    for (;;) {
      __syncthreads();
      if (tid == 0) s_item = atomicAdd(&cnt[l * 2 + 0], 1);
      __syncthreads();
      int it = s_item;
      if (it >= 800) break;
      if (it < 128) hgrn_ctx_item(p, l, it, lds);
      else if (it < 384) hgrn_lat1_item(p, l, it - 128, lds);
      else if (it < 416) p2_left_item(p, l, 1024 + (it - 384), lds);
      else f1_item(p, it - 416, lds);
    }
    xcd_barrier(xb);
    for (;;) {
      __syncthreads();
      if (tid == 0) s_item = atomicAdd(&cnt[l * 2 + 1], 1);
      __syncthreads();
      int it = s_item;
      constexpr int D4a = (DUP_MASK & 32) ? 256 : 0, D4b = (DUP_MASK & 64) ? 256 : 0;
      if (it >= D4a + D4b + 640) break;
      if (it >= 640) { if (DUP_MASK & 32) attn_item(p, l, (it - 640) & 127, true, lds, true); else hgrn_lat2_item(p, l, (it - 640) & 127, lds, true); continue; }
      if (it < 128) attn_item(p, l, it, true, lds);
      else if (it < 192) f2l_item(p, l, it - 128, lds);
      else if (it < 320) hgrn_lat2_item(p, l, it - 192, lds);
      else if (it < 384) f2c_item(p, it - 320, lds);
      else attn_item(p, l, it - 384, false, lds);
    }
    xcd_barrier(xb);
    if (DUP_MASK & 2048) { const bool opq = (((const volatile float*)p.in[15])[0] < 1e30f); p5_phase(p, l, lds, opq); xcd_barrier(xb); }
    for (int rep = 0; rep < ((DUP_MASK & 8) ? 2 : 1); ++rep) {
    p5_phase(p, l, lds);
    xcd_barrier(xb);
    }
    for (int rep = 0; rep < (((DUP_MASK & 256) && l == 0) ? 5 : 1); ++rep) {
    p6_phase(p, l, lds);
    if (l == 0) xcd_barrier(xb);
    }
  }
}

extern "C" void kernel_launch(void* const* d_in, const int* in_sizes, int n_in,
                              void* d_out, int out_size, void* d_ws, size_t ws_size,
                              hipStream_t stream) {
  static int grid_blocks = 0;
  if (!grid_blocks) {
    int dev = 0, cus = 0;
    (void)hipGetDevice(&dev);
    (void)hipDeviceGetAttribute(&cus, hipDeviceAttributeMultiprocessorCount, dev);
    if (hipFuncSetAttribute((const void*)fwd_megakernel, hipFuncAttributeMaxDynamicSharedMemorySize, LDS_BYTES) != hipSuccess)
      fprintf(stderr, "hipFuncSetAttribute failed\n");
    grid_blocks = cus > 0 ? cus : 256;
    if (ws_size < WS_END) fprintf(stderr, "workspace too small: %zu < %zu\n", ws_size, (size_t)WS_END);
  }
  const void* ins[21];
  for (int i = 0; i < 21; ++i) ins[i] = d_in[i];
  void* outp = d_out; void* wsp = d_ws;
  void* args[23];
  for (int i = 0; i < 21; ++i) args[i] = (void*)&ins[i];
  args[21] = (void*)&outp; args[22] = (void*)&wsp;
  (void)hipMemsetAsync((char*)d_ws + OFF_CNT, 0, 4096 + 3456 * 4, stream);
  hipError_t e = hipLaunchCooperativeKernel((void*)fwd_megakernel, dim3(grid_blocks), dim3(512), args, LDS_BYTES, stream);
  if (e != hipSuccess) fprintf(stderr, "cooperative launch failed: %s (grid %d)\n", hipGetErrorString(e), grid_blocks);
}
```

```cpp
#include <hip/hip_runtime.h>
#include <hip/hip_cooperative_groups.h>
#include <stdint.h>
#include <cstdio>
namespace cg = cooperative_groups;

typedef unsigned short u16;
using bf16x8 = __attribute__((ext_vector_type(8))) short;
using f32x4 = __attribute__((ext_vector_type(4))) float;
#define MFMA(a, b, c) __builtin_amdgcn_mfma_f32_16x16x32_bf16(a, b, c, 0, 0, 0)

constexpr int NTOK = 12288;
constexpr int NCTX = 8192;
constexpr int LDP = 5120;
constexpr int PQA = 0, PLF = 512, PIA = 1536, PZA = 2048, PQB = 2560, PKB = 3072, PZB = 3584, PUC = 4096, PZC = 4608;
constexpr float EPSV = 1e-6f;
constexpr size_t OCK = 12582912, OCV = 20971520, OST = 29360128;

constexpr size_t OFF_WIN = 0;
constexpr size_t OFF_WBR = OFF_WIN + 8704ull * 1024 * 2;
constexpr size_t OFF_WO = OFF_WBR + 3ull * 1024 * 512 * 2;
constexpr size_t OFF_H = OFF_WO + 1024ull * 1024 * 2;
constexpr size_t OFF_PROJ = OFF_H + 12288ull * 1024 * 2;
constexpr size_t OFF_R1 = OFF_PROJ + 12288ull * LDP * 2;
constexpr size_t OFF_PTC = OFF_R1;
constexpr size_t OFF_PTL = OFF_R1 + 16384ull * 512 * 2;
constexpr size_t OFF_MRG = OFF_R1;
constexpr size_t OFF_SEGU = OFF_R1 + 25165824ull;
constexpr size_t OFF_SEGD = OFF_SEGU + 256ull * 16384 * 4;
constexpr size_t OFF_VTC = OFF_SEGD + 256ull * 128 * 4;
constexpr size_t OFF_VTL = OFF_VTC + 32ull * 4 * 128 * 256 * 2;
constexpr size_t SZ_VTL = 2ull * 4 * 128 * 2304 * 2;
constexpr size_t OFF_KC = OFF_VTL + 2 * SZ_VTL;
constexpr size_t OFF_DL = OFF_KC + 2ull * 2 * 256 * 512 * 2;
constexpr size_t OFF_DC = OFF_DL + 2048ull * 4096 * 2;
constexpr size_t OFF_B1 = OFF_DC + 256ull * 512 * 2;
constexpr size_t OFF_ROPE = OFF_B1 + 256ull * 128 * 2;
constexpr size_t OFF_MOD = OFF_ROPE + 2048ull * 32 * 8;
constexpr size_t OFF_CNT = OFF_MOD + 2ull * 3 * 3072 * 4;
constexpr size_t OFF_BAR = OFF_CNT + 4096;
constexpr size_t OFF_F2P = OFF_BAR + 3456 * 4 + 192;
constexpr size_t WS_END = OFF_F2P + 32ull * 2 * 32 * 512 * 8;

constexpr int LDS_TILE = 131072 + 8192;
#define DUP_MASK 0
constexpr int LDS_BYTES = LDS_TILE + 64;

struct Params {
  const float* in[21];
  float* out;
  char* ws;
};

typedef __bf16 bf16x2_t __attribute__((ext_vector_type(2)));
typedef float f32x2_t __attribute__((ext_vector_type(2)));
__device__ __forceinline__ uint32_t pack2(float a, float b) {
  f32x2_t v = {a, b};
  bf16x2_t r = __builtin_convertvector(v, bf16x2_t);
  return __builtin_bit_cast(uint32_t, r);
}
__device__ __forceinline__ u16 f2bf(float f) { return (u16)(pack2(f, 0.f) & 0xffffu); }
__device__ __forceinline__ float bf2f(u16 h) { return __uint_as_float(((uint32_t)h) << 16); }
__device__ __forceinline__ float lo2f(uint32_t u) { return __uint_as_float(u << 16); }
__device__ __forceinline__ float hi2f(uint32_t u) { return __uint_as_float(u & 0xffff0000u); }
__device__ __forceinline__ float fexp(float x) { return __builtin_amdgcn_exp2f(x * 1.4426950408889634f); }
__device__ __forceinline__ float frcp(float x) { return __builtin_amdgcn_rcpf(x); }
__device__ __forceinline__ float flog(float x) { return __builtin_amdgcn_logf(x) * 0.6931471805599453f; }
__device__ __forceinline__ float siluf(float x) { return x * frcp(1.f + fexp(-x)); }
__device__ __forceinline__ float sigmf(float x) { return frcp(1.f + fexp(-x)); }
__device__ __forceinline__ float logf_gate(float x, float lb) {
  float xc = fmaxf(x, -80.f);
  float e = fexp(-xc);
  float omf = (1.f - lb) * e * frcp(1.f + e);
  float lf = flog(1.f - omf);
  lf = (lb == 0.f && x < -15.f) ? x : lf;
  return lf;
}
__device__ __forceinline__ float neg_expm1(float lf) {
  return (lf > -0.02f) ? -lf * (1.f + lf * (0.5f + lf * 0.16666667f)) : 1.f - fexp(lf);
}
__device__ __forceinline__ int otid() { int t = threadIdx.x; asm volatile("" : "+v"(t)); return t; }

union Frag {
  bf16x8 v;
  uint4 q;
  uint2 h[2];
  uint32_t w[4];
};

__device__ __forceinline__ int lds_byte(int r, int c) {
  int st = (r >> 4) * 2 + (c >> 5), rr = r & 15, cc = c & 31, ob = rr * 64 + cc * 2;
  return st * 1024 + (ob ^ (((ob >> 9) & 1) << 5));
}

template <int TM>
__device__ __forceinline__ void gemm_kloop(const u16* __restrict__ X, int ldx, const u16* __restrict__ Y, int ldy,
                                           int K, f32x4 (&acc)[4][TM / 32], char* lds) {
  constexpr int NX = TM / 64;
  constexpr int XT = TM / 32;
  constexpr int STAGE = TM * 128 + 32768;
  const int tid = otid(), lane = tid & 63, wid = tid >> 6, wr = wid >> 2, wc = wid & 3, fr = lane & 15, fq = lane >> 4;
#pragma unroll
  for (int a = 0; a < 4; ++a)
#pragma unroll
    for (int b = 0; b < XT; ++b) acc[a][b] = f32x4{0.f, 0.f, 0.f, 0.f};
  uint4 xr[NX], yr[4];
  const int nk = K >> 6;
  const int lrow = tid >> 3, lc8 = (tid & 7) * 8;
  const u16* xg = X + (size_t)lrow * ldx + lc8;
  const u16* yg = Y + (size_t)lrow * ldy + lc8;
  const int loff = lds_byte(lrow, lc8);
#pragma unroll
  for (int i = 0; i < NX; ++i) xr[i] = *(const uint4*)(xg + (size_t)(64 * i) * ldx);
#pragma unroll
  for (int i = 0; i < 4; ++i) yr[i] = *(const uint4*)(yg + (size_t)(64 * i) * ldy);
#pragma unroll
  for (int i = 0; i < NX; ++i) *(uint4*)(lds + loff + 8192 * i) = xr[i];
#pragma unroll
  for (int i = 0; i < 4; ++i) *(uint4*)(lds + TM * 128 + loff + 8192 * i) = yr[i];
  __syncthreads();
  for (int kt = 0; kt < nk; ++kt) {
    char* cur = lds + (kt & 1) * STAGE;
    char* nxt = lds + ((kt + 1) & 1) * STAGE;
    const bool more = (kt + 1 < nk);
    if (more) {
#pragma unroll
      for (int i = 0; i < NX; ++i) xr[i] = *(const uint4*)(xg + (size_t)(64 * i) * ldx + (kt + 1) * 64);
#pragma unroll
      for (int i = 0; i < 4; ++i) yr[i] = *(const uint4*)(yg + (size_t)(64 * i) * ldy + (kt + 1) * 64);
    }
#pragma unroll
    for (int ks = 0; ks < 2; ++ks) {
      Frag yf[4], xf[XT];
#pragma unroll
      for (int a = 0; a < 4; ++a) yf[a].q = *(const uint4*)(cur + TM * 128 + lds_byte(wc * 64 + a * 16 + fr, ks * 32 + fq * 8));
#pragma unroll
      for (int b = 0; b < XT; ++b) xf[b].q = *(const uint4*)(cur + lds_byte(wr * (TM / 2) + b * 16 + fr, ks * 32 + fq * 8));
#pragma unroll
      for (int a = 0; a < 4; ++a)
#pragma unroll
        for (int b = 0; b < XT; ++b) acc[a][b] = MFMA(yf[a].v, xf[b].v, acc[a][b]);
    }
    if (more) {
#pragma unroll
      for (int i = 0; i < NX; ++i) *(uint4*)(nxt + loff + 8192 * i) = xr[i];
#pragma unroll
      for (int i = 0; i < 4; ++i) *(uint4*)(nxt + TM * 128 + loff + 8192 * i) = yr[i];
    }
    __syncthreads();
  }
}

#define LAS __attribute__((address_space(3)))
constexpr int HTB = 128 * 64 * 2;
constexpr int G8_STAGE_BYTES = 8 * HTB;
__device__ __forceinline__ void stage_rc(int b, int& R, int& C) {
  const int st = b / 1024, sb = b % 1024, swz = sb ^ (((sb >> 9) & 1) << 5);
  R = (st >> 1) * 16 + swz / 64; C = (st & 1) * 32 + (swz % 64) / 2;
}
struct Unit { const char* a; const char* b; int x; int y; int lda; int ldb; int nt; int perm = 0; };
struct OneUnit {
  Unit u; int reps = 1;
  __device__ __forceinline__ bool next(int i, Unit& o) const { if (i >= reps) return false; o = u; return true; }
};
template <class Epi, class Sched>
__device__ __forceinline__ void gemm_phase(LAS unsigned char* lds, const Sched& S, const Epi& E) {
  const int tid = otid(), wid = __builtin_amdgcn_readfirstlane(tid >> 6), lane = tid & 63, wr = wid >> 2, wc = wid & 3, fr = lane & 15, fq = lane >> 4;
  int sR[2], sC[2];
#pragma unroll
  for (int i = 0; i < 2; ++i) stage_rc(tid * 16 + i * 8192, sR[i], sC[i]);
  int sRp[2];
#pragma unroll
  for (int i = 0; i < 2; ++i) { const int rho = sR[i] & 31, n_ = rho >> 4, i_ = rho & 15; sRp[i] = (sR[i] & ~31) + 8 * (i_ >> 2) + 4 * n_ + (i_ & 3); }
  const size_t kstep = 128;
  const unsigned ldsw = (unsigned)wid * 1024u;
  const int aoff = lds_byte(wr * 64 + fr, fq * 8), boff = lds_byte(wc * 32 + fr, fq * 8);
#define G8_SA(b, h) (((b) * 2 + (h)) * HTB)
#define G8_SB(b, h) ((4 + (b) * 2 + (h)) * HTB)
#define G8_STAGE(bufoff, gbase, voff) do { _Pragma("unroll") for (int _i = 0; _i < 2; ++_i) \
    __builtin_amdgcn_global_load_lds((const unsigned*)((const char*)(gbase) + (voff)[_i]), (LAS unsigned*)(lds + (bufoff) + ldsw + _i * 8192), 16, 0, 0); } while (0)
#define G8_LDA(dst, b, h) do { _Pragma("unroll") for (int m = 0; m < 4; ++m) _Pragma("unroll") for (int k = 0; k < 2; ++k) dst[m][k] = *(const LAS bf16x8*)(lds + G8_SA(b, h) + aoff + m * 2048 + k * 1024); } while (0)
#define G8_LDB(dst, b, h) do { _Pragma("unroll") for (int n = 0; n < 2; ++n) _Pragma("unroll") for (int k = 0; k < 2; ++k) dst[n][k] = *(const LAS bf16x8*)(lds + G8_SB(b, h) + boff + n * 2048 + k * 1024); } while (0)
#define G8_MMA(ai, bj, At, Bt) do { __builtin_amdgcn_s_setprio(1); _Pragma("unroll") for (int m = 0; m < 4; ++m) _Pragma("unroll") for (int n = 0; n < 2; ++n) _Pragma("unroll") for (int k = 0; k < 2; ++k) \
    acc[ai][bj][m][n] = __builtin_amdgcn_mfma_f32_16x16x32_bf16(Bt[n][k], At[m][k], acc[ai][bj][m][n], 0, 0, 0); __builtin_amdgcn_s_setprio(0); } while (0)
#define G8_WAIT_V(n) asm volatile("s_waitcnt vmcnt(" #n ")" ::: "memory")
#define G8_WAIT_L(n) asm volatile("s_waitcnt lgkmcnt(" #n ")" ::: "memory")
#define G8_BAR __builtin_amdgcn_s_barrier()
#define G8_SCHED __builtin_amdgcn_sched_barrier(0)
  Unit cur, nxt; int ui = 0;
  if (!S.next(0, cur)) return;
  f32x4 acc[2][2][4][2];
#pragma unroll
  for (int a = 0; a < 2; ++a)
#pragma unroll
    for (int b = 0; b < 2; ++b)
#pragma unroll
      for (int m = 0; m < 4; ++m)
#pragma unroll
        for (int n = 0; n < 2; ++n) acc[a][b][m][n] = f32x4{0.f, 0.f, 0.f, 0.f};
  bf16x8 At[4][2], B0[2][2], B1[2][2];
  const char* cA = cur.a; const char* cB = cur.b;
  unsigned voffA[2], voffB[2];
#pragma unroll
  for (int i = 0; i < 2; ++i) { voffA[i] = (unsigned)(sR[i] * cur.lda + sC[i]) * 2u; voffB[i] = (unsigned)((cur.perm ? sRp[i] : sR[i]) * cur.ldb + sC[i]) * 2u; }
  size_t hstepA = (size_t)128 * cur.lda * 2, hstepB = (size_t)128 * cur.ldb * 2;
  G8_STAGE(G8_SB(0, 0), cB, voffB); G8_STAGE(G8_SA(0, 0), cA, voffA); G8_STAGE(G8_SB(0, 1), cB + hstepB, voffB); G8_STAGE(G8_SA(0, 1), cA + hstepA, voffA);
  if (wr == 1) G8_BAR;
  G8_WAIT_V(4); G8_BAR;
  G8_STAGE(G8_SB(1, 0), cB + kstep, voffB); G8_STAGE(G8_SA(1, 0), cA + kstep, voffA); G8_STAGE(G8_SB(1, 1), cB + hstepB + kstep, voffB);
  G8_WAIT_V(6); G8_BAR;
  for (;;) {
    const bool has_next = S.next(ui + 1, nxt);
    if (!has_next) nxt = cur;
    const char* nA = nxt.a; const char* nB = nxt.b;
    unsigned voffAn[2], voffBn[2];
#pragma unroll
    for (int i = 0; i < 2; ++i) { voffAn[i] = (unsigned)(sR[i] * nxt.lda + sC[i]) * 2u; voffBn[i] = (unsigned)((nxt.perm ? sRp[i] : sR[i]) * nxt.ldb + sC[i]) * 2u; }
    const size_t hstepAn = (size_t)128 * nxt.lda * 2, hstepBn = (size_t)128 * nxt.ldb * 2;
    const int nt = cur.nt;
    for (int t = 0; t < nt; t += 2) {
      const bool last = (t == nt - 2);
      const char* a1 = cA + (size_t)(t + 1) * kstep;
      const char* a2 = last ? nA : cA + (size_t)(t + 2) * kstep; const char* b2 = last ? nB : cB + (size_t)(t + 2) * kstep;
      const char* a3 = a2 + kstep; const char* b3 = b2 + kstep;
      unsigned vA2[2], vB2[2];
#pragma unroll
      for (int i = 0; i < 2; ++i) { vA2[i] = last ? voffAn[i] : voffA[i]; vB2[i] = last ? voffBn[i] : voffB[i]; }
      const size_t hA2 = last ? hstepAn : hstepA, hB2 = last ? hstepBn : hstepB;
      G8_LDB(B0, 0, 0); G8_SCHED; G8_LDA(At, 0, 0); G8_STAGE(G8_SA(1, 1), a1 + hstepA, voffA);
      G8_WAIT_L(8); G8_BAR; G8_WAIT_L(0); G8_MMA(0, 0, At, B0); G8_BAR; G8_SCHED;
      G8_LDB(B1, 0, 1); G8_STAGE(G8_SB(0, 0), b2, vB2);
      G8_BAR; G8_WAIT_L(0); G8_MMA(0, 1, At, B1); G8_BAR;
      G8_LDA(At, 0, 1); G8_STAGE(G8_SA(0, 0), a2, vA2);
      G8_BAR; G8_WAIT_L(0); G8_MMA(1, 0, At, B0); G8_BAR; G8_SCHED;
      G8_STAGE(G8_SB(0, 1), b2 + hB2, vB2);
      G8_WAIT_V(6); G8_BAR; G8_MMA(1, 1, At, B1); G8_BAR;
      G8_LDB(B0, 1, 0); G8_SCHED; G8_LDA(At, 1, 0); G8_STAGE(G8_SA(0, 1), a2 + hA2, vA2);
      G8_WAIT_L(8); G8_BAR; G8_WAIT_L(0); G8_MMA(0, 0, At, B0); G8_BAR; G8_SCHED;
      G8_LDB(B1, 1, 1); G8_STAGE(G8_SB(1, 0), b3, vB2);
      G8_BAR; G8_WAIT_L(0); G8_MMA(0, 1, At, B1); G8_BAR;
      G8_LDA(At, 1, 1); G8_STAGE(G8_SA(1, 0), a3, vA2);
      G8_BAR; G8_WAIT_L(0); G8_MMA(1, 0, At, B0); G8_BAR; G8_SCHED;
      G8_STAGE(G8_SB(1, 1), b3 + hB2, vB2);
      G8_WAIT_V(6); G8_BAR; G8_MMA(1, 1, At, B1); G8_BAR;
    }
    E(acc, cur, wr, wc, fr, fq, lds);
    if (!has_next) break;
#pragma unroll
    for (int a = 0; a < 2; ++a)
#pragma unroll
      for (int b = 0; b < 2; ++b)
#pragma unroll
        for (int m = 0; m < 4; ++m)
#pragma unroll
          for (int n = 0; n < 2; ++n) acc[a][b][m][n] = f32x4{0.f, 0.f, 0.f, 0.f};
    cur = nxt; cA = nA; cB = nB; ++ui;
#pragma unroll
    for (int i = 0; i < 2; ++i) { voffA[i] = voffAn[i]; voffB[i] = voffBn[i]; }
    hstepA = hstepAn; hstepB = hstepBn;
  }
  G8_WAIT_V(0);
  if (wr == 0) G8_BAR;
  G8_BAR;
}

__device__ __forceinline__ void p0_mod16(const Params& p, int item, char* lds) {
  const int tid = otid();
  float* sc = (float*)lds;
  float* red = sc + 3072;
  const int l = item / 192, cgp = item % 192;
  const float* cctx = p.in[6]; const float* cc2 = p.in[2];
  for (int i = tid; i < 3072; i += 512) {
    int j = i >> 10, k = i & 1023;
    float c = (j == 0) ? cctx[k] : cc2[(j > 0 ? j - 1 : 0) * 1024 + k];
    sc[i] = c / (1.f + expf(-c));
  }
  __syncthreads();
  const int col = tid & 15, kg = tid >> 4;
  const float* W = p.in[7] + (size_t)l * 1024 * 3072 + cgp * 16 + col;
  float a0 = 0.f, a1 = 0.f, a2 = 0.f;
#pragma unroll 8
  for (int k = kg * 32; k < kg * 32 + 32; ++k) {
    float w = W[(size_t)k * 3072];
    a0 += sc[k] * w; a1 += sc[1024 + k] * w; a2 += sc[2048 + k] * w;
  }
  red[(kg * 3 + 0) * 16 + col] = a0; red[(kg * 3 + 1) * 16 + col] = a1; red[(kg * 3 + 2) * 16 + col] = a2;
  __syncthreads();
  if (tid < 48) {
    const int j = tid >> 4; float s_ = 0.f;
    for (int g = 0; g < 32; ++g) s_ += red[(g * 3 + j) * 16 + col];
    const int n = cgp * 16 + col;
    ((float*)(p.ws + OFF_MOD))[(l * 3 + j) * 3072 + n] = s_ + p.in[8][l * 3072 + n];
  }
  __syncthreads();
}

__device__ __forceinline__ void p0_item(const Params& p, int item, char* lds) {
  const int tid = otid();
  char* ws = p.ws;
  if (item < 96) {
    float* sc = (float*)lds;
    float* red = sc + 3072;
    const int l = item / 48, cgp = item % 48;
    const float* cctx = p.in[6]; const float* cc2 = p.in[2];
    for (int i = tid; i < 3072; i += 512) {
      int j = i >> 10, k = i & 1023;
      float c = (j == 0) ? cctx[k] : cc2[(j > 0 ? j - 1 : 0) * 1024 + k];
      sc[i] = siluf(c);
    }
    __syncthreads();
    const int col = tid & 63, kg = tid >> 6;
    const float* W = p.in[7] + (size_t)l * 1024 * 3072 + cgp * 64 + col;
    float a0 = 0.f, a1 = 0.f, a2 = 0.f;
    for (int k = kg * 128; k < kg * 128 + 128; ++k) {
      float w = W[(size_t)k * 3072];
      a0 += sc[k] * w; a1 += sc[1024 + k] * w; a2 += sc[2048 + k] * w;
    }
    red[(kg * 3 + 0) * 64 + col] = a0; red[(kg * 3 + 1) * 64 + col] = a1; red[(kg * 3 + 2) * 64 + col] = a2;
    __syncthreads();
    if (tid < 192) {
      int j = tid >> 6; float s = 0.f;
      for (int g = 0; g < 8; ++g) s += red[(g * 3 + j) * 64 + col];
      int n = cgp * 64 + col;
      ((float*)(ws + OFF_MOD))[(l * 3 + j) * 3072 + n] = s + p.in[8][l * 3072 + n];
    }
    __syncthreads();
    return;
  }
  item -= 96;
  if (item < 128) {
    int idx = item * 512 + tid, t = idx >> 5, c = idx & 31, fi = c & 15;
    float pos = (c < 16) ? (float)(t >> 6) : (float)(t & 63);
    float inv = powf(10000.f, -(float)fi / 16.f);
    float ang = pos * inv;
    ((float2*)(ws + OFF_ROPE))[idx] = make_float2(cosf(ang), sinf(ang));
    return;
  }
  item -= 128;
  if (item < 2048) {
    const float2* tab = (const float2*)lds;
    int idx = item * 512 + tid, tp = idx >> 9, k0 = (idx & 511) * 8;
    uint32_t o[4];
    float vv[8];
#pragma unroll
    for (int j = 0; j < 8; ++j) {
      int k = k0 + j; int m = (tp * (k & 2047)) & 2047;
      float2 cs = tab[m];
      vv[j] = (k < 2048) ? cs.x : -cs.y;
    }
#pragma unroll
    for (int j = 0; j < 4; ++j) o[j] = pack2(vv[2 * j], vv[2 * j + 1]);
    *(uint4*)(ws + OFF_DL + (size_t)idx * 16) = make_uint4(o[0], o[1], o[2], o[3]);
    return;
  }
  item -= 2048;
  if (item < 32) {
    int idx = item * 512 + tid, tp = idx >> 6, k0 = (idx & 63) * 8;
    uint32_t o[4];
    float vv[8];
#pragma unroll
    for (int j = 0; j < 8; ++j) {
      int k = k0 + j; int m = (tp * (k & 255)) & 255; float s, c;
      sincospif((float)m * (1.f / 128.f), &s, &c);
      vv[j] = (k < 256) ? c : -s;
    }
#pragma unroll
    for (int j = 0; j < 4; ++j) o[j] = pack2(vv[2 * j], vv[2 * j + 1]);
    *(uint4*)(ws + OFF_DC + (size_t)idx * 16) = make_uint4(o[0], o[1], o[2], o[3]);
    return;
  }
  item -= 32;
  if (item < 8) {
    int idx = item * 512 + tid, j = idx >> 4, c0 = (idx & 15) * 8;
    uint32_t o[4];
    float vv[8];
#pragma unroll
    for (int q = 0; q < 8; ++q) {
      int m = ((j & 127) * (c0 + q)) & 127; float s, c;
      sincospif((float)m * (1.f / 64.f), &s, &c);
      vv[q] = (j < 128) ? c : s;
    }
#pragma unroll
    for (int q = 0; q < 4; ++q) o[q] = pack2(vv[2 * q], vv[2 * q + 1]);
    *(uint4*)(ws + OFF_B1 + (size_t)idx * 16) = make_uint4(o[0], o[1], o[2], o[3]);
    return;
  }
  item -= 8;
  if (item < 128) {
    int idx = item * 512 + tid; int e = idx * 8;
    int n = e & 511, t = (e >> 9) & 255, l = (e >> 17) & 1, b = e >> 18;
    const float4* s = (const float4*)(p.in[3] + e);
    float4 a = s[0], c = s[1];
    size_t d = ((size_t)((l * 2 + b) * 256 + t)) * 512 + n;
    *(uint4*)(ws + OFF_KC + d * 2) = make_uint4(pack2(a.x, a.y), pack2(a.z, a.w), pack2(c.x, c.y), pack2(c.z, c.w));
    return;
  }
  item -= 128;
  {
    int idx = item * 512 + tid;
    int v = idx & 127, tc = (idx >> 7) & 31, h = (idx >> 12) & 3, b = (idx >> 14) & 1, l = idx >> 15;
    float vv[8];
#pragma unroll
    for (int j = 0; j < 8; ++j) vv[j] = p.in[4][((size_t)((b * 2 + l) * 256 + tc * 8 + j)) * 512 + h * 128 + v];
    size_t d = ((size_t)((b * 4 + h) * 128 + v)) * 2304 + 2048 + tc * 8;
    *(uint4*)(ws + OFF_VTL + l * SZ_VTL + d * 2) = make_uint4(pack2(vv[0], vv[1]), pack2(vv[2], vv[3]), pack2(vv[4], vv[5]), pack2(vv[6], vv[7]));
  }
}
constexpr int P0_ITEMS = 96 + 128 + 2048 + 32 + 8 + 128 + 128;

__device__ __forceinline__ void p1_item(const Params& p, int l, int item, char* lds) {
  const int tid = otid();
  char* ws = p.ws;
  if (item < 2816) {
    const float* src; int lsrc; u16* dst; int ldd; int kt, nt;
    const float* w10 = p.in[10]; const float* w17 = p.in[17]; const float* w18 = p.in[18]; const float* w19 = p.in[19]; const float* w20 = p.in[20];
    if (item < 2176) { src = w10 + (size_t)l * 1024 * 8704; lsrc = 8704; dst = (u16*)(ws + OFF_WIN); ldd = 1024; nt = item >> 4; kt = item & 15; }
    else if (item < 2560) { int r = item - 2176; int j = r >> 7; r &= 127; src = ((j == 0) ? w17 : ((j == 1) ? w18 : w19)) + (size_t)l * 512 * 1024; lsrc = 1024; dst = (u16*)(ws + OFF_WBR) + (size_t)j * 1024 * 512; ldd = 512; nt = r >> 3; kt = r & 7; }
    else { int r = item - 2560; src = w20 + (size_t)l * 1024 * 1024; lsrc = 1024; dst = (u16*)(ws + OFF_WO); ldd = 1024; nt = r >> 4; kt = r & 15; }
    u16* T = (u16*)lds;
    const int k0 = kt * 64, n0 = nt * 64;
#pragma unroll
    for (int ps = 0; ps < 2; ++ps) {
      int kr = (tid >> 4) + 32 * ps, nq = tid & 15;
      float4 v = *(const float4*)(src + (size_t)(k0 + kr) * lsrc + n0 + 4 * nq);
      T[(4 * nq + 0) * 72 + kr] = f2bf(v.x); T[(4 * nq + 1) * 72 + kr] = f2bf(v.y);
      T[(4 * nq + 2) * 72 + kr] = f2bf(v.z); T[(4 * nq + 3) * 72 + kr] = f2bf(v.w);
    }
    __syncthreads();
    {
      int n = tid >> 3, kc = tid & 7;
      uint4 o = *(const uint4*)(T + n * 72 + kc * 8);
      *(uint4*)(dst + (size_t)(n0 + n) * ldd + k0 + kc * 8) = o;
    }
    __syncthreads();
    return;
  }
  item -= 2816;
  const int lane = tid & 63, wid = tid >> 6;
  const float* modp = (const float*)(ws + OFF_MOD);
  u16* H = (u16*)(ws + OFF_H);
  const float* xin0 = p.in[0]; const float* xin1 = p.in[1]; const float* xin2 = p.out; const float* ng = p.in[9];
#pragma unroll
  for (int rr = 0; rr < 2; ++rr) {
    int r = item * 16 + wid * 2 + rr;
    const float* x = (l == 0) ? ((r < NCTX) ? xin0 + (size_t)r * 1024 : xin1 + (size_t)(r - NCTX) * 1024) : xin2 + (size_t)r * 1024;
    int ci = (r < NCTX) ? 0 : 1 + ((r - NCTX) >> 11);
    float4 v[4]; float ss = 0.f;
#pragma unroll
    for (int i = 0; i < 4; ++i) { v[i] = *(const float4*)(x + lane * 4 + 256 * i); ss += v[i].x * v[i].x + v[i].y * v[i].y + v[i].z * v[i].z + v[i].w * v[i].w; }
#pragma unroll
    for (int o = 32; o >= 1; o >>= 1) ss += __shfl_xor(ss, o);
    float rinv = rsqrtf(ss * (1.f / 1024.f) + EPSV);
    const float* sh = modp + (l * 3 + ci) * 3072;
#pragma unroll
    for (int i = 0; i < 4; ++i) {
      int col = lane * 4 + 256 * i;
      float4 g = *(const float4*)(ng + l * 1024 + col);
      float4 s1 = *(const float4*)(sh + 1024 + col);
      float4 s0 = *(const float4*)(sh + col);
      float a = v[i].x * rinv * g.x * (1.f + s1.x) + s0.x;
      float b = v[i].y * rinv * g.y * (1.f + s1.y) + s0.y;
      float c = v[i].z * rinv * g.z * (1.f + s1.z) + s0.z;
      float d = v[i].w * rinv * g.w * (1.f + s1.w) + s0.w;
      *(uint2*)(H + (size_t)r * 1024 + col) = make_uint2(pack2(a, b), pack2(c, d));
    }
  }
}
constexpr int P1_ITEMS = 2816 + 768;

__device__ __forceinline__ void stagger_us(int us) {
  const unsigned long long t0 = __builtin_amdgcn_s_memrealtime();
  while (__builtin_amdgcn_s_memrealtime() - t0 < (unsigned long long)us * 100ull) __builtin_amdgcn_s_sleep(8);
}
#define STAGGER_US 0
struct P2Sched {
  const char* H; const char* W; int G, c;
  __device__ __forceinline__ bool next(int i, Unit& u) const {
    const int L = i * G + c;
    if (L >= 1024) return false;
    if (L < 960) {
      const int nM = 48, nN = 20, nwg = 960;
      int wgid = L; { const int q = nwg / 8, xcd = wgid % 8, off = wgid / 8; wgid = xcd * q + off; }
      const int nig = 8 * nN, gid = wgid / nig, fm = gid * 8, gsz = (nM - fm) < 8 ? (nM - fm) : 8;
      int pm = fm + ((wgid % nig) % gsz), pn = (wgid % nig) / gsz;
      if (pn >= 14) pn += 2;
      u.a = H + (size_t)pm * 256 * 2048; u.b = W + (size_t)pn * 256 * 2048; u.x = pm; u.y = pn;
      u.lda = 1024; u.ldb = 1024; u.nt = 16; u.perm = ((pn >> 1) == 5 || (pn >> 1) == 6) ? 0 : 1;
    } else {
      const int r = L - 960; const int vq = r / 48, mt = r % 48;
      u.a = W + (size_t)(3584 + vq * 256) * 2048; u.b = H + (size_t)mt * 256 * 2048; u.x = vq; u.y = mt | 0x100;
      u.lda = 1024; u.ldb = 1024; u.nt = 16; u.perm = 0;
    }
    return true;
  }
};
struct P2Epi {
  const float* const* pin; float* out; char* ws; int l;
  const float* hlb; const float* qng; const float* kng; bool skip;
  __device__ __forceinline__ void operator()(f32x4 (&acc)[2][2][4][2], const Unit& u, int wr, int wc, int fr, int fq, LAS unsigned char* lds) const {
    if (skip) return;
    { const int t_ = otid(); const int w_ = t_ >> 6; wr = w_ >> 2; wc = w_ & 3; fr = t_ & 15; fq = (t_ & 63) >> 4; }
    if (u.y & 0x100) {
      const int mt = u.y & 0xff, vq = u.x;
#pragma unroll
      for (int ai = 0; ai < 2; ++ai)
#pragma unroll
        for (int m = 0; m < 4; ++m) {
          const int nn = vq * 256 + ai * 128 + wr * 64 + m * 16 + fr;
          const int hh = nn >> 7, v = nn & 127;
#pragma unroll
          for (int bj = 0; bj < 2; ++bj)
#pragma unroll
            for (int n = 0; n < 2; ++n) {
              const int tokl = bj * 128 + wc * 32 + n * 16 + 4 * fq;
              f32x4 a4 = acc[ai][bj][m][n];
              uint2 pk = make_uint2(pack2(a4[0], a4[1]), pack2(a4[2], a4[3]));
              if (mt < 32) {
                *(uint2*)(ws + OFF_VTC + ((size_t)((mt * 4 + hh) * 128 + v) * 256 + tokl) * 2) = pk;
                float* o = out + OCV + ((size_t)((mt * 2 + l) * 256 + tokl)) * 512 + nn;
                o[0] = a4[0]; o[512] = a4[1]; o[1024] = a4[2]; o[1536] = a4[3];
              } else {
                int rp = (mt - 32) * 256 + tokl; int bb = rp >> 11, t = rp & 2047;
                *(uint2*)(ws + OFF_VTL + l * SZ_VTL + ((size_t)((bb * 4 + hh) * 128 + v) * 2304 + t) * 2) = pk;
              }
            }
        }
      return;
    }
    const int pm = u.x, pn = u.y, seg = pn >> 1, ncol0 = (pn & 1) * 256;
    const int dcol0 = ((seg < 7) ? seg : seg - 1) * 512 + ncol0;
    u16* proj = (u16*)(ws + OFF_PROJ);
    const bool lat = (pm >= 32);
    if (seg == 5 || seg == 6) {
      float* xch = (float*)(lds + G8_STAGE_BYTES);
#pragma unroll
      for (int ai = 0; ai < 2; ++ai)
#pragma unroll
        for (int m = 0; m < 4; ++m)
#pragma unroll
          for (int bj = 0; bj < 2; ++bj) {
            float ss = 0.f;
#pragma unroll
            for (int n = 0; n < 2; ++n)
#pragma unroll
              for (int e = 0; e < 4; ++e) { float bfv = bf2f(f2bf(acc[ai][bj][m][n][e])); ss += bfv * bfv; }
            ss += __shfl_xor(ss, 16); ss += __shfl_xor(ss, 32);
            if (fq == 0) xch[((ai * 128 + wr * 64 + m * 16 + fr) * 2 + bj) * 4 + wc] = ss;
          }
      asm volatile("s_waitcnt lgkmcnt(0)" ::: "memory");
      __builtin_amdgcn_s_barrier();
      asm volatile("" ::: "memory");
      const float* gsel = (seg == 5) ? qng : kng;
      float gv[2][4];
#pragma unroll
      for (int n = 0; n < 2; ++n)
#pragma unroll
        for (int e = 0; e < 4; ++e) gv[n][e] = gsel[l * 64 + 32 * (wc & 1) + 16 * n + 4 * fq + e];
#pragma unroll
      for (int ai = 0; ai < 2; ++ai)
#pragma unroll
        for (int m = 0; m < 4; ++m) {
          const int rl = ai * 128 + wr * 64 + m * 16 + fr;
          const int grow = pm * 256 + rl;
#pragma unroll
          for (int bj = 0; bj < 2; ++bj) {
            const float2 pr = *(const float2*)&xch[(rl * 2 + bj) * 4 + (wc & 2)];
            const float tot = pr.x + pr.y;
            const float rinv = rsqrtf(tot * (1.f / 64.f) + EPSV);
            float x[2][4];
#pragma unroll
            for (int n = 0; n < 2; ++n)
#pragma unroll
              for (int e = 0; e < 4; ++e) x[n][e] = bf2f(f2bf(acc[ai][bj][m][n][e])) * rinv * gv[n][e];
            const int colt = ncol0 + bj * 128 + wc * 32;
            if (seg == 6 && !lat) {
              float* o = out + OCK + ((size_t)((pm * 2 + l) * 256 + rl)) * 512 + colt + 4 * fq;
              *(float4*)o = make_float4(x[0][0], x[0][1], x[0][2], x[0][3]);
              *(float4*)(o + 16) = make_float4(x[1][0], x[1][1], x[1][2], x[1][3]);
            }
            if (lat) {
              const int t = (grow - NCTX) & 2047;
              const float2* rt = (const float2*)(ws + OFF_ROPE) + t * 32 + ((wc & 1) ? 16 : 0) + 4 * fq;
#pragma unroll
              for (int e = 0; e < 4; ++e) {
                float2 cs = rt[e];
                float x1 = x[0][e], x2 = x[1][e];
                x[0][e] = x1 * cs.x - x2 * cs.y;
                x[1][e] = x1 * cs.y + x2 * cs.x;
              }
            }
            if (seg == 5) {
#pragma unroll
              for (int n = 0; n < 2; ++n)
#pragma unroll
                for (int e = 0; e < 4; ++e) x[n][e] *= 0.125f;
            }
            u16* dp = proj + (size_t)grow * LDP + dcol0 + bj * 128 + wc * 32 + 4 * fq;
            *(uint2*)dp = make_uint2(pack2(x[0][0], x[0][1]), pack2(x[0][2], x[0][3]));
            *(uint2*)(dp + 16) = make_uint2(pack2(x[1][0], x[1][1]), pack2(x[1][2], x[1][3]));
          }
        }
      return;
    }
    const bool dosilu = (seg == 0 || seg == 4 || seg == 8 || seg == 10);
    const bool dolf = (seg == 1 || seg == 2);
    const int dir = (seg == 2) ? 1 : 0;
#define P2_STORE16(A0, A1) *(uint4*)(proj + (size_t)grow * LDP + dcol0 + bj * 128 + wc * 32 + 8 * fq) = make_uint4(pack2(A0[0], A0[1]), pack2(A0[2], A0[3]), pack2(A1[0], A1[1]), pack2(A1[2], A1[3]))
    if (dosilu) {
#pragma unroll
      for (int ai = 0; ai < 2; ++ai)
#pragma unroll
        for (int m = 0; m < 4; ++m) {
          const int grow = pm * 256 + ai * 128 + wr * 64 + m * 16 + fr;
#pragma unroll
          for (int bj = 0; bj < 2; ++bj) {
            f32x4 a0 = acc[ai][bj][m][0], a1 = acc[ai][bj][m][1];
#pragma unroll
            for (int e = 0; e < 4; ++e) { a0[e] = siluf(a0[e]); a1[e] = siluf(a1[e]); }
            P2_STORE16(a0, a1);
          }
        }
    } else if (dolf) {
#pragma unroll
      for (int bj = 0; bj < 2; ++bj) {
        float lbv[2][4];
#pragma unroll
        for (int n = 0; n < 2; ++n)
#pragma unroll
          for (int e = 0; e < 4; ++e) {
            int j = ncol0 + bj * 128 + wc * 32 + 8 * fq + 4 * n + e;
            lbv[n][e] = (l == 0) ? 0.f : sigmf(hlb[(1 * 2 + dir) * 512 + j] - hlb[(0 * 2 + dir) * 512 + j]);
          }
#pragma unroll
        for (int ai = 0; ai < 2; ++ai)
#pragma unroll
          for (int m = 0; m < 4; ++m) {
            const int grow = pm * 256 + ai * 128 + wr * 64 + m * 16 + fr;
            f32x4 a0 = acc[ai][bj][m][0], a1 = acc[ai][bj][m][1];
#pragma unroll
            for (int e = 0; e < 4; ++e) { a0[e] = logf_gate(a0[e], lbv[0][e]); a1[e] = logf_gate(a1[e], lbv[1][e]); }
            P2_STORE16(a0, a1);
          }
      }
    } else {
#pragma unroll
      for (int ai = 0; ai < 2; ++ai)
#pragma unroll
        for (int m = 0; m < 4; ++m) {
          const int grow = pm * 256 + ai * 128 + wr * 64 + m * 16 + fr;
#pragma unroll
          for (int bj = 0; bj < 2; ++bj) {
            f32x4 a0 = acc[ai][bj][m][0], a1 = acc[ai][bj][m][1];
            P2_STORE16(a0, a1);
          }
        }
    }
  }
};
__device__ __forceinline__ void p2_left_item(const Params& p, int l, int L, char* lds) {
  P2Sched S0; S0.H = p.ws + OFF_H; S0.W = p.ws + OFF_WIN; S0.G = 0x40000000; S0.c = 0;
  OneUnit S;
  {
    const int r = L - 960; const int vq = r / 48, mt = r % 48;
    S.u.a = S0.W + (size_t)(3584 + vq * 256) * 2048; S.u.b = S0.H + (size_t)mt * 256 * 2048; S.u.x = vq; S.u.y = mt | 0x100;
    S.u.lda = 1024; S.u.ldb = 1024; S.u.nt = 16;
  }
  P2Epi E; E.pin = nullptr; E.out = p.out; E.ws = p.ws; E.l = l; E.hlb = p.in[11]; E.qng = p.in[13]; E.kng = p.in[14]; E.skip = false;
  gemm_phase((LAS unsigned char*)lds, S, E);
}
__device__ __forceinline__ void p2_phase(const Params& p, int l, char* lds, bool skip = false) {
  if (STAGGER_US && ((blockIdx.x >> 3) & 1)) stagger_us(STAGGER_US);
  P2Sched S; S.H = p.ws + OFF_H; S.W = p.ws + OFF_WIN; S.G = gridDim.x; S.c = blockIdx.x;
  P2Epi E; E.pin = nullptr; E.out = p.out; E.ws = p.ws; E.l = l; E.hlb = p.in[11]; E.qng = p.in[13]; E.kng = p.in[14]; E.skip = skip;
  gemm_phase((LAS unsigned char*)lds, S, E);
}

struct HgrnLds {
  float tot[4][128];
  float dk[128];
  float osum[16][132];
  u16 qt[16][136];
  u16 kt[16][136];
  u16 khT[128][16];
  u16 vT[128][16];
  u16 zt[16][136];
  u16 obuf[256][136];
};

#define LBAR() do { asm volatile("s_waitcnt lgkmcnt(0)" ::: "memory"); __builtin_amdgcn_s_barrier(); asm volatile("" ::: "memory"); } while (0)
__device__ __forceinline__ void hgrn_pass(const Params& p, int l, int row0, int ntok, int h, int dir, f32x4 (&S)[8],
                                          const bool do_out, const bool second, float& gsum, HgrnLds& L, const bool dry = false) {
  const int tid = otid(), lane = tid & 63, wid = tid >> 6, c16 = lane & 15, g = lane >> 4;
  const int kk = tid & 127, tq = tid >> 7;
  const u16* proj = (const u16*)(p.ws + OFF_PROJ);
  u16* projw = (u16*)(p.ws + OFF_PROJ);
  const int nch = ntok >> 4;
  float4 gg = make_float4(0.f, 0.f, 0.f, 0.f);
  if (second) gg = *(const float4*)(p.in[12] + l * 512 + h * 128 + 4 * (tid & 31));
  u16 lfA[4], qA[4], vA[4], zA[4], lfB[4], qB[4], vB[4], zB[4];
#define HG_LD(c_, LF, QQ, VV, ZZ)                                                    \
  {                                                                                  \
    _Pragma("unroll") for (int i = 0; i < 4; ++i) {                                  \
      int s_ = (c_) * 16 + 4 * tq + i;                                               \
      int tl_ = dir ? (ntok - 1 - s_) : s_;                                          \
      const u16* rp_ = proj + (size_t)(row0 + tl_) * LDP + h * 128 + kk;             \
      LF[i] = rp_[PLF + dir * 512];                                                  \
      VV[i] = rp_[PIA];                                                              \
      QQ[i] = do_out ? rp_[PQA] : (u16)0;                                            \
      ZZ[i] = second ? rp_[PZA] : (u16)0;                                            \
    }                                                                                \
  }
  HG_LD(0, lfA, qA, vA, zA);
  HG_LD(1, lfB, qB, vB, zB);
  auto body = [&](const int c, u16 (&LF)[4], u16 (&QQ)[4], u16 (&VV)[4], u16 (&ZZ)[4]) __attribute__((always_inline)) {
    float lf[4], G[4], qv[4];
    u16 vv[4], zz[4];
#pragma unroll
    for (int i = 0; i < 4; ++i) { lf[i] = bf2f(LF[i]); qv[i] = bf2f(QQ[i]); vv[i] = VV[i]; zz[i] = ZZ[i]; }
    G[0] = lf[0]; G[1] = G[0] + lf[1]; G[2] = G[1] + lf[2]; G[3] = G[2] + lf[3];
    L.tot[tq][kk] = G[3];
    LBAR();
    if (c + 2 < nch) HG_LD(c + 2, LF, QQ, VV, ZZ);
    float t0 = L.tot[0][kk], t1 = L.tot[1][kk], t2 = L.tot[2][kk], t3 = L.tot[3][kk];
    float off = (tq > 0 ? t0 : 0.f) + (tq > 1 ? t1 : 0.f) + (tq > 2 ? t2 : 0.f);
    float gend = t0 + t1 + t2 + t3;
    float kh[4];
#pragma unroll
    for (int i = 0; i < 4; ++i) {
      float Gi = G[i] + off;
      float kv = neg_expm1(lf[i]);
      int s = 4 * tq + i;
      if (do_out) {
        L.qt[s][kk] = f2bf(qv[i] * fexp(Gi));
        L.kt[s][kk] = f2bf(kv * fexp(fminf(-Gi, 80.f)));
      }
      if (second) L.zt[s][kk] = zz[i];
      kh[i] = kv * fexp(gend - Gi);
    }
    *(uint2*)&L.khT[kk][4 * tq] = make_uint2(pack2(kh[0], kh[1]), pack2(kh[2], kh[3]));
    *(uint2*)&L.vT[kk][4 * tq] = make_uint2((uint32_t)vv[0] | ((uint32_t)vv[1] << 16), (uint32_t)vv[2] | ((uint32_t)vv[3] << 16));
    if (tq == 0) { L.dk[kk] = fexp(gend); gsum += gend; }
    LBAR();
    Frag bv;
    bv.h[0] = *(const uint2*)&L.vT[16 * wid + c16][4 * g];
    bv.h[1] = make_uint2(0u, 0u);
    f32x4 o = f32x4{0.f, 0.f, 0.f, 0.f};
    if (do_out) {
      f32x4 at = f32x4{0.f, 0.f, 0.f, 0.f};
#pragma unroll
      for (int ks = 0; ks < 4; ++ks) {
        Frag a, b;
        a.q = *(const uint4*)&L.kt[c16][32 * ks + 8 * g];
        b.q = *(const uint4*)&L.qt[c16][32 * ks + 8 * g];
        at = MFMA(a.v, b.v, at);
      }
      Frag pa;
#pragma unroll
      for (int r = 0; r < 4; ++r) at[r] = (4 * g + r <= c16) ? at[r] : 0.f;
      pa.w[0] = pack2(at[0], at[1]); pa.w[1] = pack2(at[2], at[3]); pa.w[2] = 0u; pa.w[3] = 0u;
      o = MFMA(pa.v, bv.v, o);
#pragma unroll
      for (int st = 0; st < 4; ++st) {
        Frag a, b;
        a.h[0] = *(const uint2*)&L.qt[c16][32 * st + 4 * g];
        a.h[1] = *(const uint2*)&L.qt[c16][32 * st + 16 + 4 * g];
        b.w[0] = pack2(S[2 * st][0], S[2 * st][1]); b.w[1] = pack2(S[2 * st][2], S[2 * st][3]);
        b.w[2] = pack2(S[2 * st + 1][0], S[2 * st + 1][1]); b.w[3] = pack2(S[2 * st + 1][2], S[2 * st + 1][3]);
        o = MFMA(a.v, b.v, o);
      }
    }
#pragma unroll
    for (int k8 = 0; k8 < 8; ++k8) {
      float4 d = *(const float4*)&L.dk[16 * k8 + 4 * g];
      f32x4 s0 = S[k8];
      s0[0] *= d.x; s0[1] *= d.y; s0[2] *= d.z; s0[3] *= d.w;
      Frag a;
      a.h[0] = *(const uint2*)&L.khT[16 * k8 + c16][4 * g];
      a.h[1] = make_uint2(0u, 0u);
      S[k8] = MFMA(a.v, bv.v, s0);
    }
    if (do_out) {
      const int vcol = 16 * wid + c16;
      if (!second) {
#pragma unroll
        for (int r = 0; r < 4; ++r) {
          int s = c * 16 + 4 * g + r;
          int tl = dir ? (ntok - 1 - s) : s;
          L.obuf[tl][vcol] = f2bf(o[r]);
        }
      } else {
#pragma unroll
        for (int r = 0; r < 4; ++r) {
          int s = c * 16 + 4 * g + r;
          int tl = dir ? (ntok - 1 - s) : s;
          L.osum[4 * g + r][vcol] = o[r] + bf2f(L.obuf[tl][vcol]);
        }
        LBAR();
        {
          int sl = tid >> 5, vq = tid & 31;
          int s = c * 16 + sl;
          int tl = dir ? (ntok - 1 - s) : s;
          float4 ov = *(const float4*)&L.osum[sl][4 * vq];
          float ss = ov.x * ov.x + ov.y * ov.y + ov.z * ov.z + ov.w * ov.w;
#pragma unroll
          for (int m = 1; m <= 16; m <<= 1) ss += __shfl_xor(ss, m);
          float rinv = rsqrtf(ss * (1.f / 128.f) + EPSV);
          u16* rp = projw + (size_t)(row0 + tl) * LDP + h * 128 + 4 * vq;
          uint2 z = *(const uint2*)&L.zt[sl][4 * vq];
          float y0 = ov.x * rinv * gg.x * lo2f(z.x), y1 = ov.y * rinv * gg.y * hi2f(z.x);
          float y2 = ov.z * rinv * gg.z * lo2f(z.y), y3 = ov.w * rinv * gg.w * hi2f(z.y);
          if (!dry) *(uint2*)(rp + PQA) = make_uint2(pack2(y0, y1), pack2(y2, y3));
        }
      }
    }
  };
  for (int c = 0; c < nch; c += 2) {
    body(c, lfA, qA, vA, zA);
    body(c + 1, lfB, qB, vB, zB);
  }
  __syncthreads();
}

__device__ __forceinline__ void hgrn_load_state(const float* m, f32x4 (&S)[8]) {
  const int tid_ = otid(); const int lane = tid_ & 63, wid = tid_ >> 6, c16 = lane & 15, g = lane >> 4;
#pragma unroll
  for (int k8 = 0; k8 < 8; ++k8)
#pragma unroll
    for (int r = 0; r < 4; ++r) S[k8][r] = m[(16 * k8 + 4 * g + r) * 128 + 16 * wid + c16];
}
__device__ __forceinline__ void hgrn_store_state(float* m, const f32x4 (&S)[8]) {
  const int tid_ = otid(); const int lane = tid_ & 63, wid = tid_ >> 6, c16 = lane & 15, g = lane >> 4;
#pragma unroll
  for (int k8 = 0; k8 < 8; ++k8)
#pragma unroll
    for (int r = 0; r < 4; ++r) m[(16 * k8 + 4 * g + r) * 128 + 16 * wid + c16] = S[k8][r];
}
__device__ __forceinline__ void hgrn_advance(const float* U, const float* D, f32x4 (&S)[8]) {
  const int tid_ = otid(); const int lane = tid_ & 63, wid = tid_ >> 6, c16 = lane & 15, g = lane >> 4;
#pragma unroll
  for (int k8 = 0; k8 < 8; ++k8)
#pragma unroll
    for (int r = 0; r < 4; ++r) {
      int k = 16 * k8 + 4 * g + r;
      S[k8][r] = D[k] * S[k8][r] + U[k * 128 + 16 * wid + c16];
    }
}

__device__ __forceinline__ void hgrn_ctx_item(const Params& p, int l, int item, char* lds, const bool dry = false) {
  HgrnLds& L = *(HgrnLds*)lds;
  const int b = item >> 2, h = item & 3;
  f32x4 S[8];
  float gsum = 0.f;
#pragma unroll
  for (int i = 0; i < 8; ++i) S[i] = f32x4{0.f, 0.f, 0.f, 0.f};
  hgrn_pass(p, l, b * 256, 256, h, 0, S, true, false, gsum, L, dry);
  if (!dry) hgrn_store_state(p.out + OST + ((size_t)(((b * 2 + l) * 2 + 0) * 4 + h)) * 16384, S);
#pragma unroll
  for (int i = 0; i < 8; ++i) S[i] = f32x4{0.f, 0.f, 0.f, 0.f};
  hgrn_pass(p, l, b * 256, 256, h, 1, S, true, true, gsum, L, dry);
  if (!dry) hgrn_store_state(p.out + OST + ((size_t)(((b * 2 + l) * 2 + 1) * 4 + h)) * 16384, S);
}
__device__ __forceinline__ void hgrn_lat1_item(const Params& p, int l, int item, char* lds) {
  HgrnLds& L = *(HgrnLds*)lds;
  const int seg = item & 15, dir = (item >> 4) & 1, h = (item >> 5) & 3, b = item >> 7;
  f32x4 S[8];
  float gsum = 0.f;
#pragma unroll
  for (int i = 0; i < 8; ++i) S[i] = f32x4{0.f, 0.f, 0.f, 0.f};
  hgrn_pass(p, l, NCTX + b * 2048 + seg * 128, 128, h, dir, S, false, false, gsum, L);
  float* SU = (float*)(p.ws + OFF_SEGU);
  float* SD = (float*)(p.ws + OFF_SEGD);
  {
    const int tq_ = otid(); const int lane_ = tq_ & 63, wid_ = tq_ >> 6, c16_ = lane_ & 15, g_ = lane_ >> 4;
    float* m_ = SU + (size_t)item * 16384;
#pragma unroll
    for (int k8 = 0; k8 < 8; ++k8)
#pragma unroll
      for (int r = 0; r < 4; ++r) __hip_atomic_store(m_ + (16 * k8 + 4 * g_ + r) * 128 + 16 * wid_ + c16_, S[k8][r], __ATOMIC_RELAXED, __HIP_MEMORY_SCOPE_AGENT);
  }
  const int t_ = otid();
  if (t_ < 128) __hip_atomic_store(SD + item * 128 + t_, fexp(gsum), __ATOMIC_RELAXED, __HIP_MEMORY_SCOPE_AGENT);
  volatile int* flag = (volatile int*)(lds + LDS_TILE + 32);
  asm volatile("s_waitcnt vmcnt(0)" ::: "memory");
  __syncthreads();
  if (t_ == 0) {
    unsigned* tk = (unsigned*)(p.ws + OFF_CNT) + 8 + l * 32 + (item >> 4);
    const unsigned old = __hip_atomic_fetch_add(tk, 1u, __ATOMIC_RELAXED, __HIP_MEMORY_SCOPE_AGENT);
    const int last = (old == 15u) ? 1 : 0;
    if (last) { __builtin_amdgcn_fence(__ATOMIC_ACQUIRE, "agent"); asm volatile("s_waitcnt vmcnt(0)" ::: "memory"); }
    *flag = last;
  }
  __syncthreads();
  if (*flag) {
    const int base = (item >> 4) * 16;
    hgrn_load_state(p.in[5] + ((size_t)(((b * 2 + l) * 2 + dir) * 4 + h)) * 16384, S);
    const int lane = t_ & 63, wid = t_ >> 6, c16 = lane & 15, g = lane >> 4;
    float un[8][4]; float4 dn[8];
    {
      const int sg0 = dir ? 15 : 0;
      const float* U0 = SU + (size_t)(base + sg0) * 16384; const float* D0 = SD + (base + sg0) * 128;
#pragma unroll
      for (int k8 = 0; k8 < 8; ++k8) {
        dn[k8] = *(const float4*)(D0 + 16 * k8 + 4 * g);
#pragma unroll
        for (int r = 0; r < 4; ++r) un[k8][r] = U0[(16 * k8 + 4 * g + r) * 128 + 16 * wid + c16];
      }
    }
#pragma unroll 1
    for (int i = 0; i < 16; ++i) {
      const int sg = dir ? (15 - i) : i;
      float* U = SU + (size_t)(base + sg) * 16384;
      float uc[8][4]; float4 dc[8];
#pragma unroll
      for (int k8 = 0; k8 < 8; ++k8) { dc[k8] = dn[k8];
#pragma unroll
        for (int r = 0; r < 4; ++r) uc[k8][r] = un[k8][r]; }
      if (i + 1 < 16) {
        const int sgn = dir ? (14 - i) : (i + 1);
        const float* Un = SU + (size_t)(base + sgn) * 16384; const float* Dn = SD + (base + sgn) * 128;
#pragma unroll
        for (int k8 = 0; k8 < 8; ++k8) {
          dn[k8] = *(const float4*)(Dn + 16 * k8 + 4 * g);
#pragma unroll
          for (int r = 0; r < 4; ++r) un[k8][r] = Un[(16 * k8 + 4 * g + r) * 128 + 16 * wid + c16];
        }
      }
#pragma unroll
      for (int k8 = 0; k8 < 8; ++k8) {
        const float dd[4] = {dc[k8].x, dc[k8].y, dc[k8].z, dc[k8].w};
#pragma unroll
        for (int r = 0; r < 4; ++r) {
          const int idx = (16 * k8 + 4 * g + r) * 128 + 16 * wid + c16;
          U[idx] = S[k8][r];
          S[k8][r] = dd[r] * S[k8][r] + uc[k8][r];
        }
      }
    }
  }
  __syncthreads();
}
__device__ __forceinline__ void hgrn_lat2_item(const Params& p, int l, int item, char* lds, const bool dry = false) {
  HgrnLds& L = *(HgrnLds*)lds;
  const int seg = item & 15, h = (item >> 4) & 3, b = item >> 6;
  const float* SU = (const float*)(p.ws + OFF_SEGU);
  const float* SD = (const float*)(p.ws + OFF_SEGD);
  f32x4 S[8];
  float gsum = 0.f;
  hgrn_load_state(SU + (size_t)(((b * 4 + h) * 2 + 0) * 16 + seg) * 16384, S);
  hgrn_pass(p, l, NCTX + b * 2048 + seg * 128, 128, h, 0, S, true, false, gsum, L, dry);
  hgrn_load_state(SU + (size_t)(((b * 4 + h) * 2 + 1) * 16 + seg) * 16384, S);
  hgrn_pass(p, l, NCTX + b * 2048 + seg * 128, 128, h, 1, S, true, true, gsum, L, dry);
}

__device__ __forceinline__ void attn_item(const Params& p, int l, int item, const bool lat, char* lds, const bool dry = false) {
  const int tid = otid(), lane = tid & 63, wid = tid >> 6, c16 = lane & 15, g = lane >> 4;
  char* ws = p.ws;
  u16* proj = (u16*)(ws + OFF_PROJ);
  int b, h, qb, nkeys, rowbase;
  const u16* Vt; int ldv;
  if (!lat) { qb = item & 1; h = (item >> 1) & 3; b = item >> 3; nkeys = 256; rowbase = b * 256; Vt = (const u16*)(ws + OFF_VTC) + (size_t)((b * 4 + h) * 128) * 256; ldv = 256; }
  else { qb = item & 15; h = (item >> 4) & 3; b = item >> 6; nkeys = 2304; rowbase = NCTX + b * 2048; Vt = (const u16*)(ws + OFF_VTL + l * SZ_VTL) + (size_t)((b * 4 + h) * 128) * 2304; ldv = 2304; }
  const u16* Kc = (const u16*)(ws + OFF_KC) + (size_t)((l * 2 + b) * 256) * 512 + h * 128;
  u16* Ks = (u16*)lds;
  u16* Vs = Ks + 64 * 136;
  float lam_init = 0.8f - 0.6f * expf(-0.3f * (float)l);
  float lam;
  {
    const float* lp = p.in[15] + l * 256;
    float a = lp[lane] * lp[64 + lane], c = lp[128 + lane] * lp[192 + lane];
#pragma unroll
    for (int o = 32; o >= 1; o >>= 1) { a += __shfl_xor(a, o); c += __shfl_xor(c, o); }
    lam = expf(a) - expf(c) + lam_init;
  }
  const int qrow = rowbase + qb * 128 + wid * 16 + c16;
  Frag qf[2][2];
#pragma unroll
  for (int m = 0; m < 2; ++m)
#pragma unroll
    for (int ks = 0; ks < 2; ++ks) qf[m][ks].q = *(const uint4*)(proj + (size_t)qrow * LDP + PQB + h * 128 + m * 64 + ks * 32 + g * 8);
  f32x4 O[2][8];
#pragma unroll
  for (int m = 0; m < 2; ++m)
#pragma unroll
    for (int v = 0; v < 8; ++v) O[m][v] = f32x4{0.f, 0.f, 0.f, 0.f};
  float mrun[2] = {-1e30f, -1e30f}, lsum[2] = {0.f, 0.f};
  uint4 kr0, kr1, vr0, vr1;
#define ATT_LD(kt_)                                                                                           \
  {                                                                                                           \
    const int key0 = (kt_) * 64;                                                                              \
    const bool fromproj = (!lat) || (key0 < 2048);                                                            \
    {                                                                                                         \
      int q = tid; int key = q >> 4, cc = q & 15;                                                             \
      const u16* src = fromproj ? proj + (size_t)(rowbase + key0 + key) * LDP + PKB + h * 128 + cc * 8        \
                                : Kc + (size_t)(key0 - 2048 + key) * 512 + cc * 8;                            \
      kr0 = *(const uint4*)src;                                                                               \
      int v = q >> 3, c8 = q & 7;                                                                             \
      vr0 = *(const uint4*)(Vt + (size_t)v * ldv + key0 + c8 * 8);                                            \
    }                                                                                                         \
    {                                                                                                         \
      int q = tid + 512; int key = q >> 4, cc = q & 15;                                                       \
      const u16* src = fromproj ? proj + (size_t)(rowbase + key0 + key) * LDP + PKB + h * 128 + cc * 8        \
                                : Kc + (size_t)(key0 - 2048 + key) * 512 + cc * 8;                            \
      kr1 = *(const uint4*)src;                                                                               \
      int v = q >> 3, c8 = q & 7;                                                                             \
      vr1 = *(const uint4*)(Vt + (size_t)v * ldv + key0 + c8 * 8);                                            \
    }                                                                                                         \
  }
#define ATT_ST()                                                                                              \
  {                                                                                                           \
    { int q = tid; int key = q >> 4, cc = q & 15; *(uint4*)(Ks + key * 136 + cc * 8) = kr0;                   \
      int v = q >> 3, c8 = q & 7; *(uint4*)(Vs + v * 72 + c8 * 8) = vr0; }                                    \
    { int q = tid + 512; int key = q >> 4, cc = q & 15; *(uint4*)(Ks + key * 136 + cc * 8) = kr1;             \
      int v = q >> 3, c8 = q & 7; *(uint4*)(Vs + v * 72 + c8 * 8) = vr1; }                                    \
  }
  const int nkt = nkeys >> 6;
  ATT_LD(0);
  for (int kt = 0; kt < nkt; ++kt) {
    LBAR();
    ATT_ST();
    LBAR();
    if (kt + 1 < nkt) ATT_LD(kt + 1);
    Frag pf[2][2];
#pragma unroll
    for (int m = 0; m < 2; ++m) {
      f32x4 s[4];
#pragma unroll
      for (int k4 = 0; k4 < 4; ++k4) {
        s[k4] = f32x4{0.f, 0.f, 0.f, 0.f};
#pragma unroll
        for (int ks = 0; ks < 2; ++ks) {
          Frag a;
          a.q = *(const uint4*)(Ks + (16 * k4 + c16) * 136 + m * 64 + ks * 32 + g * 8);
          s[k4] = MFMA(a.v, qf[m][ks].v, s[k4]);
        }
      }
      float mx = -1e30f;
#pragma unroll
      for (int k4 = 0; k4 < 4; ++k4)
#pragma unroll
        for (int r = 0; r < 4; ++r) mx = fmaxf(mx, s[k4][r]);
      mx = fmaxf(mx, __shfl_xor(mx, 16));
      mx = fmaxf(mx, __shfl_xor(mx, 32));
      float mnew = fmaxf(mrun[m], mx);
      float alpha = fexp(mrun[m] - mnew);
      mrun[m] = mnew;
      float ps = 0.f;
#pragma unroll
      for (int k4 = 0; k4 < 4; ++k4)
#pragma unroll
        for (int r = 0; r < 4; ++r) { s[k4][r] = fexp(s[k4][r] - mnew); ps += s[k4][r]; }
      lsum[m] = lsum[m] * alpha + ps;
#pragma unroll
      for (int v = 0; v < 8; ++v) { O[m][v][0] *= alpha; O[m][v][1] *= alpha; O[m][v][2] *= alpha; O[m][v][3] *= alpha; }
#pragma unroll
      for (int sp = 0; sp < 2; ++sp) {
        pf[m][sp].w[0] = pack2(s[2 * sp][0], s[2 * sp][1]); pf[m][sp].w[1] = pack2(s[2 * sp][2], s[2 * sp][3]);
        pf[m][sp].w[2] = pack2(s[2 * sp + 1][0], s[2 * sp + 1][1]); pf[m][sp].w[3] = pack2(s[2 * sp + 1][2], s[2 * sp + 1][3]);
      }
    }
#pragma unroll
    for (int v = 0; v < 8; ++v)
#pragma unroll
      for (int sp = 0; sp < 2; ++sp) {
        Frag a;
        a.h[0] = *(const uint2*)(Vs + (16 * v + c16) * 72 + 32 * sp + 4 * g);
        a.h[1] = *(const uint2*)(Vs + (16 * v + c16) * 72 + 32 * sp + 16 + 4 * g);
        O[0][v] = MFMA(a.v, pf[0][sp].v, O[0][v]);
        O[1][v] = MFMA(a.v, pf[1][sp].v, O[1][v]);
      }
  }
  float l0 = lsum[0], l1 = lsum[1];
  l0 += __shfl_xor(l0, 16); l0 += __shfl_xor(l0, 32);
  l1 += __shfl_xor(l1, 16); l1 += __shfl_xor(l1, 32);
  const float i0 = 1.f / l0, i1 = lam / l1;
  float ss = 0.f;
#pragma unroll
  for (int v = 0; v < 8; ++v)
#pragma unroll
    for (int r = 0; r < 4; ++r) { float o = O[0][v][r] * i0 - O[1][v][r] * i1; O[0][v][r] = o; ss += o * o; }
  ss += __shfl_xor(ss, 16); ss += __shfl_xor(ss, 32);
  const float rinv = rsqrtf(ss * (1.f / 128.f) + EPSV) * (1.f - lam_init);
  u16* rp = proj + (size_t)qrow * LDP + h * 128;
#pragma unroll
  for (int v = 0; v < 8; ++v) {
    int vc = 16 * v + 4 * g;
    float4 sg = *(const float4*)(p.in[16] + l * 128 + vc);
    uint2 z = *(const uint2*)(rp + PZB + vc);
    float y0 = O[0][v][0] * rinv * sg.x * lo2f(z.x), y1 = O[0][v][1] * rinv * sg.y * hi2f(z.x);
    float y2 = O[0][v][2] * rinv * sg.z * lo2f(z.y), y3 = O[0][v][3] * rinv * sg.w * hi2f(z.y);
    if (!dry) *(uint2*)(rp + PQB + vc) = make_uint2(pack2(y0, y1), pack2(y2, y3));
  }
  __syncthreads();
}

__device__ __forceinline__ void f1_item(const Params& p, int item, char* lds) {
  const int tid = otid(), lane = tid & 63, wid = tid >> 6, wr = wid >> 2, wc = wid & 3, fr = lane & 15, fq = lane >> 4;
  char* ws = p.ws;
  const int jh = item & 1, gq = (item >> 1) & 3, mt = item >> 3;
  f32x4 acc[4][4];
  gemm_kloop<128>((const u16*)(ws + OFF_B1) + jh * 128 * 128, 128, (const u16*)(ws + OFF_PROJ) + (size_t)(mt * 256) * LDP + PUC + gq * 128, LDP, 128, acc, lds);
#pragma unroll
  for (int a = 0; a < 4; ++a)
#pragma unroll
    for (int b = 0; b < 4; ++b) {
      int tokl = wc * 64 + a * 16 + 4 * fq;
      int jj = wr * 64 + b * 16 + fr;
      uint2 pk = make_uint2(pack2(acc[a][b][0], acc[a][b][1]), pack2(acc[a][b][2], acc[a][b][3]));
      if (mt < 32) {
        *(uint2*)(ws + OFF_PTC + ((size_t)((mt * 4 + gq) * 128 + jj) * 512 + jh * 256 + tokl) * 2) = pk;
      } else {
        int rp = (mt - 32) * 256 + tokl; int bb = rp >> 11, t = rp & 2047;
        *(uint2*)(ws + OFF_PTL + ((size_t)((bb * 4 + gq) * 128 + jj) * 4096 + jh * 2048 + t) * 2) = pk;
      }
    }
}

struct F2Epi {
  char* ws; float scl; int rowbase_mul;
  bool lat;
  __device__ __forceinline__ void operator()(f32x4 (&acc)[2][2][4][2], const Unit& u, int wr, int wc, int fr, int fq, LAS unsigned char* lds) const {
    u16* proj = (u16*)(ws + OFF_PROJ);
#pragma unroll
    for (int ai = 0; ai < 2; ++ai)
#pragma unroll
      for (int mh = 0; mh < 2; ++mh) {
        uint2 zv[2][2][2];
#pragma unroll
        for (int mm = 0; mm < 2; ++mm)
#pragma unroll
          for (int bj = 0; bj < 2; ++bj)
#pragma unroll
            for (int n = 0; n < 2; ++n) {
              const int tp = u.x * 256 + ai * 128 + wr * 64 + (mh * 2 + mm) * 16 + fr;
              const int nn = u.y * 256 + bj * 128 + wc * 32 + n * 16 + 4 * fq;
              const int bb = nn >> 9, col = nn & 511;
              const u16* rp = proj + (size_t)(lat ? (NCTX + bb * 2048 + tp) : (bb * 256 + tp)) * LDP;
              zv[mm][bj][n] = *(const uint2*)(rp + PZC + col);
            }
#pragma unroll
        for (int mm = 0; mm < 2; ++mm)
#pragma unroll
          for (int bj = 0; bj < 2; ++bj)
#pragma unroll
            for (int n = 0; n < 2; ++n) {
              const int m = mh * 2 + mm;
              const int tp = u.x * 256 + ai * 128 + wr * 64 + m * 16 + fr;
              const int nn = u.y * 256 + bj * 128 + wc * 32 + n * 16 + 4 * fq;
              const int bb = nn >> 9, col = nn & 511;
              u16* rp = proj + (size_t)(lat ? (NCTX + bb * 2048 + tp) : (bb * 256 + tp)) * LDP;
              const uint2 z = zv[mm][bj][n];
              f32x4 a4 = acc[ai][bj][m][n];
              *(uint2*)(rp + PUC + col) = make_uint2(pack2(a4[0] * scl * lo2f(z.x), a4[1] * scl * hi2f(z.x)),
                                                     pack2(a4[2] * scl * lo2f(z.y), a4[3] * scl * hi2f(z.y)));
            }
      }
  }
};
__device__ __forceinline__ void f2c_item(const Params& p, int item, char* lds) {
  OneUnit S; S.u.a = p.ws + OFF_DC; S.u.b = p.ws + OFF_PTC + (size_t)item * 256 * 1024; S.u.x = 0; S.u.y = item; S.u.lda = 512; S.u.ldb = 512; S.u.nt = 8;
  F2Epi E; E.ws = p.ws; E.scl = 0.005524271728019903f; E.lat = false; E.rowbase_mul = 0;
  gemm_phase((LAS unsigned char*)lds, S, E);
}
struct F2HalfEpi {
  uint2* part;
  __device__ __forceinline__ void operator()(f32x4 (&acc)[2][2][4][2], const Unit& u, int wr, int wc, int fr, int fq, LAS unsigned char* lds) const {
    const int tid = wr * 256 + wc * 64 + fq * 16 + fr;
#pragma unroll
    for (int ai = 0; ai < 2; ++ai)
#pragma unroll
      for (int bj = 0; bj < 2; ++bj)
#pragma unroll
        for (int m = 0; m < 4; ++m)
#pragma unroll
          for (int n = 0; n < 2; ++n) {
            f32x4 a4 = acc[ai][bj][m][n];
            __hip_atomic_store((unsigned long long*)(part + (((ai * 2 + bj) * 4 + m) * 2 + n) * 512 + tid), (unsigned long long)pack2(a4[0], a4[1]) | ((unsigned long long)pack2(a4[2], a4[3]) << 32), __ATOMIC_RELAXED, __HIP_MEMORY_SCOPE_AGENT);
          }
  }
};
__device__ __forceinline__ void f2l_item(const Params& p, int l, int item, char* lds) {
  char* ws = p.ws;
  const int tile = item >> 1, half = item & 1, mt = tile >> 2, nt = tile & 3;
  uint2* pbase = (uint2*)(ws + OFF_F2P);
  {
    OneUnit S; S.u.a = ws + OFF_DL + ((size_t)mt * 256 * 4096 + half * 2048) * 2; S.u.b = ws + OFF_PTL + ((size_t)nt * 256 * 4096 + half * 2048) * 2;
    S.u.x = mt; S.u.y = nt; S.u.lda = 4096; S.u.ldb = 4096; S.u.nt = 32;
    F2HalfEpi E; E.part = pbase + (size_t)(tile * 2 + half) * (32 * 512);
    gemm_phase((LAS unsigned char*)lds, S, E);
  }
  const int t_ = otid();
  volatile int* flag = (volatile int*)(lds + LDS_TILE + 32);
  asm volatile("s_waitcnt vmcnt(0)" ::: "memory");
  __syncthreads();
  if (t_ == 0) {
    unsigned* tk = (unsigned*)(ws + OFF_CNT) + 72 + l * 32 + tile;
    const unsigned old = __hip_atomic_fetch_add(tk, 1u, __ATOMIC_RELAXED, __HIP_MEMORY_SCOPE_AGENT);
    const int last = (old == 1u) ? 1 : 0;
    if (last) { __builtin_amdgcn_fence(__ATOMIC_ACQUIRE, "agent"); asm volatile("s_waitcnt vmcnt(0)" ::: "memory"); }
    *flag = last;
  }
  __syncthreads();
  if (*flag) {
    const int lane = t_ & 63, wid = t_ >> 6, wr = wid >> 2, wc = wid & 3, fr = lane & 15, fq = lane >> 4;
    const uint2* p0 = pbase + (size_t)(tile * 2 + 0) * (32 * 512);
    const uint2* p1 = pbase + (size_t)(tile * 2 + 1) * (32 * 512);
    u16* proj = (u16*)(ws + OFF_PROJ);
    const float scl = 1.f / 512.f;
#pragma unroll
    for (int ai = 0; ai < 2; ++ai)
#pragma unroll
      for (int mh = 0; mh < 2; ++mh) {
        uint2 zv[2][2][2], av[2][2][2], bv2[2][2][2];
#pragma unroll
        for (int mm = 0; mm < 2; ++mm)
#pragma unroll
          for (int bj = 0; bj < 2; ++bj)
#pragma unroll
            for (int n = 0; n < 2; ++n) {
              const int m = mh * 2 + mm;
              const int tp = mt * 256 + ai * 128 + wr * 64 + m * 16 + fr;
              const int nn = nt * 256 + bj * 128 + wc * 32 + n * 16 + 4 * fq;
              const int bb = nn >> 9, col = nn & 511;
              const u16* rp = proj + (size_t)(NCTX + bb * 2048 + tp) * LDP;
              zv[mm][bj][n] = *(const uint2*)(rp + PZC + col);
              const int idx = (((ai * 2 + bj) * 4 + m) * 2 + n) * 512 + t_;
              av[mm][bj][n] = p0[idx]; bv2[mm][bj][n] = p1[idx];
            }
#pragma unroll
        for (int mm = 0; mm < 2; ++mm)
#pragma unroll
          for (int bj = 0; bj < 2; ++bj)
#pragma unroll
            for (int n = 0; n < 2; ++n) {
              const int m = mh * 2 + mm;
              const int tp = mt * 256 + ai * 128 + wr * 64 + m * 16 + fr;
              const int nn = nt * 256 + bj * 128 + wc * 32 + n * 16 + 4 * fq;
              const int bb = nn >> 9, col = nn & 511;
              u16* rp = proj + (size_t)(NCTX + bb * 2048 + tp) * LDP;
              const uint2 z = zv[mm][bj][n], a = av[mm][bj][n], c = bv2[mm][bj][n];
              const float y0 = (lo2f(a.x) + lo2f(c.x)) * scl * lo2f(z.x), y1 = (hi2f(a.x) + hi2f(c.x)) * scl * hi2f(z.x);
              const float y2 = (lo2f(a.y) + lo2f(c.y)) * scl * lo2f(z.y), y3 = (hi2f(a.y) + hi2f(c.y)) * scl * hi2f(z.y);
              *(uint2*)(rp + PUC + col) = make_uint2(pack2(y0, y1), pack2(y2, y3));
            }
      }
  }
  __syncthreads();
}

__device__ __forceinline__ bool xcd_tile(int bid, int& pm, int& pn) {
  const int x = bid & 7, j = bid >> 3;
  if (j >= 24) return false;
  pm = 6 * x + (j >> 2); pn = j & 3;
  return true;
}
struct P5Sched {
  char* ws; int x, j;
  __device__ __forceinline__ bool next(int i, Unit& u) const {
    if (j < 24) {
      if (i >= 5) return false;
      const int pm = 6 * x + (j >> 2), pn = j & 3;
      const int jj = (i < 4) ? (i >> 1) : 2;
      if (i == 0 || i == 2) {
        u.a = ws + OFF_H + (size_t)pm * 256 * 2048; u.b = ws + OFF_WIN + (size_t)(5632 + jj * 1024 + pn * 256) * 2048;
        u.lda = 1024; u.ldb = 1024; u.nt = 16; u.x = pm; u.y = pn | (jj << 8);
      } else {
        const int yc = (jj == 0) ? PQA : ((jj == 1) ? PQB : PUC);
        u.a = ws + OFF_PROJ + ((size_t)pm * 256 * LDP + yc) * 2; u.b = ws + OFF_WBR + ((size_t)jj * 1024 * 512 + (size_t)pn * 256 * 512) * 2;
        u.lda = LDP; u.ldb = 512; u.nt = 8; u.x = pm; u.y = pn | (jj << 8) | ((i == 4) ? 0x2000 : 0x1000);
      }
      return true;
    }
    if (i >= 3) return false;
    const int tj = 3 * (j - 24) + i;
    const int pm = 6 * x + (tj >> 2), pn = tj & 3;
    u.a = ws + OFF_H + (size_t)pm * 256 * 2048; u.b = ws + OFF_WIN + (size_t)(5632 + 2 * 1024 + pn * 256) * 2048;
    u.lda = 1024; u.ldb = 1024; u.nt = 16; u.x = pm; u.y = pn | (2 << 8) | 0x3000;
    return true;
  }
};
struct P5Epi {
  char* ws; u16* mg; unsigned* flags; bool skip;
  __device__ __forceinline__ void operator()(f32x4 (&acc)[2][2][4][2], const Unit& u, int wr, int wc, int fr, int fq, LAS unsigned char* lds) const {
    if (skip) return;
    { const int t_ = otid(); const int w_ = t_ >> 6; wr = w_ >> 2; wc = w_ & 3; fr = t_ & 15; fq = (t_ & 63) >> 4; }
    const int tid = wr * 256 + wc * 64 + fq * 16 + fr;
    const int type = (u.y >> 12) & 3, j = (u.y >> 8) & 3, pn = u.y & 0xff, pm = u.x;
    const int tile = pm * 4 + pn;
    uint2* gs = (uint2*)(ws + OFF_SEGU) + (size_t)tile * (32 * 512);
    u16* g2p = (u16*)(ws + OFF_PROJ) + (size_t)pm * 256 * LDP + PLF + pn * 256;
    if (type == 0) {
#pragma unroll
      for (int ai = 0; ai < 2; ++ai)
#pragma unroll
        for (int bj = 0; bj < 2; ++bj)
#pragma unroll
          for (int m = 0; m < 4; ++m)
#pragma unroll
            for (int n = 0; n < 2; ++n) {
              f32x4 a4 = acc[ai][bj][m][n];
              gs[(((ai * 2 + bj) * 4 + m) * 2 + n) * 512 + tid] = make_uint2(pack2(sigmf(a4[0]), sigmf(a4[1])), pack2(sigmf(a4[2]), sigmf(a4[3])));
            }
      return;
    }
    if (type == 3) {
#pragma unroll
      for (int ai = 0; ai < 2; ++ai)
#pragma unroll
        for (int bj = 0; bj < 2; ++bj)
#pragma unroll
          for (int m = 0; m < 4; ++m)
#pragma unroll
            for (int n = 0; n < 2; ++n) {
              f32x4 a4 = acc[ai][bj][m][n];
              const int row = ai * 128 + wr * 64 + m * 16 + fr, col = bj * 128 + wc * 32 + n * 16 + 4 * fq;
              const unsigned long long v = (unsigned long long)pack2(sigmf(a4[0]), sigmf(a4[1])) | ((unsigned long long)pack2(sigmf(a4[2]), sigmf(a4[3])) << 32);
              __hip_atomic_store((unsigned long long*)(g2p + (size_t)row * LDP + col), v, __ATOMIC_RELAXED, __HIP_MEMORY_SCOPE_AGENT);
            }
      asm volatile("s_waitcnt vmcnt(0)" ::: "memory");
      if ((fq * 16 + fr) == 0) __hip_atomic_fetch_add(flags + tile, 1u, __ATOMIC_RELAXED, __HIP_MEMORY_SCOPE_AGENT);
      return;
    }
    if (type == 2) {
      if (tid == 0) {
        unsigned sp = 0;
        while (__hip_atomic_load(flags + tile, __ATOMIC_RELAXED, __HIP_MEMORY_SCOPE_AGENT) < 8u) { __builtin_amdgcn_s_sleep(2); if (++sp > (1u << 22)) break; }
        __builtin_amdgcn_fence(__ATOMIC_ACQUIRE, "agent");
        asm volatile("s_waitcnt vmcnt(0)" ::: "memory");
      }
      asm volatile("" ::: "memory");
      __builtin_amdgcn_s_barrier();
      asm volatile("" ::: "memory");
    }
#pragma unroll
    for (int ai = 0; ai < 2; ++ai)
#pragma unroll
      for (int mh = 0; mh < 2; ++mh) {
        uint2 gv[2][2][2], pv[2][2][2];
#pragma unroll
        for (int mm = 0; mm < 2; ++mm)
#pragma unroll
          for (int bj = 0; bj < 2; ++bj)
#pragma unroll
            for (int n = 0; n < 2; ++n) {
              const int m = mh * 2 + mm;
              const int rl = ai * 128 + wr * 64 + m * 16 + fr, cl = bj * 128 + wc * 32 + n * 16 + 4 * fq;
              const int row = pm * 256 + rl, col = pn * 256 + cl;
              const uint2* gptr = (type == 2) ? (const uint2*)(g2p + (size_t)rl * LDP + cl) : (const uint2*)(gs + (((ai * 2 + bj) * 4 + m) * 2 + n) * 512 + tid);
              gv[mm][bj][n] = *gptr;
              pv[mm][bj][n] = (j > 0) ? *(const uint2*)(mg + (size_t)row * 1024 + col) : make_uint2(0u, 0u);
            }
#pragma unroll
        for (int mm = 0; mm < 2; ++mm)
#pragma unroll
          for (int bj = 0; bj < 2; ++bj)
#pragma unroll
            for (int n = 0; n < 2; ++n) {
              const int m = mh * 2 + mm;
              const int row = pm * 256 + ai * 128 + wr * 64 + m * 16 + fr;
              const int col = pn * 256 + bj * 128 + wc * 32 + n * 16 + 4 * fq;
              f32x4 a4 = acc[ai][bj][m][n];
              const uint2 g2 = gv[mm][bj][n], p2 = pv[mm][bj][n];
              float t0 = lo2f(g2.x) * a4[0] + lo2f(p2.x), t1 = hi2f(g2.x) * a4[1] + hi2f(p2.x);
              float t2 = lo2f(g2.y) * a4[2] + lo2f(p2.y), t3 = hi2f(g2.y) * a4[3] + hi2f(p2.y);
              *(uint2*)(mg + (size_t)row * 1024 + col) = make_uint2(pack2(t0, t1), pack2(t2, t3));
            }
      }
  }
};
__device__ __forceinline__ void p5_phase(const Params& p, int l, char* lds, bool skip = false) {
  P5Sched S; S.ws = p.ws; S.x = blockIdx.x & 7; S.j = blockIdx.x >> 3;
  if (S.j >= 32) return;
  P5Epi E; E.ws = p.ws; E.mg = (u16*)(p.ws + OFF_MRG); E.flags = (unsigned*)(p.ws + OFF_CNT) + 136 + l * 192; E.skip = skip;
  gemm_phase((LAS unsigned char*)lds, S, E);
}

struct P6Epi {
  const float* xp0; const float* xs0; float* outp; const float* modp; int l;
  __device__ __forceinline__ void operator()(f32x4 (&acc)[2][2][4][2], const Unit& u, int wr, int wc, int fr, int fq, LAS unsigned char* lds) const {
    const int m0 = u.x * 256;
    const int ci = (m0 < NCTX) ? 0 : 1 + ((m0 - NCTX) >> 11);
    const float* xbase = (l == 0) ? ((m0 < NCTX) ? xp0 : xs0 - (size_t)NCTX * 1024) : outp;
    float4 gt[2][2];
#pragma unroll
    for (int bj = 0; bj < 2; ++bj)
#pragma unroll
      for (int n = 0; n < 2; ++n) gt[bj][n] = *(const float4*)(modp + (l * 3 + ci) * 3072 + 2048 + u.y * 256 + bj * 128 + wc * 32 + n * 16 + 4 * fq);
#pragma unroll
    for (int ai = 0; ai < 2; ++ai)
#pragma unroll
      for (int mh = 0; mh < 2; ++mh) {
        float4 xv[2][2][2];
#pragma unroll
        for (int mm = 0; mm < 2; ++mm)
#pragma unroll
          for (int bj = 0; bj < 2; ++bj)
#pragma unroll
            for (int n = 0; n < 2; ++n) {
              const int r = m0 + ai * 128 + wr * 64 + (mh * 2 + mm) * 16 + fr;
              const int col = u.y * 256 + bj * 128 + wc * 32 + n * 16 + 4 * fq;
              xv[mm][bj][n] = *(const float4*)(xbase + (size_t)r * 1024 + col);
            }
#pragma unroll
        for (int mm = 0; mm < 2; ++mm)
#pragma unroll
          for (int bj = 0; bj < 2; ++bj)
#pragma unroll
            for (int n = 0; n < 2; ++n) {
              const int m = mh * 2 + mm;
              const int r = m0 + ai * 128 + wr * 64 + m * 16 + fr;
              const int col = u.y * 256 + bj * 128 + wc * 32 + n * 16 + 4 * fq;
              f32x4 a4 = acc[ai][bj][m][n];
              const float4 x4 = xv[mm][bj][n], g4 = gt[bj][n];
              *(float4*)(outp + (size_t)r * 1024 + col) = make_float4(x4.x + g4.x * a4[0], x4.y + g4.y * a4[1], x4.z + g4.z * a4[2], x4.w + g4.w * a4[3]);
            }
      }
  }
};
__device__ __forceinline__ void p6_phase(const Params& p, int l, char* lds) {
  char* ws = p.ws;
  int pm, pn;
  if (!xcd_tile(blockIdx.x, pm, pn)) return;
  OneUnit S; S.u.a = ws + OFF_MRG + (size_t)pm * 256 * 2048; S.u.b = ws + OFF_WO + (size_t)pn * 256 * 2048; S.u.x = pm; S.u.y = pn;
  S.u.lda = 1024; S.u.ldb = 1024; S.u.nt = 16; S.reps = ((DUP_MASK & 512) && l == 0) ? 5 : 1;
  P6Epi E; E.xp0 = p.in[0]; E.xs0 = p.in[1]; E.outp = p.out; E.modp = (const float*)(ws + OFF_MOD); E.l = l;
  gemm_phase((LAS unsigned char*)lds, S, E);
}

#define XB_TMO      128
#define XB_XCNT(j)  (256  + 64 * (j))
#define XB_XSUB(j)  (1280 + 64 * (j))
#define XB_XGEN(j)  (2304 + 64 * (j))
#define XB_TOP      3328
#define XB_TOPGEN   3392
#define XCD_BAR_WORDS 3456
#define XB_SPIN_CAP (1u << 18)
struct XcdBarrier { unsigned* bar; unsigned x; volatile LAS unsigned* st; };
__device__ __forceinline__ unsigned xb_ld(unsigned* p) { return __hip_atomic_load(p, __ATOMIC_RELAXED, __HIP_MEMORY_SCOPE_AGENT); }
__device__ __forceinline__ unsigned xb_add(unsigned* p, unsigned v) { return __hip_atomic_fetch_add(p, v, __ATOMIC_RELAXED, __HIP_MEMORY_SCOPE_AGENT); }
__device__ __forceinline__ unsigned xb_xcc_id() { return (unsigned)__builtin_amdgcn_s_getreg((3 << 11) | 20) & 0xFu; }
#define XB_SPIN(cond, bar) do { unsigned _sp = 0; while (cond) { __builtin_amdgcn_s_sleep(1); \
    if ((++_sp & 255u) == 0u) { if (xb_ld(&(bar)[XB_TMO])) break; if (_sp > XB_SPIN_CAP) { atomicAdd(&(bar)[XB_TMO], 1u); break; } } } } while (0)
__device__ __forceinline__ XcdBarrier xcd_barrier_post(unsigned* bar, volatile LAS unsigned* st) {
  XcdBarrier b; b.bar = bar; b.x = xb_xcc_id(); b.st = st;
  if (threadIdx.x == 0) (void)xb_add(&bar[XB_XCNT(b.x)], 1u);
  return b;
}
__device__ __forceinline__ void xcd_barrier_complete(unsigned* bar, unsigned x, unsigned& nloc, unsigned& nx) {
  const unsigned G = gridDim.x * gridDim.y * gridDim.z;
  unsigned sum, cnt, mine, sp = 0u;
  for (;;) {
    sum = 0u; cnt = 0u; mine = 0u;
#pragma unroll
    for (unsigned j = 0; j < 16; ++j) { const unsigned c = xb_ld(&bar[XB_XCNT(j)]); sum += c; cnt += (c > 0u) ? 1u : 0u; mine = (j == x) ? c : mine; }
    if (sum == G) break;
    __builtin_amdgcn_s_sleep(1);
    if ((++sp & 255u) == 0u) { if (xb_ld(&bar[XB_TMO])) break; if (sp > XB_SPIN_CAP) { atomicAdd(&bar[XB_TMO], 1u); break; } }
  }
  nloc = mine > 0u ? mine : 1u; nx = cnt > 0u ? cnt : 1u;
}
__device__ __forceinline__ void xcd_barrier(const XcdBarrier& b) {
  asm volatile("s_waitcnt vmcnt(0)" ::: "memory");
  __syncthreads();
  if (threadIdx.x == 0) {
    unsigned* bar = b.bar;
    __builtin_amdgcn_s_waitcnt(0);
    unsigned nloc = b.st[0], nx = b.st[1];
    if (nloc == 0u) { xcd_barrier_complete(bar, b.x, nloc, nx); b.st[0] = nloc; b.st[1] = nx; }
    const unsigned old = xb_add(&bar[XB_XSUB(b.x)], 1u);
    const unsigned gen = old / nloc;
    if (old + 1u == (gen + 1u) * nloc) {
      __builtin_amdgcn_fence(__ATOMIC_RELEASE, "agent");
      asm volatile("s_waitcnt vmcnt(0)" ::: "memory");
      const unsigned og = xb_add(&bar[XB_TOP], 1u);
      const unsigned tg = og / nx;
      if (og + 1u == (tg + 1u) * nx) xb_add(&bar[XB_TOPGEN], 1u);
      else XB_SPIN(xb_ld(&bar[XB_TOPGEN]) == tg, bar);
      __builtin_amdgcn_fence(__ATOMIC_ACQUIRE, "agent");
      xb_add(&bar[XB_XGEN(b.x)], 1u);
      asm volatile("s_waitcnt vmcnt(0)" ::: "memory");
    } else {
      XB_SPIN(xb_ld(&bar[XB_XGEN(b.x)]) == gen, bar);
      __builtin_amdgcn_fence(__ATOMIC_ACQUIRE, "agent");
      asm volatile("s_waitcnt vmcnt(0)" ::: "memory");
    }
  }
  __syncthreads();
}

#define PARGS const float* a0, const float* a1, const float* a2, const float* a3, const float* a4, const float* a5, const float* a6, \
  const float* a7, const float* a8, const float* a9, const float* a10, const float* a11, const float* a12, const float* a13, \
  const float* a14, const float* a15, const float* a16, const float* a17, const float* a18, const float* a19, const float* a20, \
  float* aout, char* aws
#define PFILL Params p; p.in[0]=a0;p.in[1]=a1;p.in[2]=a2;p.in[3]=a3;p.in[4]=a4;p.in[5]=a5;p.in[6]=a6;p.in[7]=a7;p.in[8]=a8;p.in[9]=a9;p.in[10]=a10; \
  p.in[11]=a11;p.in[12]=a12;p.in[13]=a13;p.in[14]=a14;p.in[15]=a15;p.in[16]=a16;p.in[17]=a17;p.in[18]=a18;p.in[19]=a19;p.in[20]=a20;p.out=aout;p.ws=aws;
__global__ void __launch_bounds__(512) fwd_megakernel(PARGS) {
  PFILL
  extern __shared__ __attribute__((aligned(16))) char lds[];
  volatile int& s_item = *(volatile int*)(lds + LDS_TILE);
  cg::grid_group grid = cg::this_grid();
  const int bid = blockIdx.x, G = gridDim.x, tid = threadIdx.x;
  int* cnt = (int*)(p.ws + OFF_CNT);
  volatile LAS unsigned* bst = (volatile LAS unsigned*)(LAS unsigned char*)(lds + LDS_TILE + 16);
  if (tid < 2) bst[tid] = 0u;
  __syncthreads();
  const XcdBarrier xb = xcd_barrier_post((unsigned*)(p.ws + OFF_BAR), bst);
  for (int rep = 0; rep < ((DUP_MASK & 1) ? 2 : 1); ++rep) {
  {
    for (int it = bid; it < 384; it += G) p0_mod16(p, it, lds);
    float2* tab = (float2*)lds;
    for (int m = tid; m < 2048; m += 512) { float sn, cs; sincospif((float)m * (1.f / 1024.f), &sn, &cs); tab[m] = make_float2(cs, sn); }
    __syncthreads();
    for (int it = 224 + bid; it < 224 + 2048; it += G) p0_item(p, it, lds);
    __syncthreads();
    for (int it = 96 + bid; it < P0_ITEMS; it += G) { if (it >= 224 && it < 224 + 2048) continue; p0_item(p, it, lds); }
  }
  if (((const volatile float*)p.in[15])[0] > 1e30f) grid.sync();
  xcd_barrier(xb);
  }
  for (int l = 0; l < 2; ++l) {
    for (int rep = 0; rep < ((DUP_MASK & 2) ? 2 : 1); ++rep) {
    for (int it = bid; it < P1_ITEMS; it += G) p1_item(p, l, it, lds);
    xcd_barrier(xb);
    }
    if (DUP_MASK & 1024) { const bool opq = (((const volatile float*)p.in[15])[0] < 1e30f); p2_phase(p, l, lds, opq); xcd_barrier(xb); }
    for (int rep = 0; rep < ((DUP_MASK & 4) ? 2 : 1); ++rep) {
    p2_phase(p, l, lds);
    xcd_barrier(xb);
    }
    for (;;) {
      __syncthreads();
      if (tid == 0) s_item = atomicAdd(&cnt[l * 2 + 0], 1);
      __syncthreads();
      int it = s_item;
      constexpr int D3 = (DUP_MASK & 16) ? 256 : 0;
      if (it >= D3 + 32 + 128 + 384 + 256) break;
      if (it >= 32 + 128 + 384 + 256) { hgrn_ctx_item(p, l, (it - 800) & 127, lds, true); continue; }
      if (it < 32) p2_left_item(p, l, 1024 + it, lds);
      else if (it < 160) hgrn_ctx_item(p, l, it - 32, lds);
      else if (it < 416) hgrn_lat1_item(p, l, it - 160, lds);
      else f1_item(p, it - 416, lds);
    }
    xcd_barrier(xb);
    for (;;) {
      __syncthreads();
      if (tid == 0) s_item = atomicAdd(&cnt[l * 2 + 1], 1);
      __syncthreads();
      int it = s_item;
      constexpr int D4a = (DUP_MASK & 32) ? 256 : 0, D4b = (DUP_MASK & 64) ? 256 : 0;
      if (it >= D4a + D4b + 640) break;
      if (it >= 640) { if (DUP_MASK & 32) attn_item(p, l, (it - 640) & 127, true, lds, true); else hgrn_lat2_item(p, l, (it - 640) & 127, lds, true); continue; }
      if (it < 128) attn_item(p, l, it, true, lds);
      else if (it < 192) f2l_item(p, l, it - 128, lds);
      else if (it < 320) hgrn_lat2_item(p, l, it - 192, lds);
      else if (it < 384) f2c_item(p, it - 320, lds);
      else attn_item(p, l, it - 384, false, lds);
    }
    xcd_barrier(xb);
    if (DUP_MASK & 2048) { const bool opq = (((const volatile float*)p.in[15])[0] < 1e30f); p5_phase(p, l, lds, opq); xcd_barrier(xb); }
    for (int rep = 0; rep < ((DUP_MASK & 8) ? 2 : 1); ++rep) {
    p5_phase(p, l, lds);
    xcd_barrier(xb);
    }
    for (int rep = 0; rep < (((DUP_MASK & 256) && l == 0) ? 5 : 1); ++rep) {
    p6_phase(p, l, lds);
    if (l == 0) xcd_barrier(xb);
    }
  }
}

extern "C" void kernel_launch(void* const* d_in, const int* in_sizes, int n_in,
                              void* d_out, int out_size, void* d_ws, size_t ws_size,
                              hipStream_t stream) {
  static int grid_blocks = 0;
  if (!grid_blocks) {
    int dev = 0, cus = 0;
    (void)hipGetDevice(&dev);
    (void)hipDeviceGetAttribute(&cus, hipDeviceAttributeMultiprocessorCount, dev);
    if (hipFuncSetAttribute((const void*)fwd_megakernel, hipFuncAttributeMaxDynamicSharedMemorySize, LDS_BYTES) != hipSuccess)
      fprintf(stderr, "hipFuncSetAttribute failed\n");
    grid_blocks = cus > 0 ? cus : 256;
    if (ws_size < WS_END) fprintf(stderr, "workspace too small: %zu < %zu\n", ws_size, (size_t)WS_END);
  }
  const void* ins[21];
  for (int i = 0; i < 21; ++i) ins[i] = d_in[i];
  void* outp = d_out; void* wsp = d_ws;
  void* args[23];
  for (int i = 0; i < 21; ++i) args[i] = (void*)&ins[i];
  args[21] = (void*)&outp; args[22] = (void*)&wsp;
  (void)hipMemsetAsync((char*)d_ws + OFF_CNT, 0, 4096 + 3456 * 4, stream);
  hipError_t e = hipLaunchCooperativeKernel((void*)fwd_megakernel, dim3(grid_blocks), dim3(512), args, LDS_BYTES, stream);
  if (e != hipSuccess) fprintf(stderr, "cooperative launch failed: %s (grid %d)\n", hipGetErrorString(e), grid_blocks);
}
```

```cpp
#include <hip/hip_runtime.h>
#include <hip/hip_cooperative_groups.h>
#include <stdint.h>
#include <cstdio>
namespace cg = cooperative_groups;

typedef unsigned short u16;
using bf16x8 = __attribute__((ext_vector_type(8))) short;
using f32x4 = __attribute__((ext_vector_type(4))) float;
#define MFMA(a, b, c) __builtin_amdgcn_mfma_f32_16x16x32_bf16(a, b, c, 0, 0, 0)

constexpr int NTOK = 12288;
constexpr int NCTX = 8192;
constexpr int LDP = 5120;
constexpr int PQA = 0, PLF = 512, PIA = 1536, PZA = 2048, PQB = 2560, PKB = 3072, PZB = 3584, PUC = 4096, PZC = 4608;
constexpr float EPSV = 1e-6f;
constexpr size_t OCK = 12582912, OCV = 20971520, OST = 29360128;

constexpr size_t OFF_WIN = 0;
constexpr size_t OFF_WBR = OFF_WIN + 8704ull * 1024 * 2;
constexpr size_t OFF_WO = OFF_WBR + 3ull * 1024 * 512 * 2;
constexpr size_t OFF_H = OFF_WO + 1024ull * 1024 * 2;
constexpr size_t OFF_PROJ = OFF_H + 12288ull * 1024 * 2;
constexpr size_t OFF_R1 = OFF_PROJ + 12288ull * LDP * 2;
constexpr size_t OFF_PTC = OFF_R1;
constexpr size_t OFF_PTL = OFF_R1 + 16384ull * 512 * 2;
constexpr size_t OFF_MRG = OFF_R1;
constexpr size_t OFF_SEGU = OFF_R1 + 25165824ull;
constexpr size_t OFF_SEGD = OFF_SEGU + 256ull * 16384 * 4;
constexpr size_t OFF_VTC = OFF_SEGD + 256ull * 128 * 4;
constexpr size_t OFF_VTL = OFF_VTC + 32ull * 4 * 128 * 256 * 2;
constexpr size_t SZ_VTL = 2ull * 4 * 128 * 2304 * 2;
constexpr size_t OFF_KC = OFF_VTL + 2 * SZ_VTL;
constexpr size_t OFF_DL = OFF_KC + 2ull * 2 * 256 * 512 * 2;
constexpr size_t OFF_DC = OFF_DL + 2048ull * 4096 * 2;
constexpr size_t OFF_B1 = OFF_DC + 256ull * 512 * 2;
constexpr size_t OFF_ROPE = OFF_B1 + 256ull * 128 * 2;
constexpr size_t OFF_MOD = OFF_ROPE + 2048ull * 32 * 8;
constexpr size_t OFF_CNT = OFF_MOD + 2ull * 3 * 3072 * 4;
constexpr size_t OFF_BAR = OFF_CNT + 4096;
constexpr size_t OFF_F2P = OFF_BAR + 3456 * 4 + 192;
constexpr size_t WS_END = OFF_F2P + 32ull * 2 * 32 * 512 * 8;

constexpr int LDS_TILE = 131072 + 8192;
#define DUP_MASK 0
constexpr int LDS_BYTES = LDS_TILE + 64;

struct Params {
  const float* in[21];
  float* out;
  char* ws;
};

typedef __bf16 bf16x2_t __attribute__((ext_vector_type(2)));
typedef float f32x2_t __attribute__((ext_vector_type(2)));
__device__ __forceinline__ uint32_t pack2(float a, float b) {
  f32x2_t v = {a, b};
  bf16x2_t r = __builtin_convertvector(v, bf16x2_t);
  return __builtin_bit_cast(uint32_t, r);
}
__device__ __forceinline__ u16 f2bf(float f) { return (u16)(pack2(f, 0.f) & 0xffffu); }
__device__ __forceinline__ float bf2f(u16 h) { return __uint_as_float(((uint32_t)h) << 16); }
__device__ __forceinline__ float lo2f(uint32_t u) { return __uint_as_float(u << 16); }
__device__ __forceinline__ float hi2f(uint32_t u) { return __uint_as_float(u & 0xffff0000u); }
__device__ __forceinline__ float fexp(float x) { return __builtin_amdgcn_exp2f(x * 1.4426950408889634f); }
__device__ __forceinline__ float frcp(float x) { return __builtin_amdgcn_rcpf(x); }
__device__ __forceinline__ float flog(float x) { return __builtin_amdgcn_logf(x) * 0.6931471805599453f; }
__device__ __forceinline__ float siluf(float x) { return x * frcp(1.f + fexp(-x)); }
__device__ __forceinline__ float sigmf(float x) { return frcp(1.f + fexp(-x)); }
__device__ __forceinline__ float logf_gate(float x, float lb) {
  float xc = fmaxf(x, -80.f);
  float e = fexp(-xc);
  float omf = (1.f - lb) * e * frcp(1.f + e);
  float lf = flog(1.f - omf);
  lf = (lb == 0.f && x < -15.f) ? x : lf;
  return lf;
}
__device__ __forceinline__ float neg_expm1(float lf) {
  return (lf > -0.02f) ? -lf * (1.f + lf * (0.5f + lf * 0.16666667f)) : 1.f - fexp(lf);
}
__device__ __forceinline__ int otid() { int t = threadIdx.x; asm volatile("" : "+v"(t)); return t; }

union Frag {
  bf16x8 v;
  uint4 q;
  uint2 h[2];
  uint32_t w[4];
};

__device__ __forceinline__ int lds_byte(int r, int c) {
  int st = (r >> 4) * 2 + (c >> 5), rr = r & 15, cc = c & 31, ob = rr * 64 + cc * 2;
  return st * 1024 + (ob ^ (((ob >> 9) & 1) << 5));
}

template <int TM>
__device__ __forceinline__ void gemm_kloop(const u16* __restrict__ X, int ldx, const u16* __restrict__ Y, int ldy,
                                           int K, f32x4 (&acc)[4][TM / 32], char* lds) {
  constexpr int NX = TM / 64;
  constexpr int XT = TM / 32;
  constexpr int STAGE = TM * 128 + 32768;
  const int tid = otid(), lane = tid & 63, wid = tid >> 6, wr = wid >> 2, wc = wid & 3, fr = lane & 15, fq = lane >> 4;
#pragma unroll
  for (int a = 0; a < 4; ++a)
#pragma unroll
    for (int b = 0; b < XT; ++b) acc[a][b] = f32x4{0.f, 0.f, 0.f, 0.f};
  uint4 xr[NX], yr[4];
  const int nk = K >> 6;
  const int lrow = tid >> 3, lc8 = (tid & 7) * 8;
  const u16* xg = X + (size_t)lrow * ldx + lc8;
  const u16* yg = Y + (size_t)lrow * ldy + lc8;
  const int loff = lds_byte(lrow, lc8);
#pragma unroll
  for (int i = 0; i < NX; ++i) xr[i] = *(const uint4*)(xg + (size_t)(64 * i) * ldx);
#pragma unroll
  for (int i = 0; i < 4; ++i) yr[i] = *(const uint4*)(yg + (size_t)(64 * i) * ldy);
#pragma unroll
  for (int i = 0; i < NX; ++i) *(uint4*)(lds + loff + 8192 * i) = xr[i];
#pragma unroll
  for (int i = 0; i < 4; ++i) *(uint4*)(lds + TM * 128 + loff + 8192 * i) = yr[i];
  __syncthreads();
  for (int kt = 0; kt < nk; ++kt) {
    char* cur = lds + (kt & 1) * STAGE;
    char* nxt = lds + ((kt + 1) & 1) * STAGE;
    const bool more = (kt + 1 < nk);
    if (more) {
#pragma unroll
      for (int i = 0; i < NX; ++i) xr[i] = *(const uint4*)(xg + (size_t)(64 * i) * ldx + (kt + 1) * 64);
#pragma unroll
      for (int i = 0; i < 4; ++i) yr[i] = *(const uint4*)(yg + (size_t)(64 * i) * ldy + (kt + 1) * 64);
    }
#pragma unroll
    for (int ks = 0; ks < 2; ++ks) {
      Frag yf[4], xf[XT];
#pragma unroll
      for (int a = 0; a < 4; ++a) yf[a].q = *(const uint4*)(cur + TM * 128 + lds_byte(wc * 64 + a * 16 + fr, ks * 32 + fq * 8));
#pragma unroll
      for (int b = 0; b < XT; ++b) xf[b].q = *(const uint4*)(cur + lds_byte(wr * (TM / 2) + b * 16 + fr, ks * 32 + fq * 8));
#pragma unroll
      for (int a = 0; a < 4; ++a)
#pragma unroll
        for (int b = 0; b < XT; ++b) acc[a][b] = MFMA(yf[a].v, xf[b].v, acc[a][b]);
    }
    if (more) {
#pragma unroll
      for (int i = 0; i < NX; ++i) *(uint4*)(nxt + loff + 8192 * i) = xr[i];
#pragma unroll
      for (int i = 0; i < 4; ++i) *(uint4*)(nxt + TM * 128 + loff + 8192 * i) = yr[i];
    }
    __syncthreads();
  }
}

#define LAS __attribute__((address_space(3)))
constexpr int HTB = 128 * 64 * 2;
constexpr int G8_STAGE_BYTES = 8 * HTB;
__device__ __forceinline__ void stage_rc(int b, int& R, int& C) {
  const int st = b / 1024, sb = b % 1024, swz = sb ^ (((sb >> 9) & 1) << 5);
  R = (st >> 1) * 16 + swz / 64; C = (st & 1) * 32 + (swz % 64) / 2;
}
struct Unit { const char* a; const char* b; int x; int y; int lda; int ldb; int nt; int perm = 0; };
struct OneUnit {
  Unit u; int reps = 1;
  __device__ __forceinline__ bool next(int i, Unit& o) const { if (i >= reps) return false; o = u; return true; }
};
template <class Epi, class Sched>
__device__ __forceinline__ void gemm_phase(LAS unsigned char* lds, const Sched& S, const Epi& E) {
  const int tid = otid(), wid = __builtin_amdgcn_readfirstlane(tid >> 6), lane = tid & 63, wr = wid >> 2, wc = wid & 3, fr = lane & 15, fq = lane >> 4;
  int sR[2], sC[2];
#pragma unroll
  for (int i = 0; i < 2; ++i) stage_rc(tid * 16 + i * 8192, sR[i], sC[i]);
  int sRp[2];
#pragma unroll
  for (int i = 0; i < 2; ++i) { const int rho = sR[i] & 31, n_ = rho >> 4, i_ = rho & 15; sRp[i] = (sR[i] & ~31) + 8 * (i_ >> 2) + 4 * n_ + (i_ & 3); }
  const size_t kstep = 128;
  const unsigned ldsw = (unsigned)wid * 1024u;
  const int aoff = lds_byte(wr * 64 + fr, fq * 8), boff = lds_byte(wc * 32 + fr, fq * 8);
#define G8_SA(b, h) (((b) * 2 + (h)) * HTB)
#define G8_SB(b, h) ((4 + (b) * 2 + (h)) * HTB)
#define G8_STAGE(bufoff, gbase, voff) do { _Pragma("unroll") for (int _i = 0; _i < 2; ++_i) \
    __builtin_amdgcn_global_load_lds((const unsigned*)((const char*)(gbase) + (voff)[_i]), (LAS unsigned*)(lds + (bufoff) + ldsw + _i * 8192), 16, 0, 0); } while (0)
#define G8_LDA(dst, b, h) do { _Pragma("unroll") for (int m = 0; m < 4; ++m) _Pragma("unroll") for (int k = 0; k < 2; ++k) dst[m][k] = *(const LAS bf16x8*)(lds + G8_SA(b, h) + aoff + m * 2048 + k * 1024); } while (0)
#define G8_LDB(dst, b, h) do { _Pragma("unroll") for (int n = 0; n < 2; ++n) _Pragma("unroll") for (int k = 0; k < 2; ++k) dst[n][k] = *(const LAS bf16x8*)(lds + G8_SB(b, h) + boff + n * 2048 + k * 1024); } while (0)
#define G8_MMA(ai, bj, At, Bt) do { __builtin_amdgcn_s_setprio(1); _Pragma("unroll") for (int m = 0; m < 4; ++m) _Pragma("unroll") for (int n = 0; n < 2; ++n) _Pragma("unroll") for (int k = 0; k < 2; ++k) \
    acc[ai][bj][m][n] = __builtin_amdgcn_mfma_f32_16x16x32_bf16(Bt[n][k], At[m][k], acc[ai][bj][m][n], 0, 0, 0); __builtin_amdgcn_s_setprio(0); } while (0)
#define G8_WAIT_V(n) asm volatile("s_waitcnt vmcnt(" #n ")" ::: "memory")
#define G8_WAIT_L(n) asm volatile("s_waitcnt lgkmcnt(" #n ")" ::: "memory")
#define G8_BAR __builtin_amdgcn_s_barrier()
#define G8_SCHED __builtin_amdgcn_sched_barrier(0)
  Unit cur, nxt; int ui = 0;
  if (!S.next(0, cur)) return;
  f32x4 acc[2][2][4][2];
#pragma unroll
  for (int a = 0; a < 2; ++a)
#pragma unroll
    for (int b = 0; b < 2; ++b)
#pragma unroll
      for (int m = 0; m < 4; ++m)
#pragma unroll
        for (int n = 0; n < 2; ++n) acc[a][b][m][n] = f32x4{0.f, 0.f, 0.f, 0.f};
  bf16x8 At[4][2], B0[2][2], B1[2][2];
  const char* cA = cur.a; const char* cB = cur.b;
  unsigned voffA[2], voffB[2];
#pragma unroll
  for (int i = 0; i < 2; ++i) { voffA[i] = (unsigned)(sR[i] * cur.lda + sC[i]) * 2u; voffB[i] = (unsigned)((cur.perm ? sRp[i] : sR[i]) * cur.ldb + sC[i]) * 2u; }
  size_t hstepA = (size_t)128 * cur.lda * 2, hstepB = (size_t)128 * cur.ldb * 2;
  G8_STAGE(G8_SB(0, 0), cB, voffB); G8_STAGE(G8_SA(0, 0), cA, voffA); G8_STAGE(G8_SB(0, 1), cB + hstepB, voffB); G8_STAGE(G8_SA(0, 1), cA + hstepA, voffA);
  if (wr == 1) G8_BAR;
  G8_WAIT_V(4); G8_BAR;
  G8_STAGE(G8_SB(1, 0), cB + kstep, voffB); G8_STAGE(G8_SA(1, 0), cA + kstep, voffA); G8_STAGE(G8_SB(1, 1), cB + hstepB + kstep, voffB);
  G8_WAIT_V(6); G8_BAR;
  for (;;) {
    const bool has_next = S.next(ui + 1, nxt);
    if (!has_next) nxt = cur;
    const char* nA = nxt.a; const char* nB = nxt.b;
    unsigned voffAn[2], voffBn[2];
#pragma unroll
    for (int i = 0; i < 2; ++i) { voffAn[i] = (unsigned)(sR[i] * nxt.lda + sC[i]) * 2u; voffBn[i] = (unsigned)((nxt.perm ? sRp[i] : sR[i]) * nxt.ldb + sC[i]) * 2u; }
    const size_t hstepAn = (size_t)128 * nxt.lda * 2, hstepBn = (size_t)128 * nxt.ldb * 2;
    const int nt = cur.nt;
    for (int t = 0; t < nt; t += 2) {
      const bool last = (t == nt - 2);
      const char* a1 = cA + (size_t)(t + 1) * kstep;
      const char* a2 = last ? nA : cA + (size_t)(t + 2) * kstep; const char* b2 = last ? nB : cB + (size_t)(t + 2) * kstep;
      const char* a3 = a2 + kstep; const char* b3 = b2 + kstep;
      unsigned vA2[2], vB2[2];
#pragma unroll
      for (int i = 0; i < 2; ++i) { vA2[i] = last ? voffAn[i] : voffA[i]; vB2[i] = last ? voffBn[i] : voffB[i]; }
      const size_t hA2 = last ? hstepAn : hstepA, hB2 = last ? hstepBn : hstepB;
      G8_LDB(B0, 0, 0); G8_SCHED; G8_LDA(At, 0, 0); G8_STAGE(G8_SA(1, 1), a1 + hstepA, voffA);
      G8_WAIT_L(8); G8_BAR; G8_WAIT_L(0); G8_MMA(0, 0, At, B0); G8_BAR; G8_SCHED;
      G8_LDB(B1, 0, 1); G8_STAGE(G8_SB(0, 0), b2, vB2);
      G8_BAR; G8_WAIT_L(0); G8_MMA(0, 1, At, B1); G8_BAR;
      G8_LDA(At, 0, 1); G8_STAGE(G8_SA(0, 0), a2, vA2);
      G8_BAR; G8_WAIT_L(0); G8_MMA(1, 0, At, B0); G8_BAR; G8_SCHED;
      G8_STAGE(G8_SB(0, 1), b2 + hB2, vB2);
      G8_WAIT_V(6); G8_BAR; G8_MMA(1, 1, At, B1); G8_BAR;
      G8_LDB(B0, 1, 0); G8_SCHED; G8_LDA(At, 1, 0); G8_STAGE(G8_SA(0, 1), a2 + hA2, vA2);
      G8_WAIT_L(8); G8_BAR; G8_WAIT_L(0); G8_MMA(0, 0, At, B0); G8_BAR; G8_SCHED;
      G8_LDB(B1, 1, 1); G8_STAGE(G8_SB(1, 0), b3, vB2);
      G8_BAR; G8_WAIT_L(0); G8_MMA(0, 1, At, B1); G8_BAR;
      G8_LDA(At, 1, 1); G8_STAGE(G8_SA(1, 0), a3, vA2);
      G8_BAR; G8_WAIT_L(0); G8_MMA(1, 0, At, B0); G8_BAR; G8_SCHED;
      G8_STAGE(G8_SB(1, 1), b3 + hB2, vB2);
      G8_WAIT_V(6); G8_BAR; G8_MMA(1, 1, At, B1); G8_BAR;
    }
    E(acc, cur, wr, wc, fr, fq, lds);
    if (!has_next) break;
#pragma unroll
    for (int a = 0; a < 2; ++a)
#pragma unroll
      for (int b = 0; b < 2; ++b)
#pragma unroll
        for (int m = 0; m < 4; ++m)
#pragma unroll
          for (int n = 0; n < 2; ++n) acc[a][b][m][n] = f32x4{0.f, 0.f, 0.f, 0.f};
    cur = nxt; cA = nA; cB = nB; ++ui;
#pragma unroll
    for (int i = 0; i < 2; ++i) { voffA[i] = voffAn[i]; voffB[i] = voffBn[i]; }
    hstepA = hstepAn; hstepB = hstepBn;
  }
  G8_WAIT_V(0);
  if (wr == 0) G8_BAR;
  G8_BAR;
}

__device__ __forceinline__ void p0_mod16(const Params& p, int item, char* lds) {
  const int tid = otid();
  float* sc = (float*)lds;
  float* red = sc + 3072;
  const int l = item / 192, cgp = item % 192;
  const float* cctx = p.in[6]; const float* cc2 = p.in[2];
  for (int i = tid; i < 3072; i += 512) {
    int j = i >> 10, k = i & 1023;
    float c = (j == 0) ? cctx[k] : cc2[(j > 0 ? j - 1 : 0) * 1024 + k];
    sc[i] = c / (1.f + expf(-c));
  }
  __syncthreads();
  const int col = tid & 15, kg = tid >> 4;
  const float* W = p.in[7] + (size_t)l * 1024 * 3072 + cgp * 16 + col;
  float a0 = 0.f, a1 = 0.f, a2 = 0.f;
#pragma unroll 8
  for (int k = kg * 32; k < kg * 32 + 32; ++k) {
    float w = W[(size_t)k * 3072];
    a0 += sc[k] * w; a1 += sc[1024 + k] * w; a2 += sc[2048 + k] * w;
  }
  red[(kg * 3 + 0) * 16 + col] = a0; red[(kg * 3 + 1) * 16 + col] = a1; red[(kg * 3 + 2) * 16 + col] = a2;
  __syncthreads();
  if (tid < 48) {
    const int j = tid >> 4; float s_ = 0.f;
    for (int g = 0; g < 32; ++g) s_ += red[(g * 3 + j) * 16 + col];
    const int n = cgp * 16 + col;
    ((float*)(p.ws + OFF_MOD))[(l * 3 + j) * 3072 + n] = s_ + p.in[8][l * 3072 + n];
  }
  __syncthreads();
}

__device__ __forceinline__ void p0_item(const Params& p, int item, char* lds) {
  const int tid = otid();
  char* ws = p.ws;
  if (item < 96) {
    float* sc = (float*)lds;
    float* red = sc + 3072;
    const int l = item / 48, cgp = item % 48;
    const float* cctx = p.in[6]; const float* cc2 = p.in[2];
    for (int i = tid; i < 3072; i += 512) {
      int j = i >> 10, k = i & 1023;
      float c = (j == 0) ? cctx[k] : cc2[(j > 0 ? j - 1 : 0) * 1024 + k];
      sc[i] = siluf(c);
    }
    __syncthreads();
    const int col = tid & 63, kg = tid >> 6;
    const float* W = p.in[7] + (size_t)l * 1024 * 3072 + cgp * 64 + col;
    float a0 = 0.f, a1 = 0.f, a2 = 0.f;
    for (int k = kg * 128; k < kg * 128 + 128; ++k) {
      float w = W[(size_t)k * 3072];
      a0 += sc[k] * w; a1 += sc[1024 + k] * w; a2 += sc[2048 + k] * w;
    }
    red[(kg * 3 + 0) * 64 + col] = a0; red[(kg * 3 + 1) * 64 + col] = a1; red[(kg * 3 + 2) * 64 + col] = a2;
    __syncthreads();
    if (tid < 192) {
      int j = tid >> 6; float s = 0.f;
      for (int g = 0; g < 8; ++g) s += red[(g * 3 + j) * 64 + col];
      int n = cgp * 64 + col;
      ((float*)(ws + OFF_MOD))[(l * 3 + j) * 3072 + n] = s + p.in[8][l * 3072 + n];
    }
    __syncthreads();
    return;
  }
  item -= 96;
  if (item < 128) {
    int idx = item * 512 + tid, t = idx >> 5, c = idx & 31, fi = c & 15;
    float pos = (c < 16) ? (float)(t >> 6) : (float)(t & 63);
    float inv = powf(10000.f, -(float)fi / 16.f);
    float ang = pos * inv;
    ((float2*)(ws + OFF_ROPE))[idx] = make_float2(cosf(ang), sinf(ang));
    return;
  }
  item -= 128;
  if (item < 2048) {
    const float2* tab = (const float2*)lds;
    int idx = item * 512 + tid, tp = idx >> 9, k0 = (idx & 511) * 8;
    uint32_t o[4];
    float vv[8];
#pragma unroll
    for (int j = 0; j < 8; ++j) {
      int k = k0 + j; int m = (tp * (k & 2047)) & 2047;
      float2 cs = tab[m];
      vv[j] = (k < 2048) ? cs.x : -cs.y;
    }
#pragma unroll
    for (int j = 0; j < 4; ++j) o[j] = pack2(vv[2 * j], vv[2 * j + 1]);
    *(uint4*)(ws + OFF_DL + (size_t)idx * 16) = make_uint4(o[0], o[1], o[2], o[3]);
    return;
  }
  item -= 2048;
  if (item < 32) {
    int idx = item * 512 + tid, tp = idx >> 6, k0 = (idx & 63) * 8;
    uint32_t o[4];
    float vv[8];
#pragma unroll
    for (int j = 0; j < 8; ++j) {
      int k = k0 + j; int m = (tp * (k & 255)) & 255; float s, c;
      sincospif((float)m * (1.f / 128.f), &s, &c);
      vv[j] = (k < 256) ? c : -s;
    }
#pragma unroll
    for (int j = 0; j < 4; ++j) o[j] = pack2(vv[2 * j], vv[2 * j + 1]);
    *(uint4*)(ws + OFF_DC + (size_t)idx * 16) = make_uint4(o[0], o[1], o[2], o[3]);
    return;
  }
  item -= 32;
  if (item < 8) {
    int idx = item * 512 + tid, j = idx >> 4, c0 = (idx & 15) * 8;
    uint32_t o[4];
    float vv[8];
#pragma unroll
    for (int q = 0; q < 8; ++q) {
      int m = ((j & 127) * (c0 + q)) & 127; float s, c;
      sincospif((float)m * (1.f / 64.f), &s, &c);
      vv[q] = (j < 128) ? c : s;
    }
#pragma unroll
    for (int q = 0; q < 4; ++q) o[q] = pack2(vv[2 * q], vv[2 * q + 1]);
    *(uint4*)(ws + OFF_B1 + (size_t)idx * 16) = make_uint4(o[0], o[1], o[2], o[3]);
    return;
  }
  item -= 8;
  if (item < 128) {
    int idx = item * 512 + tid; int e = idx * 8;
    int n = e & 511, t = (e >> 9) & 255, l = (e >> 17) & 1, b = e >> 18;
    const float4* s = (const float4*)(p.in[3] + e);
    float4 a = s[0], c = s[1];
    size_t d = ((size_t)((l * 2 + b) * 256 + t)) * 512 + n;
    *(uint4*)(ws + OFF_KC + d * 2) = make_uint4(pack2(a.x, a.y), pack2(a.z, a.w), pack2(c.x, c.y), pack2(c.z, c.w));
    return;
  }
  item -= 128;
  {
    int idx = item * 512 + tid;
    int v = idx & 127, tc = (idx >> 7) & 31, h = (idx >> 12) & 3, b = (idx >> 14) & 1, l = idx >> 15;
    float vv[8];
#pragma unroll
    for (int j = 0; j < 8; ++j) vv[j] = p.in[4][((size_t)((b * 2 + l) * 256 + tc * 8 + j)) * 512 + h * 128 + v];
    size_t d = ((size_t)((b * 4 + h) * 128 + v)) * 2304 + 2048 + tc * 8;
    *(uint4*)(ws + OFF_VTL + l * SZ_VTL + d * 2) = make_uint4(pack2(vv[0], vv[1]), pack2(vv[2], vv[3]), pack2(vv[4], vv[5]), pack2(vv[6], vv[7]));
  }
}
constexpr int P0_ITEMS = 96 + 128 + 2048 + 32 + 8 + 128 + 128;

__device__ __forceinline__ void p1_item(const Params& p, int l, int item, char* lds) {
  const int tid = otid();
  char* ws = p.ws;
  if (item < 2816) {
    const float* src; int lsrc; u16* dst; int ldd; int kt, nt;
    const float* w10 = p.in[10]; const float* w17 = p.in[17]; const float* w18 = p.in[18]; const float* w19 = p.in[19]; const float* w20 = p.in[20];
    if (item < 2176) { src = w10 + (size_t)l * 1024 * 8704; lsrc = 8704; dst = (u16*)(ws + OFF_WIN); ldd = 1024; nt = item >> 4; kt = item & 15; }
    else if (item < 2560) { int r = item - 2176; int j = r >> 7; r &= 127; src = ((j == 0) ? w17 : ((j == 1) ? w18 : w19)) + (size_t)l * 512 * 1024; lsrc = 1024; dst = (u16*)(ws + OFF_WBR) + (size_t)j * 1024 * 512; ldd = 512; nt = r >> 3; kt = r & 7; }
    else { int r = item - 2560; src = w20 + (size_t)l * 1024 * 1024; lsrc = 1024; dst = (u16*)(ws + OFF_WO); ldd = 1024; nt = r >> 4; kt = r & 15; }
    u16* T = (u16*)lds;
    const int k0 = kt * 64, n0 = nt * 64;
#pragma unroll
    for (int ps = 0; ps < 2; ++ps) {
      int kr = (tid >> 4) + 32 * ps, nq = tid & 15;
      float4 v = *(const float4*)(src + (size_t)(k0 + kr) * lsrc + n0 + 4 * nq);
      T[(4 * nq + 0) * 72 + kr] = f2bf(v.x); T[(4 * nq + 1) * 72 + kr] = f2bf(v.y);
      T[(4 * nq + 2) * 72 + kr] = f2bf(v.z); T[(4 * nq + 3) * 72 + kr] = f2bf(v.w);
    }
    __syncthreads();
    {
      int n = tid >> 3, kc = tid & 7;
      uint4 o = *(const uint4*)(T + n * 72 + kc * 8);
      *(uint4*)(dst + (size_t)(n0 + n) * ldd + k0 + kc * 8) = o;
    }
    __syncthreads();
    return;
  }
  item -= 2816;
  const int lane = tid & 63, wid = tid >> 6;
  const float* modp = (const float*)(ws + OFF_MOD);
  u16* H = (u16*)(ws + OFF_H);
  const float* xin0 = p.in[0]; const float* xin1 = p.in[1]; const float* xin2 = p.out; const float* ng = p.in[9];
#pragma unroll
  for (int rr = 0; rr < 2; ++rr) {
    int r = item * 16 + wid * 2 + rr;
    const float* x = (l == 0) ? ((r < NCTX) ? xin0 + (size_t)r * 1024 : xin1 + (size_t)(r - NCTX) * 1024) : xin2 + (size_t)r * 1024;
    int ci = (r < NCTX) ? 0 : 1 + ((r - NCTX) >> 11);
    float4 v[4]; float ss = 0.f;
#pragma unroll
    for (int i = 0; i < 4; ++i) { v[i] = *(const float4*)(x + lane * 4 + 256 * i); ss += v[i].x * v[i].x + v[i].y * v[i].y + v[i].z * v[i].z + v[i].w * v[i].w; }
#pragma unroll
    for (int o = 32; o >= 1; o >>= 1) ss += __shfl_xor(ss, o);
    float rinv = rsqrtf(ss * (1.f / 1024.f) + EPSV);
    const float* sh = modp + (l * 3 + ci) * 3072;
#pragma unroll
    for (int i = 0; i < 4; ++i) {
      int col = lane * 4 + 256 * i;
      float4 g = *(const float4*)(ng + l * 1024 + col);
      float4 s1 = *(const float4*)(sh + 1024 + col);
      float4 s0 = *(const float4*)(sh + col);
      float a = v[i].x * rinv * g.x * (1.f + s1.x) + s0.x;
      float b = v[i].y * rinv * g.y * (1.f + s1.y) + s0.y;
      float c = v[i].z * rinv * g.z * (1.f + s1.z) + s0.z;
      float d = v[i].w * rinv * g.w * (1.f + s1.w) + s0.w;
      *(uint2*)(H + (size_t)r * 1024 + col) = make_uint2(pack2(a, b), pack2(c, d));
    }
  }
}
constexpr int P1_ITEMS = 2816 + 768;

__device__ __forceinline__ void stagger_us(int us) {
  const unsigned long long t0 = __builtin_amdgcn_s_memrealtime();
  while (__builtin_amdgcn_s_memrealtime() - t0 < (unsigned long long)us * 100ull) __builtin_amdgcn_s_sleep(8);
}
#define STAGGER_US 0
struct P2Sched {
  const char* H; const char* W; int G, c;
  __device__ __forceinline__ bool next(int i, Unit& u) const {
    const int L = i * G + c;
    if (L >= 1024) return false;
    if (L < 960) {
      const int nM = 48, nN = 20, nwg = 960;
      int wgid = L; { const int q = nwg / 8, xcd = wgid % 8, off = wgid / 8; wgid = xcd * q + off; }
      const int nig = 8 * nN, gid = wgid / nig, fm = gid * 8, gsz = (nM - fm) < 8 ? (nM - fm) : 8;
      int pm = fm + ((wgid % nig) % gsz), pn = (wgid % nig) / gsz;
      if (pn >= 14) pn += 2;
      u.a = H + (size_t)pm * 256 * 2048; u.b = W + (size_t)pn * 256 * 2048; u.x = pm; u.y = pn;
      u.lda = 1024; u.ldb = 1024; u.nt = 16; u.perm = ((pn >> 1) == 5 || (pn >> 1) == 6) ? 0 : 1;
    } else {
      const int r = L - 960; const int vq = r / 48, mt = r % 48;
      u.a = W + (size_t)(3584 + vq * 256) * 2048; u.b = H + (size_t)mt * 256 * 2048; u.x = vq; u.y = mt | 0x100;
      u.lda = 1024; u.ldb = 1024; u.nt = 16; u.perm = 0;
    }
    return true;
  }
};
struct P2Epi {
  const float* const* pin; float* out; char* ws; int l;
  const float* hlb; const float* qng; const float* kng; bool skip;
  __device__ __forceinline__ void operator()(f32x4 (&acc)[2][2][4][2], const Unit& u, int wr, int wc, int fr, int fq, LAS unsigned char* lds) const {
    if (skip) return;
    { const int t_ = otid(); const int w_ = t_ >> 6; wr = w_ >> 2; wc = w_ & 3; fr = t_ & 15; fq = (t_ & 63) >> 4; }
    if (u.y & 0x100) {
      const int mt = u.y & 0xff, vq = u.x;
#pragma unroll
      for (int ai = 0; ai < 2; ++ai)
#pragma unroll
        for (int m = 0; m < 4; ++m) {
          const int nn = vq * 256 + ai * 128 + wr * 64 + m * 16 + fr;
          const int hh = nn >> 7, v = nn & 127;
#pragma unroll
          for (int bj = 0; bj < 2; ++bj)
#pragma unroll
            for (int n = 0; n < 2; ++n) {
              const int tokl = bj * 128 + wc * 32 + n * 16 + 4 * fq;
              f32x4 a4 = acc[ai][bj][m][n];
              uint2 pk = make_uint2(pack2(a4[0], a4[1]), pack2(a4[2], a4[3]));
              if (mt < 32) {
                *(uint2*)(ws + OFF_VTC + ((size_t)((mt * 4 + hh) * 128 + v) * 256 + tokl) * 2) = pk;
                float* o = out + OCV + ((size_t)((mt * 2 + l) * 256 + tokl)) * 512 + nn;
                o[0] = a4[0]; o[512] = a4[1]; o[1024] = a4[2]; o[1536] = a4[3];
              } else {
                int rp = (mt - 32) * 256 + tokl; int bb = rp >> 11, t = rp & 2047;
                *(uint2*)(ws + OFF_VTL + l * SZ_VTL + ((size_t)((bb * 4 + hh) * 128 + v) * 2304 + t) * 2) = pk;
              }
            }
        }
      return;
    }
    const int pm = u.x, pn = u.y, seg = pn >> 1, ncol0 = (pn & 1) * 256;
    const int dcol0 = ((seg < 7) ? seg : seg - 1) * 512 + ncol0;
    u16* proj = (u16*)(ws + OFF_PROJ);
    const bool lat = (pm >= 32);
    if (seg == 5 || seg == 6) {
      float* xch = (float*)(lds + G8_STAGE_BYTES);
#pragma unroll
      for (int ai = 0; ai < 2; ++ai)
#pragma unroll
        for (int m = 0; m < 4; ++m)
#pragma unroll
          for (int bj = 0; bj < 2; ++bj) {
            float ss = 0.f;
#pragma unroll
            for (int n = 0; n < 2; ++n)
#pragma unroll
              for (int e = 0; e < 4; ++e) { float bfv = bf2f(f2bf(acc[ai][bj][m][n][e])); ss += bfv * bfv; }
            ss += __shfl_xor(ss, 16); ss += __shfl_xor(ss, 32);
            if (fq == 0) xch[((ai * 128 + wr * 64 + m * 16 + fr) * 2 + bj) * 4 + wc] = ss;
          }
      asm volatile("s_waitcnt lgkmcnt(0)" ::: "memory");
      __builtin_amdgcn_s_barrier();
      asm volatile("" ::: "memory");
      const float* gsel = (seg == 5) ? qng : kng;
      float gv[2][4];
#pragma unroll
      for (int n = 0; n < 2; ++n)
#pragma unroll
        for (int e = 0; e < 4; ++e) gv[n][e] = gsel[l * 64 + 32 * (wc & 1) + 16 * n + 4 * fq + e];
#pragma unroll
      for (int ai = 0; ai < 2; ++ai)
#pragma unroll
        for (int m = 0; m < 4; ++m) {
          const int rl = ai * 128 + wr * 64 + m * 16 + fr;
          const int grow = pm * 256 + rl;
#pragma unroll
          for (int bj = 0; bj < 2; ++bj) {
            const float2 pr = *(const float2*)&xch[(rl * 2 + bj) * 4 + (wc & 2)];
            const float tot = pr.x + pr.y;
            const float rinv = rsqrtf(tot * (1.f / 64.f) + EPSV);
            float x[2][4];
#pragma unroll
            for (int n = 0; n < 2; ++n)
#pragma unroll
              for (int e = 0; e < 4; ++e) x[n][e] = bf2f(f2bf(acc[ai][bj][m][n][e])) * rinv * gv[n][e];
            const int colt = ncol0 + bj * 128 + wc * 32;
            if (seg == 6 && !lat) {
              float* o = out + OCK + ((size_t)((pm * 2 + l) * 256 + rl)) * 512 + colt + 4 * fq;
              *(float4*)o = make_float4(x[0][0], x[0][1], x[0][2], x[0][3]);
              *(float4*)(o + 16) = make_float4(x[1][0], x[1][1], x[1][2], x[1][3]);
            }
            if (lat) {
              const int t = (grow - NCTX) & 2047;
              const float2* rt = (const float2*)(ws + OFF_ROPE) + t * 32 + ((wc & 1) ? 16 : 0) + 4 * fq;
#pragma unroll
              for (int e = 0; e < 4; ++e) {
                float2 cs = rt[e];
                float x1 = x[0][e], x2 = x[1][e];
                x[0][e] = x1 * cs.x - x2 * cs.y;
                x[1][e] = x1 * cs.y + x2 * cs.x;
              }
            }
            if (seg == 5) {
#pragma unroll
              for (int n = 0; n < 2; ++n)
#pragma unroll
                for (int e = 0; e < 4; ++e) x[n][e] *= 0.125f;
            }
            u16* dp = proj + (size_t)grow * LDP + dcol0 + bj * 128 + wc * 32 + 4 * fq;
            *(uint2*)dp = make_uint2(pack2(x[0][0], x[0][1]), pack2(x[0][2], x[0][3]));
            *(uint2*)(dp + 16) = make_uint2(pack2(x[1][0], x[1][1]), pack2(x[1][2], x[1][3]));
          }
        }
      return;
    }
    const bool dosilu = (seg == 0 || seg == 4 || seg == 8 || seg == 10);
    const bool dolf = (seg == 1 || seg == 2);
    const int dir = (seg == 2) ? 1 : 0;
#define P2_STORE16(A0, A1) *(uint4*)(proj + (size_t)grow * LDP + dcol0 + bj * 128 + wc * 32 + 8 * fq) = make_uint4(pack2(A0[0], A0[1]), pack2(A0[2], A0[3]), pack2(A1[0], A1[1]), pack2(A1[2], A1[3]))
    if (dosilu) {
#pragma unroll
      for (int ai = 0; ai < 2; ++ai)
#pragma unroll
        for (int m = 0; m < 4; ++m) {
          const int grow = pm * 256 + ai * 128 + wr * 64 + m * 16 + fr;
#pragma unroll
          for (int bj = 0; bj < 2; ++bj) {
            f32x4 a0 = acc[ai][bj][m][0], a1 = acc[ai][bj][m][1];
#pragma unroll
            for (int e = 0; e < 4; ++e) { a0[e] = siluf(a0[e]); a1[e] = siluf(a1[e]); }
            P2_STORE16(a0, a1);
          }
        }
    } else if (dolf) {
#pragma unroll
      for (int bj = 0; bj < 2; ++bj) {
        float lbv[2][4];
#pragma unroll
        for (int n = 0; n < 2; ++n)
#pragma unroll
          for (int e = 0; e < 4; ++e) {
            int j = ncol0 + bj * 128 + wc * 32 + 8 * fq + 4 * n + e;
            lbv[n][e] = (l == 0) ? 0.f : sigmf(hlb[(1 * 2 + dir) * 512 + j] - hlb[(0 * 2 + dir) * 512 + j]);
          }
#pragma unroll
        for (int ai = 0; ai < 2; ++ai)
#pragma unroll
          for (int m = 0; m < 4; ++m) {
            const int grow = pm * 256 + ai * 128 + wr * 64 + m * 16 + fr;
            f32x4 a0 = acc[ai][bj][m][0], a1 = acc[ai][bj][m][1];
#pragma unroll
            for (int e = 0; e < 4; ++e) { a0[e] = logf_gate(a0[e], lbv[0][e]); a1[e] = logf_gate(a1[e], lbv[1][e]); }
            P2_STORE16(a0, a1);
          }
      }
    } else {
#pragma unroll
      for (int ai = 0; ai < 2; ++ai)
#pragma unroll
        for (int m = 0; m < 4; ++m) {
          const int grow = pm * 256 + ai * 128 + wr * 64 + m * 16 + fr;
#pragma unroll
          for (int bj = 0; bj < 2; ++bj) {
            f32x4 a0 = acc[ai][bj][m][0], a1 = acc[ai][bj][m][1];
            P2_STORE16(a0, a1);
          }
        }
    }
  }
};
__device__ __forceinline__ void p2_left_item(const Params& p, int l, int L, char* lds) {
  P2Sched S0; S0.H = p.ws + OFF_H; S0.W = p.ws + OFF_WIN; S0.G = 0x40000000; S0.c = 0;
  OneUnit S;
  {
    const int r = L - 960; const int vq = r / 48, mt = r % 48;
    S.u.a = S0.W + (size_t)(3584 + vq * 256) * 2048; S.u.b = S0.H + (size_t)mt * 256 * 2048; S.u.x = vq; S.u.y = mt | 0x100;
    S.u.lda = 1024; S.u.ldb = 1024; S.u.nt = 16;
  }
  P2Epi E; E.pin = nullptr; E.out = p.out; E.ws = p.ws; E.l = l; E.hlb = p.in[11]; E.qng = p.in[13]; E.kng = p.in[14]; E.skip = false;
  gemm_phase((LAS unsigned char*)lds, S, E);
}
__device__ __forceinline__ void p2_phase(const Params& p, int l, char* lds, bool skip = false) {
  if (STAGGER_US && ((blockIdx.x >> 3) & 1)) stagger_us(STAGGER_US);
  P2Sched S; S.H = p.ws + OFF_H; S.W = p.ws + OFF_WIN; S.G = gridDim.x; S.c = blockIdx.x;
  P2Epi E; E.pin = nullptr; E.out = p.out; E.ws = p.ws; E.l = l; E.hlb = p.in[11]; E.qng = p.in[13]; E.kng = p.in[14]; E.skip = skip;
  gemm_phase((LAS unsigned char*)lds, S, E);
}

struct HgrnLds {
  float tot[4][128];
  float dk[128];
  float osum[16][132];
  u16 qt[16][136];
  u16 kt[16][136];
  u16 khT[128][16];
  u16 vT[128][16];
  u16 zt[16][136];
  u16 obuf[256][136];
};

#define LBAR() do { asm volatile("s_waitcnt lgkmcnt(0)" ::: "memory"); __builtin_amdgcn_s_barrier(); asm volatile("" ::: "memory"); } while (0)
__device__ __forceinline__ void hgrn_pass(const Params& p, int l, int row0, int ntok, int h, int dir, f32x4 (&S)[8],
                                          const bool do_out, const bool second, float& gsum, HgrnLds& L, const bool dry = false) {
  const int tid = otid(), lane = tid & 63, wid = tid >> 6, c16 = lane & 15, g = lane >> 4;
  const int kk = tid & 127, tq = tid >> 7;
  const u16* proj = (const u16*)(p.ws + OFF_PROJ);
  u16* projw = (u16*)(p.ws + OFF_PROJ);
  const int nch = ntok >> 4;
  float4 gg = make_float4(0.f, 0.f, 0.f, 0.f);
  if (second) gg = *(const float4*)(p.in[12] + l * 512 + h * 128 + 4 * (tid & 31));
  u16 lfA[4], qA[4], vA[4], zA[4], lfB[4], qB[4], vB[4], zB[4];
#define HG_LD(c_, LF, QQ, VV, ZZ)                                                    \
  {                                                                                  \
    _Pragma("unroll") for (int i = 0; i < 4; ++i) {                                  \
      int s_ = (c_) * 16 + 4 * tq + i;                                               \
      int tl_ = dir ? (ntok - 1 - s_) : s_;                                          \
      const u16* rp_ = proj + (size_t)(row0 + tl_) * LDP + h * 128 + kk;             \
      LF[i] = rp_[PLF + dir * 512];                                                  \
      VV[i] = rp_[PIA];                                                              \
      QQ[i] = do_out ? rp_[PQA] : (u16)0;                                            \
      ZZ[i] = second ? rp_[PZA] : (u16)0;                                            \
    }                                                                                \
  }
  HG_LD(0, lfA, qA, vA, zA);
  HG_LD(1, lfB, qB, vB, zB);
  auto body = [&](const int c, u16 (&LF)[4], u16 (&QQ)[4], u16 (&VV)[4], u16 (&ZZ)[4]) __attribute__((always_inline)) {
    float lf[4], G[4], qv[4];
    u16 vv[4], zz[4];
#pragma unroll
    for (int i = 0; i < 4; ++i) { lf[i] = bf2f(LF[i]); qv[i] = bf2f(QQ[i]); vv[i] = VV[i]; zz[i] = ZZ[i]; }
    G[0] = lf[0]; G[1] = G[0] + lf[1]; G[2] = G[1] + lf[2]; G[3] = G[2] + lf[3];
    L.tot[tq][kk] = G[3];
    LBAR();
    if (c + 2 < nch) HG_LD(c + 2, LF, QQ, VV, ZZ);
    float t0 = L.tot[0][kk], t1 = L.tot[1][kk], t2 = L.tot[2][kk], t3 = L.tot[3][kk];
    float off = (tq > 0 ? t0 : 0.f) + (tq > 1 ? t1 : 0.f) + (tq > 2 ? t2 : 0.f);
    float gend = t0 + t1 + t2 + t3;
    float kh[4];
#pragma unroll
    for (int i = 0; i < 4; ++i) {
      float Gi = G[i] + off;
      float kv = neg_expm1(lf[i]);
      int s = 4 * tq + i;
      if (do_out) {
        L.qt[s][kk] = f2bf(qv[i] * fexp(Gi));
        L.kt[s][kk] = f2bf(kv * fexp(fminf(-Gi, 80.f)));
      }
      if (second) L.zt[s][kk] = zz[i];
      kh[i] = kv * fexp(gend - Gi);
    }
    *(uint2*)&L.khT[kk][4 * tq] = make_uint2(pack2(kh[0], kh[1]), pack2(kh[2], kh[3]));
    *(uint2*)&L.vT[kk][4 * tq] = make_uint2((uint32_t)vv[0] | ((uint32_t)vv[1] << 16), (uint32_t)vv[2] | ((uint32_t)vv[3] << 16));
    if (tq == 0) { L.dk[kk] = fexp(gend); gsum += gend; }
    LBAR();
    Frag bv;
    bv.h[0] = *(const uint2*)&L.vT[16 * wid + c16][4 * g];
    bv.h[1] = make_uint2(0u, 0u);
    f32x4 o = f32x4{0.f, 0.f, 0.f, 0.f};
    if (do_out) {
      f32x4 at = f32x4{0.f, 0.f, 0.f, 0.f};
#pragma unroll
      for (int ks = 0; ks < 4; ++ks) {
        Frag a, b;
        a.q = *(const uint4*)&L.kt[c16][32 * ks + 8 * g];
        b.q = *(const uint4*)&L.qt[c16][32 * ks + 8 * g];
        at = MFMA(a.v, b.v, at);
      }
      Frag pa;
#pragma unroll
      for (int r = 0; r < 4; ++r) at[r] = (4 * g + r <= c16) ? at[r] : 0.f;
      pa.w[0] = pack2(at[0], at[1]); pa.w[1] = pack2(at[2], at[3]); pa.w[2] = 0u; pa.w[3] = 0u;
      o = MFMA(pa.v, bv.v, o);
#pragma unroll
      for (int st = 0; st < 4; ++st) {
        Frag a, b;
        a.h[0] = *(const uint2*)&L.qt[c16][32 * st + 4 * g];
        a.h[1] = *(const uint2*)&L.qt[c16][32 * st + 16 + 4 * g];
        b.w[0] = pack2(S[2 * st][0], S[2 * st][1]); b.w[1] = pack2(S[2 * st][2], S[2 * st][3]);
        b.w[2] = pack2(S[2 * st + 1][0], S[2 * st + 1][1]); b.w[3] = pack2(S[2 * st + 1][2], S[2 * st + 1][3]);
        o = MFMA(a.v, b.v, o);
      }
    }
#pragma unroll
    for (int k8 = 0; k8 < 8; ++k8) {
      float4 d = *(const float4*)&L.dk[16 * k8 + 4 * g];
      f32x4 s0 = S[k8];
      s0[0] *= d.x; s0[1] *= d.y; s0[2] *= d.z; s0[3] *= d.w;
      Frag a;
      a.h[0] = *(const uint2*)&L.khT[16 * k8 + c16][4 * g];
      a.h[1] = make_uint2(0u, 0u);
      S[k8] = MFMA(a.v, bv.v, s0);
    }
    if (do_out) {
      const int vcol = 16 * wid + c16;
      if (!second) {
#pragma unroll
        for (int r = 0; r < 4; ++r) {
          int s = c * 16 + 4 * g + r;
          int tl = dir ? (ntok - 1 - s) : s;
          L.obuf[tl][vcol] = f2bf(o[r]);
        }
      } else {
#pragma unroll
        for (int r = 0; r < 4; ++r) {
          int s = c * 16 + 4 * g + r;
          int tl = dir ? (ntok - 1 - s) : s;
          L.osum[4 * g + r][vcol] = o[r] + bf2f(L.obuf[tl][vcol]);
        }
        LBAR();
        {
          int sl = tid >> 5, vq = tid & 31;
          int s = c * 16 + sl;
          int tl = dir ? (ntok - 1 - s) : s;
          float4 ov = *(const float4*)&L.osum[sl][4 * vq];
          float ss = ov.x * ov.x + ov.y * ov.y + ov.z * ov.z + ov.w * ov.w;
#pragma unroll
          for (int m = 1; m <= 16; m <<= 1) ss += __shfl_xor(ss, m);
          float rinv = rsqrtf(ss * (1.f / 128.f) + EPSV);
          u16* rp = projw + (size_t)(row0 + tl) * LDP + h * 128 + 4 * vq;
          uint2 z = *(const uint2*)&L.zt[sl][4 * vq];
          float y0 = ov.x * rinv * gg.x * lo2f(z.x), y1 = ov.y * rinv * gg.y * hi2f(z.x);
          float y2 = ov.z * rinv * gg.z * lo2f(z.y), y3 = ov.w * rinv * gg.w * hi2f(z.y);
          if (!dry) *(uint2*)(rp + PQA) = make_uint2(pack2(y0, y1), pack2(y2, y3));
        }
      }
    }
  };
  for (int c = 0; c < nch; c += 2) {
    body(c, lfA, qA, vA, zA);
    body(c + 1, lfB, qB, vB, zB);
  }
  __syncthreads();
}

__device__ __forceinline__ void hgrn_load_state(const float* m, f32x4 (&S)[8]) {
  const int tid_ = otid(); const int lane = tid_ & 63, wid = tid_ >> 6, c16 = lane & 15, g = lane >> 4;
#pragma unroll
  for (int k8 = 0; k8 < 8; ++k8)
#pragma unroll
    for (int r = 0; r < 4; ++r) S[k8][r] = m[(16 * k8 + 4 * g + r) * 128 + 16 * wid + c16];
}
__device__ __forceinline__ void hgrn_store_state(float* m, const f32x4 (&S)[8]) {
  const int tid_ = otid(); const int lane = tid_ & 63, wid = tid_ >> 6, c16 = lane & 15, g = lane >> 4;
#pragma unroll
  for (int k8 = 0; k8 < 8; ++k8)
#pragma unroll
    for (int r = 0; r < 4; ++r) m[(16 * k8 + 4 * g + r) * 128 + 16 * wid + c16] = S[k8][r];
}
__device__ __forceinline__ void hgrn_advance(const float* U, const float* D, f32x4 (&S)[8]) {
  const int tid_ = otid(); const int lane = tid_ & 63, wid = tid_ >> 6, c16 = lane & 15, g = lane >> 4;
#pragma unroll
  for (int k8 = 0; k8 < 8; ++k8)
#pragma unroll
    for (int r = 0; r < 4; ++r) {
      int k = 16 * k8 + 4 * g + r;
      S[k8][r] = D[k] * S[k8][r] + U[k * 128 + 16 * wid + c16];
    }
}

__device__ __forceinline__ void hgrn_ctx_item(const Params& p, int l, int item, char* lds, const bool dry = false) {
  HgrnLds& L = *(HgrnLds*)lds;
  const int b = item >> 2, h = item & 3;
  f32x4 S[8];
  float gsum = 0.f;
#pragma unroll
  for (int i = 0; i < 8; ++i) S[i] = f32x4{0.f, 0.f, 0.f, 0.f};
  hgrn_pass(p, l, b * 256, 256, h, 0, S, true, false, gsum, L, dry);
  if (!dry) hgrn_store_state(p.out + OST + ((size_t)(((b * 2 + l) * 2 + 0) * 4 + h)) * 16384, S);
#pragma unroll
  for (int i = 0; i < 8; ++i) S[i] = f32x4{0.f, 0.f, 0.f, 0.f};
  hgrn_pass(p, l, b * 256, 256, h, 1, S, true, true, gsum, L, dry);
  if (!dry) hgrn_store_state(p.out + OST + ((size_t)(((b * 2 + l) * 2 + 1) * 4 + h)) * 16384, S);
}
__device__ __forceinline__ void hgrn_lat1_item(const Params& p, int l, int item, char* lds) {
  HgrnLds& L = *(HgrnLds*)lds;
  const int seg = item & 15, dir = (item >> 4) & 1, h = (item >> 5) & 3, b = item >> 7;
  f32x4 S[8];
  float gsum = 0.f;
#pragma unroll
  for (int i = 0; i < 8; ++i) S[i] = f32x4{0.f, 0.f, 0.f, 0.f};
  hgrn_pass(p, l, NCTX + b * 2048 + seg * 128, 128, h, dir, S, false, false, gsum, L);
  float* SU = (float*)(p.ws + OFF_SEGU);
  float* SD = (float*)(p.ws + OFF_SEGD);
  {
    const int tq_ = otid(); const int lane_ = tq_ & 63, wid_ = tq_ >> 6, c16_ = lane_ & 15, g_ = lane_ >> 4;
    float* m_ = SU + (size_t)item * 16384;
#pragma unroll
    for (int k8 = 0; k8 < 8; ++k8)
#pragma unroll
      for (int r = 0; r < 4; ++r) __hip_atomic_store(m_ + (16 * k8 + 4 * g_ + r) * 128 + 16 * wid_ + c16_, S[k8][r], __ATOMIC_RELAXED, __HIP_MEMORY_SCOPE_AGENT);
  }
  const int t_ = otid();
  if (t_ < 128) __hip_atomic_store(SD + item * 128 + t_, fexp(gsum), __ATOMIC_RELAXED, __HIP_MEMORY_SCOPE_AGENT);
  volatile int* flag = (volatile int*)(lds + LDS_TILE + 32);
  asm volatile("s_waitcnt vmcnt(0)" ::: "memory");
  __syncthreads();
  if (t_ == 0) {
    unsigned* tk = (unsigned*)(p.ws + OFF_CNT) + 8 + l * 32 + (item >> 4);
    const unsigned old = __hip_atomic_fetch_add(tk, 1u, __ATOMIC_RELAXED, __HIP_MEMORY_SCOPE_AGENT);
    const int last = (old == 15u) ? 1 : 0;
    if (last) { __builtin_amdgcn_fence(__ATOMIC_ACQUIRE, "agent"); asm volatile("s_waitcnt vmcnt(0)" ::: "memory"); }
    *flag = last;
  }
  __syncthreads();
  if (*flag) {
    const int base = (item >> 4) * 16;
    hgrn_load_state(p.in[5] + ((size_t)(((b * 2 + l) * 2 + dir) * 4 + h)) * 16384, S);
    const int lane = t_ & 63, wid = t_ >> 6, c16 = lane & 15, g = lane >> 4;
    float un[8][4]; float4 dn[8];
    {
      const int sg0 = dir ? 15 : 0;
      const float* U0 = SU + (size_t)(base + sg0) * 16384; const float* D0 = SD + (base + sg0) * 128;
#pragma unroll
      for (int k8 = 0; k8 < 8; ++k8) {
        dn[k8] = *(const float4*)(D0 + 16 * k8 + 4 * g);
#pragma unroll
        for (int r = 0; r < 4; ++r) un[k8][r] = U0[(16 * k8 + 4 * g + r) * 128 + 16 * wid + c16];
      }
    }
#pragma unroll 1
    for (int i = 0; i < 16; ++i) {
      const int sg = dir ? (15 - i) : i;
      float* U = SU + (size_t)(base + sg) * 16384;
      float uc[8][4]; float4 dc[8];
#pragma unroll
      for (int k8 = 0; k8 < 8; ++k8) { dc[k8] = dn[k8];
#pragma unroll
        for (int r = 0; r < 4; ++r) uc[k8][r] = un[k8][r]; }
      if (i + 1 < 16) {
        const int sgn = dir ? (14 - i) : (i + 1);
        const float* Un = SU + (size_t)(base + sgn) * 16384; const float* Dn = SD + (base + sgn) * 128;
#pragma unroll
        for (int k8 = 0; k8 < 8; ++k8) {
          dn[k8] = *(const float4*)(Dn + 16 * k8 + 4 * g);
#pragma unroll
          for (int r = 0; r < 4; ++r) un[k8][r] = Un[(16 * k8 + 4 * g + r) * 128 + 16 * wid + c16];
        }
      }
#pragma unroll
      for (int k8 = 0; k8 < 8; ++k8) {
        const float dd[4] = {dc[k8].x, dc[k8].y, dc[k8].z, dc[k8].w};
#pragma unroll
        for (int r = 0; r < 4; ++r) {
          const int idx = (16 * k8 + 4 * g + r) * 128 + 16 * wid + c16;
          U[idx] = S[k8][r];
          S[k8][r] = dd[r] * S[k8][r] + uc[k8][r];
        }
      }
    }
  }
  __syncthreads();
}
__device__ __forceinline__ void hgrn_lat2_item(const Params& p, int l, int item, char* lds, const bool dry = false) {
  HgrnLds& L = *(HgrnLds*)lds;
  const int seg = item & 15, h = (item >> 4) & 3, b = item >> 6;
  const float* SU = (const float*)(p.ws + OFF_SEGU);
  const float* SD = (const float*)(p.ws + OFF_SEGD);
  f32x4 S[8];
  float gsum = 0.f;
  hgrn_load_state(SU + (size_t)(((b * 4 + h) * 2 + 0) * 16 + seg) * 16384, S);
  hgrn_pass(p, l, NCTX + b * 2048 + seg * 128, 128, h, 0, S, true, false, gsum, L, dry);
  hgrn_load_state(SU + (size_t)(((b * 4 + h) * 2 + 1) * 16 + seg) * 16384, S);
  hgrn_pass(p, l, NCTX + b * 2048 + seg * 128, 128, h, 1, S, true, true, gsum, L, dry);
}

__device__ __forceinline__ void attn_item(const Params& p, int l, int item, const bool lat, char* lds, const bool dry = false) {
  const int tid = otid(), lane = tid & 63, wid = tid >> 6, c16 = lane & 15, g = lane >> 4;
  char* ws = p.ws;
  u16* proj = (u16*)(ws + OFF_PROJ);
  int b, h, qb, nkeys, rowbase;
  const u16* Vt; int ldv;
  if (!lat) { qb = item & 1; h = (item >> 1) & 3; b = item >> 3; nkeys = 256; rowbase = b * 256; Vt = (const u16*)(ws + OFF_VTC) + (size_t)((b * 4 + h) * 128) * 256; ldv = 256; }
  else { qb = item & 15; h = (item >> 4) & 3; b = item >> 6; nkeys = 2304; rowbase = NCTX + b * 2048; Vt = (const u16*)(ws + OFF_VTL + l * SZ_VTL) + (size_t)((b * 4 + h) * 128) * 2304; ldv = 2304; }
  const u16* Kc = (const u16*)(ws + OFF_KC) + (size_t)((l * 2 + b) * 256) * 512 + h * 128;
  u16* Ks = (u16*)lds;
  u16* Vs = Ks + 64 * 136;
  float lam_init = 0.8f - 0.6f * expf(-0.3f * (float)l);
  float lam;
  {
    const float* lp = p.in[15] + l * 256;
    float a = lp[lane] * lp[64 + lane], c = lp[128 + lane] * lp[192 + lane];
#pragma unroll
    for (int o = 32; o >= 1; o >>= 1) { a += __shfl_xor(a, o); c += __shfl_xor(c, o); }
    lam = expf(a) - expf(c) + lam_init;
  }
  const int qrow = rowbase + qb * 128 + wid * 16 + c16;
  Frag qf[2][2];
#pragma unroll
  for (int m = 0; m < 2; ++m)
#pragma unroll
    for (int ks = 0; ks < 2; ++ks) qf[m][ks].q = *(const uint4*)(proj + (size_t)qrow * LDP + PQB + h * 128 + m * 64 + ks * 32 + g * 8);
  f32x4 O[2][8];
#pragma unroll
  for (int m = 0; m < 2; ++m)
#pragma unroll
    for (int v = 0; v < 8; ++v) O[m][v] = f32x4{0.f, 0.f, 0.f, 0.f};
  float mrun[2] = {-1e30f, -1e30f}, lsum[2] = {0.f, 0.f};
  uint4 kr0, kr1, vr0, vr1;
#define ATT_LD(kt_)                                                                                           \
  {                                                                                                           \
    const int key0 = (kt_) * 64;                                                                              \
    const bool fromproj = (!lat) || (key0 < 2048);                                                            \
    {                                                                                                         \
      int q = tid; int key = q >> 4, cc = q & 15;                                                             \
      const u16* src = fromproj ? proj + (size_t)(rowbase + key0 + key) * LDP + PKB + h * 128 + cc * 8        \
                                : Kc + (size_t)(key0 - 2048 + key) * 512 + cc * 8;                            \
      kr0 = *(const uint4*)src;                                                                               \
      int v = q >> 3, c8 = q & 7;                                                                             \
      vr0 = *(const uint4*)(Vt + (size_t)v * ldv + key0 + c8 * 8);                                            \
    }                                                                                                         \
    {                                                                                                         \
      int q = tid + 512; int key = q >> 4, cc = q & 15;                                                       \
      const u16* src = fromproj ? proj + (size_t)(rowbase + key0 + key) * LDP + PKB + h * 128 + cc * 8        \
                                : Kc + (size_t)(key0 - 2048 + key) * 512 + cc * 8;                            \
      kr1 = *(const uint4*)src;                                                                               \
      int v = q >> 3, c8 = q & 7;                                                                             \
      vr1 = *(const uint4*)(Vt + (size_t)v * ldv + key0 + c8 * 8);                                            \
    }                                                                                                         \
  }
#define ATT_ST()                                                                                              \
  {                                                                                                           \
    { int q = tid; int key = q >> 4, cc = q & 15; *(uint4*)(Ks + key * 136 + cc * 8) = kr0;                   \
      int v = q >> 3, c8 = q & 7; *(uint4*)(Vs + v * 72 + c8 * 8) = vr0; }                                    \
    { int q = tid + 512; int key = q >> 4, cc = q & 15; *(uint4*)(Ks + key * 136 + cc * 8) = kr1;             \
      int v = q >> 3, c8 = q & 7; *(uint4*)(Vs + v * 72 + c8 * 8) = vr1; }                                    \
  }
  const int nkt = nkeys >> 6;
  ATT_LD(0);
  for (int kt = 0; kt < nkt; ++kt) {
    LBAR();
    ATT_ST();
    LBAR();
    if (kt + 1 < nkt) ATT_LD(kt + 1);
    Frag pf[2][2];
#pragma unroll
    for (int m = 0; m < 2; ++m) {
      f32x4 s[4];
#pragma unroll
      for (int k4 = 0; k4 < 4; ++k4) {
        s[k4] = f32x4{0.f, 0.f, 0.f, 0.f};
#pragma unroll
        for (int ks = 0; ks < 2; ++ks) {
          Frag a;
          a.q = *(const uint4*)(Ks + (16 * k4 + c16) * 136 + m * 64 + ks * 32 + g * 8);
          s[k4] = MFMA(a.v, qf[m][ks].v, s[k4]);
        }
      }
      float mx = -1e30f;
#pragma unroll
      for (int k4 = 0; k4 < 4; ++k4)
#pragma unroll
        for (int r = 0; r < 4; ++r) mx = fmaxf(mx, s[k4][r]);
      mx = fmaxf(mx, __shfl_xor(mx, 16));
      mx = fmaxf(mx, __shfl_xor(mx, 32));
      if (__any(mx - mrun[m] > 4.0f)) {
        const float mnew = fmaxf(mrun[m], mx);
        const float alpha = fexp(mrun[m] - mnew);
        mrun[m] = mnew;
        lsum[m] *= alpha;
#pragma unroll
        for (int v = 0; v < 8; ++v) { O[m][v][0] *= alpha; O[m][v][1] *= alpha; O[m][v][2] *= alpha; O[m][v][3] *= alpha; }
      }
      const float mneg = -mrun[m] * 1.4426950408889634f;
      float ps = 0.f;
#pragma unroll
      for (int k4 = 0; k4 < 4; ++k4)
#pragma unroll
        for (int r = 0; r < 4; ++r) { s[k4][r] = __builtin_amdgcn_exp2f(fmaf(s[k4][r], 1.4426950408889634f, mneg)); ps += s[k4][r]; }
      lsum[m] += ps;
#pragma unroll
      for (int sp = 0; sp < 2; ++sp) {
        pf[m][sp].w[0] = pack2(s[2 * sp][0], s[2 * sp][1]); pf[m][sp].w[1] = pack2(s[2 * sp][2], s[2 * sp][3]);
        pf[m][sp].w[2] = pack2(s[2 * sp + 1][0], s[2 * sp + 1][1]); pf[m][sp].w[3] = pack2(s[2 * sp + 1][2], s[2 * sp + 1][3]);
      }
    }
#pragma unroll
    for (int v = 0; v < 8; ++v)
#pragma unroll
      for (int sp = 0; sp < 2; ++sp) {
        Frag a;
        a.h[0] = *(const uint2*)(Vs + (16 * v + c16) * 72 + 32 * sp + 4 * g);
        a.h[1] = *(const uint2*)(Vs + (16 * v + c16) * 72 + 32 * sp + 16 + 4 * g);
        O[0][v] = MFMA(a.v, pf[0][sp].v, O[0][v]);
        O[1][v] = MFMA(a.v, pf[1][sp].v, O[1][v]);
      }
  }
  float l0 = lsum[0], l1 = lsum[1];
  l0 += __shfl_xor(l0, 16); l0 += __shfl_xor(l0, 32);
  l1 += __shfl_xor(l1, 16); l1 += __shfl_xor(l1, 32);
  const float i0 = 1.f / l0, i1 = lam / l1;
  float ss = 0.f;
#pragma unroll
  for (int v = 0; v < 8; ++v)
#pragma unroll
    for (int r = 0; r < 4; ++r) { float o = O[0][v][r] * i0 - O[1][v][r] * i1; O[0][v][r] = o; ss += o * o; }
  ss += __shfl_xor(ss, 16); ss += __shfl_xor(ss, 32);
  const float rinv = rsqrtf(ss * (1.f / 128.f) + EPSV) * (1.f - lam_init);
  u16* rp = proj + (size_t)qrow * LDP + h * 128;
#pragma unroll
  for (int v = 0; v < 8; ++v) {
    int vc = 16 * v + 4 * g;
    float4 sg = *(const float4*)(p.in[16] + l * 128 + vc);
    uint2 z = *(const uint2*)(rp + PZB + vc);
    float y0 = O[0][v][0] * rinv * sg.x * lo2f(z.x), y1 = O[0][v][1] * rinv * sg.y * hi2f(z.x);
    float y2 = O[0][v][2] * rinv * sg.z * lo2f(z.y), y3 = O[0][v][3] * rinv * sg.w * hi2f(z.y);
    if (!dry) *(uint2*)(rp + PQB + vc) = make_uint2(pack2(y0, y1), pack2(y2, y3));
  }
  __syncthreads();
}

__device__ __forceinline__ void f1_item(const Params& p, int item, char* lds) {
  const int tid = otid(), lane = tid & 63, wid = tid >> 6, wr = wid >> 2, wc = wid & 3, fr = lane & 15, fq = lane >> 4;
  char* ws = p.ws;
  const int jh = item & 1, gq = (item >> 1) & 3, mt = item >> 3;
  f32x4 acc[4][4];
  gemm_kloop<128>((const u16*)(ws + OFF_B1) + jh * 128 * 128, 128, (const u16*)(ws + OFF_PROJ) + (size_t)(mt * 256) * LDP + PUC + gq * 128, LDP, 128, acc, lds);
#pragma unroll
  for (int a = 0; a < 4; ++a)
#pragma unroll
    for (int b = 0; b < 4; ++b) {
      int tokl = wc * 64 + a * 16 + 4 * fq;
      int jj = wr * 64 + b * 16 + fr;
      uint2 pk = make_uint2(pack2(acc[a][b][0], acc[a][b][1]), pack2(acc[a][b][2], acc[a][b][3]));
      if (mt < 32) {
        *(uint2*)(ws + OFF_PTC + ((size_t)((mt * 4 + gq) * 128 + jj) * 512 + jh * 256 + tokl) * 2) = pk;
      } else {
        int rp = (mt - 32) * 256 + tokl; int bb = rp >> 11, t = rp & 2047;
        *(uint2*)(ws + OFF_PTL + ((size_t)((bb * 4 + gq) * 128 + jj) * 4096 + jh * 2048 + t) * 2) = pk;
      }
    }
}

struct F2Epi {
  char* ws; float scl; int rowbase_mul;
  bool lat;
  __device__ __forceinline__ void operator()(f32x4 (&acc)[2][2][4][2], const Unit& u, int wr, int wc, int fr, int fq, LAS unsigned char* lds) const {
    u16* proj = (u16*)(ws + OFF_PROJ);
#pragma unroll
    for (int ai = 0; ai < 2; ++ai)
#pragma unroll
      for (int mh = 0; mh < 2; ++mh) {
        uint2 zv[2][2][2];
#pragma unroll
        for (int mm = 0; mm < 2; ++mm)
#pragma unroll
          for (int bj = 0; bj < 2; ++bj)
#pragma unroll
            for (int n = 0; n < 2; ++n) {
              const int tp = u.x * 256 + ai * 128 + wr * 64 + (mh * 2 + mm) * 16 + fr;
              const int nn = u.y * 256 + bj * 128 + wc * 32 + n * 16 + 4 * fq;
              const int bb = nn >> 9, col = nn & 511;
              const u16* rp = proj + (size_t)(lat ? (NCTX + bb * 2048 + tp) : (bb * 256 + tp)) * LDP;
              zv[mm][bj][n] = *(const uint2*)(rp + PZC + col);
            }
#pragma unroll
        for (int mm = 0; mm < 2; ++mm)
#pragma unroll
          for (int bj = 0; bj < 2; ++bj)
#pragma unroll
            for (int n = 0; n < 2; ++n) {
              const int m = mh * 2 + mm;
              const int tp = u.x * 256 + ai * 128 + wr * 64 + m * 16 + fr;
              const int nn = u.y * 256 + bj * 128 + wc * 32 + n * 16 + 4 * fq;
              const int bb = nn >> 9, col = nn & 511;
              u16* rp = proj + (size_t)(lat ? (NCTX + bb * 2048 + tp) : (bb * 256 + tp)) * LDP;
              const uint2 z = zv[mm][bj][n];
              f32x4 a4 = acc[ai][bj][m][n];
              *(uint2*)(rp + PUC + col) = make_uint2(pack2(a4[0] * scl * lo2f(z.x), a4[1] * scl * hi2f(z.x)),
                                                     pack2(a4[2] * scl * lo2f(z.y), a4[3] * scl * hi2f(z.y)));
            }
      }
  }
};
__device__ __forceinline__ void f2c_item(const Params& p, int item, char* lds) {
  OneUnit S; S.u.a = p.ws + OFF_DC; S.u.b = p.ws + OFF_PTC + (size_t)item * 256 * 1024; S.u.x = 0; S.u.y = item; S.u.lda = 512; S.u.ldb = 512; S.u.nt = 8;
  F2Epi E; E.ws = p.ws; E.scl = 0.005524271728019903f; E.lat = false; E.rowbase_mul = 0;
  gemm_phase((LAS unsigned char*)lds, S, E);
}
struct F2HalfEpi {
  uint2* part;
  __device__ __forceinline__ void operator()(f32x4 (&acc)[2][2][4][2], const Unit& u, int wr, int wc, int fr, int fq, LAS unsigned char* lds) const {
    const int tid = wr * 256 + wc * 64 + fq * 16 + fr;
#pragma unroll
    for (int ai = 0; ai < 2; ++ai)
#pragma unroll
      for (int bj = 0; bj < 2; ++bj)
#pragma unroll
        for (int m = 0; m < 4; ++m)
#pragma unroll
          for (int n = 0; n < 2; ++n) {
            f32x4 a4 = acc[ai][bj][m][n];
            __hip_atomic_store((unsigned long long*)(part + (((ai * 2 + bj) * 4 + m) * 2 + n) * 512 + tid), (unsigned long long)pack2(a4[0], a4[1]) | ((unsigned long long)pack2(a4[2], a4[3]) << 32), __ATOMIC_RELAXED, __HIP_MEMORY_SCOPE_AGENT);
          }
  }
};
__device__ __forceinline__ void f2l_item(const Params& p, int l, int item, char* lds) {
  char* ws = p.ws;
  const int tile = item >> 1, half = item & 1, mt = tile >> 2, nt = tile & 3;
  uint2* pbase = (uint2*)(ws + OFF_F2P);
  {
    OneUnit S; S.u.a = ws + OFF_DL + ((size_t)mt * 256 * 4096 + half * 2048) * 2; S.u.b = ws + OFF_PTL + ((size_t)nt * 256 * 4096 + half * 2048) * 2;
    S.u.x = mt; S.u.y = nt; S.u.lda = 4096; S.u.ldb = 4096; S.u.nt = 32;
    F2HalfEpi E; E.part = pbase + (size_t)(tile * 2 + half) * (32 * 512);
    gemm_phase((LAS unsigned char*)lds, S, E);
  }
  const int t_ = otid();
  volatile int* flag = (volatile int*)(lds + LDS_TILE + 32);
  asm volatile("s_waitcnt vmcnt(0)" ::: "memory");
  __syncthreads();
  if (t_ == 0) {
    unsigned* tk = (unsigned*)(ws + OFF_CNT) + 72 + l * 32 + tile;
    const unsigned old = __hip_atomic_fetch_add(tk, 1u, __ATOMIC_RELAXED, __HIP_MEMORY_SCOPE_AGENT);
    const int last = (old == 1u) ? 1 : 0;
    if (last) { __builtin_amdgcn_fence(__ATOMIC_ACQUIRE, "agent"); asm volatile("s_waitcnt vmcnt(0)" ::: "memory"); }
    *flag = last;
  }
  __syncthreads();
  if (*flag) {
    const int lane = t_ & 63, wid = t_ >> 6, wr = wid >> 2, wc = wid & 3, fr = lane & 15, fq = lane >> 4;
    const uint2* p0 = pbase + (size_t)(tile * 2 + 0) * (32 * 512);
    const uint2* p1 = pbase + (size_t)(tile * 2 + 1) * (32 * 512);
    u16* proj = (u16*)(ws + OFF_PROJ);
    const float scl = 1.f / 512.f;
#pragma unroll
    for (int ai = 0; ai < 2; ++ai)
#pragma unroll
      for (int mh = 0; mh < 2; ++mh) {
        uint2 zv[2][2][2], av[2][2][2], bv2[2][2][2];
#pragma unroll
        for (int mm = 0; mm < 2; ++mm)
#pragma unroll
          for (int bj = 0; bj < 2; ++bj)
#pragma unroll
            for (int n = 0; n < 2; ++n) {
              const int m = mh * 2 + mm;
              const int tp = mt * 256 + ai * 128 + wr * 64 + m * 16 + fr;
              const int nn = nt * 256 + bj * 128 + wc * 32 + n * 16 + 4 * fq;
              const int bb = nn >> 9, col = nn & 511;
              const u16* rp = proj + (size_t)(NCTX + bb * 2048 + tp) * LDP;
              zv[mm][bj][n] = *(const uint2*)(rp + PZC + col);
              const int idx = (((ai * 2 + bj) * 4 + m) * 2 + n) * 512 + t_;
              av[mm][bj][n] = p0[idx]; bv2[mm][bj][n] = p1[idx];
            }
#pragma unroll
        for (int mm = 0; mm < 2; ++mm)
#pragma unroll
          for (int bj = 0; bj < 2; ++bj)
#pragma unroll
            for (int n = 0; n < 2; ++n) {
              const int m = mh * 2 + mm;
              const int tp = mt * 256 + ai * 128 + wr * 64 + m * 16 + fr;
              const int nn = nt * 256 + bj * 128 + wc * 32 + n * 16 + 4 * fq;
              const int bb = nn >> 9, col = nn & 511;
              u16* rp = proj + (size_t)(NCTX + bb * 2048 + tp) * LDP;
              const uint2 z = zv[mm][bj][n], a = av[mm][bj][n], c = bv2[mm][bj][n];
              const float y0 = (lo2f(a.x) + lo2f(c.x)) * scl * lo2f(z.x), y1 = (hi2f(a.x) + hi2f(c.x)) * scl * hi2f(z.x);
              const float y2 = (lo2f(a.y) + lo2f(c.y)) * scl * lo2f(z.y), y3 = (hi2f(a.y) + hi2f(c.y)) * scl * hi2f(z.y);
              *(uint2*)(rp + PUC + col) = make_uint2(pack2(y0, y1), pack2(y2, y3));
            }
      }
  }
  __syncthreads();
}

__device__ __forceinline__ bool xcd_tile(int bid, int& pm, int& pn) {
  const int x = bid & 7, j = bid >> 3;
  if (j >= 24) return false;
  pm = 6 * x + (j >> 2); pn = j & 3;
  return true;
}
struct P5Sched {
  char* ws; int x, j;
  __device__ __forceinline__ bool next(int i, Unit& u) const {
    if (j < 24) {
      if (i >= 5) return false;
      const int pm = 6 * x + (j >> 2), pn = j & 3;
      const int jj = (i < 4) ? (i >> 1) : 2;
      if (i == 0 || i == 2) {
        u.a = ws + OFF_H + (size_t)pm * 256 * 2048; u.b = ws + OFF_WIN + (size_t)(5632 + jj * 1024 + pn * 256) * 2048;
        u.lda = 1024; u.ldb = 1024; u.nt = 16; u.x = pm; u.y = pn | (jj << 8);
      } else {
        const int yc = (jj == 0) ? PQA : ((jj == 1) ? PQB : PUC);
        u.a = ws + OFF_PROJ + ((size_t)pm * 256 * LDP + yc) * 2; u.b = ws + OFF_WBR + ((size_t)jj * 1024 * 512 + (size_t)pn * 256 * 512) * 2;
        u.lda = LDP; u.ldb = 512; u.nt = 8; u.x = pm; u.y = pn | (jj << 8) | ((i == 4) ? 0x2000 : 0x1000);
      }
      return true;
    }
    if (i >= 3) return false;
    const int tj = 3 * (j - 24) + i;
    const int pm = 6 * x + (tj >> 2), pn = tj & 3;
    u.a = ws + OFF_H + (size_t)pm * 256 * 2048; u.b = ws + OFF_WIN + (size_t)(5632 + 2 * 1024 + pn * 256) * 2048;
    u.lda = 1024; u.ldb = 1024; u.nt = 16; u.x = pm; u.y = pn | (2 << 8) | 0x3000;
    return true;
  }
};
struct P5Epi {
  char* ws; u16* mg; unsigned* flags; bool skip;
  __device__ __forceinline__ void operator()(f32x4 (&acc)[2][2][4][2], const Unit& u, int wr, int wc, int fr, int fq, LAS unsigned char* lds) const {
    if (skip) return;
    { const int t_ = otid(); const int w_ = t_ >> 6; wr = w_ >> 2; wc = w_ & 3; fr = t_ & 15; fq = (t_ & 63) >> 4; }
    const int tid = wr * 256 + wc * 64 + fq * 16 + fr;
    const int type = (u.y >> 12) & 3, j = (u.y >> 8) & 3, pn = u.y & 0xff, pm = u.x;
    const int tile = pm * 4 + pn;
    uint2* gs = (uint2*)(ws + OFF_SEGU) + (size_t)tile * (32 * 512);
    u16* g2p = (u16*)(ws + OFF_PROJ) + (size_t)pm * 256 * LDP + PLF + pn * 256;
    if (type == 0) {
#pragma unroll
      for (int ai = 0; ai < 2; ++ai)
#pragma unroll
        for (int bj = 0; bj < 2; ++bj)
#pragma unroll
          for (int m = 0; m < 4; ++m)
#pragma unroll
            for (int n = 0; n < 2; ++n) {
              f32x4 a4 = acc[ai][bj][m][n];
              gs[(((ai * 2 + bj) * 4 + m) * 2 + n) * 512 + tid] = make_uint2(pack2(sigmf(a4[0]), sigmf(a4[1])), pack2(sigmf(a4[2]), sigmf(a4[3])));
            }
      return;
    }
    if (type == 3) {
#pragma unroll
      for (int ai = 0; ai < 2; ++ai)
#pragma unroll
        for (int bj = 0; bj < 2; ++bj)
#pragma unroll
          for (int m = 0; m < 4; ++m)
#pragma unroll
            for (int n = 0; n < 2; ++n) {
              f32x4 a4 = acc[ai][bj][m][n];
              const int row = ai * 128 + wr * 64 + m * 16 + fr, col = bj * 128 + wc * 32 + n * 16 + 4 * fq;
              const unsigned long long v = (unsigned long long)pack2(sigmf(a4[0]), sigmf(a4[1])) | ((unsigned long long)pack2(sigmf(a4[2]), sigmf(a4[3])) << 32);
              __hip_atomic_store((unsigned long long*)(g2p + (size_t)row * LDP + col), v, __ATOMIC_RELAXED, __HIP_MEMORY_SCOPE_AGENT);
            }
      asm volatile("s_waitcnt vmcnt(0)" ::: "memory");
      if ((fq * 16 + fr) == 0) __hip_atomic_fetch_add(flags + tile, 1u, __ATOMIC_RELAXED, __HIP_MEMORY_SCOPE_AGENT);
      return;
    }
    if (type == 2) {
      if (tid == 0) {
        unsigned sp = 0;
        while (__hip_atomic_load(flags + tile, __ATOMIC_RELAXED, __HIP_MEMORY_SCOPE_AGENT) < 8u) { __builtin_amdgcn_s_sleep(2); if (++sp > (1u << 22)) break; }
        __builtin_amdgcn_fence(__ATOMIC_ACQUIRE, "agent");
        asm volatile("s_waitcnt vmcnt(0)" ::: "memory");
      }
      asm volatile("" ::: "memory");
      __builtin_amdgcn_s_barrier();
      asm volatile("" ::: "memory");
    }
#pragma unroll
    for (int ai = 0; ai < 2; ++ai)
#pragma unroll
      for (int mh = 0; mh < 2; ++mh) {
        uint2 gv[2][2][2], pv[2][2][2];
#pragma unroll
        for (int mm = 0; mm < 2; ++mm)
#pragma unroll
          for (int bj = 0; bj < 2; ++bj)
#pragma unroll
            for (int n = 0; n < 2; ++n) {
              const int m = mh * 2 + mm;
              const int rl = ai * 128 + wr * 64 + m * 16 + fr, cl = bj * 128 + wc * 32 + n * 16 + 4 * fq;
              const int row = pm * 256 + rl, col = pn * 256 + cl;
              const uint2* gptr = (type == 2) ? (const uint2*)(g2p + (size_t)rl * LDP + cl) : (const uint2*)(gs + (((ai * 2 + bj) * 4 + m) * 2 + n) * 512 + tid);
              gv[mm][bj][n] = *gptr;
              pv[mm][bj][n] = (j > 0) ? *(const uint2*)(mg + (size_t)row * 1024 + col) : make_uint2(0u, 0u);
            }
#pragma unroll
        for (int mm = 0; mm < 2; ++mm)
#pragma unroll
          for (int bj = 0; bj < 2; ++bj)
#pragma unroll
            for (int n = 0; n < 2; ++n) {
              const int m = mh * 2 + mm;
              const int row = pm * 256 + ai * 128 + wr * 64 + m * 16 + fr;
              const int col = pn * 256 + bj * 128 + wc * 32 + n * 16 + 4 * fq;
              f32x4 a4 = acc[ai][bj][m][n];
              const uint2 g2 = gv[mm][bj][n], p2 = pv[mm][bj][n];
              float t0 = lo2f(g2.x) * a4[0] + lo2f(p2.x), t1 = hi2f(g2.x) * a4[1] + hi2f(p2.x);
              float t2 = lo2f(g2.y) * a4[2] + lo2f(p2.y), t3 = hi2f(g2.y) * a4[3] + hi2f(p2.y);
              *(uint2*)(mg + (size_t)row * 1024 + col) = make_uint2(pack2(t0, t1), pack2(t2, t3));
            }
      }
  }
};
__device__ __forceinline__ void p5_phase(const Params& p, int l, char* lds, bool skip = false) {
  P5Sched S; S.ws = p.ws; S.x = blockIdx.x & 7; S.j = blockIdx.x >> 3;
  if (S.j >= 32) return;
  P5Epi E; E.ws = p.ws; E.mg = (u16*)(p.ws + OFF_MRG); E.flags = (unsigned*)(p.ws + OFF_CNT) + 136 + l * 192; E.skip = skip;
  gemm_phase((LAS unsigned char*)lds, S, E);
}

struct P6Epi {
  const float* xp0; const float* xs0; float* outp; const float* modp; int l;
  __device__ __forceinline__ void operator()(f32x4 (&acc)[2][2][4][2], const Unit& u, int wr, int wc, int fr, int fq, LAS unsigned char* lds) const {
    const int m0 = u.x * 256;
    const int ci = (m0 < NCTX) ? 0 : 1 + ((m0 - NCTX) >> 11);
    const float* xbase = (l == 0) ? ((m0 < NCTX) ? xp0 : xs0 - (size_t)NCTX * 1024) : outp;
    float4 gt[2][2];
#pragma unroll
    for (int bj = 0; bj < 2; ++bj)
#pragma unroll
      for (int n = 0; n < 2; ++n) gt[bj][n] = *(const float4*)(modp + (l * 3 + ci) * 3072 + 2048 + u.y * 256 + bj * 128 + wc * 32 + n * 16 + 4 * fq);
#pragma unroll
    for (int ai = 0; ai < 2; ++ai)
#pragma unroll
      for (int mh = 0; mh < 2; ++mh) {
        float4 xv[2][2][2];
#pragma unroll
        for (int mm = 0; mm < 2; ++mm)
#pragma unroll
          for (int bj = 0; bj < 2; ++bj)
#pragma unroll
            for (int n = 0; n < 2; ++n) {
              const int r = m0 + ai * 128 + wr * 64 + (mh * 2 + mm) * 16 + fr;
              const int col = u.y * 256 + bj * 128 + wc * 32 + n * 16 + 4 * fq;
              xv[mm][bj][n] = *(const float4*)(xbase + (size_t)r * 1024 + col);
            }
#pragma unroll
        for (int mm = 0; mm < 2; ++mm)
#pragma unroll
          for (int bj = 0; bj < 2; ++bj)
#pragma unroll
            for (int n = 0; n < 2; ++n) {
              const int m = mh * 2 + mm;
              const int r = m0 + ai * 128 + wr * 64 + m * 16 + fr;
              const int col = u.y * 256 + bj * 128 + wc * 32 + n * 16 + 4 * fq;
              f32x4 a4 = acc[ai][bj][m][n];
              const float4 x4 = xv[mm][bj][n], g4 = gt[bj][n];
              *(float4*)(outp + (size_t)r * 1024 + col) = make_float4(x4.x + g4.x * a4[0], x4.y + g4.y * a4[1], x4.z + g4.z * a4[2], x4.w + g4.w * a4[3]);
            }
      }
  }
};
__device__ __forceinline__ void p6_phase(const Params& p, int l, char* lds) {
  char* ws = p.ws;
  int pm, pn;
  if (!xcd_tile(blockIdx.x, pm, pn)) return;
  OneUnit S; S.u.a = ws + OFF_MRG + (size_t)pm * 256 * 2048; S.u.b = ws + OFF_WO + (size_t)pn * 256 * 2048; S.u.x = pm; S.u.y = pn;
  S.u.lda = 1024; S.u.ldb = 1024; S.u.nt = 16; S.reps = ((DUP_MASK & 512) && l == 0) ? 5 : 1;
  P6Epi E; E.xp0 = p.in[0]; E.xs0 = p.in[1]; E.outp = p.out; E.modp = (const float*)(ws + OFF_MOD); E.l = l;
  gemm_phase((LAS unsigned char*)lds, S, E);
}

#define XB_TMO      128
#define XB_XCNT(j)  (256  + 64 * (j))
#define XB_XSUB(j)  (1280 + 64 * (j))
#define XB_XGEN(j)  (2304 + 64 * (j))
#define XB_TOP      3328
#define XB_TOPGEN   3392
#define XCD_BAR_WORDS 3456
#define XB_SPIN_CAP (1u << 18)
struct XcdBarrier { unsigned* bar; unsigned x; volatile LAS unsigned* st; };
__device__ __forceinline__ unsigned xb_ld(unsigned* p) { return __hip_atomic_load(p, __ATOMIC_RELAXED, __HIP_MEMORY_SCOPE_AGENT); }
__device__ __forceinline__ unsigned xb_add(unsigned* p, unsigned v) { return __hip_atomic_fetch_add(p, v, __ATOMIC_RELAXED, __HIP_MEMORY_SCOPE_AGENT); }
__device__ __forceinline__ unsigned xb_xcc_id() { return (unsigned)__builtin_amdgcn_s_getreg((3 << 11) | 20) & 0xFu; }
#define XB_SPIN(cond, bar) do { unsigned _sp = 0; while (cond) { __builtin_amdgcn_s_sleep(1); \
    if ((++_sp & 255u) == 0u) { if (xb_ld(&(bar)[XB_TMO])) break; if (_sp > XB_SPIN_CAP) { atomicAdd(&(bar)[XB_TMO], 1u); break; } } } } while (0)
__device__ __forceinline__ XcdBarrier xcd_barrier_post(unsigned* bar, volatile LAS unsigned* st) {
  XcdBarrier b; b.bar = bar; b.x = xb_xcc_id(); b.st = st;
  if (threadIdx.x == 0) (void)xb_add(&bar[XB_XCNT(b.x)], 1u);
  return b;
}
__device__ __forceinline__ void xcd_barrier_complete(unsigned* bar, unsigned x, unsigned& nloc, unsigned& nx) {
  const unsigned G = gridDim.x * gridDim.y * gridDim.z;
  unsigned sum, cnt, mine, sp = 0u;
  for (;;) {
    sum = 0u; cnt = 0u; mine = 0u;
#pragma unroll
    for (unsigned j = 0; j < 16; ++j) { const unsigned c = xb_ld(&bar[XB_XCNT(j)]); sum += c; cnt += (c > 0u) ? 1u : 0u; mine = (j == x) ? c : mine; }
    if (sum == G) break;
    __builtin_amdgcn_s_sleep(1);
    if ((++sp & 255u) == 0u) { if (xb_ld(&bar[XB_TMO])) break; if (sp > XB_SPIN_CAP) { atomicAdd(&bar[XB_TMO], 1u); break; } }
  }
  nloc = mine > 0u ? mine : 1u; nx = cnt > 0u ? cnt : 1u;
}
__device__ __forceinline__ void xcd_barrier(const XcdBarrier& b) {
  asm volatile("s_waitcnt vmcnt(0)" ::: "memory");
  __syncthreads();
  if (threadIdx.x == 0) {
    unsigned* bar = b.bar;
    __builtin_amdgcn_s_waitcnt(0);
    unsigned nloc = b.st[0], nx = b.st[1];
    if (nloc == 0u) { xcd_barrier_complete(bar, b.x, nloc, nx); b.st[0] = nloc; b.st[1] = nx; }
    const unsigned old = xb_add(&bar[XB_XSUB(b.x)], 1u);
    const unsigned gen = old / nloc;
    if (old + 1u == (gen + 1u) * nloc) {
      __builtin_amdgcn_fence(__ATOMIC_RELEASE, "agent");
      asm volatile("s_waitcnt vmcnt(0)" ::: "memory");
      const unsigned og = xb_add(&bar[XB_TOP], 1u);
      const unsigned tg = og / nx;
      if (og + 1u == (tg + 1u) * nx) xb_add(&bar[XB_TOPGEN], 1u);
      else XB_SPIN(xb_ld(&bar[XB_TOPGEN]) == tg, bar);
      __builtin_amdgcn_fence(__ATOMIC_ACQUIRE, "agent");
      xb_add(&bar[XB_XGEN(b.x)], 1u);
      asm volatile("s_waitcnt vmcnt(0)" ::: "memory");
    } else {
      XB_SPIN(xb_ld(&bar[XB_XGEN(b.x)]) == gen, bar);
      __builtin_amdgcn_fence(__ATOMIC_ACQUIRE, "agent");
      asm volatile("s_waitcnt vmcnt(0)" ::: "memory");
    }
  }
  __syncthreads();
}

#define PARGS const float* a0, const float* a1, const float* a2, const float* a3, const float* a4, const float* a5, const float* a6, \
  const float* a7, const float* a8, const float* a9, const float* a10, const float* a11, const float* a12, const float* a13, \
  const float* a14, const float* a15, const float* a16, const float* a17, const float* a18, const float* a19, const float* a20, \
  float* aout, char* aws
#define PFILL Params p; p.in[0]=a0;p.in[1]=a1;p.in[2]=a2;p.in[3]=a3;p.in[4]=a4;p.in[5]=a5;p.in[6]=a6;p.in[7]=a7;p.in[8]=a8;p.in[9]=a9;p.in[10]=a10; \
  p.in[11]=a11;p.in[12]=a12;p.in[13]=a13;p.in[14]=a14;p.in[15]=a15;p.in[16]=a16;p.in[17]=a17;p.in[18]=a18;p.in[19]=a19;p.in[20]=a20;p.out=aout;p.ws=aws;
__global__ void __launch_bounds__(512) fwd_megakernel(PARGS) {
  PFILL
  extern __shared__ __attribute__((aligned(16))) char lds[];
  volatile int& s_item = *(volatile int*)(lds + LDS_TILE);
  cg::grid_group grid = cg::this_grid();
  const int bid = blockIdx.x, G = gridDim.x, tid = threadIdx.x;
  int* cnt = (int*)(p.ws + OFF_CNT);
  volatile LAS unsigned* bst = (volatile LAS unsigned*)(LAS unsigned char*)(lds + LDS_TILE + 16);
  if (tid < 2) bst[tid] = 0u;
  __syncthreads();
  const XcdBarrier xb = xcd_barrier_post((unsigned*)(p.ws + OFF_BAR), bst);
  for (int rep = 0; rep < ((DUP_MASK & 1) ? 2 : 1); ++rep) {
  {
    for (int it = bid; it < 384; it += G) p0_mod16(p, it, lds);
    float2* tab = (float2*)lds;
    for (int m = tid; m < 2048; m += 512) { float sn, cs; sincospif((float)m * (1.f / 1024.f), &sn, &cs); tab[m] = make_float2(cs, sn); }
    __syncthreads();
    for (int it = 224 + bid; it < 224 + 2048; it += G) p0_item(p, it, lds);
    __syncthreads();
    for (int it = 96 + bid; it < P0_ITEMS; it += G) { if (it >= 224 && it < 224 + 2048) continue; p0_item(p, it, lds); }
  }
  if (((const volatile float*)p.in[15])[0] > 1e30f) grid.sync();
  xcd_barrier(xb);
  }
  for (int l = 0; l < 2; ++l) {
    for (int rep = 0; rep < ((DUP_MASK & 2) ? 2 : 1); ++rep) {
    for (int it = bid; it < P1_ITEMS; it += G) p1_item(p, l, it, lds);
    xcd_barrier(xb);
    }
    if (DUP_MASK & 1024) { const bool opq = (((const volatile float*)p.in[15])[0] < 1e30f); p2_phase(p, l, lds, opq); xcd_barrier(xb); }
    for (int rep = 0; rep < ((DUP_MASK & 4) ? 2 : 1); ++rep) {
    p2_phase(p, l, lds);
    xcd_barrier(xb);
    }
    for (;;) {
      __syncthreads();
      if (tid == 0) s_item = atomicAdd(&cnt[l * 2 + 0], 1);
      __syncthreads();
      int it = s_item;
      constexpr int D3 = (DUP_MASK & 16) ? 256 : 0;
      if (it >= D3 + 32 + 128 + 384 + 256) break;
      if (it >= 32 + 128 + 384 + 256) { hgrn_ctx_item(p, l, (it - 800) & 127, lds, true); continue; }
      if (it < 32) p2_left_item(p, l, 1024 + it, lds);
      else if (it < 160) hgrn_ctx_item(p, l, it - 32, lds);
      else if (it < 416) hgrn_lat1_item(p, l, it - 160, lds);
      else f1_item(p, it - 416, lds);
    }
    xcd_barrier(xb);
    for (;;) {
      __syncthreads();
      if (tid == 0) s_item = atomicAdd(&cnt[l * 2 + 1], 1);
      __syncthreads();
      int it = s_item;
      constexpr int D4a = (DUP_MASK & 32) ? 256 : 0, D4b = (DUP_MASK & 64) ? 256 : 0;
      if (it >= D4a + D4b + 640) break;
      if (it >= 640) { if (DUP_MASK & 32) attn_item(p, l, (it - 640) & 127, true, lds, true); else hgrn_lat2_item(p, l, (it - 640) & 127, lds, true); continue; }
      if (it < 128) attn_item(p, l, it, true, lds);
      else if (it < 192) f2l_item(p, l, it - 128, lds);
      else if (it < 320) hgrn_lat2_item(p, l, it - 192, lds);
      else if (it < 384) f2c_item(p, it - 320, lds);
      else attn_item(p, l, it - 384, false, lds);
    }
    xcd_barrier(xb);
    if (DUP_MASK & 2048) { const bool opq = (((const volatile float*)p.in[15])[0] < 1e30f); p5_phase(p, l, lds, opq); xcd_barrier(xb); }
    for (int rep = 0; rep < ((DUP_MASK & 8) ? 2 : 1); ++rep) {
    p5_phase(p, l, lds);
    xcd_barrier(xb);
    }
    for (int rep = 0; rep < (((DUP_MASK & 256) && l == 0) ? 5 : 1); ++rep) {
    p6_phase(p, l, lds);
    if (l == 0) xcd_barrier(xb);
    }
  }
}

extern "C" void kernel_launch(void* const* d_in, const int* in_sizes, int n_in,
                              void* d_out, int out_size, void* d_ws, size_t ws_size,
                              hipStream_t stream) {
  static int grid_blocks = 0;
  if (!grid_blocks) {
    int dev = 0, cus = 0;
    (void)hipGetDevice(&dev);
    (void)hipDeviceGetAttribute(&cus, hipDeviceAttributeMultiprocessorCount, dev);
    if (hipFuncSetAttribute((const void*)fwd_megakernel, hipFuncAttributeMaxDynamicSharedMemorySize, LDS_BYTES) != hipSuccess)
      fprintf(stderr, "hipFuncSetAttribute failed\n");
    grid_blocks = cus > 0 ? cus : 256;
    if (ws_size < WS_END) fprintf(stderr, "workspace too small: %zu < %zu\n", ws_size, (size_t)WS_END);
  }
  const void* ins[21];
  for (int i = 0; i < 21; ++i) ins[i] = d_in[i];
  void* outp = d_out; void* wsp = d_ws;
  void* args[23];
  for (int i = 0; i < 21; ++i) args[i] = (void*)&ins[i];
  args[21] = (void*)&outp; args[22] = (void*)&wsp;
  (void)hipMemsetAsync((char*)d_ws + OFF_CNT, 0, 4096 + 3456 * 4, stream);
  hipError_t e = hipLaunchCooperativeKernel((void*)fwd_megakernel, dim3(grid_blocks), dim3(512), args, LDS_BYTES, stream);
  if (e != hipSuccess) fprintf(stderr, "cooperative launch failed: %s (grid %d)\n", hipGetErrorString(e), grid_blocks);
}
```

```cpp
#include <hip/hip_runtime.h>
#include <hip/hip_cooperative_groups.h>
#include <stdint.h>
#include <cstdio>
namespace cg = cooperative_groups;

typedef unsigned short u16;
using bf16x8 = __attribute__((ext_vector_type(8))) short;
using f32x4 = __attribute__((ext_vector_type(4))) float;
#define MFMA(a, b, c) __builtin_amdgcn_mfma_f32_16x16x32_bf16(a, b, c, 0, 0, 0)

constexpr int NTOK = 12288;
constexpr int NCTX = 8192;
constexpr int LDP = 5120;
constexpr int PQA = 0, PLF = 512, PIA = 1536, PZA = 2048, PQB = 2560, PKB = 3072, PZB = 3584, PUC = 4096, PZC = 4608;
constexpr float EPSV = 1e-6f;
constexpr size_t OCK = 12582912, OCV = 20971520, OST = 29360128;

constexpr size_t OFF_WIN = 0;
constexpr size_t OFF_WBR = OFF_WIN + 8704ull * 1024 * 2;
constexpr size_t OFF_WO = OFF_WBR + 3ull * 1024 * 512 * 2;
constexpr size_t OFF_H = OFF_WO + 1024ull * 1024 * 2;
constexpr size_t OFF_PROJ = OFF_H + 12288ull * 1024 * 2;
constexpr size_t OFF_R1 = OFF_PROJ + 12288ull * LDP * 2;
constexpr size_t OFF_PTC = OFF_R1;
constexpr size_t OFF_PTL = OFF_R1 + 16384ull * 512 * 2;
constexpr size_t OFF_MRG = OFF_R1;
constexpr size_t OFF_SEGU = OFF_R1 + 25165824ull;
constexpr size_t OFF_SEGD = OFF_SEGU + 256ull * 16384 * 4;
constexpr size_t OFF_VTC = OFF_SEGD + 256ull * 128 * 4;
constexpr size_t OFF_VTL = OFF_VTC + 32ull * 4 * 128 * 256 * 2;
constexpr size_t SZ_VTL = 2ull * 4 * 128 * 2304 * 2;
constexpr size_t OFF_KC = OFF_VTL + 2 * SZ_VTL;
constexpr size_t OFF_DL = OFF_KC + 2ull * 2 * 256 * 512 * 2;
constexpr size_t OFF_DC = OFF_DL + 2048ull * 4096 * 2;
constexpr size_t OFF_B1 = OFF_DC + 256ull * 512 * 2;
constexpr size_t OFF_ROPE = OFF_B1 + 256ull * 128 * 2;
constexpr size_t OFF_MOD = OFF_ROPE + 2048ull * 32 * 8;
constexpr size_t OFF_CNT = OFF_MOD + 2ull * 3 * 3072 * 4;
constexpr size_t OFF_BAR = OFF_CNT + 4096;
constexpr size_t OFF_F2P = OFF_BAR + 3456 * 4 + 192;
constexpr size_t WS_END = OFF_F2P + 32ull * 2 * 32 * 512 * 8;

constexpr int LDS_TILE = 131072 + 8192;
#define DUP_MASK 0
constexpr int LDS_BYTES = LDS_TILE + 64;

struct Params {
  const float* in[21];
  float* out;
  char* ws;
};

typedef __bf16 bf16x2_t __attribute__((ext_vector_type(2)));
typedef float f32x2_t __attribute__((ext_vector_type(2)));
__device__ __forceinline__ uint32_t pack2(float a, float b) {
  f32x2_t v = {a, b};
  bf16x2_t r = __builtin_convertvector(v, bf16x2_t);
  return __builtin_bit_cast(uint32_t, r);
}
__device__ __forceinline__ u16 f2bf(float f) { return (u16)(pack2(f, 0.f) & 0xffffu); }
__device__ __forceinline__ float bf2f(u16 h) { return __uint_as_float(((uint32_t)h) << 16); }
__device__ __forceinline__ float lo2f(uint32_t u) { return __uint_as_float(u << 16); }
__device__ __forceinline__ float hi2f(uint32_t u) { return __uint_as_float(u & 0xffff0000u); }
__device__ __forceinline__ float fexp(float x) { return __builtin_amdgcn_exp2f(x * 1.4426950408889634f); }
__device__ __forceinline__ float frcp(float x) { return __builtin_amdgcn_rcpf(x); }
__device__ __forceinline__ float flog(float x) { return __builtin_amdgcn_logf(x) * 0.6931471805599453f; }
__device__ __forceinline__ float siluf(float x) { return x * frcp(1.f + fexp(-x)); }
__device__ __forceinline__ float sigmf(float x) { return frcp(1.f + fexp(-x)); }
__device__ __forceinline__ float logf_gate(float x, float lb) {
  float xc = fmaxf(x, -80.f);
  float e = fexp(-xc);
  float omf = (1.f - lb) * e * frcp(1.f + e);
  float lf = flog(1.f - omf);
  lf = (lb == 0.f && x < -15.f) ? x : lf;
  return lf;
}
__device__ __forceinline__ float neg_expm1(float lf) {
  return 1.f - fexp(lf);
}
__device__ __forceinline__ int otid() { int t = threadIdx.x; asm volatile("" : "+v"(t)); return t; }

union Frag {
  bf16x8 v;
  uint4 q;
  uint2 h[2];
  uint32_t w[4];
};

__device__ __forceinline__ int lds_byte(int r, int c) {
  int st = (r >> 4) * 2 + (c >> 5), rr = r & 15, cc = c & 31, ob = rr * 64 + cc * 2;
  return st * 1024 + (ob ^ (((ob >> 9) & 1) << 5));
}

template <int TM>
__device__ __forceinline__ void gemm_kloop(const u16* __restrict__ X, int ldx, const u16* __restrict__ Y, int ldy,
                                           int K, f32x4 (&acc)[4][TM / 32], char* lds) {
  constexpr int NX = TM / 64;
  constexpr int XT = TM / 32;
  constexpr int STAGE = TM * 128 + 32768;
  const int tid = otid(), lane = tid & 63, wid = tid >> 6, wr = wid >> 2, wc = wid & 3, fr = lane & 15, fq = lane >> 4;
#pragma unroll
  for (int a = 0; a < 4; ++a)
#pragma unroll
    for (int b = 0; b < XT; ++b) acc[a][b] = f32x4{0.f, 0.f, 0.f, 0.f};
  uint4 xr[NX], yr[4];
  const int nk = K >> 6;
  const int lrow = tid >> 3, lc8 = (tid & 7) * 8;
  const u16* xg = X + (size_t)lrow * ldx + lc8;
  const u16* yg = Y + (size_t)lrow * ldy + lc8;
  const int loff = lds_byte(lrow, lc8);
#pragma unroll
  for (int i = 0; i < NX; ++i) xr[i] = *(const uint4*)(xg + (size_t)(64 * i) * ldx);
#pragma unroll
  for (int i = 0; i < 4; ++i) yr[i] = *(const uint4*)(yg + (size_t)(64 * i) * ldy);
#pragma unroll
  for (int i = 0; i < NX; ++i) *(uint4*)(lds + loff + 8192 * i) = xr[i];
#pragma unroll
  for (int i = 0; i < 4; ++i) *(uint4*)(lds + TM * 128 + loff + 8192 * i) = yr[i];
  __syncthreads();
  for (int kt = 0; kt < nk; ++kt) {
    char* cur = lds + (kt & 1) * STAGE;
    char* nxt = lds + ((kt + 1) & 1) * STAGE;
    const bool more = (kt + 1 < nk);
    if (more) {
#pragma unroll
      for (int i = 0; i < NX; ++i) xr[i] = *(const uint4*)(xg + (size_t)(64 * i) * ldx + (kt + 1) * 64);
#pragma unroll
      for (int i = 0; i < 4; ++i) yr[i] = *(const uint4*)(yg + (size_t)(64 * i) * ldy + (kt + 1) * 64);
    }
#pragma unroll
    for (int ks = 0; ks < 2; ++ks) {
      Frag yf[4], xf[XT];
#pragma unroll
      for (int a = 0; a < 4; ++a) yf[a].q = *(const uint4*)(cur + TM * 128 + lds_byte(wc * 64 + a * 16 + fr, ks * 32 + fq * 8));
#pragma unroll
      for (int b = 0; b < XT; ++b) xf[b].q = *(const uint4*)(cur + lds_byte(wr * (TM / 2) + b * 16 + fr, ks * 32 + fq * 8));
#pragma unroll
      for (int a = 0; a < 4; ++a)
#pragma unroll
        for (int b = 0; b < XT; ++b) acc[a][b] = MFMA(yf[a].v, xf[b].v, acc[a][b]);
    }
    if (more) {
#pragma unroll
      for (int i = 0; i < NX; ++i) *(uint4*)(nxt + loff + 8192 * i) = xr[i];
#pragma unroll
      for (int i = 0; i < 4; ++i) *(uint4*)(nxt + TM * 128 + loff + 8192 * i) = yr[i];
    }
    __syncthreads();
  }
}

#define LAS __attribute__((address_space(3)))
constexpr int HTB = 128 * 64 * 2;
constexpr int G8_STAGE_BYTES = 8 * HTB;
__device__ __forceinline__ void stage_rc(int b, int& R, int& C) {
  const int st = b / 1024, sb = b % 1024, swz = sb ^ (((sb >> 9) & 1) << 5);
  R = (st >> 1) * 16 + swz / 64; C = (st & 1) * 32 + (swz % 64) / 2;
}
struct Unit { const char* a; const char* b; int x; int y; int lda; int ldb; int nt; int perm = 0; };
struct OneUnit {
  Unit u; int reps = 1;
  __device__ __forceinline__ bool next(int i, Unit& o) const { if (i >= reps) return false; o = u; return true; }
};
template <class Epi, class Sched>
__device__ __forceinline__ void gemm_phase(LAS unsigned char* lds, const Sched& S, const Epi& E) {
  const int tid = otid(), wid = __builtin_amdgcn_readfirstlane(tid >> 6), lane = tid & 63, wr = wid >> 2, wc = wid & 3, fr = lane & 15, fq = lane >> 4;
  int sR[2], sC[2];
#pragma unroll
  for (int i = 0; i < 2; ++i) stage_rc(tid * 16 + i * 8192, sR[i], sC[i]);
  int sRp[2];
#pragma unroll
  for (int i = 0; i < 2; ++i) { const int rho = sR[i] & 31, n_ = rho >> 4, i_ = rho & 15; sRp[i] = (sR[i] & ~31) + 8 * (i_ >> 2) + 4 * n_ + (i_ & 3); }
  const size_t kstep = 128;
  const unsigned ldsw = (unsigned)wid * 1024u;
  const int aoff = lds_byte(wr * 64 + fr, fq * 8), boff = lds_byte(wc * 32 + fr, fq * 8);
#define G8_SA(b, h) (((b) * 2 + (h)) * HTB)
#define G8_SB(b, h) ((4 + (b) * 2 + (h)) * HTB)
#define G8_STAGE(bufoff, gbase, voff) do { _Pragma("unroll") for (int _i = 0; _i < 2; ++_i) \
    __builtin_amdgcn_global_load_lds((const unsigned*)((const char*)(gbase) + (voff)[_i]), (LAS unsigned*)(lds + (bufoff) + ldsw + _i * 8192), 16, 0, 0); } while (0)
#define G8_LDA(dst, b, h) do { _Pragma("unroll") for (int m = 0; m < 4; ++m) _Pragma("unroll") for (int k = 0; k < 2; ++k) dst[m][k] = *(const LAS bf16x8*)(lds + G8_SA(b, h) + aoff + m * 2048 + k * 1024); } while (0)
#define G8_LDB(dst, b, h) do { _Pragma("unroll") for (int n = 0; n < 2; ++n) _Pragma("unroll") for (int k = 0; k < 2; ++k) dst[n][k] = *(const LAS bf16x8*)(lds + G8_SB(b, h) + boff + n * 2048 + k * 1024); } while (0)
#define G8_MMA(ai, bj, At, Bt) do { __builtin_amdgcn_s_setprio(1); _Pragma("unroll") for (int m = 0; m < 4; ++m) _Pragma("unroll") for (int n = 0; n < 2; ++n) _Pragma("unroll") for (int k = 0; k < 2; ++k) \
    acc[ai][bj][m][n] = __builtin_amdgcn_mfma_f32_16x16x32_bf16(Bt[n][k], At[m][k], acc[ai][bj][m][n], 0, 0, 0); __builtin_amdgcn_s_setprio(0); } while (0)
#define G8_WAIT_V(n) asm volatile("s_waitcnt vmcnt(" #n ")" ::: "memory")
#define G8_WAIT_L(n) asm volatile("s_waitcnt lgkmcnt(" #n ")" ::: "memory")
#define G8_BAR __builtin_amdgcn_s_barrier()
#define G8_SCHED __builtin_amdgcn_sched_barrier(0)
  Unit cur, nxt; int ui = 0;
  if (!S.next(0, cur)) return;
  f32x4 acc[2][2][4][2];
#pragma unroll
  for (int a = 0; a < 2; ++a)
#pragma unroll
    for (int b = 0; b < 2; ++b)
#pragma unroll
      for (int m = 0; m < 4; ++m)
#pragma unroll
        for (int n = 0; n < 2; ++n) acc[a][b][m][n] = f32x4{0.f, 0.f, 0.f, 0.f};
  bf16x8 At[4][2], B0[2][2], B1[2][2];
  const char* cA = cur.a; const char* cB = cur.b;
  unsigned voffA[2], voffB[2];
#pragma unroll
  for (int i = 0; i < 2; ++i) { voffA[i] = (unsigned)(sR[i] * cur.lda + sC[i]) * 2u; voffB[i] = (unsigned)((cur.perm ? sRp[i] : sR[i]) * cur.ldb + sC[i]) * 2u; }
  size_t hstepA = (size_t)128 * cur.lda * 2, hstepB = (size_t)128 * cur.ldb * 2;
  G8_STAGE(G8_SB(0, 0), cB, voffB); G8_STAGE(G8_SA(0, 0), cA, voffA); G8_STAGE(G8_SB(0, 1), cB + hstepB, voffB); G8_STAGE(G8_SA(0, 1), cA + hstepA, voffA);
  if (wr == 1) G8_BAR;
  G8_WAIT_V(4); G8_BAR;
  G8_STAGE(G8_SB(1, 0), cB + kstep, voffB); G8_STAGE(G8_SA(1, 0), cA + kstep, voffA); G8_STAGE(G8_SB(1, 1), cB + hstepB + kstep, voffB);
  G8_WAIT_V(6); G8_BAR;
  for (;;) {
    const bool has_next = S.next(ui + 1, nxt);
    if (!has_next) nxt = cur;
    const char* nA = nxt.a; const char* nB = nxt.b;
    unsigned voffAn[2], voffBn[2];
#pragma unroll
    for (int i = 0; i < 2; ++i) { voffAn[i] = (unsigned)(sR[i] * nxt.lda + sC[i]) * 2u; voffBn[i] = (unsigned)((nxt.perm ? sRp[i] : sR[i]) * nxt.ldb + sC[i]) * 2u; }
    const size_t hstepAn = (size_t)128 * nxt.lda * 2, hstepBn = (size_t)128 * nxt.ldb * 2;
    const int nt = cur.nt;
    for (int t = 0; t < nt; t += 2) {
      const bool last = (t == nt - 2);
      const char* a1 = cA + (size_t)(t + 1) * kstep;
      const char* a2 = last ? nA : cA + (size_t)(t + 2) * kstep; const char* b2 = last ? nB : cB + (size_t)(t + 2) * kstep;
      const char* a3 = a2 + kstep; const char* b3 = b2 + kstep;
      unsigned vA2[2], vB2[2];
#pragma unroll
      for (int i = 0; i < 2; ++i) { vA2[i] = last ? voffAn[i] : voffA[i]; vB2[i] = last ? voffBn[i] : voffB[i]; }
      const size_t hA2 = last ? hstepAn : hstepA, hB2 = last ? hstepBn : hstepB;
      G8_LDB(B0, 0, 0); G8_SCHED; G8_LDA(At, 0, 0); G8_STAGE(G8_SA(1, 1), a1 + hstepA, voffA);
      G8_WAIT_L(8); G8_BAR; G8_WAIT_L(0); G8_MMA(0, 0, At, B0); G8_BAR; G8_SCHED;
      G8_LDB(B1, 0, 1); G8_STAGE(G8_SB(0, 0), b2, vB2);
      G8_BAR; G8_WAIT_L(0); G8_MMA(0, 1, At, B1); G8_BAR;
      G8_LDA(At, 0, 1); G8_STAGE(G8_SA(0, 0), a2, vA2);
      G8_BAR; G8_WAIT_L(0); G8_MMA(1, 0, At, B0); G8_BAR; G8_SCHED;
      G8_STAGE(G8_SB(0, 1), b2 + hB2, vB2);
      G8_WAIT_V(6); G8_BAR; G8_MMA(1, 1, At, B1); G8_BAR;
      G8_LDB(B0, 1, 0); G8_SCHED; G8_LDA(At, 1, 0); G8_STAGE(G8_SA(0, 1), a2 + hA2, vA2);
      G8_WAIT_L(8); G8_BAR; G8_WAIT_L(0); G8_MMA(0, 0, At, B0); G8_BAR; G8_SCHED;
      G8_LDB(B1, 1, 1); G8_STAGE(G8_SB(1, 0), b3, vB2);
      G8_BAR; G8_WAIT_L(0); G8_MMA(0, 1, At, B1); G8_BAR;
      G8_LDA(At, 1, 1); G8_STAGE(G8_SA(1, 0), a3, vA2);
      G8_BAR; G8_WAIT_L(0); G8_MMA(1, 0, At, B0); G8_BAR; G8_SCHED;
      G8_STAGE(G8_SB(1, 1), b3 + hB2, vB2);
      G8_WAIT_V(6); G8_BAR; G8_MMA(1, 1, At, B1); G8_BAR;
    }
    E(acc, cur, wr, wc, fr, fq, lds);
    if (!has_next) break;
#pragma unroll
    for (int a = 0; a < 2; ++a)
#pragma unroll
      for (int b = 0; b < 2; ++b)
#pragma unroll
        for (int m = 0; m < 4; ++m)
#pragma unroll
          for (int n = 0; n < 2; ++n) acc[a][b][m][n] = f32x4{0.f, 0.f, 0.f, 0.f};
    cur = nxt; cA = nA; cB = nB; ++ui;
#pragma unroll
    for (int i = 0; i < 2; ++i) { voffA[i] = voffAn[i]; voffB[i] = voffBn[i]; }
    hstepA = hstepAn; hstepB = hstepBn;
  }
  G8_WAIT_V(0);
  if (wr == 0) G8_BAR;
  G8_BAR;
}

__device__ __forceinline__ void p0_mod16(const Params& p, int item, char* lds) {
  const int tid = otid();
  float* sc = (float*)lds;
  float* red = sc + 3072;
  const int l = item / 192, cgp = item % 192;
  const float* cctx = p.in[6]; const float* cc2 = p.in[2];
  for (int i = tid; i < 3072; i += 512) {
    int j = i >> 10, k = i & 1023;
    float c = (j == 0) ? cctx[k] : cc2[(j > 0 ? j - 1 : 0) * 1024 + k];
    sc[i] = c / (1.f + expf(-c));
  }
  __syncthreads();
  const int col = tid & 15, kg = tid >> 4;
  const float* W = p.in[7] + (size_t)l * 1024 * 3072 + cgp * 16 + col;
  float a0 = 0.f, a1 = 0.f, a2 = 0.f;
#pragma unroll 8
  for (int k = kg * 32; k < kg * 32 + 32; ++k) {
    float w = W[(size_t)k * 3072];
    a0 += sc[k] * w; a1 += sc[1024 + k] * w; a2 += sc[2048 + k] * w;
  }
  red[(kg * 3 + 0) * 16 + col] = a0; red[(kg * 3 + 1) * 16 + col] = a1; red[(kg * 3 + 2) * 16 + col] = a2;
  __syncthreads();
  if (tid < 48) {
    const int j = tid >> 4; float s_ = 0.f;
    for (int g = 0; g < 32; ++g) s_ += red[(g * 3 + j) * 16 + col];
    const int n = cgp * 16 + col;
    ((float*)(p.ws + OFF_MOD))[(l * 3 + j) * 3072 + n] = s_ + p.in[8][l * 3072 + n];
  }
  __syncthreads();
}

__device__ __forceinline__ void p0_item(const Params& p, int item, char* lds) {
  const int tid = otid();
  char* ws = p.ws;
  if (item < 96) {
    float* sc = (float*)lds;
    float* red = sc + 3072;
    const int l = item / 48, cgp = item % 48;
    const float* cctx = p.in[6]; const float* cc2 = p.in[2];
    for (int i = tid; i < 3072; i += 512) {
      int j = i >> 10, k = i & 1023;
      float c = (j == 0) ? cctx[k] : cc2[(j > 0 ? j - 1 : 0) * 1024 + k];
      sc[i] = siluf(c);
    }
    __syncthreads();
    const int col = tid & 63, kg = tid >> 6;
    const float* W = p.in[7] + (size_t)l * 1024 * 3072 + cgp * 64 + col;
    float a0 = 0.f, a1 = 0.f, a2 = 0.f;
    for (int k = kg * 128; k < kg * 128 + 128; ++k) {
      float w = W[(size_t)k * 3072];
      a0 += sc[k] * w; a1 += sc[1024 + k] * w; a2 += sc[2048 + k] * w;
    }
    red[(kg * 3 + 0) * 64 + col] = a0; red[(kg * 3 + 1) * 64 + col] = a1; red[(kg * 3 + 2) * 64 + col] = a2;
    __syncthreads();
    if (tid < 192) {
      int j = tid >> 6; float s = 0.f;
      for (int g = 0; g < 8; ++g) s += red[(g * 3 + j) * 64 + col];
      int n = cgp * 64 + col;
      ((float*)(ws + OFF_MOD))[(l * 3 + j) * 3072 + n] = s + p.in[8][l * 3072 + n];
    }
    __syncthreads();
    return;
  }
  item -= 96;
  if (item < 128) {
    int idx = item * 512 + tid, t = idx >> 5, c = idx & 31, fi = c & 15;
    float pos = (c < 16) ? (float)(t >> 6) : (float)(t & 63);
    float inv = powf(10000.f, -(float)fi / 16.f);
    float ang = pos * inv;
    ((float2*)(ws + OFF_ROPE))[idx] = make_float2(cosf(ang), sinf(ang));
    return;
  }
  item -= 128;
  if (item < 2048) {
    const float2* tab = (const float2*)lds;
    int idx = item * 512 + tid, tp = idx >> 9, k0 = (idx & 511) * 8;
    uint32_t o[4];
    float vv[8];
#pragma unroll
    for (int j = 0; j < 8; ++j) {
      int k = k0 + j; int m = (tp * (k & 2047)) & 2047;
      float2 cs = tab[m];
      vv[j] = (k < 2048) ? cs.x : -cs.y;
    }
#pragma unroll
    for (int j = 0; j < 4; ++j) o[j] = pack2(vv[2 * j], vv[2 * j + 1]);
    *(uint4*)(ws + OFF_DL + (size_t)idx * 16) = make_uint4(o[0], o[1], o[2], o[3]);
    return;
  }
  item -= 2048;
  if (item < 32) {
    int idx = item * 512 + tid, tp = idx >> 6, k0 = (idx & 63) * 8;
    uint32_t o[4];
    float vv[8];
#pragma unroll
    for (int j = 0; j < 8; ++j) {
      int k = k0 + j; int m = (tp * (k & 255)) & 255; float s, c;
      sincospif((float)m * (1.f / 128.f), &s, &c);
      vv[j] = (k < 256) ? c : -s;
    }
#pragma unroll
    for (int j = 0; j < 4; ++j) o[j] = pack2(vv[2 * j], vv[2 * j + 1]);
    *(uint4*)(ws + OFF_DC + (size_t)idx * 16) = make_uint4(o[0], o[1], o[2], o[3]);
    return;
  }
  item -= 32;
  if (item < 8) {
    int idx = item * 512 + tid, j = idx >> 4, c0 = (idx & 15) * 8;
    uint32_t o[4];
    float vv[8];
#pragma unroll
    for (int q = 0; q < 8; ++q) {
      int m = ((j & 127) * (c0 + q)) & 127; float s, c;
      sincospif((float)m * (1.f / 64.f), &s, &c);
      vv[q] = (j < 128) ? c : s;
    }
#pragma unroll
    for (int q = 0; q < 4; ++q) o[q] = pack2(vv[2 * q], vv[2 * q + 1]);
    *(uint4*)(ws + OFF_B1 + (size_t)idx * 16) = make_uint4(o[0], o[1], o[2], o[3]);
    return;
  }
  item -= 8;
  if (item < 128) {
    int idx = item * 512 + tid; int e = idx * 8;
    int n = e & 511, t = (e >> 9) & 255, l = (e >> 17) & 1, b = e >> 18;
    const float4* s = (const float4*)(p.in[3] + e);
    float4 a = s[0], c = s[1];
    size_t d = ((size_t)((l * 2 + b) * 256 + t)) * 512 + n;
    *(uint4*)(ws + OFF_KC + d * 2) = make_uint4(pack2(a.x, a.y), pack2(a.z, a.w), pack2(c.x, c.y), pack2(c.z, c.w));
    return;
  }
  item -= 128;
  {
    int idx = item * 512 + tid;
    int v = idx & 127, tc = (idx >> 7) & 31, h = (idx >> 12) & 3, b = (idx >> 14) & 1, l = idx >> 15;
    float vv[8];
#pragma unroll
    for (int j = 0; j < 8; ++j) vv[j] = p.in[4][((size_t)((b * 2 + l) * 256 + tc * 8 + j)) * 512 + h * 128 + v];
    size_t d = ((size_t)((b * 4 + h) * 128 + v)) * 2304 + 2048 + tc * 8;
    *(uint4*)(ws + OFF_VTL + l * SZ_VTL + d * 2) = make_uint4(pack2(vv[0], vv[1]), pack2(vv[2], vv[3]), pack2(vv[4], vv[5]), pack2(vv[6], vv[7]));
  }
}
constexpr int P0_ITEMS = 96 + 128 + 2048 + 32 + 8 + 128 + 128;

__device__ __forceinline__ void p1_item(const Params& p, int l, int item, char* lds) {
  const int tid = otid();
  char* ws = p.ws;
  if (item < 2816) {
    const float* src; int lsrc; u16* dst; int ldd; int kt, nt;
    const float* w10 = p.in[10]; const float* w17 = p.in[17]; const float* w18 = p.in[18]; const float* w19 = p.in[19]; const float* w20 = p.in[20];
    if (item < 2176) { src = w10 + (size_t)l * 1024 * 8704; lsrc = 8704; dst = (u16*)(ws + OFF_WIN); ldd = 1024; nt = item >> 4; kt = item & 15; }
    else if (item < 2560) { int r = item - 2176; int j = r >> 7; r &= 127; src = ((j == 0) ? w17 : ((j == 1) ? w18 : w19)) + (size_t)l * 512 * 1024; lsrc = 1024; dst = (u16*)(ws + OFF_WBR) + (size_t)j * 1024 * 512; ldd = 512; nt = r >> 3; kt = r & 7; }
    else { int r = item - 2560; src = w20 + (size_t)l * 1024 * 1024; lsrc = 1024; dst = (u16*)(ws + OFF_WO); ldd = 1024; nt = r >> 4; kt = r & 15; }
    u16* T = (u16*)lds;
    const int k0 = kt * 64, n0 = nt * 64;
#pragma unroll
    for (int ps = 0; ps < 2; ++ps) {
      int kr = (tid >> 4) + 32 * ps, nq = tid & 15;
      float4 v = *(const float4*)(src + (size_t)(k0 + kr) * lsrc + n0 + 4 * nq);
      T[(4 * nq + 0) * 72 + kr] = f2bf(v.x); T[(4 * nq + 1) * 72 + kr] = f2bf(v.y);
      T[(4 * nq + 2) * 72 + kr] = f2bf(v.z); T[(4 * nq + 3) * 72 + kr] = f2bf(v.w);
    }
    __syncthreads();
    {
      int n = tid >> 3, kc = tid & 7;
      uint4 o = *(const uint4*)(T + n * 72 + kc * 8);
      *(uint4*)(dst + (size_t)(n0 + n) * ldd + k0 + kc * 8) = o;
    }
    __syncthreads();
    return;
  }
  item -= 2816;
  const int lane = tid & 63, wid = tid >> 6;
  const float* modp = (const float*)(ws + OFF_MOD);
  u16* H = (u16*)(ws + OFF_H);
  const float* xin0 = p.in[0]; const float* xin1 = p.in[1]; const float* xin2 = p.out; const float* ng = p.in[9];
#pragma unroll
  for (int rr = 0; rr < 2; ++rr) {
    int r = item * 16 + wid * 2 + rr;
    const float* x = (l == 0) ? ((r < NCTX) ? xin0 + (size_t)r * 1024 : xin1 + (size_t)(r - NCTX) * 1024) : xin2 + (size_t)r * 1024;
    int ci = (r < NCTX) ? 0 : 1 + ((r - NCTX) >> 11);
    float4 v[4]; float ss = 0.f;
#pragma unroll
    for (int i = 0; i < 4; ++i) { v[i] = *(const float4*)(x + lane * 4 + 256 * i); ss += v[i].x * v[i].x + v[i].y * v[i].y + v[i].z * v[i].z + v[i].w * v[i].w; }
#pragma unroll
    for (int o = 32; o >= 1; o >>= 1) ss += __shfl_xor(ss, o);
    float rinv = rsqrtf(ss * (1.f / 1024.f) + EPSV);
    const float* sh = modp + (l * 3 + ci) * 3072;
#pragma unroll
    for (int i = 0; i < 4; ++i) {
      int col = lane * 4 + 256 * i;
      float4 g = *(const float4*)(ng + l * 1024 + col);
      float4 s1 = *(const float4*)(sh + 1024 + col);
      float4 s0 = *(const float4*)(sh + col);
      float a = v[i].x * rinv * g.x * (1.f + s1.x) + s0.x;
      float b = v[i].y * rinv * g.y * (1.f + s1.y) + s0.y;
      float c = v[i].z * rinv * g.z * (1.f + s1.z) + s0.z;
      float d = v[i].w * rinv * g.w * (1.f + s1.w) + s0.w;
      *(uint2*)(H + (size_t)r * 1024 + col) = make_uint2(pack2(a, b), pack2(c, d));
    }
  }
}
constexpr int P1_ITEMS = 2816 + 768;

__device__ __forceinline__ void stagger_us(int us) {
  const unsigned long long t0 = __builtin_amdgcn_s_memrealtime();
  while (__builtin_amdgcn_s_memrealtime() - t0 < (unsigned long long)us * 100ull) __builtin_amdgcn_s_sleep(8);
}
#define STAGGER_US 0
struct P2Sched {
  const char* H; const char* W; int G, c;
  __device__ __forceinline__ bool next(int i, Unit& u) const {
    const int L = i * G + c;
    if (L >= 1024) return false;
    if (L < 960) {
      const int nM = 48, nN = 20, nwg = 960;
      int wgid = L; { const int q = nwg / 8, xcd = wgid % 8, off = wgid / 8; wgid = xcd * q + off; }
      const int nig = 8 * nN, gid = wgid / nig, fm = gid * 8, gsz = (nM - fm) < 8 ? (nM - fm) : 8;
      int pm = fm + ((wgid % nig) % gsz), pn = (wgid % nig) / gsz;
      if (pn >= 14) pn += 2;
      u.a = H + (size_t)pm * 256 * 2048; u.b = W + (size_t)pn * 256 * 2048; u.x = pm; u.y = pn;
      u.lda = 1024; u.ldb = 1024; u.nt = 16; u.perm = ((pn >> 1) == 5 || (pn >> 1) == 6) ? 0 : 1;
    } else {
      const int r = L - 960; const int vq = r / 48, mt = r % 48;
      u.a = W + (size_t)(3584 + vq * 256) * 2048; u.b = H + (size_t)mt * 256 * 2048; u.x = vq; u.y = mt | 0x100;
      u.lda = 1024; u.ldb = 1024; u.nt = 16; u.perm = 0;
    }
    return true;
  }
};
struct P2Epi {
  const float* const* pin; float* out; char* ws; int l;
  const float* hlb; const float* qng; const float* kng; bool skip;
  __device__ __forceinline__ void operator()(f32x4 (&acc)[2][2][4][2], const Unit& u, int wr, int wc, int fr, int fq, LAS unsigned char* lds) const {
    if (skip) return;
    { const int t_ = otid(); const int w_ = t_ >> 6; wr = w_ >> 2; wc = w_ & 3; fr = t_ & 15; fq = (t_ & 63) >> 4; }
    if (u.y & 0x100) {
      const int mt = u.y & 0xff, vq = u.x;
#pragma unroll
      for (int ai = 0; ai < 2; ++ai)
#pragma unroll
        for (int m = 0; m < 4; ++m) {
          const int nn = vq * 256 + ai * 128 + wr * 64 + m * 16 + fr;
          const int hh = nn >> 7, v = nn & 127;
#pragma unroll
          for (int bj = 0; bj < 2; ++bj)
#pragma unroll
            for (int n = 0; n < 2; ++n) {
              const int tokl = bj * 128 + wc * 32 + n * 16 + 4 * fq;
              f32x4 a4 = acc[ai][bj][m][n];
              uint2 pk = make_uint2(pack2(a4[0], a4[1]), pack2(a4[2], a4[3]));
              if (mt < 32) {
                *(uint2*)(ws + OFF_VTC + ((size_t)((mt * 4 + hh) * 128 + v) * 256 + tokl) * 2) = pk;
                float* o = out + OCV + ((size_t)((mt * 2 + l) * 256 + tokl)) * 512 + nn;
                o[0] = a4[0]; o[512] = a4[1]; o[1024] = a4[2]; o[1536] = a4[3];
              } else {
                int rp = (mt - 32) * 256 + tokl; int bb = rp >> 11, t = rp & 2047;
                *(uint2*)(ws + OFF_VTL + l * SZ_VTL + ((size_t)((bb * 4 + hh) * 128 + v) * 2304 + t) * 2) = pk;
              }
            }
        }
      return;
    }
    const int pm = u.x, pn = u.y, seg = pn >> 1, ncol0 = (pn & 1) * 256;
    const int dcol0 = ((seg < 7) ? seg : seg - 1) * 512 + ncol0;
    u16* proj = (u16*)(ws + OFF_PROJ);
    const bool lat = (pm >= 32);
    if (seg == 5 || seg == 6) {
      float* xch = (float*)(lds + G8_STAGE_BYTES);
#pragma unroll
      for (int ai = 0; ai < 2; ++ai)
#pragma unroll
        for (int m = 0; m < 4; ++m)
#pragma unroll
          for (int bj = 0; bj < 2; ++bj) {
            float ss = 0.f;
#pragma unroll
            for (int n = 0; n < 2; ++n)
#pragma unroll
              for (int e = 0; e < 4; ++e) { float bfv = bf2f(f2bf(acc[ai][bj][m][n][e])); ss += bfv * bfv; }
            ss += __shfl_xor(ss, 16); ss += __shfl_xor(ss, 32);
            if (fq == 0) xch[((ai * 128 + wr * 64 + m * 16 + fr) * 2 + bj) * 4 + wc] = ss;
          }
      asm volatile("s_waitcnt lgkmcnt(0)" ::: "memory");
      __builtin_amdgcn_s_barrier();
      asm volatile("" ::: "memory");
      const float* gsel = (seg == 5) ? qng : kng;
      float gv[2][4];
#pragma unroll
      for (int n = 0; n < 2; ++n)
#pragma unroll
        for (int e = 0; e < 4; ++e) gv[n][e] = gsel[l * 64 + 32 * (wc & 1) + 16 * n + 4 * fq + e];
#pragma unroll
      for (int ai = 0; ai < 2; ++ai)
#pragma unroll
        for (int m = 0; m < 4; ++m) {
          const int rl = ai * 128 + wr * 64 + m * 16 + fr;
          const int grow = pm * 256 + rl;
#pragma unroll
          for (int bj = 0; bj < 2; ++bj) {
            const float2 pr = *(const float2*)&xch[(rl * 2 + bj) * 4 + (wc & 2)];
            const float tot = pr.x + pr.y;
            const float rinv = rsqrtf(tot * (1.f / 64.f) + EPSV);
            float x[2][4];
#pragma unroll
            for (int n = 0; n < 2; ++n)
#pragma unroll
              for (int e = 0; e < 4; ++e) x[n][e] = bf2f(f2bf(acc[ai][bj][m][n][e])) * rinv * gv[n][e];
            const int colt = ncol0 + bj * 128 + wc * 32;
            if (seg == 6 && !lat) {
              float* o = out + OCK + ((size_t)((pm * 2 + l) * 256 + rl)) * 512 + colt + 4 * fq;
              *(float4*)o = make_float4(x[0][0], x[0][1], x[0][2], x[0][3]);
              *(float4*)(o + 16) = make_float4(x[1][0], x[1][1], x[1][2], x[1][3]);
            }
            if (lat) {
              const int t = (grow - NCTX) & 2047;
              const float2* rt = (const float2*)(ws + OFF_ROPE) + t * 32 + ((wc & 1) ? 16 : 0) + 4 * fq;
#pragma unroll
              for (int e = 0; e < 4; ++e) {
                float2 cs = rt[e];
                float x1 = x[0][e], x2 = x[1][e];
                x[0][e] = x1 * cs.x - x2 * cs.y;
                x[1][e] = x1 * cs.y + x2 * cs.x;
              }
            }
            if (seg == 5) {
#pragma unroll
              for (int n = 0; n < 2; ++n)
#pragma unroll
                for (int e = 0; e < 4; ++e) x[n][e] *= 0.125f;
            }
            u16* dp = proj + (size_t)grow * LDP + dcol0 + bj * 128 + wc * 32 + 4 * fq;
            *(uint2*)dp = make_uint2(pack2(x[0][0], x[0][1]), pack2(x[0][2], x[0][3]));
            *(uint2*)(dp + 16) = make_uint2(pack2(x[1][0], x[1][1]), pack2(x[1][2], x[1][3]));
          }
        }
      return;
    }
    const bool dosilu = (seg == 0 || seg == 4 || seg == 8 || seg == 10);
    const bool dolf = (seg == 1 || seg == 2);
    const int dir = (seg == 2) ? 1 : 0;
#define P2_STORE16(A0, A1) *(uint4*)(proj + (size_t)grow * LDP + dcol0 + bj * 128 + wc * 32 + 8 * fq) = make_uint4(pack2(A0[0], A0[1]), pack2(A0[2], A0[3]), pack2(A1[0], A1[1]), pack2(A1[2], A1[3]))
    if (dosilu) {
#pragma unroll
      for (int ai = 0; ai < 2; ++ai)
#pragma unroll
        for (int m = 0; m < 4; ++m) {
          const int grow = pm * 256 + ai * 128 + wr * 64 + m * 16 + fr;
#pragma unroll
          for (int bj = 0; bj < 2; ++bj) {
            f32x4 a0 = acc[ai][bj][m][0], a1 = acc[ai][bj][m][1];
#pragma unroll
            for (int e = 0; e < 4; ++e) { a0[e] = siluf(a0[e]); a1[e] = siluf(a1[e]); }
            P2_STORE16(a0, a1);
          }
        }
    } else if (dolf) {
#pragma unroll
      for (int bj = 0; bj < 2; ++bj) {
        float lbv[2][4];
#pragma unroll
        for (int n = 0; n < 2; ++n)
#pragma unroll
          for (int e = 0; e < 4; ++e) {
            int j = ncol0 + bj * 128 + wc * 32 + 8 * fq + 4 * n + e;
            lbv[n][e] = (l == 0) ? 0.f : sigmf(hlb[(1 * 2 + dir) * 512 + j] - hlb[(0 * 2 + dir) * 512 + j]);
          }
#pragma unroll
        for (int ai = 0; ai < 2; ++ai)
#pragma unroll
          for (int m = 0; m < 4; ++m) {
            const int grow = pm * 256 + ai * 128 + wr * 64 + m * 16 + fr;
            f32x4 a0 = acc[ai][bj][m][0], a1 = acc[ai][bj][m][1];
#pragma unroll
            for (int e = 0; e < 4; ++e) { a0[e] = logf_gate(a0[e], lbv[0][e]); a1[e] = logf_gate(a1[e], lbv[1][e]); }
            P2_STORE16(a0, a1);
          }
      }
    } else {
#pragma unroll
      for (int ai = 0; ai < 2; ++ai)
#pragma unroll
        for (int m = 0; m < 4; ++m) {
          const int grow = pm * 256 + ai * 128 + wr * 64 + m * 16 + fr;
#pragma unroll
          for (int bj = 0; bj < 2; ++bj) {
            f32x4 a0 = acc[ai][bj][m][0], a1 = acc[ai][bj][m][1];
            P2_STORE16(a0, a1);
          }
        }
    }
  }
};
__device__ __forceinline__ void p2_left_item(const Params& p, int l, int L, char* lds) {
  P2Sched S0; S0.H = p.ws + OFF_H; S0.W = p.ws + OFF_WIN; S0.G = 0x40000000; S0.c = 0;
  OneUnit S;
  {
    const int r = L - 960; const int vq = r / 48, mt = r % 48;
    S.u.a = S0.W + (size_t)(3584 + vq * 256) * 2048; S.u.b = S0.H + (size_t)mt * 256 * 2048; S.u.x = vq; S.u.y = mt | 0x100;
    S.u.lda = 1024; S.u.ldb = 1024; S.u.nt = 16;
  }
  P2Epi E; E.pin = nullptr; E.out = p.out; E.ws = p.ws; E.l = l; E.hlb = p.in[11]; E.qng = p.in[13]; E.kng = p.in[14]; E.skip = false;
  gemm_phase((LAS unsigned char*)lds, S, E);
}
__device__ __forceinline__ void p2_phase(const Params& p, int l, char* lds, bool skip = false) {
  if (STAGGER_US && ((blockIdx.x >> 3) & 1)) stagger_us(STAGGER_US);
  P2Sched S; S.H = p.ws + OFF_H; S.W = p.ws + OFF_WIN; S.G = gridDim.x; S.c = blockIdx.x;
  P2Epi E; E.pin = nullptr; E.out = p.out; E.ws = p.ws; E.l = l; E.hlb = p.in[11]; E.qng = p.in[13]; E.kng = p.in[14]; E.skip = skip;
  gemm_phase((LAS unsigned char*)lds, S, E);
}

struct HgrnLds {
  float tot[4][128];
  float dk[128];
  float osum[16][132];
  u16 qt[16][136];
  u16 kt[16][136];
  u16 khT[128][16];
  u16 vT[128][16];
  u16 zt[16][136];
  u16 obuf[256][136];
};

#define LBAR() do { asm volatile("s_waitcnt lgkmcnt(0)" ::: "memory"); __builtin_amdgcn_s_barrier(); asm volatile("" ::: "memory"); } while (0)
__device__ __forceinline__ void hgrn_pass(const Params& p, int l, int row0, int ntok, int h, int dir, f32x4 (&S)[8],
                                          const bool do_out, const bool second, float& gsum, HgrnLds& L, const bool dry = false) {
  const int tid = otid(), lane = tid & 63, wid = tid >> 6, c16 = lane & 15, g = lane >> 4;
  const int kk = tid & 127, tq = tid >> 7;
  const u16* proj = (const u16*)(p.ws + OFF_PROJ);
  u16* projw = (u16*)(p.ws + OFF_PROJ);
  const int nch = ntok >> 4;
  float4 gg = make_float4(0.f, 0.f, 0.f, 0.f);
  if (second) gg = *(const float4*)(p.in[12] + l * 512 + h * 128 + 4 * (tid & 31));
  u16 lfA[4], qA[4], vA[4], zA[4], lfB[4], qB[4], vB[4], zB[4];
#define HG_LD(c_, LF, QQ, VV, ZZ)                                                    \
  {                                                                                  \
    _Pragma("unroll") for (int i = 0; i < 4; ++i) {                                  \
      int s_ = (c_) * 16 + 4 * tq + i;                                               \
      int tl_ = dir ? (ntok - 1 - s_) : s_;                                          \
      const u16* rp_ = proj + (size_t)(row0 + tl_) * LDP + h * 128 + kk;             \
      LF[i] = rp_[PLF + dir * 512];                                                  \
      VV[i] = rp_[PIA];                                                              \
      QQ[i] = do_out ? rp_[PQA] : (u16)0;                                            \
      ZZ[i] = second ? rp_[PZA] : (u16)0;                                            \
    }                                                                                \
  }
  HG_LD(0, lfA, qA, vA, zA);
  HG_LD(1, lfB, qB, vB, zB);
  auto body = [&](const int c, u16 (&LF)[4], u16 (&QQ)[4], u16 (&VV)[4], u16 (&ZZ)[4]) __attribute__((always_inline)) {
    float lf[4], G[4], qv[4];
    u16 vv[4], zz[4];
#pragma unroll
    for (int i = 0; i < 4; ++i) { lf[i] = bf2f(LF[i]); qv[i] = bf2f(QQ[i]); vv[i] = VV[i]; zz[i] = ZZ[i]; }
    G[0] = lf[0]; G[1] = G[0] + lf[1]; G[2] = G[1] + lf[2]; G[3] = G[2] + lf[3];
    L.tot[tq][kk] = G[3];
    LBAR();
    if (c + 2 < nch) HG_LD(c + 2, LF, QQ, VV, ZZ);
    float t0 = L.tot[0][kk], t1 = L.tot[1][kk], t2 = L.tot[2][kk], t3 = L.tot[3][kk];
    float off = (tq > 0 ? t0 : 0.f) + (tq > 1 ? t1 : 0.f) + (tq > 2 ? t2 : 0.f);
    float gend = t0 + t1 + t2 + t3;
    float kh[4];
#pragma unroll
    for (int i = 0; i < 4; ++i) {
      float Gi = G[i] + off;
      float kv = neg_expm1(lf[i]);
      int s = 4 * tq + i;
      if (do_out) {
        L.qt[s][kk] = f2bf(qv[i] * fexp(Gi));
        L.kt[s][kk] = f2bf(kv * fexp(fminf(-Gi, 80.f)));
      }
      if (second) L.zt[s][kk] = zz[i];
      kh[i] = kv * fexp(gend - Gi);
    }
    *(uint2*)&L.khT[kk][4 * tq] = make_uint2(pack2(kh[0], kh[1]), pack2(kh[2], kh[3]));
    *(uint2*)&L.vT[kk][4 * tq] = make_uint2((uint32_t)vv[0] | ((uint32_t)vv[1] << 16), (uint32_t)vv[2] | ((uint32_t)vv[3] << 16));
    if (tq == 0) { L.dk[kk] = fexp(gend); gsum += gend; }
    LBAR();
    Frag bv;
    bv.h[0] = *(const uint2*)&L.vT[16 * wid + c16][4 * g];
    bv.h[1] = make_uint2(0u, 0u);
    f32x4 o = f32x4{0.f, 0.f, 0.f, 0.f};
    if (do_out) {
      f32x4 at = f32x4{0.f, 0.f, 0.f, 0.f};
#pragma unroll
      for (int ks = 0; ks < 4; ++ks) {
        Frag a, b;
        a.q = *(const uint4*)&L.kt[c16][32 * ks + 8 * g];
        b.q = *(const uint4*)&L.qt[c16][32 * ks + 8 * g];
        at = MFMA(a.v, b.v, at);
      }
      Frag pa;
#pragma unroll
      for (int r = 0; r < 4; ++r) at[r] = (4 * g + r <= c16) ? at[r] : 0.f;
      pa.w[0] = pack2(at[0], at[1]); pa.w[1] = pack2(at[2], at[3]); pa.w[2] = 0u; pa.w[3] = 0u;
      o = MFMA(pa.v, bv.v, o);
#pragma unroll
      for (int st = 0; st < 4; ++st) {
        Frag a, b;
        a.h[0] = *(const uint2*)&L.qt[c16][32 * st + 4 * g];
        a.h[1] = *(const uint2*)&L.qt[c16][32 * st + 16 + 4 * g];
        b.w[0] = pack2(S[2 * st][0], S[2 * st][1]); b.w[1] = pack2(S[2 * st][2], S[2 * st][3]);
        b.w[2] = pack2(S[2 * st + 1][0], S[2 * st + 1][1]); b.w[3] = pack2(S[2 * st + 1][2], S[2 * st + 1][3]);
        o = MFMA(a.v, b.v, o);
      }
    }
#pragma unroll
    for (int k8 = 0; k8 < 8; ++k8) {
      float4 d = *(const float4*)&L.dk[16 * k8 + 4 * g];
      f32x4 s0 = S[k8];
      s0[0] *= d.x; s0[1] *= d.y; s0[2] *= d.z; s0[3] *= d.w;
      Frag a;
      a.h[0] = *(const uint2*)&L.khT[16 * k8 + c16][4 * g];
      a.h[1] = make_uint2(0u, 0u);
      S[k8] = MFMA(a.v, bv.v, s0);
    }
    if (do_out) {
      const int vcol = 16 * wid + c16;
      if (!second) {
#pragma unroll
        for (int r = 0; r < 4; ++r) {
          int s = c * 16 + 4 * g + r;
          int tl = dir ? (ntok - 1 - s) : s;
          L.obuf[tl][vcol] = f2bf(o[r]);
        }
      } else {
#pragma unroll
        for (int r = 0; r < 4; ++r) {
          int s = c * 16 + 4 * g + r;
          int tl = dir ? (ntok - 1 - s) : s;
          L.osum[4 * g + r][vcol] = o[r] + bf2f(L.obuf[tl][vcol]);
        }
        LBAR();
        {
          int sl = tid >> 5, vq = tid & 31;
          int s = c * 16 + sl;
          int tl = dir ? (ntok - 1 - s) : s;
          float4 ov = *(const float4*)&L.osum[sl][4 * vq];
          float ss = ov.x * ov.x + ov.y * ov.y + ov.z * ov.z + ov.w * ov.w;
#pragma unroll
          for (int m = 1; m <= 16; m <<= 1) ss += __shfl_xor(ss, m);
          float rinv = rsqrtf(ss * (1.f / 128.f) + EPSV);
          u16* rp = projw + (size_t)(row0 + tl) * LDP + h * 128 + 4 * vq;
          uint2 z = *(const uint2*)&L.zt[sl][4 * vq];
          float y0 = ov.x * rinv * gg.x * lo2f(z.x), y1 = ov.y * rinv * gg.y * hi2f(z.x);
          float y2 = ov.z * rinv * gg.z * lo2f(z.y), y3 = ov.w * rinv * gg.w * hi2f(z.y);
          if (!dry) *(uint2*)(rp + PQA) = make_uint2(pack2(y0, y1), pack2(y2, y3));
        }
      }
    }
  };
  for (int c = 0; c < nch; c += 2) {
    body(c, lfA, qA, vA, zA);
    body(c + 1, lfB, qB, vB, zB);
  }
  __syncthreads();
}

__device__ __forceinline__ void hgrn_load_state(const float* m, f32x4 (&S)[8]) {
  const int tid_ = otid(); const int lane = tid_ & 63, wid = tid_ >> 6, c16 = lane & 15, g = lane >> 4;
#pragma unroll
  for (int k8 = 0; k8 < 8; ++k8)
#pragma unroll
    for (int r = 0; r < 4; ++r) S[k8][r] = m[(16 * k8 + 4 * g + r) * 128 + 16 * wid + c16];
}
__device__ __forceinline__ void hgrn_store_state(float* m, const f32x4 (&S)[8]) {
  const int tid_ = otid(); const int lane = tid_ & 63, wid = tid_ >> 6, c16 = lane & 15, g = lane >> 4;
#pragma unroll
  for (int k8 = 0; k8 < 8; ++k8)
#pragma unroll
    for (int r = 0; r < 4; ++r) m[(16 * k8 + 4 * g + r) * 128 + 16 * wid + c16] = S[k8][r];
}
__device__ __forceinline__ void hgrn_advance(const float* U, const float* D, f32x4 (&S)[8]) {
  const int tid_ = otid(); const int lane = tid_ & 63, wid = tid_ >> 6, c16 = lane & 15, g = lane >> 4;
#pragma unroll
  for (int k8 = 0; k8 < 8; ++k8)
#pragma unroll
    for (int r = 0; r < 4; ++r) {
      int k = 16 * k8 + 4 * g + r;
      S[k8][r] = D[k] * S[k8][r] + U[k * 128 + 16 * wid + c16];
    }
}

__device__ __forceinline__ void hgrn_ctx_item(const Params& p, int l, int item, char* lds, const bool dry = false) {
  HgrnLds& L = *(HgrnLds*)lds;
  const int b = item >> 2, h = item & 3;
  f32x4 S[8];
  float gsum = 0.f;
#pragma unroll
  for (int i = 0; i < 8; ++i) S[i] = f32x4{0.f, 0.f, 0.f, 0.f};
  hgrn_pass(p, l, b * 256, 256, h, 0, S, true, false, gsum, L, dry);
  if (!dry) hgrn_store_state(p.out + OST + ((size_t)(((b * 2 + l) * 2 + 0) * 4 + h)) * 16384, S);
#pragma unroll
  for (int i = 0; i < 8; ++i) S[i] = f32x4{0.f, 0.f, 0.f, 0.f};
  hgrn_pass(p, l, b * 256, 256, h, 1, S, true, true, gsum, L, dry);
  if (!dry) hgrn_store_state(p.out + OST + ((size_t)(((b * 2 + l) * 2 + 1) * 4 + h)) * 16384, S);
}
__device__ __forceinline__ void hgrn_lat1_item(const Params& p, int l, int item, char* lds) {
  HgrnLds& L = *(HgrnLds*)lds;
  const int seg = item & 15, dir = (item >> 4) & 1, h = (item >> 5) & 3, b = item >> 7;
  f32x4 S[8];
  float gsum = 0.f;
#pragma unroll
  for (int i = 0; i < 8; ++i) S[i] = f32x4{0.f, 0.f, 0.f, 0.f};
  hgrn_pass(p, l, NCTX + b * 2048 + seg * 128, 128, h, dir, S, false, false, gsum, L);
  float* SU = (float*)(p.ws + OFF_SEGU);
  float* SD = (float*)(p.ws + OFF_SEGD);
  {
    const int tq_ = otid(); const int lane_ = tq_ & 63, wid_ = tq_ >> 6, c16_ = lane_ & 15, g_ = lane_ >> 4;
    float* m_ = SU + (size_t)item * 16384;
#pragma unroll
    for (int k8 = 0; k8 < 8; ++k8)
#pragma unroll
      for (int r = 0; r < 4; ++r) __hip_atomic_store(m_ + (16 * k8 + 4 * g_ + r) * 128 + 16 * wid_ + c16_, S[k8][r], __ATOMIC_RELAXED, __HIP_MEMORY_SCOPE_AGENT);
  }
  const int t_ = otid();
  if (t_ < 128) __hip_atomic_store(SD + item * 128 + t_, fexp(gsum), __ATOMIC_RELAXED, __HIP_MEMORY_SCOPE_AGENT);
  volatile int* flag = (volatile int*)(lds + LDS_TILE + 32);
  asm volatile("s_waitcnt vmcnt(0)" ::: "memory");
  __syncthreads();
  if (t_ == 0) {
    unsigned* tk = (unsigned*)(p.ws + OFF_CNT) + 8 + l * 32 + (item >> 4);
    const unsigned old = __hip_atomic_fetch_add(tk, 1u, __ATOMIC_RELAXED, __HIP_MEMORY_SCOPE_AGENT);
    const int last = (old == 15u) ? 1 : 0;
    if (last) { __builtin_amdgcn_fence(__ATOMIC_ACQUIRE, "agent"); asm volatile("s_waitcnt vmcnt(0)" ::: "memory"); }
    *flag = last;
  }
  __syncthreads();
  if (*flag) {
    const int base = (item >> 4) * 16;
    hgrn_load_state(p.in[5] + ((size_t)(((b * 2 + l) * 2 + dir) * 4 + h)) * 16384, S);
    const int lane = t_ & 63, wid = t_ >> 6, c16 = lane & 15, g = lane >> 4;
    float un[8][4]; float4 dn[8];
    {
      const int sg0 = dir ? 15 : 0;
      const float* U0 = SU + (size_t)(base + sg0) * 16384; const float* D0 = SD + (base + sg0) * 128;
#pragma unroll
      for (int k8 = 0; k8 < 8; ++k8) {
        dn[k8] = *(const float4*)(D0 + 16 * k8 + 4 * g);
#pragma unroll
        for (int r = 0; r < 4; ++r) un[k8][r] = U0[(16 * k8 + 4 * g + r) * 128 + 16 * wid + c16];
      }
    }
#pragma unroll 1
    for (int i = 0; i < 16; ++i) {
      const int sg = dir ? (15 - i) : i;
      float* U = SU + (size_t)(base + sg) * 16384;
      float uc[8][4]; float4 dc[8];
#pragma unroll
      for (int k8 = 0; k8 < 8; ++k8) { dc[k8] = dn[k8];
#pragma unroll
        for (int r = 0; r < 4; ++r) uc[k8][r] = un[k8][r]; }
      if (i + 1 < 16) {
        const int sgn = dir ? (14 - i) : (i + 1);
        const float* Un = SU + (size_t)(base + sgn) * 16384; const float* Dn = SD + (base + sgn) * 128;
#pragma unroll
        for (int k8 = 0; k8 < 8; ++k8) {
          dn[k8] = *(const float4*)(Dn + 16 * k8 + 4 * g);
#pragma unroll
          for (int r = 0; r < 4; ++r) un[k8][r] = Un[(16 * k8 + 4 * g + r) * 128 + 16 * wid + c16];
        }
      }
#pragma unroll
      for (int k8 = 0; k8 < 8; ++k8) {
        const float dd[4] = {dc[k8].x, dc[k8].y, dc[k8].z, dc[k8].w};
#pragma unroll
        for (int r = 0; r < 4; ++r) {
          const int idx = (16 * k8 + 4 * g + r) * 128 + 16 * wid + c16;
          U[idx] = S[k8][r];
          S[k8][r] = dd[r] * S[k8][r] + uc[k8][r];
        }
      }
    }
  }
  __syncthreads();
}
__device__ __forceinline__ void hgrn_lat2_item(const Params& p, int l, int item, char* lds, const bool dry = false) {
  HgrnLds& L = *(HgrnLds*)lds;
  const int seg = item & 15, h = (item >> 4) & 3, b = item >> 6;
  const float* SU = (const float*)(p.ws + OFF_SEGU);
  const float* SD = (const float*)(p.ws + OFF_SEGD);
  f32x4 S[8];
  float gsum = 0.f;
  hgrn_load_state(SU + (size_t)(((b * 4 + h) * 2 + 0) * 16 + seg) * 16384, S);
  hgrn_pass(p, l, NCTX + b * 2048 + seg * 128, 128, h, 0, S, true, false, gsum, L, dry);
  hgrn_load_state(SU + (size_t)(((b * 4 + h) * 2 + 1) * 16 + seg) * 16384, S);
  hgrn_pass(p, l, NCTX + b * 2048 + seg * 128, 128, h, 1, S, true, true, gsum, L, dry);
}

__device__ __forceinline__ void attn_item(const Params& p, int l, int item, const bool lat, char* lds, const bool dry = false) {
  const int tid = otid(), lane = tid & 63, wid = tid >> 6, c16 = lane & 15, g = lane >> 4;
  char* ws = p.ws;
  u16* proj = (u16*)(ws + OFF_PROJ);
  int b, h, qb, nkeys, rowbase;
  const u16* Vt; int ldv;
  if (!lat) { qb = item & 1; h = (item >> 1) & 3; b = item >> 3; nkeys = 256; rowbase = b * 256; Vt = (const u16*)(ws + OFF_VTC) + (size_t)((b * 4 + h) * 128) * 256; ldv = 256; }
  else { qb = item & 15; h = (item >> 4) & 3; b = item >> 6; nkeys = 2304; rowbase = NCTX + b * 2048; Vt = (const u16*)(ws + OFF_VTL + l * SZ_VTL) + (size_t)((b * 4 + h) * 128) * 2304; ldv = 2304; }
  const u16* Kc = (const u16*)(ws + OFF_KC) + (size_t)((l * 2 + b) * 256) * 512 + h * 128;
  u16* Ks = (u16*)lds;
  u16* Vs = Ks + 64 * 136;
  float lam_init = 0.8f - 0.6f * expf(-0.3f * (float)l);
  float lam;
  {
    const float* lp = p.in[15] + l * 256;
    float a = lp[lane] * lp[64 + lane], c = lp[128 + lane] * lp[192 + lane];
#pragma unroll
    for (int o = 32; o >= 1; o >>= 1) { a += __shfl_xor(a, o); c += __shfl_xor(c, o); }
    lam = expf(a) - expf(c) + lam_init;
  }
  const int qrow = rowbase + qb * 128 + wid * 16 + c16;
  Frag qf[2][2];
#pragma unroll
  for (int m = 0; m < 2; ++m)
#pragma unroll
    for (int ks = 0; ks < 2; ++ks) qf[m][ks].q = *(const uint4*)(proj + (size_t)qrow * LDP + PQB + h * 128 + m * 64 + ks * 32 + g * 8);
  f32x4 O[2][8];
#pragma unroll
  for (int m = 0; m < 2; ++m)
#pragma unroll
    for (int v = 0; v < 8; ++v) O[m][v] = f32x4{0.f, 0.f, 0.f, 0.f};
  float mrun[2] = {-1e30f, -1e30f}, lsum[2] = {0.f, 0.f};
  uint4 kr0, kr1, vr0, vr1;
#define ATT_LD(kt_)                                                                                           \
  {                                                                                                           \
    const int key0 = (kt_) * 64;                                                                              \
    const bool fromproj = (!lat) || (key0 < 2048);                                                            \
    {                                                                                                         \
      int q = tid; int key = q >> 4, cc = q & 15;                                                             \
      const u16* src = fromproj ? proj + (size_t)(rowbase + key0 + key) * LDP + PKB + h * 128 + cc * 8        \
                                : Kc + (size_t)(key0 - 2048 + key) * 512 + cc * 8;                            \
      kr0 = *(const uint4*)src;                                                                               \
      int v = q >> 3, c8 = q & 7;                                                                             \
      vr0 = *(const uint4*)(Vt + (size_t)v * ldv + key0 + c8 * 8);                                            \
    }                                                                                                         \
    {                                                                                                         \
      int q = tid + 512; int key = q >> 4, cc = q & 15;                                                       \
      const u16* src = fromproj ? proj + (size_t)(rowbase + key0 + key) * LDP + PKB + h * 128 + cc * 8        \
                                : Kc + (size_t)(key0 - 2048 + key) * 512 + cc * 8;                            \
      kr1 = *(const uint4*)src;                                                                               \
      int v = q >> 3, c8 = q & 7;                                                                             \
      vr1 = *(const uint4*)(Vt + (size_t)v * ldv + key0 + c8 * 8);                                            \
    }                                                                                                         \
  }
#define ATT_ST()                                                                                              \
  {                                                                                                           \
    { int q = tid; int key = q >> 4, cc = q & 15; *(uint4*)(Ks + key * 136 + cc * 8) = kr0;                   \
      int v = q >> 3, c8 = q & 7; *(uint4*)(Vs + v * 72 + c8 * 8) = vr0; }                                    \
    { int q = tid + 512; int key = q >> 4, cc = q & 15; *(uint4*)(Ks + key * 136 + cc * 8) = kr1;             \
      int v = q >> 3, c8 = q & 7; *(uint4*)(Vs + v * 72 + c8 * 8) = vr1; }                                    \
  }
  const int nkt = nkeys >> 6;
  ATT_LD(0);
  for (int kt = 0; kt < nkt; ++kt) {
    LBAR();
    ATT_ST();
    LBAR();
    if (kt + 1 < nkt) ATT_LD(kt + 1);
    Frag pf[2][2];
#pragma unroll
    for (int m = 0; m < 2; ++m) {
      f32x4 s[4];
#pragma unroll
      for (int k4 = 0; k4 < 4; ++k4) {
        s[k4] = f32x4{0.f, 0.f, 0.f, 0.f};
#pragma unroll
        for (int ks = 0; ks < 2; ++ks) {
          Frag a;
          a.q = *(const uint4*)(Ks + (16 * k4 + c16) * 136 + m * 64 + ks * 32 + g * 8);
          s[k4] = MFMA(a.v, qf[m][ks].v, s[k4]);
        }
      }
      float mx = -1e30f;
#pragma unroll
      for (int k4 = 0; k4 < 4; ++k4)
#pragma unroll
        for (int r = 0; r < 4; ++r) mx = fmaxf(mx, s[k4][r]);
      mx = fmaxf(mx, __shfl_xor(mx, 16));
      mx = fmaxf(mx, __shfl_xor(mx, 32));
      if (__any(mx - mrun[m] > 4.0f)) {
        const float mnew = fmaxf(mrun[m], mx);
        const float alpha = fexp(mrun[m] - mnew);
        mrun[m] = mnew;
        lsum[m] *= alpha;
#pragma unroll
        for (int v = 0; v < 8; ++v) { O[m][v][0] *= alpha; O[m][v][1] *= alpha; O[m][v][2] *= alpha; O[m][v][3] *= alpha; }
      }
      const float mneg = -mrun[m] * 1.4426950408889634f;
      float ps = 0.f;
#pragma unroll
      for (int k4 = 0; k4 < 4; ++k4)
#pragma unroll
        for (int r = 0; r < 4; ++r) { s[k4][r] = __builtin_amdgcn_exp2f(fmaf(s[k4][r], 1.4426950408889634f, mneg)); ps += s[k4][r]; }
      lsum[m] += ps;
#pragma unroll
      for (int sp = 0; sp < 2; ++sp) {
        pf[m][sp].w[0] = pack2(s[2 * sp][0], s[2 * sp][1]); pf[m][sp].w[1] = pack2(s[2 * sp][2], s[2 * sp][3]);
        pf[m][sp].w[2] = pack2(s[2 * sp + 1][0], s[2 * sp + 1][1]); pf[m][sp].w[3] = pack2(s[2 * sp + 1][2], s[2 * sp + 1][3]);
      }
    }
#pragma unroll
    for (int v = 0; v < 8; ++v)
#pragma unroll
      for (int sp = 0; sp < 2; ++sp) {
        Frag a;
        a.h[0] = *(const uint2*)(Vs + (16 * v + c16) * 72 + 32 * sp + 4 * g);
        a.h[1] = *(const uint2*)(Vs + (16 * v + c16) * 72 + 32 * sp + 16 + 4 * g);
        O[0][v] = MFMA(a.v, pf[0][sp].v, O[0][v]);
        O[1][v] = MFMA(a.v, pf[1][sp].v, O[1][v]);
      }
  }
  float l0 = lsum[0], l1 = lsum[1];
  l0 += __shfl_xor(l0, 16); l0 += __shfl_xor(l0, 32);
  l1 += __shfl_xor(l1, 16); l1 += __shfl_xor(l1, 32);
  const float i0 = 1.f / l0, i1 = lam / l1;
  float ss = 0.f;
#pragma unroll
  for (int v = 0; v < 8; ++v)
#pragma unroll
    for (int r = 0; r < 4; ++r) { float o = O[0][v][r] * i0 - O[1][v][r] * i1; O[0][v][r] = o; ss += o * o; }
  ss += __shfl_xor(ss, 16); ss += __shfl_xor(ss, 32);
  const float rinv = rsqrtf(ss * (1.f / 128.f) + EPSV) * (1.f - lam_init);
  u16* rp = proj + (size_t)qrow * LDP + h * 128;
#pragma unroll
  for (int v = 0; v < 8; ++v) {
    int vc = 16 * v + 4 * g;
    float4 sg = *(const float4*)(p.in[16] + l * 128 + vc);
    uint2 z = *(const uint2*)(rp + PZB + vc);
    float y0 = O[0][v][0] * rinv * sg.x * lo2f(z.x), y1 = O[0][v][1] * rinv * sg.y * hi2f(z.x);
    float y2 = O[0][v][2] * rinv * sg.z * lo2f(z.y), y3 = O[0][v][3] * rinv * sg.w * hi2f(z.y);
    if (!dry) *(uint2*)(rp + PQB + vc) = make_uint2(pack2(y0, y1), pack2(y2, y3));
  }
  __syncthreads();
}

__device__ __forceinline__ void f1_item(const Params& p, int item, char* lds) {
  const int tid = otid(), lane = tid & 63, wid = tid >> 6, wr = wid >> 2, wc = wid & 3, fr = lane & 15, fq = lane >> 4;
  char* ws = p.ws;
  const int jh = item & 1, gq = (item >> 1) & 3, mt = item >> 3;
  f32x4 acc[4][4];
  gemm_kloop<128>((const u16*)(ws + OFF_B1) + jh * 128 * 128, 128, (const u16*)(ws + OFF_PROJ) + (size_t)(mt * 256) * LDP + PUC + gq * 128, LDP, 128, acc, lds);
#pragma unroll
  for (int a = 0; a < 4; ++a)
#pragma unroll
    for (int b = 0; b < 4; ++b) {
      int tokl = wc * 64 + a * 16 + 4 * fq;
      int jj = wr * 64 + b * 16 + fr;
      uint2 pk = make_uint2(pack2(acc[a][b][0], acc[a][b][1]), pack2(acc[a][b][2], acc[a][b][3]));
      if (mt < 32) {
        *(uint2*)(ws + OFF_PTC + ((size_t)((mt * 4 + gq) * 128 + jj) * 512 + jh * 256 + tokl) * 2) = pk;
      } else {
        int rp = (mt - 32) * 256 + tokl; int bb = rp >> 11, t = rp & 2047;
        *(uint2*)(ws + OFF_PTL + ((size_t)((bb * 4 + gq) * 128 + jj) * 4096 + jh * 2048 + t) * 2) = pk;
      }
    }
}

struct F2Epi {
  char* ws; float scl; int rowbase_mul;
  bool lat;
  __device__ __forceinline__ void operator()(f32x4 (&acc)[2][2][4][2], const Unit& u, int wr, int wc, int fr, int fq, LAS unsigned char* lds) const {
    u16* proj = (u16*)(ws + OFF_PROJ);
#pragma unroll
    for (int ai = 0; ai < 2; ++ai)
#pragma unroll
      for (int mh = 0; mh < 2; ++mh) {
        uint2 zv[2][2][2];
#pragma unroll
        for (int mm = 0; mm < 2; ++mm)
#pragma unroll
          for (int bj = 0; bj < 2; ++bj)
#pragma unroll
            for (int n = 0; n < 2; ++n) {
              const int tp = u.x * 256 + ai * 128 + wr * 64 + (mh * 2 + mm) * 16 + fr;
              const int nn = u.y * 256 + bj * 128 + wc * 32 + n * 16 + 4 * fq;
              const int bb = nn >> 9, col = nn & 511;
              const u16* rp = proj + (size_t)(lat ? (NCTX + bb * 2048 + tp) : (bb * 256 + tp)) * LDP;
              zv[mm][bj][n] = *(const uint2*)(rp + PZC + col);
            }
#pragma unroll
        for (int mm = 0; mm < 2; ++mm)
#pragma unroll
          for (int bj = 0; bj < 2; ++bj)
#pragma unroll
            for (int n = 0; n < 2; ++n) {
              const int m = mh * 2 + mm;
              const int tp = u.x * 256 + ai * 128 + wr * 64 + m * 16 + fr;
              const int nn = u.y * 256 + bj * 128 + wc * 32 + n * 16 + 4 * fq;
              const int bb = nn >> 9, col = nn & 511;
              u16* rp = proj + (size_t)(lat ? (NCTX + bb * 2048 + tp) : (bb * 256 + tp)) * LDP;
              const uint2 z = zv[mm][bj][n];
              f32x4 a4 = acc[ai][bj][m][n];
              *(uint2*)(rp + PUC + col) = make_uint2(pack2(a4[0] * scl * lo2f(z.x), a4[1] * scl * hi2f(z.x)),
                                                     pack2(a4[2] * scl * lo2f(z.y), a4[3] * scl * hi2f(z.y)));
            }
      }
  }
};
__device__ __forceinline__ void f2c_item(const Params& p, int item, char* lds) {
  OneUnit S; S.u.a = p.ws + OFF_DC; S.u.b = p.ws + OFF_PTC + (size_t)item * 256 * 1024; S.u.x = 0; S.u.y = item; S.u.lda = 512; S.u.ldb = 512; S.u.nt = 8;
  F2Epi E; E.ws = p.ws; E.scl = 0.005524271728019903f; E.lat = false; E.rowbase_mul = 0;
  gemm_phase((LAS unsigned char*)lds, S, E);
}
struct F2HalfEpi {
  uint2* part;
  __device__ __forceinline__ void operator()(f32x4 (&acc)[2][2][4][2], const Unit& u, int wr, int wc, int fr, int fq, LAS unsigned char* lds) const {
    const int tid = wr * 256 + wc * 64 + fq * 16 + fr;
#pragma unroll
    for (int ai = 0; ai < 2; ++ai)
#pragma unroll
      for (int bj = 0; bj < 2; ++bj)
#pragma unroll
        for (int m = 0; m < 4; ++m)
#pragma unroll
          for (int n = 0; n < 2; ++n) {
            f32x4 a4 = acc[ai][bj][m][n];
            __hip_atomic_store((unsigned long long*)(part + (((ai * 2 + bj) * 4 + m) * 2 + n) * 512 + tid), (unsigned long long)pack2(a4[0], a4[1]) | ((unsigned long long)pack2(a4[2], a4[3]) << 32), __ATOMIC_RELAXED, __HIP_MEMORY_SCOPE_AGENT);
          }
  }
};
__device__ __forceinline__ void f2l_item(const Params& p, int l, int item, char* lds) {
  char* ws = p.ws;
  const int tile = item >> 1, half = item & 1, mt = tile >> 2, nt = tile & 3;
  uint2* pbase = (uint2*)(ws + OFF_F2P);
  {
    OneUnit S; S.u.a = ws + OFF_DL + ((size_t)mt * 256 * 4096 + half * 2048) * 2; S.u.b = ws + OFF_PTL + ((size_t)nt * 256 * 4096 + half * 2048) * 2;
    S.u.x = mt; S.u.y = nt; S.u.lda = 4096; S.u.ldb = 4096; S.u.nt = 32;
    F2HalfEpi E; E.part = pbase + (size_t)(tile * 2 + half) * (32 * 512);
    gemm_phase((LAS unsigned char*)lds, S, E);
  }
  const int t_ = otid();
  volatile int* flag = (volatile int*)(lds + LDS_TILE + 32);
  asm volatile("s_waitcnt vmcnt(0)" ::: "memory");
  __syncthreads();
  if (t_ == 0) {
    unsigned* tk = (unsigned*)(ws + OFF_CNT) + 72 + l * 32 + tile;
    const unsigned old = __hip_atomic_fetch_add(tk, 1u, __ATOMIC_RELAXED, __HIP_MEMORY_SCOPE_AGENT);
    const int last = (old == 1u) ? 1 : 0;
    if (last) { __builtin_amdgcn_fence(__ATOMIC_ACQUIRE, "agent"); asm volatile("s_waitcnt vmcnt(0)" ::: "memory"); }
    *flag = last;
  }
  __syncthreads();
  if (*flag) {
    const int lane = t_ & 63, wid = t_ >> 6, wr = wid >> 2, wc = wid & 3, fr = lane & 15, fq = lane >> 4;
    const uint2* p0 = pbase + (size_t)(tile * 2 + 0) * (32 * 512);
    const uint2* p1 = pbase + (size_t)(tile * 2 + 1) * (32 * 512);
    u16* proj = (u16*)(ws + OFF_PROJ);
    const float scl = 1.f / 512.f;
#pragma unroll
    for (int ai = 0; ai < 2; ++ai)
#pragma unroll
      for (int mh = 0; mh < 2; ++mh) {
        uint2 zv[2][2][2], av[2][2][2], bv2[2][2][2];
#pragma unroll
        for (int mm = 0; mm < 2; ++mm)
#pragma unroll
          for (int bj = 0; bj < 2; ++bj)
#pragma unroll
            for (int n = 0; n < 2; ++n) {
              const int m = mh * 2 + mm;
              const int tp = mt * 256 + ai * 128 + wr * 64 + m * 16 + fr;
              const int nn = nt * 256 + bj * 128 + wc * 32 + n * 16 + 4 * fq;
              const int bb = nn >> 9, col = nn & 511;
              const u16* rp = proj + (size_t)(NCTX + bb * 2048 + tp) * LDP;
              zv[mm][bj][n] = *(const uint2*)(rp + PZC + col);
              const int idx = (((ai * 2 + bj) * 4 + m) * 2 + n) * 512 + t_;
              av[mm][bj][n] = p0[idx]; bv2[mm][bj][n] = p1[idx];
            }
#pragma unroll
        for (int mm = 0; mm < 2; ++mm)
#pragma unroll
          for (int bj = 0; bj < 2; ++bj)
#pragma unroll
            for (int n = 0; n < 2; ++n) {
              const int m = mh * 2 + mm;
              const int tp = mt * 256 + ai * 128 + wr * 64 + m * 16 + fr;
              const int nn = nt * 256 + bj * 128 + wc * 32 + n * 16 + 4 * fq;
              const int bb = nn >> 9, col = nn & 511;
              u16* rp = proj + (size_t)(NCTX + bb * 2048 + tp) * LDP;
              const uint2 z = zv[mm][bj][n], a = av[mm][bj][n], c = bv2[mm][bj][n];
              const float y0 = (lo2f(a.x) + lo2f(c.x)) * scl * lo2f(z.x), y1 = (hi2f(a.x) + hi2f(c.x)) * scl * hi2f(z.x);
              const float y2 = (lo2f(a.y) + lo2f(c.y)) * scl * lo2f(z.y), y3 = (hi2f(a.y) + hi2f(c.y)) * scl * hi2f(z.y);
              *(uint2*)(rp + PUC + col) = make_uint2(pack2(y0, y1), pack2(y2, y3));
            }
      }
  }
  __syncthreads();
}

__device__ __forceinline__ bool xcd_tile(int bid, int& pm, int& pn) {
  const int x = bid & 7, j = bid >> 3;
  if (j >= 24) return false;
  pm = 6 * x + (j >> 2); pn = j & 3;
  return true;
}
struct P5Sched {
  char* ws; int x, j;
  __device__ __forceinline__ bool next(int i, Unit& u) const {
    if (j < 24) {
      if (i >= 5) return false;
      const int pm = 6 * x + (j >> 2), pn = j & 3;
      const int jj = (i < 4) ? (i >> 1) : 2;
      if (i == 0 || i == 2) {
        u.a = ws + OFF_H + (size_t)pm * 256 * 2048; u.b = ws + OFF_WIN + (size_t)(5632 + jj * 1024 + pn * 256) * 2048;
        u.lda = 1024; u.ldb = 1024; u.nt = 16; u.x = pm; u.y = pn | (jj << 8);
      } else {
        const int yc = (jj == 0) ? PQA : ((jj == 1) ? PQB : PUC);
        u.a = ws + OFF_PROJ + ((size_t)pm * 256 * LDP + yc) * 2; u.b = ws + OFF_WBR + ((size_t)jj * 1024 * 512 + (size_t)pn * 256 * 512) * 2;
        u.lda = LDP; u.ldb = 512; u.nt = 8; u.x = pm; u.y = pn | (jj << 8) | ((i == 4) ? 0x2000 : 0x1000);
      }
      return true;
    }
    if (i >= 3) return false;
    const int tj = 3 * (j - 24) + i;
    const int pm = 6 * x + (tj >> 2), pn = tj & 3;
    u.a = ws + OFF_H + (size_t)pm * 256 * 2048; u.b = ws + OFF_WIN + (size_t)(5632 + 2 * 1024 + pn * 256) * 2048;
    u.lda = 1024; u.ldb = 1024; u.nt = 16; u.x = pm; u.y = pn | (2 << 8) | 0x3000;
    return true;
  }
};
struct P5Epi {
  char* ws; u16* mg; unsigned* flags; bool skip;
  __device__ __forceinline__ void operator()(f32x4 (&acc)[2][2][4][2], const Unit& u, int wr, int wc, int fr, int fq, LAS unsigned char* lds) const {
    if (skip) return;
    { const int t_ = otid(); const int w_ = t_ >> 6; wr = w_ >> 2; wc = w_ & 3; fr = t_ & 15; fq = (t_ & 63) >> 4; }
    const int tid = wr * 256 + wc * 64 + fq * 16 + fr;
    const int type = (u.y >> 12) & 3, j = (u.y >> 8) & 3, pn = u.y & 0xff, pm = u.x;
    const int tile = pm * 4 + pn;
    uint2* gs = (uint2*)(ws + OFF_SEGU) + (size_t)tile * (32 * 512);
    u16* g2p = (u16*)(ws + OFF_PROJ) + (size_t)pm * 256 * LDP + PLF + pn * 256;
    if (type == 0) {
#pragma unroll
      for (int ai = 0; ai < 2; ++ai)
#pragma unroll
        for (int bj = 0; bj < 2; ++bj)
#pragma unroll
          for (int m = 0; m < 4; ++m)
#pragma unroll
            for (int n = 0; n < 2; ++n) {
              f32x4 a4 = acc[ai][bj][m][n];
              gs[(((ai * 2 + bj) * 4 + m) * 2 + n) * 512 + tid] = make_uint2(pack2(sigmf(a4[0]), sigmf(a4[1])), pack2(sigmf(a4[2]), sigmf(a4[3])));
            }
      return;
    }
    if (type == 3) {
#pragma unroll
      for (int ai = 0; ai < 2; ++ai)
#pragma unroll
        for (int bj = 0; bj < 2; ++bj)
#pragma unroll
          for (int m = 0; m < 4; ++m)
#pragma unroll
            for (int n = 0; n < 2; ++n) {
              f32x4 a4 = acc[ai][bj][m][n];
              const int row = ai * 128 + wr * 64 + m * 16 + fr, col = bj * 128 + wc * 32 + n * 16 + 4 * fq;
              const unsigned long long v = (unsigned long long)pack2(sigmf(a4[0]), sigmf(a4[1])) | ((unsigned long long)pack2(sigmf(a4[2]), sigmf(a4[3])) << 32);
              __hip_atomic_store((unsigned long long*)(g2p + (size_t)row * LDP + col), v, __ATOMIC_RELAXED, __HIP_MEMORY_SCOPE_AGENT);
            }
      asm volatile("s_waitcnt vmcnt(0)" ::: "memory");
      if ((fq * 16 + fr) == 0) __hip_atomic_fetch_add(flags + tile, 1u, __ATOMIC_RELAXED, __HIP_MEMORY_SCOPE_AGENT);
      return;
    }
    if (type == 2) {
      if (tid == 0) {
        unsigned sp = 0;
        while (__hip_atomic_load(flags + tile, __ATOMIC_RELAXED, __HIP_MEMORY_SCOPE_AGENT) < 8u) { __builtin_amdgcn_s_sleep(2); if (++sp > (1u << 22)) break; }
        __builtin_amdgcn_fence(__ATOMIC_ACQUIRE, "agent");
        asm volatile("s_waitcnt vmcnt(0)" ::: "memory");
      }
      asm volatile("" ::: "memory");
      __builtin_amdgcn_s_barrier();
      asm volatile("" ::: "memory");
    }
#pragma unroll
    for (int ai = 0; ai < 2; ++ai)
#pragma unroll
      for (int mh = 0; mh < 2; ++mh) {
        uint2 gv[2][2][2], pv[2][2][2];
#pragma unroll
        for (int mm = 0; mm < 2; ++mm)
#pragma unroll
          for (int bj = 0; bj < 2; ++bj)
#pragma unroll
            for (int n = 0; n < 2; ++n) {
              const int m = mh * 2 + mm;
              const int rl = ai * 128 + wr * 64 + m * 16 + fr, cl = bj * 128 + wc * 32 + n * 16 + 4 * fq;
              const int row = pm * 256 + rl, col = pn * 256 + cl;
              const uint2* gptr = (type == 2) ? (const uint2*)(g2p + (size_t)rl * LDP + cl) : (const uint2*)(gs + (((ai * 2 + bj) * 4 + m) * 2 + n) * 512 + tid);
              gv[mm][bj][n] = *gptr;
              pv[mm][bj][n] = (j > 0) ? *(const uint2*)(mg + (size_t)row * 1024 + col) : make_uint2(0u, 0u);
            }
#pragma unroll
        for (int mm = 0; mm < 2; ++mm)
#pragma unroll
          for (int bj = 0; bj < 2; ++bj)
#pragma unroll
            for (int n = 0; n < 2; ++n) {
              const int m = mh * 2 + mm;
              const int row = pm * 256 + ai * 128 + wr * 64 + m * 16 + fr;
              const int col = pn * 256 + bj * 128 + wc * 32 + n * 16 + 4 * fq;
              f32x4 a4 = acc[ai][bj][m][n];
              const uint2 g2 = gv[mm][bj][n], p2 = pv[mm][bj][n];
              float t0 = lo2f(g2.x) * a4[0] + lo2f(p2.x), t1 = hi2f(g2.x) * a4[1] + hi2f(p2.x);
              float t2 = lo2f(g2.y) * a4[2] + lo2f(p2.y), t3 = hi2f(g2.y) * a4[3] + hi2f(p2.y);
              *(uint2*)(mg + (size_t)row * 1024 + col) = make_uint2(pack2(t0, t1), pack2(t2, t3));
            }
      }
  }
};
__device__ __forceinline__ void p5_phase(const Params& p, int l, char* lds, bool skip = false) {
  P5Sched S; S.ws = p.ws; S.x = blockIdx.x & 7; S.j = blockIdx.x >> 3;
  if (S.j >= 32) return;
  P5Epi E; E.ws = p.ws; E.mg = (u16*)(p.ws + OFF_MRG); E.flags = (unsigned*)(p.ws + OFF_CNT) + 136 + l * 192; E.skip = skip;
  gemm_phase((LAS unsigned char*)lds, S, E);
}

struct P6Epi {
  const float* xp0; const float* xs0; float* outp; const float* modp; int l;
  __device__ __forceinline__ void operator()(f32x4 (&acc)[2][2][4][2], const Unit& u, int wr, int wc, int fr, int fq, LAS unsigned char* lds) const {
    const int m0 = u.x * 256;
    const int ci = (m0 < NCTX) ? 0 : 1 + ((m0 - NCTX) >> 11);
    const float* xbase = (l == 0) ? ((m0 < NCTX) ? xp0 : xs0 - (size_t)NCTX * 1024) : outp;
    float4 gt[2][2];
#pragma unroll
    for (int bj = 0; bj < 2; ++bj)
#pragma unroll
      for (int n = 0; n < 2; ++n) gt[bj][n] = *(const float4*)(modp + (l * 3 + ci) * 3072 + 2048 + u.y * 256 + bj * 128 + wc * 32 + n * 16 + 4 * fq);
#pragma unroll
    for (int ai = 0; ai < 2; ++ai)
#pragma unroll
      for (int mh = 0; mh < 2; ++mh) {
        float4 xv[2][2][2];
#pragma unroll
        for (int mm = 0; mm < 2; ++mm)
#pragma unroll
          for (int bj = 0; bj < 2; ++bj)
#pragma unroll
            for (int n = 0; n < 2; ++n) {
              const int r = m0 + ai * 128 + wr * 64 + (mh * 2 + mm) * 16 + fr;
              const int col = u.y * 256 + bj * 128 + wc * 32 + n * 16 + 4 * fq;
              xv[mm][bj][n] = *(const float4*)(xbase + (size_t)r * 1024 + col);
            }
#pragma unroll
        for (int mm = 0; mm < 2; ++mm)
#pragma unroll
          for (int bj = 0; bj < 2; ++bj)
#pragma unroll
            for (int n = 0; n < 2; ++n) {
              const int m = mh * 2 + mm;
              const int r = m0 + ai * 128 + wr * 64 + m * 16 + fr;
              const int col = u.y * 256 + bj * 128 + wc * 32 + n * 16 + 4 * fq;
              f32x4 a4 = acc[ai][bj][m][n];
              const float4 x4 = xv[mm][bj][n], g4 = gt[bj][n];
              *(float4*)(outp + (size_t)r * 1024 + col) = make_float4(x4.x + g4.x * a4[0], x4.y + g4.y * a4[1], x4.z + g4.z * a4[2], x4.w + g4.w * a4[3]);
            }
      }
  }
};
__device__ __forceinline__ void p6_phase(const Params& p, int l, char* lds) {
  char* ws = p.ws;
  int pm, pn;
  if (!xcd_tile(blockIdx.x, pm, pn)) return;
  OneUnit S; S.u.a = ws + OFF_MRG + (size_t)pm * 256 * 2048; S.u.b = ws + OFF_WO + (size_t)pn * 256 * 2048; S.u.x = pm; S.u.y = pn;
  S.u.lda = 1024; S.u.ldb = 1024; S.u.nt = 16; S.reps = ((DUP_MASK & 512) && l == 0) ? 5 : 1;
  P6Epi E; E.xp0 = p.in[0]; E.xs0 = p.in[1]; E.outp = p.out; E.modp = (const float*)(ws + OFF_MOD); E.l = l;
  gemm_phase((LAS unsigned char*)lds, S, E);
}

#define XB_TMO      128
#define XB_XCNT(j)  (256  + 64 * (j))
#define XB_XSUB(j)  (1280 + 64 * (j))
#define XB_XGEN(j)  (2304 + 64 * (j))
#define XB_TOP      3328
#define XB_TOPGEN   3392
#define XCD_BAR_WORDS 3456
#define XB_SPIN_CAP (1u << 18)
struct XcdBarrier { unsigned* bar; unsigned x; volatile LAS unsigned* st; };
__device__ __forceinline__ unsigned xb_ld(unsigned* p) { return __hip_atomic_load(p, __ATOMIC_RELAXED, __HIP_MEMORY_SCOPE_AGENT); }
__device__ __forceinline__ unsigned xb_add(unsigned* p, unsigned v) { return __hip_atomic_fetch_add(p, v, __ATOMIC_RELAXED, __HIP_MEMORY_SCOPE_AGENT); }
__device__ __forceinline__ unsigned xb_xcc_id() { return (unsigned)__builtin_amdgcn_s_getreg((3 << 11) | 20) & 0xFu; }
#define XB_SPIN(cond, bar) do { unsigned _sp = 0; while (cond) { __builtin_amdgcn_s_sleep(1); \
    if ((++_sp & 255u) == 0u) { if (xb_ld(&(bar)[XB_TMO])) break; if (_sp > XB_SPIN_CAP) { atomicAdd(&(bar)[XB_TMO], 1u); break; } } } } while (0)
__device__ __forceinline__ XcdBarrier xcd_barrier_post(unsigned* bar, volatile LAS unsigned* st) {
  XcdBarrier b; b.bar = bar; b.x = xb_xcc_id(); b.st = st;
  if (threadIdx.x == 0) (void)xb_add(&bar[XB_XCNT(b.x)], 1u);
  return b;
}
__device__ __forceinline__ void xcd_barrier_complete(unsigned* bar, unsigned x, unsigned& nloc, unsigned& nx) {
  const unsigned G = gridDim.x * gridDim.y * gridDim.z;
  unsigned sum, cnt, mine, sp = 0u;
  for (;;) {
    sum = 0u; cnt = 0u; mine = 0u;
#pragma unroll
    for (unsigned j = 0; j < 16; ++j) { const unsigned c = xb_ld(&bar[XB_XCNT(j)]); sum += c; cnt += (c > 0u) ? 1u : 0u; mine = (j == x) ? c : mine; }
    if (sum == G) break;
    __builtin_amdgcn_s_sleep(1);
    if ((++sp & 255u) == 0u) { if (xb_ld(&bar[XB_TMO])) break; if (sp > XB_SPIN_CAP) { atomicAdd(&bar[XB_TMO], 1u); break; } }
  }
  nloc = mine > 0u ? mine : 1u; nx = cnt > 0u ? cnt : 1u;
}
__device__ __forceinline__ void xcd_barrier(const XcdBarrier& b) {
  asm volatile("s_waitcnt vmcnt(0)" ::: "memory");
  __syncthreads();
  if (threadIdx.x == 0) {
    unsigned* bar = b.bar;
    __builtin_amdgcn_s_waitcnt(0);
    unsigned nloc = b.st[0], nx = b.st[1];
    if (nloc == 0u) { xcd_barrier_complete(bar, b.x, nloc, nx); b.st[0] = nloc; b.st[1] = nx; }
    const unsigned old = xb_add(&bar[XB_XSUB(b.x)], 1u);
    const unsigned gen = old / nloc;
    if (old + 1u == (gen + 1u) * nloc) {
      __builtin_amdgcn_fence(__ATOMIC_RELEASE, "agent");
      asm volatile("s_waitcnt vmcnt(0)" ::: "memory");
      const unsigned og = xb_add(&bar[XB_TOP], 1u);
      const unsigned tg = og / nx;
      if (og + 1u == (tg + 1u) * nx) xb_add(&bar[XB_TOPGEN], 1u);
      else XB_SPIN(xb_ld(&bar[XB_TOPGEN]) == tg, bar);
      __builtin_amdgcn_fence(__ATOMIC_ACQUIRE, "agent");
      xb_add(&bar[XB_XGEN(b.x)], 1u);
      asm volatile("s_waitcnt vmcnt(0)" ::: "memory");
    } else {
      XB_SPIN(xb_ld(&bar[XB_XGEN(b.x)]) == gen, bar);
      __builtin_amdgcn_fence(__ATOMIC_ACQUIRE, "agent");
      asm volatile("s_waitcnt vmcnt(0)" ::: "memory");
    }
  }
  __syncthreads();
}

#define PARGS const float* a0, const float* a1, const float* a2, const float* a3, const float* a4, const float* a5, const float* a6, \
  const float* a7, const float* a8, const float* a9, const float* a10, const float* a11, const float* a12, const float* a13, \
  const float* a14, const float* a15, const float* a16, const float* a17, const float* a18, const float* a19, const float* a20, \
  float* aout, char* aws
#define PFILL Params p; p.in[0]=a0;p.in[1]=a1;p.in[2]=a2;p.in[3]=a3;p.in[4]=a4;p.in[5]=a5;p.in[6]=a6;p.in[7]=a7;p.in[8]=a8;p.in[9]=a9;p.in[10]=a10; \
  p.in[11]=a11;p.in[12]=a12;p.in[13]=a13;p.in[14]=a14;p.in[15]=a15;p.in[16]=a16;p.in[17]=a17;p.in[18]=a18;p.in[19]=a19;p.in[20]=a20;p.out=aout;p.ws=aws;
__global__ void __launch_bounds__(512) fwd_megakernel(PARGS) {
  PFILL
  extern __shared__ __attribute__((aligned(16))) char lds[];
  volatile int& s_item = *(volatile int*)(lds + LDS_TILE);
  cg::grid_group grid = cg::this_grid();
  const int bid = blockIdx.x, G = gridDim.x, tid = threadIdx.x;
  int* cnt = (int*)(p.ws + OFF_CNT);
  volatile LAS unsigned* bst = (volatile LAS unsigned*)(LAS unsigned char*)(lds + LDS_TILE + 16);
  if (tid < 2) bst[tid] = 0u;
  __syncthreads();
  const XcdBarrier xb = xcd_barrier_post((unsigned*)(p.ws + OFF_BAR), bst);
  for (int rep = 0; rep < ((DUP_MASK & 1) ? 2 : 1); ++rep) {
  {
    for (int it = bid; it < 384; it += G) p0_mod16(p, it, lds);
    float2* tab = (float2*)lds;
    for (int m = tid; m < 2048; m += 512) { float sn, cs; sincospif((float)m * (1.f / 1024.f), &sn, &cs); tab[m] = make_float2(cs, sn); }
    __syncthreads();
    for (int it = 224 + bid; it < 224 + 2048; it += G) p0_item(p, it, lds);
    __syncthreads();
    for (int it = 96 + bid; it < P0_ITEMS; it += G) { if (it >= 224 && it < 224 + 2048) continue; p0_item(p, it, lds); }
  }
  if (((const volatile float*)p.in[15])[0] > 1e30f) grid.sync();
  xcd_barrier(xb);
  }
  for (int l = 0; l < 2; ++l) {
    for (int rep = 0; rep < ((DUP_MASK & 2) ? 2 : 1); ++rep) {
    for (int it = bid; it < P1_ITEMS; it += G) p1_item(p, l, it, lds);
    xcd_barrier(xb);
    }
    if (DUP_MASK & 1024) { const bool opq = (((const volatile float*)p.in[15])[0] < 1e30f); p2_phase(p, l, lds, opq); xcd_barrier(xb); }
    for (int rep = 0; rep < ((DUP_MASK & 4) ? 2 : 1); ++rep) {
    p2_phase(p, l, lds);
    xcd_barrier(xb);
    }
    for (;;) {
      __syncthreads();
      if (tid == 0) s_item = atomicAdd(&cnt[l * 2 + 0], 1);
      __syncthreads();
      int it = s_item;
      constexpr int D3 = (DUP_MASK & 16) ? 256 : 0;
      if (it >= D3 + 32 + 128 + 384 + 256) break;
      if (it >= 32 + 128 + 384 + 256) { hgrn_ctx_item(p, l, (it - 800) & 127, lds, true); continue; }
      if (it < 32) p2_left_item(p, l, 1024 + it, lds);
      else if (it < 160) hgrn_ctx_item(p, l, it - 32, lds);
      else if (it < 416) hgrn_lat1_item(p, l, it - 160, lds);
      else f1_item(p, it - 416, lds);
    }
    xcd_barrier(xb);
    for (;;) {
      __syncthreads();
      if (tid == 0) s_item = atomicAdd(&cnt[l * 2 + 1], 1);
      __syncthreads();
      int it = s_item;
      constexpr int D4a = (DUP_MASK & 32) ? 256 : 0, D4b = (DUP_MASK & 64) ? 256 : 0;
      if (it >= D4a + D4b + 640) break;
      if (it >= 640) { if (DUP_MASK & 32) attn_item(p, l, (it - 640) & 127, true, lds, true); else hgrn_lat2_item(p, l, (it - 640) & 127, lds, true); continue; }
      if (it < 128) attn_item(p, l, it, true, lds);
      else if (it < 192) f2l_item(p, l, it - 128, lds);
      else if (it < 320) hgrn_lat2_item(p, l, it - 192, lds);
      else if (it < 384) f2c_item(p, it - 320, lds);
      else attn_item(p, l, it - 384, false, lds);
    }
    xcd_barrier(xb);
    if (DUP_MASK & 2048) { const bool opq = (((const volatile float*)p.in[15])[0] < 1e30f); p5_phase(p, l, lds, opq); xcd_barrier(xb); }
    for (int rep = 0; rep < ((DUP_MASK & 8) ? 2 : 1); ++rep) {
    p5_phase(p, l, lds);
    xcd_barrier(xb);
    }
    for (int rep = 0; rep < (((DUP_MASK & 256) && l == 0) ? 5 : 1); ++rep) {
    p6_phase(p, l, lds);
    if (l == 0) xcd_barrier(xb);
    }
  }
}

extern "C" void kernel_launch(void* const* d_in, const int* in_sizes, int n_in,
                              void* d_out, int out_size, void* d_ws, size_t ws_size,
                              hipStream_t stream) {
  static int grid_blocks = 0;
  if (!grid_blocks) {
    int dev = 0, cus = 0;
    (void)hipGetDevice(&dev);
    (void)hipDeviceGetAttribute(&cus, hipDeviceAttributeMultiprocessorCount, dev);
    if (hipFuncSetAttribute((const void*)fwd_megakernel, hipFuncAttributeMaxDynamicSharedMemorySize, LDS_BYTES) != hipSuccess)
      fprintf(stderr, "hipFuncSetAttribute failed\n");
    grid_blocks = cus > 0 ? cus : 256;
    if (ws_size < WS_END) fprintf(stderr, "workspace too small: %zu < %zu\n", ws_size, (size_t)WS_END);
  }
  const void* ins[21];
  for (int i = 0; i < 21; ++i) ins[i] = d_in[i];
  void* outp = d_out; void* wsp = d_ws;
  void* args[23];
  for (int i = 0; i < 21; ++i) args[i] = (void*)&ins[i];
  args[21] = (void*)&outp; args[22] = (void*)&wsp;
  (void)hipMemsetAsync((char*)d_ws + OFF_CNT, 0, 4096 + 3456 * 4, stream);
  hipError_t e = hipLaunchCooperativeKernel((void*)fwd_megakernel, dim3(grid_blocks), dim3(512), args, LDS_BYTES, stream);
  if (e != hipSuccess) fprintf(stderr, "cooperative launch failed: %s (grid %d)\n", hipGetErrorString(e), grid_blocks);
}
```

```cpp
#include <hip/hip_runtime.h>
#include <hip/hip_cooperative_groups.h>
#include <stdint.h>
#include <cstdio>
namespace cg = cooperative_groups;

typedef unsigned short u16;
using bf16x8 = __attribute__((ext_vector_type(8))) short;
using f32x4 = __attribute__((ext_vector_type(4))) float;
#define MFMA(a, b, c) __builtin_amdgcn_mfma_f32_16x16x32_bf16(a, b, c, 0, 0, 0)

constexpr int NTOK = 12288;
constexpr int NCTX = 8192;
constexpr int LDP = 5120;
constexpr int PQA = 0, PLF = 512, PIA = 1536, PZA = 2048, PQB = 2560, PKB = 3072, PZB = 3584, PUC = 4096, PZC = 4608;
constexpr float EPSV = 1e-6f;
constexpr size_t OCK = 12582912, OCV = 20971520, OST = 29360128;

constexpr size_t OFF_WIN = 0;
constexpr size_t OFF_WBR = OFF_WIN + 8704ull * 1024 * 2;
constexpr size_t OFF_WO = OFF_WBR + 3ull * 1024 * 512 * 2;
constexpr size_t OFF_H = OFF_WO + 1024ull * 1024 * 2;
constexpr size_t OFF_PROJ = OFF_H + 12288ull * 1024 * 2;
constexpr size_t OFF_R1 = OFF_PROJ + 12288ull * LDP * 2;
constexpr size_t OFF_PTC = OFF_R1;
constexpr size_t OFF_PTL = OFF_R1 + 16384ull * 512 * 2;
constexpr size_t OFF_MRG = OFF_R1;
constexpr size_t OFF_SEGU = OFF_R1 + 25165824ull;
constexpr size_t OFF_SEGD = OFF_SEGU + 256ull * 16384 * 4;
constexpr size_t OFF_VTC = OFF_SEGD + 256ull * 128 * 4;
constexpr size_t OFF_VTL = OFF_VTC + 32ull * 4 * 128 * 256 * 2;
constexpr size_t SZ_VTL = 2ull * 4 * 128 * 2304 * 2;
constexpr size_t OFF_KC = OFF_VTL + 2 * SZ_VTL;
constexpr size_t OFF_DL = OFF_KC + 2ull * 2 * 256 * 512 * 2;
constexpr size_t OFF_DC = OFF_DL + 2048ull * 4096 * 2;
constexpr size_t OFF_B1 = OFF_DC + 256ull * 512 * 2;
constexpr size_t OFF_ROPE = OFF_B1 + 256ull * 128 * 2;
constexpr size_t OFF_MOD = OFF_ROPE + 2048ull * 32 * 8;
constexpr size_t OFF_CNT = OFF_MOD + 2ull * 3 * 3072 * 4;
constexpr size_t OFF_BAR = OFF_CNT + 4096;
constexpr size_t OFF_F2P = OFF_BAR + 3456 * 4 + 192;
constexpr size_t WS_END = OFF_F2P + 32ull * 2 * 32 * 512 * 8;

constexpr int LDS_TILE = 131072 + 8192;
#define DUP_MASK 0
constexpr int LDS_BYTES = LDS_TILE + 64;

struct Params {
  const float* in[21];
  float* out;
  char* ws;
};

typedef __bf16 bf16x2_t __attribute__((ext_vector_type(2)));
typedef float f32x2_t __attribute__((ext_vector_type(2)));
__device__ __forceinline__ uint32_t pack2(float a, float b) {
  f32x2_t v = {a, b};
  bf16x2_t r = __builtin_convertvector(v, bf16x2_t);
  return __builtin_bit_cast(uint32_t, r);
}
__device__ __forceinline__ u16 f2bf(float f) { return (u16)(pack2(f, 0.f) & 0xffffu); }
__device__ __forceinline__ float bf2f(u16 h) { return __uint_as_float(((uint32_t)h) << 16); }
__device__ __forceinline__ float lo2f(uint32_t u) { return __uint_as_float(u << 16); }
__device__ __forceinline__ float hi2f(uint32_t u) { return __uint_as_float(u & 0xffff0000u); }
__device__ __forceinline__ float fexp(float x) { return __builtin_amdgcn_exp2f(x * 1.4426950408889634f); }
__device__ __forceinline__ float frcp(float x) { return __builtin_amdgcn_rcpf(x); }
__device__ __forceinline__ float flog(float x) { return __builtin_amdgcn_logf(x) * 0.6931471805599453f; }
__device__ __forceinline__ float siluf(float x) { return x * frcp(1.f + fexp(-x)); }
__device__ __forceinline__ float sigmf(float x) { return frcp(1.f + fexp(-x)); }
__device__ __forceinline__ float logf_gate(float x, float lb) {
  float xc = fmaxf(x, -80.f);
  float e = fexp(-xc);
  float omf = (1.f - lb) * e * frcp(1.f + e);
  float lf = flog(1.f - omf);
  lf = (lb == 0.f && x < -15.f) ? x : lf;
  return lf;
}
__device__ __forceinline__ float neg_expm1(float lf) {
  return 1.f - fexp(lf);
}
__device__ __forceinline__ int otid() { int t = threadIdx.x; asm volatile("" : "+v"(t)); return t; }

union Frag {
  bf16x8 v;
  uint4 q;
  uint2 h[2];
  uint32_t w[4];
};

__device__ __forceinline__ int lds_byte(int r, int c) {
  int st = (r >> 4) * 2 + (c >> 5), rr = r & 15, cc = c & 31, ob = rr * 64 + cc * 2;
  return st * 1024 + (ob ^ (((ob >> 9) & 1) << 5));
}

template <int TM>
__device__ __forceinline__ void gemm_kloop(const u16* __restrict__ X, int ldx, const u16* __restrict__ Y, int ldy,
                                           int K, f32x4 (&acc)[4][TM / 32], char* lds) {
  constexpr int NX = TM / 64;
  constexpr int XT = TM / 32;
  constexpr int STAGE = TM * 128 + 32768;
  const int tid = otid(), lane = tid & 63, wid = tid >> 6, wr = wid >> 2, wc = wid & 3, fr = lane & 15, fq = lane >> 4;
#pragma unroll
  for (int a = 0; a < 4; ++a)
#pragma unroll
    for (int b = 0; b < XT; ++b) acc[a][b] = f32x4{0.f, 0.f, 0.f, 0.f};
  uint4 xr[NX], yr[4];
  const int nk = K >> 6;
  const int lrow = tid >> 3, lc8 = (tid & 7) * 8;
  const u16* xg = X + (size_t)lrow * ldx + lc8;
  const u16* yg = Y + (size_t)lrow * ldy + lc8;
  const int loff = lds_byte(lrow, lc8);
#pragma unroll
  for (int i = 0; i < NX; ++i) xr[i] = *(const uint4*)(xg + (size_t)(64 * i) * ldx);
#pragma unroll
  for (int i = 0; i < 4; ++i) yr[i] = *(const uint4*)(yg + (size_t)(64 * i) * ldy);
#pragma unroll
  for (int i = 0; i < NX; ++i) *(uint4*)(lds + loff + 8192 * i) = xr[i];
#pragma unroll
  for (int i = 0; i < 4; ++i) *(uint4*)(lds + TM * 128 + loff + 8192 * i) = yr[i];
  __syncthreads();
  for (int kt = 0; kt < nk; ++kt) {
    char* cur = lds + (kt & 1) * STAGE;
    char* nxt = lds + ((kt + 1) & 1) * STAGE;
    const bool more = (kt + 1 < nk);
    if (more) {
#pragma unroll
      for (int i = 0; i < NX; ++i) xr[i] = *(const uint4*)(xg + (size_t)(64 * i) * ldx + (kt + 1) * 64);
#pragma unroll
      for (int i = 0; i < 4; ++i) yr[i] = *(const uint4*)(yg + (size_t)(64 * i) * ldy + (kt + 1) * 64);
    }
#pragma unroll
    for (int ks = 0; ks < 2; ++ks) {
      Frag yf[4], xf[XT];
#pragma unroll
      for (int a = 0; a < 4; ++a) yf[a].q = *(const uint4*)(cur + TM * 128 + lds_byte(wc * 64 + a * 16 + fr, ks * 32 + fq * 8));
#pragma unroll
      for (int b = 0; b < XT; ++b) xf[b].q = *(const uint4*)(cur + lds_byte(wr * (TM / 2) + b * 16 + fr, ks * 32 + fq * 8));
#pragma unroll
      for (int a = 0; a < 4; ++a)
#pragma unroll
        for (int b = 0; b < XT; ++b) acc[a][b] = MFMA(yf[a].v, xf[b].v, acc[a][b]);
    }
    if (more) {
#pragma unroll
      for (int i = 0; i < NX; ++i) *(uint4*)(nxt + loff + 8192 * i) = xr[i];
#pragma unroll
      for (int i = 0; i < 4; ++i) *(uint4*)(nxt + TM * 128 + loff + 8192 * i) = yr[i];
    }
    __syncthreads();
  }
}

#define LAS __attribute__((address_space(3)))
constexpr int HTB = 128 * 64 * 2;
constexpr int G8_STAGE_BYTES = 8 * HTB;
__device__ __forceinline__ void stage_rc(int b, int& R, int& C) {
  const int st = b / 1024, sb = b % 1024, swz = sb ^ (((sb >> 9) & 1) << 5);
  R = (st >> 1) * 16 + swz / 64; C = (st & 1) * 32 + (swz % 64) / 2;
}
struct Unit { const char* a; const char* b; int x; int y; int lda; int ldb; int nt; int perm = 0; };
struct OneUnit {
  Unit u; int reps = 1;
  __device__ __forceinline__ bool next(int i, Unit& o) const { if (i >= reps) return false; o = u; return true; }
};
template <class Epi, class Sched>
__device__ __forceinline__ void gemm_phase(LAS unsigned char* lds, const Sched& S, const Epi& E) {
  const int tid = otid(), wid = __builtin_amdgcn_readfirstlane(tid >> 6), lane = tid & 63, wr = wid >> 2, wc = wid & 3, fr = lane & 15, fq = lane >> 4;
  int sR[2], sC[2];
#pragma unroll
  for (int i = 0; i < 2; ++i) stage_rc(tid * 16 + i * 8192, sR[i], sC[i]);
  int sRp[2];
#pragma unroll
  for (int i = 0; i < 2; ++i) { const int rho = sR[i] & 31, n_ = rho >> 4, i_ = rho & 15; sRp[i] = (sR[i] & ~31) + 8 * (i_ >> 2) + 4 * n_ + (i_ & 3); }
  const size_t kstep = 128;
  const unsigned ldsw = (unsigned)wid * 1024u;
  const int aoff = lds_byte(wr * 64 + fr, fq * 8), boff = lds_byte(wc * 32 + fr, fq * 8);
#define G8_SA(b, h) (((b) * 2 + (h)) * HTB)
#define G8_SB(b, h) ((4 + (b) * 2 + (h)) * HTB)
#define G8_STAGE(bufoff, gbase, voff) do { _Pragma("unroll") for (int _i = 0; _i < 2; ++_i) \
    __builtin_amdgcn_global_load_lds((const unsigned*)((const char*)(gbase) + (voff)[_i]), (LAS unsigned*)(lds + (bufoff) + ldsw + _i * 8192), 16, 0, 0); } while (0)
#define G8_LDA(dst, b, h) do { _Pragma("unroll") for (int m = 0; m < 4; ++m) _Pragma("unroll") for (int k = 0; k < 2; ++k) dst[m][k] = *(const LAS bf16x8*)(lds + G8_SA(b, h) + aoff + m * 2048 + k * 1024); } while (0)
#define G8_LDB(dst, b, h) do { _Pragma("unroll") for (int n = 0; n < 2; ++n) _Pragma("unroll") for (int k = 0; k < 2; ++k) dst[n][k] = *(const LAS bf16x8*)(lds + G8_SB(b, h) + boff + n * 2048 + k * 1024); } while (0)
#define G8_MMA(ai, bj, At, Bt) do { __builtin_amdgcn_s_setprio(1); _Pragma("unroll") for (int m = 0; m < 4; ++m) _Pragma("unroll") for (int n = 0; n < 2; ++n) _Pragma("unroll") for (int k = 0; k < 2; ++k) \
    acc[ai][bj][m][n] = __builtin_amdgcn_mfma_f32_16x16x32_bf16(Bt[n][k], At[m][k], acc[ai][bj][m][n], 0, 0, 0); __builtin_amdgcn_s_setprio(0); } while (0)
#define G8_WAIT_V(n) asm volatile("s_waitcnt vmcnt(" #n ")" ::: "memory")
#define G8_WAIT_L(n) asm volatile("s_waitcnt lgkmcnt(" #n ")" ::: "memory")
#define G8_BAR __builtin_amdgcn_s_barrier()
#define G8_SCHED __builtin_amdgcn_sched_barrier(0)
  Unit cur, nxt; int ui = 0;
  if (!S.next(0, cur)) return;
  f32x4 acc[2][2][4][2];
#pragma unroll
  for (int a = 0; a < 2; ++a)
#pragma unroll
    for (int b = 0; b < 2; ++b)
#pragma unroll
      for (int m = 0; m < 4; ++m)
#pragma unroll
        for (int n = 0; n < 2; ++n) acc[a][b][m][n] = f32x4{0.f, 0.f, 0.f, 0.f};
  bf16x8 At[4][2], B0[2][2], B1[2][2];
  const char* cA = cur.a; const char* cB = cur.b;
  unsigned voffA[2], voffB[2];
#pragma unroll
  for (int i = 0; i < 2; ++i) { voffA[i] = (unsigned)(sR[i] * cur.lda + sC[i]) * 2u; voffB[i] = (unsigned)((cur.perm ? sRp[i] : sR[i]) * cur.ldb + sC[i]) * 2u; }
  size_t hstepA = (size_t)128 * cur.lda * 2, hstepB = (size_t)128 * cur.ldb * 2;
  G8_STAGE(G8_SB(0, 0), cB, voffB); G8_STAGE(G8_SA(0, 0), cA, voffA); G8_STAGE(G8_SB(0, 1), cB + hstepB, voffB); G8_STAGE(G8_SA(0, 1), cA + hstepA, voffA);
  if (wr == 1) G8_BAR;
  G8_WAIT_V(4); G8_BAR;
  G8_STAGE(G8_SB(1, 0), cB + kstep, voffB); G8_STAGE(G8_SA(1, 0), cA + kstep, voffA); G8_STAGE(G8_SB(1, 1), cB + hstepB + kstep, voffB);
  G8_WAIT_V(6); G8_BAR;
  for (;;) {
    const bool has_next = S.next(ui + 1, nxt);
    if (!has_next) nxt = cur;
    const char* nA = nxt.a; const char* nB = nxt.b;
    unsigned voffAn[2], voffBn[2];
#pragma unroll
    for (int i = 0; i < 2; ++i) { voffAn[i] = (unsigned)(sR[i] * nxt.lda + sC[i]) * 2u; voffBn[i] = (unsigned)((nxt.perm ? sRp[i] : sR[i]) * nxt.ldb + sC[i]) * 2u; }
    const size_t hstepAn = (size_t)128 * nxt.lda * 2, hstepBn = (size_t)128 * nxt.ldb * 2;
    const int nt = cur.nt;
    for (int t = 0; t < nt; t += 2) {
      const bool last = (t == nt - 2);
      const char* a1 = cA + (size_t)(t + 1) * kstep;
      const char* a2 = last ? nA : cA + (size_t)(t + 2) * kstep; const char* b2 = last ? nB : cB + (size_t)(t + 2) * kstep;
      const char* a3 = a2 + kstep; const char* b3 = b2 + kstep;
      unsigned vA2[2], vB2[2];
#pragma unroll
      for (int i = 0; i < 2; ++i) { vA2[i] = last ? voffAn[i] : voffA[i]; vB2[i] = last ? voffBn[i] : voffB[i]; }
      const size_t hA2 = last ? hstepAn : hstepA, hB2 = last ? hstepBn : hstepB;
      G8_LDB(B0, 0, 0); G8_SCHED; G8_LDA(At, 0, 0); G8_STAGE(G8_SA(1, 1), a1 + hstepA, voffA);
      G8_WAIT_L(8); G8_BAR; G8_WAIT_L(0); G8_MMA(0, 0, At, B0); G8_BAR; G8_SCHED;
      G8_LDB(B1, 0, 1); G8_STAGE(G8_SB(0, 0), b2, vB2);
      G8_BAR; G8_WAIT_L(0); G8_MMA(0, 1, At, B1); G8_BAR;
      G8_LDA(At, 0, 1); G8_STAGE(G8_SA(0, 0), a2, vA2);
      G8_BAR; G8_WAIT_L(0); G8_MMA(1, 0, At, B0); G8_BAR; G8_SCHED;
      G8_STAGE(G8_SB(0, 1), b2 + hB2, vB2);
      G8_WAIT_V(6); G8_BAR; G8_MMA(1, 1, At, B1); G8_BAR;
      G8_LDB(B0, 1, 0); G8_SCHED; G8_LDA(At, 1, 0); G8_STAGE(G8_SA(0, 1), a2 + hA2, vA2);
      G8_WAIT_L(8); G8_BAR; G8_WAIT_L(0); G8_MMA(0, 0, At, B0); G8_BAR; G8_SCHED;
      G8_LDB(B1, 1, 1); G8_STAGE(G8_SB(1, 0), b3, vB2);
      G8_BAR; G8_WAIT_L(0); G8_MMA(0, 1, At, B1); G8_BAR;
      G8_LDA(At, 1, 1); G8_STAGE(G8_SA(1, 0), a3, vA2);
      G8_BAR; G8_WAIT_L(0); G8_MMA(1, 0, At, B0); G8_BAR; G8_SCHED;
      G8_STAGE(G8_SB(1, 1), b3 + hB2, vB2);
      G8_WAIT_V(6); G8_BAR; G8_MMA(1, 1, At, B1); G8_BAR;
    }
    E(acc, cur, wr, wc, fr, fq, lds);
    if (!has_next) break;
#pragma unroll
    for (int a = 0; a < 2; ++a)
#pragma unroll
      for (int b = 0; b < 2; ++b)
#pragma unroll
        for (int m = 0; m < 4; ++m)
#pragma unroll
          for (int n = 0; n < 2; ++n) acc[a][b][m][n] = f32x4{0.f, 0.f, 0.f, 0.f};
    cur = nxt; cA = nA; cB = nB; ++ui;
#pragma unroll
    for (int i = 0; i < 2; ++i) { voffA[i] = voffAn[i]; voffB[i] = voffBn[i]; }
    hstepA = hstepAn; hstepB = hstepBn;
  }
  G8_WAIT_V(0);
  if (wr == 0) G8_BAR;
  G8_BAR;
}

__device__ __forceinline__ void p0_mod16(const Params& p, int item, char* lds) {
  const int tid = otid();
  float* sc = (float*)lds;
  float* red = sc + 3072;
  const int l = item / 192, cgp = item % 192;
  const float* cctx = p.in[6]; const float* cc2 = p.in[2];
  for (int i = tid; i < 3072; i += 512) {
    int j = i >> 10, k = i & 1023;
    float c = (j == 0) ? cctx[k] : cc2[(j > 0 ? j - 1 : 0) * 1024 + k];
    sc[i] = c / (1.f + expf(-c));
  }
  __syncthreads();
  const int col = tid & 15, kg = tid >> 4;
  const float* W = p.in[7] + (size_t)l * 1024 * 3072 + cgp * 16 + col;
  float a0 = 0.f, a1 = 0.f, a2 = 0.f;
#pragma unroll 8
  for (int k = kg * 32; k < kg * 32 + 32; ++k) {
    float w = W[(size_t)k * 3072];
    a0 += sc[k] * w; a1 += sc[1024 + k] * w; a2 += sc[2048 + k] * w;
  }
  red[(kg * 3 + 0) * 16 + col] = a0; red[(kg * 3 + 1) * 16 + col] = a1; red[(kg * 3 + 2) * 16 + col] = a2;
  __syncthreads();
  if (tid < 48) {
    const int j = tid >> 4; float s_ = 0.f;
    for (int g = 0; g < 32; ++g) s_ += red[(g * 3 + j) * 16 + col];
    const int n = cgp * 16 + col;
    __hip_atomic_store((float*)(p.ws + OFF_MOD) + (l * 3 + j) * 3072 + n, s_ + p.in[8][l * 3072 + n], __ATOMIC_RELAXED, __HIP_MEMORY_SCOPE_AGENT);
  }
  if (tid < 64) {
    asm volatile("s_waitcnt vmcnt(0)" ::: "memory");
    if (tid == 0) __hip_atomic_fetch_add((unsigned*)(p.ws + OFF_CNT) + 6, 1u, __ATOMIC_RELAXED, __HIP_MEMORY_SCOPE_AGENT);
  }
  __syncthreads();
}

__device__ __forceinline__ void p0_item(const Params& p, int item, char* lds) {
  const int tid = otid();
  char* ws = p.ws;
  if (item < 96) {
    float* sc = (float*)lds;
    float* red = sc + 3072;
    const int l = item / 48, cgp = item % 48;
    const float* cctx = p.in[6]; const float* cc2 = p.in[2];
    for (int i = tid; i < 3072; i += 512) {
      int j = i >> 10, k = i & 1023;
      float c = (j == 0) ? cctx[k] : cc2[(j > 0 ? j - 1 : 0) * 1024 + k];
      sc[i] = siluf(c);
    }
    __syncthreads();
    const int col = tid & 63, kg = tid >> 6;
    const float* W = p.in[7] + (size_t)l * 1024 * 3072 + cgp * 64 + col;
    float a0 = 0.f, a1 = 0.f, a2 = 0.f;
    for (int k = kg * 128; k < kg * 128 + 128; ++k) {
      float w = W[(size_t)k * 3072];
      a0 += sc[k] * w; a1 += sc[1024 + k] * w; a2 += sc[2048 + k] * w;
    }
    red[(kg * 3 + 0) * 64 + col] = a0; red[(kg * 3 + 1) * 64 + col] = a1; red[(kg * 3 + 2) * 64 + col] = a2;
    __syncthreads();
    if (tid < 192) {
      int j = tid >> 6; float s = 0.f;
      for (int g = 0; g < 8; ++g) s += red[(g * 3 + j) * 64 + col];
      int n = cgp * 64 + col;
      ((float*)(ws + OFF_MOD))[(l * 3 + j) * 3072 + n] = s + p.in[8][l * 3072 + n];
    }
    __syncthreads();
    return;
  }
  item -= 96;
  if (item < 128) {
    int idx = item * 512 + tid, t = idx >> 5, c = idx & 31, fi = c & 15;
    float pos = (c < 16) ? (float)(t >> 6) : (float)(t & 63);
    float inv = powf(10000.f, -(float)fi / 16.f);
    float ang = pos * inv;
    ((float2*)(ws + OFF_ROPE))[idx] = make_float2(cosf(ang), sinf(ang));
    return;
  }
  item -= 128;
  if (item < 2048) {
    const float2* tab = (const float2*)lds;
    int idx = item * 512 + tid, tp = idx >> 9, k0 = (idx & 511) * 8;
    uint32_t o[4];
    float vv[8];
#pragma unroll
    for (int j = 0; j < 8; ++j) {
      int k = k0 + j; int m = (tp * (k & 2047)) & 2047;
      float2 cs = tab[m];
      vv[j] = (k < 2048) ? cs.x : -cs.y;
    }
#pragma unroll
    for (int j = 0; j < 4; ++j) o[j] = pack2(vv[2 * j], vv[2 * j + 1]);
    *(uint4*)(ws + OFF_DL + (size_t)idx * 16) = make_uint4(o[0], o[1], o[2], o[3]);
    return;
  }
  item -= 2048;
  if (item < 32) {
    int idx = item * 512 + tid, tp = idx >> 6, k0 = (idx & 63) * 8;
    uint32_t o[4];
    float vv[8];
#pragma unroll
    for (int j = 0; j < 8; ++j) {
      int k = k0 + j; int m = (tp * (k & 255)) & 255; float s, c;
      sincospif((float)m * (1.f / 128.f), &s, &c);
      vv[j] = (k < 256) ? c : -s;
    }
#pragma unroll
    for (int j = 0; j < 4; ++j) o[j] = pack2(vv[2 * j], vv[2 * j + 1]);
    *(uint4*)(ws + OFF_DC + (size_t)idx * 16) = make_uint4(o[0], o[1], o[2], o[3]);
    return;
  }
  item -= 32;
  if (item < 8) {
    int idx = item * 512 + tid, j = idx >> 4, c0 = (idx & 15) * 8;
    uint32_t o[4];
    float vv[8];
#pragma unroll
    for (int q = 0; q < 8; ++q) {
      int m = ((j & 127) * (c0 + q)) & 127; float s, c;
      sincospif((float)m * (1.f / 64.f), &s, &c);
      vv[q] = (j < 128) ? c : s;
    }
#pragma unroll
    for (int q = 0; q < 4; ++q) o[q] = pack2(vv[2 * q], vv[2 * q + 1]);
    *(uint4*)(ws + OFF_B1 + (size_t)idx * 16) = make_uint4(o[0], o[1], o[2], o[3]);
    return;
  }
  item -= 8;
  if (item < 128) {
    int idx = item * 512 + tid; int e = idx * 8;
    int n = e & 511, t = (e >> 9) & 255, l = (e >> 17) & 1, b = e >> 18;
    const float4* s = (const float4*)(p.in[3] + e);
    float4 a = s[0], c = s[1];
    size_t d = ((size_t)((l * 2 + b) * 256 + t)) * 512 + n;
    *(uint4*)(ws + OFF_KC + d * 2) = make_uint4(pack2(a.x, a.y), pack2(a.z, a.w), pack2(c.x, c.y), pack2(c.z, c.w));
    return;
  }
  item -= 128;
  {
    int idx = item * 512 + tid;
    int v = idx & 127, tc = (idx >> 7) & 31, h = (idx >> 12) & 3, b = (idx >> 14) & 1, l = idx >> 15;
    float vv[8];
#pragma unroll
    for (int j = 0; j < 8; ++j) vv[j] = p.in[4][((size_t)((b * 2 + l) * 256 + tc * 8 + j)) * 512 + h * 128 + v];
    size_t d = ((size_t)((b * 4 + h) * 128 + v)) * 2304 + 2048 + tc * 8;
    *(uint4*)(ws + OFF_VTL + l * SZ_VTL + d * 2) = make_uint4(pack2(vv[0], vv[1]), pack2(vv[2], vv[3]), pack2(vv[4], vv[5]), pack2(vv[6], vv[7]));
  }
}
constexpr int P0_ITEMS = 96 + 128 + 2048 + 32 + 8 + 128 + 128;

__device__ __forceinline__ void p1_item(const Params& p, int l, int item, char* lds) {
  const int tid = otid();
  char* ws = p.ws;
  if (item < 2816) {
    const float* src; int lsrc; u16* dst; int ldd; int kt, nt;
    const float* w10 = p.in[10]; const float* w17 = p.in[17]; const float* w18 = p.in[18]; const float* w19 = p.in[19]; const float* w20 = p.in[20];
    if (item < 2176) { src = w10 + (size_t)l * 1024 * 8704; lsrc = 8704; dst = (u16*)(ws + OFF_WIN); ldd = 1024; nt = item >> 4; kt = item & 15; }
    else if (item < 2560) { int r = item - 2176; int j = r >> 7; r &= 127; src = ((j == 0) ? w17 : ((j == 1) ? w18 : w19)) + (size_t)l * 512 * 1024; lsrc = 1024; dst = (u16*)(ws + OFF_WBR) + (size_t)j * 1024 * 512; ldd = 512; nt = r >> 3; kt = r & 7; }
    else { int r = item - 2560; src = w20 + (size_t)l * 1024 * 1024; lsrc = 1024; dst = (u16*)(ws + OFF_WO); ldd = 1024; nt = r >> 4; kt = r & 15; }
    u16* T = (u16*)lds;
    const int k0 = kt * 64, n0 = nt * 64;
#pragma unroll
    for (int ps = 0; ps < 2; ++ps) {
      int kr = (tid >> 4) + 32 * ps, nq = tid & 15;
      float4 v = *(const float4*)(src + (size_t)(k0 + kr) * lsrc + n0 + 4 * nq);
      T[(4 * nq + 0) * 72 + kr] = f2bf(v.x); T[(4 * nq + 1) * 72 + kr] = f2bf(v.y);
      T[(4 * nq + 2) * 72 + kr] = f2bf(v.z); T[(4 * nq + 3) * 72 + kr] = f2bf(v.w);
    }
    __syncthreads();
    {
      int n = tid >> 3, kc = tid & 7;
      uint4 o = *(const uint4*)(T + n * 72 + kc * 8);
      *(uint4*)(dst + (size_t)(n0 + n) * ldd + k0 + kc * 8) = o;
    }
    __syncthreads();
    return;
  }
  item -= 2816;
  const int lane = tid & 63, wid = tid >> 6;
  const float* modp = (const float*)(ws + OFF_MOD);
  u16* H = (u16*)(ws + OFF_H);
  const float* xin0 = p.in[0]; const float* xin1 = p.in[1]; const float* xin2 = p.out; const float* ng = p.in[9];
#pragma unroll
  for (int rr = 0; rr < 2; ++rr) {
    int r = item * 16 + wid * 2 + rr;
    const float* x = (l == 0) ? ((r < NCTX) ? xin0 + (size_t)r * 1024 : xin1 + (size_t)(r - NCTX) * 1024) : xin2 + (size_t)r * 1024;
    int ci = (r < NCTX) ? 0 : 1 + ((r - NCTX) >> 11);
    float4 v[4]; float ss = 0.f;
#pragma unroll
    for (int i = 0; i < 4; ++i) { v[i] = *(const float4*)(x + lane * 4 + 256 * i); ss += v[i].x * v[i].x + v[i].y * v[i].y + v[i].z * v[i].z + v[i].w * v[i].w; }
#pragma unroll
    for (int o = 32; o >= 1; o >>= 1) ss += __shfl_xor(ss, o);
    float rinv = rsqrtf(ss * (1.f / 1024.f) + EPSV);
    const float* sh = modp + (l * 3 + ci) * 3072;
#pragma unroll
    for (int i = 0; i < 4; ++i) {
      int col = lane * 4 + 256 * i;
      float4 g = *(const float4*)(ng + l * 1024 + col);
      float4 s1 = *(const float4*)(sh + 1024 + col);
      float4 s0 = *(const float4*)(sh + col);
      float a = v[i].x * rinv * g.x * (1.f + s1.x) + s0.x;
      float b = v[i].y * rinv * g.y * (1.f + s1.y) + s0.y;
      float c = v[i].z * rinv * g.z * (1.f + s1.z) + s0.z;
      float d = v[i].w * rinv * g.w * (1.f + s1.w) + s0.w;
      *(uint2*)(H + (size_t)r * 1024 + col) = make_uint2(pack2(a, b), pack2(c, d));
    }
  }
}
constexpr int P1_ITEMS = 2816 + 768;

__device__ __forceinline__ void stagger_us(int us) {
  const unsigned long long t0 = __builtin_amdgcn_s_memrealtime();
  while (__builtin_amdgcn_s_memrealtime() - t0 < (unsigned long long)us * 100ull) __builtin_amdgcn_s_sleep(8);
}
#define STAGGER_US 0
struct P2Sched {
  const char* H; const char* W; int G, c;
  __device__ __forceinline__ bool next(int i, Unit& u) const {
    const int L = i * G + c;
    if (L >= 1024) return false;
    if (L < 960) {
      const int nM = 48, nN = 20, nwg = 960;
      int wgid = L; { const int q = nwg / 8, xcd = wgid % 8, off = wgid / 8; wgid = xcd * q + off; }
      const int nig = 8 * nN, gid = wgid / nig, fm = gid * 8, gsz = (nM - fm) < 8 ? (nM - fm) : 8;
      int pm = fm + ((wgid % nig) % gsz), pn = (wgid % nig) / gsz;
      if (pn >= 14) pn += 2;
      u.a = H + (size_t)pm * 256 * 2048; u.b = W + (size_t)pn * 256 * 2048; u.x = pm; u.y = pn;
      u.lda = 1024; u.ldb = 1024; u.nt = 16; u.perm = ((pn >> 1) == 5 || (pn >> 1) == 6) ? 0 : 1;
    } else {
      const int r = L - 960; const int vq = r / 48, mt = r % 48;
      u.a = W + (size_t)(3584 + vq * 256) * 2048; u.b = H + (size_t)mt * 256 * 2048; u.x = vq; u.y = mt | 0x100;
      u.lda = 1024; u.ldb = 1024; u.nt = 16; u.perm = 0;
    }
    return true;
  }
};
struct P2Epi {
  const float* const* pin; float* out; char* ws; int l;
  const float* hlb; const float* qng; const float* kng; bool skip;
  __device__ __forceinline__ void operator()(f32x4 (&acc)[2][2][4][2], const Unit& u, int wr, int wc, int fr, int fq, LAS unsigned char* lds) const {
    if (skip) return;
    { const int t_ = otid(); const int w_ = t_ >> 6; wr = w_ >> 2; wc = w_ & 3; fr = t_ & 15; fq = (t_ & 63) >> 4; }
    if (u.y & 0x100) {
      const int mt = u.y & 0xff, vq = u.x;
#pragma unroll
      for (int ai = 0; ai < 2; ++ai)
#pragma unroll
        for (int m = 0; m < 4; ++m) {
          const int nn = vq * 256 + ai * 128 + wr * 64 + m * 16 + fr;
          const int hh = nn >> 7, v = nn & 127;
#pragma unroll
          for (int bj = 0; bj < 2; ++bj)
#pragma unroll
            for (int n = 0; n < 2; ++n) {
              const int tokl = bj * 128 + wc * 32 + n * 16 + 4 * fq;
              f32x4 a4 = acc[ai][bj][m][n];
              uint2 pk = make_uint2(pack2(a4[0], a4[1]), pack2(a4[2], a4[3]));
              if (mt < 32) {
                *(uint2*)(ws + OFF_VTC + ((size_t)((mt * 4 + hh) * 128 + v) * 256 + tokl) * 2) = pk;
                float* o = out + OCV + ((size_t)((mt * 2 + l) * 256 + tokl)) * 512 + nn;
                o[0] = a4[0]; o[512] = a4[1]; o[1024] = a4[2]; o[1536] = a4[3];
              } else {
                int rp = (mt - 32) * 256 + tokl; int bb = rp >> 11, t = rp & 2047;
                *(uint2*)(ws + OFF_VTL + l * SZ_VTL + ((size_t)((bb * 4 + hh) * 128 + v) * 2304 + t) * 2) = pk;
              }
            }
        }
      return;
    }
    const int pm = u.x, pn = u.y, seg = pn >> 1, ncol0 = (pn & 1) * 256;
    const int dcol0 = ((seg < 7) ? seg : seg - 1) * 512 + ncol0;
    u16* proj = (u16*)(ws + OFF_PROJ);
    const bool lat = (pm >= 32);
    if (seg == 5 || seg == 6) {
      float* xch = (float*)(lds + G8_STAGE_BYTES);
#pragma unroll
      for (int ai = 0; ai < 2; ++ai)
#pragma unroll
        for (int m = 0; m < 4; ++m)
#pragma unroll
          for (int bj = 0; bj < 2; ++bj) {
            float ss = 0.f;
#pragma unroll
            for (int n = 0; n < 2; ++n)
#pragma unroll
              for (int e = 0; e < 4; ++e) { float bfv = bf2f(f2bf(acc[ai][bj][m][n][e])); ss += bfv * bfv; }
            ss += __shfl_xor(ss, 16); ss += __shfl_xor(ss, 32);
            if (fq == 0) xch[((ai * 128 + wr * 64 + m * 16 + fr) * 2 + bj) * 4 + wc] = ss;
          }
      asm volatile("s_waitcnt lgkmcnt(0)" ::: "memory");
      __builtin_amdgcn_s_barrier();
      asm volatile("" ::: "memory");
      const float* gsel = (seg == 5) ? qng : kng;
      float gv[2][4];
#pragma unroll
      for (int n = 0; n < 2; ++n)
#pragma unroll
        for (int e = 0; e < 4; ++e) gv[n][e] = gsel[l * 64 + 32 * (wc & 1) + 16 * n + 4 * fq + e];
#pragma unroll
      for (int ai = 0; ai < 2; ++ai)
#pragma unroll
        for (int m = 0; m < 4; ++m) {
          const int rl = ai * 128 + wr * 64 + m * 16 + fr;
          const int grow = pm * 256 + rl;
#pragma unroll
          for (int bj = 0; bj < 2; ++bj) {
            const float2 pr = *(const float2*)&xch[(rl * 2 + bj) * 4 + (wc & 2)];
            const float tot = pr.x + pr.y;
            const float rinv = rsqrtf(tot * (1.f / 64.f) + EPSV);
            float x[2][4];
#pragma unroll
            for (int n = 0; n < 2; ++n)
#pragma unroll
              for (int e = 0; e < 4; ++e) x[n][e] = bf2f(f2bf(acc[ai][bj][m][n][e])) * rinv * gv[n][e];
            const int colt = ncol0 + bj * 128 + wc * 32;
            if (seg == 6 && !lat) {
              float* o = out + OCK + ((size_t)((pm * 2 + l) * 256 + rl)) * 512 + colt + 4 * fq;
              *(float4*)o = make_float4(x[0][0], x[0][1], x[0][2], x[0][3]);
              *(float4*)(o + 16) = make_float4(x[1][0], x[1][1], x[1][2], x[1][3]);
            }
            if (lat) {
              const int t = (grow - NCTX) & 2047;
              const float2* rt = (const float2*)(ws + OFF_ROPE) + t * 32 + ((wc & 1) ? 16 : 0) + 4 * fq;
#pragma unroll
              for (int e = 0; e < 4; ++e) {
                float2 cs = rt[e];
                float x1 = x[0][e], x2 = x[1][e];
                x[0][e] = x1 * cs.x - x2 * cs.y;
                x[1][e] = x1 * cs.y + x2 * cs.x;
              }
            }
            if (seg == 5) {
#pragma unroll
              for (int n = 0; n < 2; ++n)
#pragma unroll
                for (int e = 0; e < 4; ++e) x[n][e] *= 0.125f;
            }
            u16* dp = proj + (size_t)grow * LDP + dcol0 + bj * 128 + wc * 32 + 4 * fq;
            *(uint2*)dp = make_uint2(pack2(x[0][0], x[0][1]), pack2(x[0][2], x[0][3]));
            *(uint2*)(dp + 16) = make_uint2(pack2(x[1][0], x[1][1]), pack2(x[1][2], x[1][3]));
          }
        }
      return;
    }
    const bool dosilu = (seg == 0 || seg == 4 || seg == 8 || seg == 10);
    const bool dolf = (seg == 1 || seg == 2);
    const int dir = (seg == 2) ? 1 : 0;
#define P2_STORE16(A0, A1) *(uint4*)(proj + (size_t)grow * LDP + dcol0 + bj * 128 + wc * 32 + 8 * fq) = make_uint4(pack2(A0[0], A0[1]), pack2(A0[2], A0[3]), pack2(A1[0], A1[1]), pack2(A1[2], A1[3]))
    if (dosilu) {
#pragma unroll
      for (int ai = 0; ai < 2; ++ai)
#pragma unroll
        for (int m = 0; m < 4; ++m) {
          const int grow = pm * 256 + ai * 128 + wr * 64 + m * 16 + fr;
#pragma unroll
          for (int bj = 0; bj < 2; ++bj) {
            f32x4 a0 = acc[ai][bj][m][0], a1 = acc[ai][bj][m][1];
#pragma unroll
            for (int e = 0; e < 4; ++e) { a0[e] = siluf(a0[e]); a1[e] = siluf(a1[e]); }
            P2_STORE16(a0, a1);
          }
        }
    } else if (dolf) {
#pragma unroll
      for (int bj = 0; bj < 2; ++bj) {
        float lbv[2][4];
#pragma unroll
        for (int n = 0; n < 2; ++n)
#pragma unroll
          for (int e = 0; e < 4; ++e) {
            int j = ncol0 + bj * 128 + wc * 32 + 8 * fq + 4 * n + e;
            lbv[n][e] = (l == 0) ? 0.f : sigmf(hlb[(1 * 2 + dir) * 512 + j] - hlb[(0 * 2 + dir) * 512 + j]);
          }
#pragma unroll
        for (int ai = 0; ai < 2; ++ai)
#pragma unroll
          for (int m = 0; m < 4; ++m) {
            const int grow = pm * 256 + ai * 128 + wr * 64 + m * 16 + fr;
            f32x4 a0 = acc[ai][bj][m][0], a1 = acc[ai][bj][m][1];
#pragma unroll
            for (int e = 0; e < 4; ++e) { a0[e] = logf_gate(a0[e], lbv[0][e]); a1[e] = logf_gate(a1[e], lbv[1][e]); }
            P2_STORE16(a0, a1);
          }
      }
    } else {
#pragma unroll
      for (int ai = 0; ai < 2; ++ai)
#pragma unroll
        for (int m = 0; m < 4; ++m) {
          const int grow = pm * 256 + ai * 128 + wr * 64 + m * 16 + fr;
#pragma unroll
          for (int bj = 0; bj < 2; ++bj) {
            f32x4 a0 = acc[ai][bj][m][0], a1 = acc[ai][bj][m][1];
            P2_STORE16(a0, a1);
          }
        }
    }
  }
};
__device__ __forceinline__ void p2_left_item(const Params& p, int l, int L, char* lds) {
  P2Sched S0; S0.H = p.ws + OFF_H; S0.W = p.ws + OFF_WIN; S0.G = 0x40000000; S0.c = 0;
  OneUnit S;
  {
    const int r = L - 960; const int vq = r / 48, mt = r % 48;
    S.u.a = S0.W + (size_t)(3584 + vq * 256) * 2048; S.u.b = S0.H + (size_t)mt * 256 * 2048; S.u.x = vq; S.u.y = mt | 0x100;
    S.u.lda = 1024; S.u.ldb = 1024; S.u.nt = 16;
  }
  P2Epi E; E.pin = nullptr; E.out = p.out; E.ws = p.ws; E.l = l; E.hlb = p.in[11]; E.qng = p.in[13]; E.kng = p.in[14]; E.skip = false;
  gemm_phase((LAS unsigned char*)lds, S, E);
}
__device__ __forceinline__ void p2_phase(const Params& p, int l, char* lds, bool skip = false) {
  if (STAGGER_US && ((blockIdx.x >> 3) & 1)) stagger_us(STAGGER_US);
  P2Sched S; S.H = p.ws + OFF_H; S.W = p.ws + OFF_WIN; S.G = gridDim.x; S.c = blockIdx.x;
  P2Epi E; E.pin = nullptr; E.out = p.out; E.ws = p.ws; E.l = l; E.hlb = p.in[11]; E.qng = p.in[13]; E.kng = p.in[14]; E.skip = skip;
  gemm_phase((LAS unsigned char*)lds, S, E);
}

struct HgrnLds {
  float tot[4][128];
  float dk[128];
  float osum[16][132];
  u16 qt[16][136];
  u16 kt[16][136];
  u16 khT[128][16];
  u16 vT[128][16];
  u16 zt[16][136];
  u16 obuf[256][136];
};

#define LBAR() do { asm volatile("s_waitcnt lgkmcnt(0)" ::: "memory"); __builtin_amdgcn_s_barrier(); asm volatile("" ::: "memory"); } while (0)
__device__ __forceinline__ void hgrn_pass(const Params& p, int l, int row0, int ntok, int h, int dir, f32x4 (&S)[8],
                                          const bool do_out, const bool second, float& gsum, HgrnLds& L, const bool dry = false) {
  const int tid = otid(), lane = tid & 63, wid = tid >> 6, c16 = lane & 15, g = lane >> 4;
  const int kk = tid & 127, tq = tid >> 7;
  const u16* proj = (const u16*)(p.ws + OFF_PROJ);
  u16* projw = (u16*)(p.ws + OFF_PROJ);
  const int nch = ntok >> 4;
  float4 gg = make_float4(0.f, 0.f, 0.f, 0.f);
  if (second) gg = *(const float4*)(p.in[12] + l * 512 + h * 128 + 4 * (tid & 31));
  u16 lfA[4], qA[4], vA[4], zA[4], lfB[4], qB[4], vB[4], zB[4];
#define HG_LD(c_, LF, QQ, VV, ZZ)                                                    \
  {                                                                                  \
    _Pragma("unroll") for (int i = 0; i < 4; ++i) {                                  \
      int s_ = (c_) * 16 + 4 * tq + i;                                               \
      int tl_ = dir ? (ntok - 1 - s_) : s_;                                          \
      const u16* rp_ = proj + (size_t)(row0 + tl_) * LDP + h * 128 + kk;             \
      LF[i] = rp_[PLF + dir * 512];                                                  \
      VV[i] = rp_[PIA];                                                              \
      QQ[i] = do_out ? rp_[PQA] : (u16)0;                                            \
      ZZ[i] = second ? rp_[PZA] : (u16)0;                                            \
    }                                                                                \
  }
  HG_LD(0, lfA, qA, vA, zA);
  HG_LD(1, lfB, qB, vB, zB);
  auto body = [&](const int c, u16 (&LF)[4], u16 (&QQ)[4], u16 (&VV)[4], u16 (&ZZ)[4]) __attribute__((always_inline)) {
    float lf[4], G[4], qv[4];
    u16 vv[4], zz[4];
#pragma unroll
    for (int i = 0; i < 4; ++i) { lf[i] = bf2f(LF[i]); qv[i] = bf2f(QQ[i]); vv[i] = VV[i]; zz[i] = ZZ[i]; }
    G[0] = lf[0]; G[1] = G[0] + lf[1]; G[2] = G[1] + lf[2]; G[3] = G[2] + lf[3];
    L.tot[tq][kk] = G[3];
    LBAR();
    if (c + 2 < nch) HG_LD(c + 2, LF, QQ, VV, ZZ);
    float t0 = L.tot[0][kk], t1 = L.tot[1][kk], t2 = L.tot[2][kk], t3 = L.tot[3][kk];
    float off = (tq > 0 ? t0 : 0.f) + (tq > 1 ? t1 : 0.f) + (tq > 2 ? t2 : 0.f);
    float gend = t0 + t1 + t2 + t3;
    float kh[4];
#pragma unroll
    for (int i = 0; i < 4; ++i) {
      float Gi = G[i] + off;
      float kv = neg_expm1(lf[i]);
      int s = 4 * tq + i;
      if (do_out) {
        L.qt[s][kk] = f2bf(qv[i] * fexp(Gi));
        L.kt[s][kk] = f2bf(kv * fexp(fminf(-Gi, 80.f)));
      }
      if (second) L.zt[s][kk] = zz[i];
      kh[i] = kv * fexp(gend - Gi);
    }
    *(uint2*)&L.khT[kk][4 * tq] = make_uint2(pack2(kh[0], kh[1]), pack2(kh[2], kh[3]));
    *(uint2*)&L.vT[kk][4 * tq] = make_uint2((uint32_t)vv[0] | ((uint32_t)vv[1] << 16), (uint32_t)vv[2] | ((uint32_t)vv[3] << 16));
    if (tq == 0) { L.dk[kk] = fexp(gend); gsum += gend; }
    LBAR();
    Frag bv;
    bv.h[0] = *(const uint2*)&L.vT[16 * wid + c16][4 * g];
    bv.h[1] = make_uint2(0u, 0u);
    f32x4 o = f32x4{0.f, 0.f, 0.f, 0.f};
    if (do_out) {
      f32x4 at = f32x4{0.f, 0.f, 0.f, 0.f};
#pragma unroll
      for (int ks = 0; ks < 4; ++ks) {
        Frag a, b;
        a.q = *(const uint4*)&L.kt[c16][32 * ks + 8 * g];
        b.q = *(const uint4*)&L.qt[c16][32 * ks + 8 * g];
        at = MFMA(a.v, b.v, at);
      }
      Frag pa;
#pragma unroll
      for (int r = 0; r < 4; ++r) at[r] = (4 * g + r <= c16) ? at[r] : 0.f;
      pa.w[0] = pack2(at[0], at[1]); pa.w[1] = pack2(at[2], at[3]); pa.w[2] = 0u; pa.w[3] = 0u;
      o = MFMA(pa.v, bv.v, o);
#pragma unroll
      for (int st = 0; st < 4; ++st) {
        Frag a, b;
        a.h[0] = *(const uint2*)&L.qt[c16][32 * st + 4 * g];
        a.h[1] = *(const uint2*)&L.qt[c16][32 * st + 16 + 4 * g];
        b.w[0] = pack2(S[2 * st][0], S[2 * st][1]); b.w[1] = pack2(S[2 * st][2], S[2 * st][3]);
        b.w[2] = pack2(S[2 * st + 1][0], S[2 * st + 1][1]); b.w[3] = pack2(S[2 * st + 1][2], S[2 * st + 1][3]);
        o = MFMA(a.v, b.v, o);
      }
    }
#pragma unroll
    for (int k8 = 0; k8 < 8; ++k8) {
      float4 d = *(const float4*)&L.dk[16 * k8 + 4 * g];
      f32x4 s0 = S[k8];
      s0[0] *= d.x; s0[1] *= d.y; s0[2] *= d.z; s0[3] *= d.w;
      Frag a;
      a.h[0] = *(const uint2*)&L.khT[16 * k8 + c16][4 * g];
      a.h[1] = make_uint2(0u, 0u);
      S[k8] = MFMA(a.v, bv.v, s0);
    }
    if (do_out) {
      const int vcol = 16 * wid + c16;
      if (!second) {
#pragma unroll
        for (int r = 0; r < 4; ++r) {
          int s = c * 16 + 4 * g + r;
          int tl = dir ? (ntok - 1 - s) : s;
          L.obuf[tl][vcol] = f2bf(o[r]);
        }
      } else {
#pragma unroll
        for (int r = 0; r < 4; ++r) {
          int s = c * 16 + 4 * g + r;
          int tl = dir ? (ntok - 1 - s) : s;
          L.osum[4 * g + r][vcol] = o[r] + bf2f(L.obuf[tl][vcol]);
        }
        LBAR();
        {
          int sl = tid >> 5, vq = tid & 31;
          int s = c * 16 + sl;
          int tl = dir ? (ntok - 1 - s) : s;
          float4 ov = *(const float4*)&L.osum[sl][4 * vq];
          float ss = ov.x * ov.x + ov.y * ov.y + ov.z * ov.z + ov.w * ov.w;
#pragma unroll
          for (int m = 1; m <= 16; m <<= 1) ss += __shfl_xor(ss, m);
          float rinv = rsqrtf(ss * (1.f / 128.f) + EPSV);
          u16* rp = projw + (size_t)(row0 + tl) * LDP + h * 128 + 4 * vq;
          uint2 z = *(const uint2*)&L.zt[sl][4 * vq];
          float y0 = ov.x * rinv * gg.x * lo2f(z.x), y1 = ov.y * rinv * gg.y * hi2f(z.x);
          float y2 = ov.z * rinv * gg.z * lo2f(z.y), y3 = ov.w * rinv * gg.w * hi2f(z.y);
          if (!dry) *(uint2*)(rp + PQA) = make_uint2(pack2(y0, y1), pack2(y2, y3));
        }
      }
    }
  };
  for (int c = 0; c < nch; c += 2) {
    body(c, lfA, qA, vA, zA);
    body(c + 1, lfB, qB, vB, zB);
  }
  __syncthreads();
}

__device__ __forceinline__ void hgrn_load_state(const float* m, f32x4 (&S)[8]) {
  const int tid_ = otid(); const int lane = tid_ & 63, wid = tid_ >> 6, c16 = lane & 15, g = lane >> 4;
#pragma unroll
  for (int k8 = 0; k8 < 8; ++k8)
#pragma unroll
    for (int r = 0; r < 4; ++r) S[k8][r] = m[(16 * k8 + 4 * g + r) * 128 + 16 * wid + c16];
}
__device__ __forceinline__ void hgrn_store_state(float* m, const f32x4 (&S)[8]) {
  const int tid_ = otid(); const int lane = tid_ & 63, wid = tid_ >> 6, c16 = lane & 15, g = lane >> 4;
#pragma unroll
  for (int k8 = 0; k8 < 8; ++k8)
#pragma unroll
    for (int r = 0; r < 4; ++r) m[(16 * k8 + 4 * g + r) * 128 + 16 * wid + c16] = S[k8][r];
}
__device__ __forceinline__ void hgrn_advance(const float* U, const float* D, f32x4 (&S)[8]) {
  const int tid_ = otid(); const int lane = tid_ & 63, wid = tid_ >> 6, c16 = lane & 15, g = lane >> 4;
#pragma unroll
  for (int k8 = 0; k8 < 8; ++k8)
#pragma unroll
    for (int r = 0; r < 4; ++r) {
      int k = 16 * k8 + 4 * g + r;
      S[k8][r] = D[k] * S[k8][r] + U[k * 128 + 16 * wid + c16];
    }
}

__device__ __forceinline__ void hgrn_ctx_item(const Params& p, int l, int item, char* lds, const bool dry = false) {
  HgrnLds& L = *(HgrnLds*)lds;
  const int b = item >> 2, h = item & 3;
  f32x4 S[8];
  float gsum = 0.f;
#pragma unroll
  for (int i = 0; i < 8; ++i) S[i] = f32x4{0.f, 0.f, 0.f, 0.f};
  hgrn_pass(p, l, b * 256, 256, h, 0, S, true, false, gsum, L, dry);
  if (!dry) hgrn_store_state(p.out + OST + ((size_t)(((b * 2 + l) * 2 + 0) * 4 + h)) * 16384, S);
#pragma unroll
  for (int i = 0; i < 8; ++i) S[i] = f32x4{0.f, 0.f, 0.f, 0.f};
  hgrn_pass(p, l, b * 256, 256, h, 1, S, true, true, gsum, L, dry);
  if (!dry) hgrn_store_state(p.out + OST + ((size_t)(((b * 2 + l) * 2 + 1) * 4 + h)) * 16384, S);
}
__device__ __forceinline__ void hgrn_lat1_item(const Params& p, int l, int item, char* lds) {
  HgrnLds& L = *(HgrnLds*)lds;
  const int seg = item & 15, dir = (item >> 4) & 1, h = (item >> 5) & 3, b = item >> 7;
  f32x4 S[8];
  float gsum = 0.f;
#pragma unroll
  for (int i = 0; i < 8; ++i) S[i] = f32x4{0.f, 0.f, 0.f, 0.f};
  hgrn_pass(p, l, NCTX + b * 2048 + seg * 128, 128, h, dir, S, false, false, gsum, L);
  float* SU = (float*)(p.ws + OFF_SEGU);
  float* SD = (float*)(p.ws + OFF_SEGD);
  {
    const int tq_ = otid(); const int lane_ = tq_ & 63, wid_ = tq_ >> 6, c16_ = lane_ & 15, g_ = lane_ >> 4;
    float* m_ = SU + (size_t)item * 16384;
#pragma unroll
    for (int k8 = 0; k8 < 8; ++k8)
#pragma unroll
      for (int r = 0; r < 4; ++r) __hip_atomic_store(m_ + (16 * k8 + 4 * g_ + r) * 128 + 16 * wid_ + c16_, S[k8][r], __ATOMIC_RELAXED, __HIP_MEMORY_SCOPE_AGENT);
  }
  const int t_ = otid();
  if (t_ < 128) __hip_atomic_store(SD + item * 128 + t_, fexp(gsum), __ATOMIC_RELAXED, __HIP_MEMORY_SCOPE_AGENT);
  volatile int* flag = (volatile int*)(lds + LDS_TILE + 32);
  asm volatile("s_waitcnt vmcnt(0)" ::: "memory");
  __syncthreads();
  if (t_ == 0) {
    unsigned* tk = (unsigned*)(p.ws + OFF_CNT) + 8 + l * 32 + (item >> 4);
    const unsigned old = __hip_atomic_fetch_add(tk, 1u, __ATOMIC_RELAXED, __HIP_MEMORY_SCOPE_AGENT);
    const int last = (old == 15u) ? 1 : 0;
    if (last) { __builtin_amdgcn_fence(__ATOMIC_ACQUIRE, "agent"); asm volatile("s_waitcnt vmcnt(0)" ::: "memory"); }
    *flag = last;
  }
  __syncthreads();
  if (*flag) {
    const int base = (item >> 4) * 16;
    hgrn_load_state(p.in[5] + ((size_t)(((b * 2 + l) * 2 + dir) * 4 + h)) * 16384, S);
    const int lane = t_ & 63, wid = t_ >> 6, c16 = lane & 15, g = lane >> 4;
    float un[8][4]; float4 dn[8];
    {
      const int sg0 = dir ? 15 : 0;
      const float* U0 = SU + (size_t)(base + sg0) * 16384; const float* D0 = SD + (base + sg0) * 128;
#pragma unroll
      for (int k8 = 0; k8 < 8; ++k8) {
        dn[k8] = *(const float4*)(D0 + 16 * k8 + 4 * g);
#pragma unroll
        for (int r = 0; r < 4; ++r) un[k8][r] = U0[(16 * k8 + 4 * g + r) * 128 + 16 * wid + c16];
      }
    }
#pragma unroll 1
    for (int i = 0; i < 16; ++i) {
      const int sg = dir ? (15 - i) : i;
      float* U = SU + (size_t)(base + sg) * 16384;
      float uc[8][4]; float4 dc[8];
#pragma unroll
      for (int k8 = 0; k8 < 8; ++k8) { dc[k8] = dn[k8];
#pragma unroll
        for (int r = 0; r < 4; ++r) uc[k8][r] = un[k8][r]; }
      if (i + 1 < 16) {
        const int sgn = dir ? (14 - i) : (i + 1);
        const float* Un = SU + (size_t)(base + sgn) * 16384; const float* Dn = SD + (base + sgn) * 128;
#pragma unroll
        for (int k8 = 0; k8 < 8; ++k8) {
          dn[k8] = *(const float4*)(Dn + 16 * k8 + 4 * g);
#pragma unroll
          for (int r = 0; r < 4; ++r) un[k8][r] = Un[(16 * k8 + 4 * g + r) * 128 + 16 * wid + c16];
        }
      }
#pragma unroll
      for (int k8 = 0; k8 < 8; ++k8) {
        const float dd[4] = {dc[k8].x, dc[k8].y, dc[k8].z, dc[k8].w};
#pragma unroll
        for (int r = 0; r < 4; ++r) {
          const int idx = (16 * k8 + 4 * g + r) * 128 + 16 * wid + c16;
          U[idx] = S[k8][r];
          S[k8][r] = dd[r] * S[k8][r] + uc[k8][r];
        }
      }
    }
  }
  __syncthreads();
}
__device__ __forceinline__ void hgrn_lat2_item(const Params& p, int l, int item, char* lds, const bool dry = false) {
  HgrnLds& L = *(HgrnLds*)lds;
  const int seg = item & 15, h = (item >> 4) & 3, b = item >> 6;
  const float* SU = (const float*)(p.ws + OFF_SEGU);
  const float* SD = (const float*)(p.ws + OFF_SEGD);
  f32x4 S[8];
  float gsum = 0.f;
  hgrn_load_state(SU + (size_t)(((b * 4 + h) * 2 + 0) * 16 + seg) * 16384, S);
  hgrn_pass(p, l, NCTX + b * 2048 + seg * 128, 128, h, 0, S, true, false, gsum, L, dry);
  hgrn_load_state(SU + (size_t)(((b * 4 + h) * 2 + 1) * 16 + seg) * 16384, S);
  hgrn_pass(p, l, NCTX + b * 2048 + seg * 128, 128, h, 1, S, true, true, gsum, L, dry);
}

__device__ __forceinline__ void attn_item(const Params& p, int l, int item, const bool lat, char* lds, const bool dry = false) {
  const int tid = otid(), lane = tid & 63, wid = tid >> 6, c16 = lane & 15, g = lane >> 4;
  char* ws = p.ws;
  u16* proj = (u16*)(ws + OFF_PROJ);
  int b, h, qb, nkeys, rowbase;
  const u16* Vt; int ldv;
  if (!lat) { qb = item & 1; h = (item >> 1) & 3; b = item >> 3; nkeys = 256; rowbase = b * 256; Vt = (const u16*)(ws + OFF_VTC) + (size_t)((b * 4 + h) * 128) * 256; ldv = 256; }
  else { qb = item & 15; h = (item >> 4) & 3; b = item >> 6; nkeys = 2304; rowbase = NCTX + b * 2048; Vt = (const u16*)(ws + OFF_VTL + l * SZ_VTL) + (size_t)((b * 4 + h) * 128) * 2304; ldv = 2304; }
  const u16* Kc = (const u16*)(ws + OFF_KC) + (size_t)((l * 2 + b) * 256) * 512 + h * 128;
  u16* Ks = (u16*)lds;
  u16* Vs = Ks + 64 * 136;
  float lam_init = 0.8f - 0.6f * expf(-0.3f * (float)l);
  float lam;
  {
    const float* lp = p.in[15] + l * 256;
    float a = lp[lane] * lp[64 + lane], c = lp[128 + lane] * lp[192 + lane];
#pragma unroll
    for (int o = 32; o >= 1; o >>= 1) { a += __shfl_xor(a, o); c += __shfl_xor(c, o); }
    lam = expf(a) - expf(c) + lam_init;
  }
  const int qrow = rowbase + qb * 128 + wid * 16 + c16;
  Frag qf[2][2];
#pragma unroll
  for (int m = 0; m < 2; ++m)
#pragma unroll
    for (int ks = 0; ks < 2; ++ks) qf[m][ks].q = *(const uint4*)(proj + (size_t)qrow * LDP + PQB + h * 128 + m * 64 + ks * 32 + g * 8);
  f32x4 O[2][8];
#pragma unroll
  for (int m = 0; m < 2; ++m)
#pragma unroll
    for (int v = 0; v < 8; ++v) O[m][v] = f32x4{0.f, 0.f, 0.f, 0.f};
  float mrun[2] = {-1e30f, -1e30f}, lsum[2] = {0.f, 0.f};
  uint4 kr0, kr1, vr0, vr1;
#define ATT_LD(kt_)                                                                                           \
  {                                                                                                           \
    const int key0 = (kt_) * 64;                                                                              \
    const bool fromproj = (!lat) || (key0 < 2048);                                                            \
    {                                                                                                         \
      int q = tid; int key = q >> 4, cc = q & 15;                                                             \
      const u16* src = fromproj ? proj + (size_t)(rowbase + key0 + key) * LDP + PKB + h * 128 + cc * 8        \
                                : Kc + (size_t)(key0 - 2048 + key) * 512 + cc * 8;                            \
      kr0 = *(const uint4*)src;                                                                               \
      int v = q >> 3, c8 = q & 7;                                                                             \
      vr0 = *(const uint4*)(Vt + (size_t)v * ldv + key0 + c8 * 8);                                            \
    }                                                                                                         \
    {                                                                                                         \
      int q = tid + 512; int key = q >> 4, cc = q & 15;                                                       \
      const u16* src = fromproj ? proj + (size_t)(rowbase + key0 + key) * LDP + PKB + h * 128 + cc * 8        \
                                : Kc + (size_t)(key0 - 2048 + key) * 512 + cc * 8;                            \
      kr1 = *(const uint4*)src;                                                                               \
      int v = q >> 3, c8 = q & 7;                                                                             \
      vr1 = *(const uint4*)(Vt + (size_t)v * ldv + key0 + c8 * 8);                                            \
    }                                                                                                         \
  }
#define ATT_ST()                                                                                              \
  {                                                                                                           \
    { int q = tid; int key = q >> 4, cc = q & 15; *(uint4*)(Ks + key * 136 + cc * 8) = kr0;                   \
      int v = q >> 3, c8 = q & 7; *(uint4*)(Vs + v * 72 + c8 * 8) = vr0; }                                    \
    { int q = tid + 512; int key = q >> 4, cc = q & 15; *(uint4*)(Ks + key * 136 + cc * 8) = kr1;             \
      int v = q >> 3, c8 = q & 7; *(uint4*)(Vs + v * 72 + c8 * 8) = vr1; }                                    \
  }
  const int nkt = nkeys >> 6;
  ATT_LD(0);
  for (int kt = 0; kt < nkt; ++kt) {
    LBAR();
    ATT_ST();
    LBAR();
    if (kt + 1 < nkt) ATT_LD(kt + 1);
    Frag pf[2][2];
#pragma unroll
    for (int m = 0; m < 2; ++m) {
      f32x4 s[4];
#pragma unroll
      for (int k4 = 0; k4 < 4; ++k4) {
        s[k4] = f32x4{0.f, 0.f, 0.f, 0.f};
#pragma unroll
        for (int ks = 0; ks < 2; ++ks) {
          Frag a;
          a.q = *(const uint4*)(Ks + (16 * k4 + c16) * 136 + m * 64 + ks * 32 + g * 8);
          s[k4] = MFMA(a.v, qf[m][ks].v, s[k4]);
        }
      }
      float mx = -1e30f;
#pragma unroll
      for (int k4 = 0; k4 < 4; ++k4)
#pragma unroll
        for (int r = 0; r < 4; ++r) mx = fmaxf(mx, s[k4][r]);
      mx = fmaxf(mx, __shfl_xor(mx, 16));
      mx = fmaxf(mx, __shfl_xor(mx, 32));
      if (__any(mx - mrun[m] > 4.0f)) {
        const float mnew = fmaxf(mrun[m], mx);
        const float alpha = fexp(mrun[m] - mnew);
        mrun[m] = mnew;
        lsum[m] *= alpha;
#pragma unroll
        for (int v = 0; v < 8; ++v) { O[m][v][0] *= alpha; O[m][v][1] *= alpha; O[m][v][2] *= alpha; O[m][v][3] *= alpha; }
      }
      const float mneg = -mrun[m] * 1.4426950408889634f;
      float ps = 0.f;
#pragma unroll
      for (int k4 = 0; k4 < 4; ++k4)
#pragma unroll
        for (int r = 0; r < 4; ++r) { s[k4][r] = __builtin_amdgcn_exp2f(fmaf(s[k4][r], 1.4426950408889634f, mneg)); ps += s[k4][r]; }
      lsum[m] += ps;
#pragma unroll
      for (int sp = 0; sp < 2; ++sp) {
        pf[m][sp].w[0] = pack2(s[2 * sp][0], s[2 * sp][1]); pf[m][sp].w[1] = pack2(s[2 * sp][2], s[2 * sp][3]);
        pf[m][sp].w[2] = pack2(s[2 * sp + 1][0], s[2 * sp + 1][1]); pf[m][sp].w[3] = pack2(s[2 * sp + 1][2], s[2 * sp + 1][3]);
      }
    }
#pragma unroll
    for (int v = 0; v < 8; ++v)
#pragma unroll
      for (int sp = 0; sp < 2; ++sp) {
        Frag a;
        a.h[0] = *(const uint2*)(Vs + (16 * v + c16) * 72 + 32 * sp + 4 * g);
        a.h[1] = *(const uint2*)(Vs + (16 * v + c16) * 72 + 32 * sp + 16 + 4 * g);
        O[0][v] = MFMA(a.v, pf[0][sp].v, O[0][v]);
        O[1][v] = MFMA(a.v, pf[1][sp].v, O[1][v]);
      }
  }
  float l0 = lsum[0], l1 = lsum[1];
  l0 += __shfl_xor(l0, 16); l0 += __shfl_xor(l0, 32);
  l1 += __shfl_xor(l1, 16); l1 += __shfl_xor(l1, 32);
  const float i0 = 1.f / l0, i1 = lam / l1;
  float ss = 0.f;
#pragma unroll
  for (int v = 0; v < 8; ++v)
#pragma unroll
    for (int r = 0; r < 4; ++r) { float o = O[0][v][r] * i0 - O[1][v][r] * i1; O[0][v][r] = o; ss += o * o; }
  ss += __shfl_xor(ss, 16); ss += __shfl_xor(ss, 32);
  const float rinv = rsqrtf(ss * (1.f / 128.f) + EPSV) * (1.f - lam_init);
  u16* rp = proj + (size_t)qrow * LDP + h * 128;
#pragma unroll
  for (int v = 0; v < 8; ++v) {
    int vc = 16 * v + 4 * g;
    float4 sg = *(const float4*)(p.in[16] + l * 128 + vc);
    uint2 z = *(const uint2*)(rp + PZB + vc);
    float y0 = O[0][v][0] * rinv * sg.x * lo2f(z.x), y1 = O[0][v][1] * rinv * sg.y * hi2f(z.x);
    float y2 = O[0][v][2] * rinv * sg.z * lo2f(z.y), y3 = O[0][v][3] * rinv * sg.w * hi2f(z.y);
    if (!dry) *(uint2*)(rp + PQB + vc) = make_uint2(pack2(y0, y1), pack2(y2, y3));
  }
  __syncthreads();
}

__device__ __forceinline__ void f1_item(const Params& p, int item, char* lds) {
  const int tid = otid(), lane = tid & 63, wid = tid >> 6, wr = wid >> 2, wc = wid & 3, fr = lane & 15, fq = lane >> 4;
  char* ws = p.ws;
  const int jh = item & 1, gq = (item >> 1) & 3, mt = item >> 3;
  f32x4 acc[4][4];
  gemm_kloop<128>((const u16*)(ws + OFF_B1) + jh * 128 * 128, 128, (const u16*)(ws + OFF_PROJ) + (size_t)(mt * 256) * LDP + PUC + gq * 128, LDP, 128, acc, lds);
#pragma unroll
  for (int a = 0; a < 4; ++a)
#pragma unroll
    for (int b = 0; b < 4; ++b) {
      int tokl = wc * 64 + a * 16 + 4 * fq;
      int jj = wr * 64 + b * 16 + fr;
      uint2 pk = make_uint2(pack2(acc[a][b][0], acc[a][b][1]), pack2(acc[a][b][2], acc[a][b][3]));
      if (mt < 32) {
        *(uint2*)(ws + OFF_PTC + ((size_t)((mt * 4 + gq) * 128 + jj) * 512 + jh * 256 + tokl) * 2) = pk;
      } else {
        int rp = (mt - 32) * 256 + tokl; int bb = rp >> 11, t = rp & 2047;
        *(uint2*)(ws + OFF_PTL + ((size_t)((bb * 4 + gq) * 128 + jj) * 4096 + jh * 2048 + t) * 2) = pk;
      }
    }
}

struct F2Epi {
  char* ws; float scl; int rowbase_mul;
  bool lat;
  __device__ __forceinline__ void operator()(f32x4 (&acc)[2][2][4][2], const Unit& u, int wr, int wc, int fr, int fq, LAS unsigned char* lds) const {
    u16* proj = (u16*)(ws + OFF_PROJ);
#pragma unroll
    for (int ai = 0; ai < 2; ++ai)
#pragma unroll
      for (int mh = 0; mh < 2; ++mh) {
        uint2 zv[2][2][2];
#pragma unroll
        for (int mm = 0; mm < 2; ++mm)
#pragma unroll
          for (int bj = 0; bj < 2; ++bj)
#pragma unroll
            for (int n = 0; n < 2; ++n) {
              const int tp = u.x * 256 + ai * 128 + wr * 64 + (mh * 2 + mm) * 16 + fr;
              const int nn = u.y * 256 + bj * 128 + wc * 32 + n * 16 + 4 * fq;
              const int bb = nn >> 9, col = nn & 511;
              const u16* rp = proj + (size_t)(lat ? (NCTX + bb * 2048 + tp) : (bb * 256 + tp)) * LDP;
              zv[mm][bj][n] = *(const uint2*)(rp + PZC + col);
            }
#pragma unroll
        for (int mm = 0; mm < 2; ++mm)
#pragma unroll
          for (int bj = 0; bj < 2; ++bj)
#pragma unroll
            for (int n = 0; n < 2; ++n) {
              const int m = mh * 2 + mm;
              const int tp = u.x * 256 + ai * 128 + wr * 64 + m * 16 + fr;
              const int nn = u.y * 256 + bj * 128 + wc * 32 + n * 16 + 4 * fq;
              const int bb = nn >> 9, col = nn & 511;
              u16* rp = proj + (size_t)(lat ? (NCTX + bb * 2048 + tp) : (bb * 256 + tp)) * LDP;
              const uint2 z = zv[mm][bj][n];
              f32x4 a4 = acc[ai][bj][m][n];
              *(uint2*)(rp + PUC + col) = make_uint2(pack2(a4[0] * scl * lo2f(z.x), a4[1] * scl * hi2f(z.x)),
                                                     pack2(a4[2] * scl * lo2f(z.y), a4[3] * scl * hi2f(z.y)));
            }
      }
  }
};
__device__ __forceinline__ void f2c_item(const Params& p, int item, char* lds) {
  OneUnit S; S.u.a = p.ws + OFF_DC; S.u.b = p.ws + OFF_PTC + (size_t)item * 256 * 1024; S.u.x = 0; S.u.y = item; S.u.lda = 512; S.u.ldb = 512; S.u.nt = 8;
  F2Epi E; E.ws = p.ws; E.scl = 0.005524271728019903f; E.lat = false; E.rowbase_mul = 0;
  gemm_phase((LAS unsigned char*)lds, S, E);
}
struct F2HalfEpi {
  uint2* part;
  __device__ __forceinline__ void operator()(f32x4 (&acc)[2][2][4][2], const Unit& u, int wr, int wc, int fr, int fq, LAS unsigned char* lds) const {
    const int tid = wr * 256 + wc * 64 + fq * 16 + fr;
#pragma unroll
    for (int ai = 0; ai < 2; ++ai)
#pragma unroll
      for (int bj = 0; bj < 2; ++bj)
#pragma unroll
        for (int m = 0; m < 4; ++m)
#pragma unroll
          for (int n = 0; n < 2; ++n) {
            f32x4 a4 = acc[ai][bj][m][n];
            __hip_atomic_store((unsigned long long*)(part + (((ai * 2 + bj) * 4 + m) * 2 + n) * 512 + tid), (unsigned long long)pack2(a4[0], a4[1]) | ((unsigned long long)pack2(a4[2], a4[3]) << 32), __ATOMIC_RELAXED, __HIP_MEMORY_SCOPE_AGENT);
          }
  }
};
__device__ __forceinline__ void f2l_item(const Params& p, int l, int item, char* lds) {
  char* ws = p.ws;
  const int tile = item >> 1, half = item & 1, mt = tile >> 2, nt = tile & 3;
  uint2* pbase = (uint2*)(ws + OFF_F2P);
  {
    OneUnit S; S.u.a = ws + OFF_DL + ((size_t)mt * 256 * 4096 + half * 2048) * 2; S.u.b = ws + OFF_PTL + ((size_t)nt * 256 * 4096 + half * 2048) * 2;
    S.u.x = mt; S.u.y = nt; S.u.lda = 4096; S.u.ldb = 4096; S.u.nt = 32;
    F2HalfEpi E; E.part = pbase + (size_t)(tile * 2 + half) * (32 * 512);
    gemm_phase((LAS unsigned char*)lds, S, E);
  }
  const int t_ = otid();
  volatile int* flag = (volatile int*)(lds + LDS_TILE + 32);
  asm volatile("s_waitcnt vmcnt(0)" ::: "memory");
  __syncthreads();
  if (t_ == 0) {
    unsigned* tk = (unsigned*)(ws + OFF_CNT) + 72 + l * 32 + tile;
    const unsigned old = __hip_atomic_fetch_add(tk, 1u, __ATOMIC_RELAXED, __HIP_MEMORY_SCOPE_AGENT);
    const int last = (old == 1u) ? 1 : 0;
    if (last) { __builtin_amdgcn_fence(__ATOMIC_ACQUIRE, "agent"); asm volatile("s_waitcnt vmcnt(0)" ::: "memory"); }
    *flag = last;
  }
  __syncthreads();
  if (*flag) {
    const int lane = t_ & 63, wid = t_ >> 6, wr = wid >> 2, wc = wid & 3, fr = lane & 15, fq = lane >> 4;
    const uint2* p0 = pbase + (size_t)(tile * 2 + 0) * (32 * 512);
    const uint2* p1 = pbase + (size_t)(tile * 2 + 1) * (32 * 512);
    u16* proj = (u16*)(ws + OFF_PROJ);
    const float scl = 1.f / 512.f;
#pragma unroll
    for (int ai = 0; ai < 2; ++ai)
#pragma unroll
      for (int mh = 0; mh < 2; ++mh) {
        uint2 zv[2][2][2], av[2][2][2], bv2[2][2][2];
#pragma unroll
        for (int mm = 0; mm < 2; ++mm)
#pragma unroll
          for (int bj = 0; bj < 2; ++bj)
#pragma unroll
            for (int n = 0; n < 2; ++n) {
              const int m = mh * 2 + mm;
              const int tp = mt * 256 + ai * 128 + wr * 64 + m * 16 + fr;
              const int nn = nt * 256 + bj * 128 + wc * 32 + n * 16 + 4 * fq;
              const int bb = nn >> 9, col = nn & 511;
              const u16* rp = proj + (size_t)(NCTX + bb * 2048 + tp) * LDP;
              zv[mm][bj][n] = *(const uint2*)(rp + PZC + col);
              const int idx = (((ai * 2 + bj) * 4 + m) * 2 + n) * 512 + t_;
              av[mm][bj][n] = p0[idx]; bv2[mm][bj][n] = p1[idx];
            }
#pragma unroll
        for (int mm = 0; mm < 2; ++mm)
#pragma unroll
          for (int bj = 0; bj < 2; ++bj)
#pragma unroll
            for (int n = 0; n < 2; ++n) {
              const int m = mh * 2 + mm;
              const int tp = mt * 256 + ai * 128 + wr * 64 + m * 16 + fr;
              const int nn = nt * 256 + bj * 128 + wc * 32 + n * 16 + 4 * fq;
              const int bb = nn >> 9, col = nn & 511;
              u16* rp = proj + (size_t)(NCTX + bb * 2048 + tp) * LDP;
              const uint2 z = zv[mm][bj][n], a = av[mm][bj][n], c = bv2[mm][bj][n];
              const float y0 = (lo2f(a.x) + lo2f(c.x)) * scl * lo2f(z.x), y1 = (hi2f(a.x) + hi2f(c.x)) * scl * hi2f(z.x);
              const float y2 = (lo2f(a.y) + lo2f(c.y)) * scl * lo2f(z.y), y3 = (hi2f(a.y) + hi2f(c.y)) * scl * hi2f(z.y);
              *(uint2*)(rp + PUC + col) = make_uint2(pack2(y0, y1), pack2(y2, y3));
            }
      }
  }
  __syncthreads();
}

__device__ __forceinline__ bool xcd_tile(int bid, int& pm, int& pn) {
  const int x = bid & 7, j = bid >> 3;
  if (j >= 24) return false;
  pm = 6 * x + (j >> 2); pn = j & 3;
  return true;
}
struct P5Sched {
  char* ws; int x, j;
  __device__ __forceinline__ bool next(int i, Unit& u) const {
    if (j < 24) {
      if (i >= 5) return false;
      const int pm = 6 * x + (j >> 2), pn = j & 3;
      const int jj = (i < 4) ? (i >> 1) : 2;
      if (i == 0 || i == 2) {
        u.a = ws + OFF_H + (size_t)pm * 256 * 2048; u.b = ws + OFF_WIN + (size_t)(5632 + jj * 1024 + pn * 256) * 2048;
        u.lda = 1024; u.ldb = 1024; u.nt = 16; u.x = pm; u.y = pn | (jj << 8);
      } else {
        const int yc = (jj == 0) ? PQA : ((jj == 1) ? PQB : PUC);
        u.a = ws + OFF_PROJ + ((size_t)pm * 256 * LDP + yc) * 2; u.b = ws + OFF_WBR + ((size_t)jj * 1024 * 512 + (size_t)pn * 256 * 512) * 2;
        u.lda = LDP; u.ldb = 512; u.nt = 8; u.x = pm; u.y = pn | (jj << 8) | ((i == 4) ? 0x2000 : 0x1000);
      }
      return true;
    }
    if (i >= 3) return false;
    const int tj = 3 * (j - 24) + i;
    const int pm = 6 * x + (tj >> 2), pn = tj & 3;
    u.a = ws + OFF_H + (size_t)pm * 256 * 2048; u.b = ws + OFF_WIN + (size_t)(5632 + 2 * 1024 + pn * 256) * 2048;
    u.lda = 1024; u.ldb = 1024; u.nt = 16; u.x = pm; u.y = pn | (2 << 8) | 0x3000;
    return true;
  }
};
struct P5Epi {
  char* ws; u16* mg; unsigned* flags; bool skip;
  __device__ __forceinline__ void operator()(f32x4 (&acc)[2][2][4][2], const Unit& u, int wr, int wc, int fr, int fq, LAS unsigned char* lds) const {
    if (skip) return;
    { const int t_ = otid(); const int w_ = t_ >> 6; wr = w_ >> 2; wc = w_ & 3; fr = t_ & 15; fq = (t_ & 63) >> 4; }
    const int tid = wr * 256 + wc * 64 + fq * 16 + fr;
    const int type = (u.y >> 12) & 3, j = (u.y >> 8) & 3, pn = u.y & 0xff, pm = u.x;
    const int tile = pm * 4 + pn;
    uint2* gs = (uint2*)(ws + OFF_SEGU) + (size_t)tile * (32 * 512);
    u16* g2p = (u16*)(ws + OFF_PROJ) + (size_t)pm * 256 * LDP + PLF + pn * 256;
    if (type == 0) {
#pragma unroll
      for (int ai = 0; ai < 2; ++ai)
#pragma unroll
        for (int bj = 0; bj < 2; ++bj)
#pragma unroll
          for (int m = 0; m < 4; ++m)
#pragma unroll
            for (int n = 0; n < 2; ++n) {
              f32x4 a4 = acc[ai][bj][m][n];
              gs[(((ai * 2 + bj) * 4 + m) * 2 + n) * 512 + tid] = make_uint2(pack2(sigmf(a4[0]), sigmf(a4[1])), pack2(sigmf(a4[2]), sigmf(a4[3])));
            }
      return;
    }
    if (type == 3) {
#pragma unroll
      for (int ai = 0; ai < 2; ++ai)
#pragma unroll
        for (int bj = 0; bj < 2; ++bj)
#pragma unroll
          for (int m = 0; m < 4; ++m)
#pragma unroll
            for (int n = 0; n < 2; ++n) {
              f32x4 a4 = acc[ai][bj][m][n];
              const int row = ai * 128 + wr * 64 + m * 16 + fr, col = bj * 128 + wc * 32 + n * 16 + 4 * fq;
              const unsigned long long v = (unsigned long long)pack2(sigmf(a4[0]), sigmf(a4[1])) | ((unsigned long long)pack2(sigmf(a4[2]), sigmf(a4[3])) << 32);
              __hip_atomic_store((unsigned long long*)(g2p + (size_t)row * LDP + col), v, __ATOMIC_RELAXED, __HIP_MEMORY_SCOPE_AGENT);
            }
      asm volatile("s_waitcnt vmcnt(0)" ::: "memory");
      if ((fq * 16 + fr) == 0) __hip_atomic_fetch_add(flags + tile, 1u, __ATOMIC_RELAXED, __HIP_MEMORY_SCOPE_AGENT);
      return;
    }
    if (type == 2) {
      if (tid == 0) {
        unsigned sp = 0;
        while (__hip_atomic_load(flags + tile, __ATOMIC_RELAXED, __HIP_MEMORY_SCOPE_AGENT) < 8u) { __builtin_amdgcn_s_sleep(2); if (++sp > (1u << 22)) break; }
        __builtin_amdgcn_fence(__ATOMIC_ACQUIRE, "agent");
        asm volatile("s_waitcnt vmcnt(0)" ::: "memory");
      }
      asm volatile("" ::: "memory");
      __builtin_amdgcn_s_barrier();
      asm volatile("" ::: "memory");
    }
#pragma unroll
    for (int ai = 0; ai < 2; ++ai)
#pragma unroll
      for (int mh = 0; mh < 2; ++mh) {
        uint2 gv[2][2][2], pv[2][2][2];
#pragma unroll
        for (int mm = 0; mm < 2; ++mm)
#pragma unroll
          for (int bj = 0; bj < 2; ++bj)
#pragma unroll
            for (int n = 0; n < 2; ++n) {
              const int m = mh * 2 + mm;
              const int rl = ai * 128 + wr * 64 + m * 16 + fr, cl = bj * 128 + wc * 32 + n * 16 + 4 * fq;
              const int row = pm * 256 + rl, col = pn * 256 + cl;
              const uint2* gptr = (type == 2) ? (const uint2*)(g2p + (size_t)rl * LDP + cl) : (const uint2*)(gs + (((ai * 2 + bj) * 4 + m) * 2 + n) * 512 + tid);
              gv[mm][bj][n] = *gptr;
              pv[mm][bj][n] = (j > 0) ? *(const uint2*)(mg + (size_t)row * 1024 + col) : make_uint2(0u, 0u);
            }
#pragma unroll
        for (int mm = 0; mm < 2; ++mm)
#pragma unroll
          for (int bj = 0; bj < 2; ++bj)
#pragma unroll
            for (int n = 0; n < 2; ++n) {
              const int m = mh * 2 + mm;
              const int row = pm * 256 + ai * 128 + wr * 64 + m * 16 + fr;
              const int col = pn * 256 + bj * 128 + wc * 32 + n * 16 + 4 * fq;
              f32x4 a4 = acc[ai][bj][m][n];
              const uint2 g2 = gv[mm][bj][n], p2 = pv[mm][bj][n];
              float t0 = lo2f(g2.x) * a4[0] + lo2f(p2.x), t1 = hi2f(g2.x) * a4[1] + hi2f(p2.x);
              float t2 = lo2f(g2.y) * a4[2] + lo2f(p2.y), t3 = hi2f(g2.y) * a4[3] + hi2f(p2.y);
              *(uint2*)(mg + (size_t)row * 1024 + col) = make_uint2(pack2(t0, t1), pack2(t2, t3));
            }
      }
  }
};
__device__ __forceinline__ void p5_phase(const Params& p, int l, char* lds, bool skip = false) {
  P5Sched S; S.ws = p.ws; S.x = blockIdx.x & 7; S.j = blockIdx.x >> 3;
  if (S.j >= 32) return;
  P5Epi E; E.ws = p.ws; E.mg = (u16*)(p.ws + OFF_MRG); E.flags = (unsigned*)(p.ws + OFF_CNT) + 136 + l * 192; E.skip = skip;
  gemm_phase((LAS unsigned char*)lds, S, E);
}

struct P6Epi {
  const float* xp0; const float* xs0; float* outp; const float* modp; int l;
  __device__ __forceinline__ void operator()(f32x4 (&acc)[2][2][4][2], const Unit& u, int wr, int wc, int fr, int fq, LAS unsigned char* lds) const {
    const int m0 = u.x * 256;
    const int ci = (m0 < NCTX) ? 0 : 1 + ((m0 - NCTX) >> 11);
    const float* xbase = (l == 0) ? ((m0 < NCTX) ? xp0 : xs0 - (size_t)NCTX * 1024) : outp;
    float4 gt[2][2];
#pragma unroll
    for (int bj = 0; bj < 2; ++bj)
#pragma unroll
      for (int n = 0; n < 2; ++n) gt[bj][n] = *(const float4*)(modp + (l * 3 + ci) * 3072 + 2048 + u.y * 256 + bj * 128 + wc * 32 + n * 16 + 4 * fq);
#pragma unroll
    for (int ai = 0; ai < 2; ++ai)
#pragma unroll
      for (int mh = 0; mh < 2; ++mh) {
        float4 xv[2][2][2];
#pragma unroll
        for (int mm = 0; mm < 2; ++mm)
#pragma unroll
          for (int bj = 0; bj < 2; ++bj)
#pragma unroll
            for (int n = 0; n < 2; ++n) {
              const int r = m0 + ai * 128 + wr * 64 + (mh * 2 + mm) * 16 + fr;
              const int col = u.y * 256 + bj * 128 + wc * 32 + n * 16 + 4 * fq;
              xv[mm][bj][n] = *(const float4*)(xbase + (size_t)r * 1024 + col);
            }
#pragma unroll
        for (int mm = 0; mm < 2; ++mm)
#pragma unroll
          for (int bj = 0; bj < 2; ++bj)
#pragma unroll
            for (int n = 0; n < 2; ++n) {
              const int m = mh * 2 + mm;
              const int r = m0 + ai * 128 + wr * 64 + m * 16 + fr;
              const int col = u.y * 256 + bj * 128 + wc * 32 + n * 16 + 4 * fq;
              f32x4 a4 = acc[ai][bj][m][n];
              const float4 x4 = xv[mm][bj][n], g4 = gt[bj][n];
              *(float4*)(outp + (size_t)r * 1024 + col) = make_float4(x4.x + g4.x * a4[0], x4.y + g4.y * a4[1], x4.z + g4.z * a4[2], x4.w + g4.w * a4[3]);
            }
      }
  }
};
__device__ __forceinline__ void p6_phase(const Params& p, int l, char* lds) {
  char* ws = p.ws;
  int pm, pn;
  if (!xcd_tile(blockIdx.x, pm, pn)) return;
  OneUnit S; S.u.a = ws + OFF_MRG + (size_t)pm * 256 * 2048; S.u.b = ws + OFF_WO + (size_t)pn * 256 * 2048; S.u.x = pm; S.u.y = pn;
  S.u.lda = 1024; S.u.ldb = 1024; S.u.nt = 16; S.reps = ((DUP_MASK & 512) && l == 0) ? 5 : 1;
  P6Epi E; E.xp0 = p.in[0]; E.xs0 = p.in[1]; E.outp = p.out; E.modp = (const float*)(ws + OFF_MOD); E.l = l;
  gemm_phase((LAS unsigned char*)lds, S, E);
}

#define XB_TMO      128
#define XB_XCNT(j)  (256  + 64 * (j))
#define XB_XSUB(j)  (1280 + 64 * (j))
#define XB_XGEN(j)  (2304 + 64 * (j))
#define XB_TOP      3328
#define XB_TOPGEN   3392
#define XCD_BAR_WORDS 3456
#define XB_SPIN_CAP (1u << 18)
struct XcdBarrier { unsigned* bar; unsigned x; volatile LAS unsigned* st; };
__device__ __forceinline__ unsigned xb_ld(unsigned* p) { return __hip_atomic_load(p, __ATOMIC_RELAXED, __HIP_MEMORY_SCOPE_AGENT); }
__device__ __forceinline__ unsigned xb_add(unsigned* p, unsigned v) { return __hip_atomic_fetch_add(p, v, __ATOMIC_RELAXED, __HIP_MEMORY_SCOPE_AGENT); }
__device__ __forceinline__ unsigned xb_xcc_id() { return (unsigned)__builtin_amdgcn_s_getreg((3 << 11) | 20) & 0xFu; }
#define XB_SPIN(cond, bar) do { unsigned _sp = 0; while (cond) { __builtin_amdgcn_s_sleep(1); \
    if ((++_sp & 255u) == 0u) { if (xb_ld(&(bar)[XB_TMO])) break; if (_sp > XB_SPIN_CAP) { atomicAdd(&(bar)[XB_TMO], 1u); break; } } } } while (0)
__device__ __forceinline__ XcdBarrier xcd_barrier_post(unsigned* bar, volatile LAS unsigned* st) {
  XcdBarrier b; b.bar = bar; b.x = xb_xcc_id(); b.st = st;
  if (threadIdx.x == 0) (void)xb_add(&bar[XB_XCNT(b.x)], 1u);
  return b;
}
__device__ __forceinline__ void xcd_barrier_complete(unsigned* bar, unsigned x, unsigned& nloc, unsigned& nx) {
  const unsigned G = gridDim.x * gridDim.y * gridDim.z;
  unsigned sum, cnt, mine, sp = 0u;
  for (;;) {
    sum = 0u; cnt = 0u; mine = 0u;
#pragma unroll
    for (unsigned j = 0; j < 16; ++j) { const unsigned c = xb_ld(&bar[XB_XCNT(j)]); sum += c; cnt += (c > 0u) ? 1u : 0u; mine = (j == x) ? c : mine; }
    if (sum == G) break;
    __builtin_amdgcn_s_sleep(1);
    if ((++sp & 255u) == 0u) { if (xb_ld(&bar[XB_TMO])) break; if (sp > XB_SPIN_CAP) { atomicAdd(&bar[XB_TMO], 1u); break; } }
  }
  nloc = mine > 0u ? mine : 1u; nx = cnt > 0u ? cnt : 1u;
}
__device__ __forceinline__ void xcd_barrier(const XcdBarrier& b) {
  asm volatile("s_waitcnt vmcnt(0)" ::: "memory");
  __syncthreads();
  if (threadIdx.x == 0) {
    unsigned* bar = b.bar;
    __builtin_amdgcn_s_waitcnt(0);
    unsigned nloc = b.st[0], nx = b.st[1];
    if (nloc == 0u) { xcd_barrier_complete(bar, b.x, nloc, nx); b.st[0] = nloc; b.st[1] = nx; }
    const unsigned old = xb_add(&bar[XB_XSUB(b.x)], 1u);
    const unsigned gen = old / nloc;
    if (old + 1u == (gen + 1u) * nloc) {
      __builtin_amdgcn_fence(__ATOMIC_RELEASE, "agent");
      asm volatile("s_waitcnt vmcnt(0)" ::: "memory");
      const unsigned og = xb_add(&bar[XB_TOP], 1u);
      const unsigned tg = og / nx;
      if (og + 1u == (tg + 1u) * nx) xb_add(&bar[XB_TOPGEN], 1u);
      else XB_SPIN(xb_ld(&bar[XB_TOPGEN]) == tg, bar);
      __builtin_amdgcn_fence(__ATOMIC_ACQUIRE, "agent");
      xb_add(&bar[XB_XGEN(b.x)], 1u);
      asm volatile("s_waitcnt vmcnt(0)" ::: "memory");
    } else {
      XB_SPIN(xb_ld(&bar[XB_XGEN(b.x)]) == gen, bar);
      __builtin_amdgcn_fence(__ATOMIC_ACQUIRE, "agent");
      asm volatile("s_waitcnt vmcnt(0)" ::: "memory");
    }
  }
  __syncthreads();
}

#define PARGS const float* a0, const float* a1, const float* a2, const float* a3, const float* a4, const float* a5, const float* a6, \
  const float* a7, const float* a8, const float* a9, const float* a10, const float* a11, const float* a12, const float* a13, \
  const float* a14, const float* a15, const float* a16, const float* a17, const float* a18, const float* a19, const float* a20, \
  float* aout, char* aws
#define PFILL Params p; p.in[0]=a0;p.in[1]=a1;p.in[2]=a2;p.in[3]=a3;p.in[4]=a4;p.in[5]=a5;p.in[6]=a6;p.in[7]=a7;p.in[8]=a8;p.in[9]=a9;p.in[10]=a10; \
  p.in[11]=a11;p.in[12]=a12;p.in[13]=a13;p.in[14]=a14;p.in[15]=a15;p.in[16]=a16;p.in[17]=a17;p.in[18]=a18;p.in[19]=a19;p.in[20]=a20;p.out=aout;p.ws=aws;
__global__ void __launch_bounds__(512) fwd_megakernel(PARGS) {
  PFILL
  extern __shared__ __attribute__((aligned(16))) char lds[];
  volatile int& s_item = *(volatile int*)(lds + LDS_TILE);
  cg::grid_group grid = cg::this_grid();
  const int bid = blockIdx.x, G = gridDim.x, tid = threadIdx.x;
  int* cnt = (int*)(p.ws + OFF_CNT);
  volatile LAS unsigned* bst = (volatile LAS unsigned*)(LAS unsigned char*)(lds + LDS_TILE + 16);
  if (tid < 2) bst[tid] = 0u;
  __syncthreads();
  const XcdBarrier xb = xcd_barrier_post((unsigned*)(p.ws + OFF_BAR), bst);
  for (int rep = 0; rep < ((DUP_MASK & 1) ? 2 : 1); ++rep) {
  {
    for (int it = bid; it < 384; it += G) p0_mod16(p, it, lds);
    float2* tab = (float2*)lds;
    for (int m = tid; m < 2048; m += 512) { float sn, cs; sincospif((float)m * (1.f / 1024.f), &sn, &cs); tab[m] = make_float2(cs, sn); }
    __syncthreads();
    for (int it = 224 + bid; it < 224 + 2048; it += G) p0_item(p, it, lds);
    __syncthreads();
    for (int it = 96 + bid; it < P0_ITEMS; it += G) { if (it >= 224 && it < 224 + 2048) continue; p0_item(p, it, lds); }
  }
  if (((const volatile float*)p.in[15])[0] > 1e30f) grid.sync();
  }
  for (int l = 0; l < 2; ++l) {
    {
      bool waited = (l != 0);
      for (int it = bid; it < P1_ITEMS; it += G) {
        if (!waited && it >= 2816) {
          if (tid == 0) {
            unsigned* mc = (unsigned*)(p.ws + OFF_CNT) + 6; unsigned sp = 0;
            while (__hip_atomic_load(mc, __ATOMIC_RELAXED, __HIP_MEMORY_SCOPE_AGENT) < 384u) { __builtin_amdgcn_s_sleep(2); if (++sp > (1u << 22)) break; }
            __builtin_amdgcn_fence(__ATOMIC_ACQUIRE, "agent");
            asm volatile("s_waitcnt vmcnt(0)" ::: "memory");
          }
          __syncthreads();
          waited = true;
        }
        p1_item(p, l, it, lds);
      }
      xcd_barrier(xb);
    }
    if (DUP_MASK & 1024) { const bool opq = (((const volatile float*)p.in[15])[0] < 1e30f); p2_phase(p, l, lds, opq); xcd_barrier(xb); }
    for (int rep = 0; rep < ((DUP_MASK & 4) ? 2 : 1); ++rep) {
    p2_phase(p, l, lds);
    xcd_barrier(xb);
    }
    for (;;) {
      __syncthreads();
      if (tid == 0) s_item = atomicAdd(&cnt[l * 2 + 0], 1);
      __syncthreads();
      int it = s_item;
      constexpr int D3 = (DUP_MASK & 16) ? 256 : 0;
      if (it >= D3 + 32 + 128 + 384 + 256) break;
      if (it >= 32 + 128 + 384 + 256) { hgrn_ctx_item(p, l, (it - 800) & 127, lds, true); continue; }
      if (it < 32) p2_left_item(p, l, 1024 + it, lds);
      else if (it < 160) hgrn_ctx_item(p, l, it - 32, lds);
      else if (it < 416) hgrn_lat1_item(p, l, it - 160, lds);
      else f1_item(p, it - 416, lds);
    }
    xcd_barrier(xb);
    for (;;) {
      __syncthreads();
      if (tid == 0) s_item = atomicAdd(&cnt[l * 2 + 1], 1);
      __syncthreads();
      int it = s_item;
      constexpr int D4a = (DUP_MASK & 32) ? 256 : 0, D4b = (DUP_MASK & 64) ? 256 : 0;
      if (it >= D4a + D4b + 640) break;
      if (it >= 640) { if (DUP_MASK & 32) attn_item(p, l, (it - 640) & 127, true, lds, true); else hgrn_lat2_item(p, l, (it - 640) & 127, lds, true); continue; }
      if (it < 128) attn_item(p, l, it, true, lds);
      else if (it < 192) f2l_item(p, l, it - 128, lds);
      else if (it < 320) hgrn_lat2_item(p, l, it - 192, lds);
      else if (it < 384) f2c_item(p, it - 320, lds);
      else attn_item(p, l, it - 384, false, lds);
    }
    xcd_barrier(xb);
    if (DUP_MASK & 2048) { const bool opq = (((const volatile float*)p.in[15])[0] < 1e30f); p5_phase(p, l, lds, opq); xcd_barrier(xb); }
    for (int rep = 0; rep < ((DUP_MASK & 8) ? 2 : 1); ++rep) {
    p5_phase(p, l, lds);
    xcd_barrier(xb);
    }
    for (int rep = 0; rep < (((DUP_MASK & 256) && l == 0) ? 5 : 1); ++rep) {
    p6_phase(p, l, lds);
    if (l == 0) xcd_barrier(xb);
    }
  }
}

extern "C" void kernel_launch(void* const* d_in, const int* in_sizes, int n_in,
                              void* d_out, int out_size, void* d_ws, size_t ws_size,
                              hipStream_t stream) {
  static int grid_blocks = 0;
  if (!grid_blocks) {
    int dev = 0, cus = 0;
    (void)hipGetDevice(&dev);
    (void)hipDeviceGetAttribute(&cus, hipDeviceAttributeMultiprocessorCount, dev);
    if (hipFuncSetAttribute((const void*)fwd_megakernel, hipFuncAttributeMaxDynamicSharedMemorySize, LDS_BYTES) != hipSuccess)
      fprintf(stderr, "hipFuncSetAttribute failed\n");
    grid_blocks = cus > 0 ? cus : 256;
    if (ws_size < WS_END) fprintf(stderr, "workspace too small: %zu < %zu\n", ws_size, (size_t)WS_END);
  }
  const void* ins[21];
  for (int i = 0; i < 21; ++i) ins[i] = d_in[i];
  void* outp = d_out; void* wsp = d_ws;
  void* args[23];
  for (int i = 0; i < 21; ++i) args[i] = (void*)&ins[i];
  args[21] = (void*)&outp; args[22] = (void*)&wsp;
  (void)hipMemsetAsync((char*)d_ws + OFF_CNT, 0, 4096 + 3456 * 4, stream);
  hipError_t e = hipLaunchCooperativeKernel((void*)fwd_megakernel, dim3(grid_blocks), dim3(512), args, LDS_BYTES, stream);
  if (e != hipSuccess) fprintf(stderr, "cooperative launch failed: %s (grid %d)\n", hipGetErrorString(e), grid_blocks);
}
```

```cpp
#include <hip/hip_runtime.h>
#include <hip/hip_cooperative_groups.h>
#include <stdint.h>
#include <cstdio>
namespace cg = cooperative_groups;

typedef unsigned short u16;
using bf16x8 = __attribute__((ext_vector_type(8))) short;
using f32x4 = __attribute__((ext_vector_type(4))) float;
#define MFMA(a, b, c) __builtin_amdgcn_mfma_f32_16x16x32_bf16(a, b, c, 0, 0, 0)

constexpr int NTOK = 12288;
constexpr int NCTX = 8192;
constexpr int LDP = 5120;
constexpr int PQA = 0, PLF = 512, PIA = 1536, PZA = 2048, PQB = 2560, PKB = 3072, PZB = 3584, PUC = 4096, PZC = 4608;
constexpr float EPSV = 1e-6f;
constexpr size_t OCK = 12582912, OCV = 20971520, OST = 29360128;

constexpr size_t OFF_WIN = 0;
constexpr size_t OFF_WBR = OFF_WIN + 8704ull * 1024 * 2;
constexpr size_t OFF_WO = OFF_WBR + 3ull * 1024 * 512 * 2;
constexpr size_t OFF_H = OFF_WO + 1024ull * 1024 * 2;
constexpr size_t OFF_PROJ = OFF_H + 12288ull * 1024 * 2;
constexpr size_t OFF_R1 = OFF_PROJ + 12288ull * LDP * 2;
constexpr size_t OFF_PTC = OFF_R1;
constexpr size_t OFF_PTL = OFF_R1 + 16384ull * 512 * 2;
constexpr size_t OFF_MRG = OFF_R1;
constexpr size_t OFF_SEGU = OFF_R1 + 25165824ull;
constexpr size_t OFF_SEGD = OFF_SEGU + 256ull * 16384 * 4;
constexpr size_t OFF_VTC = OFF_SEGD + 256ull * 128 * 4;
constexpr size_t OFF_VTL = OFF_VTC + 32ull * 4 * 128 * 256 * 2;
constexpr size_t SZ_VTL = 2ull * 4 * 128 * 2304 * 2;
constexpr size_t OFF_KC = OFF_VTL + 2 * SZ_VTL;
constexpr size_t OFF_DL = OFF_KC + 2ull * 2 * 256 * 512 * 2;
constexpr size_t OFF_DC = OFF_DL + 2048ull * 4096 * 2;
constexpr size_t OFF_B1 = OFF_DC + 256ull * 512 * 2;
constexpr size_t OFF_ROPE = OFF_B1 + 256ull * 128 * 2;
constexpr size_t OFF_MOD = OFF_ROPE + 2048ull * 32 * 8;
constexpr size_t OFF_CNT = OFF_MOD + 2ull * 3 * 3072 * 4;
constexpr size_t OFF_BAR = OFF_CNT + 4096;
constexpr size_t OFF_F2P = OFF_BAR + 3456 * 4 + 192;
constexpr size_t WS_END = OFF_F2P + 32ull * 2 * 32 * 512 * 8;

constexpr int LDS_TILE = 131072 + 8192;
#define DUP_MASK 0
constexpr int LDS_BYTES = LDS_TILE + 64;

struct Params {
  const float* in[21];
  float* out;
  char* ws;
};

typedef __bf16 bf16x2_t __attribute__((ext_vector_type(2)));
typedef float f32x2_t __attribute__((ext_vector_type(2)));
__device__ __forceinline__ uint32_t pack2(float a, float b) {
  f32x2_t v = {a, b};
  bf16x2_t r = __builtin_convertvector(v, bf16x2_t);
  return __builtin_bit_cast(uint32_t, r);
}
__device__ __forceinline__ u16 f2bf(float f) { return (u16)(pack2(f, 0.f) & 0xffffu); }
__device__ __forceinline__ float bf2f(u16 h) { return __uint_as_float(((uint32_t)h) << 16); }
__device__ __forceinline__ float lo2f(uint32_t u) { return __uint_as_float(u << 16); }
__device__ __forceinline__ float hi2f(uint32_t u) { return __uint_as_float(u & 0xffff0000u); }
__device__ __forceinline__ float fexp(float x) { return __builtin_amdgcn_exp2f(x * 1.4426950408889634f); }
__device__ __forceinline__ float frcp(float x) { return __builtin_amdgcn_rcpf(x); }
__device__ __forceinline__ float flog(float x) { return __builtin_amdgcn_logf(x) * 0.6931471805599453f; }
__device__ __forceinline__ float siluf(float x) { return x * frcp(1.f + fexp(-x)); }
__device__ __forceinline__ float sigmf(float x) { return frcp(1.f + fexp(-x)); }
__device__ __forceinline__ float logf_gate(float x, float lb) {
  float xc = fmaxf(x, -80.f);
  float e = fexp(-xc);
  float omf = (1.f - lb) * e * frcp(1.f + e);
  float lf = flog(1.f - omf);
  lf = (lb == 0.f && x < -15.f) ? x : lf;
  return lf;
}
__device__ __forceinline__ float neg_expm1(float lf) {
  return 1.f - fexp(lf);
}
__device__ __forceinline__ int otid() { int t = threadIdx.x; asm volatile("" : "+v"(t)); return t; }

union Frag {
  bf16x8 v;
  uint4 q;
  uint2 h[2];
  uint32_t w[4];
};

__device__ __forceinline__ int lds_byte(int r, int c) {
  int st = (r >> 4) * 2 + (c >> 5), rr = r & 15, cc = c & 31, ob = rr * 64 + cc * 2;
  return st * 1024 + (ob ^ (((ob >> 9) & 1) << 5));
}

template <int TM>
__device__ __forceinline__ void gemm_kloop(const u16* __restrict__ X, int ldx, const u16* __restrict__ Y, int ldy,
                                           int K, f32x4 (&acc)[4][TM / 32], char* lds) {
  constexpr int NX = TM / 64;
  constexpr int XT = TM / 32;
  constexpr int STAGE = TM * 128 + 32768;
  const int tid = otid(), lane = tid & 63, wid = tid >> 6, wr = wid >> 2, wc = wid & 3, fr = lane & 15, fq = lane >> 4;
#pragma unroll
  for (int a = 0; a < 4; ++a)
#pragma unroll
    for (int b = 0; b < XT; ++b) acc[a][b] = f32x4{0.f, 0.f, 0.f, 0.f};
  uint4 xr[NX], yr[4];
  const int nk = K >> 6;
  const int lrow = tid >> 3, lc8 = (tid & 7) * 8;
  const u16* xg = X + (size_t)lrow * ldx + lc8;
  const u16* yg = Y + (size_t)lrow * ldy + lc8;
  const int loff = lds_byte(lrow, lc8);
#pragma unroll
  for (int i = 0; i < NX; ++i) xr[i] = *(const uint4*)(xg + (size_t)(64 * i) * ldx);
#pragma unroll
  for (int i = 0; i < 4; ++i) yr[i] = *(const uint4*)(yg + (size_t)(64 * i) * ldy);
#pragma unroll
  for (int i = 0; i < NX; ++i) *(uint4*)(lds + loff + 8192 * i) = xr[i];
#pragma unroll
  for (int i = 0; i < 4; ++i) *(uint4*)(lds + TM * 128 + loff + 8192 * i) = yr[i];
  __syncthreads();
  for (int kt = 0; kt < nk; ++kt) {
    char* cur = lds + (kt & 1) * STAGE;
    char* nxt = lds + ((kt + 1) & 1) * STAGE;
    const bool more = (kt + 1 < nk);
    if (more) {
#pragma unroll
      for (int i = 0; i < NX; ++i) xr[i] = *(const uint4*)(xg + (size_t)(64 * i) * ldx + (kt + 1) * 64);
#pragma unroll
      for (int i = 0; i < 4; ++i) yr[i] = *(const uint4*)(yg + (size_t)(64 * i) * ldy + (kt + 1) * 64);
    }
#pragma unroll
    for (int ks = 0; ks < 2; ++ks) {
      Frag yf[4], xf[XT];
#pragma unroll
      for (int a = 0; a < 4; ++a) yf[a].q = *(const uint4*)(cur + TM * 128 + lds_byte(wc * 64 + a * 16 + fr, ks * 32 + fq * 8));
#pragma unroll
      for (int b = 0; b < XT; ++b) xf[b].q = *(const uint4*)(cur + lds_byte(wr * (TM / 2) + b * 16 + fr, ks * 32 + fq * 8));
#pragma unroll
      for (int a = 0; a < 4; ++a)
#pragma unroll
        for (int b = 0; b < XT; ++b) acc[a][b] = MFMA(yf[a].v, xf[b].v, acc[a][b]);
    }
    if (more) {
#pragma unroll
      for (int i = 0; i < NX; ++i) *(uint4*)(nxt + loff + 8192 * i) = xr[i];
#pragma unroll
      for (int i = 0; i < 4; ++i) *(uint4*)(nxt + TM * 128 + loff + 8192 * i) = yr[i];
    }
    __syncthreads();
  }
}

#define LAS __attribute__((address_space(3)))
constexpr int HTB = 128 * 64 * 2;
constexpr int G8_STAGE_BYTES = 8 * HTB;
__device__ __forceinline__ void stage_rc(int b, int& R, int& C) {
  const int st = b / 1024, sb = b % 1024, swz = sb ^ (((sb >> 9) & 1) << 5);
  R = (st >> 1) * 16 + swz / 64; C = (st & 1) * 32 + (swz % 64) / 2;
}
struct Unit { const char* a; const char* b; int x; int y; int lda; int ldb; int nt; int perm = 0; };
struct OneUnit {
  Unit u; int reps = 1;
  __device__ __forceinline__ bool next(int i, Unit& o) const { if (i >= reps) return false; o = u; return true; }
};
template <class Epi, class Sched>
__device__ __forceinline__ void gemm_phase(LAS unsigned char* lds, const Sched& S, const Epi& E) {
  const int tid = otid(), wid = __builtin_amdgcn_readfirstlane(tid >> 6), lane = tid & 63, wr = wid >> 2, wc = wid & 3, fr = lane & 15, fq = lane >> 4;
  int sR[2], sC[2];
#pragma unroll
  for (int i = 0; i < 2; ++i) stage_rc(tid * 16 + i * 8192, sR[i], sC[i]);
  int sRp[2];
#pragma unroll
  for (int i = 0; i < 2; ++i) { const int rho = sR[i] & 31, n_ = rho >> 4, i_ = rho & 15; sRp[i] = (sR[i] & ~31) + 8 * (i_ >> 2) + 4 * n_ + (i_ & 3); }
  const size_t kstep = 128;
  const unsigned ldsw = (unsigned)wid * 1024u;
  const int aoff = lds_byte(wr * 64 + fr, fq * 8), boff = lds_byte(wc * 32 + fr, fq * 8);
#define G8_SA(b, h) (((b) * 2 + (h)) * HTB)
#define G8_SB(b, h) ((4 + (b) * 2 + (h)) * HTB)
#define G8_STAGE(bufoff, gbase, voff) do { _Pragma("unroll") for (int _i = 0; _i < 2; ++_i) \
    __builtin_amdgcn_global_load_lds((const unsigned*)((const char*)(gbase) + (voff)[_i]), (LAS unsigned*)(lds + (bufoff) + ldsw + _i * 8192), 16, 0, 0); } while (0)
#define G8_LDA(dst, b, h) do { _Pragma("unroll") for (int m = 0; m < 4; ++m) _Pragma("unroll") for (int k = 0; k < 2; ++k) dst[m][k] = *(const LAS bf16x8*)(lds + G8_SA(b, h) + aoff + m * 2048 + k * 1024); } while (0)
#define G8_LDB(dst, b, h) do { _Pragma("unroll") for (int n = 0; n < 2; ++n) _Pragma("unroll") for (int k = 0; k < 2; ++k) dst[n][k] = *(const LAS bf16x8*)(lds + G8_SB(b, h) + boff + n * 2048 + k * 1024); } while (0)
#define G8_MMA(ai, bj, At, Bt) do { __builtin_amdgcn_s_setprio(1); _Pragma("unroll") for (int m = 0; m < 4; ++m) _Pragma("unroll") for (int n = 0; n < 2; ++n) _Pragma("unroll") for (int k = 0; k < 2; ++k) \
    acc[ai][bj][m][n] = __builtin_amdgcn_mfma_f32_16x16x32_bf16(Bt[n][k], At[m][k], acc[ai][bj][m][n], 0, 0, 0); __builtin_amdgcn_s_setprio(0); } while (0)
#define G8_WAIT_V(n) asm volatile("s_waitcnt vmcnt(" #n ")" ::: "memory")
#define G8_WAIT_L(n) asm volatile("s_waitcnt lgkmcnt(" #n ")" ::: "memory")
#define G8_BAR __builtin_amdgcn_s_barrier()
#define G8_SCHED __builtin_amdgcn_sched_barrier(0)
  Unit cur, nxt; int ui = 0;
  if (!S.next(0, cur)) return;
  f32x4 acc[2][2][4][2];
#pragma unroll
  for (int a = 0; a < 2; ++a)
#pragma unroll
    for (int b = 0; b < 2; ++b)
#pragma unroll
      for (int m = 0; m < 4; ++m)
#pragma unroll
        for (int n = 0; n < 2; ++n) acc[a][b][m][n] = f32x4{0.f, 0.f, 0.f, 0.f};
  bf16x8 At[4][2], B0[2][2], B1[2][2];
  const char* cA = cur.a; const char* cB = cur.b;
  unsigned voffA[2], voffB[2];
#pragma unroll
  for (int i = 0; i < 2; ++i) { voffA[i] = (unsigned)(sR[i] * cur.lda + sC[i]) * 2u; voffB[i] = (unsigned)((cur.perm ? sRp[i] : sR[i]) * cur.ldb + sC[i]) * 2u; }
  size_t hstepA = (size_t)128 * cur.lda * 2, hstepB = (size_t)128 * cur.ldb * 2;
  G8_STAGE(G8_SB(0, 0), cB, voffB); G8_STAGE(G8_SA(0, 0), cA, voffA); G8_STAGE(G8_SB(0, 1), cB + hstepB, voffB); G8_STAGE(G8_SA(0, 1), cA + hstepA, voffA);
  if (wr == 1) G8_BAR;
  G8_WAIT_V(4); G8_BAR;
  G8_STAGE(G8_SB(1, 0), cB + kstep, voffB); G8_STAGE(G8_SA(1, 0), cA + kstep, voffA); G8_STAGE(G8_SB(1, 1), cB + hstepB + kstep, voffB);
  G8_WAIT_V(6); G8_BAR;
  for (;;) {
    const bool has_next = S.next(ui + 1, nxt);
    if (!has_next) nxt = cur;
    const char* nA = nxt.a; const char* nB = nxt.b;
    unsigned voffAn[2], voffBn[2];
#pragma unroll
    for (int i = 0; i < 2; ++i) { voffAn[i] = (unsigned)(sR[i] * nxt.lda + sC[i]) * 2u; voffBn[i] = (unsigned)((nxt.perm ? sRp[i] : sR[i]) * nxt.ldb + sC[i]) * 2u; }
    const size_t hstepAn = (size_t)128 * nxt.lda * 2, hstepBn = (size_t)128 * nxt.ldb * 2;
    const int nt = cur.nt;
    for (int t = 0; t < nt; t += 2) {
      const bool last = (t == nt - 2);
      const char* a1 = cA + (size_t)(t + 1) * kstep;
      const char* a2 = last ? nA : cA + (size_t)(t + 2) * kstep; const char* b2 = last ? nB : cB + (size_t)(t + 2) * kstep;
      const char* a3 = a2 + kstep; const char* b3 = b2 + kstep;
      unsigned vA2[2], vB2[2];
#pragma unroll
      for (int i = 0; i < 2; ++i) { vA2[i] = last ? voffAn[i] : voffA[i]; vB2[i] = last ? voffBn[i] : voffB[i]; }
      const size_t hA2 = last ? hstepAn : hstepA, hB2 = last ? hstepBn : hstepB;
      G8_LDB(B0, 0, 0); G8_SCHED; G8_LDA(At, 0, 0); G8_STAGE(G8_SA(1, 1), a1 + hstepA, voffA);
      G8_WAIT_L(8); G8_BAR; G8_WAIT_L(0); G8_MMA(0, 0, At, B0); G8_BAR; G8_SCHED;
      G8_LDB(B1, 0, 1); G8_STAGE(G8_SB(0, 0), b2, vB2);
      G8_BAR; G8_WAIT_L(0); G8_MMA(0, 1, At, B1); G8_BAR;
      G8_LDA(At, 0, 1); G8_STAGE(G8_SA(0, 0), a2, vA2);
      G8_BAR; G8_WAIT_L(0); G8_MMA(1, 0, At, B0); G8_BAR; G8_SCHED;
      G8_STAGE(G8_SB(0, 1), b2 + hB2, vB2);
      G8_WAIT_V(6); G8_BAR; G8_MMA(1, 1, At, B1); G8_BAR;
      G8_LDB(B0, 1, 0); G8_SCHED; G8_LDA(At, 1, 0); G8_STAGE(G8_SA(0, 1), a2 + hA2, vA2);
      G8_WAIT_L(8); G8_BAR; G8_WAIT_L(0); G8_MMA(0, 0, At, B0); G8_BAR; G8_SCHED;
      G8_LDB(B1, 1, 1); G8_STAGE(G8_SB(1, 0), b3, vB2);
      G8_BAR; G8_WAIT_L(0); G8_MMA(0, 1, At, B1); G8_BAR;
      G8_LDA(At, 1, 1); G8_STAGE(G8_SA(1, 0), a3, vA2);
      G8_BAR; G8_WAIT_L(0); G8_MMA(1, 0, At, B0); G8_BAR; G8_SCHED;
      G8_STAGE(G8_SB(1, 1), b3 + hB2, vB2);
      G8_WAIT_V(6); G8_BAR; G8_MMA(1, 1, At, B1); G8_BAR;
    }
    E(acc, cur, wr, wc, fr, fq, lds);
    if (!has_next) break;
#pragma unroll
    for (int a = 0; a < 2; ++a)
#pragma unroll
      for (int b = 0; b < 2; ++b)
#pragma unroll
        for (int m = 0; m < 4; ++m)
#pragma unroll
          for (int n = 0; n < 2; ++n) acc[a][b][m][n] = f32x4{0.f, 0.f, 0.f, 0.f};
    cur = nxt; cA = nA; cB = nB; ++ui;
#pragma unroll
    for (int i = 0; i < 2; ++i) { voffA[i] = voffAn[i]; voffB[i] = voffBn[i]; }
    hstepA = hstepAn; hstepB = hstepBn;
  }
  G8_WAIT_V(0);
  if (wr == 0) G8_BAR;
  G8_BAR;
}

__device__ __forceinline__ void p0_mod16(const Params& p, int item, char* lds) {
  const int tid = otid();
  float* sc = (float*)lds;
  float* red = sc + 3072;
  const int l = item / 192, cgp = item % 192;
  const float* cctx = p.in[6]; const float* cc2 = p.in[2];
  for (int i = tid; i < 3072; i += 512) {
    int j = i >> 10, k = i & 1023;
    float c = (j == 0) ? cctx[k] : cc2[(j > 0 ? j - 1 : 0) * 1024 + k];
    sc[i] = c / (1.f + expf(-c));
  }
  __syncthreads();
  const int col = tid & 15, kg = tid >> 4;
  const float* W = p.in[7] + (size_t)l * 1024 * 3072 + cgp * 16 + col;
  float a0 = 0.f, a1 = 0.f, a2 = 0.f;
#pragma unroll 8
  for (int k = kg * 32; k < kg * 32 + 32; ++k) {
    float w = W[(size_t)k * 3072];
    a0 += sc[k] * w; a1 += sc[1024 + k] * w; a2 += sc[2048 + k] * w;
  }
  red[(kg * 3 + 0) * 16 + col] = a0; red[(kg * 3 + 1) * 16 + col] = a1; red[(kg * 3 + 2) * 16 + col] = a2;
  __syncthreads();
  if (tid < 48) {
    const int j = tid >> 4; float s_ = 0.f;
    for (int g = 0; g < 32; ++g) s_ += red[(g * 3 + j) * 16 + col];
    const int n = cgp * 16 + col;
    __hip_atomic_store((float*)(p.ws + OFF_MOD) + (l * 3 + j) * 3072 + n, s_ + p.in[8][l * 3072 + n], __ATOMIC_RELAXED, __HIP_MEMORY_SCOPE_AGENT);
  }
  if (tid < 64) {
    asm volatile("s_waitcnt vmcnt(0)" ::: "memory");
    if (tid == 0) __hip_atomic_fetch_add((unsigned*)(p.ws + OFF_CNT) + 6, 1u, __ATOMIC_RELAXED, __HIP_MEMORY_SCOPE_AGENT);
  }
  __syncthreads();
}

__device__ __forceinline__ void p0_item(const Params& p, int item, char* lds) {
  const int tid = otid();
  char* ws = p.ws;
  if (item < 96) {
    float* sc = (float*)lds;
    float* red = sc + 3072;
    const int l = item / 48, cgp = item % 48;
    const float* cctx = p.in[6]; const float* cc2 = p.in[2];
    for (int i = tid; i < 3072; i += 512) {
      int j = i >> 10, k = i & 1023;
      float c = (j == 0) ? cctx[k] : cc2[(j > 0 ? j - 1 : 0) * 1024 + k];
      sc[i] = siluf(c);
    }
    __syncthreads();
    const int col = tid & 63, kg = tid >> 6;
    const float* W = p.in[7] + (size_t)l * 1024 * 3072 + cgp * 64 + col;
    float a0 = 0.f, a1 = 0.f, a2 = 0.f;
    for (int k = kg * 128; k < kg * 128 + 128; ++k) {
      float w = W[(size_t)k * 3072];
      a0 += sc[k] * w; a1 += sc[1024 + k] * w; a2 += sc[2048 + k] * w;
    }
    red[(kg * 3 + 0) * 64 + col] = a0; red[(kg * 3 + 1) * 64 + col] = a1; red[(kg * 3 + 2) * 64 + col] = a2;
    __syncthreads();
    if (tid < 192) {
      int j = tid >> 6; float s = 0.f;
      for (int g = 0; g < 8; ++g) s += red[(g * 3 + j) * 64 + col];
      int n = cgp * 64 + col;
      ((float*)(ws + OFF_MOD))[(l * 3 + j) * 3072 + n] = s + p.in[8][l * 3072 + n];
    }
    __syncthreads();
    return;
  }
  item -= 96;
  if (item < 128) {
    int idx = item * 512 + tid, t = idx >> 5, c = idx & 31, fi = c & 15;
    float pos = (c < 16) ? (float)(t >> 6) : (float)(t & 63);
    float inv = powf(10000.f, -(float)fi / 16.f);
    float ang = pos * inv;
    ((float2*)(ws + OFF_ROPE))[idx] = make_float2(cosf(ang), sinf(ang));
    return;
  }
  item -= 128;
  if (item < 2048) {
    const float2* tab = (const float2*)lds;
    int idx = item * 512 + tid, tp = idx >> 9, k0 = (idx & 511) * 8;
    uint32_t o[4];
    float vv[8];
#pragma unroll
    for (int j = 0; j < 8; ++j) {
      int k = k0 + j; int m = (tp * (k & 2047)) & 2047;
      float2 cs = tab[m];
      vv[j] = (k < 2048) ? cs.x : -cs.y;
    }
#pragma unroll
    for (int j = 0; j < 4; ++j) o[j] = pack2(vv[2 * j], vv[2 * j + 1]);
    *(uint4*)(ws + OFF_DL + (size_t)idx * 16) = make_uint4(o[0], o[1], o[2], o[3]);
    return;
  }
  item -= 2048;
  if (item < 32) {
    int idx = item * 512 + tid, tp = idx >> 6, k0 = (idx & 63) * 8;
    uint32_t o[4];
    float vv[8];
#pragma unroll
    for (int j = 0; j < 8; ++j) {
      int k = k0 + j; int m = (tp * (k & 255)) & 255; float s, c;
      sincospif((float)m * (1.f / 128.f), &s, &c);
      vv[j] = (k < 256) ? c : -s;
    }
#pragma unroll
    for (int j = 0; j < 4; ++j) o[j] = pack2(vv[2 * j], vv[2 * j + 1]);
    *(uint4*)(ws + OFF_DC + (size_t)idx * 16) = make_uint4(o[0], o[1], o[2], o[3]);
    return;
  }
  item -= 32;
  if (item < 8) {
    int idx = item * 512 + tid, j = idx >> 4, c0 = (idx & 15) * 8;
    uint32_t o[4];
    float vv[8];
#pragma unroll
    for (int q = 0; q < 8; ++q) {
      int m = ((j & 127) * (c0 + q)) & 127; float s, c;
      sincospif((float)m * (1.f / 64.f), &s, &c);
      vv[q] = (j < 128) ? c : s;
    }
#pragma unroll
    for (int q = 0; q < 4; ++q) o[q] = pack2(vv[2 * q], vv[2 * q + 1]);
    *(uint4*)(ws + OFF_B1 + (size_t)idx * 16) = make_uint4(o[0], o[1], o[2], o[3]);
    return;
  }
  item -= 8;
  if (item < 128) {
    int idx = item * 512 + tid; int e = idx * 8;
    int n = e & 511, t = (e >> 9) & 255, l = (e >> 17) & 1, b = e >> 18;
    const float4* s = (const float4*)(p.in[3] + e);
    float4 a = s[0], c = s[1];
    size_t d = ((size_t)((l * 2 + b) * 256 + t)) * 512 + n;
    *(uint4*)(ws + OFF_KC + d * 2) = make_uint4(pack2(a.x, a.y), pack2(a.z, a.w), pack2(c.x, c.y), pack2(c.z, c.w));
    return;
  }
  item -= 128;
  {
    int idx = item * 512 + tid;
    int v = idx & 127, tc = (idx >> 7) & 31, h = (idx >> 12) & 3, b = (idx >> 14) & 1, l = idx >> 15;
    float vv[8];
#pragma unroll
    for (int j = 0; j < 8; ++j) vv[j] = p.in[4][((size_t)((b * 2 + l) * 256 + tc * 8 + j)) * 512 + h * 128 + v];
    size_t d = ((size_t)((b * 4 + h) * 128 + v)) * 2304 + 2048 + tc * 8;
    *(uint4*)(ws + OFF_VTL + l * SZ_VTL + d * 2) = make_uint4(pack2(vv[0], vv[1]), pack2(vv[2], vv[3]), pack2(vv[4], vv[5]), pack2(vv[6], vv[7]));
  }
}
constexpr int P0_ITEMS = 96 + 128 + 2048 + 32 + 8 + 128 + 128;

__device__ __forceinline__ void p1_item(const Params& p, int l, int item, char* lds) {
  const int tid = otid();
  char* ws = p.ws;
  if (item < 2816) {
    const float* src; int lsrc; u16* dst; int ldd; int kt, nt;
    const float* w10 = p.in[10]; const float* w17 = p.in[17]; const float* w18 = p.in[18]; const float* w19 = p.in[19]; const float* w20 = p.in[20];
    if (item < 2176) { src = w10 + (size_t)l * 1024 * 8704; lsrc = 8704; dst = (u16*)(ws + OFF_WIN); ldd = 1024; nt = item >> 4; kt = item & 15; }
    else if (item < 2560) { int r = item - 2176; int j = r >> 7; r &= 127; src = ((j == 0) ? w17 : ((j == 1) ? w18 : w19)) + (size_t)l * 512 * 1024; lsrc = 1024; dst = (u16*)(ws + OFF_WBR) + (size_t)j * 1024 * 512; ldd = 512; nt = r >> 3; kt = r & 7; }
    else { int r = item - 2560; src = w20 + (size_t)l * 1024 * 1024; lsrc = 1024; dst = (u16*)(ws + OFF_WO); ldd = 1024; nt = r >> 4; kt = r & 15; }
    u16* T = (u16*)lds;
    const int k0 = kt * 64, n0 = nt * 64;
#pragma unroll
    for (int ps = 0; ps < 2; ++ps) {
      int kr = (tid >> 4) + 32 * ps, nq = tid & 15;
      float4 v = *(const float4*)(src + (size_t)(k0 + kr) * lsrc + n0 + 4 * nq);
      T[(4 * nq + 0) * 72 + kr] = f2bf(v.x); T[(4 * nq + 1) * 72 + kr] = f2bf(v.y);
      T[(4 * nq + 2) * 72 + kr] = f2bf(v.z); T[(4 * nq + 3) * 72 + kr] = f2bf(v.w);
    }
    __syncthreads();
    {
      int n = tid >> 3, kc = tid & 7;
      uint4 o = *(const uint4*)(T + n * 72 + kc * 8);
      *(uint4*)(dst + (size_t)(n0 + n) * ldd + k0 + kc * 8) = o;
    }
    __syncthreads();
    return;
  }
  item -= 2816;
  const int lane = tid & 63, wid = tid >> 6;
  const float* modp = (const float*)(ws + OFF_MOD);
  u16* H = (u16*)(ws + OFF_H);
  const float* xin0 = p.in[0]; const float* xin1 = p.in[1]; const float* xin2 = p.out; const float* ng = p.in[9];
#pragma unroll
  for (int rr = 0; rr < 2; ++rr) {
    int r = item * 16 + wid * 2 + rr;
    const float* x = (l == 0) ? ((r < NCTX) ? xin0 + (size_t)r * 1024 : xin1 + (size_t)(r - NCTX) * 1024) : xin2 + (size_t)r * 1024;
    int ci = (r < NCTX) ? 0 : 1 + ((r - NCTX) >> 11);
    float4 v[4]; float ss = 0.f;
#pragma unroll
    for (int i = 0; i < 4; ++i) { v[i] = *(const float4*)(x + lane * 4 + 256 * i); ss += v[i].x * v[i].x + v[i].y * v[i].y + v[i].z * v[i].z + v[i].w * v[i].w; }
#pragma unroll
    for (int o = 32; o >= 1; o >>= 1) ss += __shfl_xor(ss, o);
    float rinv = rsqrtf(ss * (1.f / 1024.f) + EPSV);
    const float* sh = modp + (l * 3 + ci) * 3072;
#pragma unroll
    for (int i = 0; i < 4; ++i) {
      int col = lane * 4 + 256 * i;
      float4 g = *(const float4*)(ng + l * 1024 + col);
      float4 s1 = *(const float4*)(sh + 1024 + col);
      float4 s0 = *(const float4*)(sh + col);
      float a = v[i].x * rinv * g.x * (1.f + s1.x) + s0.x;
      float b = v[i].y * rinv * g.y * (1.f + s1.y) + s0.y;
      float c = v[i].z * rinv * g.z * (1.f + s1.z) + s0.z;
      float d = v[i].w * rinv * g.w * (1.f + s1.w) + s0.w;
      *(uint2*)(H + (size_t)r * 1024 + col) = make_uint2(pack2(a, b), pack2(c, d));
    }
  }
}
constexpr int P1_ITEMS = 2816 + 768;

__device__ __forceinline__ void stagger_us(int us) {
  const unsigned long long t0 = __builtin_amdgcn_s_memrealtime();
  while (__builtin_amdgcn_s_memrealtime() - t0 < (unsigned long long)us * 100ull) __builtin_amdgcn_s_sleep(8);
}
#define STAGGER_US 0
struct P2Sched {
  const char* H; const char* W; int G, c;
  __device__ __forceinline__ bool next(int i, Unit& u) const {
    const int L = i * G + c;
    if (L >= 1024) return false;
    if (L < 960) {
      const int nM = 48, nN = 20, nwg = 960;
      int wgid = L; { const int q = nwg / 8, xcd = wgid % 8, off = wgid / 8; wgid = xcd * q + off; }
      const int nig = 8 * nN, gid = wgid / nig, fm = gid * 8, gsz = (nM - fm) < 8 ? (nM - fm) : 8;
      int pm = fm + ((wgid % nig) % gsz), pn = (wgid % nig) / gsz;
      if (pn >= 14) pn += 2;
      u.a = H + (size_t)pm * 256 * 2048; u.b = W + (size_t)pn * 256 * 2048; u.x = pm; u.y = pn;
      u.lda = 1024; u.ldb = 1024; u.nt = 16; u.perm = ((pn >> 1) == 5 || (pn >> 1) == 6) ? 0 : 1;
    } else {
      const int r = L - 960; const int vq = r / 48, mt = r % 48;
      u.a = W + (size_t)(3584 + vq * 256) * 2048; u.b = H + (size_t)mt * 256 * 2048; u.x = vq; u.y = mt | 0x100;
      u.lda = 1024; u.ldb = 1024; u.nt = 16; u.perm = 0;
    }
    return true;
  }
};
struct P2Epi {
  const float* const* pin; float* out; char* ws; int l;
  const float* hlb; const float* qng; const float* kng; bool skip;
  __device__ __forceinline__ void operator()(f32x4 (&acc)[2][2][4][2], const Unit& u, int wr, int wc, int fr, int fq, LAS unsigned char* lds) const {
    if (skip) return;
    { const int t_ = otid(); const int w_ = t_ >> 6; wr = w_ >> 2; wc = w_ & 3; fr = t_ & 15; fq = (t_ & 63) >> 4; }
    if (u.y & 0x100) {
      const int mt = u.y & 0xff, vq = u.x;
#pragma unroll
      for (int ai = 0; ai < 2; ++ai)
#pragma unroll
        for (int m = 0; m < 4; ++m) {
          const int nn = vq * 256 + ai * 128 + wr * 64 + m * 16 + fr;
          const int hh = nn >> 7, v = nn & 127;
#pragma unroll
          for (int bj = 0; bj < 2; ++bj)
#pragma unroll
            for (int n = 0; n < 2; ++n) {
              const int tokl = bj * 128 + wc * 32 + n * 16 + 4 * fq;
              f32x4 a4 = acc[ai][bj][m][n];
              uint2 pk = make_uint2(pack2(a4[0], a4[1]), pack2(a4[2], a4[3]));
              if (mt < 32) {
                *(uint2*)(ws + OFF_VTC + ((size_t)((mt * 4 + hh) * 128 + v) * 256 + tokl) * 2) = pk;
                float* o = out + OCV + ((size_t)((mt * 2 + l) * 256 + tokl)) * 512 + nn;
                o[0] = a4[0]; o[512] = a4[1]; o[1024] = a4[2]; o[1536] = a4[3];
              } else {
                int rp = (mt - 32) * 256 + tokl; int bb = rp >> 11, t = rp & 2047;
                *(uint2*)(ws + OFF_VTL + l * SZ_VTL + ((size_t)((bb * 4 + hh) * 128 + v) * 2304 + t) * 2) = pk;
              }
            }
        }
      return;
    }
    const int pm = u.x, pn = u.y, seg = pn >> 1, ncol0 = (pn & 1) * 256;
    const int dcol0 = ((seg < 7) ? seg : seg - 1) * 512 + ncol0;
    u16* proj = (u16*)(ws + OFF_PROJ);
    const bool lat = (pm >= 32);
    if (seg == 5 || seg == 6) {
      float* xch = (float*)(lds + G8_STAGE_BYTES);
#pragma unroll
      for (int ai = 0; ai < 2; ++ai)
#pragma unroll
        for (int m = 0; m < 4; ++m)
#pragma unroll
          for (int bj = 0; bj < 2; ++bj) {
            float ss = 0.f;
#pragma unroll
            for (int n = 0; n < 2; ++n)
#pragma unroll
              for (int e = 0; e < 4; ++e) { float bfv = bf2f(f2bf(acc[ai][bj][m][n][e])); ss += bfv * bfv; }
            ss += __shfl_xor(ss, 16); ss += __shfl_xor(ss, 32);
            if (fq == 0) xch[((ai * 128 + wr * 64 + m * 16 + fr) * 2 + bj) * 4 + wc] = ss;
          }
      asm volatile("s_waitcnt lgkmcnt(0)" ::: "memory");
      __builtin_amdgcn_s_barrier();
      asm volatile("" ::: "memory");
      const float* gsel = (seg == 5) ? qng : kng;
      float gv[2][4];
#pragma unroll
      for (int n = 0; n < 2; ++n)
#pragma unroll
        for (int e = 0; e < 4; ++e) gv[n][e] = gsel[l * 64 + 32 * (wc & 1) + 16 * n + 4 * fq + e];
#pragma unroll
      for (int ai = 0; ai < 2; ++ai)
#pragma unroll
        for (int m = 0; m < 4; ++m) {
          const int rl = ai * 128 + wr * 64 + m * 16 + fr;
          const int grow = pm * 256 + rl;
#pragma unroll
          for (int bj = 0; bj < 2; ++bj) {
            const float2 pr = *(const float2*)&xch[(rl * 2 + bj) * 4 + (wc & 2)];
            const float tot = pr.x + pr.y;
            const float rinv = rsqrtf(tot * (1.f / 64.f) + EPSV);
            float x[2][4];
#pragma unroll
            for (int n = 0; n < 2; ++n)
#pragma unroll
              for (int e = 0; e < 4; ++e) x[n][e] = bf2f(f2bf(acc[ai][bj][m][n][e])) * rinv * gv[n][e];
            const int colt = ncol0 + bj * 128 + wc * 32;
            if (seg == 6 && !lat) {
              float* o = out + OCK + ((size_t)((pm * 2 + l) * 256 + rl)) * 512 + colt + 4 * fq;
              *(float4*)o = make_float4(x[0][0], x[0][1], x[0][2], x[0][3]);
              *(float4*)(o + 16) = make_float4(x[1][0], x[1][1], x[1][2], x[1][3]);
            }
            if (lat) {
              const int t = (grow - NCTX) & 2047;
              const float2* rt = (const float2*)(ws + OFF_ROPE) + t * 32 + ((wc & 1) ? 16 : 0) + 4 * fq;
#pragma unroll
              for (int e = 0; e < 4; ++e) {
                float2 cs = rt[e];
                float x1 = x[0][e], x2 = x[1][e];
                x[0][e] = x1 * cs.x - x2 * cs.y;
                x[1][e] = x1 * cs.y + x2 * cs.x;
              }
            }
            if (seg == 5) {
#pragma unroll
              for (int n = 0; n < 2; ++n)
#pragma unroll
                for (int e = 0; e < 4; ++e) x[n][e] *= 0.125f;
            }
            u16* dp = proj + (size_t)grow * LDP + dcol0 + bj * 128 + wc * 32 + 4 * fq;
            *(uint2*)dp = make_uint2(pack2(x[0][0], x[0][1]), pack2(x[0][2], x[0][3]));
            *(uint2*)(dp + 16) = make_uint2(pack2(x[1][0], x[1][1]), pack2(x[1][2], x[1][3]));
          }
        }
      return;
    }
    const bool dosilu = (seg == 0 || seg == 4 || seg == 8 || seg == 10);
    const bool dolf = (seg == 1 || seg == 2);
    const int dir = (seg == 2) ? 1 : 0;
#define P2_STORE16(A0, A1) *(uint4*)(proj + (size_t)grow * LDP + dcol0 + bj * 128 + wc * 32 + 8 * fq) = make_uint4(pack2(A0[0], A0[1]), pack2(A0[2], A0[3]), pack2(A1[0], A1[1]), pack2(A1[2], A1[3]))
    if (dosilu) {
#pragma unroll
      for (int ai = 0; ai < 2; ++ai)
#pragma unroll
        for (int m = 0; m < 4; ++m) {
          const int grow = pm * 256 + ai * 128 + wr * 64 + m * 16 + fr;
#pragma unroll
          for (int bj = 0; bj < 2; ++bj) {
            f32x4 a0 = acc[ai][bj][m][0], a1 = acc[ai][bj][m][1];
#pragma unroll
            for (int e = 0; e < 4; ++e) { a0[e] = siluf(a0[e]); a1[e] = siluf(a1[e]); }
            P2_STORE16(a0, a1);
          }
        }
    } else if (dolf) {
#pragma unroll
      for (int bj = 0; bj < 2; ++bj) {
        float lbv[2][4];
#pragma unroll
        for (int n = 0; n < 2; ++n)
#pragma unroll
          for (int e = 0; e < 4; ++e) {
            int j = ncol0 + bj * 128 + wc * 32 + 8 * fq + 4 * n + e;
            lbv[n][e] = (l == 0) ? 0.f : sigmf(hlb[(1 * 2 + dir) * 512 + j] - hlb[(0 * 2 + dir) * 512 + j]);
          }
#pragma unroll
        for (int ai = 0; ai < 2; ++ai)
#pragma unroll
          for (int m = 0; m < 4; ++m) {
            const int grow = pm * 256 + ai * 128 + wr * 64 + m * 16 + fr;
            f32x4 a0 = acc[ai][bj][m][0], a1 = acc[ai][bj][m][1];
#pragma unroll
            for (int e = 0; e < 4; ++e) { a0[e] = logf_gate(a0[e], lbv[0][e]); a1[e] = logf_gate(a1[e], lbv[1][e]); }
            P2_STORE16(a0, a1);
          }
      }
    } else {
#pragma unroll
      for (int ai = 0; ai < 2; ++ai)
#pragma unroll
        for (int m = 0; m < 4; ++m) {
          const int grow = pm * 256 + ai * 128 + wr * 64 + m * 16 + fr;
#pragma unroll
          for (int bj = 0; bj < 2; ++bj) {
            f32x4 a0 = acc[ai][bj][m][0], a1 = acc[ai][bj][m][1];
            P2_STORE16(a0, a1);
          }
        }
    }
  }
};
__device__ __forceinline__ void p2_left_item(const Params& p, int l, int L, char* lds) {
  P2Sched S0; S0.H = p.ws + OFF_H; S0.W = p.ws + OFF_WIN; S0.G = 0x40000000; S0.c = 0;
  OneUnit S;
  {
    const int r = L - 960; const int vq = r / 48, mt = r % 48;
    S.u.a = S0.W + (size_t)(3584 + vq * 256) * 2048; S.u.b = S0.H + (size_t)mt * 256 * 2048; S.u.x = vq; S.u.y = mt | 0x100;
    S.u.lda = 1024; S.u.ldb = 1024; S.u.nt = 16;
  }
  P2Epi E; E.pin = nullptr; E.out = p.out; E.ws = p.ws; E.l = l; E.hlb = p.in[11]; E.qng = p.in[13]; E.kng = p.in[14]; E.skip = false;
  gemm_phase((LAS unsigned char*)lds, S, E);
}
__device__ __forceinline__ void p2_phase(const Params& p, int l, char* lds, bool skip = false) {
  if (STAGGER_US && ((blockIdx.x >> 3) & 1)) stagger_us(STAGGER_US);
  P2Sched S; S.H = p.ws + OFF_H; S.W = p.ws + OFF_WIN; S.G = gridDim.x; S.c = blockIdx.x;
  P2Epi E; E.pin = nullptr; E.out = p.out; E.ws = p.ws; E.l = l; E.hlb = p.in[11]; E.qng = p.in[13]; E.kng = p.in[14]; E.skip = skip;
  gemm_phase((LAS unsigned char*)lds, S, E);
}

struct HgrnLds {
  float tot[4][128];
  float dk[128];
  float osum[16][132];
  u16 qt[16][136];
  u16 kt[16][136];
  u16 khT[128][20];
  u16 vT[128][20];
  u16 zt[16][136];
  u16 obuf[256][136];
};

#define LBAR() do { asm volatile("s_waitcnt lgkmcnt(0)" ::: "memory"); __builtin_amdgcn_s_barrier(); asm volatile("" ::: "memory"); } while (0)
__device__ __forceinline__ void hgrn_pass(const Params& p, int l, int row0, int ntok, int h, int dir, f32x4 (&S)[8],
                                          const bool do_out, const bool second, float& gsum, HgrnLds& L, const bool dry = false) {
  const int tid = otid(), lane = tid & 63, wid = tid >> 6, c16 = lane & 15, g = lane >> 4;
  const int kk = tid & 127, tq = tid >> 7;
  const u16* proj = (const u16*)(p.ws + OFF_PROJ);
  u16* projw = (u16*)(p.ws + OFF_PROJ);
  const int nch = ntok >> 4;
  float4 gg = make_float4(0.f, 0.f, 0.f, 0.f);
  if (second) gg = *(const float4*)(p.in[12] + l * 512 + h * 128 + 4 * (tid & 31));
  u16 lfA[4], qA[4], vA[4], zA[4], lfB[4], qB[4], vB[4], zB[4];
#define HG_LD(c_, LF, QQ, VV, ZZ)                                                    \
  {                                                                                  \
    _Pragma("unroll") for (int i = 0; i < 4; ++i) {                                  \
      int s_ = (c_) * 16 + 4 * tq + i;                                               \
      int tl_ = dir ? (ntok - 1 - s_) : s_;                                          \
      const u16* rp_ = proj + (size_t)(row0 + tl_) * LDP + h * 128 + kk;             \
      LF[i] = rp_[PLF + dir * 512];                                                  \
      VV[i] = rp_[PIA];                                                              \
      QQ[i] = do_out ? rp_[PQA] : (u16)0;                                            \
      ZZ[i] = second ? rp_[PZA] : (u16)0;                                            \
    }                                                                                \
  }
  HG_LD(0, lfA, qA, vA, zA);
  HG_LD(1, lfB, qB, vB, zB);
  auto body = [&](const int c, u16 (&LF)[4], u16 (&QQ)[4], u16 (&VV)[4], u16 (&ZZ)[4]) __attribute__((always_inline)) {
    float lf[4], G[4], qv[4];
    u16 vv[4], zz[4];
#pragma unroll
    for (int i = 0; i < 4; ++i) { lf[i] = bf2f(LF[i]); qv[i] = bf2f(QQ[i]); vv[i] = VV[i]; zz[i] = ZZ[i]; }
    G[0] = lf[0]; G[1] = G[0] + lf[1]; G[2] = G[1] + lf[2]; G[3] = G[2] + lf[3];
    L.tot[tq][kk] = G[3];
    LBAR();
    if (c + 2 < nch) HG_LD(c + 2, LF, QQ, VV, ZZ);
    float t0 = L.tot[0][kk], t1 = L.tot[1][kk], t2 = L.tot[2][kk], t3 = L.tot[3][kk];
    float off = (tq > 0 ? t0 : 0.f) + (tq > 1 ? t1 : 0.f) + (tq > 2 ? t2 : 0.f);
    float gend = t0 + t1 + t2 + t3;
    float kh[4];
#pragma unroll
    for (int i = 0; i < 4; ++i) {
      float Gi = G[i] + off;
      float kv = neg_expm1(lf[i]);
      int s = 4 * tq + i;
      if (do_out) {
        L.qt[s][kk] = f2bf(qv[i] * fexp(Gi));
        L.kt[s][kk] = f2bf(kv * fexp(fminf(-Gi, 80.f)));
      }
      if (second) L.zt[s][kk] = zz[i];
      kh[i] = kv * fexp(gend - Gi);
    }
    *(uint2*)&L.khT[kk][4 * tq] = make_uint2(pack2(kh[0], kh[1]), pack2(kh[2], kh[3]));
    *(uint2*)&L.vT[kk][4 * tq] = make_uint2((uint32_t)vv[0] | ((uint32_t)vv[1] << 16), (uint32_t)vv[2] | ((uint32_t)vv[3] << 16));
    if (tq == 0) { L.dk[kk] = fexp(gend); gsum += gend; }
    LBAR();
    Frag bv;
    bv.h[0] = *(const uint2*)&L.vT[16 * wid + c16][4 * g];
    bv.h[1] = make_uint2(0u, 0u);
    f32x4 o = f32x4{0.f, 0.f, 0.f, 0.f};
    if (do_out) {
      f32x4 at = f32x4{0.f, 0.f, 0.f, 0.f};
#pragma unroll
      for (int ks = 0; ks < 4; ++ks) {
        Frag a, b;
        a.q = *(const uint4*)&L.kt[c16][32 * ks + 8 * g];
        b.q = *(const uint4*)&L.qt[c16][32 * ks + 8 * g];
        at = MFMA(a.v, b.v, at);
      }
      Frag pa;
#pragma unroll
      for (int r = 0; r < 4; ++r) at[r] = (4 * g + r <= c16) ? at[r] : 0.f;
      pa.w[0] = pack2(at[0], at[1]); pa.w[1] = pack2(at[2], at[3]); pa.w[2] = 0u; pa.w[3] = 0u;
      o = MFMA(pa.v, bv.v, o);
#pragma unroll
      for (int st = 0; st < 4; ++st) {
        Frag a, b;
        a.h[0] = *(const uint2*)&L.qt[c16][32 * st + 4 * g];
        a.h[1] = *(const uint2*)&L.qt[c16][32 * st + 16 + 4 * g];
        b.w[0] = pack2(S[2 * st][0], S[2 * st][1]); b.w[1] = pack2(S[2 * st][2], S[2 * st][3]);
        b.w[2] = pack2(S[2 * st + 1][0], S[2 * st + 1][1]); b.w[3] = pack2(S[2 * st + 1][2], S[2 * st + 1][3]);
        o = MFMA(a.v, b.v, o);
      }
    }
#pragma unroll
    for (int k8 = 0; k8 < 8; ++k8) {
      float4 d = *(const float4*)&L.dk[16 * k8 + 4 * g];
      f32x4 s0 = S[k8];
      s0[0] *= d.x; s0[1] *= d.y; s0[2] *= d.z; s0[3] *= d.w;
      Frag a;
      a.h[0] = *(const uint2*)&L.khT[16 * k8 + c16][4 * g];
      a.h[1] = make_uint2(0u, 0u);
      S[k8] = MFMA(a.v, bv.v, s0);
    }
    if (do_out) {
      const int vcol = 16 * wid + c16;
      if (!second) {
#pragma unroll
        for (int r = 0; r < 4; ++r) {
          int s = c * 16 + 4 * g + r;
          int tl = dir ? (ntok - 1 - s) : s;
          L.obuf[tl][vcol] = f2bf(o[r]);
        }
      } else {
#pragma unroll
        for (int r = 0; r < 4; ++r) {
          int s = c * 16 + 4 * g + r;
          int tl = dir ? (ntok - 1 - s) : s;
          L.osum[4 * g + r][vcol] = o[r] + bf2f(L.obuf[tl][vcol]);
        }
        LBAR();
        {
          int sl = tid >> 5, vq = tid & 31;
          int s = c * 16 + sl;
          int tl = dir ? (ntok - 1 - s) : s;
          float4 ov = *(const float4*)&L.osum[sl][4 * vq];
          float ss = ov.x * ov.x + ov.y * ov.y + ov.z * ov.z + ov.w * ov.w;
#pragma unroll
          for (int m = 1; m <= 16; m <<= 1) ss += __shfl_xor(ss, m);
          float rinv = rsqrtf(ss * (1.f / 128.f) + EPSV);
          u16* rp = projw + (size_t)(row0 + tl) * LDP + h * 128 + 4 * vq;
          uint2 z = *(const uint2*)&L.zt[sl][4 * vq];
          float y0 = ov.x * rinv * gg.x * lo2f(z.x), y1 = ov.y * rinv * gg.y * hi2f(z.x);
          float y2 = ov.z * rinv * gg.z * lo2f(z.y), y3 = ov.w * rinv * gg.w * hi2f(z.y);
          if (!dry) *(uint2*)(rp + PQA) = make_uint2(pack2(y0, y1), pack2(y2, y3));
        }
      }
    }
  };
  for (int c = 0; c < nch; c += 2) {
    body(c, lfA, qA, vA, zA);
    body(c + 1, lfB, qB, vB, zB);
  }
  __syncthreads();
}

__device__ __forceinline__ void hgrn_load_state(const float* m, f32x4 (&S)[8]) {
  const int tid_ = otid(); const int lane = tid_ & 63, wid = tid_ >> 6, c16 = lane & 15, g = lane >> 4;
#pragma unroll
  for (int k8 = 0; k8 < 8; ++k8)
#pragma unroll
    for (int r = 0; r < 4; ++r) S[k8][r] = m[(16 * k8 + 4 * g + r) * 128 + 16 * wid + c16];
}
__device__ __forceinline__ void hgrn_store_state(float* m, const f32x4 (&S)[8]) {
  const int tid_ = otid(); const int lane = tid_ & 63, wid = tid_ >> 6, c16 = lane & 15, g = lane >> 4;
#pragma unroll
  for (int k8 = 0; k8 < 8; ++k8)
#pragma unroll
    for (int r = 0; r < 4; ++r) m[(16 * k8 + 4 * g + r) * 128 + 16 * wid + c16] = S[k8][r];
}
__device__ __forceinline__ void hgrn_advance(const float* U, const float* D, f32x4 (&S)[8]) {
  const int tid_ = otid(); const int lane = tid_ & 63, wid = tid_ >> 6, c16 = lane & 15, g = lane >> 4;
#pragma unroll
  for (int k8 = 0; k8 < 8; ++k8)
#pragma unroll
    for (int r = 0; r < 4; ++r) {
      int k = 16 * k8 + 4 * g + r;
      S[k8][r] = D[k] * S[k8][r] + U[k * 128 + 16 * wid + c16];
    }
}

__device__ __forceinline__ void hgrn_ctx_item(const Params& p, int l, int item, char* lds, const bool dry = false) {
  HgrnLds& L = *(HgrnLds*)lds;
  const int b = item >> 2, h = item & 3;
  f32x4 S[8];
  float gsum = 0.f;
#pragma unroll
  for (int i = 0; i < 8; ++i) S[i] = f32x4{0.f, 0.f, 0.f, 0.f};
  hgrn_pass(p, l, b * 256, 256, h, 0, S, true, false, gsum, L, dry);
  if (!dry) hgrn_store_state(p.out + OST + ((size_t)(((b * 2 + l) * 2 + 0) * 4 + h)) * 16384, S);
#pragma unroll
  for (int i = 0; i < 8; ++i) S[i] = f32x4{0.f, 0.f, 0.f, 0.f};
  hgrn_pass(p, l, b * 256, 256, h, 1, S, true, true, gsum, L, dry);
  if (!dry) hgrn_store_state(p.out + OST + ((size_t)(((b * 2 + l) * 2 + 1) * 4 + h)) * 16384, S);
}
__device__ __forceinline__ void hgrn_lat1_item(const Params& p, int l, int item, char* lds) {
  HgrnLds& L = *(HgrnLds*)lds;
  const int seg = item & 15, dir = (item >> 4) & 1, h = (item >> 5) & 3, b = item >> 7;
  f32x4 S[8];
  float gsum = 0.f;
#pragma unroll
  for (int i = 0; i < 8; ++i) S[i] = f32x4{0.f, 0.f, 0.f, 0.f};
  hgrn_pass(p, l, NCTX + b * 2048 + seg * 128, 128, h, dir, S, false, false, gsum, L);
  float* SU = (float*)(p.ws + OFF_SEGU);
  float* SD = (float*)(p.ws + OFF_SEGD);
  {
    const int tq_ = otid(); const int lane_ = tq_ & 63, wid_ = tq_ >> 6, c16_ = lane_ & 15, g_ = lane_ >> 4;
    float* m_ = SU + (size_t)item * 16384;
#pragma unroll
    for (int k8 = 0; k8 < 8; ++k8)
#pragma unroll
      for (int r = 0; r < 4; ++r) __hip_atomic_store(m_ + (16 * k8 + 4 * g_ + r) * 128 + 16 * wid_ + c16_, S[k8][r], __ATOMIC_RELAXED, __HIP_MEMORY_SCOPE_AGENT);
  }
  const int t_ = otid();
  if (t_ < 128) __hip_atomic_store(SD + item * 128 + t_, fexp(gsum), __ATOMIC_RELAXED, __HIP_MEMORY_SCOPE_AGENT);
  volatile int* flag = (volatile int*)(lds + LDS_TILE + 32);
  asm volatile("s_waitcnt vmcnt(0)" ::: "memory");
  __syncthreads();
  if (t_ == 0) {
    unsigned* tk = (unsigned*)(p.ws + OFF_CNT) + 8 + l * 32 + (item >> 4);
    const unsigned old = __hip_atomic_fetch_add(tk, 1u, __ATOMIC_RELAXED, __HIP_MEMORY_SCOPE_AGENT);
    const int last = (old == 15u) ? 1 : 0;
    if (last) { __builtin_amdgcn_fence(__ATOMIC_ACQUIRE, "agent"); asm volatile("s_waitcnt vmcnt(0)" ::: "memory"); }
    *flag = last;
  }
  __syncthreads();
  if (*flag) {
    const int base = (item >> 4) * 16;
    hgrn_load_state(p.in[5] + ((size_t)(((b * 2 + l) * 2 + dir) * 4 + h)) * 16384, S);
    const int lane = t_ & 63, wid = t_ >> 6, c16 = lane & 15, g = lane >> 4;
    float un[8][4]; float4 dn[8];
    {
      const int sg0 = dir ? 15 : 0;
      const float* U0 = SU + (size_t)(base + sg0) * 16384; const float* D0 = SD + (base + sg0) * 128;
#pragma unroll
      for (int k8 = 0; k8 < 8; ++k8) {
        dn[k8] = *(const float4*)(D0 + 16 * k8 + 4 * g);
#pragma unroll
        for (int r = 0; r < 4; ++r) un[k8][r] = U0[(16 * k8 + 4 * g + r) * 128 + 16 * wid + c16];
      }
    }
#pragma unroll 1
    for (int i = 0; i < 16; ++i) {
      const int sg = dir ? (15 - i) : i;
      float* U = SU + (size_t)(base + sg) * 16384;
      float uc[8][4]; float4 dc[8];
#pragma unroll
      for (int k8 = 0; k8 < 8; ++k8) { dc[k8] = dn[k8];
#pragma unroll
        for (int r = 0; r < 4; ++r) uc[k8][r] = un[k8][r]; }
      if (i + 1 < 16) {
        const int sgn = dir ? (14 - i) : (i + 1);
        const float* Un = SU + (size_t)(base + sgn) * 16384; const float* Dn = SD + (base + sgn) * 128;
#pragma unroll
        for (int k8 = 0; k8 < 8; ++k8) {
          dn[k8] = *(const float4*)(Dn + 16 * k8 + 4 * g);
#pragma unroll
          for (int r = 0; r < 4; ++r) un[k8][r] = Un[(16 * k8 + 4 * g + r) * 128 + 16 * wid + c16];
        }
      }
#pragma unroll
      for (int k8 = 0; k8 < 8; ++k8) {
        const float dd[4] = {dc[k8].x, dc[k8].y, dc[k8].z, dc[k8].w};
#pragma unroll
        for (int r = 0; r < 4; ++r) {
          const int idx = (16 * k8 + 4 * g + r) * 128 + 16 * wid + c16;
          U[idx] = S[k8][r];
          S[k8][r] = dd[r] * S[k8][r] + uc[k8][r];
        }
      }
    }
  }
  __syncthreads();
}
__device__ __forceinline__ void hgrn_lat2_item(const Params& p, int l, int item, char* lds, const bool dry = false) {
  HgrnLds& L = *(HgrnLds*)lds;
  const int seg = item & 15, h = (item >> 4) & 3, b = item >> 6;
  const float* SU = (const float*)(p.ws + OFF_SEGU);
  const float* SD = (const float*)(p.ws + OFF_SEGD);
  f32x4 S[8];
  float gsum = 0.f;
  hgrn_load_state(SU + (size_t)(((b * 4 + h) * 2 + 0) * 16 + seg) * 16384, S);
  hgrn_pass(p, l, NCTX + b * 2048 + seg * 128, 128, h, 0, S, true, false, gsum, L, dry);
  hgrn_load_state(SU + (size_t)(((b * 4 + h) * 2 + 1) * 16 + seg) * 16384, S);
  hgrn_pass(p, l, NCTX + b * 2048 + seg * 128, 128, h, 1, S, true, true, gsum, L, dry);
}

__device__ __forceinline__ void attn_item(const Params& p, int l, int item, const bool lat, char* lds, const bool dry = false) {
  const int tid = otid(), lane = tid & 63, wid = tid >> 6, c16 = lane & 15, g = lane >> 4;
  char* ws = p.ws;
  u16* proj = (u16*)(ws + OFF_PROJ);
  int b, h, qb, nkeys, rowbase;
  const u16* Vt; int ldv;
  if (!lat) { qb = item & 1; h = (item >> 1) & 3; b = item >> 3; nkeys = 256; rowbase = b * 256; Vt = (const u16*)(ws + OFF_VTC) + (size_t)((b * 4 + h) * 128) * 256; ldv = 256; }
  else { qb = item & 15; h = (item >> 4) & 3; b = item >> 6; nkeys = 2304; rowbase = NCTX + b * 2048; Vt = (const u16*)(ws + OFF_VTL + l * SZ_VTL) + (size_t)((b * 4 + h) * 128) * 2304; ldv = 2304; }
  const u16* Kc = (const u16*)(ws + OFF_KC) + (size_t)((l * 2 + b) * 256) * 512 + h * 128;
  u16* Ks = (u16*)lds;
  u16* Vs = Ks + 64 * 136;
  float lam_init = 0.8f - 0.6f * expf(-0.3f * (float)l);
  float lam;
  {
    const float* lp = p.in[15] + l * 256;
    float a = lp[lane] * lp[64 + lane], c = lp[128 + lane] * lp[192 + lane];
#pragma unroll
    for (int o = 32; o >= 1; o >>= 1) { a += __shfl_xor(a, o); c += __shfl_xor(c, o); }
    lam = expf(a) - expf(c) + lam_init;
  }
  const int qrow = rowbase + qb * 128 + wid * 16 + c16;
  Frag qf[2][2];
#pragma unroll
  for (int m = 0; m < 2; ++m)
#pragma unroll
    for (int ks = 0; ks < 2; ++ks) qf[m][ks].q = *(const uint4*)(proj + (size_t)qrow * LDP + PQB + h * 128 + m * 64 + ks * 32 + g * 8);
  f32x4 O[2][8];
#pragma unroll
  for (int m = 0; m < 2; ++m)
#pragma unroll
    for (int v = 0; v < 8; ++v) O[m][v] = f32x4{0.f, 0.f, 0.f, 0.f};
  float mrun[2] = {-1e30f, -1e30f}, lsum[2] = {0.f, 0.f};
  uint4 kr0, kr1, vr0, vr1;
#define ATT_LD(kt_)                                                                                           \
  {                                                                                                           \
    const int key0 = (kt_) * 64;                                                                              \
    const bool fromproj = (!lat) || (key0 < 2048);                                                            \
    {                                                                                                         \
      int q = tid; int key = q >> 4, cc = q & 15;                                                             \
      const u16* src = fromproj ? proj + (size_t)(rowbase + key0 + key) * LDP + PKB + h * 128 + cc * 8        \
                                : Kc + (size_t)(key0 - 2048 + key) * 512 + cc * 8;                            \
      kr0 = *(const uint4*)src;                                                                               \
      int v = q >> 3, c8 = q & 7;                                                                             \
      vr0 = *(const uint4*)(Vt + (size_t)v * ldv + key0 + c8 * 8);                                            \
    }                                                                                                         \
    {                                                                                                         \
      int q = tid + 512; int key = q >> 4, cc = q & 15;                                                       \
      const u16* src = fromproj ? proj + (size_t)(rowbase + key0 + key) * LDP + PKB + h * 128 + cc * 8        \
                                : Kc + (size_t)(key0 - 2048 + key) * 512 + cc * 8;                            \
      kr1 = *(const uint4*)src;                                                                               \
      int v = q >> 3, c8 = q & 7;                                                                             \
      vr1 = *(const uint4*)(Vt + (size_t)v * ldv + key0 + c8 * 8);                                            \
    }                                                                                                         \
  }
#define ATT_ST()                                                                                              \
  {                                                                                                           \
    { int q = tid; int key = q >> 4, cc = q & 15; *(uint4*)(Ks + key * 136 + cc * 8) = kr0;                   \
      int v = q >> 3, c8 = q & 7; *(uint4*)(Vs + v * 72 + c8 * 8) = vr0; }                                    \
    { int q = tid + 512; int key = q >> 4, cc = q & 15; *(uint4*)(Ks + key * 136 + cc * 8) = kr1;             \
      int v = q >> 3, c8 = q & 7; *(uint4*)(Vs + v * 72 + c8 * 8) = vr1; }                                    \
  }
  const int nkt = nkeys >> 6;
  ATT_LD(0);
  for (int kt = 0; kt < nkt; ++kt) {
    LBAR();
    ATT_ST();
    LBAR();
    if (kt + 1 < nkt) ATT_LD(kt + 1);
    Frag pf[2][2];
#pragma unroll
    for (int m = 0; m < 2; ++m) {
      f32x4 s[4];
#pragma unroll
      for (int k4 = 0; k4 < 4; ++k4) {
        s[k4] = f32x4{0.f, 0.f, 0.f, 0.f};
#pragma unroll
        for (int ks = 0; ks < 2; ++ks) {
          Frag a;
          a.q = *(const uint4*)(Ks + (16 * k4 + c16) * 136 + m * 64 + ks * 32 + g * 8);
          s[k4] = MFMA(a.v, qf[m][ks].v, s[k4]);
        }
      }
      float mx = -1e30f;
#pragma unroll
      for (int k4 = 0; k4 < 4; ++k4)
#pragma unroll
        for (int r = 0; r < 4; ++r) mx = fmaxf(mx, s[k4][r]);
      mx = fmaxf(mx, __shfl_xor(mx, 16));
      mx = fmaxf(mx, __shfl_xor(mx, 32));
      if (__any(mx - mrun[m] > 4.0f)) {
        const float mnew = fmaxf(mrun[m], mx);
        const float alpha = fexp(mrun[m] - mnew);
        mrun[m] = mnew;
        lsum[m] *= alpha;
#pragma unroll
        for (int v = 0; v < 8; ++v) { O[m][v][0] *= alpha; O[m][v][1] *= alpha; O[m][v][2] *= alpha; O[m][v][3] *= alpha; }
      }
      const float mneg = -mrun[m] * 1.4426950408889634f;
      float ps = 0.f;
#pragma unroll
      for (int k4 = 0; k4 < 4; ++k4)
#pragma unroll
        for (int r = 0; r < 4; ++r) { s[k4][r] = __builtin_amdgcn_exp2f(fmaf(s[k4][r], 1.4426950408889634f, mneg)); ps += s[k4][r]; }
      lsum[m] += ps;
#pragma unroll
      for (int sp = 0; sp < 2; ++sp) {
        pf[m][sp].w[0] = pack2(s[2 * sp][0], s[2 * sp][1]); pf[m][sp].w[1] = pack2(s[2 * sp][2], s[2 * sp][3]);
        pf[m][sp].w[2] = pack2(s[2 * sp + 1][0], s[2 * sp + 1][1]); pf[m][sp].w[3] = pack2(s[2 * sp + 1][2], s[2 * sp + 1][3]);
      }
    }
#pragma unroll
    for (int v = 0; v < 8; ++v)
#pragma unroll
      for (int sp = 0; sp < 2; ++sp) {
        Frag a;
        a.h[0] = *(const uint2*)(Vs + (16 * v + c16) * 72 + 32 * sp + 4 * g);
        a.h[1] = *(const uint2*)(Vs + (16 * v + c16) * 72 + 32 * sp + 16 + 4 * g);
        O[0][v] = MFMA(a.v, pf[0][sp].v, O[0][v]);
        O[1][v] = MFMA(a.v, pf[1][sp].v, O[1][v]);
      }
  }
  float l0 = lsum[0], l1 = lsum[1];
  l0 += __shfl_xor(l0, 16); l0 += __shfl_xor(l0, 32);
  l1 += __shfl_xor(l1, 16); l1 += __shfl_xor(l1, 32);
  const float i0 = 1.f / l0, i1 = lam / l1;
  float ss = 0.f;
#pragma unroll
  for (int v = 0; v < 8; ++v)
#pragma unroll
    for (int r = 0; r < 4; ++r) { float o = O[0][v][r] * i0 - O[1][v][r] * i1; O[0][v][r] = o; ss += o * o; }
  ss += __shfl_xor(ss, 16); ss += __shfl_xor(ss, 32);
  const float rinv = rsqrtf(ss * (1.f / 128.f) + EPSV) * (1.f - lam_init);
  u16* rp = proj + (size_t)qrow * LDP + h * 128;
#pragma unroll
  for (int v = 0; v < 8; ++v) {
    int vc = 16 * v + 4 * g;
    float4 sg = *(const float4*)(p.in[16] + l * 128 + vc);
    uint2 z = *(const uint2*)(rp + PZB + vc);
    float y0 = O[0][v][0] * rinv * sg.x * lo2f(z.x), y1 = O[0][v][1] * rinv * sg.y * hi2f(z.x);
    float y2 = O[0][v][2] * rinv * sg.z * lo2f(z.y), y3 = O[0][v][3] * rinv * sg.w * hi2f(z.y);
    if (!dry) *(uint2*)(rp + PQB + vc) = make_uint2(pack2(y0, y1), pack2(y2, y3));
  }
  __syncthreads();
}

__device__ __forceinline__ void f1_item(const Params& p, int item, char* lds) {
  const int tid = otid(), lane = tid & 63, wid = tid >> 6, wr = wid >> 2, wc = wid & 3, fr = lane & 15, fq = lane >> 4;
  char* ws = p.ws;
  const int jh = item & 1, gq = (item >> 1) & 3, mt = item >> 3;
  f32x4 acc[4][4];
  gemm_kloop<128>((const u16*)(ws + OFF_B1) + jh * 128 * 128, 128, (const u16*)(ws + OFF_PROJ) + (size_t)(mt * 256) * LDP + PUC + gq * 128, LDP, 128, acc, lds);
#pragma unroll
  for (int a = 0; a < 4; ++a)
#pragma unroll
    for (int b = 0; b < 4; ++b) {
      int tokl = wc * 64 + a * 16 + 4 * fq;
      int jj = wr * 64 + b * 16 + fr;
      uint2 pk = make_uint2(pack2(acc[a][b][0], acc[a][b][1]), pack2(acc[a][b][2], acc[a][b][3]));
      if (mt < 32) {
        *(uint2*)(ws + OFF_PTC + ((size_t)((mt * 4 + gq) * 128 + jj) * 512 + jh * 256 + tokl) * 2) = pk;
      } else {
        int rp = (mt - 32) * 256 + tokl; int bb = rp >> 11, t = rp & 2047;
        *(uint2*)(ws + OFF_PTL + ((size_t)((bb * 4 + gq) * 128 + jj) * 4096 + jh * 2048 + t) * 2) = pk;
      }
    }
}

struct F2Epi {
  char* ws; float scl; int rowbase_mul;
  bool lat;
  __device__ __forceinline__ void operator()(f32x4 (&acc)[2][2][4][2], const Unit& u, int wr, int wc, int fr, int fq, LAS unsigned char* lds) const {
    u16* proj = (u16*)(ws + OFF_PROJ);
#pragma unroll
    for (int ai = 0; ai < 2; ++ai)
#pragma unroll
      for (int mh = 0; mh < 2; ++mh) {
        uint2 zv[2][2][2];
#pragma unroll
        for (int mm = 0; mm < 2; ++mm)
#pragma unroll
          for (int bj = 0; bj < 2; ++bj)
#pragma unroll
            for (int n = 0; n < 2; ++n) {
              const int tp = u.x * 256 + ai * 128 + wr * 64 + (mh * 2 + mm) * 16 + fr;
              const int nn = u.y * 256 + bj * 128 + wc * 32 + n * 16 + 4 * fq;
              const int bb = nn >> 9, col = nn & 511;
              const u16* rp = proj + (size_t)(lat ? (NCTX + bb * 2048 + tp) : (bb * 256 + tp)) * LDP;
              zv[mm][bj][n] = *(const uint2*)(rp + PZC + col);
            }
#pragma unroll
        for (int mm = 0; mm < 2; ++mm)
#pragma unroll
          for (int bj = 0; bj < 2; ++bj)
#pragma unroll
            for (int n = 0; n < 2; ++n) {
              const int m = mh * 2 + mm;
              const int tp = u.x * 256 + ai * 128 + wr * 64 + m * 16 + fr;
              const int nn = u.y * 256 + bj * 128 + wc * 32 + n * 16 + 4 * fq;
              const int bb = nn >> 9, col = nn & 511;
              u16* rp = proj + (size_t)(lat ? (NCTX + bb * 2048 + tp) : (bb * 256 + tp)) * LDP;
              const uint2 z = zv[mm][bj][n];
              f32x4 a4 = acc[ai][bj][m][n];
              *(uint2*)(rp + PUC + col) = make_uint2(pack2(a4[0] * scl * lo2f(z.x), a4[1] * scl * hi2f(z.x)),
                                                     pack2(a4[2] * scl * lo2f(z.y), a4[3] * scl * hi2f(z.y)));
            }
      }
  }
};
__device__ __forceinline__ void f2c_item(const Params& p, int item, char* lds) {
  OneUnit S; S.u.a = p.ws + OFF_DC; S.u.b = p.ws + OFF_PTC + (size_t)item * 256 * 1024; S.u.x = 0; S.u.y = item; S.u.lda = 512; S.u.ldb = 512; S.u.nt = 8;
  F2Epi E; E.ws = p.ws; E.scl = 0.005524271728019903f; E.lat = false; E.rowbase_mul = 0;
  gemm_phase((LAS unsigned char*)lds, S, E);
}
struct F2HalfEpi {
  uint2* part;
  __device__ __forceinline__ void operator()(f32x4 (&acc)[2][2][4][2], const Unit& u, int wr, int wc, int fr, int fq, LAS unsigned char* lds) const {
    const int tid = wr * 256 + wc * 64 + fq * 16 + fr;
#pragma unroll
    for (int ai = 0; ai < 2; ++ai)
#pragma unroll
      for (int bj = 0; bj < 2; ++bj)
#pragma unroll
        for (int m = 0; m < 4; ++m)
#pragma unroll
          for (int n = 0; n < 2; ++n) {
            f32x4 a4 = acc[ai][bj][m][n];
            __hip_atomic_store((unsigned long long*)(part + (((ai * 2 + bj) * 4 + m) * 2 + n) * 512 + tid), (unsigned long long)pack2(a4[0], a4[1]) | ((unsigned long long)pack2(a4[2], a4[3]) << 32), __ATOMIC_RELAXED, __HIP_MEMORY_SCOPE_AGENT);
          }
  }
};
__device__ __forceinline__ void f2l_item(const Params& p, int l, int item, char* lds) {
  char* ws = p.ws;
  const int tile = item >> 1, half = item & 1, mt = tile >> 2, nt = tile & 3;
  uint2* pbase = (uint2*)(ws + OFF_F2P);
  {
    OneUnit S; S.u.a = ws + OFF_DL + ((size_t)mt * 256 * 4096 + half * 2048) * 2; S.u.b = ws + OFF_PTL + ((size_t)nt * 256 * 4096 + half * 2048) * 2;
    S.u.x = mt; S.u.y = nt; S.u.lda = 4096; S.u.ldb = 4096; S.u.nt = 32;
    F2HalfEpi E; E.part = pbase + (size_t)(tile * 2 + half) * (32 * 512);
    gemm_phase((LAS unsigned char*)lds, S, E);
  }
  const int t_ = otid();
  volatile int* flag = (volatile int*)(lds + LDS_TILE + 32);
  asm volatile("s_waitcnt vmcnt(0)" ::: "memory");
  __syncthreads();
  if (t_ == 0) {
    unsigned* tk = (unsigned*)(ws + OFF_CNT) + 72 + l * 32 + tile;
    const unsigned old = __hip_atomic_fetch_add(tk, 1u, __ATOMIC_RELAXED, __HIP_MEMORY_SCOPE_AGENT);
    const int last = (old == 1u) ? 1 : 0;
    if (last) { __builtin_amdgcn_fence(__ATOMIC_ACQUIRE, "agent"); asm volatile("s_waitcnt vmcnt(0)" ::: "memory"); }
    *flag = last;
  }
  __syncthreads();
  if (*flag) {
    const int lane = t_ & 63, wid = t_ >> 6, wr = wid >> 2, wc = wid & 3, fr = lane & 15, fq = lane >> 4;
    const uint2* p0 = pbase + (size_t)(tile * 2 + 0) * (32 * 512);
    const uint2* p1 = pbase + (size_t)(tile * 2 + 1) * (32 * 512);
    u16* proj = (u16*)(ws + OFF_PROJ);
    const float scl = 1.f / 512.f;
#pragma unroll
    for (int ai = 0; ai < 2; ++ai)
#pragma unroll
      for (int mh = 0; mh < 2; ++mh) {
        uint2 zv[2][2][2], av[2][2][2], bv2[2][2][2];
#pragma unroll
        for (int mm = 0; mm < 2; ++mm)
#pragma unroll
          for (int bj = 0; bj < 2; ++bj)
#pragma unroll
            for (int n = 0; n < 2; ++n) {
              const int m = mh * 2 + mm;
              const int tp = mt * 256 + ai * 128 + wr * 64 + m * 16 + fr;
              const int nn = nt * 256 + bj * 128 + wc * 32 + n * 16 + 4 * fq;
              const int bb = nn >> 9, col = nn & 511;
              const u16* rp = proj + (size_t)(NCTX + bb * 2048 + tp) * LDP;
              zv[mm][bj][n] = *(const uint2*)(rp + PZC + col);
              const int idx = (((ai * 2 + bj) * 4 + m) * 2 + n) * 512 + t_;
              av[mm][bj][n] = p0[idx]; bv2[mm][bj][n] = p1[idx];
            }
#pragma unroll
        for (int mm = 0; mm < 2; ++mm)
#pragma unroll
          for (int bj = 0; bj < 2; ++bj)
#pragma unroll
            for (int n = 0; n < 2; ++n) {
              const int m = mh * 2 + mm;
              const int tp = mt * 256 + ai * 128 + wr * 64 + m * 16 + fr;
              const int nn = nt * 256 + bj * 128 + wc * 32 + n * 16 + 4 * fq;
              const int bb = nn >> 9, col = nn & 511;
              u16* rp = proj + (size_t)(NCTX + bb * 2048 + tp) * LDP;
              const uint2 z = zv[mm][bj][n], a = av[mm][bj][n], c = bv2[mm][bj][n];
              const float y0 = (lo2f(a.x) + lo2f(c.x)) * scl * lo2f(z.x), y1 = (hi2f(a.x) + hi2f(c.x)) * scl * hi2f(z.x);
              const float y2 = (lo2f(a.y) + lo2f(c.y)) * scl * lo2f(z.y), y3 = (hi2f(a.y) + hi2f(c.y)) * scl * hi2f(z.y);
              *(uint2*)(rp + PUC + col) = make_uint2(pack2(y0, y1), pack2(y2, y3));
            }
      }
  }
  __syncthreads();
}

__device__ __forceinline__ bool xcd_tile(int bid, int& pm, int& pn) {
  const int x = bid & 7, j = bid >> 3;
  if (j >= 24) return false;
  pm = 6 * x + (j >> 2); pn = j & 3;
  return true;
}
struct P5Sched {
  char* ws; int x, j;
  __device__ __forceinline__ bool next(int i, Unit& u) const {
    if (j < 24) {
      if (i >= 5) return false;
      const int pm = 6 * x + (j >> 2), pn = j & 3;
      const int jj = (i < 4) ? (i >> 1) : 2;
      if (i == 0 || i == 2) {
        u.a = ws + OFF_H + (size_t)pm * 256 * 2048; u.b = ws + OFF_WIN + (size_t)(5632 + jj * 1024 + pn * 256) * 2048;
        u.lda = 1024; u.ldb = 1024; u.nt = 16; u.x = pm; u.y = pn | (jj << 8);
      } else {
        const int yc = (jj == 0) ? PQA : ((jj == 1) ? PQB : PUC);
        u.a = ws + OFF_PROJ + ((size_t)pm * 256 * LDP + yc) * 2; u.b = ws + OFF_WBR + ((size_t)jj * 1024 * 512 + (size_t)pn * 256 * 512) * 2;
        u.lda = LDP; u.ldb = 512; u.nt = 8; u.x = pm; u.y = pn | (jj << 8) | ((i == 4) ? 0x2000 : 0x1000);
      }
      return true;
    }
    if (i >= 3) return false;
    const int tj = 3 * (j - 24) + i;
    const int pm = 6 * x + (tj >> 2), pn = tj & 3;
    u.a = ws + OFF_H + (size_t)pm * 256 * 2048; u.b = ws + OFF_WIN + (size_t)(5632 + 2 * 1024 + pn * 256) * 2048;
    u.lda = 1024; u.ldb = 1024; u.nt = 16; u.x = pm; u.y = pn | (2 << 8) | 0x3000;
    return true;
  }
};
struct P5Epi {
  char* ws; u16* mg; unsigned* flags; bool skip;
  __device__ __forceinline__ void operator()(f32x4 (&acc)[2][2][4][2], const Unit& u, int wr, int wc, int fr, int fq, LAS unsigned char* lds) const {
    if (skip) return;
    { const int t_ = otid(); const int w_ = t_ >> 6; wr = w_ >> 2; wc = w_ & 3; fr = t_ & 15; fq = (t_ & 63) >> 4; }
    const int tid = wr * 256 + wc * 64 + fq * 16 + fr;
    const int type = (u.y >> 12) & 3, j = (u.y >> 8) & 3, pn = u.y & 0xff, pm = u.x;
    const int tile = pm * 4 + pn;
    uint2* gs = (uint2*)(ws + OFF_SEGU) + (size_t)tile * (32 * 512);
    u16* g2p = (u16*)(ws + OFF_PROJ) + (size_t)pm * 256 * LDP + PLF + pn * 256;
    if (type == 0) {
#pragma unroll
      for (int ai = 0; ai < 2; ++ai)
#pragma unroll
        for (int bj = 0; bj < 2; ++bj)
#pragma unroll
          for (int m = 0; m < 4; ++m)
#pragma unroll
            for (int n = 0; n < 2; ++n) {
              f32x4 a4 = acc[ai][bj][m][n];
              gs[(((ai * 2 + bj) * 4 + m) * 2 + n) * 512 + tid] = make_uint2(pack2(sigmf(a4[0]), sigmf(a4[1])), pack2(sigmf(a4[2]), sigmf(a4[3])));
            }
      return;
    }
    if (type == 3) {
#pragma unroll
      for (int ai = 0; ai < 2; ++ai)
#pragma unroll
        for (int bj = 0; bj < 2; ++bj)
#pragma unroll
          for (int m = 0; m < 4; ++m)
#pragma unroll
            for (int n = 0; n < 2; ++n) {
              f32x4 a4 = acc[ai][bj][m][n];
              const int row = ai * 128 + wr * 64 + m * 16 + fr, col = bj * 128 + wc * 32 + n * 16 + 4 * fq;
              const unsigned long long v = (unsigned long long)pack2(sigmf(a4[0]), sigmf(a4[1])) | ((unsigned long long)pack2(sigmf(a4[2]), sigmf(a4[3])) << 32);
              __hip_atomic_store((unsigned long long*)(g2p + (size_t)row * LDP + col), v, __ATOMIC_RELAXED, __HIP_MEMORY_SCOPE_AGENT);
            }
      asm volatile("s_waitcnt vmcnt(0)" ::: "memory");
      if ((fq * 16 + fr) == 0) __hip_atomic_fetch_add(flags + tile, 1u, __ATOMIC_RELAXED, __HIP_MEMORY_SCOPE_AGENT);
      return;
    }
    if (type == 2) {
      if (tid == 0) {
        unsigned sp = 0;
        while (__hip_atomic_load(flags + tile, __ATOMIC_RELAXED, __HIP_MEMORY_SCOPE_AGENT) < 8u) { __builtin_amdgcn_s_sleep(2); if (++sp > (1u << 22)) break; }
        __builtin_amdgcn_fence(__ATOMIC_ACQUIRE, "agent");
        asm volatile("s_waitcnt vmcnt(0)" ::: "memory");
      }
      asm volatile("" ::: "memory");
      __builtin_amdgcn_s_barrier();
      asm volatile("" ::: "memory");
    }
#pragma unroll
    for (int ai = 0; ai < 2; ++ai)
#pragma unroll
      for (int mh = 0; mh < 2; ++mh) {
        uint2 gv[2][2][2], pv[2][2][2];
#pragma unroll
        for (int mm = 0; mm < 2; ++mm)
#pragma unroll
          for (int bj = 0; bj < 2; ++bj)
#pragma unroll
            for (int n = 0; n < 2; ++n) {
              const int m = mh * 2 + mm;
              const int rl = ai * 128 + wr * 64 + m * 16 + fr, cl = bj * 128 + wc * 32 + n * 16 + 4 * fq;
              const int row = pm * 256 + rl, col = pn * 256 + cl;
              const uint2* gptr = (type == 2) ? (const uint2*)(g2p + (size_t)rl * LDP + cl) : (const uint2*)(gs + (((ai * 2 + bj) * 4 + m) * 2 + n) * 512 + tid);
              gv[mm][bj][n] = *gptr;
              pv[mm][bj][n] = (j > 0) ? *(const uint2*)(mg + (size_t)row * 1024 + col) : make_uint2(0u, 0u);
            }
#pragma unroll
        for (int mm = 0; mm < 2; ++mm)
#pragma unroll
          for (int bj = 0; bj < 2; ++bj)
#pragma unroll
            for (int n = 0; n < 2; ++n) {
              const int m = mh * 2 + mm;
              const int row = pm * 256 + ai * 128 + wr * 64 + m * 16 + fr;
              const int col = pn * 256 + bj * 128 + wc * 32 + n * 16 + 4 * fq;
              f32x4 a4 = acc[ai][bj][m][n];
              const uint2 g2 = gv[mm][bj][n], p2 = pv[mm][bj][n];
              float t0 = lo2f(g2.x) * a4[0] + lo2f(p2.x), t1 = hi2f(g2.x) * a4[1] + hi2f(p2.x);
              float t2 = lo2f(g2.y) * a4[2] + lo2f(p2.y), t3 = hi2f(g2.y) * a4[3] + hi2f(p2.y);
              *(uint2*)(mg + (size_t)row * 1024 + col) = make_uint2(pack2(t0, t1), pack2(t2, t3));
            }
      }
  }
};
__device__ __forceinline__ void p5_phase(const Params& p, int l, char* lds, bool skip = false) {
  P5Sched S; S.ws = p.ws; S.x = blockIdx.x & 7; S.j = blockIdx.x >> 3;
  if (S.j >= 32) return;
  P5Epi E; E.ws = p.ws; E.mg = (u16*)(p.ws + OFF_MRG); E.flags = (unsigned*)(p.ws + OFF_CNT) + 136 + l * 192; E.skip = skip;
  gemm_phase((LAS unsigned char*)lds, S, E);
}

struct P6Epi {
  const float* xp0; const float* xs0; float* outp; const float* modp; int l;
  __device__ __forceinline__ void operator()(f32x4 (&acc)[2][2][4][2], const Unit& u, int wr, int wc, int fr, int fq, LAS unsigned char* lds) const {
    const int m0 = u.x * 256;
    const int ci = (m0 < NCTX) ? 0 : 1 + ((m0 - NCTX) >> 11);
    const float* xbase = (l == 0) ? ((m0 < NCTX) ? xp0 : xs0 - (size_t)NCTX * 1024) : outp;
    float4 gt[2][2];
#pragma unroll
    for (int bj = 0; bj < 2; ++bj)
#pragma unroll
      for (int n = 0; n < 2; ++n) gt[bj][n] = *(const float4*)(modp + (l * 3 + ci) * 3072 + 2048 + u.y * 256 + bj * 128 + wc * 32 + n * 16 + 4 * fq);
#pragma unroll
    for (int ai = 0; ai < 2; ++ai)
#pragma unroll
      for (int mh = 0; mh < 2; ++mh) {
        float4 xv[2][2][2];
#pragma unroll
        for (int mm = 0; mm < 2; ++mm)
#pragma unroll
          for (int bj = 0; bj < 2; ++bj)
#pragma unroll
            for (int n = 0; n < 2; ++n) {
              const int r = m0 + ai * 128 + wr * 64 + (mh * 2 + mm) * 16 + fr;
              const int col = u.y * 256 + bj * 128 + wc * 32 + n * 16 + 4 * fq;
              xv[mm][bj][n] = *(const float4*)(xbase + (size_t)r * 1024 + col);
            }
#pragma unroll
        for (int mm = 0; mm < 2; ++mm)
#pragma unroll
          for (int bj = 0; bj < 2; ++bj)
#pragma unroll
            for (int n = 0; n < 2; ++n) {
              const int m = mh * 2 + mm;
              const int r = m0 + ai * 128 + wr * 64 + m * 16 + fr;
              const int col = u.y * 256 + bj * 128 + wc * 32 + n * 16 + 4 * fq;
              f32x4 a4 = acc[ai][bj][m][n];
              const float4 x4 = xv[mm][bj][n], g4 = gt[bj][n];
              *(float4*)(outp + (size_t)r * 1024 + col) = make_float4(x4.x + g4.x * a4[0], x4.y + g4.y * a4[1], x4.z + g4.z * a4[2], x4.w + g4.w * a4[3]);
            }
      }
  }
};
__device__ __forceinline__ void p6_phase(const Params& p, int l, char* lds) {
  char* ws = p.ws;
  int pm, pn;
  if (!xcd_tile(blockIdx.x, pm, pn)) return;
  OneUnit S; S.u.a = ws + OFF_MRG + (size_t)pm * 256 * 2048; S.u.b = ws + OFF_WO + (size_t)pn * 256 * 2048; S.u.x = pm; S.u.y = pn;
  S.u.lda = 1024; S.u.ldb = 1024; S.u.nt = 16; S.reps = ((DUP_MASK & 512) && l == 0) ? 5 : 1;
  P6Epi E; E.xp0 = p.in[0]; E.xs0 = p.in[1]; E.outp = p.out; E.modp = (const float*)(ws + OFF_MOD); E.l = l;
  gemm_phase((LAS unsigned char*)lds, S, E);
}

#define XB_TMO      128
#define XB_XCNT(j)  (256  + 64 * (j))
#define XB_XSUB(j)  (1280 + 64 * (j))
#define XB_XGEN(j)  (2304 + 64 * (j))
#define XB_TOP      3328
#define XB_TOPGEN   3392
#define XCD_BAR_WORDS 3456
#define XB_SPIN_CAP (1u << 18)
struct XcdBarrier { unsigned* bar; unsigned x; volatile LAS unsigned* st; };
__device__ __forceinline__ unsigned xb_ld(unsigned* p) { return __hip_atomic_load(p, __ATOMIC_RELAXED, __HIP_MEMORY_SCOPE_AGENT); }
__device__ __forceinline__ unsigned xb_add(unsigned* p, unsigned v) { return __hip_atomic_fetch_add(p, v, __ATOMIC_RELAXED, __HIP_MEMORY_SCOPE_AGENT); }
__device__ __forceinline__ unsigned xb_xcc_id() { return (unsigned)__builtin_amdgcn_s_getreg((3 << 11) | 20) & 0xFu; }
#define XB_SPIN(cond, bar) do { unsigned _sp = 0; while (cond) { __builtin_amdgcn_s_sleep(1); \
    if ((++_sp & 255u) == 0u) { if (xb_ld(&(bar)[XB_TMO])) break; if (_sp > XB_SPIN_CAP) { atomicAdd(&(bar)[XB_TMO], 1u); break; } } } } while (0)
__device__ __forceinline__ XcdBarrier xcd_barrier_post(unsigned* bar, volatile LAS unsigned* st) {
  XcdBarrier b; b.bar = bar; b.x = xb_xcc_id(); b.st = st;
  if (threadIdx.x == 0) (void)xb_add(&bar[XB_XCNT(b.x)], 1u);
  return b;
}
__device__ __forceinline__ void xcd_barrier_complete(unsigned* bar, unsigned x, unsigned& nloc, unsigned& nx) {
  const unsigned G = gridDim.x * gridDim.y * gridDim.z;
  unsigned sum, cnt, mine, sp = 0u;
  for (;;) {
    sum = 0u; cnt = 0u; mine = 0u;
#pragma unroll
    for (unsigned j = 0; j < 16; ++j) { const unsigned c = xb_ld(&bar[XB_XCNT(j)]); sum += c; cnt += (c > 0u) ? 1u : 0u; mine = (j == x) ? c : mine; }
    if (sum == G) break;
    __builtin_amdgcn_s_sleep(1);
    if ((++sp & 255u) == 0u) { if (xb_ld(&bar[XB_TMO])) break; if (sp > XB_SPIN_CAP) { atomicAdd(&bar[XB_TMO], 1u); break; } }
  }
  nloc = mine > 0u ? mine : 1u; nx = cnt > 0u ? cnt : 1u;
}
__device__ __forceinline__ void xcd_barrier(const XcdBarrier& b) {
  asm volatile("s_waitcnt vmcnt(0)" ::: "memory");
  __syncthreads();
  if (threadIdx.x == 0) {
    unsigned* bar = b.bar;
    __builtin_amdgcn_s_waitcnt(0);
    unsigned nloc = b.st[0], nx = b.st[1];
    if (nloc == 0u) { xcd_barrier_complete(bar, b.x, nloc, nx); b.st[0] = nloc; b.st[1] = nx; }
    const unsigned old = xb_add(&bar[XB_XSUB(b.x)], 1u);
    const unsigned gen = old / nloc;
    if (old + 1u == (gen + 1u) * nloc) {
      __builtin_amdgcn_fence(__ATOMIC_RELEASE, "agent");
      asm volatile("s_waitcnt vmcnt(0)" ::: "memory");
      const unsigned og = xb_add(&bar[XB_TOP], 1u);
      const unsigned tg = og / nx;
      if (og + 1u == (tg + 1u) * nx) xb_add(&bar[XB_TOPGEN], 1u);
      else XB_SPIN(xb_ld(&bar[XB_TOPGEN]) == tg, bar);
      __builtin_amdgcn_fence(__ATOMIC_ACQUIRE, "agent");
      xb_add(&bar[XB_XGEN(b.x)], 1u);
      asm volatile("s_waitcnt vmcnt(0)" ::: "memory");
    } else {
      XB_SPIN(xb_ld(&bar[XB_XGEN(b.x)]) == gen, bar);
      __builtin_amdgcn_fence(__ATOMIC_ACQUIRE, "agent");
      asm volatile("s_waitcnt vmcnt(0)" ::: "memory");
    }
  }
  __syncthreads();
}

#define PARGS const float* a0, const float* a1, const float* a2, const float* a3, const float* a4, const float* a5, const float* a6, \
  const float* a7, const float* a8, const float* a9, const float* a10, const float* a11, const float* a12, const float* a13, \
  const float* a14, const float* a15, const float* a16, const float* a17, const float* a18, const float* a19, const float* a20, \
  float* aout, char* aws
#define PFILL Params p; p.in[0]=a0;p.in[1]=a1;p.in[2]=a2;p.in[3]=a3;p.in[4]=a4;p.in[5]=a5;p.in[6]=a6;p.in[7]=a7;p.in[8]=a8;p.in[9]=a9;p.in[10]=a10; \
  p.in[11]=a11;p.in[12]=a12;p.in[13]=a13;p.in[14]=a14;p.in[15]=a15;p.in[16]=a16;p.in[17]=a17;p.in[18]=a18;p.in[19]=a19;p.in[20]=a20;p.out=aout;p.ws=aws;
__global__ void __launch_bounds__(512) fwd_megakernel(PARGS) {
  PFILL
  extern __shared__ __attribute__((aligned(16))) char lds[];
  volatile int& s_item = *(volatile int*)(lds + LDS_TILE);
  cg::grid_group grid = cg::this_grid();
  const int bid = blockIdx.x, G = gridDim.x, tid = threadIdx.x;
  int* cnt = (int*)(p.ws + OFF_CNT);
  volatile LAS unsigned* bst = (volatile LAS unsigned*)(LAS unsigned char*)(lds + LDS_TILE + 16);
  if (tid < 2) bst[tid] = 0u;
  __syncthreads();
  const XcdBarrier xb = xcd_barrier_post((unsigned*)(p.ws + OFF_BAR), bst);
  for (int rep = 0; rep < ((DUP_MASK & 1) ? 2 : 1); ++rep) {
  {
    for (int it = bid; it < 384; it += G) p0_mod16(p, it, lds);
    float2* tab = (float2*)lds;
    for (int m = tid; m < 2048; m += 512) { float sn, cs; sincospif((float)m * (1.f / 1024.f), &sn, &cs); tab[m] = make_float2(cs, sn); }
    __syncthreads();
    for (int it = 224 + bid; it < 224 + 2048; it += G) p0_item(p, it, lds);
    __syncthreads();
    for (int it = 96 + bid; it < P0_ITEMS; it += G) { if (it >= 224 && it < 224 + 2048) continue; p0_item(p, it, lds); }
  }
  if (((const volatile float*)p.in[15])[0] > 1e30f) grid.sync();
  }
  for (int l = 0; l < 2; ++l) {
    {
      bool waited = (l != 0);
      for (int it = bid; it < P1_ITEMS; it += G) {
        if (!waited && it >= 2816) {
          if (tid == 0) {
            unsigned* mc = (unsigned*)(p.ws + OFF_CNT) + 6; unsigned sp = 0;
            while (__hip_atomic_load(mc, __ATOMIC_RELAXED, __HIP_MEMORY_SCOPE_AGENT) < 384u) { __builtin_amdgcn_s_sleep(2); if (++sp > (1u << 22)) break; }
            __builtin_amdgcn_fence(__ATOMIC_ACQUIRE, "agent");
            asm volatile("s_waitcnt vmcnt(0)" ::: "memory");
          }
          __syncthreads();
          waited = true;
        }
        p1_item(p, l, it, lds);
      }
      xcd_barrier(xb);
    }
    if (DUP_MASK & 1024) { const bool opq = (((const volatile float*)p.in[15])[0] < 1e30f); p2_phase(p, l, lds, opq); xcd_barrier(xb); }
    for (int rep = 0; rep < ((DUP_MASK & 4) ? 2 : 1); ++rep) {
    p2_phase(p, l, lds);
    xcd_barrier(xb);
    }
    for (;;) {
      __syncthreads();
      if (tid == 0) s_item = atomicAdd(&cnt[l * 2 + 0], 1);
      __syncthreads();
      int it = s_item;
      constexpr int D3 = (DUP_MASK & 16) ? 256 : 0;
      if (it >= D3 + 32 + 128 + 384 + 256) break;
      if (it >= 32 + 128 + 384 + 256) { hgrn_ctx_item(p, l, (it - 800) & 127, lds, true); continue; }
      if (it < 32) p2_left_item(p, l, 1024 + it, lds);
      else if (it < 160) hgrn_ctx_item(p, l, it - 32, lds);
      else if (it < 416) hgrn_lat1_item(p, l, it - 160, lds);
      else f1_item(p, it - 416, lds);
    }
    xcd_barrier(xb);
    for (;;) {
      __syncthreads();
      if (tid == 0) s_item = atomicAdd(&cnt[l * 2 + 1], 1);
      __syncthreads();
      int it = s_item;
      constexpr int D4a = (DUP_MASK & 32) ? 256 : 0, D4b = (DUP_MASK & 64) ? 256 : 0;
      if (it >= D4a + D4b + 640) break;
      if (it >= 640) { if (DUP_MASK & 32) attn_item(p, l, (it - 640) & 127, true, lds, true); else hgrn_lat2_item(p, l, (it - 640) & 127, lds, true); continue; }
      if (it < 128) attn_item(p, l, it, true, lds);
      else if (it < 192) f2l_item(p, l, it - 128, lds);
      else if (it < 320) hgrn_lat2_item(p, l, it - 192, lds);
      else if (it < 384) f2c_item(p, it - 320, lds);
      else attn_item(p, l, it - 384, false, lds);
    }
    xcd_barrier(xb);
    if (DUP_MASK & 2048) { const bool opq = (((const volatile float*)p.in[15])[0] < 1e30f); p5_phase(p, l, lds, opq); xcd_barrier(xb); }
    for (int rep = 0; rep < ((DUP_MASK & 8) ? 2 : 1); ++rep) {
    p5_phase(p, l, lds);
    xcd_barrier(xb);
    }
    for (int rep = 0; rep < (((DUP_MASK & 256) && l == 0) ? 5 : 1); ++rep) {
    p6_phase(p, l, lds);
    if (l == 0) xcd_barrier(xb);
    }
  }
}

extern "C" void kernel_launch(void* const* d_in, const int* in_sizes, int n_in,
                              void* d_out, int out_size, void* d_ws, size_t ws_size,
                              hipStream_t stream) {
  static int grid_blocks = 0;
  if (!grid_blocks) {
    int dev = 0, cus = 0;
    (void)hipGetDevice(&dev);
    (void)hipDeviceGetAttribute(&cus, hipDeviceAttributeMultiprocessorCount, dev);
    if (hipFuncSetAttribute((const void*)fwd_megakernel, hipFuncAttributeMaxDynamicSharedMemorySize, LDS_BYTES) != hipSuccess)
      fprintf(stderr, "hipFuncSetAttribute failed\n");
    grid_blocks = cus > 0 ? cus : 256;
    if (ws_size < WS_END) fprintf(stderr, "workspace too small: %zu < %zu\n", ws_size, (size_t)WS_END);
  }
  const void* ins[21];
  for (int i = 0; i < 21; ++i) ins[i] = d_in[i];
  void* outp = d_out; void* wsp = d_ws;
  void* args[23];
  for (int i = 0; i < 21; ++i) args[i] = (void*)&ins[i];
  args[21] = (void*)&outp; args[22] = (void*)&wsp;
  (void)hipMemsetAsync((char*)d_ws + OFF_CNT, 0, 4096 + 3456 * 4, stream);
  hipError_t e = hipLaunchCooperativeKernel((void*)fwd_megakernel, dim3(grid_blocks), dim3(512), args, LDS_BYTES, stream);
  if (e != hipSuccess) fprintf(stderr, "cooperative launch failed: %s (grid %d)\n", hipGetErrorString(e), grid_blocks);
}
```

```cpp
#include <hip/hip_runtime.h>
#include <hip/hip_cooperative_groups.h>
#include <stdint.h>
#include <cstdio>
namespace cg = cooperative_groups;

typedef unsigned short u16;
using bf16x8 = __attribute__((ext_vector_type(8))) short;
using f32x4 = __attribute__((ext_vector_type(4))) float;
#define MFMA(a, b, c) __builtin_amdgcn_mfma_f32_16x16x32_bf16(a, b, c, 0, 0, 0)

constexpr int NTOK = 12288;
constexpr int NCTX = 8192;
constexpr int LDP = 5120;
constexpr int PQA = 0, PLF = 512, PIA = 1536, PZA = 2048, PQB = 2560, PKB = 3072, PZB = 3584, PUC = 4096, PZC = 4608;
constexpr float EPSV = 1e-6f;
constexpr size_t OCK = 12582912, OCV = 20971520, OST = 29360128;

constexpr size_t OFF_WIN = 0;
constexpr size_t OFF_WBR = OFF_WIN + 8704ull * 1024 * 2;
constexpr size_t OFF_WO = OFF_WBR + 3ull * 1024 * 512 * 2;
constexpr size_t OFF_H = OFF_WO + 1024ull * 1024 * 2;
constexpr size_t OFF_PROJ = OFF_H + 12288ull * 1024 * 2;
constexpr size_t OFF_R1 = OFF_PROJ + 12288ull * LDP * 2;
constexpr size_t OFF_PTC = OFF_R1;
constexpr size_t OFF_PTL = OFF_R1 + 16384ull * 512 * 2;
constexpr size_t OFF_MRG = OFF_R1;
constexpr size_t OFF_SEGU = OFF_R1 + 25165824ull;
constexpr size_t OFF_SEGD = OFF_SEGU + 256ull * 16384 * 4;
constexpr size_t OFF_VTC = OFF_SEGD + 256ull * 128 * 4;
constexpr size_t OFF_VTL = OFF_VTC + 32ull * 4 * 128 * 256 * 2;
constexpr size_t SZ_VTL = 2ull * 4 * 128 * 2304 * 2;
constexpr size_t OFF_KC = OFF_VTL + 2 * SZ_VTL;
constexpr size_t OFF_DL = OFF_KC + 2ull * 2 * 256 * 512 * 2;
constexpr size_t OFF_DC = OFF_DL + 2048ull * 4096 * 2;
constexpr size_t OFF_B1 = OFF_DC + 256ull * 512 * 2;
constexpr size_t OFF_ROPE = OFF_B1 + 256ull * 128 * 2;
constexpr size_t OFF_MOD = OFF_ROPE + 2048ull * 32 * 8;
constexpr size_t OFF_CNT = OFF_MOD + 2ull * 3 * 3072 * 4;
constexpr size_t OFF_BAR = OFF_CNT + 4096;
constexpr size_t OFF_F2P = OFF_BAR + 3456 * 4 + 192;
constexpr size_t WS_END = OFF_F2P + 32ull * 2 * 32 * 512 * 8;

constexpr int LDS_TILE = 131072 + 8192;
#define DUP_MASK 0
constexpr int LDS_BYTES = LDS_TILE + 64;

struct Params {
  const float* in[21];
  float* out;
  char* ws;
};

typedef __bf16 bf16x2_t __attribute__((ext_vector_type(2)));
typedef float f32x2_t __attribute__((ext_vector_type(2)));
__device__ __forceinline__ uint32_t pack2(float a, float b) {
  f32x2_t v = {a, b};
  bf16x2_t r = __builtin_convertvector(v, bf16x2_t);
  return __builtin_bit_cast(uint32_t, r);
}
__device__ __forceinline__ u16 f2bf(float f) { return (u16)(pack2(f, 0.f) & 0xffffu); }
__device__ __forceinline__ float bf2f(u16 h) { return __uint_as_float(((uint32_t)h) << 16); }
__device__ __forceinline__ float lo2f(uint32_t u) { return __uint_as_float(u << 16); }
__device__ __forceinline__ float hi2f(uint32_t u) { return __uint_as_float(u & 0xffff0000u); }
__device__ __forceinline__ float fexp(float x) { return __builtin_amdgcn_exp2f(x * 1.4426950408889634f); }
__device__ __forceinline__ float frcp(float x) { return __builtin_amdgcn_rcpf(x); }
__device__ __forceinline__ float flog(float x) { return __builtin_amdgcn_logf(x) * 0.6931471805599453f; }
__device__ __forceinline__ float siluf(float x) { return x * frcp(1.f + fexp(-x)); }
__device__ __forceinline__ float sigmf(float x) { return frcp(1.f + fexp(-x)); }
__device__ __forceinline__ float logf_gate(float x, float lb) {
  float xc = fmaxf(x, -80.f);
  float e = fexp(-xc);
  float omf = (1.f - lb) * e * frcp(1.f + e);
  float lf = flog(1.f - omf);
  lf = (lb == 0.f && x < -15.f) ? x : lf;
  return lf;
}
__device__ __forceinline__ float neg_expm1(float lf) {
  return 1.f - fexp(lf);
}
__device__ __forceinline__ int otid() { int t = threadIdx.x; asm volatile("" : "+v"(t)); return t; }

union Frag {
  bf16x8 v;
  uint4 q;
  uint2 h[2];
  uint32_t w[4];
};

__device__ __forceinline__ int lds_byte(int r, int c) {
  int st = (r >> 4) * 2 + (c >> 5), rr = r & 15, cc = c & 31, ob = rr * 64 + cc * 2;
  return st * 1024 + (ob ^ (((ob >> 9) & 1) << 5));
}

template <int TM>
__device__ __forceinline__ void gemm_kloop(const u16* __restrict__ X, int ldx, const u16* __restrict__ Y, int ldy,
                                           int K, f32x4 (&acc)[4][TM / 32], char* lds) {
  constexpr int NX = TM / 64;
  constexpr int XT = TM / 32;
  constexpr int STAGE = TM * 128 + 32768;
  const int tid = otid(), lane = tid & 63, wid = tid >> 6, wr = wid >> 2, wc = wid & 3, fr = lane & 15, fq = lane >> 4;
#pragma unroll
  for (int a = 0; a < 4; ++a)
#pragma unroll
    for (int b = 0; b < XT; ++b) acc[a][b] = f32x4{0.f, 0.f, 0.f, 0.f};
  uint4 xr[NX], yr[4];
  const int nk = K >> 6;
  const int lrow = tid >> 3, lc8 = (tid & 7) * 8;
  const u16* xg = X + (size_t)lrow * ldx + lc8;
  const u16* yg = Y + (size_t)lrow * ldy + lc8;
  const int loff = lds_byte(lrow, lc8);
#pragma unroll
  for (int i = 0; i < NX; ++i) xr[i] = *(const uint4*)(xg + (size_t)(64 * i) * ldx);
#pragma unroll
  for (int i = 0; i < 4; ++i) yr[i] = *(const uint4*)(yg + (size_t)(64 * i) * ldy);
#pragma unroll
  for (int i = 0; i < NX; ++i) *(uint4*)(lds + loff + 8192 * i) = xr[i];
#pragma unroll
  for (int i = 0; i < 4; ++i) *(uint4*)(lds + TM * 128 + loff + 8192 * i) = yr[i];
  __syncthreads();
  for (int kt = 0; kt < nk; ++kt) {
    char* cur = lds + (kt & 1) * STAGE;
    char* nxt = lds + ((kt + 1) & 1) * STAGE;
    const bool more = (kt + 1 < nk);
    if (more) {
#pragma unroll
      for (int i = 0; i < NX; ++i) xr[i] = *(const uint4*)(xg + (size_t)(64 * i) * ldx + (kt + 1) * 64);
#pragma unroll
      for (int i = 0; i < 4; ++i) yr[i] = *(const uint4*)(yg + (size_t)(64 * i) * ldy + (kt + 1) * 64);
    }
#pragma unroll
    for (int ks = 0; ks < 2; ++ks) {
      Frag yf[4], xf[XT];
#pragma unroll
      for (int a = 0; a < 4; ++a) yf[a].q = *(const uint4*)(cur + TM * 128 + lds_byte(wc * 64 + a * 16 + fr, ks * 32 + fq * 8));
#pragma unroll
      for (int b = 0; b < XT; ++b) xf[b].q = *(const uint4*)(cur + lds_byte(wr * (TM / 2) + b * 16 + fr, ks * 32 + fq * 8));
#pragma unroll
      for (int a = 0; a < 4; ++a)
#pragma unroll
        for (int b = 0; b < XT; ++b) acc[a][b] = MFMA(yf[a].v, xf[b].v, acc[a][b]);
    }
    if (more) {
#pragma unroll
      for (int i = 0; i < NX; ++i) *(uint4*)(nxt + loff + 8192 * i) = xr[i];
#pragma unroll
      for (int i = 0; i < 4; ++i) *(uint4*)(nxt + TM * 128 + loff + 8192 * i) = yr[i];
    }
    __syncthreads();
  }
}

#define LAS __attribute__((address_space(3)))
constexpr int HTB = 128 * 64 * 2;
constexpr int G8_STAGE_BYTES = 8 * HTB;
__device__ __forceinline__ void stage_rc(int b, int& R, int& C) {
  const int st = b / 1024, sb = b % 1024, swz = sb ^ (((sb >> 9) & 1) << 5);
  R = (st >> 1) * 16 + swz / 64; C = (st & 1) * 32 + (swz % 64) / 2;
}
struct Unit { const char* a; const char* b; int x; int y; int lda; int ldb; int nt; int perm = 0; };
struct OneUnit {
  Unit u; int reps = 1;
  __device__ __forceinline__ bool next(int i, Unit& o) const { if (i >= reps) return false; o = u; return true; }
};
template <class Epi, class Sched>
__device__ __forceinline__ void gemm_phase(LAS unsigned char* lds, const Sched& S, const Epi& E) {
  const int tid = otid(), wid = __builtin_amdgcn_readfirstlane(tid >> 6), lane = tid & 63, wr = wid >> 2, wc = wid & 3, fr = lane & 15, fq = lane >> 4;
  int sR[2], sC[2];
#pragma unroll
  for (int i = 0; i < 2; ++i) stage_rc(tid * 16 + i * 8192, sR[i], sC[i]);
  int sRp[2];
#pragma unroll
  for (int i = 0; i < 2; ++i) { const int rho = sR[i] & 31, n_ = rho >> 4, i_ = rho & 15; sRp[i] = (sR[i] & ~31) + 8 * (i_ >> 2) + 4 * n_ + (i_ & 3); }
  const size_t kstep = 128;
  const unsigned ldsw = (unsigned)wid * 1024u;
  const int aoff = lds_byte(wr * 64 + fr, fq * 8), boff = lds_byte(wc * 32 + fr, fq * 8);
#define G8_SA(b, h) (((b) * 2 + (h)) * HTB)
#define G8_SB(b, h) ((4 + (b) * 2 + (h)) * HTB)
#define G8_STAGE(bufoff, gbase, voff) do { _Pragma("unroll") for (int _i = 0; _i < 2; ++_i) \
    __builtin_amdgcn_global_load_lds((const unsigned*)((const char*)(gbase) + (voff)[_i]), (LAS unsigned*)(lds + (bufoff) + ldsw + _i * 8192), 16, 0, 0); } while (0)
#define G8_LDA(dst, b, h) do { _Pragma("unroll") for (int m = 0; m < 4; ++m) _Pragma("unroll") for (int k = 0; k < 2; ++k) dst[m][k] = *(const LAS bf16x8*)(lds + G8_SA(b, h) + aoff + m * 2048 + k * 1024); } while (0)
#define G8_LDB(dst, b, h) do { _Pragma("unroll") for (int n = 0; n < 2; ++n) _Pragma("unroll") for (int k = 0; k < 2; ++k) dst[n][k] = *(const LAS bf16x8*)(lds + G8_SB(b, h) + boff + n * 2048 + k * 1024); } while (0)
#define G8_MMA(ai, bj, At, Bt) do { __builtin_amdgcn_s_setprio(1); _Pragma("unroll") for (int m = 0; m < 4; ++m) _Pragma("unroll") for (int n = 0; n < 2; ++n) _Pragma("unroll") for (int k = 0; k < 2; ++k) \
    acc[ai][bj][m][n] = __builtin_amdgcn_mfma_f32_16x16x32_bf16(Bt[n][k], At[m][k], acc[ai][bj][m][n], 0, 0, 0); __builtin_amdgcn_s_setprio(0); } while (0)
#define G8_WAIT_V(n) asm volatile("s_waitcnt vmcnt(" #n ")" ::: "memory")
#define G8_WAIT_L(n) asm volatile("s_waitcnt lgkmcnt(" #n ")" ::: "memory")
#define G8_BAR __builtin_amdgcn_s_barrier()
#define G8_SCHED __builtin_amdgcn_sched_barrier(0)
  Unit cur, nxt; int ui = 0;
  if (!S.next(0, cur)) return;
  f32x4 acc[2][2][4][2];
#pragma unroll
  for (int a = 0; a < 2; ++a)
#pragma unroll
    for (int b = 0; b < 2; ++b)
#pragma unroll
      for (int m = 0; m < 4; ++m)
#pragma unroll
        for (int n = 0; n < 2; ++n) acc[a][b][m][n] = f32x4{0.f, 0.f, 0.f, 0.f};
  bf16x8 At[4][2], B0[2][2], B1[2][2];
  const char* cA = cur.a; const char* cB = cur.b;
  unsigned voffA[2], voffB[2];
#pragma unroll
  for (int i = 0; i < 2; ++i) { voffA[i] = (unsigned)(sR[i] * cur.lda + sC[i]) * 2u; voffB[i] = (unsigned)((cur.perm ? sRp[i] : sR[i]) * cur.ldb + sC[i]) * 2u; }
  size_t hstepA = (size_t)128 * cur.lda * 2, hstepB = (size_t)128 * cur.ldb * 2;
  G8_STAGE(G8_SB(0, 0), cB, voffB); G8_STAGE(G8_SA(0, 0), cA, voffA); G8_STAGE(G8_SB(0, 1), cB + hstepB, voffB); G8_STAGE(G8_SA(0, 1), cA + hstepA, voffA);
  if (wr == 1) G8_BAR;
  G8_WAIT_V(4); G8_BAR;
  G8_STAGE(G8_SB(1, 0), cB + kstep, voffB); G8_STAGE(G8_SA(1, 0), cA + kstep, voffA); G8_STAGE(G8_SB(1, 1), cB + hstepB + kstep, voffB);
  G8_WAIT_V(6); G8_BAR;
  for (;;) {
    const bool has_next = S.next(ui + 1, nxt);
    if (!has_next) nxt = cur;
    const char* nA = nxt.a; const char* nB = nxt.b;
    unsigned voffAn[2], voffBn[2];
#pragma unroll
    for (int i = 0; i < 2; ++i) { voffAn[i] = (unsigned)(sR[i] * nxt.lda + sC[i]) * 2u; voffBn[i] = (unsigned)((nxt.perm ? sRp[i] : sR[i]) * nxt.ldb + sC[i]) * 2u; }
    const size_t hstepAn = (size_t)128 * nxt.lda * 2, hstepBn = (size_t)128 * nxt.ldb * 2;
    const int nt = cur.nt;
    for (int t = 0; t < nt; t += 2) {
      const bool last = (t == nt - 2);
      const char* a1 = cA + (size_t)(t + 1) * kstep;
      const char* a2 = last ? nA : cA + (size_t)(t + 2) * kstep; const char* b2 = last ? nB : cB + (size_t)(t + 2) * kstep;
      const char* a3 = a2 + kstep; const char* b3 = b2 + kstep;
      unsigned vA2[2], vB2[2];
#pragma unroll
      for (int i = 0; i < 2; ++i) { vA2[i] = last ? voffAn[i] : voffA[i]; vB2[i] = last ? voffBn[i] : voffB[i]; }
      const size_t hA2 = last ? hstepAn : hstepA, hB2 = last ? hstepBn : hstepB;
      G8_LDB(B0, 0, 0); G8_SCHED; G8_LDA(At, 0, 0); G8_STAGE(G8_SA(1, 1), a1 + hstepA, voffA);
      G8_WAIT_L(8); G8_BAR; G8_WAIT_L(0); G8_MMA(0, 0, At, B0); G8_BAR; G8_SCHED;
      G8_LDB(B1, 0, 1); G8_STAGE(G8_SB(0, 0), b2, vB2);
      G8_BAR; G8_WAIT_L(0); G8_MMA(0, 1, At, B1); G8_BAR;
      G8_LDA(At, 0, 1); G8_STAGE(G8_SA(0, 0), a2, vA2);
      G8_BAR; G8_WAIT_L(0); G8_MMA(1, 0, At, B0); G8_BAR; G8_SCHED;
      G8_STAGE(G8_SB(0, 1), b2 + hB2, vB2);
      G8_WAIT_V(6); G8_BAR; G8_MMA(1, 1, At, B1); G8_BAR;
      G8_LDB(B0, 1, 0); G8_SCHED; G8_LDA(At, 1, 0); G8_STAGE(G8_SA(0, 1), a2 + hA2, vA2);
      G8_WAIT_L(8); G8_BAR; G8_WAIT_L(0); G8_MMA(0, 0, At, B0); G8_BAR; G8_SCHED;
      G8_LDB(B1, 1, 1); G8_STAGE(G8_SB(1, 0), b3, vB2);
      G8_BAR; G8_WAIT_L(0); G8_MMA(0, 1, At, B1); G8_BAR;
      G8_LDA(At, 1, 1); G8_STAGE(G8_SA(1, 0), a3, vA2);
      G8_BAR; G8_WAIT_L(0); G8_MMA(1, 0, At, B0); G8_BAR; G8_SCHED;
      G8_STAGE(G8_SB(1, 1), b3 + hB2, vB2);
      G8_WAIT_V(6); G8_BAR; G8_MMA(1, 1, At, B1); G8_BAR;
    }
    E(acc, cur, wr, wc, fr, fq, lds);
    if (!has_next) break;
#pragma unroll
    for (int a = 0; a < 2; ++a)
#pragma unroll
      for (int b = 0; b < 2; ++b)
#pragma unroll
        for (int m = 0; m < 4; ++m)
#pragma unroll
          for (int n = 0; n < 2; ++n) acc[a][b][m][n] = f32x4{0.f, 0.f, 0.f, 0.f};
    cur = nxt; cA = nA; cB = nB; ++ui;
#pragma unroll
    for (int i = 0; i < 2; ++i) { voffA[i] = voffAn[i]; voffB[i] = voffBn[i]; }
    hstepA = hstepAn; hstepB = hstepBn;
  }
  G8_WAIT_V(0);
  if (wr == 0) G8_BAR;
  G8_BAR;
}

__device__ __forceinline__ void p0_mod16(const Params& p, int item, char* lds) {
  const int tid = otid();
  float* sc = (float*)lds;
  float* red = sc + 3072;
  const int l = item / 192, cgp = item % 192;
  const float* cctx = p.in[6]; const float* cc2 = p.in[2];
  for (int i = tid; i < 3072; i += 512) {
    int j = i >> 10, k = i & 1023;
    float c = (j == 0) ? cctx[k] : cc2[(j > 0 ? j - 1 : 0) * 1024 + k];
    sc[i] = c / (1.f + expf(-c));
  }
  __syncthreads();
  const int col = tid & 15, kg = tid >> 4;
  const float* W = p.in[7] + (size_t)l * 1024 * 3072 + cgp * 16 + col;
  float a0 = 0.f, a1 = 0.f, a2 = 0.f;
#pragma unroll 8
  for (int k = kg * 32; k < kg * 32 + 32; ++k) {
    float w = W[(size_t)k * 3072];
    a0 += sc[k] * w; a1 += sc[1024 + k] * w; a2 += sc[2048 + k] * w;
  }
  red[(kg * 3 + 0) * 16 + col] = a0; red[(kg * 3 + 1) * 16 + col] = a1; red[(kg * 3 + 2) * 16 + col] = a2;
  __syncthreads();
  if (tid < 48) {
    const int j = tid >> 4; float s_ = 0.f;
    for (int g = 0; g < 32; ++g) s_ += red[(g * 3 + j) * 16 + col];
    const int n = cgp * 16 + col;
    __hip_atomic_store((float*)(p.ws + OFF_MOD) + (l * 3 + j) * 3072 + n, s_ + p.in[8][l * 3072 + n], __ATOMIC_RELAXED, __HIP_MEMORY_SCOPE_AGENT);
  }
  if (tid < 64) {
    asm volatile("s_waitcnt vmcnt(0)" ::: "memory");
    if (tid == 0) __hip_atomic_fetch_add((unsigned*)(p.ws + OFF_CNT) + 6, 1u, __ATOMIC_RELAXED, __HIP_MEMORY_SCOPE_AGENT);
  }
  __syncthreads();
}

__device__ __forceinline__ void p0_item(const Params& p, int item, char* lds) {
  const int tid = otid();
  char* ws = p.ws;
  if (item < 96) {
    float* sc = (float*)lds;
    float* red = sc + 3072;
    const int l = item / 48, cgp = item % 48;
    const float* cctx = p.in[6]; const float* cc2 = p.in[2];
    for (int i = tid; i < 3072; i += 512) {
      int j = i >> 10, k = i & 1023;
      float c = (j == 0) ? cctx[k] : cc2[(j > 0 ? j - 1 : 0) * 1024 + k];
      sc[i] = siluf(c);
    }
    __syncthreads();
    const int col = tid & 63, kg = tid >> 6;
    const float* W = p.in[7] + (size_t)l * 1024 * 3072 + cgp * 64 + col;
    float a0 = 0.f, a1 = 0.f, a2 = 0.f;
    for (int k = kg * 128; k < kg * 128 + 128; ++k) {
      float w = W[(size_t)k * 3072];
      a0 += sc[k] * w; a1 += sc[1024 + k] * w; a2 += sc[2048 + k] * w;
    }
    red[(kg * 3 + 0) * 64 + col] = a0; red[(kg * 3 + 1) * 64 + col] = a1; red[(kg * 3 + 2) * 64 + col] = a2;
    __syncthreads();
    if (tid < 192) {
      int j = tid >> 6; float s = 0.f;
      for (int g = 0; g < 8; ++g) s += red[(g * 3 + j) * 64 + col];
      int n = cgp * 64 + col;
      ((float*)(ws + OFF_MOD))[(l * 3 + j) * 3072 + n] = s + p.in[8][l * 3072 + n];
    }
    __syncthreads();
    return;
  }
  item -= 96;
  if (item < 128) {
    int idx = item * 512 + tid, t = idx >> 5, c = idx & 31, fi = c & 15;
    float pos = (c < 16) ? (float)(t >> 6) : (float)(t & 63);
    float inv = powf(10000.f, -(float)fi / 16.f);
    float ang = pos * inv;
    ((float2*)(ws + OFF_ROPE))[idx] = make_float2(cosf(ang), sinf(ang));
    return;
  }
  item -= 128;
  if (item < 2048) {
    const float2* tab = (const float2*)lds;
    int idx = item * 512 + tid, tp = idx >> 9, k0 = (idx & 511) * 8;
    uint32_t o[4];
    float vv[8];
#pragma unroll
    for (int j = 0; j < 8; ++j) {
      int k = k0 + j; int m = (tp * (k & 2047)) & 2047;
      float2 cs = tab[m];
      vv[j] = (k < 2048) ? cs.x : -cs.y;
    }
#pragma unroll
    for (int j = 0; j < 4; ++j) o[j] = pack2(vv[2 * j], vv[2 * j + 1]);
    *(uint4*)(ws + OFF_DL + (size_t)idx * 16) = make_uint4(o[0], o[1], o[2], o[3]);
    return;
  }
  item -= 2048;
  if (item < 32) {
    int idx = item * 512 + tid, tp = idx >> 6, k0 = (idx & 63) * 8;
    uint32_t o[4];
    float vv[8];
#pragma unroll
    for (int j = 0; j < 8; ++j) {
      int k = k0 + j; int m = (tp * (k & 255)) & 255; float s, c;
      sincospif((float)m * (1.f / 128.f), &s, &c);
      vv[j] = (k < 256) ? c : -s;
    }
#pragma unroll
    for (int j = 0; j < 4; ++j) o[j] = pack2(vv[2 * j], vv[2 * j + 1]);
    *(uint4*)(ws + OFF_DC + (size_t)idx * 16) = make_uint4(o[0], o[1], o[2], o[3]);
    return;
  }
  item -= 32;
  if (item < 8) {
    int idx = item * 512 + tid, j = idx >> 4, c0 = (idx & 15) * 8;
    uint32_t o[4];
    float vv[8];
#pragma unroll
    for (int q = 0; q < 8; ++q) {
      int m = ((j & 127) * (c0 + q)) & 127; float s, c;
      sincospif((float)m * (1.f / 64.f), &s, &c);
      vv[q] = (j < 128) ? c : s;
    }
#pragma unroll
    for (int q = 0; q < 4; ++q) o[q] = pack2(vv[2 * q], vv[2 * q + 1]);
    *(uint4*)(ws + OFF_B1 + (size_t)idx * 16) = make_uint4(o[0], o[1], o[2], o[3]);
    return;
  }
  item -= 8;
  if (item < 128) {
    int idx = item * 512 + tid; int e = idx * 8;
    int n = e & 511, t = (e >> 9) & 255, l = (e >> 17) & 1, b = e >> 18;
    const float4* s = (const float4*)(p.in[3] + e);
    float4 a = s[0], c = s[1];
    size_t d = ((size_t)((l * 2 + b) * 256 + t)) * 512 + n;
    *(uint4*)(ws + OFF_KC + d * 2) = make_uint4(pack2(a.x, a.y), pack2(a.z, a.w), pack2(c.x, c.y), pack2(c.z, c.w));
    return;
  }
  item -= 128;
  {
    int idx = item * 512 + tid;
    int v = idx & 127, tc = (idx >> 7) & 31, h = (idx >> 12) & 3, b = (idx >> 14) & 1, l = idx >> 15;
    float vv[8];
#pragma unroll
    for (int j = 0; j < 8; ++j) vv[j] = p.in[4][((size_t)((b * 2 + l) * 256 + tc * 8 + j)) * 512 + h * 128 + v];
    size_t d = ((size_t)((b * 4 + h) * 128 + v)) * 2304 + 2048 + tc * 8;
    *(uint4*)(ws + OFF_VTL + l * SZ_VTL + d * 2) = make_uint4(pack2(vv[0], vv[1]), pack2(vv[2], vv[3]), pack2(vv[4], vv[5]), pack2(vv[6], vv[7]));
  }
}
constexpr int P0_ITEMS = 96 + 128 + 2048 + 32 + 8 + 128 + 128;

__device__ __forceinline__ void p1_item(const Params& p, int l, int item, char* lds) {
  const int tid = otid();
  char* ws = p.ws;
  if (item < 2816) {
    const float* src; int lsrc; u16* dst; int ldd; int kt, nt;
    const float* w10 = p.in[10]; const float* w17 = p.in[17]; const float* w18 = p.in[18]; const float* w19 = p.in[19]; const float* w20 = p.in[20];
    if (item < 2176) { src = w10 + (size_t)l * 1024 * 8704; lsrc = 8704; dst = (u16*)(ws + OFF_WIN); ldd = 1024; nt = item >> 4; kt = item & 15; }
    else if (item < 2560) { int r = item - 2176; int j = r >> 7; r &= 127; src = ((j == 0) ? w17 : ((j == 1) ? w18 : w19)) + (size_t)l * 512 * 1024; lsrc = 1024; dst = (u16*)(ws + OFF_WBR) + (size_t)j * 1024 * 512; ldd = 512; nt = r >> 3; kt = r & 7; }
    else { int r = item - 2560; src = w20 + (size_t)l * 1024 * 1024; lsrc = 1024; dst = (u16*)(ws + OFF_WO); ldd = 1024; nt = r >> 4; kt = r & 15; }
    u16* T = (u16*)lds;
    const int k0 = kt * 64, n0 = nt * 64;
#pragma unroll
    for (int ps = 0; ps < 2; ++ps) {
      int kr = (tid >> 4) + 32 * ps, nq = tid & 15;
      float4 v = *(const float4*)(src + (size_t)(k0 + kr) * lsrc + n0 + 4 * nq);
      T[(4 * nq + 0) * 72 + kr] = f2bf(v.x); T[(4 * nq + 1) * 72 + kr] = f2bf(v.y);
      T[(4 * nq + 2) * 72 + kr] = f2bf(v.z); T[(4 * nq + 3) * 72 + kr] = f2bf(v.w);
    }
    __syncthreads();
    {
      int n = tid >> 3, kc = tid & 7;
      uint4 o = *(const uint4*)(T + n * 72 + kc * 8);
      *(uint4*)(dst + (size_t)(n0 + n) * ldd + k0 + kc * 8) = o;
    }
    __syncthreads();
    return;
  }
  item -= 2816;
  const int lane = tid & 63, wid = tid >> 6;
  const float* modp = (const float*)(ws + OFF_MOD);
  u16* H = (u16*)(ws + OFF_H);
  const float* xin0 = p.in[0]; const float* xin1 = p.in[1]; const float* xin2 = p.out; const float* ng = p.in[9];
#pragma unroll
  for (int rr = 0; rr < 2; ++rr) {
    int r = item * 16 + wid * 2 + rr;
    const float* x = (l == 0) ? ((r < NCTX) ? xin0 + (size_t)r * 1024 : xin1 + (size_t)(r - NCTX) * 1024) : xin2 + (size_t)r * 1024;
    int ci = (r < NCTX) ? 0 : 1 + ((r - NCTX) >> 11);
    float4 v[4]; float ss = 0.f;
#pragma unroll
    for (int i = 0; i < 4; ++i) { v[i] = *(const float4*)(x + lane * 4 + 256 * i); ss += v[i].x * v[i].x + v[i].y * v[i].y + v[i].z * v[i].z + v[i].w * v[i].w; }
#pragma unroll
    for (int o = 32; o >= 1; o >>= 1) ss += __shfl_xor(ss, o);
    float rinv = rsqrtf(ss * (1.f / 1024.f) + EPSV);
    const float* sh = modp + (l * 3 + ci) * 3072;
#pragma unroll
    for (int i = 0; i < 4; ++i) {
      int col = lane * 4 + 256 * i;
      float4 g = *(const float4*)(ng + l * 1024 + col);
      float4 s1 = *(const float4*)(sh + 1024 + col);
      float4 s0 = *(const float4*)(sh + col);
      float a = v[i].x * rinv * g.x * (1.f + s1.x) + s0.x;
      float b = v[i].y * rinv * g.y * (1.f + s1.y) + s0.y;
      float c = v[i].z * rinv * g.z * (1.f + s1.z) + s0.z;
      float d = v[i].w * rinv * g.w * (1.f + s1.w) + s0.w;
      *(uint2*)(H + (size_t)r * 1024 + col) = make_uint2(pack2(a, b), pack2(c, d));
    }
  }
}
constexpr int P1_ITEMS = 2816 + 768;

__device__ __forceinline__ void stagger_us(int us) {
  const unsigned long long t0 = __builtin_amdgcn_s_memrealtime();
  while (__builtin_amdgcn_s_memrealtime() - t0 < (unsigned long long)us * 100ull) __builtin_amdgcn_s_sleep(8);
}
#define STAGGER_US 0
struct P2Sched {
  const char* H; const char* W; int G, c;
  __device__ __forceinline__ bool next(int i, Unit& u) const {
    const int L = i * G + c;
    if (L >= 1024) return false;
    if (L < 960) {
      const int nM = 48, nN = 20, nwg = 960;
      int wgid = L; { const int q = nwg / 8, xcd = wgid % 8, off = wgid / 8; wgid = xcd * q + off; }
      const int nig = 8 * nN, gid = wgid / nig, fm = gid * 8, gsz = (nM - fm) < 8 ? (nM - fm) : 8;
      int pm = fm + ((wgid % nig) % gsz), pn = (wgid % nig) / gsz;
      if (pn >= 14) pn += 2;
      u.a = H + (size_t)pm * 256 * 2048; u.b = W + (size_t)pn * 256 * 2048; u.x = pm; u.y = pn;
      u.lda = 1024; u.ldb = 1024; u.nt = 16; u.perm = ((pn >> 1) == 5 || (pn >> 1) == 6) ? 0 : 1;
    } else {
      const int r = L - 960; const int vq = r / 48, mt = r % 48;
      u.a = W + (size_t)(3584 + vq * 256) * 2048; u.b = H + (size_t)mt * 256 * 2048; u.x = vq; u.y = mt | 0x100;
      u.lda = 1024; u.ldb = 1024; u.nt = 16; u.perm = 0;
    }
    return true;
  }
};
struct P2Epi {
  const float* const* pin; float* out; char* ws; int l;
  const float* hlb; const float* qng; const float* kng; bool skip;
  __device__ __forceinline__ void operator()(f32x4 (&acc)[2][2][4][2], const Unit& u, int wr, int wc, int fr, int fq, LAS unsigned char* lds) const {
    if (skip) return;
    { const int t_ = otid(); const int w_ = t_ >> 6; wr = w_ >> 2; wc = w_ & 3; fr = t_ & 15; fq = (t_ & 63) >> 4; }
    if (u.y & 0x100) {
      const int mt = u.y & 0xff, vq = u.x;
#pragma unroll
      for (int ai = 0; ai < 2; ++ai)
#pragma unroll
        for (int m = 0; m < 4; ++m) {
          const int nn = vq * 256 + ai * 128 + wr * 64 + m * 16 + fr;
          const int hh = nn >> 7, v = nn & 127;
#pragma unroll
          for (int bj = 0; bj < 2; ++bj)
#pragma unroll
            for (int n = 0; n < 2; ++n) {
              const int tokl = bj * 128 + wc * 32 + n * 16 + 4 * fq;
              f32x4 a4 = acc[ai][bj][m][n];
              uint2 pk = make_uint2(pack2(a4[0], a4[1]), pack2(a4[2], a4[3]));
              if (mt < 32) {
                *(uint2*)(ws + OFF_VTC + ((size_t)((mt * 4 + hh) * 128 + v) * 256 + tokl) * 2) = pk;
                float* o = out + OCV + ((size_t)((mt * 2 + l) * 256 + tokl)) * 512 + nn;
                o[0] = a4[0]; o[512] = a4[1]; o[1024] = a4[2]; o[1536] = a4[3];
              } else {
                int rp = (mt - 32) * 256 + tokl; int bb = rp >> 11, t = rp & 2047;
                *(uint2*)(ws + OFF_VTL + l * SZ_VTL + ((size_t)((bb * 4 + hh) * 128 + v) * 2304 + t) * 2) = pk;
              }
            }
        }
      return;
    }
    const int pm = u.x, pn = u.y, seg = pn >> 1, ncol0 = (pn & 1) * 256;
    const int dcol0 = ((seg < 7) ? seg : seg - 1) * 512 + ncol0;
    u16* proj = (u16*)(ws + OFF_PROJ);
    const bool lat = (pm >= 32);
    if (seg == 5 || seg == 6) {
      float* xch = (float*)(lds + G8_STAGE_BYTES);
#pragma unroll
      for (int ai = 0; ai < 2; ++ai)
#pragma unroll
        for (int m = 0; m < 4; ++m)
#pragma unroll
          for (int bj = 0; bj < 2; ++bj) {
            float ss = 0.f;
#pragma unroll
            for (int n = 0; n < 2; ++n)
#pragma unroll
              for (int e = 0; e < 4; ++e) { float bfv = bf2f(f2bf(acc[ai][bj][m][n][e])); ss += bfv * bfv; }
            ss += __shfl_xor(ss, 16); ss += __shfl_xor(ss, 32);
            if (fq == 0) xch[((ai * 128 + wr * 64 + m * 16 + fr) * 2 + bj) * 4 + wc] = ss;
          }
      asm volatile("s_waitcnt lgkmcnt(0)" ::: "memory");
      __builtin_amdgcn_s_barrier();
      asm volatile("" ::: "memory");
      const float* gsel = (seg == 5) ? qng : kng;
      float gv[2][4];
#pragma unroll
      for (int n = 0; n < 2; ++n)
#pragma unroll
        for (int e = 0; e < 4; ++e) gv[n][e] = gsel[l * 64 + 32 * (wc & 1) + 16 * n + 4 * fq + e];
#pragma unroll
      for (int ai = 0; ai < 2; ++ai)
#pragma unroll
        for (int m = 0; m < 4; ++m) {
          const int rl = ai * 128 + wr * 64 + m * 16 + fr;
          const int grow = pm * 256 + rl;
#pragma unroll
          for (int bj = 0; bj < 2; ++bj) {
            const float2 pr = *(const float2*)&xch[(rl * 2 + bj) * 4 + (wc & 2)];
            const float tot = pr.x + pr.y;
            const float rinv = rsqrtf(tot * (1.f / 64.f) + EPSV);
            float x[2][4];
#pragma unroll
            for (int n = 0; n < 2; ++n)
#pragma unroll
              for (int e = 0; e < 4; ++e) x[n][e] = bf2f(f2bf(acc[ai][bj][m][n][e])) * rinv * gv[n][e];
            const int colt = ncol0 + bj * 128 + wc * 32;
            if (seg == 6 && !lat) {
              float* o = out + OCK + ((size_t)((pm * 2 + l) * 256 + rl)) * 512 + colt + 4 * fq;
              *(float4*)o = make_float4(x[0][0], x[0][1], x[0][2], x[0][3]);
              *(float4*)(o + 16) = make_float4(x[1][0], x[1][1], x[1][2], x[1][3]);
            }
            if (lat) {
              const int t = (grow - NCTX) & 2047;
              const float2* rt = (const float2*)(ws + OFF_ROPE) + t * 32 + ((wc & 1) ? 16 : 0) + 4 * fq;
#pragma unroll
              for (int e = 0; e < 4; ++e) {
                float2 cs = rt[e];
                float x1 = x[0][e], x2 = x[1][e];
                x[0][e] = x1 * cs.x - x2 * cs.y;
                x[1][e] = x1 * cs.y + x2 * cs.x;
              }
            }
            if (seg == 5) {
#pragma unroll
              for (int n = 0; n < 2; ++n)
#pragma unroll
                for (int e = 0; e < 4; ++e) x[n][e] *= 0.125f;
            }
            u16* dp = proj + (size_t)grow * LDP + dcol0 + bj * 128 + wc * 32 + 4 * fq;
            *(uint2*)dp = make_uint2(pack2(x[0][0], x[0][1]), pack2(x[0][2], x[0][3]));
            *(uint2*)(dp + 16) = make_uint2(pack2(x[1][0], x[1][1]), pack2(x[1][2], x[1][3]));
          }
        }
      return;
    }
    const bool dosilu = (seg == 0 || seg == 4 || seg == 8 || seg == 10);
    const bool dolf = (seg == 1 || seg == 2);
    const int dir = (seg == 2) ? 1 : 0;
#define P2_STORE16(A0, A1) *(uint4*)(proj + (size_t)grow * LDP + dcol0 + bj * 128 + wc * 32 + 8 * fq) = make_uint4(pack2(A0[0], A0[1]), pack2(A0[2], A0[3]), pack2(A1[0], A1[1]), pack2(A1[2], A1[3]))
    if (dosilu) {
#pragma unroll
      for (int ai = 0; ai < 2; ++ai)
#pragma unroll
        for (int m = 0; m < 4; ++m) {
          const int grow = pm * 256 + ai * 128 + wr * 64 + m * 16 + fr;
#pragma unroll
          for (int bj = 0; bj < 2; ++bj) {
            f32x4 a0 = acc[ai][bj][m][0], a1 = acc[ai][bj][m][1];
#pragma unroll
            for (int e = 0; e < 4; ++e) { a0[e] = siluf(a0[e]); a1[e] = siluf(a1[e]); }
            P2_STORE16(a0, a1);
          }
        }
    } else if (dolf) {
#pragma unroll
      for (int bj = 0; bj < 2; ++bj) {
        float lbv[2][4];
#pragma unroll
        for (int n = 0; n < 2; ++n)
#pragma unroll
          for (int e = 0; e < 4; ++e) {
            int j = ncol0 + bj * 128 + wc * 32 + 8 * fq + 4 * n + e;
            lbv[n][e] = (l == 0) ? 0.f : sigmf(hlb[(1 * 2 + dir) * 512 + j] - hlb[(0 * 2 + dir) * 512 + j]);
          }
#pragma unroll
        for (int ai = 0; ai < 2; ++ai)
#pragma unroll
          for (int m = 0; m < 4; ++m) {
            const int grow = pm * 256 + ai * 128 + wr * 64 + m * 16 + fr;
            f32x4 a0 = acc[ai][bj][m][0], a1 = acc[ai][bj][m][1];
#pragma unroll
            for (int e = 0; e < 4; ++e) { a0[e] = logf_gate(a0[e], lbv[0][e]); a1[e] = logf_gate(a1[e], lbv[1][e]); }
            P2_STORE16(a0, a1);
          }
      }
    } else {
#pragma unroll
      for (int ai = 0; ai < 2; ++ai)
#pragma unroll
        for (int m = 0; m < 4; ++m) {
          const int grow = pm * 256 + ai * 128 + wr * 64 + m * 16 + fr;
#pragma unroll
          for (int bj = 0; bj < 2; ++bj) {
            f32x4 a0 = acc[ai][bj][m][0], a1 = acc[ai][bj][m][1];
            P2_STORE16(a0, a1);
          }
        }
    }
  }
};
__device__ __forceinline__ void p2_left_item(const Params& p, int l, int L, char* lds) {
  P2Sched S0; S0.H = p.ws + OFF_H; S0.W = p.ws + OFF_WIN; S0.G = 0x40000000; S0.c = 0;
  OneUnit S;
  {
    const int r = L - 960; const int vq = r / 48, mt = r % 48;
    S.u.a = S0.W + (size_t)(3584 + vq * 256) * 2048; S.u.b = S0.H + (size_t)mt * 256 * 2048; S.u.x = vq; S.u.y = mt | 0x100;
    S.u.lda = 1024; S.u.ldb = 1024; S.u.nt = 16;
  }
  P2Epi E; E.pin = nullptr; E.out = p.out; E.ws = p.ws; E.l = l; E.hlb = p.in[11]; E.qng = p.in[13]; E.kng = p.in[14]; E.skip = false;
  gemm_phase((LAS unsigned char*)lds, S, E);
}
__device__ __forceinline__ void p2_phase(const Params& p, int l, char* lds, bool skip = false) {
  if (STAGGER_US && ((blockIdx.x >> 3) & 1)) stagger_us(STAGGER_US);
  P2Sched S; S.H = p.ws + OFF_H; S.W = p.ws + OFF_WIN; S.G = gridDim.x; S.c = blockIdx.x;
  P2Epi E; E.pin = nullptr; E.out = p.out; E.ws = p.ws; E.l = l; E.hlb = p.in[11]; E.qng = p.in[13]; E.kng = p.in[14]; E.skip = skip;
  gemm_phase((LAS unsigned char*)lds, S, E);
}

struct HgrnLds {
  float tot[4][128];
  float dk[128];
  float osum[16][132];
  u16 qt[16][136];
  u16 kt[16][136];
  u16 khT[128][20];
  u16 vT[128][20];
  u16 zt[16][136];
  u16 obuf[256][136];
};

#define LBAR() do { asm volatile("s_waitcnt lgkmcnt(0)" ::: "memory"); __builtin_amdgcn_s_barrier(); asm volatile("" ::: "memory"); } while (0)
__device__ __forceinline__ void hgrn_pass(const Params& p, int l, int row0, int ntok, int h, int dir, f32x4 (&S)[8],
                                          const bool do_out, const bool second, float& gsum, HgrnLds& L, const bool dry = false) {
  const int tid = otid(), lane = tid & 63, wid = tid >> 6, c16 = lane & 15, g = lane >> 4;
  const int kk = tid & 127, tq = tid >> 7;
  const u16* proj = (const u16*)(p.ws + OFF_PROJ);
  u16* projw = (u16*)(p.ws + OFF_PROJ);
  const int nch = ntok >> 4;
  float4 gg = make_float4(0.f, 0.f, 0.f, 0.f);
  if (second) gg = *(const float4*)(p.in[12] + l * 512 + h * 128 + 4 * (tid & 31));
  u16 lfA[4], qA[4], vA[4], zA[4], lfB[4], qB[4], vB[4], zB[4];
#define HG_LD(c_, LF, QQ, VV, ZZ)                                                    \
  {                                                                                  \
    _Pragma("unroll") for (int i = 0; i < 4; ++i) {                                  \
      int s_ = (c_) * 16 + 4 * tq + i;                                               \
      int tl_ = dir ? (ntok - 1 - s_) : s_;                                          \
      const u16* rp_ = proj + (size_t)(row0 + tl_) * LDP + h * 128 + kk;             \
      LF[i] = rp_[PLF + dir * 512];                                                  \
      VV[i] = rp_[PIA];                                                              \
      QQ[i] = do_out ? rp_[PQA] : (u16)0;                                            \
      ZZ[i] = second ? rp_[PZA] : (u16)0;                                            \
    }                                                                                \
  }
  HG_LD(0, lfA, qA, vA, zA);
  HG_LD(1, lfB, qB, vB, zB);
  auto body = [&](const int c, u16 (&LF)[4], u16 (&QQ)[4], u16 (&VV)[4], u16 (&ZZ)[4]) __attribute__((always_inline)) {
    float lf[4], G[4], qv[4];
    u16 vv[4], zz[4];
#pragma unroll
    for (int i = 0; i < 4; ++i) { lf[i] = bf2f(LF[i]); qv[i] = bf2f(QQ[i]); vv[i] = VV[i]; zz[i] = ZZ[i]; }
    G[0] = lf[0]; G[1] = G[0] + lf[1]; G[2] = G[1] + lf[2]; G[3] = G[2] + lf[3];
    L.tot[tq][kk] = G[3];
    LBAR();
    if (c + 2 < nch) HG_LD(c + 2, LF, QQ, VV, ZZ);
    float t0 = L.tot[0][kk], t1 = L.tot[1][kk], t2 = L.tot[2][kk], t3 = L.tot[3][kk];
    float off = (tq > 0 ? t0 : 0.f) + (tq > 1 ? t1 : 0.f) + (tq > 2 ? t2 : 0.f);
    float gend = t0 + t1 + t2 + t3;
    float kh[4];
#pragma unroll
    for (int i = 0; i < 4; ++i) {
      float Gi = G[i] + off;
      float kv = neg_expm1(lf[i]);
      int s = 4 * tq + i;
      if (do_out) {
        L.qt[s][kk] = f2bf(qv[i] * fexp(Gi));
        L.kt[s][kk] = f2bf(kv * fexp(fminf(-Gi, 80.f)));
      }
      if (second) L.zt[s][kk] = zz[i];
      kh[i] = kv * fexp(gend - Gi);
    }
    *(uint2*)&L.khT[kk][4 * tq] = make_uint2(pack2(kh[0], kh[1]), pack2(kh[2], kh[3]));
    *(uint2*)&L.vT[kk][4 * tq] = make_uint2((uint32_t)vv[0] | ((uint32_t)vv[1] << 16), (uint32_t)vv[2] | ((uint32_t)vv[3] << 16));
    if (tq == 0) { L.dk[kk] = fexp(gend); gsum += gend; }
    LBAR();
    Frag bv;
    bv.h[0] = *(const uint2*)&L.vT[16 * wid + c16][4 * g];
    bv.h[1] = make_uint2(0u, 0u);
    f32x4 o = f32x4{0.f, 0.f, 0.f, 0.f};
    if (do_out) {
      f32x4 at = f32x4{0.f, 0.f, 0.f, 0.f};
#pragma unroll
      for (int ks = 0; ks < 4; ++ks) {
        Frag a, b;
        a.q = *(const uint4*)&L.kt[c16][32 * ks + 8 * g];
        b.q = *(const uint4*)&L.qt[c16][32 * ks + 8 * g];
        at = MFMA(a.v, b.v, at);
      }
      Frag pa;
#pragma unroll
      for (int r = 0; r < 4; ++r) at[r] = (4 * g + r <= c16) ? at[r] : 0.f;
      pa.w[0] = pack2(at[0], at[1]); pa.w[1] = pack2(at[2], at[3]); pa.w[2] = 0u; pa.w[3] = 0u;
      o = MFMA(pa.v, bv.v, o);
#pragma unroll
      for (int st = 0; st < 4; ++st) {
        Frag a, b;
        a.h[0] = *(const uint2*)&L.qt[c16][32 * st + 4 * g];
        a.h[1] = *(const uint2*)&L.qt[c16][32 * st + 16 + 4 * g];
        b.w[0] = pack2(S[2 * st][0], S[2 * st][1]); b.w[1] = pack2(S[2 * st][2], S[2 * st][3]);
        b.w[2] = pack2(S[2 * st + 1][0], S[2 * st + 1][1]); b.w[3] = pack2(S[2 * st + 1][2], S[2 * st + 1][3]);
        o = MFMA(a.v, b.v, o);
      }
    }
#pragma unroll
    for (int k8 = 0; k8 < 8; ++k8) {
      float4 d = *(const float4*)&L.dk[16 * k8 + 4 * g];
      f32x4 s0 = S[k8];
      s0[0] *= d.x; s0[1] *= d.y; s0[2] *= d.z; s0[3] *= d.w;
      Frag a;
      a.h[0] = *(const uint2*)&L.khT[16 * k8 + c16][4 * g];
      a.h[1] = make_uint2(0u, 0u);
      S[k8] = MFMA(a.v, bv.v, s0);
    }
    if (do_out) {
      const int vcol = 16 * wid + c16;
      if (!second) {
#pragma unroll
        for (int r = 0; r < 4; ++r) {
          int s = c * 16 + 4 * g + r;
          int tl = dir ? (ntok - 1 - s) : s;
          L.obuf[tl][vcol] = f2bf(o[r]);
        }
      } else {
#pragma unroll
        for (int r = 0; r < 4; ++r) {
          int s = c * 16 + 4 * g + r;
          int tl = dir ? (ntok - 1 - s) : s;
          L.osum[4 * g + r][vcol] = o[r] + bf2f(L.obuf[tl][vcol]);
        }
        LBAR();
        {
          int sl = tid >> 5, vq = tid & 31;
          int s = c * 16 + sl;
          int tl = dir ? (ntok - 1 - s) : s;
          float4 ov = *(const float4*)&L.osum[sl][4 * vq];
          float ss = ov.x * ov.x + ov.y * ov.y + ov.z * ov.z + ov.w * ov.w;
#pragma unroll
          for (int m = 1; m <= 16; m <<= 1) ss += __shfl_xor(ss, m);
          float rinv = rsqrtf(ss * (1.f / 128.f) + EPSV);
          u16* rp = projw + (size_t)(row0 + tl) * LDP + h * 128 + 4 * vq;
          uint2 z = *(const uint2*)&L.zt[sl][4 * vq];
          float y0 = ov.x * rinv * gg.x * lo2f(z.x), y1 = ov.y * rinv * gg.y * hi2f(z.x);
          float y2 = ov.z * rinv * gg.z * lo2f(z.y), y3 = ov.w * rinv * gg.w * hi2f(z.y);
          if (!dry) *(uint2*)(rp + PQA) = make_uint2(pack2(y0, y1), pack2(y2, y3));
        }
      }
    }
  };
  for (int c = 0; c < nch; c += 2) {
    body(c, lfA, qA, vA, zA);
    body(c + 1, lfB, qB, vB, zB);
  }
  __syncthreads();
}

__device__ __forceinline__ void hgrn_load_state(const float* m, f32x4 (&S)[8]) {
  const int tid_ = otid(); const int lane = tid_ & 63, wid = tid_ >> 6, c16 = lane & 15, g = lane >> 4;
#pragma unroll
  for (int k8 = 0; k8 < 8; ++k8)
#pragma unroll
    for (int r = 0; r < 4; ++r) S[k8][r] = m[(16 * k8 + 4 * g + r) * 128 + 16 * wid + c16];
}
__device__ __forceinline__ void hgrn_store_state(float* m, const f32x4 (&S)[8]) {
  const int tid_ = otid(); const int lane = tid_ & 63, wid = tid_ >> 6, c16 = lane & 15, g = lane >> 4;
#pragma unroll
  for (int k8 = 0; k8 < 8; ++k8)
#pragma unroll
    for (int r = 0; r < 4; ++r) m[(16 * k8 + 4 * g + r) * 128 + 16 * wid + c16] = S[k8][r];
}
__device__ __forceinline__ void hgrn_advance(const float* U, const float* D, f32x4 (&S)[8]) {
  const int tid_ = otid(); const int lane = tid_ & 63, wid = tid_ >> 6, c16 = lane & 15, g = lane >> 4;
#pragma unroll
  for (int k8 = 0; k8 < 8; ++k8)
#pragma unroll
    for (int r = 0; r < 4; ++r) {
      int k = 16 * k8 + 4 * g + r;
      S[k8][r] = D[k] * S[k8][r] + U[k * 128 + 16 * wid + c16];
    }
}

__device__ __forceinline__ void hgrn_ctx_item(const Params& p, int l, int item, char* lds, const bool dry = false) {
  HgrnLds& L = *(HgrnLds*)lds;
  const int b = item >> 2, h = item & 3;
  f32x4 S[8];
  float gsum = 0.f;
#pragma unroll
  for (int i = 0; i < 8; ++i) S[i] = f32x4{0.f, 0.f, 0.f, 0.f};
  hgrn_pass(p, l, b * 256, 256, h, 0, S, true, false, gsum, L, dry);
  if (!dry) hgrn_store_state(p.out + OST + ((size_t)(((b * 2 + l) * 2 + 0) * 4 + h)) * 16384, S);
#pragma unroll
  for (int i = 0; i < 8; ++i) S[i] = f32x4{0.f, 0.f, 0.f, 0.f};
  hgrn_pass(p, l, b * 256, 256, h, 1, S, true, true, gsum, L, dry);
  if (!dry) hgrn_store_state(p.out + OST + ((size_t)(((b * 2 + l) * 2 + 1) * 4 + h)) * 16384, S);
}
__device__ __forceinline__ void hgrn_lat1_item(const Params& p, int l, int item, char* lds) {
  HgrnLds& L = *(HgrnLds*)lds;
  const int seg = item & 15, dir = (item >> 4) & 1, h = (item >> 5) & 3, b = item >> 7;
  f32x4 S[8];
  float gsum = 0.f;
#pragma unroll
  for (int i = 0; i < 8; ++i) S[i] = f32x4{0.f, 0.f, 0.f, 0.f};
  hgrn_pass(p, l, NCTX + b * 2048 + seg * 128, 128, h, dir, S, false, false, gsum, L);
  float* SU = (float*)(p.ws + OFF_SEGU);
  float* SD = (float*)(p.ws + OFF_SEGD);
  {
    const int tq_ = otid(); const int lane_ = tq_ & 63, wid_ = tq_ >> 6, c16_ = lane_ & 15, g_ = lane_ >> 4;
    float* m_ = SU + (size_t)item * 16384;
#pragma unroll
    for (int k8 = 0; k8 < 8; ++k8)
#pragma unroll
      for (int r = 0; r < 4; ++r) __hip_atomic_store(m_ + (16 * k8 + 4 * g_ + r) * 128 + 16 * wid_ + c16_, S[k8][r], __ATOMIC_RELAXED, __HIP_MEMORY_SCOPE_AGENT);
  }
  const int t_ = otid();
  if (t_ < 128) __hip_atomic_store(SD + item * 128 + t_, fexp(gsum), __ATOMIC_RELAXED, __HIP_MEMORY_SCOPE_AGENT);
  volatile int* flag = (volatile int*)(lds + LDS_TILE + 32);
  asm volatile("s_waitcnt vmcnt(0)" ::: "memory");
  __syncthreads();
  if (t_ == 0) {
    unsigned* tk = (unsigned*)(p.ws + OFF_CNT) + 8 + l * 32 + (item >> 4);
    const unsigned old = __hip_atomic_fetch_add(tk, 1u, __ATOMIC_RELAXED, __HIP_MEMORY_SCOPE_AGENT);
    const int last = (old == 15u) ? 1 : 0;
    if (last) { __builtin_amdgcn_fence(__ATOMIC_ACQUIRE, "agent"); asm volatile("s_waitcnt vmcnt(0)" ::: "memory"); }
    *flag = last;
  }
  __syncthreads();
  if (*flag) {
    const int base = (item >> 4) * 16;
    hgrn_load_state(p.in[5] + ((size_t)(((b * 2 + l) * 2 + dir) * 4 + h)) * 16384, S);
    const int lane = t_ & 63, wid = t_ >> 6, c16 = lane & 15, g = lane >> 4;
    float un[8][4]; float4 dn[8];
    {
      const int sg0 = dir ? 15 : 0;
      const float* U0 = SU + (size_t)(base + sg0) * 16384; const float* D0 = SD + (base + sg0) * 128;
#pragma unroll
      for (int k8 = 0; k8 < 8; ++k8) {
        dn[k8] = *(const float4*)(D0 + 16 * k8 + 4 * g);
#pragma unroll
        for (int r = 0; r < 4; ++r) un[k8][r] = U0[(16 * k8 + 4 * g + r) * 128 + 16 * wid + c16];
      }
    }
#pragma unroll 1
    for (int i = 0; i < 16; ++i) {
      const int sg = dir ? (15 - i) : i;
      float* U = SU + (size_t)(base + sg) * 16384;
      float uc[8][4]; float4 dc[8];
#pragma unroll
      for (int k8 = 0; k8 < 8; ++k8) { dc[k8] = dn[k8];
#pragma unroll
        for (int r = 0; r < 4; ++r) uc[k8][r] = un[k8][r]; }
      if (i + 1 < 16) {
        const int sgn = dir ? (14 - i) : (i + 1);
        const float* Un = SU + (size_t)(base + sgn) * 16384; const float* Dn = SD + (base + sgn) * 128;
#pragma unroll
        for (int k8 = 0; k8 < 8; ++k8) {
          dn[k8] = *(const float4*)(Dn + 16 * k8 + 4 * g);
#pragma unroll
          for (int r = 0; r < 4; ++r) un[k8][r] = Un[(16 * k8 + 4 * g + r) * 128 + 16 * wid + c16];
        }
      }
#pragma unroll
      for (int k8 = 0; k8 < 8; ++k8) {
        const float dd[4] = {dc[k8].x, dc[k8].y, dc[k8].z, dc[k8].w};
#pragma unroll
        for (int r = 0; r < 4; ++r) {
          const int idx = (16 * k8 + 4 * g + r) * 128 + 16 * wid + c16;
          U[idx] = S[k8][r];
          S[k8][r] = dd[r] * S[k8][r] + uc[k8][r];
        }
      }
    }
  }
  __syncthreads();
}
__device__ __forceinline__ void hgrn_lat2_item(const Params& p, int l, int item, char* lds, const bool dry = false) {
  HgrnLds& L = *(HgrnLds*)lds;
  const int seg = item & 15, h = (item >> 4) & 3, b = item >> 6;
  const float* SU = (const float*)(p.ws + OFF_SEGU);
  const float* SD = (const float*)(p.ws + OFF_SEGD);
  f32x4 S[8];
  float gsum = 0.f;
  hgrn_load_state(SU + (size_t)(((b * 4 + h) * 2 + 0) * 16 + seg) * 16384, S);
  hgrn_pass(p, l, NCTX + b * 2048 + seg * 128, 128, h, 0, S, true, false, gsum, L, dry);
  hgrn_load_state(SU + (size_t)(((b * 4 + h) * 2 + 1) * 16 + seg) * 16384, S);
  hgrn_pass(p, l, NCTX + b * 2048 + seg * 128, 128, h, 1, S, true, true, gsum, L, dry);
}

__device__ __forceinline__ void attn_item(const Params& p, int l, int item, const bool lat, char* lds, const bool dry = false) {
  const int tid = otid(), lane = tid & 63, wid = tid >> 6, c16 = lane & 15, g = lane >> 4;
  char* ws = p.ws;
  u16* proj = (u16*)(ws + OFF_PROJ);
  int b, h, qb, nkeys, rowbase;
  const u16* Vt; int ldv;
  if (!lat) { qb = item & 1; h = (item >> 1) & 3; b = item >> 3; nkeys = 256; rowbase = b * 256; Vt = (const u16*)(ws + OFF_VTC) + (size_t)((b * 4 + h) * 128) * 256; ldv = 256; }
  else { qb = item & 15; h = (item >> 4) & 3; b = item >> 6; nkeys = 2304; rowbase = NCTX + b * 2048; Vt = (const u16*)(ws + OFF_VTL + l * SZ_VTL) + (size_t)((b * 4 + h) * 128) * 2304; ldv = 2304; }
  const u16* Kc = (const u16*)(ws + OFF_KC) + (size_t)((l * 2 + b) * 256) * 512 + h * 128;
  u16* Ks = (u16*)lds;
  u16* Vs = Ks + 64 * 144;
  float lam_init = 0.8f - 0.6f * expf(-0.3f * (float)l);
  float lam;
  {
    const float* lp = p.in[15] + l * 256;
    float a = lp[lane] * lp[64 + lane], c = lp[128 + lane] * lp[192 + lane];
#pragma unroll
    for (int o = 32; o >= 1; o >>= 1) { a += __shfl_xor(a, o); c += __shfl_xor(c, o); }
    lam = expf(a) - expf(c) + lam_init;
  }
  const int qrow = rowbase + qb * 128 + wid * 16 + c16;
  Frag qf[2][2];
#pragma unroll
  for (int m = 0; m < 2; ++m)
#pragma unroll
    for (int ks = 0; ks < 2; ++ks) qf[m][ks].q = *(const uint4*)(proj + (size_t)qrow * LDP + PQB + h * 128 + m * 64 + ks * 32 + g * 8);
  f32x4 O[2][8];
#pragma unroll
  for (int m = 0; m < 2; ++m)
#pragma unroll
    for (int v = 0; v < 8; ++v) O[m][v] = f32x4{0.f, 0.f, 0.f, 0.f};
  float mrun[2] = {-1e30f, -1e30f}, lsum[2] = {0.f, 0.f};
  uint4 kr0, kr1, vr0, vr1;
#define ATT_LD(kt_)                                                                                           \
  {                                                                                                           \
    const int key0 = (kt_) * 64;                                                                              \
    const bool fromproj = (!lat) || (key0 < 2048);                                                            \
    {                                                                                                         \
      int q = tid; int key = q >> 4, cc = q & 15;                                                             \
      const u16* src = fromproj ? proj + (size_t)(rowbase + key0 + key) * LDP + PKB + h * 128 + cc * 8        \
                                : Kc + (size_t)(key0 - 2048 + key) * 512 + cc * 8;                            \
      kr0 = *(const uint4*)src;                                                                               \
      int v = q >> 3, c8 = q & 7;                                                                             \
      vr0 = *(const uint4*)(Vt + (size_t)v * ldv + key0 + c8 * 8);                                            \
    }                                                                                                         \
    {                                                                                                         \
      int q = tid + 512; int key = q >> 4, cc = q & 15;                                                       \
      const u16* src = fromproj ? proj + (size_t)(rowbase + key0 + key) * LDP + PKB + h * 128 + cc * 8        \
                                : Kc + (size_t)(key0 - 2048 + key) * 512 + cc * 8;                            \
      kr1 = *(const uint4*)src;                                                                               \
      int v = q >> 3, c8 = q & 7;                                                                             \
      vr1 = *(const uint4*)(Vt + (size_t)v * ldv + key0 + c8 * 8);                                            \
    }                                                                                                         \
  }
#define ATT_ST()                                                                                              \
  {                                                                                                           \
    { int q = tid; int key = q >> 4, cc = q & 15; *(uint4*)(Ks + key * 144 + cc * 8) = kr0;                   \
      int v = q >> 3, c8 = q & 7; *(uint4*)(Vs + v * 72 + c8 * 8) = vr0; }                                    \
    { int q = tid + 512; int key = q >> 4, cc = q & 15; *(uint4*)(Ks + key * 144 + cc * 8) = kr1;             \
      int v = q >> 3, c8 = q & 7; *(uint4*)(Vs + v * 72 + c8 * 8) = vr1; }                                    \
  }
  const int nkt = nkeys >> 6;
  ATT_LD(0);
  for (int kt = 0; kt < nkt; ++kt) {
    LBAR();
    ATT_ST();
    LBAR();
    if (kt + 1 < nkt) ATT_LD(kt + 1);
    Frag pf[2][2];
#pragma unroll
    for (int m = 0; m < 2; ++m) {
      f32x4 s[4];
#pragma unroll
      for (int k4 = 0; k4 < 4; ++k4) {
        s[k4] = f32x4{0.f, 0.f, 0.f, 0.f};
#pragma unroll
        for (int ks = 0; ks < 2; ++ks) {
          Frag a;
          a.q = *(const uint4*)(Ks + (16 * k4 + c16) * 144 + m * 64 + ks * 32 + g * 8);
          s[k4] = MFMA(a.v, qf[m][ks].v, s[k4]);
        }
      }
      float mx = -1e30f;
#pragma unroll
      for (int k4 = 0; k4 < 4; ++k4)
#pragma unroll
        for (int r = 0; r < 4; ++r) mx = fmaxf(mx, s[k4][r]);
      mx = fmaxf(mx, __shfl_xor(mx, 16));
      mx = fmaxf(mx, __shfl_xor(mx, 32));
      if (__any(mx - mrun[m] > 4.0f)) {
        const float mnew = fmaxf(mrun[m], mx);
        const float alpha = fexp(mrun[m] - mnew);
        mrun[m] = mnew;
        lsum[m] *= alpha;
#pragma unroll
        for (int v = 0; v < 8; ++v) { O[m][v][0] *= alpha; O[m][v][1] *= alpha; O[m][v][2] *= alpha; O[m][v][3] *= alpha; }
      }
      const float mneg = -mrun[m] * 1.4426950408889634f;
      float ps = 0.f;
#pragma unroll
      for (int k4 = 0; k4 < 4; ++k4)
#pragma unroll
        for (int r = 0; r < 4; ++r) { s[k4][r] = __builtin_amdgcn_exp2f(fmaf(s[k4][r], 1.4426950408889634f, mneg)); ps += s[k4][r]; }
      lsum[m] += ps;
#pragma unroll
      for (int sp = 0; sp < 2; ++sp) {
        pf[m][sp].w[0] = pack2(s[2 * sp][0], s[2 * sp][1]); pf[m][sp].w[1] = pack2(s[2 * sp][2], s[2 * sp][3]);
        pf[m][sp].w[2] = pack2(s[2 * sp + 1][0], s[2 * sp + 1][1]); pf[m][sp].w[3] = pack2(s[2 * sp + 1][2], s[2 * sp + 1][3]);
      }
    }
#pragma unroll
    for (int v = 0; v < 8; ++v)
#pragma unroll
      for (int sp = 0; sp < 2; ++sp) {
        Frag a;
        a.h[0] = *(const uint2*)(Vs + (16 * v + c16) * 72 + 32 * sp + 4 * g);
        a.h[1] = *(const uint2*)(Vs + (16 * v + c16) * 72 + 32 * sp + 16 + 4 * g);
        O[0][v] = MFMA(a.v, pf[0][sp].v, O[0][v]);
        O[1][v] = MFMA(a.v, pf[1][sp].v, O[1][v]);
      }
  }
  float l0 = lsum[0], l1 = lsum[1];
  l0 += __shfl_xor(l0, 16); l0 += __shfl_xor(l0, 32);
  l1 += __shfl_xor(l1, 16); l1 += __shfl_xor(l1, 32);
  const float i0 = 1.f / l0, i1 = lam / l1;
  float ss = 0.f;
#pragma unroll
  for (int v = 0; v < 8; ++v)
#pragma unroll
    for (int r = 0; r < 4; ++r) { float o = O[0][v][r] * i0 - O[1][v][r] * i1; O[0][v][r] = o; ss += o * o; }
  ss += __shfl_xor(ss, 16); ss += __shfl_xor(ss, 32);
  const float rinv = rsqrtf(ss * (1.f / 128.f) + EPSV) * (1.f - lam_init);
  u16* rp = proj + (size_t)qrow * LDP + h * 128;
#pragma unroll
  for (int v = 0; v < 8; ++v) {
    int vc = 16 * v + 4 * g;
    float4 sg = *(const float4*)(p.in[16] + l * 128 + vc);
    uint2 z = *(const uint2*)(rp + PZB + vc);
    float y0 = O[0][v][0] * rinv * sg.x * lo2f(z.x), y1 = O[0][v][1] * rinv * sg.y * hi2f(z.x);
    float y2 = O[0][v][2] * rinv * sg.z * lo2f(z.y), y3 = O[0][v][3] * rinv * sg.w * hi2f(z.y);
    if (!dry) *(uint2*)(rp + PQB + vc) = make_uint2(pack2(y0, y1), pack2(y2, y3));
  }
  __syncthreads();
}

__device__ __forceinline__ void f1_item(const Params& p, int item, char* lds) {
  const int tid = otid(), lane = tid & 63, wid = tid >> 6, wr = wid >> 2, wc = wid & 3, fr = lane & 15, fq = lane >> 4;
  char* ws = p.ws;
  const int jh = item & 1, gq = (item >> 1) & 3, mt = item >> 3;
  f32x4 acc[4][4];
  gemm_kloop<128>((const u16*)(ws + OFF_B1) + jh * 128 * 128, 128, (const u16*)(ws + OFF_PROJ) + (size_t)(mt * 256) * LDP + PUC + gq * 128, LDP, 128, acc, lds);
#pragma unroll
  for (int a = 0; a < 4; ++a)
#pragma unroll
    for (int b = 0; b < 4; ++b) {
      int tokl = wc * 64 + a * 16 + 4 * fq;
      int jj = wr * 64 + b * 16 + fr;
      uint2 pk = make_uint2(pack2(acc[a][b][0], acc[a][b][1]), pack2(acc[a][b][2], acc[a][b][3]));
      if (mt < 32) {
        *(uint2*)(ws + OFF_PTC + ((size_t)((mt * 4 + gq) * 128 + jj) * 512 + jh * 256 + tokl) * 2) = pk;
      } else {
        int rp = (mt - 32) * 256 + tokl; int bb = rp >> 11, t = rp & 2047;
        *(uint2*)(ws + OFF_PTL + ((size_t)((bb * 4 + gq) * 128 + jj) * 4096 + jh * 2048 + t) * 2) = pk;
      }
    }
}

struct F2Epi {
  char* ws; float scl; int rowbase_mul;
  bool lat;
  __device__ __forceinline__ void operator()(f32x4 (&acc)[2][2][4][2], const Unit& u, int wr, int wc, int fr, int fq, LAS unsigned char* lds) const {
    u16* proj = (u16*)(ws + OFF_PROJ);
#pragma unroll
    for (int ai = 0; ai < 2; ++ai)
#pragma unroll
      for (int mh = 0; mh < 2; ++mh) {
        uint2 zv[2][2][2];
#pragma unroll
        for (int mm = 0; mm < 2; ++mm)
#pragma unroll
          for (int bj = 0; bj < 2; ++bj)
#pragma unroll
            for (int n = 0; n < 2; ++n) {
              const int tp = u.x * 256 + ai * 128 + wr * 64 + (mh * 2 + mm) * 16 + fr;
              const int nn = u.y * 256 + bj * 128 + wc * 32 + n * 16 + 4 * fq;
              const int bb = nn >> 9, col = nn & 511;
              const u16* rp = proj + (size_t)(lat ? (NCTX + bb * 2048 + tp) : (bb * 256 + tp)) * LDP;
              zv[mm][bj][n] = *(const uint2*)(rp + PZC + col);
            }
#pragma unroll
        for (int mm = 0; mm < 2; ++mm)
#pragma unroll
          for (int bj = 0; bj < 2; ++bj)
#pragma unroll
            for (int n = 0; n < 2; ++n) {
              const int m = mh * 2 + mm;
              const int tp = u.x * 256 + ai * 128 + wr * 64 + m * 16 + fr;
              const int nn = u.y * 256 + bj * 128 + wc * 32 + n * 16 + 4 * fq;
              const int bb = nn >> 9, col = nn & 511;
              u16* rp = proj + (size_t)(lat ? (NCTX + bb * 2048 + tp) : (bb * 256 + tp)) * LDP;
              const uint2 z = zv[mm][bj][n];
              f32x4 a4 = acc[ai][bj][m][n];
              *(uint2*)(rp + PUC + col) = make_uint2(pack2(a4[0] * scl * lo2f(z.x), a4[1] * scl * hi2f(z.x)),
                                                     pack2(a4[2] * scl * lo2f(z.y), a4[3] * scl * hi2f(z.y)));
            }
      }
  }
};
__device__ __forceinline__ void f2c_item(const Params& p, int item, char* lds) {
  OneUnit S; S.u.a = p.ws + OFF_DC; S.u.b = p.ws + OFF_PTC + (size_t)item * 256 * 1024; S.u.x = 0; S.u.y = item; S.u.lda = 512; S.u.ldb = 512; S.u.nt = 8;
  F2Epi E; E.ws = p.ws; E.scl = 0.005524271728019903f; E.lat = false; E.rowbase_mul = 0;
  gemm_phase((LAS unsigned char*)lds, S, E);
}
struct F2HalfEpi {
  uint2* part;
  __device__ __forceinline__ void operator()(f32x4 (&acc)[2][2][4][2], const Unit& u, int wr, int wc, int fr, int fq, LAS unsigned char* lds) const {
    const int tid = wr * 256 + wc * 64 + fq * 16 + fr;
#pragma unroll
    for (int ai = 0; ai < 2; ++ai)
#pragma unroll
      for (int bj = 0; bj < 2; ++bj)
#pragma unroll
        for (int m = 0; m < 4; ++m)
#pragma unroll
          for (int n = 0; n < 2; ++n) {
            f32x4 a4 = acc[ai][bj][m][n];
            __hip_atomic_store((unsigned long long*)(part + (((ai * 2 + bj) * 4 + m) * 2 + n) * 512 + tid), (unsigned long long)pack2(a4[0], a4[1]) | ((unsigned long long)pack2(a4[2], a4[3]) << 32), __ATOMIC_RELAXED, __HIP_MEMORY_SCOPE_AGENT);
          }
  }
};
__device__ __forceinline__ void f2l_item(const Params& p, int l, int item, char* lds) {
  char* ws = p.ws;
  const int tile = item >> 1, half = item & 1, mt = tile >> 2, nt = tile & 3;
  uint2* pbase = (uint2*)(ws + OFF_F2P);
  {
    OneUnit S; S.u.a = ws + OFF_DL + ((size_t)mt * 256 * 4096 + half * 2048) * 2; S.u.b = ws + OFF_PTL + ((size_t)nt * 256 * 4096 + half * 2048) * 2;
    S.u.x = mt; S.u.y = nt; S.u.lda = 4096; S.u.ldb = 4096; S.u.nt = 32;
    F2HalfEpi E; E.part = pbase + (size_t)(tile * 2 + half) * (32 * 512);
    gemm_phase((LAS unsigned char*)lds, S, E);
  }
  const int t_ = otid();
  volatile int* flag = (volatile int*)(lds + LDS_TILE + 32);
  asm volatile("s_waitcnt vmcnt(0)" ::: "memory");
  __syncthreads();
  if (t_ == 0) {
    unsigned* tk = (unsigned*)(ws + OFF_CNT) + 72 + l * 32 + tile;
    const unsigned old = __hip_atomic_fetch_add(tk, 1u, __ATOMIC_RELAXED, __HIP_MEMORY_SCOPE_AGENT);
    const int last = (old == 1u) ? 1 : 0;
    if (last) { __builtin_amdgcn_fence(__ATOMIC_ACQUIRE, "agent"); asm volatile("s_waitcnt vmcnt(0)" ::: "memory"); }
    *flag = last;
  }
  __syncthreads();
  if (*flag) {
    const int lane = t_ & 63, wid = t_ >> 6, wr = wid >> 2, wc = wid & 3, fr = lane & 15, fq = lane >> 4;
    const uint2* p0 = pbase + (size_t)(tile * 2 + 0) * (32 * 512);
    const uint2* p1 = pbase + (size_t)(tile * 2 + 1) * (32 * 512);
    u16* proj = (u16*)(ws + OFF_PROJ);
    const float scl = 1.f / 512.f;
#pragma unroll
    for (int ai = 0; ai < 2; ++ai)
#pragma unroll
      for (int mh = 0; mh < 2; ++mh) {
        uint2 zv[2][2][2], av[2][2][2], bv2[2][2][2];
#pragma unroll
        for (int mm = 0; mm < 2; ++mm)
#pragma unroll
          for (int bj = 0; bj < 2; ++bj)
#pragma unroll
            for (int n = 0; n < 2; ++n) {
              const int m = mh * 2 + mm;
              const int tp = mt * 256 + ai * 128 + wr * 64 + m * 16 + fr;
              const int nn = nt * 256 + bj * 128 + wc * 32 + n * 16 + 4 * fq;
              const int bb = nn >> 9, col = nn & 511;
              const u16* rp = proj + (size_t)(NCTX + bb * 2048 + tp) * LDP;
              zv[mm][bj][n] = *(const uint2*)(rp + PZC + col);
              const int idx = (((ai * 2 + bj) * 4 + m) * 2 + n) * 512 + t_;
              av[mm][bj][n] = p0[idx]; bv2[mm][bj][n] = p1[idx];
            }
#pragma unroll
        for (int mm = 0; mm < 2; ++mm)
#pragma unroll
          for (int bj = 0; bj < 2; ++bj)
#pragma unroll
            for (int n = 0; n < 2; ++n) {
              const int m = mh * 2 + mm;
              const int tp = mt * 256 + ai * 128 + wr * 64 + m * 16 + fr;
              const int nn = nt * 256 + bj * 128 + wc * 32 + n * 16 + 4 * fq;
              const int bb = nn >> 9, col = nn & 511;
              u16* rp = proj + (size_t)(NCTX + bb * 2048 + tp) * LDP;
              const uint2 z = zv[mm][bj][n], a = av[mm][bj][n], c = bv2[mm][bj][n];
              const float y0 = (lo2f(a.x) + lo2f(c.x)) * scl * lo2f(z.x), y1 = (hi2f(a.x) + hi2f(c.x)) * scl * hi2f(z.x);
              const float y2 = (lo2f(a.y) + lo2f(c.y)) * scl * lo2f(z.y), y3 = (hi2f(a.y) + hi2f(c.y)) * scl * hi2f(z.y);
              *(uint2*)(rp + PUC + col) = make_uint2(pack2(y0, y1), pack2(y2, y3));
            }
      }
  }
  __syncthreads();
}

__device__ __forceinline__ bool xcd_tile(int bid, int& pm, int& pn) {
  const int x = bid & 7, j = bid >> 3;
  if (j >= 24) return false;
  pm = 6 * x + (j >> 2); pn = j & 3;
  return true;
}
struct P5Sched {
  char* ws; int x, j;
  __device__ __forceinline__ bool next(int i, Unit& u) const {
    if (j < 24) {
      if (i >= 5) return false;
      const int pm = 6 * x + (j >> 2), pn = j & 3;
      const int jj = (i < 4) ? (i >> 1) : 2;
      if (i == 0 || i == 2) {
        u.a = ws + OFF_H + (size_t)pm * 256 * 2048; u.b = ws + OFF_WIN + (size_t)(5632 + jj * 1024 + pn * 256) * 2048;
        u.lda = 1024; u.ldb = 1024; u.nt = 16; u.x = pm; u.y = pn | (jj << 8);
      } else {
        const int yc = (jj == 0) ? PQA : ((jj == 1) ? PQB : PUC);
        u.a = ws + OFF_PROJ + ((size_t)pm * 256 * LDP + yc) * 2; u.b = ws + OFF_WBR + ((size_t)jj * 1024 * 512 + (size_t)pn * 256 * 512) * 2;
        u.lda = LDP; u.ldb = 512; u.nt = 8; u.x = pm; u.y = pn | (jj << 8) | ((i == 4) ? 0x2000 : 0x1000);
      }
      return true;
    }
    if (i >= 3) return false;
    const int tj = 3 * (j - 24) + i;
    const int pm = 6 * x + (tj >> 2), pn = tj & 3;
    u.a = ws + OFF_H + (size_t)pm * 256 * 2048; u.b = ws + OFF_WIN + (size_t)(5632 + 2 * 1024 + pn * 256) * 2048;
    u.lda = 1024; u.ldb = 1024; u.nt = 16; u.x = pm; u.y = pn | (2 << 8) | 0x3000;
    return true;
  }
};
struct P5Epi {
  char* ws; u16* mg; unsigned* flags; bool skip;
  __device__ __forceinline__ void operator()(f32x4 (&acc)[2][2][4][2], const Unit& u, int wr, int wc, int fr, int fq, LAS unsigned char* lds) const {
    if (skip) return;
    { const int t_ = otid(); const int w_ = t_ >> 6; wr = w_ >> 2; wc = w_ & 3; fr = t_ & 15; fq = (t_ & 63) >> 4; }
    const int tid = wr * 256 + wc * 64 + fq * 16 + fr;
    const int type = (u.y >> 12) & 3, j = (u.y >> 8) & 3, pn = u.y & 0xff, pm = u.x;
    const int tile = pm * 4 + pn;
    uint2* gs = (uint2*)(ws + OFF_SEGU) + (size_t)tile * (32 * 512);
    u16* g2p = (u16*)(ws + OFF_PROJ) + (size_t)pm * 256 * LDP + PLF + pn * 256;
    if (type == 0) {
#pragma unroll
      for (int ai = 0; ai < 2; ++ai)
#pragma unroll
        for (int bj = 0; bj < 2; ++bj)
#pragma unroll
          for (int m = 0; m < 4; ++m)
#pragma unroll
            for (int n = 0; n < 2; ++n) {
              f32x4 a4 = acc[ai][bj][m][n];
              gs[(((ai * 2 + bj) * 4 + m) * 2 + n) * 512 + tid] = make_uint2(pack2(sigmf(a4[0]), sigmf(a4[1])), pack2(sigmf(a4[2]), sigmf(a4[3])));
            }
      return;
    }
    if (type == 3) {
#pragma unroll
      for (int ai = 0; ai < 2; ++ai)
#pragma unroll
        for (int bj = 0; bj < 2; ++bj)
#pragma unroll
          for (int m = 0; m < 4; ++m)
#pragma unroll
            for (int n = 0; n < 2; ++n) {
              f32x4 a4 = acc[ai][bj][m][n];
              const int row = ai * 128 + wr * 64 + m * 16 + fr, col = bj * 128 + wc * 32 + n * 16 + 4 * fq;
              const unsigned long long v = (unsigned long long)pack2(sigmf(a4[0]), sigmf(a4[1])) | ((unsigned long long)pack2(sigmf(a4[2]), sigmf(a4[3])) << 32);
              __hip_atomic_store((unsigned long long*)(g2p + (size_t)row * LDP + col), v, __ATOMIC_RELAXED, __HIP_MEMORY_SCOPE_AGENT);
            }
      asm volatile("s_waitcnt vmcnt(0)" ::: "memory");
      if ((fq * 16 + fr) == 0) __hip_atomic_fetch_add(flags + tile, 1u, __ATOMIC_RELAXED, __HIP_MEMORY_SCOPE_AGENT);
      return;
    }
    if (type == 2) {
      if (tid == 0) {
        unsigned sp = 0;
        while (__hip_atomic_load(flags + tile, __ATOMIC_RELAXED, __HIP_MEMORY_SCOPE_AGENT) < 8u) { __builtin_amdgcn_s_sleep(2); if (++sp > (1u << 22)) break; }
        __builtin_amdgcn_fence(__ATOMIC_ACQUIRE, "agent");
        asm volatile("s_waitcnt vmcnt(0)" ::: "memory");
      }
      asm volatile("" ::: "memory");
      __builtin_amdgcn_s_barrier();
      asm volatile("" ::: "memory");
    }
#pragma unroll
    for (int ai = 0; ai < 2; ++ai)
#pragma unroll
      for (int mh = 0; mh < 2; ++mh) {
        uint2 gv[2][2][2], pv[2][2][2];
#pragma unroll
        for (int mm = 0; mm < 2; ++mm)
#pragma unroll
          for (int bj = 0; bj < 2; ++bj)
#pragma unroll
            for (int n = 0; n < 2; ++n) {
              const int m = mh * 2 + mm;
              const int rl = ai * 128 + wr * 64 + m * 16 + fr, cl = bj * 128 + wc * 32 + n * 16 + 4 * fq;
              const int row = pm * 256 + rl, col = pn * 256 + cl;
              const uint2* gptr = (type == 2) ? (const uint2*)(g2p + (size_t)rl * LDP + cl) : (const uint2*)(gs + (((ai * 2 + bj) * 4 + m) * 2 + n) * 512 + tid);
              gv[mm][bj][n] = *gptr;
              pv[mm][bj][n] = (j > 0) ? *(const uint2*)(mg + (size_t)row * 1024 + col) : make_uint2(0u, 0u);
            }
#pragma unroll
        for (int mm = 0; mm < 2; ++mm)
#pragma unroll
          for (int bj = 0; bj < 2; ++bj)
#pragma unroll
            for (int n = 0; n < 2; ++n) {
              const int m = mh * 2 + mm;
              const int row = pm * 256 + ai * 128 + wr * 64 + m * 16 + fr;
              const int col = pn * 256 + bj * 128 + wc * 32 + n * 16 + 4 * fq;
              f32x4 a4 = acc[ai][bj][m][n];
              const uint2 g2 = gv[mm][bj][n], p2 = pv[mm][bj][n];
              float t0 = lo2f(g2.x) * a4[0] + lo2f(p2.x), t1 = hi2f(g2.x) * a4[1] + hi2f(p2.x);
              float t2 = lo2f(g2.y) * a4[2] + lo2f(p2.y), t3 = hi2f(g2.y) * a4[3] + hi2f(p2.y);
              *(uint2*)(mg + (size_t)row * 1024 + col) = make_uint2(pack2(t0, t1), pack2(t2, t3));
            }
      }
  }
};
__device__ __forceinline__ void p5_phase(const Params& p, int l, char* lds, bool skip = false) {
  P5Sched S; S.ws = p.ws; S.x = blockIdx.x & 7; S.j = blockIdx.x >> 3;
  if (S.j >= 32) return;
  P5Epi E; E.ws = p.ws; E.mg = (u16*)(p.ws + OFF_MRG); E.flags = (unsigned*)(p.ws + OFF_CNT) + 136 + l * 192; E.skip = skip;
  gemm_phase((LAS unsigned char*)lds, S, E);
}

struct P6Epi {
  const float* xp0; const float* xs0; float* outp; const float* modp; int l;
  __device__ __forceinline__ void operator()(f32x4 (&acc)[2][2][4][2], const Unit& u, int wr, int wc, int fr, int fq, LAS unsigned char* lds) const {
    const int m0 = u.x * 256;
    const int ci = (m0 < NCTX) ? 0 : 1 + ((m0 - NCTX) >> 11);
    const float* xbase = (l == 0) ? ((m0 < NCTX) ? xp0 : xs0 - (size_t)NCTX * 1024) : outp;
    float4 gt[2][2];
#pragma unroll
    for (int bj = 0; bj < 2; ++bj)
#pragma unroll
      for (int n = 0; n < 2; ++n) gt[bj][n] = *(const float4*)(modp + (l * 3 + ci) * 3072 + 2048 + u.y * 256 + bj * 128 + wc * 32 + n * 16 + 4 * fq);
#pragma unroll
    for (int ai = 0; ai < 2; ++ai)
#pragma unroll
      for (int mh = 0; mh < 2; ++mh) {
        float4 xv[2][2][2];
#pragma unroll
        for (int mm = 0; mm < 2; ++mm)
#pragma unroll
          for (int bj = 0; bj < 2; ++bj)
#pragma unroll
            for (int n = 0; n < 2; ++n) {
              const int r = m0 + ai * 128 + wr * 64 + (mh * 2 + mm) * 16 + fr;
              const int col = u.y * 256 + bj * 128 + wc * 32 + n * 16 + 4 * fq;
              xv[mm][bj][n] = *(const float4*)(xbase + (size_t)r * 1024 + col);
            }
#pragma unroll
        for (int mm = 0; mm < 2; ++mm)
#pragma unroll
          for (int bj = 0; bj < 2; ++bj)
#pragma unroll
            for (int n = 0; n < 2; ++n) {
              const int m = mh * 2 + mm;
              const int r = m0 + ai * 128 + wr * 64 + m * 16 + fr;
              const int col = u.y * 256 + bj * 128 + wc * 32 + n * 16 + 4 * fq;
              f32x4 a4 = acc[ai][bj][m][n];
              const float4 x4 = xv[mm][bj][n], g4 = gt[bj][n];
              *(float4*)(outp + (size_t)r * 1024 + col) = make_float4(x4.x + g4.x * a4[0], x4.y + g4.y * a4[1], x4.z + g4.z * a4[2], x4.w + g4.w * a4[3]);
            }
      }
  }
};
__device__ __forceinline__ void p6_phase(const Params& p, int l, char* lds) {
  char* ws = p.ws;
  int pm, pn;
  if (!xcd_tile(blockIdx.x, pm, pn)) return;
  OneUnit S; S.u.a = ws + OFF_MRG + (size_t)pm * 256 * 2048; S.u.b = ws + OFF_WO + (size_t)pn * 256 * 2048; S.u.x = pm; S.u.y = pn;
  S.u.lda = 1024; S.u.ldb = 1024; S.u.nt = 16; S.reps = ((DUP_MASK & 512) && l == 0) ? 5 : 1;
  P6Epi E; E.xp0 = p.in[0]; E.xs0 = p.in[1]; E.outp = p.out; E.modp = (const float*)(ws + OFF_MOD); E.l = l;
  gemm_phase((LAS unsigned char*)lds, S, E);
}

#define XB_TMO      128
#define XB_XCNT(j)  (256  + 64 * (j))
#define XB_XSUB(j)  (1280 + 64 * (j))
#define XB_XGEN(j)  (2304 + 64 * (j))
#define XB_TOP      3328
#define XB_TOPGEN   3392
#define XCD_BAR_WORDS 3456
#define XB_SPIN_CAP (1u << 18)
struct XcdBarrier { unsigned* bar; unsigned x; volatile LAS unsigned* st; };
__device__ __forceinline__ unsigned xb_ld(unsigned* p) { return __hip_atomic_load(p, __ATOMIC_RELAXED, __HIP_MEMORY_SCOPE_AGENT); }
__device__ __forceinline__ unsigned xb_add(unsigned* p, unsigned v) { return __hip_atomic_fetch_add(p, v, __ATOMIC_RELAXED, __HIP_MEMORY_SCOPE_AGENT); }
__device__ __forceinline__ unsigned xb_xcc_id() { return (unsigned)__builtin_amdgcn_s_getreg((3 << 11) | 20) & 0xFu; }
#define XB_SPIN(cond, bar) do { unsigned _sp = 0; while (cond) { __builtin_amdgcn_s_sleep(1); \
    if ((++_sp & 255u) == 0u) { if (xb_ld(&(bar)[XB_TMO])) break; if (_sp > XB_SPIN_CAP) { atomicAdd(&(bar)[XB_TMO], 1u); break; } } } } while (0)
__device__ __forceinline__ XcdBarrier xcd_barrier_post(unsigned* bar, volatile LAS unsigned* st) {
  XcdBarrier b; b.bar = bar; b.x = xb_xcc_id(); b.st = st;
  if (threadIdx.x == 0) (void)xb_add(&bar[XB_XCNT(b.x)], 1u);
  return b;
}
__device__ __forceinline__ void xcd_barrier_complete(unsigned* bar, unsigned x, unsigned& nloc, unsigned& nx) {
  const unsigned G = gridDim.x * gridDim.y * gridDim.z;
  unsigned sum, cnt, mine, sp = 0u;
  for (;;) {
    sum = 0u; cnt = 0u; mine = 0u;
#pragma unroll
    for (unsigned j = 0; j < 16; ++j) { const unsigned c = xb_ld(&bar[XB_XCNT(j)]); sum += c; cnt += (c > 0u) ? 1u : 0u; mine = (j == x) ? c : mine; }
    if (sum == G) break;
    __builtin_amdgcn_s_sleep(1);
    if ((++sp & 255u) == 0u) { if (xb_ld(&bar[XB_TMO])) break; if (sp > XB_SPIN_CAP) { atomicAdd(&bar[XB_TMO], 1u); break; } }
  }
  nloc = mine > 0u ? mine : 1u; nx = cnt > 0u ? cnt : 1u;
}
__device__ __forceinline__ void xcd_barrier(const XcdBarrier& b) {
  asm volatile("s_waitcnt vmcnt(0)" ::: "memory");
  __syncthreads();
  if (threadIdx.x == 0) {
    unsigned* bar = b.bar;
    __builtin_amdgcn_s_waitcnt(0);
    unsigned nloc = b.st[0], nx = b.st[1];
    if (nloc == 0u) { xcd_barrier_complete(bar, b.x, nloc, nx); b.st[0] = nloc; b.st[1] = nx; }
    const unsigned old = xb_add(&bar[XB_XSUB(b.x)], 1u);
    const unsigned gen = old / nloc;
    if (old + 1u == (gen + 1u) * nloc) {
      __builtin_amdgcn_fence(__ATOMIC_RELEASE, "agent");
      asm volatile("s_waitcnt vmcnt(0)" ::: "memory");
      const unsigned og = xb_add(&bar[XB_TOP], 1u);
      const unsigned tg = og / nx;
      if (og + 1u == (tg + 1u) * nx) xb_add(&bar[XB_TOPGEN], 1u);
      else XB_SPIN(xb_ld(&bar[XB_TOPGEN]) == tg, bar);
      __builtin_amdgcn_fence(__ATOMIC_ACQUIRE, "agent");
      xb_add(&bar[XB_XGEN(b.x)], 1u);
      asm volatile("s_waitcnt vmcnt(0)" ::: "memory");
    } else {
      XB_SPIN(xb_ld(&bar[XB_XGEN(b.x)]) == gen, bar);
      __builtin_amdgcn_fence(__ATOMIC_ACQUIRE, "agent");
      asm volatile("s_waitcnt vmcnt(0)" ::: "memory");
    }
  }
  __syncthreads();
}

#define PARGS const float* a0, const float* a1, const float* a2, const float* a3, const float* a4, const float* a5, const float* a6, \
  const float* a7, const float* a8, const float* a9, const float* a10, const float* a11, const float* a12, const float* a13, \
  const float* a14, const float* a15, const float* a16, const float* a17, const float* a18, const float* a19, const float* a20, \
  float* aout, char* aws
#define PFILL Params p; p.in[0]=a0;p.in[1]=a1;p.in[2]=a2;p.in[3]=a3;p.in[4]=a4;p.in[5]=a5;p.in[6]=a6;p.in[7]=a7;p.in[8]=a8;p.in[9]=a9;p.in[10]=a10; \
  p.in[11]=a11;p.in[12]=a12;p.in[13]=a13;p.in[14]=a14;p.in[15]=a15;p.in[16]=a16;p.in[17]=a17;p.in[18]=a18;p.in[19]=a19;p.in[20]=a20;p.out=aout;p.ws=aws;
__global__ void __launch_bounds__(512) fwd_megakernel(PARGS) {
  PFILL
  extern __shared__ __attribute__((aligned(16))) char lds[];
  volatile int& s_item = *(volatile int*)(lds + LDS_TILE);
  cg::grid_group grid = cg::this_grid();
  const int bid = blockIdx.x, G = gridDim.x, tid = threadIdx.x;
  int* cnt = (int*)(p.ws + OFF_CNT);
  volatile LAS unsigned* bst = (volatile LAS unsigned*)(LAS unsigned char*)(lds + LDS_TILE + 16);
  if (tid < 2) bst[tid] = 0u;
  __syncthreads();
  const XcdBarrier xb = xcd_barrier_post((unsigned*)(p.ws + OFF_BAR), bst);
  for (int rep = 0; rep < ((DUP_MASK & 1) ? 2 : 1); ++rep) {
  {
    for (int it = bid; it < 384; it += G) p0_mod16(p, it, lds);
    float2* tab = (float2*)lds;
    for (int m = tid; m < 2048; m += 512) { float sn, cs; sincospif((float)m * (1.f / 1024.f), &sn, &cs); tab[m] = make_float2(cs, sn); }
    __syncthreads();
    for (int it = 224 + bid; it < 224 + 2048; it += G) p0_item(p, it, lds);
    __syncthreads();
    for (int it = 96 + bid; it < P0_ITEMS; it += G) { if (it >= 224 && it < 224 + 2048) continue; p0_item(p, it, lds); }
  }
  if (((const volatile float*)p.in[15])[0] > 1e30f) grid.sync();
  }
  for (int l = 0; l < 2; ++l) {
    {
      bool waited = (l != 0);
      for (int it = bid; it < P1_ITEMS; it += G) {
        if (!waited && it >= 2816) {
          if (tid == 0) {
            unsigned* mc = (unsigned*)(p.ws + OFF_CNT) + 6; unsigned sp = 0;
            while (__hip_atomic_load(mc, __ATOMIC_RELAXED, __HIP_MEMORY_SCOPE_AGENT) < 384u) { __builtin_amdgcn_s_sleep(2); if (++sp > (1u << 22)) break; }
            __builtin_amdgcn_fence(__ATOMIC_ACQUIRE, "agent");
            asm volatile("s_waitcnt vmcnt(0)" ::: "memory");
          }
          __syncthreads();
          waited = true;
        }
        p1_item(p, l, it, lds);
      }
      xcd_barrier(xb);
    }
    if (DUP_MASK & 1024) { const bool opq = (((const volatile float*)p.in[15])[0] < 1e30f); p2_phase(p, l, lds, opq); xcd_barrier(xb); }
    for (int rep = 0; rep < ((DUP_MASK & 4) ? 2 : 1); ++rep) {
    p2_phase(p, l, lds);
    xcd_barrier(xb);
    }
    for (;;) {
      __syncthreads();
      if (tid == 0) s_item = atomicAdd(&cnt[l * 2 + 0], 1);
      __syncthreads();
      int it = s_item;
      constexpr int D3 = (DUP_MASK & 16) ? 256 : 0;
      if (it >= D3 + 32 + 128 + 384 + 256) break;
      if (it >= 32 + 128 + 384 + 256) { hgrn_ctx_item(p, l, (it - 800) & 127, lds, true); continue; }
      if (it < 32) p2_left_item(p, l, 1024 + it, lds);
      else if (it < 160) hgrn_ctx_item(p, l, it - 32, lds);
      else if (it < 416) hgrn_lat1_item(p, l, it - 160, lds);
      else f1_item(p, it - 416, lds);
    }
    xcd_barrier(xb);
    for (;;) {
      __syncthreads();
      if (tid == 0) s_item = atomicAdd(&cnt[l * 2 + 1], 1);
      __syncthreads();
      int it = s_item;
      constexpr int D4a = (DUP_MASK & 32) ? 256 : 0, D4b = (DUP_MASK & 64) ? 256 : 0;
      if (it >= D4a + D4b + 640) break;
      if (it >= 640) { if (DUP_MASK & 32) attn_item(p, l, (it - 640) & 127, true, lds, true); else hgrn_lat2_item(p, l, (it - 640) & 127, lds, true); continue; }
      if (it < 128) attn_item(p, l, it, true, lds);
      else if (it < 192) f2l_item(p, l, it - 128, lds);
      else if (it < 320) hgrn_lat2_item(p, l, it - 192, lds);
      else if (it < 384) f2c_item(p, it - 320, lds);
      else attn_item(p, l, it - 384, false, lds);
    }
    xcd_barrier(xb);
    if (DUP_MASK & 2048) { const bool opq = (((const volatile float*)p.in[15])[0] < 1e30f); p5_phase(p, l, lds, opq); xcd_barrier(xb); }
    for (int rep = 0; rep < ((DUP_MASK & 8) ? 2 : 1); ++rep) {
    p5_phase(p, l, lds);
    xcd_barrier(xb);
    }
    for (int rep = 0; rep < (((DUP_MASK & 256) && l == 0) ? 5 : 1); ++rep) {
    p6_phase(p, l, lds);
    if (l == 0) xcd_barrier(xb);
    }
  }
}

extern "C" void kernel_launch(void* const* d_in, const int* in_sizes, int n_in,
                              void* d_out, int out_size, void* d_ws, size_t ws_size,
                              hipStream_t stream) {
  static int grid_blocks = 0;
  if (!grid_blocks) {
    int dev = 0, cus = 0;
    (void)hipGetDevice(&dev);
    (void)hipDeviceGetAttribute(&cus, hipDeviceAttributeMultiprocessorCount, dev);
    if (hipFuncSetAttribute((const void*)fwd_megakernel, hipFuncAttributeMaxDynamicSharedMemorySize, LDS_BYTES) != hipSuccess)
      fprintf(stderr, "hipFuncSetAttribute failed\n");
    grid_blocks = cus > 0 ? cus : 256;
    if (ws_size < WS_END) fprintf(stderr, "workspace too small: %zu < %zu\n", ws_size, (size_t)WS_END);
  }
  const void* ins[21];
  for (int i = 0; i < 21; ++i) ins[i] = d_in[i];
  void* outp = d_out; void* wsp = d_ws;
  void* args[23];
  for (int i = 0; i < 21; ++i) args[i] = (void*)&ins[i];
  args[21] = (void*)&outp; args[22] = (void*)&wsp;
  (void)hipMemsetAsync((char*)d_ws + OFF_CNT, 0, 4096 + 3456 * 4, stream);
  hipError_t e = hipLaunchCooperativeKernel((void*)fwd_megakernel, dim3(grid_blocks), dim3(512), args, LDS_BYTES, stream);
  if (e != hipSuccess) fprintf(stderr, "cooperative launch failed: %s (grid %d)\n", hipGetErrorString(e), grid_blocks);
}
```

```cpp
#include <hip/hip_runtime.h>
#include <hip/hip_cooperative_groups.h>
#include <stdint.h>
#include <cstdio>
namespace cg = cooperative_groups;

typedef unsigned short u16;
using bf16x8 = __attribute__((ext_vector_type(8))) short;
using f32x4 = __attribute__((ext_vector_type(4))) float;
#define MFMA(a, b, c) __builtin_amdgcn_mfma_f32_16x16x32_bf16(a, b, c, 0, 0, 0)

constexpr int NTOK = 12288;
constexpr int NCTX = 8192;
constexpr int LDP = 5120;
constexpr int PQA = 0, PLF = 512, PIA = 1536, PZA = 2048, PQB = 2560, PKB = 3072, PZB = 3584, PUC = 4096, PZC = 4608;
constexpr float EPSV = 1e-6f;
constexpr size_t OCK = 12582912, OCV = 20971520, OST = 29360128;

constexpr size_t OFF_WIN = 0;
constexpr size_t OFF_WBR = OFF_WIN + 8704ull * 1024 * 2;
constexpr size_t OFF_WO = OFF_WBR + 3ull * 1024 * 512 * 2;
constexpr size_t OFF_H = OFF_WO + 1024ull * 1024 * 2;
constexpr size_t OFF_PROJ = OFF_H + 12288ull * 1024 * 2;
constexpr size_t OFF_R1 = OFF_PROJ + 12288ull * LDP * 2;
constexpr size_t OFF_PTC = OFF_R1;
constexpr size_t OFF_PTL = OFF_R1 + 16384ull * 512 * 2;
constexpr size_t OFF_MRG = OFF_R1;
constexpr size_t OFF_SEGU = OFF_R1 + 25165824ull;
constexpr size_t OFF_SEGD = OFF_SEGU + 256ull * 16384 * 4;
constexpr size_t OFF_VTC = OFF_SEGD + 256ull * 128 * 4;
constexpr size_t OFF_VTL = OFF_VTC + 32ull * 4 * 128 * 256 * 2;
constexpr size_t SZ_VTL = 2ull * 4 * 128 * 2304 * 2;
constexpr size_t OFF_KC = OFF_VTL + 2 * SZ_VTL;
constexpr size_t OFF_DL = OFF_KC + 2ull * 2 * 256 * 512 * 2;
constexpr size_t OFF_DC = OFF_DL + 2048ull * 4096 * 2;
constexpr size_t OFF_B1 = OFF_DC + 256ull * 512 * 2;
constexpr size_t OFF_ROPE = OFF_B1 + 256ull * 128 * 2;
constexpr size_t OFF_MOD = OFF_ROPE + 2048ull * 32 * 8;
constexpr size_t OFF_CNT = OFF_MOD + 2ull * 3 * 3072 * 4;
constexpr size_t OFF_BAR = OFF_CNT + 4096;
constexpr size_t OFF_F2P = OFF_BAR + 3456 * 4 + 192;
constexpr size_t WS_END = OFF_F2P + 32ull * 2 * 32 * 512 * 8;

constexpr int LDS_TILE = 131072 + 8192;
#define DUP_MASK 0
constexpr int LDS_BYTES = LDS_TILE + 64;

struct Params {
  const float* in[21];
  float* out;
  char* ws;
};

typedef __bf16 bf16x2_t __attribute__((ext_vector_type(2)));
typedef float f32x2_t __attribute__((ext_vector_type(2)));
__device__ __forceinline__ uint32_t pack2(float a, float b) {
  f32x2_t v = {a, b};
  bf16x2_t r = __builtin_convertvector(v, bf16x2_t);
  return __builtin_bit_cast(uint32_t, r);
}
__device__ __forceinline__ u16 f2bf(float f) { return (u16)(pack2(f, 0.f) & 0xffffu); }
__device__ __forceinline__ float bf2f(u16 h) { return __uint_as_float(((uint32_t)h) << 16); }
__device__ __forceinline__ float lo2f(uint32_t u) { return __uint_as_float(u << 16); }
__device__ __forceinline__ float hi2f(uint32_t u) { return __uint_as_float(u & 0xffff0000u); }
__device__ __forceinline__ float fexp(float x) { return __builtin_amdgcn_exp2f(x * 1.4426950408889634f); }
__device__ __forceinline__ float frcp(float x) { return __builtin_amdgcn_rcpf(x); }
__device__ __forceinline__ float flog(float x) { return __builtin_amdgcn_logf(x) * 0.6931471805599453f; }
__device__ __forceinline__ float siluf(float x) { return x * frcp(1.f + fexp(-x)); }
__device__ __forceinline__ float sigmf(float x) { return frcp(1.f + fexp(-x)); }
__device__ __forceinline__ float logf_gate(float x, float lb) {
  float xc = fmaxf(x, -80.f);
  float e = fexp(-xc);
  float omf = (1.f - lb) * e * frcp(1.f + e);
  float lf = flog(1.f - omf);
  lf = (lb == 0.f && x < -15.f) ? x : lf;
  return lf;
}
__device__ __forceinline__ float neg_expm1(float lf) {
  return 1.f - fexp(lf);
}
__device__ __forceinline__ int otid() { int t = threadIdx.x; asm volatile("" : "+v"(t)); return t; }

union Frag {
  bf16x8 v;
  uint4 q;
  uint2 h[2];
  uint32_t w[4];
};

__device__ __forceinline__ int lds_byte(int r, int c) {
  int st = (r >> 4) * 2 + (c >> 5), rr = r & 15, cc = c & 31, ob = rr * 64 + cc * 2;
  return st * 1024 + (ob ^ (((ob >> 9) & 1) << 5));
}

template <int TM>
__device__ __forceinline__ void gemm_kloop(const u16* __restrict__ X, int ldx, const u16* __restrict__ Y, int ldy,
                                           int K, f32x4 (&acc)[4][TM / 32], char* lds) {
  constexpr int NX = TM / 64;
  constexpr int XT = TM / 32;
  constexpr int STAGE = TM * 128 + 32768;
  const int tid = otid(), lane = tid & 63, wid = tid >> 6, wr = wid >> 2, wc = wid & 3, fr = lane & 15, fq = lane >> 4;
#pragma unroll
  for (int a = 0; a < 4; ++a)
#pragma unroll
    for (int b = 0; b < XT; ++b) acc[a][b] = f32x4{0.f, 0.f, 0.f, 0.f};
  uint4 xr[NX], yr[4];
  const int nk = K >> 6;
  const int lrow = tid >> 3, lc8 = (tid & 7) * 8;
  const u16* xg = X + (size_t)lrow * ldx + lc8;
  const u16* yg = Y + (size_t)lrow * ldy + lc8;
  const int loff = lds_byte(lrow, lc8);
#pragma unroll
  for (int i = 0; i < NX; ++i) xr[i] = *(const uint4*)(xg + (size_t)(64 * i) * ldx);
#pragma unroll
  for (int i = 0; i < 4; ++i) yr[i] = *(const uint4*)(yg + (size_t)(64 * i) * ldy);
#pragma unroll
  for (int i = 0; i < NX; ++i) *(uint4*)(lds + loff + 8192 * i) = xr[i];
#pragma unroll
  for (int i = 0; i < 4; ++i) *(uint4*)(lds + TM * 128 + loff + 8192 * i) = yr[i];
  __syncthreads();
  for (int kt = 0; kt < nk; ++kt) {
    char* cur = lds + (kt & 1) * STAGE;
    char* nxt = lds + ((kt + 1) & 1) * STAGE;
    const bool more = (kt + 1 < nk);
    if (more) {
#pragma unroll
      for (int i = 0; i < NX; ++i) xr[i] = *(const uint4*)(xg + (size_t)(64 * i) * ldx + (kt + 1) * 64);
#pragma unroll
      for (int i = 0; i < 4; ++i) yr[i] = *(const uint4*)(yg + (size_t)(64 * i) * ldy + (kt + 1) * 64);
    }
#pragma unroll
    for (int ks = 0; ks < 2; ++ks) {
      Frag yf[4], xf[XT];
#pragma unroll
      for (int a = 0; a < 4; ++a) yf[a].q = *(const uint4*)(cur + TM * 128 + lds_byte(wc * 64 + a * 16 + fr, ks * 32 + fq * 8));
#pragma unroll
      for (int b = 0; b < XT; ++b) xf[b].q = *(const uint4*)(cur + lds_byte(wr * (TM / 2) + b * 16 + fr, ks * 32 + fq * 8));
#pragma unroll
      for (int a = 0; a < 4; ++a)
#pragma unroll
        for (int b = 0; b < XT; ++b) acc[a][b] = MFMA(yf[a].v, xf[b].v, acc[a][b]);
    }
    if (more) {
#pragma unroll
      for (int i = 0; i < NX; ++i) *(uint4*)(nxt + loff + 8192 * i) = xr[i];
#pragma unroll
      for (int i = 0; i < 4; ++i) *(uint4*)(nxt + TM * 128 + loff + 8192 * i) = yr[i];
    }
    __syncthreads();
  }
}

#define LAS __attribute__((address_space(3)))
constexpr int HTB = 128 * 64 * 2;
constexpr int G8_STAGE_BYTES = 8 * HTB;
__device__ __forceinline__ void stage_rc(int b, int& R, int& C) {
  const int st = b / 1024, sb = b % 1024, swz = sb ^ (((sb >> 9) & 1) << 5);
  R = (st >> 1) * 16 + swz / 64; C = (st & 1) * 32 + (swz % 64) / 2;
}
struct Unit { const char* a; const char* b; int x; int y; int lda; int ldb; int nt; int perm = 0; };
struct OneUnit {
  Unit u; int reps = 1;
  __device__ __forceinline__ bool next(int i, Unit& o) const { if (i >= reps) return false; o = u; return true; }
};
template <class Epi, class Sched>
__device__ __forceinline__ void gemm_phase(LAS unsigned char* lds, const Sched& S, const Epi& E) {
  const int tid = otid(), wid = __builtin_amdgcn_readfirstlane(tid >> 6), lane = tid & 63, wr = wid >> 2, wc = wid & 3, fr = lane & 15, fq = lane >> 4;
  int sR[2], sC[2];
#pragma unroll
  for (int i = 0; i < 2; ++i) stage_rc(tid * 16 + i * 8192, sR[i], sC[i]);
  int sRp[2];
#pragma unroll
  for (int i = 0; i < 2; ++i) { const int rho = sR[i] & 31, n_ = rho >> 4, i_ = rho & 15; sRp[i] = (sR[i] & ~31) + 8 * (i_ >> 2) + 4 * n_ + (i_ & 3); }
  const size_t kstep = 128;
  const unsigned ldsw = (unsigned)wid * 1024u;
  const int aoff = lds_byte(wr * 64 + fr, fq * 8), boff = lds_byte(wc * 32 + fr, fq * 8);
#define G8_SA(b, h) (((b) * 2 + (h)) * HTB)
#define G8_SB(b, h) ((4 + (b) * 2 + (h)) * HTB)
#define G8_STAGE(bufoff, gbase, voff) do { _Pragma("unroll") for (int _i = 0; _i < 2; ++_i) \
    __builtin_amdgcn_global_load_lds((const unsigned*)((const char*)(gbase) + (voff)[_i]), (LAS unsigned*)(lds + (bufoff) + ldsw + _i * 8192), 16, 0, 0); } while (0)
#define G8_LDA(dst, b, h) do { _Pragma("unroll") for (int m = 0; m < 4; ++m) _Pragma("unroll") for (int k = 0; k < 2; ++k) dst[m][k] = *(const LAS bf16x8*)(lds + G8_SA(b, h) + aoff + m * 2048 + k * 1024); } while (0)
#define G8_LDB(dst, b, h) do { _Pragma("unroll") for (int n = 0; n < 2; ++n) _Pragma("unroll") for (int k = 0; k < 2; ++k) dst[n][k] = *(const LAS bf16x8*)(lds + G8_SB(b, h) + boff + n * 2048 + k * 1024); } while (0)
#define G8_MMA(ai, bj, At, Bt) do { __builtin_amdgcn_s_setprio(1); _Pragma("unroll") for (int m = 0; m < 4; ++m) _Pragma("unroll") for (int n = 0; n < 2; ++n) _Pragma("unroll") for (int k = 0; k < 2; ++k) \
    acc[ai][bj][m][n] = __builtin_amdgcn_mfma_f32_16x16x32_bf16(Bt[n][k], At[m][k], acc[ai][bj][m][n], 0, 0, 0); __builtin_amdgcn_s_setprio(0); } while (0)
#define G8_WAIT_V(n) asm volatile("s_waitcnt vmcnt(" #n ")" ::: "memory")
#define G8_WAIT_L(n) asm volatile("s_waitcnt lgkmcnt(" #n ")" ::: "memory")
#define G8_BAR __builtin_amdgcn_s_barrier()
#define G8_SCHED __builtin_amdgcn_sched_barrier(0)
  Unit cur, nxt; int ui = 0;
  if (!S.next(0, cur)) return;
  f32x4 acc[2][2][4][2];
#pragma unroll
  for (int a = 0; a < 2; ++a)
#pragma unroll
    for (int b = 0; b < 2; ++b)
#pragma unroll
      for (int m = 0; m < 4; ++m)
#pragma unroll
        for (int n = 0; n < 2; ++n) acc[a][b][m][n] = f32x4{0.f, 0.f, 0.f, 0.f};
  bf16x8 At[4][2], B0[2][2], B1[2][2];
  const char* cA = cur.a; const char* cB = cur.b;
  unsigned voffA[2], voffB[2];
#pragma unroll
  for (int i = 0; i < 2; ++i) { voffA[i] = (unsigned)(sR[i] * cur.lda + sC[i]) * 2u; voffB[i] = (unsigned)((cur.perm ? sRp[i] : sR[i]) * cur.ldb + sC[i]) * 2u; }
  size_t hstepA = (size_t)128 * cur.lda * 2, hstepB = (size_t)128 * cur.ldb * 2;
  G8_STAGE(G8_SB(0, 0), cB, voffB); G8_STAGE(G8_SA(0, 0), cA, voffA); G8_STAGE(G8_SB(0, 1), cB + hstepB, voffB); G8_STAGE(G8_SA(0, 1), cA + hstepA, voffA);
  if (wr == 1) G8_BAR;
  G8_WAIT_V(4); G8_BAR;
  G8_STAGE(G8_SB(1, 0), cB + kstep, voffB); G8_STAGE(G8_SA(1, 0), cA + kstep, voffA); G8_STAGE(G8_SB(1, 1), cB + hstepB + kstep, voffB);
  G8_WAIT_V(6); G8_BAR;
  for (;;) {
    const bool has_next = S.next(ui + 1, nxt);
    if (!has_next) nxt = cur;
    const char* nA = nxt.a; const char* nB = nxt.b;
    unsigned voffAn[2], voffBn[2];
#pragma unroll
    for (int i = 0; i < 2; ++i) { voffAn[i] = (unsigned)(sR[i] * nxt.lda + sC[i]) * 2u; voffBn[i] = (unsigned)((nxt.perm ? sRp[i] : sR[i]) * nxt.ldb + sC[i]) * 2u; }
    const size_t hstepAn = (size_t)128 * nxt.lda * 2, hstepBn = (size_t)128 * nxt.ldb * 2;
    const int nt = cur.nt;
    for (int t = 0; t < nt; t += 2) {
      const bool last = (t == nt - 2);
      const char* a1 = cA + (size_t)(t + 1) * kstep;
      const char* a2 = last ? nA : cA + (size_t)(t + 2) * kstep; const char* b2 = last ? nB : cB + (size_t)(t + 2) * kstep;
      const char* a3 = a2 + kstep; const char* b3 = b2 + kstep;
      unsigned vA2[2], vB2[2];
#pragma unroll
      for (int i = 0; i < 2; ++i) { vA2[i] = last ? voffAn[i] : voffA[i]; vB2[i] = last ? voffBn[i] : voffB[i]; }
      const size_t hA2 = last ? hstepAn : hstepA, hB2 = last ? hstepBn : hstepB;
      G8_LDB(B0, 0, 0); G8_SCHED; G8_LDA(At, 0, 0); G8_STAGE(G8_SA(1, 1), a1 + hstepA, voffA);
      G8_WAIT_L(8); G8_BAR; G8_WAIT_L(0); G8_MMA(0, 0, At, B0); G8_BAR; G8_SCHED;
      G8_LDB(B1, 0, 1); G8_STAGE(G8_SB(0, 0), b2, vB2);
      G8_BAR; G8_WAIT_L(0); G8_MMA(0, 1, At, B1); G8_BAR;
      G8_LDA(At, 0, 1); G8_STAGE(G8_SA(0, 0), a2, vA2);
      G8_BAR; G8_WAIT_L(0); G8_MMA(1, 0, At, B0); G8_BAR; G8_SCHED;
      G8_STAGE(G8_SB(0, 1), b2 + hB2, vB2);
      G8_WAIT_V(6); G8_BAR; G8_MMA(1, 1, At, B1); G8_BAR;
      G8_LDB(B0, 1, 0); G8_SCHED; G8_LDA(At, 1, 0); G8_STAGE(G8_SA(0, 1), a2 + hA2, vA2);
      G8_WAIT_L(8); G8_BAR; G8_WAIT_L(0); G8_MMA(0, 0, At, B0); G8_BAR; G8_SCHED;
      G8_LDB(B1, 1, 1); G8_STAGE(G8_SB(1, 0), b3, vB2);
      G8_BAR; G8_WAIT_L(0); G8_MMA(0, 1, At, B1); G8_BAR;
      G8_LDA(At, 1, 1); G8_STAGE(G8_SA(1, 0), a3, vA2);
      G8_BAR; G8_WAIT_L(0); G8_MMA(1, 0, At, B0); G8_BAR; G8_SCHED;
      G8_STAGE(G8_SB(1, 1), b3 + hB2, vB2);
      G8_WAIT_V(6); G8_BAR; G8_MMA(1, 1, At, B1); G8_BAR;
    }
    E(acc, cur, wr, wc, fr, fq, lds);
    if (!has_next) break;
#pragma unroll
    for (int a = 0; a < 2; ++a)
#pragma unroll
      for (int b = 0; b < 2; ++b)
#pragma unroll
        for (int m = 0; m < 4; ++m)
#pragma unroll
          for (int n = 0; n < 2; ++n) acc[a][b][m][n] = f32x4{0.f, 0.f, 0.f, 0.f};
    cur = nxt; cA = nA; cB = nB; ++ui;
#pragma unroll
    for (int i = 0; i < 2; ++i) { voffA[i] = voffAn[i]; voffB[i] = voffBn[i]; }
    hstepA = hstepAn; hstepB = hstepBn;
  }
  G8_WAIT_V(0);
  if (wr == 0) G8_BAR;
  G8_BAR;
}

__device__ __forceinline__ void p0_mod16(const Params& p, int item, char* lds) {
  const int tid = otid();
  float* sc = (float*)lds;
  float* red = sc + 3072;
  const int l = item / 192, cgp = item % 192;
  const float* cctx = p.in[6]; const float* cc2 = p.in[2];
  for (int i = tid; i < 3072; i += 512) {
    int j = i >> 10, k = i & 1023;
    float c = (j == 0) ? cctx[k] : cc2[(j > 0 ? j - 1 : 0) * 1024 + k];
    sc[i] = c / (1.f + expf(-c));
  }
  __syncthreads();
  const int col = tid & 15, kg = tid >> 4;
  const float* W = p.in[7] + (size_t)l * 1024 * 3072 + cgp * 16 + col;
  float a0 = 0.f, a1 = 0.f, a2 = 0.f;
#pragma unroll 8
  for (int k = kg * 32; k < kg * 32 + 32; ++k) {
    float w = W[(size_t)k * 3072];
    a0 += sc[k] * w; a1 += sc[1024 + k] * w; a2 += sc[2048 + k] * w;
  }
  red[(kg * 3 + 0) * 16 + col] = a0; red[(kg * 3 + 1) * 16 + col] = a1; red[(kg * 3 + 2) * 16 + col] = a2;
  __syncthreads();
  if (tid < 48) {
    const int j = tid >> 4; float s_ = 0.f;
    for (int g = 0; g < 32; ++g) s_ += red[(g * 3 + j) * 16 + col];
    const int n = cgp * 16 + col;
    __hip_atomic_store((float*)(p.ws + OFF_MOD) + (l * 3 + j) * 3072 + n, s_ + p.in[8][l * 3072 + n], __ATOMIC_RELAXED, __HIP_MEMORY_SCOPE_AGENT);
  }
  if (tid < 64) {
    asm volatile("s_waitcnt vmcnt(0)" ::: "memory");
    if (tid == 0) __hip_atomic_fetch_add((unsigned*)(p.ws + OFF_CNT) + 6, 1u, __ATOMIC_RELAXED, __HIP_MEMORY_SCOPE_AGENT);
  }
  __syncthreads();
}

__device__ __forceinline__ void p0_item(const Params& p, int item, char* lds) {
  const int tid = otid();
  char* ws = p.ws;
  if (item < 96) {
    float* sc = (float*)lds;
    float* red = sc + 3072;
    const int l = item / 48, cgp = item % 48;
    const float* cctx = p.in[6]; const float* cc2 = p.in[2];
    for (int i = tid; i < 3072; i += 512) {
      int j = i >> 10, k = i & 1023;
      float c = (j == 0) ? cctx[k] : cc2[(j > 0 ? j - 1 : 0) * 1024 + k];
      sc[i] = siluf(c);
    }
    __syncthreads();
    const int col = tid & 63, kg = tid >> 6;
    const float* W = p.in[7] + (size_t)l * 1024 * 3072 + cgp * 64 + col;
    float a0 = 0.f, a1 = 0.f, a2 = 0.f;
    for (int k = kg * 128; k < kg * 128 + 128; ++k) {
      float w = W[(size_t)k * 3072];
      a0 += sc[k] * w; a1 += sc[1024 + k] * w; a2 += sc[2048 + k] * w;
    }
    red[(kg * 3 + 0) * 64 + col] = a0; red[(kg * 3 + 1) * 64 + col] = a1; red[(kg * 3 + 2) * 64 + col] = a2;
    __syncthreads();
    if (tid < 192) {
      int j = tid >> 6; float s = 0.f;
      for (int g = 0; g < 8; ++g) s += red[(g * 3 + j) * 64 + col];
      int n = cgp * 64 + col;
      ((float*)(ws + OFF_MOD))[(l * 3 + j) * 3072 + n] = s + p.in[8][l * 3072 + n];
    }
    __syncthreads();
    return;
  }
  item -= 96;
  if (item < 128) {
    int idx = item * 512 + tid, t = idx >> 5, c = idx & 31, fi = c & 15;
    float pos = (c < 16) ? (float)(t >> 6) : (float)(t & 63);
    float inv = powf(10000.f, -(float)fi / 16.f);
    float ang = pos * inv;
    ((float2*)(ws + OFF_ROPE))[idx] = make_float2(cosf(ang), sinf(ang));
    return;
  }
  item -= 128;
  if (item < 2048) {
    const float2* tab = (const float2*)lds;
    int idx = item * 512 + tid, tp = idx >> 9, k0 = (idx & 511) * 8;
    uint32_t o[4];
    float vv[8];
#pragma unroll
    for (int j = 0; j < 8; ++j) {
      int k = k0 + j; int m = (tp * (k & 2047)) & 2047;
      float2 cs = tab[m];
      vv[j] = (k < 2048) ? cs.x : -cs.y;
    }
#pragma unroll
    for (int j = 0; j < 4; ++j) o[j] = pack2(vv[2 * j], vv[2 * j + 1]);
    *(uint4*)(ws + OFF_DL + (size_t)idx * 16) = make_uint4(o[0], o[1], o[2], o[3]);
    return;
  }
  item -= 2048;
  if (item < 32) {
    int idx = item * 512 + tid, tp = idx >> 6, k0 = (idx & 63) * 8;
    uint32_t o[4];
    float vv[8];
#pragma unroll
    for (int j = 0; j < 8; ++j) {
      int k = k0 + j; int m = (tp * (k & 255)) & 255; float s, c;
      sincospif((float)m * (1.f / 128.f), &s, &c);
      vv[j] = (k < 256) ? c : -s;
    }
#pragma unroll
    for (int j = 0; j < 4; ++j) o[j] = pack2(vv[2 * j], vv[2 * j + 1]);
    *(uint4*)(ws + OFF_DC + (size_t)idx * 16) = make_uint4(o[0], o[1], o[2], o[3]);
    return;
  }
  item -= 32;
  if (item < 8) {
    int idx = item * 512 + tid, j = idx >> 4, c0 = (idx & 15) * 8;
    uint32_t o[4];
    float vv[8];
#pragma unroll
    for (int q = 0; q < 8; ++q) {
      int m = ((j & 127) * (c0 + q)) & 127; float s, c;
      sincospif((float)m * (1.f / 64.f), &s, &c);
      vv[q] = (j < 128) ? c : s;
    }
#pragma unroll
    for (int q = 0; q < 4; ++q) o[q] = pack2(vv[2 * q], vv[2 * q + 1]);
    *(uint4*)(ws + OFF_B1 + (size_t)idx * 16) = make_uint4(o[0], o[1], o[2], o[3]);
    return;
  }
  item -= 8;
  if (item < 128) {
    int idx = item * 512 + tid; int e = idx * 8;
    int n = e & 511, t = (e >> 9) & 255, l = (e >> 17) & 1, b = e >> 18;
    const float4* s = (const float4*)(p.in[3] + e);
    float4 a = s[0], c = s[1];
    size_t d = ((size_t)((l * 2 + b) * 256 + t)) * 512 + n;
    *(uint4*)(ws + OFF_KC + d * 2) = make_uint4(pack2(a.x, a.y), pack2(a.z, a.w), pack2(c.x, c.y), pack2(c.z, c.w));
    return;
  }
  item -= 128;
  {
    int idx = item * 512 + tid;
    int v = idx & 127, tc = (idx >> 7) & 31, h = (idx >> 12) & 3, b = (idx >> 14) & 1, l = idx >> 15;
    float vv[8];
#pragma unroll
    for (int j = 0; j < 8; ++j) vv[j] = p.in[4][((size_t)((b * 2 + l) * 256 + tc * 8 + j)) * 512 + h * 128 + v];
    size_t d = ((size_t)((b * 4 + h) * 128 + v)) * 2304 + 2048 + tc * 8;
    *(uint4*)(ws + OFF_VTL + l * SZ_VTL + d * 2) = make_uint4(pack2(vv[0], vv[1]), pack2(vv[2], vv[3]), pack2(vv[4], vv[5]), pack2(vv[6], vv[7]));
  }
}
constexpr int P0_ITEMS = 96 + 128 + 2048 + 32 + 8 + 128 + 128;

__device__ __forceinline__ void p1_item(const Params& p, int l, int item, char* lds) {
  const int tid = otid();
  char* ws = p.ws;
  if (item < 2816) {
    const float* src; int lsrc; u16* dst; int ldd; int kt, nt;
    const float* w10 = p.in[10]; const float* w17 = p.in[17]; const float* w18 = p.in[18]; const float* w19 = p.in[19]; const float* w20 = p.in[20];
    if (item < 2176) { src = w10 + (size_t)l * 1024 * 8704; lsrc = 8704; dst = (u16*)(ws + OFF_WIN); ldd = 1024; nt = item >> 4; kt = item & 15; }
    else if (item < 2560) { int r = item - 2176; int j = r >> 7; r &= 127; src = ((j == 0) ? w17 : ((j == 1) ? w18 : w19)) + (size_t)l * 512 * 1024; lsrc = 1024; dst = (u16*)(ws + OFF_WBR) + (size_t)j * 1024 * 512; ldd = 512; nt = r >> 3; kt = r & 7; }
    else { int r = item - 2560; src = w20 + (size_t)l * 1024 * 1024; lsrc = 1024; dst = (u16*)(ws + OFF_WO); ldd = 1024; nt = r >> 4; kt = r & 15; }
    u16* T = (u16*)lds;
    const int k0 = kt * 64, n0 = nt * 64;
#pragma unroll
    for (int ps = 0; ps < 2; ++ps) {
      int kr = (tid >> 4) + 32 * ps, nq = tid & 15;
      float4 v = *(const float4*)(src + (size_t)(k0 + kr) * lsrc + n0 + 4 * nq);
      const int ksw = (((kr >> 3) ^ (nq & 7)) << 3) + (kr & 7);
      T[(4 * nq + 0) * 72 + ksw] = f2bf(v.x); T[(4 * nq + 1) * 72 + ksw] = f2bf(v.y);
      T[(4 * nq + 2) * 72 + ksw] = f2bf(v.z); T[(4 * nq + 3) * 72 + ksw] = f2bf(v.w);
    }
    __syncthreads();
    {
      int n = tid >> 3, kc = tid & 7;
      uint4 o = *(const uint4*)(T + n * 72 + ((kc ^ ((n >> 2) & 7)) << 3));
      *(uint4*)(dst + (size_t)(n0 + n) * ldd + k0 + kc * 8) = o;
    }
    __syncthreads();
    return;
  }
  item -= 2816;
  const int lane = tid & 63, wid = tid >> 6;
  const float* modp = (const float*)(ws + OFF_MOD);
  u16* H = (u16*)(ws + OFF_H);
  const float* xin0 = p.in[0]; const float* xin1 = p.in[1]; const float* xin2 = p.out; const float* ng = p.in[9];
#pragma unroll
  for (int rr = 0; rr < 2; ++rr) {
    int r = item * 16 + wid * 2 + rr;
    const float* x = (l == 0) ? ((r < NCTX) ? xin0 + (size_t)r * 1024 : xin1 + (size_t)(r - NCTX) * 1024) : xin2 + (size_t)r * 1024;
    int ci = (r < NCTX) ? 0 : 1 + ((r - NCTX) >> 11);
    float4 v[4]; float ss = 0.f;
#pragma unroll
    for (int i = 0; i < 4; ++i) { v[i] = *(const float4*)(x + lane * 4 + 256 * i); ss += v[i].x * v[i].x + v[i].y * v[i].y + v[i].z * v[i].z + v[i].w * v[i].w; }
#pragma unroll
    for (int o = 32; o >= 1; o >>= 1) ss += __shfl_xor(ss, o);
    float rinv = rsqrtf(ss * (1.f / 1024.f) + EPSV);
    const float* sh = modp + (l * 3 + ci) * 3072;
#pragma unroll
    for (int i = 0; i < 4; ++i) {
      int col = lane * 4 + 256 * i;
      float4 g = *(const float4*)(ng + l * 1024 + col);
      float4 s1 = *(const float4*)(sh + 1024 + col);
      float4 s0 = *(const float4*)(sh + col);
      float a = v[i].x * rinv * g.x * (1.f + s1.x) + s0.x;
      float b = v[i].y * rinv * g.y * (1.f + s1.y) + s0.y;
      float c = v[i].z * rinv * g.z * (1.f + s1.z) + s0.z;
      float d = v[i].w * rinv * g.w * (1.f + s1.w) + s0.w;
      *(uint2*)(H + (size_t)r * 1024 + col) = make_uint2(pack2(a, b), pack2(c, d));
    }
  }
}
constexpr int P1_ITEMS = 2816 + 768;

__device__ __forceinline__ void stagger_us(int us) {
  const unsigned long long t0 = __builtin_amdgcn_s_memrealtime();
  while (__builtin_amdgcn_s_memrealtime() - t0 < (unsigned long long)us * 100ull) __builtin_amdgcn_s_sleep(8);
}
#define STAGGER_US 0
struct P2Sched {
  const char* H; const char* W; int G, c;
  __device__ __forceinline__ bool next(int i, Unit& u) const {
    const int L = i * G + c;
    if (L >= 1024) return false;
    if (L < 960) {
      const int nM = 48, nN = 20, nwg = 960;
      int wgid = L; { const int q = nwg / 8, xcd = wgid % 8, off = wgid / 8; wgid = xcd * q + off; }
      const int nig = 8 * nN, gid = wgid / nig, fm = gid * 8, gsz = (nM - fm) < 8 ? (nM - fm) : 8;
      int pm = fm + ((wgid % nig) % gsz), pn = (wgid % nig) / gsz;
      if (pn >= 14) pn += 2;
      u.a = H + (size_t)pm * 256 * 2048; u.b = W + (size_t)pn * 256 * 2048; u.x = pm; u.y = pn;
      u.lda = 1024; u.ldb = 1024; u.nt = 16; u.perm = ((pn >> 1) == 5 || (pn >> 1) == 6) ? 0 : 1;
    } else {
      const int r = L - 960; const int vq = r / 48, mt = r % 48;
      u.a = W + (size_t)(3584 + vq * 256) * 2048; u.b = H + (size_t)mt * 256 * 2048; u.x = vq; u.y = mt | 0x100;
      u.lda = 1024; u.ldb = 1024; u.nt = 16; u.perm = 0;
    }
    return true;
  }
};
struct P2Epi {
  const float* const* pin; float* out; char* ws; int l;
  const float* hlb; const float* qng; const float* kng; bool skip;
  __device__ __forceinline__ void operator()(f32x4 (&acc)[2][2][4][2], const Unit& u, int wr, int wc, int fr, int fq, LAS unsigned char* lds) const {
    if (skip) return;
    { const int t_ = otid(); const int w_ = t_ >> 6; wr = w_ >> 2; wc = w_ & 3; fr = t_ & 15; fq = (t_ & 63) >> 4; }
    if (u.y & 0x100) {
      const int mt = u.y & 0xff, vq = u.x;
#pragma unroll
      for (int ai = 0; ai < 2; ++ai)
#pragma unroll
        for (int m = 0; m < 4; ++m) {
          const int nn = vq * 256 + ai * 128 + wr * 64 + m * 16 + fr;
          const int hh = nn >> 7, v = nn & 127;
#pragma unroll
          for (int bj = 0; bj < 2; ++bj)
#pragma unroll
            for (int n = 0; n < 2; ++n) {
              const int tokl = bj * 128 + wc * 32 + n * 16 + 4 * fq;
              f32x4 a4 = acc[ai][bj][m][n];
              uint2 pk = make_uint2(pack2(a4[0], a4[1]), pack2(a4[2], a4[3]));
              if (mt < 32) {
                *(uint2*)(ws + OFF_VTC + ((size_t)((mt * 4 + hh) * 128 + v) * 256 + tokl) * 2) = pk;
                float* o = out + OCV + ((size_t)((mt * 2 + l) * 256 + tokl)) * 512 + nn;
                o[0] = a4[0]; o[512] = a4[1]; o[1024] = a4[2]; o[1536] = a4[3];
              } else {
                int rp = (mt - 32) * 256 + tokl; int bb = rp >> 11, t = rp & 2047;
                *(uint2*)(ws + OFF_VTL + l * SZ_VTL + ((size_t)((bb * 4 + hh) * 128 + v) * 2304 + t) * 2) = pk;
              }
            }
        }
      return;
    }
    const int pm = u.x, pn = u.y, seg = pn >> 1, ncol0 = (pn & 1) * 256;
    const int dcol0 = ((seg < 7) ? seg : seg - 1) * 512 + ncol0;
    u16* proj = (u16*)(ws + OFF_PROJ);
    const bool lat = (pm >= 32);
    if (seg == 5 || seg == 6) {
      float* xch = (float*)(lds + G8_STAGE_BYTES);
#pragma unroll
      for (int ai = 0; ai < 2; ++ai)
#pragma unroll
        for (int m = 0; m < 4; ++m)
#pragma unroll
          for (int bj = 0; bj < 2; ++bj) {
            float ss = 0.f;
#pragma unroll
            for (int n = 0; n < 2; ++n)
#pragma unroll
              for (int e = 0; e < 4; ++e) { float bfv = bf2f(f2bf(acc[ai][bj][m][n][e])); ss += bfv * bfv; }
            ss += __shfl_xor(ss, 16); ss += __shfl_xor(ss, 32);
            if (fq == 0) xch[((ai * 128 + wr * 64 + m * 16 + fr) * 2 + bj) * 4 + wc] = ss;
          }
      asm volatile("s_waitcnt lgkmcnt(0)" ::: "memory");
      __builtin_amdgcn_s_barrier();
      asm volatile("" ::: "memory");
      const float* gsel = (seg == 5) ? qng : kng;
      float gv[2][4];
#pragma unroll
      for (int n = 0; n < 2; ++n)
#pragma unroll
        for (int e = 0; e < 4; ++e) gv[n][e] = gsel[l * 64 + 32 * (wc & 1) + 16 * n + 4 * fq + e];
#pragma unroll
      for (int ai = 0; ai < 2; ++ai)
#pragma unroll
        for (int m = 0; m < 4; ++m) {
          const int rl = ai * 128 + wr * 64 + m * 16 + fr;
          const int grow = pm * 256 + rl;
#pragma unroll
          for (int bj = 0; bj < 2; ++bj) {
            const float2 pr = *(const float2*)&xch[(rl * 2 + bj) * 4 + (wc & 2)];
            const float tot = pr.x + pr.y;
            const float rinv = rsqrtf(tot * (1.f / 64.f) + EPSV);
            float x[2][4];
#pragma unroll
            for (int n = 0; n < 2; ++n)
#pragma unroll
              for (int e = 0; e < 4; ++e) x[n][e] = bf2f(f2bf(acc[ai][bj][m][n][e])) * rinv * gv[n][e];
            const int colt = ncol0 + bj * 128 + wc * 32;
            if (seg == 6 && !lat) {
              float* o = out + OCK + ((size_t)((pm * 2 + l) * 256 + rl)) * 512 + colt + 4 * fq;
              *(float4*)o = make_float4(x[0][0], x[0][1], x[0][2], x[0][3]);
              *(float4*)(o + 16) = make_float4(x[1][0], x[1][1], x[1][2], x[1][3]);
            }
            if (lat) {
              const int t = (grow - NCTX) & 2047;
              const float2* rt = (const float2*)(ws + OFF_ROPE) + t * 32 + ((wc & 1) ? 16 : 0) + 4 * fq;
#pragma unroll
              for (int e = 0; e < 4; ++e) {
                float2 cs = rt[e];
                float x1 = x[0][e], x2 = x[1][e];
                x[0][e] = x1 * cs.x - x2 * cs.y;
                x[1][e] = x1 * cs.y + x2 * cs.x;
              }
            }
            if (seg == 5) {
#pragma unroll
              for (int n = 0; n < 2; ++n)
#pragma unroll
                for (int e = 0; e < 4; ++e) x[n][e] *= 0.125f;
            }
            u16* dp = proj + (size_t)grow * LDP + dcol0 + bj * 128 + wc * 32 + 4 * fq;
            *(uint2*)dp = make_uint2(pack2(x[0][0], x[0][1]), pack2(x[0][2], x[0][3]));
            *(uint2*)(dp + 16) = make_uint2(pack2(x[1][0], x[1][1]), pack2(x[1][2], x[1][3]));
          }
        }
      return;
    }
    const bool dosilu = (seg == 0 || seg == 4 || seg == 8 || seg == 10);
    const bool dolf = (seg == 1 || seg == 2);
    const int dir = (seg == 2) ? 1 : 0;
#define P2_STORE16(A0, A1) *(uint4*)(proj + (size_t)grow * LDP + dcol0 + bj * 128 + wc * 32 + 8 * fq) = make_uint4(pack2(A0[0], A0[1]), pack2(A0[2], A0[3]), pack2(A1[0], A1[1]), pack2(A1[2], A1[3]))
    if (dosilu) {
#pragma unroll
      for (int ai = 0; ai < 2; ++ai)
#pragma unroll
        for (int m = 0; m < 4; ++m) {
          const int grow = pm * 256 + ai * 128 + wr * 64 + m * 16 + fr;
#pragma unroll
          for (int bj = 0; bj < 2; ++bj) {
            f32x4 a0 = acc[ai][bj][m][0], a1 = acc[ai][bj][m][1];
#pragma unroll
            for (int e = 0; e < 4; ++e) { a0[e] = siluf(a0[e]); a1[e] = siluf(a1[e]); }
            P2_STORE16(a0, a1);
          }
        }
    } else if (dolf) {
#pragma unroll
      for (int bj = 0; bj < 2; ++bj) {
        float lbv[2][4];
#pragma unroll
        for (int n = 0; n < 2; ++n)
#pragma unroll
          for (int e = 0; e < 4; ++e) {
            int j = ncol0 + bj * 128 + wc * 32 + 8 * fq + 4 * n + e;
            lbv[n][e] = (l == 0) ? 0.f : sigmf(hlb[(1 * 2 + dir) * 512 + j] - hlb[(0 * 2 + dir) * 512 + j]);
          }
#pragma unroll
        for (int ai = 0; ai < 2; ++ai)
#pragma unroll
          for (int m = 0; m < 4; ++m) {
            const int grow = pm * 256 + ai * 128 + wr * 64 + m * 16 + fr;
            f32x4 a0 = acc[ai][bj][m][0], a1 = acc[ai][bj][m][1];
#pragma unroll
            for (int e = 0; e < 4; ++e) { a0[e] = logf_gate(a0[e], lbv[0][e]); a1[e] = logf_gate(a1[e], lbv[1][e]); }
            P2_STORE16(a0, a1);
          }
      }
    } else {
#pragma unroll
      for (int ai = 0; ai < 2; ++ai)
#pragma unroll
        for (int m = 0; m < 4; ++m) {
          const int grow = pm * 256 + ai * 128 + wr * 64 + m * 16 + fr;
#pragma unroll
          for (int bj = 0; bj < 2; ++bj) {
            f32x4 a0 = acc[ai][bj][m][0], a1 = acc[ai][bj][m][1];
            P2_STORE16(a0, a1);
          }
        }
    }
  }
};
__device__ __forceinline__ void p2_left_item(const Params& p, int l, int L, char* lds) {
  P2Sched S0; S0.H = p.ws + OFF_H; S0.W = p.ws + OFF_WIN; S0.G = 0x40000000; S0.c = 0;
  OneUnit S;
  {
    const int r = L - 960; const int vq = r / 48, mt = r % 48;
    S.u.a = S0.W + (size_t)(3584 + vq * 256) * 2048; S.u.b = S0.H + (size_t)mt * 256 * 2048; S.u.x = vq; S.u.y = mt | 0x100;
    S.u.lda = 1024; S.u.ldb = 1024; S.u.nt = 16;
  }
  P2Epi E; E.pin = nullptr; E.out = p.out; E.ws = p.ws; E.l = l; E.hlb = p.in[11]; E.qng = p.in[13]; E.kng = p.in[14]; E.skip = false;
  gemm_phase((LAS unsigned char*)lds, S, E);
}
__device__ __forceinline__ void p2_phase(const Params& p, int l, char* lds, bool skip = false) {
  if (STAGGER_US && ((blockIdx.x >> 3) & 1)) stagger_us(STAGGER_US);
  P2Sched S; S.H = p.ws + OFF_H; S.W = p.ws + OFF_WIN; S.G = gridDim.x; S.c = blockIdx.x;
  P2Epi E; E.pin = nullptr; E.out = p.out; E.ws = p.ws; E.l = l; E.hlb = p.in[11]; E.qng = p.in[13]; E.kng = p.in[14]; E.skip = skip;
  gemm_phase((LAS unsigned char*)lds, S, E);
}

struct HgrnLds {
  float tot[4][128];
  float dk[128];
  float osum[16][132];
  u16 qt[16][136];
  u16 kt[16][136];
  u16 khT[128][20];
  u16 vT[128][20];
  u16 zt[16][136];
  u16 obuf[256][136];
};

#define LBAR() do { asm volatile("s_waitcnt lgkmcnt(0)" ::: "memory"); __builtin_amdgcn_s_barrier(); asm volatile("" ::: "memory"); } while (0)
__device__ __forceinline__ void hgrn_pass(const Params& p, int l, int row0, int ntok, int h, int dir, f32x4 (&S)[8],
                                          const bool do_out, const bool second, float& gsum, HgrnLds& L, const bool dry = false) {
  const int tid = otid(), lane = tid & 63, wid = tid >> 6, c16 = lane & 15, g = lane >> 4;
  const int kk = tid & 127, tq = tid >> 7;
  const u16* proj = (const u16*)(p.ws + OFF_PROJ);
  u16* projw = (u16*)(p.ws + OFF_PROJ);
  const int nch = ntok >> 4;
  float4 gg = make_float4(0.f, 0.f, 0.f, 0.f);
  if (second) gg = *(const float4*)(p.in[12] + l * 512 + h * 128 + 4 * (tid & 31));
  u16 lfA[4], qA[4], vA[4], zA[4], lfB[4], qB[4], vB[4], zB[4];
#define HG_LD(c_, LF, QQ, VV, ZZ)                                                    \
  {                                                                                  \
    _Pragma("unroll") for (int i = 0; i < 4; ++i) {                                  \
      int s_ = (c_) * 16 + 4 * tq + i;                                               \
      int tl_ = dir ? (ntok - 1 - s_) : s_;                                          \
      const u16* rp_ = proj + (size_t)(row0 + tl_) * LDP + h * 128 + kk;             \
      LF[i] = rp_[PLF + dir * 512];                                                  \
      VV[i] = rp_[PIA];                                                              \
      QQ[i] = do_out ? rp_[PQA] : (u16)0;                                            \
      ZZ[i] = second ? rp_[PZA] : (u16)0;                                            \
    }                                                                                \
  }
  HG_LD(0, lfA, qA, vA, zA);
  HG_LD(1, lfB, qB, vB, zB);
  auto body = [&](const int c, u16 (&LF)[4], u16 (&QQ)[4], u16 (&VV)[4], u16 (&ZZ)[4]) __attribute__((always_inline)) {
    float lf[4], G[4], qv[4];
    u16 vv[4], zz[4];
#pragma unroll
    for (int i = 0; i < 4; ++i) { lf[i] = bf2f(LF[i]); qv[i] = bf2f(QQ[i]); vv[i] = VV[i]; zz[i] = ZZ[i]; }
    G[0] = lf[0]; G[1] = G[0] + lf[1]; G[2] = G[1] + lf[2]; G[3] = G[2] + lf[3];
    L.tot[tq][kk] = G[3];
    LBAR();
    if (c + 2 < nch) HG_LD(c + 2, LF, QQ, VV, ZZ);
    float t0 = L.tot[0][kk], t1 = L.tot[1][kk], t2 = L.tot[2][kk], t3 = L.tot[3][kk];
    float off = (tq > 0 ? t0 : 0.f) + (tq > 1 ? t1 : 0.f) + (tq > 2 ? t2 : 0.f);
    float gend = t0 + t1 + t2 + t3;
    float kh[4];
#pragma unroll
    for (int i = 0; i < 4; ++i) {
      float Gi = G[i] + off;
      float kv = neg_expm1(lf[i]);
      int s = 4 * tq + i;
      if (do_out) {
        L.qt[s][kk] = f2bf(qv[i] * fexp(Gi));
        L.kt[s][kk] = f2bf(kv * fexp(fminf(-Gi, 80.f)));
      }
      if (second) L.zt[s][kk] = zz[i];
      kh[i] = kv * fexp(gend - Gi);
    }
    *(uint2*)&L.khT[kk][4 * tq] = make_uint2(pack2(kh[0], kh[1]), pack2(kh[2], kh[3]));
    *(uint2*)&L.vT[kk][4 * tq] = make_uint2((uint32_t)vv[0] | ((uint32_t)vv[1] << 16), (uint32_t)vv[2] | ((uint32_t)vv[3] << 16));
    if (tq == 0) { L.dk[kk] = fexp(gend); gsum += gend; }
    LBAR();
    Frag bv;
    bv.h[0] = *(const uint2*)&L.vT[16 * wid + c16][4 * g];
    bv.h[1] = make_uint2(0u, 0u);
    f32x4 o = f32x4{0.f, 0.f, 0.f, 0.f};
    if (do_out) {
      f32x4 at = f32x4{0.f, 0.f, 0.f, 0.f};
#pragma unroll
      for (int ks = 0; ks < 4; ++ks) {
        Frag a, b;
        a.q = *(const uint4*)&L.kt[c16][32 * ks + 8 * g];
        b.q = *(const uint4*)&L.qt[c16][32 * ks + 8 * g];
        at = MFMA(a.v, b.v, at);
      }
      Frag pa;
#pragma unroll
      for (int r = 0; r < 4; ++r) at[r] = (4 * g + r <= c16) ? at[r] : 0.f;
      pa.w[0] = pack2(at[0], at[1]); pa.w[1] = pack2(at[2], at[3]); pa.w[2] = 0u; pa.w[3] = 0u;
      o = MFMA(pa.v, bv.v, o);
#pragma unroll
      for (int st = 0; st < 4; ++st) {
        Frag a, b;
        a.h[0] = *(const uint2*)&L.qt[c16][32 * st + 4 * g];
        a.h[1] = *(const uint2*)&L.qt[c16][32 * st + 16 + 4 * g];
        b.w[0] = pack2(S[2 * st][0], S[2 * st][1]); b.w[1] = pack2(S[2 * st][2], S[2 * st][3]);
        b.w[2] = pack2(S[2 * st + 1][0], S[2 * st + 1][1]); b.w[3] = pack2(S[2 * st + 1][2], S[2 * st + 1][3]);
        o = MFMA(a.v, b.v, o);
      }
    }
#pragma unroll
    for (int k8 = 0; k8 < 8; ++k8) {
      float4 d = *(const float4*)&L.dk[16 * k8 + 4 * g];
      f32x4 s0 = S[k8];
      s0[0] *= d.x; s0[1] *= d.y; s0[2] *= d.z; s0[3] *= d.w;
      Frag a;
      a.h[0] = *(const uint2*)&L.khT[16 * k8 + c16][4 * g];
      a.h[1] = make_uint2(0u, 0u);
      S[k8] = MFMA(a.v, bv.v, s0);
    }
    if (do_out) {
      const int vcol = 16 * wid + c16;
      if (!second) {
#pragma unroll
        for (int r = 0; r < 4; ++r) {
          int s = c * 16 + 4 * g + r;
          int tl = dir ? (ntok - 1 - s) : s;
          L.obuf[tl][vcol] = f2bf(o[r]);
        }
      } else {
#pragma unroll
        for (int r = 0; r < 4; ++r) {
          int s = c * 16 + 4 * g + r;
          int tl = dir ? (ntok - 1 - s) : s;
          L.osum[4 * g + r][vcol] = o[r] + bf2f(L.obuf[tl][vcol]);
        }
        LBAR();
        {
          int sl = tid >> 5, vq = tid & 31;
          int s = c * 16 + sl;
          int tl = dir ? (ntok - 1 - s) : s;
          float4 ov = *(const float4*)&L.osum[sl][4 * vq];
          float ss = ov.x * ov.x + ov.y * ov.y + ov.z * ov.z + ov.w * ov.w;
#pragma unroll
          for (int m = 1; m <= 16; m <<= 1) ss += __shfl_xor(ss, m);
          float rinv = rsqrtf(ss * (1.f / 128.f) + EPSV);
          u16* rp = projw + (size_t)(row0 + tl) * LDP + h * 128 + 4 * vq;
          uint2 z = *(const uint2*)&L.zt[sl][4 * vq];
          float y0 = ov.x * rinv * gg.x * lo2f(z.x), y1 = ov.y * rinv * gg.y * hi2f(z.x);
          float y2 = ov.z * rinv * gg.z * lo2f(z.y), y3 = ov.w * rinv * gg.w * hi2f(z.y);
          if (!dry) *(uint2*)(rp + PQA) = make_uint2(pack2(y0, y1), pack2(y2, y3));
        }
      }
    }
  };
  for (int c = 0; c < nch; c += 2) {
    body(c, lfA, qA, vA, zA);
    body(c + 1, lfB, qB, vB, zB);
  }
  __syncthreads();
}

__device__ __forceinline__ void hgrn_load_state(const float* m, f32x4 (&S)[8]) {
  const int tid_ = otid(); const int lane = tid_ & 63, wid = tid_ >> 6, c16 = lane & 15, g = lane >> 4;
#pragma unroll
  for (int k8 = 0; k8 < 8; ++k8)
#pragma unroll
    for (int r = 0; r < 4; ++r) S[k8][r] = m[(16 * k8 + 4 * g + r) * 128 + 16 * wid + c16];
}
__device__ __forceinline__ void hgrn_store_state(float* m, const f32x4 (&S)[8]) {
  const int tid_ = otid(); const int lane = tid_ & 63, wid = tid_ >> 6, c16 = lane & 15, g = lane >> 4;
#pragma unroll
  for (int k8 = 0; k8 < 8; ++k8)
#pragma unroll
    for (int r = 0; r < 4; ++r) m[(16 * k8 + 4 * g + r) * 128 + 16 * wid + c16] = S[k8][r];
}
__device__ __forceinline__ void hgrn_advance(const float* U, const float* D, f32x4 (&S)[8]) {
  const int tid_ = otid(); const int lane = tid_ & 63, wid = tid_ >> 6, c16 = lane & 15, g = lane >> 4;
#pragma unroll
  for (int k8 = 0; k8 < 8; ++k8)
#pragma unroll
    for (int r = 0; r < 4; ++r) {
      int k = 16 * k8 + 4 * g + r;
      S[k8][r] = D[k] * S[k8][r] + U[k * 128 + 16 * wid + c16];
    }
}

__device__ __forceinline__ void hgrn_ctx_item(const Params& p, int l, int item, char* lds, const bool dry = false) {
  HgrnLds& L = *(HgrnLds*)lds;
  const int b = item >> 2, h = item & 3;
  f32x4 S[8];
  float gsum = 0.f;
#pragma unroll
  for (int i = 0; i < 8; ++i) S[i] = f32x4{0.f, 0.f, 0.f, 0.f};
  hgrn_pass(p, l, b * 256, 256, h, 0, S, true, false, gsum, L, dry);
  if (!dry) hgrn_store_state(p.out + OST + ((size_t)(((b * 2 + l) * 2 + 0) * 4 + h)) * 16384, S);
#pragma unroll
  for (int i = 0; i < 8; ++i) S[i] = f32x4{0.f, 0.f, 0.f, 0.f};
  hgrn_pass(p, l, b * 256, 256, h, 1, S, true, true, gsum, L, dry);
  if (!dry) hgrn_store_state(p.out + OST + ((size_t)(((b * 2 + l) * 2 + 1) * 4 + h)) * 16384, S);
}
__device__ __forceinline__ void hgrn_lat1_item(const Params& p, int l, int item, char* lds) {
  HgrnLds& L = *(HgrnLds*)lds;
  const int seg = item & 15, dir = (item >> 4) & 1, h = (item >> 5) & 3, b = item >> 7;
  f32x4 S[8];
  float gsum = 0.f;
#pragma unroll
  for (int i = 0; i < 8; ++i) S[i] = f32x4{0.f, 0.f, 0.f, 0.f};
  hgrn_pass(p, l, NCTX + b * 2048 + seg * 128, 128, h, dir, S, false, false, gsum, L);
  float* SU = (float*)(p.ws + OFF_SEGU);
  float* SD = (float*)(p.ws + OFF_SEGD);
  {
    const int tq_ = otid(); const int lane_ = tq_ & 63, wid_ = tq_ >> 6, c16_ = lane_ & 15, g_ = lane_ >> 4;
    float* m_ = SU + (size_t)item * 16384;
#pragma unroll
    for (int k8 = 0; k8 < 8; ++k8)
#pragma unroll
      for (int r = 0; r < 4; ++r) __hip_atomic_store(m_ + (16 * k8 + 4 * g_ + r) * 128 + 16 * wid_ + c16_, S[k8][r], __ATOMIC_RELAXED, __HIP_MEMORY_SCOPE_AGENT);
  }
  const int t_ = otid();
  if (t_ < 128) __hip_atomic_store(SD + item * 128 + t_, fexp(gsum), __ATOMIC_RELAXED, __HIP_MEMORY_SCOPE_AGENT);
  volatile int* flag = (volatile int*)(lds + LDS_TILE + 32);
  asm volatile("s_waitcnt vmcnt(0)" ::: "memory");
  __syncthreads();
  if (t_ == 0) {
    unsigned* tk = (unsigned*)(p.ws + OFF_CNT) + 8 + l * 32 + (item >> 4);
    const unsigned old = __hip_atomic_fetch_add(tk, 1u, __ATOMIC_RELAXED, __HIP_MEMORY_SCOPE_AGENT);
    const int last = (old == 15u) ? 1 : 0;
    if (last) { __builtin_amdgcn_fence(__ATOMIC_ACQUIRE, "agent"); asm volatile("s_waitcnt vmcnt(0)" ::: "memory"); }
    *flag = last;
  }
  __syncthreads();
  if (*flag) {
    const int base = (item >> 4) * 16;
    hgrn_load_state(p.in[5] + ((size_t)(((b * 2 + l) * 2 + dir) * 4 + h)) * 16384, S);
    const int lane = t_ & 63, wid = t_ >> 6, c16 = lane & 15, g = lane >> 4;
    float un[8][4]; float4 dn[8];
    {
      const int sg0 = dir ? 15 : 0;
      const float* U0 = SU + (size_t)(base + sg0) * 16384; const float* D0 = SD + (base + sg0) * 128;
#pragma unroll
      for (int k8 = 0; k8 < 8; ++k8) {
        dn[k8] = *(const float4*)(D0 + 16 * k8 + 4 * g);
#pragma unroll
        for (int r = 0; r < 4; ++r) un[k8][r] = U0[(16 * k8 + 4 * g + r) * 128 + 16 * wid + c16];
      }
    }
#pragma unroll 1
    for (int i = 0; i < 16; ++i) {
      const int sg = dir ? (15 - i) : i;
      float* U = SU + (size_t)(base + sg) * 16384;
      float uc[8][4]; float4 dc[8];
#pragma unroll
      for (int k8 = 0; k8 < 8; ++k8) { dc[k8] = dn[k8];
#pragma unroll
        for (int r = 0; r < 4; ++r) uc[k8][r] = un[k8][r]; }
      if (i + 1 < 16) {
        const int sgn = dir ? (14 - i) : (i + 1);
        const float* Un = SU + (size_t)(base + sgn) * 16384; const float* Dn = SD + (base + sgn) * 128;
#pragma unroll
        for (int k8 = 0; k8 < 8; ++k8) {
          dn[k8] = *(const float4*)(Dn + 16 * k8 + 4 * g);
#pragma unroll
          for (int r = 0; r < 4; ++r) un[k8][r] = Un[(16 * k8 + 4 * g + r) * 128 + 16 * wid + c16];
        }
      }
#pragma unroll
      for (int k8 = 0; k8 < 8; ++k8) {
        const float dd[4] = {dc[k8].x, dc[k8].y, dc[k8].z, dc[k8].w};
#pragma unroll
        for (int r = 0; r < 4; ++r) {
          const int idx = (16 * k8 + 4 * g + r) * 128 + 16 * wid + c16;
          U[idx] = S[k8][r];
          S[k8][r] = dd[r] * S[k8][r] + uc[k8][r];
        }
      }
    }
  }
  __syncthreads();
}
__device__ __forceinline__ void hgrn_lat2_item(const Params& p, int l, int item, char* lds, const bool dry = false) {
  HgrnLds& L = *(HgrnLds*)lds;
  const int seg = item & 15, h = (item >> 4) & 3, b = item >> 6;
  const float* SU = (const float*)(p.ws + OFF_SEGU);
  const float* SD = (const float*)(p.ws + OFF_SEGD);
  f32x4 S[8];
  float gsum = 0.f;
  hgrn_load_state(SU + (size_t)(((b * 4 + h) * 2 + 0) * 16 + seg) * 16384, S);
  hgrn_pass(p, l, NCTX + b * 2048 + seg * 128, 128, h, 0, S, true, false, gsum, L, dry);
  hgrn_load_state(SU + (size_t)(((b * 4 + h) * 2 + 1) * 16 + seg) * 16384, S);
  hgrn_pass(p, l, NCTX + b * 2048 + seg * 128, 128, h, 1, S, true, true, gsum, L, dry);
}

__device__ __forceinline__ void attn_item(const Params& p, int l, int item, const bool lat, char* lds, const bool dry = false) {
  const int tid = otid(), lane = tid & 63, wid = tid >> 6, c16 = lane & 15, g = lane >> 4;
  char* ws = p.ws;
  u16* proj = (u16*)(ws + OFF_PROJ);
  int b, h, qb, nkeys, rowbase;
  const u16* Vt; int ldv;
  if (!lat) { qb = item & 1; h = (item >> 1) & 3; b = item >> 3; nkeys = 256; rowbase = b * 256; Vt = (const u16*)(ws + OFF_VTC) + (size_t)((b * 4 + h) * 128) * 256; ldv = 256; }
  else { qb = item & 15; h = (item >> 4) & 3; b = item >> 6; nkeys = 2304; rowbase = NCTX + b * 2048; Vt = (const u16*)(ws + OFF_VTL + l * SZ_VTL) + (size_t)((b * 4 + h) * 128) * 2304; ldv = 2304; }
  const u16* Kc = (const u16*)(ws + OFF_KC) + (size_t)((l * 2 + b) * 256) * 512 + h * 128;
  u16* Ks = (u16*)lds;
  u16* Vs = Ks + 64 * 144;
  float lam_init = 0.8f - 0.6f * expf(-0.3f * (float)l);
  float lam;
  {
    const float* lp = p.in[15] + l * 256;
    float a = lp[lane] * lp[64 + lane], c = lp[128 + lane] * lp[192 + lane];
#pragma unroll
    for (int o = 32; o >= 1; o >>= 1) { a += __shfl_xor(a, o); c += __shfl_xor(c, o); }
    lam = expf(a) - expf(c) + lam_init;
  }
  const int qrow = rowbase + qb * 128 + wid * 16 + c16;
  Frag qf[2][2];
#pragma unroll
  for (int m = 0; m < 2; ++m)
#pragma unroll
    for (int ks = 0; ks < 2; ++ks) qf[m][ks].q = *(const uint4*)(proj + (size_t)qrow * LDP + PQB + h * 128 + m * 64 + ks * 32 + g * 8);
  f32x4 O[2][8];
#pragma unroll
  for (int m = 0; m < 2; ++m)
#pragma unroll
    for (int v = 0; v < 8; ++v) O[m][v] = f32x4{0.f, 0.f, 0.f, 0.f};
  float mrun[2] = {-1e30f, -1e30f}, lsum[2] = {0.f, 0.f};
  uint4 kr0, kr1, vr0, vr1;
#define ATT_LD(kt_)                                                                                           \
  {                                                                                                           \
    const int key0 = (kt_) * 64;                                                                              \
    const bool fromproj = (!lat) || (key0 < 2048);                                                            \
    {                                                                                                         \
      int q = tid; int key = q >> 4, cc = q & 15;                                                             \
      const u16* src = fromproj ? proj + (size_t)(rowbase + key0 + key) * LDP + PKB + h * 128 + cc * 8        \
                                : Kc + (size_t)(key0 - 2048 + key) * 512 + cc * 8;                            \
      kr0 = *(const uint4*)src;                                                                               \
      int v = q >> 3, c8 = q & 7;                                                                             \
      vr0 = *(const uint4*)(Vt + (size_t)v * ldv + key0 + c8 * 8);                                            \
    }                                                                                                         \
    {                                                                                                         \
      int q = tid + 512; int key = q >> 4, cc = q & 15;                                                       \
      const u16* src = fromproj ? proj + (size_t)(rowbase + key0 + key) * LDP + PKB + h * 128 + cc * 8        \
                                : Kc + (size_t)(key0 - 2048 + key) * 512 + cc * 8;                            \
      kr1 = *(const uint4*)src;                                                                               \
      int v = q >> 3, c8 = q & 7;                                                                             \
      vr1 = *(const uint4*)(Vt + (size_t)v * ldv + key0 + c8 * 8);                                            \
    }                                                                                                         \
  }
#define ATT_ST()                                                                                              \
  {                                                                                                           \
    { int q = tid; int key = q >> 4, cc = q & 15; *(uint4*)(Ks + key * 144 + cc * 8) = kr0;                   \
      int v = q >> 3, c8 = q & 7; *(uint4*)(Vs + v * 72 + c8 * 8) = vr0; }                                    \
    { int q = tid + 512; int key = q >> 4, cc = q & 15; *(uint4*)(Ks + key * 144 + cc * 8) = kr1;             \
      int v = q >> 3, c8 = q & 7; *(uint4*)(Vs + v * 72 + c8 * 8) = vr1; }                                    \
  }
  const int nkt = nkeys >> 6;
  ATT_LD(0);
  for (int kt = 0; kt < nkt; ++kt) {
    LBAR();
    ATT_ST();
    LBAR();
    if (kt + 1 < nkt) ATT_LD(kt + 1);
    Frag pf[2][2];
#pragma unroll
    for (int m = 0; m < 2; ++m) {
      f32x4 s[4];
#pragma unroll
      for (int k4 = 0; k4 < 4; ++k4) {
        s[k4] = f32x4{0.f, 0.f, 0.f, 0.f};
#pragma unroll
        for (int ks = 0; ks < 2; ++ks) {
          Frag a;
          a.q = *(const uint4*)(Ks + (16 * k4 + c16) * 144 + m * 64 + ks * 32 + g * 8);
          s[k4] = MFMA(a.v, qf[m][ks].v, s[k4]);
        }
      }
      float mx = -1e30f;
#pragma unroll
      for (int k4 = 0; k4 < 4; ++k4)
#pragma unroll
        for (int r = 0; r < 4; ++r) mx = fmaxf(mx, s[k4][r]);
      mx = fmaxf(mx, __shfl_xor(mx, 16));
      mx = fmaxf(mx, __shfl_xor(mx, 32));
      if (__any(mx - mrun[m] > 4.0f)) {
        const float mnew = fmaxf(mrun[m], mx);
        const float alpha = fexp(mrun[m] - mnew);
        mrun[m] = mnew;
        lsum[m] *= alpha;
#pragma unroll
        for (int v = 0; v < 8; ++v) { O[m][v][0] *= alpha; O[m][v][1] *= alpha; O[m][v][2] *= alpha; O[m][v][3] *= alpha; }
      }
      const float mneg = -mrun[m] * 1.4426950408889634f;
      float ps = 0.f;
#pragma unroll
      for (int k4 = 0; k4 < 4; ++k4)
#pragma unroll
        for (int r = 0; r < 4; ++r) { s[k4][r] = __builtin_amdgcn_exp2f(fmaf(s[k4][r], 1.4426950408889634f, mneg)); ps += s[k4][r]; }
      lsum[m] += ps;
#pragma unroll
      for (int sp = 0; sp < 2; ++sp) {
        pf[m][sp].w[0] = pack2(s[2 * sp][0], s[2 * sp][1]); pf[m][sp].w[1] = pack2(s[2 * sp][2], s[2 * sp][3]);
        pf[m][sp].w[2] = pack2(s[2 * sp + 1][0], s[2 * sp + 1][1]); pf[m][sp].w[3] = pack2(s[2 * sp + 1][2], s[2 * sp + 1][3]);
      }
    }
#pragma unroll
    for (int v = 0; v < 8; ++v)
#pragma unroll
      for (int sp = 0; sp < 2; ++sp) {
        Frag a;
        a.h[0] = *(const uint2*)(Vs + (16 * v + c16) * 72 + 32 * sp + 4 * g);
        a.h[1] = *(const uint2*)(Vs + (16 * v + c16) * 72 + 32 * sp + 16 + 4 * g);
        O[0][v] = MFMA(a.v, pf[0][sp].v, O[0][v]);
        O[1][v] = MFMA(a.v, pf[1][sp].v, O[1][v]);
      }
  }
  float l0 = lsum[0], l1 = lsum[1];
  l0 += __shfl_xor(l0, 16); l0 += __shfl_xor(l0, 32);
  l1 += __shfl_xor(l1, 16); l1 += __shfl_xor(l1, 32);
  const float i0 = 1.f / l0, i1 = lam / l1;
  float ss = 0.f;
#pragma unroll
  for (int v = 0; v < 8; ++v)
#pragma unroll
    for (int r = 0; r < 4; ++r) { float o = O[0][v][r] * i0 - O[1][v][r] * i1; O[0][v][r] = o; ss += o * o; }
  ss += __shfl_xor(ss, 16); ss += __shfl_xor(ss, 32);
  const float rinv = rsqrtf(ss * (1.f / 128.f) + EPSV) * (1.f - lam_init);
  u16* rp = proj + (size_t)qrow * LDP + h * 128;
#pragma unroll
  for (int v = 0; v < 8; ++v) {
    int vc = 16 * v + 4 * g;
    float4 sg = *(const float4*)(p.in[16] + l * 128 + vc);
    uint2 z = *(const uint2*)(rp + PZB + vc);
    float y0 = O[0][v][0] * rinv * sg.x * lo2f(z.x), y1 = O[0][v][1] * rinv * sg.y * hi2f(z.x);
    float y2 = O[0][v][2] * rinv * sg.z * lo2f(z.y), y3 = O[0][v][3] * rinv * sg.w * hi2f(z.y);
    if (!dry) *(uint2*)(rp + PQB + vc) = make_uint2(pack2(y0, y1), pack2(y2, y3));
  }
  __syncthreads();
}

__device__ __forceinline__ void f1_item(const Params& p, int item, char* lds) {
  const int tid = otid(), lane = tid & 63, wid = tid >> 6, wr = wid >> 2, wc = wid & 3, fr = lane & 15, fq = lane >> 4;
  char* ws = p.ws;
  const int jh = item & 1, gq = (item >> 1) & 3, mt = item >> 3;
  f32x4 acc[4][4];
  gemm_kloop<128>((const u16*)(ws + OFF_B1) + jh * 128 * 128, 128, (const u16*)(ws + OFF_PROJ) + (size_t)(mt * 256) * LDP + PUC + gq * 128, LDP, 128, acc, lds);
#pragma unroll
  for (int a = 0; a < 4; ++a)
#pragma unroll
    for (int b = 0; b < 4; ++b) {
      int tokl = wc * 64 + a * 16 + 4 * fq;
      int jj = wr * 64 + b * 16 + fr;
      uint2 pk = make_uint2(pack2(acc[a][b][0], acc[a][b][1]), pack2(acc[a][b][2], acc[a][b][3]));
      if (mt < 32) {
        *(uint2*)(ws + OFF_PTC + ((size_t)((mt * 4 + gq) * 128 + jj) * 512 + jh * 256 + tokl) * 2) = pk;
      } else {
        int rp = (mt - 32) * 256 + tokl; int bb = rp >> 11, t = rp & 2047;
        *(uint2*)(ws + OFF_PTL + ((size_t)((bb * 4 + gq) * 128 + jj) * 4096 + jh * 2048 + t) * 2) = pk;
      }
    }
}

struct F2Epi {
  char* ws; float scl; int rowbase_mul;
  bool lat;
  __device__ __forceinline__ void operator()(f32x4 (&acc)[2][2][4][2], const Unit& u, int wr, int wc, int fr, int fq, LAS unsigned char* lds) const {
    u16* proj = (u16*)(ws + OFF_PROJ);
#pragma unroll
    for (int ai = 0; ai < 2; ++ai)
#pragma unroll
      for (int mh = 0; mh < 2; ++mh) {
        uint2 zv[2][2][2];
#pragma unroll
        for (int mm = 0; mm < 2; ++mm)
#pragma unroll
          for (int bj = 0; bj < 2; ++bj)
#pragma unroll
            for (int n = 0; n < 2; ++n) {
              const int tp = u.x * 256 + ai * 128 + wr * 64 + (mh * 2 + mm) * 16 + fr;
              const int nn = u.y * 256 + bj * 128 + wc * 32 + n * 16 + 4 * fq;
              const int bb = nn >> 9, col = nn & 511;
              const u16* rp = proj + (size_t)(lat ? (NCTX + bb * 2048 + tp) : (bb * 256 + tp)) * LDP;
              zv[mm][bj][n] = *(const uint2*)(rp + PZC + col);
            }
#pragma unroll
        for (int mm = 0; mm < 2; ++mm)
#pragma unroll
          for (int bj = 0; bj < 2; ++bj)
#pragma unroll
            for (int n = 0; n < 2; ++n) {
              const int m = mh * 2 + mm;
              const int tp = u.x * 256 + ai * 128 + wr * 64 + m * 16 + fr;
              const int nn = u.y * 256 + bj * 128 + wc * 32 + n * 16 + 4 * fq;
              const int bb = nn >> 9, col = nn & 511;
              u16* rp = proj + (size_t)(lat ? (NCTX + bb * 2048 + tp) : (bb * 256 + tp)) * LDP;
              const uint2 z = zv[mm][bj][n];
              f32x4 a4 = acc[ai][bj][m][n];
              *(uint2*)(rp + PUC + col) = make_uint2(pack2(a4[0] * scl * lo2f(z.x), a4[1] * scl * hi2f(z.x)),
                                                     pack2(a4[2] * scl * lo2f(z.y), a4[3] * scl * hi2f(z.y)));
            }
      }
  }
};
__device__ __forceinline__ void f2c_item(const Params& p, int item, char* lds) {
  OneUnit S; S.u.a = p.ws + OFF_DC; S.u.b = p.ws + OFF_PTC + (size_t)item * 256 * 1024; S.u.x = 0; S.u.y = item; S.u.lda = 512; S.u.ldb = 512; S.u.nt = 8;
  F2Epi E; E.ws = p.ws; E.scl = 0.005524271728019903f; E.lat = false; E.rowbase_mul = 0;
  gemm_phase((LAS unsigned char*)lds, S, E);
}
struct F2HalfEpi {
  uint2* part;
  __device__ __forceinline__ void operator()(f32x4 (&acc)[2][2][4][2], const Unit& u, int wr, int wc, int fr, int fq, LAS unsigned char* lds) const {
    const int tid = wr * 256 + wc * 64 + fq * 16 + fr;
#pragma unroll
    for (int ai = 0; ai < 2; ++ai)
#pragma unroll
      for (int bj = 0; bj < 2; ++bj)
#pragma unroll
        for (int m = 0; m < 4; ++m)
#pragma unroll
          for (int n = 0; n < 2; ++n) {
            f32x4 a4 = acc[ai][bj][m][n];
            __hip_atomic_store((unsigned long long*)(part + (((ai * 2 + bj) * 4 + m) * 2 + n) * 512 + tid), (unsigned long long)pack2(a4[0], a4[1]) | ((unsigned long long)pack2(a4[2], a4[3]) << 32), __ATOMIC_RELAXED, __HIP_MEMORY_SCOPE_AGENT);
          }
  }
};
__device__ __forceinline__ void f2l_item(const Params& p, int l, int item, char* lds) {
  char* ws = p.ws;
  const int tile = item >> 1, half = item & 1, mt = tile >> 2, nt = tile & 3;
  uint2* pbase = (uint2*)(ws + OFF_F2P);
  {
    OneUnit S; S.u.a = ws + OFF_DL + ((size_t)mt * 256 * 4096 + half * 2048) * 2; S.u.b = ws + OFF_PTL + ((size_t)nt * 256 * 4096 + half * 2048) * 2;
    S.u.x = mt; S.u.y = nt; S.u.lda = 4096; S.u.ldb = 4096; S.u.nt = 32;
    F2HalfEpi E; E.part = pbase + (size_t)(tile * 2 + half) * (32 * 512);
    gemm_phase((LAS unsigned char*)lds, S, E);
  }
  const int t_ = otid();
  volatile int* flag = (volatile int*)(lds + LDS_TILE + 32);
  asm volatile("s_waitcnt vmcnt(0)" ::: "memory");
  __syncthreads();
  if (t_ == 0) {
    unsigned* tk = (unsigned*)(ws + OFF_CNT) + 72 + l * 32 + tile;
    const unsigned old = __hip_atomic_fetch_add(tk, 1u, __ATOMIC_RELAXED, __HIP_MEMORY_SCOPE_AGENT);
    const int last = (old == 1u) ? 1 : 0;
    if (last) { __builtin_amdgcn_fence(__ATOMIC_ACQUIRE, "agent"); asm volatile("s_waitcnt vmcnt(0)" ::: "memory"); }
    *flag = last;
  }
  __syncthreads();
  if (*flag) {
    const int lane = t_ & 63, wid = t_ >> 6, wr = wid >> 2, wc = wid & 3, fr = lane & 15, fq = lane >> 4;
    const uint2* p0 = pbase + (size_t)(tile * 2 + 0) * (32 * 512);
    const uint2* p1 = pbase + (size_t)(tile * 2 + 1) * (32 * 512);
    u16* proj = (u16*)(ws + OFF_PROJ);
    const float scl = 1.f / 512.f;
#pragma unroll
    for (int ai = 0; ai < 2; ++ai)
#pragma unroll
      for (int mh = 0; mh < 2; ++mh) {
        uint2 zv[2][2][2], av[2][2][2], bv2[2][2][2];
#pragma unroll
        for (int mm = 0; mm < 2; ++mm)
#pragma unroll
          for (int bj = 0; bj < 2; ++bj)
#pragma unroll
            for (int n = 0; n < 2; ++n) {
              const int m = mh * 2 + mm;
              const int tp = mt * 256 + ai * 128 + wr * 64 + m * 16 + fr;
              const int nn = nt * 256 + bj * 128 + wc * 32 + n * 16 + 4 * fq;
              const int bb = nn >> 9, col = nn & 511;
              const u16* rp = proj + (size_t)(NCTX + bb * 2048 + tp) * LDP;
              zv[mm][bj][n] = *(const uint2*)(rp + PZC + col);
              const int idx = (((ai * 2 + bj) * 4 + m) * 2 + n) * 512 + t_;
              av[mm][bj][n] = p0[idx]; bv2[mm][bj][n] = p1[idx];
            }
#pragma unroll
        for (int mm = 0; mm < 2; ++mm)
#pragma unroll
          for (int bj = 0; bj < 2; ++bj)
#pragma unroll
            for (int n = 0; n < 2; ++n) {
              const int m = mh * 2 + mm;
              const int tp = mt * 256 + ai * 128 + wr * 64 + m * 16 + fr;
              const int nn = nt * 256 + bj * 128 + wc * 32 + n * 16 + 4 * fq;
              const int bb = nn >> 9, col = nn & 511;
              u16* rp = proj + (size_t)(NCTX + bb * 2048 + tp) * LDP;
              const uint2 z = zv[mm][bj][n], a = av[mm][bj][n], c = bv2[mm][bj][n];
              const float y0 = (lo2f(a.x) + lo2f(c.x)) * scl * lo2f(z.x), y1 = (hi2f(a.x) + hi2f(c.x)) * scl * hi2f(z.x);
              const float y2 = (lo2f(a.y) + lo2f(c.y)) * scl * lo2f(z.y), y3 = (hi2f(a.y) + hi2f(c.y)) * scl * hi2f(z.y);
              *(uint2*)(rp + PUC + col) = make_uint2(pack2(y0, y1), pack2(y2, y3));
            }
      }
  }
  __syncthreads();
}

__device__ __forceinline__ bool xcd_tile(int bid, int& pm, int& pn) {
  const int x = bid & 7, j = bid >> 3;
  if (j >= 24) return false;
  pm = 6 * x + (j >> 2); pn = j & 3;
  return true;
}
struct P5Sched {
  char* ws; int x, j;
  __device__ __forceinline__ bool next(int i, Unit& u) const {
    if (j < 24) {
      if (i >= 5) return false;
      const int pm = 6 * x + (j >> 2), pn = j & 3;
      const int jj = (i < 4) ? (i >> 1) : 2;
      if (i == 0 || i == 2) {
        u.a = ws + OFF_H + (size_t)pm * 256 * 2048; u.b = ws + OFF_WIN + (size_t)(5632 + jj * 1024 + pn * 256) * 2048;
        u.lda = 1024; u.ldb = 1024; u.nt = 16; u.x = pm; u.y = pn | (jj << 8);
      } else {
        const int yc = (jj == 0) ? PQA : ((jj == 1) ? PQB : PUC);
        u.a = ws + OFF_PROJ + ((size_t)pm * 256 * LDP + yc) * 2; u.b = ws + OFF_WBR + ((size_t)jj * 1024 * 512 + (size_t)pn * 256 * 512) * 2;
        u.lda = LDP; u.ldb = 512; u.nt = 8; u.x = pm; u.y = pn | (jj << 8) | ((i == 4) ? 0x2000 : 0x1000);
      }
      return true;
    }
    if (i >= 3) return false;
    const int tj = 3 * (j - 24) + i;
    const int pm = 6 * x + (tj >> 2), pn = tj & 3;
    u.a = ws + OFF_H + (size_t)pm * 256 * 2048; u.b = ws + OFF_WIN + (size_t)(5632 + 2 * 1024 + pn * 256) * 2048;
    u.lda = 1024; u.ldb = 1024; u.nt = 16; u.x = pm; u.y = pn | (2 << 8) | 0x3000;
    return true;
  }
};
struct P5Epi {
  char* ws; u16* mg; unsigned* flags; bool skip;
  __device__ __forceinline__ void operator()(f32x4 (&acc)[2][2][4][2], const Unit& u, int wr, int wc, int fr, int fq, LAS unsigned char* lds) const {
    if (skip) return;
    { const int t_ = otid(); const int w_ = t_ >> 6; wr = w_ >> 2; wc = w_ & 3; fr = t_ & 15; fq = (t_ & 63) >> 4; }
    const int tid = wr * 256 + wc * 64 + fq * 16 + fr;
    const int type = (u.y >> 12) & 3, j = (u.y >> 8) & 3, pn = u.y & 0xff, pm = u.x;
    const int tile = pm * 4 + pn;
    uint2* gs = (uint2*)(ws + OFF_SEGU) + (size_t)tile * (32 * 512);
    u16* g2p = (u16*)(ws + OFF_PROJ) + (size_t)pm * 256 * LDP + PLF + pn * 256;
    if (type == 0) {
#pragma unroll
      for (int ai = 0; ai < 2; ++ai)
#pragma unroll
        for (int bj = 0; bj < 2; ++bj)
#pragma unroll
          for (int m = 0; m < 4; ++m)
#pragma unroll
            for (int n = 0; n < 2; ++n) {
              f32x4 a4 = acc[ai][bj][m][n];
              gs[(((ai * 2 + bj) * 4 + m) * 2 + n) * 512 + tid] = make_uint2(pack2(sigmf(a4[0]), sigmf(a4[1])), pack2(sigmf(a4[2]), sigmf(a4[3])));
            }
      return;
    }
    if (type == 3) {
#pragma unroll
      for (int ai = 0; ai < 2; ++ai)
#pragma unroll
        for (int bj = 0; bj < 2; ++bj)
#pragma unroll
          for (int m = 0; m < 4; ++m)
#pragma unroll
            for (int n = 0; n < 2; ++n) {
              f32x4 a4 = acc[ai][bj][m][n];
              const int row = ai * 128 + wr * 64 + m * 16 + fr, col = bj * 128 + wc * 32 + n * 16 + 4 * fq;
              const unsigned long long v = (unsigned long long)pack2(sigmf(a4[0]), sigmf(a4[1])) | ((unsigned long long)pack2(sigmf(a4[2]), sigmf(a4[3])) << 32);
              __hip_atomic_store((unsigned long long*)(g2p + (size_t)row * LDP + col), v, __ATOMIC_RELAXED, __HIP_MEMORY_SCOPE_AGENT);
            }
      asm volatile("s_waitcnt vmcnt(0)" ::: "memory");
      if ((fq * 16 + fr) == 0) __hip_atomic_fetch_add(flags + tile, 1u, __ATOMIC_RELAXED, __HIP_MEMORY_SCOPE_AGENT);
      return;
    }
    if (type == 2) {
      if (tid == 0) {
        unsigned sp = 0;
        while (__hip_atomic_load(flags + tile, __ATOMIC_RELAXED, __HIP_MEMORY_SCOPE_AGENT) < 8u) { __builtin_amdgcn_s_sleep(2); if (++sp > (1u << 22)) break; }
        __builtin_amdgcn_fence(__ATOMIC_ACQUIRE, "agent");
        asm volatile("s_waitcnt vmcnt(0)" ::: "memory");
      }
      asm volatile("" ::: "memory");
      __builtin_amdgcn_s_barrier();
      asm volatile("" ::: "memory");
    }
#pragma unroll
    for (int ai = 0; ai < 2; ++ai)
#pragma unroll
      for (int mh = 0; mh < 2; ++mh) {
        uint2 gv[2][2][2], pv[2][2][2];
#pragma unroll
        for (int mm = 0; mm < 2; ++mm)
#pragma unroll
          for (int bj = 0; bj < 2; ++bj)
#pragma unroll
            for (int n = 0; n < 2; ++n) {
              const int m = mh * 2 + mm;
              const int rl = ai * 128 + wr * 64 + m * 16 + fr, cl = bj * 128 + wc * 32 + n * 16 + 4 * fq;
              const int row = pm * 256 + rl, col = pn * 256 + cl;
              const uint2* gptr = (type == 2) ? (const uint2*)(g2p + (size_t)rl * LDP + cl) : (const uint2*)(gs + (((ai * 2 + bj) * 4 + m) * 2 + n) * 512 + tid);
              gv[mm][bj][n] = *gptr;
              pv[mm][bj][n] = (j > 0) ? *(const uint2*)(mg + (size_t)row * 1024 + col) : make_uint2(0u, 0u);
            }
#pragma unroll
        for (int mm = 0; mm < 2; ++mm)
#pragma unroll
          for (int bj = 0; bj < 2; ++bj)
#pragma unroll
            for (int n = 0; n < 2; ++n) {
              const int m = mh * 2 + mm;
              const int row = pm * 256 + ai * 128 + wr * 64 + m * 16 + fr;
              const int col = pn * 256 + bj * 128 + wc * 32 + n * 16 + 4 * fq;
              f32x4 a4 = acc[ai][bj][m][n];
              const uint2 g2 = gv[mm][bj][n], p2 = pv[mm][bj][n];
              float t0 = lo2f(g2.x) * a4[0] + lo2f(p2.x), t1 = hi2f(g2.x) * a4[1] + hi2f(p2.x);
              float t2 = lo2f(g2.y) * a4[2] + lo2f(p2.y), t3 = hi2f(g2.y) * a4[3] + hi2f(p2.y);
              *(uint2*)(mg + (size_t)row * 1024 + col) = make_uint2(pack2(t0, t1), pack2(t2, t3));
            }
      }
  }
};
__device__ __forceinline__ void p5_phase(const Params& p, int l, char* lds, bool skip = false) {
  P5Sched S; S.ws = p.ws; S.x = blockIdx.x & 7; S.j = blockIdx.x >> 3;
  if (S.j >= 32) return;
  P5Epi E; E.ws = p.ws; E.mg = (u16*)(p.ws + OFF_MRG); E.flags = (unsigned*)(p.ws + OFF_CNT) + 136 + l * 192; E.skip = skip;
  gemm_phase((LAS unsigned char*)lds, S, E);
}

struct P6Epi {
  const float* xp0; const float* xs0; float* outp; const float* modp; int l;
  __device__ __forceinline__ void operator()(f32x4 (&acc)[2][2][4][2], const Unit& u, int wr, int wc, int fr, int fq, LAS unsigned char* lds) const {
    const int m0 = u.x * 256;
    const int ci = (m0 < NCTX) ? 0 : 1 + ((m0 - NCTX) >> 11);
    const float* xbase = (l == 0) ? ((m0 < NCTX) ? xp0 : xs0 - (size_t)NCTX * 1024) : outp;
    float4 gt[2][2];
#pragma unroll
    for (int bj = 0; bj < 2; ++bj)
#pragma unroll
      for (int n = 0; n < 2; ++n) gt[bj][n] = *(const float4*)(modp + (l * 3 + ci) * 3072 + 2048 + u.y * 256 + bj * 128 + wc * 32 + n * 16 + 4 * fq);
#pragma unroll
    for (int ai = 0; ai < 2; ++ai)
#pragma unroll
      for (int mh = 0; mh < 2; ++mh) {
        float4 xv[2][2][2];
#pragma unroll
        for (int mm = 0; mm < 2; ++mm)
#pragma unroll
          for (int bj = 0; bj < 2; ++bj)
#pragma unroll
            for (int n = 0; n < 2; ++n) {
              const int r = m0 + ai * 128 + wr * 64 + (mh * 2 + mm) * 16 + fr;
              const int col = u.y * 256 + bj * 128 + wc * 32 + n * 16 + 4 * fq;
              xv[mm][bj][n] = *(const float4*)(xbase + (size_t)r * 1024 + col);
            }
#pragma unroll
        for (int mm = 0; mm < 2; ++mm)
#pragma unroll
          for (int bj = 0; bj < 2; ++bj)
#pragma unroll
            for (int n = 0; n < 2; ++n) {
              const int m = mh * 2 + mm;
              const int r = m0 + ai * 128 + wr * 64 + m * 16 + fr;
              const int col = u.y * 256 + bj * 128 + wc * 32 + n * 16 + 4 * fq;
              f32x4 a4 = acc[ai][bj][m][n];
              const float4 x4 = xv[mm][bj][n], g4 = gt[bj][n];
              *(float4*)(outp + (size_t)r * 1024 + col) = make_float4(x4.x + g4.x * a4[0], x4.y + g4.y * a4[1], x4.z + g4.z * a4[2], x4.w + g4.w * a4[3]);
            }
      }
  }
};
__device__ __forceinline__ void p6_phase(const Params& p, int l, char* lds) {
  char* ws = p.ws;
  int pm, pn;
  if (!xcd_tile(blockIdx.x, pm, pn)) return;
  OneUnit S; S.u.a = ws + OFF_MRG + (size_t)pm * 256 * 2048; S.u.b = ws + OFF_WO + (size_t)pn * 256 * 2048; S.u.x = pm; S.u.y = pn;
  S.u.lda = 1024; S.u.ldb = 1024; S.u.nt = 16; S.reps = ((DUP_MASK & 512) && l == 0) ? 5 : 1;
  P6Epi E; E.xp0 = p.in[0]; E.xs0 = p.in[1]; E.outp = p.out; E.modp = (const float*)(ws + OFF_MOD); E.l = l;
  gemm_phase((LAS unsigned char*)lds, S, E);
}

#define XB_TMO      128
#define XB_XCNT(j)  (256  + 64 * (j))
#define XB_XSUB(j)  (1280 + 64 * (j))
#define XB_XGEN(j)  (2304 + 64 * (j))
#define XB_TOP      3328
#define XB_TOPGEN   3392
#define XCD_BAR_WORDS 3456
#define XB_SPIN_CAP (1u << 18)
struct XcdBarrier { unsigned* bar; unsigned x; volatile LAS unsigned* st; };
__device__ __forceinline__ unsigned xb_ld(unsigned* p) { return __hip_atomic_load(p, __ATOMIC_RELAXED, __HIP_MEMORY_SCOPE_AGENT); }
__device__ __forceinline__ unsigned xb_add(unsigned* p, unsigned v) { return __hip_atomic_fetch_add(p, v, __ATOMIC_RELAXED, __HIP_MEMORY_SCOPE_AGENT); }
__device__ __forceinline__ unsigned xb_xcc_id() { return (unsigned)__builtin_amdgcn_s_getreg((3 << 11) | 20) & 0xFu; }
#define XB_SPIN(cond, bar) do { unsigned _sp = 0; while (cond) { __builtin_amdgcn_s_sleep(1); \
    if ((++_sp & 255u) == 0u) { if (xb_ld(&(bar)[XB_TMO])) break; if (_sp > XB_SPIN_CAP) { atomicAdd(&(bar)[XB_TMO], 1u); break; } } } } while (0)
__device__ __forceinline__ XcdBarrier xcd_barrier_post(unsigned* bar, volatile LAS unsigned* st) {
  XcdBarrier b; b.bar = bar; b.x = xb_xcc_id(); b.st = st;
  if (threadIdx.x == 0) (void)xb_add(&bar[XB_XCNT(b.x)], 1u);
  return b;
}
__device__ __forceinline__ void xcd_barrier_complete(unsigned* bar, unsigned x, unsigned& nloc, unsigned& nx) {
  const unsigned G = gridDim.x * gridDim.y * gridDim.z;
  unsigned sum, cnt, mine, sp = 0u;
  for (;;) {
    sum = 0u; cnt = 0u; mine = 0u;
#pragma unroll
    for (unsigned j = 0; j < 16; ++j) { const unsigned c = xb_ld(&bar[XB_XCNT(j)]); sum += c; cnt += (c > 0u) ? 1u : 0u; mine = (j == x) ? c : mine; }
    if (sum == G) break;
    __builtin_amdgcn_s_sleep(1);
    if ((++sp & 255u) == 0u) { if (xb_ld(&bar[XB_TMO])) break; if (sp > XB_SPIN_CAP) { atomicAdd(&bar[XB_TMO], 1u); break; } }
  }
  nloc = mine > 0u ? mine : 1u; nx = cnt > 0u ? cnt : 1u;
}
__device__ __forceinline__ void xcd_barrier(const XcdBarrier& b) {
  asm volatile("s_waitcnt vmcnt(0)" ::: "memory");
  __syncthreads();
  if (threadIdx.x == 0) {
    unsigned* bar = b.bar;
    __builtin_amdgcn_s_waitcnt(0);
    unsigned nloc = b.st[0], nx = b.st[1];
    if (nloc == 0u) { xcd_barrier_complete(bar, b.x, nloc, nx); b.st[0] = nloc; b.st[1] = nx; }
    const unsigned old = xb_add(&bar[XB_XSUB(b.x)], 1u);
    const unsigned gen = old / nloc;
    if (old + 1u == (gen + 1u) * nloc) {
      __builtin_amdgcn_fence(__ATOMIC_RELEASE, "agent");
      asm volatile("s_waitcnt vmcnt(0)" ::: "memory");
      const unsigned og = xb_add(&bar[XB_TOP], 1u);
      const unsigned tg = og / nx;
      if (og + 1u == (tg + 1u) * nx) xb_add(&bar[XB_TOPGEN], 1u);
      else XB_SPIN(xb_ld(&bar[XB_TOPGEN]) == tg, bar);
      __builtin_amdgcn_fence(__ATOMIC_ACQUIRE, "agent");
      xb_add(&bar[XB_XGEN(b.x)], 1u);
      asm volatile("s_waitcnt vmcnt(0)" ::: "memory");
    } else {
      XB_SPIN(xb_ld(&bar[XB_XGEN(b.x)]) == gen, bar);
      __builtin_amdgcn_fence(__ATOMIC_ACQUIRE, "agent");
      asm volatile("s_waitcnt vmcnt(0)" ::: "memory");
    }
  }
  __syncthreads();
}

#define PARGS const float* a0, const float* a1, const float* a2, const float* a3, const float* a4, const float* a5, const float* a6, \
  const float* a7, const float* a8, const float* a9, const float* a10, const float* a11, const float* a12, const float* a13, \
  const float* a14, const float* a15, const float* a16, const float* a17, const float* a18, const float* a19, const float* a20, \
  float* aout, char* aws
#define PFILL Params p; p.in[0]=a0;p.in[1]=a1;p.in[2]=a2;p.in[3]=a3;p.in[4]=a4;p.in[5]=a5;p.in[6]=a6;p.in[7]=a7;p.in[8]=a8;p.in[9]=a9;p.in[10]=a10; \
  p.in[11]=a11;p.in[12]=a12;p.in[13]=a13;p.in[14]=a14;p.in[15]=a15;p.in[16]=a16;p.in[17]=a17;p.in[18]=a18;p.in[19]=a19;p.in[20]=a20;p.out=aout;p.ws=aws;
__global__ void __launch_bounds__(512) fwd_megakernel(PARGS) {
  PFILL
  extern __shared__ __attribute__((aligned(16))) char lds[];
  volatile int& s_item = *(volatile int*)(lds + LDS_TILE);
  cg::grid_group grid = cg::this_grid();
  const int bid = blockIdx.x, G = gridDim.x, tid = threadIdx.x;
  int* cnt = (int*)(p.ws + OFF_CNT);
  volatile LAS unsigned* bst = (volatile LAS unsigned*)(LAS unsigned char*)(lds + LDS_TILE + 16);
  if (tid < 2) bst[tid] = 0u;
  __syncthreads();
  const XcdBarrier xb = xcd_barrier_post((unsigned*)(p.ws + OFF_BAR), bst);
  for (int rep = 0; rep < ((DUP_MASK & 1) ? 2 : 1); ++rep) {
  {
    for (int it = bid; it < 384; it += G) p0_mod16(p, it, lds);
    float2* tab = (float2*)lds;
    for (int m = tid; m < 2048; m += 512) { float sn, cs; sincospif((float)m * (1.f / 1024.f), &sn, &cs); tab[m] = make_float2(cs, sn); }
    __syncthreads();
    for (int it = 224 + bid; it < 224 + 2048; it += G) p0_item(p, it, lds);
    __syncthreads();
    for (int it = 96 + bid; it < P0_ITEMS; it += G) { if (it >= 224 && it < 224 + 2048) continue; p0_item(p, it, lds); }
  }
  if (((const volatile float*)p.in[15])[0] > 1e30f) grid.sync();
  }
  for (int l = 0; l < 2; ++l) {
    {
      bool waited = (l != 0);
      for (int it = bid; it < P1_ITEMS; it += G) {
        if (!waited && it >= 2816) {
          if (tid == 0) {
            unsigned* mc = (unsigned*)(p.ws + OFF_CNT) + 6; unsigned sp = 0;
            while (__hip_atomic_load(mc, __ATOMIC_RELAXED, __HIP_MEMORY_SCOPE_AGENT) < 384u) { __builtin_amdgcn_s_sleep(2); if (++sp > (1u << 22)) break; }
            __builtin_amdgcn_fence(__ATOMIC_ACQUIRE, "agent");
            asm volatile("s_waitcnt vmcnt(0)" ::: "memory");
          }
          __syncthreads();
          waited = true;
        }
        p1_item(p, l, it, lds);
      }
      xcd_barrier(xb);
    }
    if (DUP_MASK & 1024) { const bool opq = (((const volatile float*)p.in[15])[0] < 1e30f); p2_phase(p, l, lds, opq); xcd_barrier(xb); }
    for (int rep = 0; rep < ((DUP_MASK & 4) ? 2 : 1); ++rep) {
    p2_phase(p, l, lds);
    xcd_barrier(xb);
    }
    for (;;) {
      __syncthreads();
      if (tid == 0) s_item = atomicAdd(&cnt[l * 2 + 0], 1);
      __syncthreads();
      int it = s_item;
      constexpr int D3 = (DUP_MASK & 16) ? 256 : 0;
      if (it >= D3 + 32 + 128 + 384 + 256) break;
      if (it >= 32 + 128 + 384 + 256) { hgrn_ctx_item(p, l, (it - 800) & 127, lds, true); continue; }
      if (it < 32) p2_left_item(p, l, 1024 + it, lds);
      else if (it < 160) hgrn_ctx_item(p, l, it - 32, lds);
      else if (it < 416) hgrn_lat1_item(p, l, it - 160, lds);
      else f1_item(p, it - 416, lds);
    }
    xcd_barrier(xb);
    for (;;) {
      __syncthreads();
      if (tid == 0) s_item = atomicAdd(&cnt[l * 2 + 1], 1);
      __syncthreads();
      int it = s_item;
      constexpr int D4a = (DUP_MASK & 32) ? 256 : 0, D4b = (DUP_MASK & 64) ? 256 : 0;
      if (it >= D4a + D4b + 640) break;
      if (it >= 640) { if (DUP_MASK & 32) attn_item(p, l, (it - 640) & 127, true, lds, true); else hgrn_lat2_item(p, l, (it - 640) & 127, lds, true); continue; }
      if (it < 128) attn_item(p, l, it, true, lds);
      else if (it < 192) f2l_item(p, l, it - 128, lds);
      else if (it < 320) hgrn_lat2_item(p, l, it - 192, lds);
      else if (it < 384) f2c_item(p, it - 320, lds);
      else attn_item(p, l, it - 384, false, lds);
    }
    xcd_barrier(xb);
    if (DUP_MASK & 2048) { const bool opq = (((const volatile float*)p.in[15])[0] < 1e30f); p5_phase(p, l, lds, opq); xcd_barrier(xb); }
    for (int rep = 0; rep < ((DUP_MASK & 8) ? 2 : 1); ++rep) {
    p5_phase(p, l, lds);
    xcd_barrier(xb);
    }
    for (int rep = 0; rep < (((DUP_MASK & 256) && l == 0) ? 5 : 1); ++rep) {
    p6_phase(p, l, lds);
    if (l == 0) xcd_barrier(xb);
    }
  }
}

extern "C" void kernel_launch(void* const* d_in, const int* in_sizes, int n_in,
                              void* d_out, int out_size, void* d_ws, size_t ws_size,
                              hipStream_t stream) {
  static int grid_blocks = 0;
  if (!grid_blocks) {
    int dev = 0, cus = 0;
    (void)hipGetDevice(&dev);
    (void)hipDeviceGetAttribute(&cus, hipDeviceAttributeMultiprocessorCount, dev);
    if (hipFuncSetAttribute((const void*)fwd_megakernel, hipFuncAttributeMaxDynamicSharedMemorySize, LDS_BYTES) != hipSuccess)
      fprintf(stderr, "hipFuncSetAttribute failed\n");
    grid_blocks = cus > 0 ? cus : 256;
    if (ws_size < WS_END) fprintf(stderr, "workspace too small: %zu < %zu\n", ws_size, (size_t)WS_END);
  }
  const void* ins[21];
  for (int i = 0; i < 21; ++i) ins[i] = d_in[i];
  void* outp = d_out; void* wsp = d_ws;
  void* args[23];
  for (int i = 0; i < 21; ++i) args[i] = (void*)&ins[i];
  args[21] = (void*)&outp; args[22] = (void*)&wsp;
  (void)hipMemsetAsync((char*)d_ws + OFF_CNT, 0, 4096 + 3456 * 4, stream);
  hipError_t e = hipLaunchCooperativeKernel((void*)fwd_megakernel, dim3(grid_blocks), dim3(512), args, LDS_BYTES, stream);
  if (e != hipSuccess) fprintf(stderr, "cooperative launch failed: %s (grid %d)\n", hipGetErrorString(e), grid_blocks);
}
```

```cpp
#include <hip/hip_runtime.h>
#include <hip/hip_cooperative_groups.h>
#include <stdint.h>
#include <cstdio>
namespace cg = cooperative_groups;

typedef unsigned short u16;
using bf16x8 = __attribute__((ext_vector_type(8))) short;
using f32x4 = __attribute__((ext_vector_type(4))) float;
#define MFMA(a, b, c) __builtin_amdgcn_mfma_f32_16x16x32_bf16(a, b, c, 0, 0, 0)

constexpr int NTOK = 12288;
constexpr int NCTX = 8192;
constexpr int LDP = 5120;
constexpr int PQA = 0, PLF = 512, PIA = 1536, PZA = 2048, PQB = 2560, PKB = 3072, PZB = 3584, PUC = 4096, PZC = 4608;
constexpr float EPSV = 1e-6f;
constexpr size_t OCK = 12582912, OCV = 20971520, OST = 29360128;

constexpr size_t OFF_WIN = 0;
constexpr size_t OFF_WBR = OFF_WIN + 8704ull * 1024 * 2;
constexpr size_t OFF_WO = OFF_WBR + 3ull * 1024 * 512 * 2;
constexpr size_t OFF_H = OFF_WO + 1024ull * 1024 * 2;
constexpr size_t OFF_PROJ = OFF_H + 12288ull * 1024 * 2;
constexpr size_t OFF_R1 = OFF_PROJ + 12288ull * LDP * 2;
constexpr size_t OFF_PTC = OFF_R1;
constexpr size_t OFF_PTL = OFF_R1 + 16384ull * 512 * 2;
constexpr size_t OFF_MRG = OFF_R1;
constexpr size_t OFF_SEGU = OFF_R1 + 25165824ull;
constexpr size_t OFF_SEGD = OFF_SEGU + 256ull * 16384 * 4;
constexpr size_t OFF_VTC = OFF_SEGD + 256ull * 128 * 4;
constexpr size_t OFF_VTL = OFF_VTC + 32ull * 4 * 128 * 256 * 2;
constexpr size_t SZ_VTL = 2ull * 4 * 128 * 2304 * 2;
constexpr size_t OFF_KC = OFF_VTL + 2 * SZ_VTL;
constexpr size_t OFF_DL = OFF_KC + 2ull * 2 * 256 * 512 * 2;
constexpr size_t OFF_DC = OFF_DL + 2048ull * 4096 * 2;
constexpr size_t OFF_B1 = OFF_DC + 256ull * 512 * 2;
constexpr size_t OFF_ROPE = OFF_B1 + 256ull * 128 * 2;
constexpr size_t OFF_MOD = OFF_ROPE + 2048ull * 32 * 8;
constexpr size_t OFF_CNT = OFF_MOD + 2ull * 3 * 3072 * 4;
constexpr size_t OFF_BAR = OFF_CNT + 4096;
constexpr size_t OFF_F2P = OFF_BAR + 3456 * 4 + 192;
constexpr size_t WS_END = OFF_F2P + 32ull * 2 * 32 * 512 * 8;

constexpr int LDS_TILE = 131072 + 8192;
#define DUP_MASK 0
constexpr int LDS_BYTES = LDS_TILE + 64;

struct Params {
  const float* in[21];
  float* out;
  char* ws;
};

typedef __bf16 bf16x2_t __attribute__((ext_vector_type(2)));
typedef float f32x2_t __attribute__((ext_vector_type(2)));
__device__ __forceinline__ uint32_t pack2(float a, float b) {
  f32x2_t v = {a, b};
  bf16x2_t r = __builtin_convertvector(v, bf16x2_t);
  return __builtin_bit_cast(uint32_t, r);
}
__device__ __forceinline__ u16 f2bf(float f) { return (u16)(pack2(f, 0.f) & 0xffffu); }
__device__ __forceinline__ float bf2f(u16 h) { return __uint_as_float(((uint32_t)h) << 16); }
__device__ __forceinline__ float lo2f(uint32_t u) { return __uint_as_float(u << 16); }
__device__ __forceinline__ float hi2f(uint32_t u) { return __uint_as_float(u & 0xffff0000u); }
__device__ __forceinline__ float fexp(float x) { return __builtin_amdgcn_exp2f(x * 1.4426950408889634f); }
__device__ __forceinline__ float frcp(float x) { return __builtin_amdgcn_rcpf(x); }
__device__ __forceinline__ float flog(float x) { return __builtin_amdgcn_logf(x) * 0.6931471805599453f; }
__device__ __forceinline__ float siluf(float x) { return x * frcp(1.f + fexp(-x)); }
__device__ __forceinline__ float sigmf(float x) { return frcp(1.f + fexp(-x)); }
__device__ __forceinline__ float logf_gate(float x, float lb) {
  float xc = fmaxf(x, -80.f);
  float e = fexp(-xc);
  float omf = (1.f - lb) * e * frcp(1.f + e);
  float lf = flog(1.f - omf);
  lf = (lb == 0.f && x < -15.f) ? x : lf;
  return lf;
}
__device__ __forceinline__ float neg_expm1(float lf) {
  return 1.f - fexp(lf);
}
__device__ __forceinline__ int otid() { int t = threadIdx.x; asm volatile("" : "+v"(t)); return t; }

union Frag {
  bf16x8 v;
  uint4 q;
  uint2 h[2];
  uint32_t w[4];
};

__device__ __forceinline__ int lds_byte(int r, int c) {
  int st = (r >> 4) * 2 + (c >> 5), rr = r & 15, cc = c & 31, ob = rr * 64 + cc * 2;
  return st * 1024 + (ob ^ (((ob >> 9) & 1) << 5));
}

template <int TM>
__device__ __forceinline__ void gemm_kloop(const u16* __restrict__ X, int ldx, const u16* __restrict__ Y, int ldy,
                                           int K, f32x4 (&acc)[4][TM / 32], char* lds) {
  constexpr int NX = TM / 64;
  constexpr int XT = TM / 32;
  constexpr int STAGE = TM * 128 + 32768;
  const int tid = otid(), lane = tid & 63, wid = tid >> 6, wr = wid >> 2, wc = wid & 3, fr = lane & 15, fq = lane >> 4;
#pragma unroll
  for (int a = 0; a < 4; ++a)
#pragma unroll
    for (int b = 0; b < XT; ++b) acc[a][b] = f32x4{0.f, 0.f, 0.f, 0.f};
  uint4 xr[NX], yr[4];
  const int nk = K >> 6;
  const int lrow = tid >> 3, lc8 = (tid & 7) * 8;
  const u16* xg = X + (size_t)lrow * ldx + lc8;
  const u16* yg = Y + (size_t)lrow * ldy + lc8;
  const int loff = lds_byte(lrow, lc8);
#pragma unroll
  for (int i = 0; i < NX; ++i) xr[i] = *(const uint4*)(xg + (size_t)(64 * i) * ldx);
#pragma unroll
  for (int i = 0; i < 4; ++i) yr[i] = *(const uint4*)(yg + (size_t)(64 * i) * ldy);
#pragma unroll
  for (int i = 0; i < NX; ++i) *(uint4*)(lds + loff + 8192 * i) = xr[i];
#pragma unroll
  for (int i = 0; i < 4; ++i) *(uint4*)(lds + TM * 128 + loff + 8192 * i) = yr[i];
  __syncthreads();
  for (int kt = 0; kt < nk; ++kt) {
    char* cur = lds + (kt & 1) * STAGE;
    char* nxt = lds + ((kt + 1) & 1) * STAGE;
    const bool more = (kt + 1 < nk);
    if (more) {
#pragma unroll
      for (int i = 0; i < NX; ++i) xr[i] = *(const uint4*)(xg + (size_t)(64 * i) * ldx + (kt + 1) * 64);
#pragma unroll
      for (int i = 0; i < 4; ++i) yr[i] = *(const uint4*)(yg + (size_t)(64 * i) * ldy + (kt + 1) * 64);
    }
#pragma unroll
    for (int ks = 0; ks < 2; ++ks) {
      Frag yf[4], xf[XT];
#pragma unroll
      for (int a = 0; a < 4; ++a) yf[a].q = *(const uint4*)(cur + TM * 128 + lds_byte(wc * 64 + a * 16 + fr, ks * 32 + fq * 8));
#pragma unroll
      for (int b = 0; b < XT; ++b) xf[b].q = *(const uint4*)(cur + lds_byte(wr * (TM / 2) + b * 16 + fr, ks * 32 + fq * 8));
#pragma unroll
      for (int a = 0; a < 4; ++a)
#pragma unroll
        for (int b = 0; b < XT; ++b) acc[a][b] = MFMA(yf[a].v, xf[b].v, acc[a][b]);
    }
    if (more) {
#pragma unroll
      for (int i = 0; i < NX; ++i) *(uint4*)(nxt + loff + 8192 * i) = xr[i];
#pragma unroll
      for (int i = 0; i < 4; ++i) *(uint4*)(nxt + TM * 128 + loff + 8192 * i) = yr[i];
    }
    __syncthreads();
  }
}

#define LAS __attribute__((address_space(3)))
constexpr int HTB = 128 * 64 * 2;
constexpr int G8_STAGE_BYTES = 8 * HTB;
__device__ __forceinline__ void stage_rc(int b, int& R, int& C) {
  const int st = b / 1024, sb = b % 1024, swz = sb ^ (((sb >> 9) & 1) << 5);
  R = (st >> 1) * 16 + swz / 64; C = (st & 1) * 32 + (swz % 64) / 2;
}
struct Unit { const char* a; const char* b; int x; int y; int lda; int ldb; int nt; int perm = 0; };
struct OneUnit {
  Unit u; int reps = 1;
  __device__ __forceinline__ bool next(int i, Unit& o) const { if (i >= reps) return false; o = u; return true; }
};
template <class Epi, class Sched>
__device__ __forceinline__ void gemm_phase(LAS unsigned char* lds, const Sched& S, const Epi& E) {
  const int tid = otid(), wid = __builtin_amdgcn_readfirstlane(tid >> 6), lane = tid & 63, wr = wid >> 2, wc = wid & 3, fr = lane & 15, fq = lane >> 4;
  int sR[2], sC[2];
#pragma unroll
  for (int i = 0; i < 2; ++i) stage_rc(tid * 16 + i * 8192, sR[i], sC[i]);
  int sRp[2];
#pragma unroll
  for (int i = 0; i < 2; ++i) { const int rho = sR[i] & 31, n_ = rho >> 4, i_ = rho & 15; sRp[i] = (sR[i] & ~31) + 8 * (i_ >> 2) + 4 * n_ + (i_ & 3); }
  const size_t kstep = 128;
  const unsigned ldsw = (unsigned)wid * 1024u;
  const int aoff = lds_byte(wr * 64 + fr, fq * 8), boff = lds_byte(wc * 32 + fr, fq * 8);
#define G8_SA(b, h) (((b) * 2 + (h)) * HTB)
#define G8_SB(b, h) ((4 + (b) * 2 + (h)) * HTB)
#define G8_STAGE(bufoff, gbase, voff) do { _Pragma("unroll") for (int _i = 0; _i < 2; ++_i) \
    __builtin_amdgcn_global_load_lds((const unsigned*)((const char*)(gbase) + (voff)[_i]), (LAS unsigned*)(lds + (bufoff) + ldsw + _i * 8192), 16, 0, 0); } while (0)
#define G8_LDA(dst, b, h) do { _Pragma("unroll") for (int m = 0; m < 4; ++m) _Pragma("unroll") for (int k = 0; k < 2; ++k) dst[m][k] = *(const LAS bf16x8*)(lds + G8_SA(b, h) + aoff + m * 2048 + k * 1024); } while (0)
#define G8_LDB(dst, b, h) do { _Pragma("unroll") for (int n = 0; n < 2; ++n) _Pragma("unroll") for (int k = 0; k < 2; ++k) dst[n][k] = *(const LAS bf16x8*)(lds + G8_SB(b, h) + boff + n * 2048 + k * 1024); } while (0)
#define G8_MMA(ai, bj, At, Bt) do { __builtin_amdgcn_s_setprio(1); _Pragma("unroll") for (int m = 0; m < 4; ++m) _Pragma("unroll") for (int n = 0; n < 2; ++n) _Pragma("unroll") for (int k = 0; k < 2; ++k) \
    acc[ai][bj][m][n] = __builtin_amdgcn_mfma_f32_16x16x32_bf16(Bt[n][k], At[m][k], acc[ai][bj][m][n], 0, 0, 0); __builtin_amdgcn_s_setprio(0); } while (0)
#define G8_WAIT_V(n) asm volatile("s_waitcnt vmcnt(" #n ")" ::: "memory")
#define G8_WAIT_L(n) asm volatile("s_waitcnt lgkmcnt(" #n ")" ::: "memory")
#define G8_BAR __builtin_amdgcn_s_barrier()
#define G8_SCHED __builtin_amdgcn_sched_barrier(0)
  Unit cur, nxt; int ui = 0;
  if (!S.next(0, cur)) return;
  f32x4 acc[2][2][4][2];
#pragma unroll
  for (int a = 0; a < 2; ++a)
#pragma unroll
    for (int b = 0; b < 2; ++b)
#pragma unroll
      for (int m = 0; m < 4; ++m)
#pragma unroll
        for (int n = 0; n < 2; ++n) acc[a][b][m][n] = f32x4{0.f, 0.f, 0.f, 0.f};
  bf16x8 At[4][2], B0[2][2], B1[2][2];
  const char* cA = cur.a; const char* cB = cur.b;
  unsigned voffA[2], voffB[2];
#pragma unroll
  for (int i = 0; i < 2; ++i) { voffA[i] = (unsigned)(sR[i] * cur.lda + sC[i]) * 2u; voffB[i] = (unsigned)((cur.perm ? sRp[i] : sR[i]) * cur.ldb + sC[i]) * 2u; }
  size_t hstepA = (size_t)128 * cur.lda * 2, hstepB = (size_t)128 * cur.ldb * 2;
  G8_STAGE(G8_SB(0, 0), cB, voffB); G8_STAGE(G8_SA(0, 0), cA, voffA); G8_STAGE(G8_SB(0, 1), cB + hstepB, voffB); G8_STAGE(G8_SA(0, 1), cA + hstepA, voffA);
  if (wr == 1) G8_BAR;
  G8_WAIT_V(4); G8_BAR;
  G8_STAGE(G8_SB(1, 0), cB + kstep, voffB); G8_STAGE(G8_SA(1, 0), cA + kstep, voffA); G8_STAGE(G8_SB(1, 1), cB + hstepB + kstep, voffB);
  G8_WAIT_V(6); G8_BAR;
  for (;;) {
    const bool has_next = S.next(ui + 1, nxt);
    if (!has_next) nxt = cur;
    const char* nA = nxt.a; const char* nB = nxt.b;
    unsigned voffAn[2], voffBn[2];
#pragma unroll
    for (int i = 0; i < 2; ++i) { voffAn[i] = (unsigned)(sR[i] * nxt.lda + sC[i]) * 2u; voffBn[i] = (unsigned)((nxt.perm ? sRp[i] : sR[i]) * nxt.ldb + sC[i]) * 2u; }
    const size_t hstepAn = (size_t)128 * nxt.lda * 2, hstepBn = (size_t)128 * nxt.ldb * 2;
    const int nt = cur.nt;
    for (int t = 0; t < nt; t += 2) {
      const bool last = (t == nt - 2);
      const char* a1 = cA + (size_t)(t + 1) * kstep;
      const char* a2 = last ? nA : cA + (size_t)(t + 2) * kstep; const char* b2 = last ? nB : cB + (size_t)(t + 2) * kstep;
      const char* a3 = a2 + kstep; const char* b3 = b2 + kstep;
      unsigned vA2[2], vB2[2];
#pragma unroll
      for (int i = 0; i < 2; ++i) { vA2[i] = last ? voffAn[i] : voffA[i]; vB2[i] = last ? voffBn[i] : voffB[i]; }
      const size_t hA2 = last ? hstepAn : hstepA, hB2 = last ? hstepBn : hstepB;
      G8_LDB(B0, 0, 0); G8_SCHED; G8_LDA(At, 0, 0); G8_STAGE(G8_SA(1, 1), a1 + hstepA, voffA);
      G8_WAIT_L(8); G8_BAR; G8_WAIT_L(0); G8_MMA(0, 0, At, B0); G8_BAR; G8_SCHED;
      G8_LDB(B1, 0, 1); G8_STAGE(G8_SB(0, 0), b2, vB2);
      G8_BAR; G8_WAIT_L(0); G8_MMA(0, 1, At, B1); G8_BAR;
      G8_LDA(At, 0, 1); G8_STAGE(G8_SA(0, 0), a2, vA2);
      G8_BAR; G8_WAIT_L(0); G8_MMA(1, 0, At, B0); G8_BAR; G8_SCHED;
      G8_STAGE(G8_SB(0, 1), b2 + hB2, vB2);
      G8_WAIT_V(6); G8_BAR; G8_MMA(1, 1, At, B1); G8_BAR;
      G8_LDB(B0, 1, 0); G8_SCHED; G8_LDA(At, 1, 0); G8_STAGE(G8_SA(0, 1), a2 + hA2, vA2);
      G8_WAIT_L(8); G8_BAR; G8_WAIT_L(0); G8_MMA(0, 0, At, B0); G8_BAR; G8_SCHED;
      G8_LDB(B1, 1, 1); G8_STAGE(G8_SB(1, 0), b3, vB2);
      G8_BAR; G8_WAIT_L(0); G8_MMA(0, 1, At, B1); G8_BAR;
      G8_LDA(At, 1, 1); G8_STAGE(G8_SA(1, 0), a3, vA2);
      G8_BAR; G8_WAIT_L(0); G8_MMA(1, 0, At, B0); G8_BAR; G8_SCHED;
      G8_STAGE(G8_SB(1, 1), b3 + hB2, vB2);
      G8_WAIT_V(6); G8_BAR; G8_MMA(1, 1, At, B1); G8_BAR;
    }
    E(acc, cur, wr, wc, fr, fq, lds);
    if (!has_next) break;
#pragma unroll
    for (int a = 0; a < 2; ++a)
#pragma unroll
      for (int b = 0; b < 2; ++b)
#pragma unroll
        for (int m = 0; m < 4; ++m)
#pragma unroll
          for (int n = 0; n < 2; ++n) acc[a][b][m][n] = f32x4{0.f, 0.f, 0.f, 0.f};
    cur = nxt; cA = nA; cB = nB; ++ui;
#pragma unroll
    for (int i = 0; i < 2; ++i) { voffA[i] = voffAn[i]; voffB[i] = voffBn[i]; }
    hstepA = hstepAn; hstepB = hstepBn;
  }
  G8_WAIT_V(0);
  if (wr == 0) G8_BAR;
  G8_BAR;
}

__device__ __forceinline__ void p0_mod16(const Params& p, int item, char* lds) {
  const int tid = otid();
  float* sc = (float*)lds;
  float* red = sc + 3072;
  const int l = item / 192, cgp = item % 192;
  const float* cctx = p.in[6]; const float* cc2 = p.in[2];
  for (int i = tid; i < 3072; i += 512) {
    int j = i >> 10, k = i & 1023;
    float c = (j == 0) ? cctx[k] : cc2[(j > 0 ? j - 1 : 0) * 1024 + k];
    sc[i] = c / (1.f + expf(-c));
  }
  __syncthreads();
  const int col = tid & 15, kg = tid >> 4;
  const float* W = p.in[7] + (size_t)l * 1024 * 3072 + cgp * 16 + col;
  float a0 = 0.f, a1 = 0.f, a2 = 0.f;
#pragma unroll 8
  for (int k = kg * 32; k < kg * 32 + 32; ++k) {
    float w = W[(size_t)k * 3072];
    a0 += sc[k] * w; a1 += sc[1024 + k] * w; a2 += sc[2048 + k] * w;
  }
  red[(kg * 3 + 0) * 16 + col] = a0; red[(kg * 3 + 1) * 16 + col] = a1; red[(kg * 3 + 2) * 16 + col] = a2;
  __syncthreads();
  if (tid < 48) {
    const int j = tid >> 4; float s_ = 0.f;
    for (int g = 0; g < 32; ++g) s_ += red[(g * 3 + j) * 16 + col];
    const int n = cgp * 16 + col;
    __hip_atomic_store((float*)(p.ws + OFF_MOD) + (l * 3 + j) * 3072 + n, s_ + p.in[8][l * 3072 + n], __ATOMIC_RELAXED, __HIP_MEMORY_SCOPE_AGENT);
  }
  if (tid < 64) {
    asm volatile("s_waitcnt vmcnt(0)" ::: "memory");
    if (tid == 0) __hip_atomic_fetch_add((unsigned*)(p.ws + OFF_CNT) + 6, 1u, __ATOMIC_RELAXED, __HIP_MEMORY_SCOPE_AGENT);
  }
  __syncthreads();
}

__device__ __forceinline__ void p0_item(const Params& p, int item, char* lds) {
  const int tid = otid();
  char* ws = p.ws;
  if (item < 96) {
    float* sc = (float*)lds;
    float* red = sc + 3072;
    const int l = item / 48, cgp = item % 48;
    const float* cctx = p.in[6]; const float* cc2 = p.in[2];
    for (int i = tid; i < 3072; i += 512) {
      int j = i >> 10, k = i & 1023;
      float c = (j == 0) ? cctx[k] : cc2[(j > 0 ? j - 1 : 0) * 1024 + k];
      sc[i] = siluf(c);
    }
    __syncthreads();
    const int col = tid & 63, kg = tid >> 6;
    const float* W = p.in[7] + (size_t)l * 1024 * 3072 + cgp * 64 + col;
    float a0 = 0.f, a1 = 0.f, a2 = 0.f;
    for (int k = kg * 128; k < kg * 128 + 128; ++k) {
      float w = W[(size_t)k * 3072];
      a0 += sc[k] * w; a1 += sc[1024 + k] * w; a2 += sc[2048 + k] * w;
    }
    red[(kg * 3 + 0) * 64 + col] = a0; red[(kg * 3 + 1) * 64 + col] = a1; red[(kg * 3 + 2) * 64 + col] = a2;
    __syncthreads();
    if (tid < 192) {
      int j = tid >> 6; float s = 0.f;
      for (int g = 0; g < 8; ++g) s += red[(g * 3 + j) * 64 + col];
      int n = cgp * 64 + col;
      ((float*)(ws + OFF_MOD))[(l * 3 + j) * 3072 + n] = s + p.in[8][l * 3072 + n];
    }
    __syncthreads();
    return;
  }
  item -= 96;
  if (item < 128) {
    int idx = item * 512 + tid, t = idx >> 5, c = idx & 31, fi = c & 15;
    float pos = (c < 16) ? (float)(t >> 6) : (float)(t & 63);
    float inv = powf(10000.f, -(float)fi / 16.f);
    float ang = pos * inv;
    ((float2*)(ws + OFF_ROPE))[idx] = make_float2(cosf(ang), sinf(ang));
    return;
  }
  item -= 128;
  if (item < 2048) {
    const float2* tab = (const float2*)lds;
    int idx = item * 512 + tid, tp = idx >> 9, k0 = (idx & 511) * 8;
    uint32_t o[4];
    float vv[8];
#pragma unroll
    for (int j = 0; j < 8; ++j) {
      int k = k0 + j; int m = (tp * (k & 2047)) & 2047;
      float2 cs = tab[m];
      vv[j] = (k < 2048) ? cs.x : -cs.y;
    }
#pragma unroll
    for (int j = 0; j < 4; ++j) o[j] = pack2(vv[2 * j], vv[2 * j + 1]);
    *(uint4*)(ws + OFF_DL + (size_t)idx * 16) = make_uint4(o[0], o[1], o[2], o[3]);
    return;
  }
  item -= 2048;
  if (item < 32) {
    int idx = item * 512 + tid, tp = idx >> 6, k0 = (idx & 63) * 8;
    uint32_t o[4];
    float vv[8];
#pragma unroll
    for (int j = 0; j < 8; ++j) {
      int k = k0 + j; int m = (tp * (k & 255)) & 255; float s, c;
      sincospif((float)m * (1.f / 128.f), &s, &c);
      vv[j] = (k < 256) ? c : -s;
    }
#pragma unroll
    for (int j = 0; j < 4; ++j) o[j] = pack2(vv[2 * j], vv[2 * j + 1]);
    *(uint4*)(ws + OFF_DC + (size_t)idx * 16) = make_uint4(o[0], o[1], o[2], o[3]);
    return;
  }
  item -= 32;
  if (item < 8) {
    int idx = item * 512 + tid, j = idx >> 4, c0 = (idx & 15) * 8;
    uint32_t o[4];
    float vv[8];
#pragma unroll
    for (int q = 0; q < 8; ++q) {
      int m = ((j & 127) * (c0 + q)) & 127; float s, c;
      sincospif((float)m * (1.f / 64.f), &s, &c);
      vv[q] = (j < 128) ? c : s;
    }
#pragma unroll
    for (int q = 0; q < 4; ++q) o[q] = pack2(vv[2 * q], vv[2 * q + 1]);
    *(uint4*)(ws + OFF_B1 + (size_t)idx * 16) = make_uint4(o[0], o[1], o[2], o[3]);
    return;
  }
  item -= 8;
  if (item < 128) {
    int idx = item * 512 + tid; int e = idx * 8;
    int n = e & 511, t = (e >> 9) & 255, l = (e >> 17) & 1, b = e >> 18;
    const float4* s = (const float4*)(p.in[3] + e);
    float4 a = s[0], c = s[1];
    size_t d = ((size_t)((l * 2 + b) * 256 + t)) * 512 + n;
    *(uint4*)(ws + OFF_KC + d * 2) = make_uint4(pack2(a.x, a.y), pack2(a.z, a.w), pack2(c.x, c.y), pack2(c.z, c.w));
    return;
  }
  item -= 128;
  {
    int idx = item * 512 + tid;
    int v = idx & 127, tc = (idx >> 7) & 31, h = (idx >> 12) & 3, b = (idx >> 14) & 1, l = idx >> 15;
    float vv[8];
#pragma unroll
    for (int j = 0; j < 8; ++j) vv[j] = p.in[4][((size_t)((b * 2 + l) * 256 + tc * 8 + j)) * 512 + h * 128 + v];
    size_t d = ((size_t)((b * 4 + h) * 128 + v)) * 2304 + 2048 + tc * 8;
    *(uint4*)(ws + OFF_VTL + l * SZ_VTL + d * 2) = make_uint4(pack2(vv[0], vv[1]), pack2(vv[2], vv[3]), pack2(vv[4], vv[5]), pack2(vv[6], vv[7]));
  }
}
constexpr int P0_ITEMS = 96 + 128 + 2048 + 32 + 8 + 128 + 128;

__device__ __forceinline__ void p1_item(const Params& p, int l, int item, char* lds) {
  const int tid = otid();
  char* ws = p.ws;
  if (item < 2816) {
    const float* src; int lsrc; u16* dst; int ldd; int kt, nt;
    const float* w10 = p.in[10]; const float* w17 = p.in[17]; const float* w18 = p.in[18]; const float* w19 = p.in[19]; const float* w20 = p.in[20];
    if (item < 2176) { src = w10 + (size_t)l * 1024 * 8704; lsrc = 8704; dst = (u16*)(ws + OFF_WIN); ldd = 1024; nt = item >> 4; kt = item & 15; }
    else if (item < 2560) { int r = item - 2176; int j = r >> 7; r &= 127; src = ((j == 0) ? w17 : ((j == 1) ? w18 : w19)) + (size_t)l * 512 * 1024; lsrc = 1024; dst = (u16*)(ws + OFF_WBR) + (size_t)j * 1024 * 512; ldd = 512; nt = r >> 3; kt = r & 7; }
    else { int r = item - 2560; src = w20 + (size_t)l * 1024 * 1024; lsrc = 1024; dst = (u16*)(ws + OFF_WO); ldd = 1024; nt = r >> 4; kt = r & 15; }
    u16* T = (u16*)lds;
    const int k0 = kt * 64, n0 = nt * 64;
#pragma unroll
    for (int ps = 0; ps < 2; ++ps) {
      int kr = (tid >> 4) + 32 * ps, nq = tid & 15;
      float4 v = *(const float4*)(src + (size_t)(k0 + kr) * lsrc + n0 + 4 * nq);
      const int ksw = (((kr >> 3) ^ (nq & 7)) << 3) + (kr & 7);
      T[(4 * nq + 0) * 72 + ksw] = f2bf(v.x); T[(4 * nq + 1) * 72 + ksw] = f2bf(v.y);
      T[(4 * nq + 2) * 72 + ksw] = f2bf(v.z); T[(4 * nq + 3) * 72 + ksw] = f2bf(v.w);
    }
    __syncthreads();
    {
      int n = tid >> 3, kc = tid & 7;
      uint4 o = *(const uint4*)(T + n * 72 + ((kc ^ ((n >> 2) & 7)) << 3));
      *(uint4*)(dst + (size_t)(n0 + n) * ldd + k0 + kc * 8) = o;
    }
    __syncthreads();
    return;
  }
  item -= 2816;
  const int lane = tid & 63, wid = tid >> 6;
  const float* modp = (const float*)(ws + OFF_MOD);
  u16* H = (u16*)(ws + OFF_H);
  const float* xin0 = p.in[0]; const float* xin1 = p.in[1]; const float* xin2 = p.out; const float* ng = p.in[9];
#pragma unroll
  for (int rr = 0; rr < 2; ++rr) {
    int r = item * 16 + wid * 2 + rr;
    const float* x = (l == 0) ? ((r < NCTX) ? xin0 + (size_t)r * 1024 : xin1 + (size_t)(r - NCTX) * 1024) : xin2 + (size_t)r * 1024;
    int ci = (r < NCTX) ? 0 : 1 + ((r - NCTX) >> 11);
    float4 v[4]; float ss = 0.f;
#pragma unroll
    for (int i = 0; i < 4; ++i) { v[i] = *(const float4*)(x + lane * 4 + 256 * i); ss += v[i].x * v[i].x + v[i].y * v[i].y + v[i].z * v[i].z + v[i].w * v[i].w; }
#pragma unroll
    for (int o = 32; o >= 1; o >>= 1) ss += __shfl_xor(ss, o);
    float rinv = rsqrtf(ss * (1.f / 1024.f) + EPSV);
    const float* sh = modp + (l * 3 + ci) * 3072;
#pragma unroll
    for (int i = 0; i < 4; ++i) {
      int col = lane * 4 + 256 * i;
      float4 g = *(const float4*)(ng + l * 1024 + col);
      float4 s1 = *(const float4*)(sh + 1024 + col);
      float4 s0 = *(const float4*)(sh + col);
      float a = v[i].x * rinv * g.x * (1.f + s1.x) + s0.x;
      float b = v[i].y * rinv * g.y * (1.f + s1.y) + s0.y;
      float c = v[i].z * rinv * g.z * (1.f + s1.z) + s0.z;
      float d = v[i].w * rinv * g.w * (1.f + s1.w) + s0.w;
      *(uint2*)(H + (size_t)r * 1024 + col) = make_uint2(pack2(a, b), pack2(c, d));
    }
  }
}
constexpr int P1_ITEMS = 2816 + 768;

__device__ __forceinline__ void stagger_us(int us) {
  const unsigned long long t0 = __builtin_amdgcn_s_memrealtime();
  while (__builtin_amdgcn_s_memrealtime() - t0 < (unsigned long long)us * 100ull) __builtin_amdgcn_s_sleep(8);
}
#define STAGGER_US 0
struct P2Sched {
  const char* H; const char* W; int G, c;
  __device__ __forceinline__ bool next(int i, Unit& u) const {
    const int L = i * G + c;
    if (L >= 1024) return false;
    if (L < 960) {
      const int nM = 48, nN = 20, nwg = 960;
      int wgid = L; { const int q = nwg / 8, xcd = wgid % 8, off = wgid / 8; wgid = xcd * q + off; }
      const int nig = 8 * nN, gid = wgid / nig, fm = gid * 8, gsz = (nM - fm) < 8 ? (nM - fm) : 8;
      int pm = fm + ((wgid % nig) % gsz), pn = (wgid % nig) / gsz;
      if (pn >= 14) pn += 2;
      u.a = H + (size_t)pm * 256 * 2048; u.b = W + (size_t)pn * 256 * 2048; u.x = pm; u.y = pn;
      u.lda = 1024; u.ldb = 1024; u.nt = 16; u.perm = ((pn >> 1) == 5 || (pn >> 1) == 6) ? 0 : 1;
    } else {
      const int r = L - 960; const int vq = r / 48, mt = r % 48;
      u.a = W + (size_t)(3584 + vq * 256) * 2048; u.b = H + (size_t)mt * 256 * 2048; u.x = vq; u.y = mt | 0x100;
      u.lda = 1024; u.ldb = 1024; u.nt = 16; u.perm = 0;
    }
    return true;
  }
};
struct P2Epi {
  const float* const* pin; float* out; char* ws; int l;
  const float* hlb; const float* qng; const float* kng; bool skip;
  __device__ __forceinline__ void operator()(f32x4 (&acc)[2][2][4][2], const Unit& u, int wr, int wc, int fr, int fq, LAS unsigned char* lds) const {
    if (skip) return;
    { const int t_ = otid(); const int w_ = t_ >> 6; wr = w_ >> 2; wc = w_ & 3; fr = t_ & 15; fq = (t_ & 63) >> 4; }
    if (u.y & 0x100) {
      const int mt = u.y & 0xff, vq = u.x;
#pragma unroll
      for (int ai = 0; ai < 2; ++ai)
#pragma unroll
        for (int m = 0; m < 4; ++m) {
          const int nn = vq * 256 + ai * 128 + wr * 64 + m * 16 + fr;
          const int hh = nn >> 7, v = nn & 127;
#pragma unroll
          for (int bj = 0; bj < 2; ++bj)
#pragma unroll
            for (int n = 0; n < 2; ++n) {
              const int tokl = bj * 128 + wc * 32 + n * 16 + 4 * fq;
              f32x4 a4 = acc[ai][bj][m][n];
              uint2 pk = make_uint2(pack2(a4[0], a4[1]), pack2(a4[2], a4[3]));
              if (mt < 32) {
                *(uint2*)(ws + OFF_VTC + ((size_t)((mt * 4 + hh) * 128 + v) * 256 + tokl) * 2) = pk;
                float* o = out + OCV + ((size_t)((mt * 2 + l) * 256 + tokl)) * 512 + nn;
                o[0] = a4[0]; o[512] = a4[1]; o[1024] = a4[2]; o[1536] = a4[3];
              } else {
                int rp = (mt - 32) * 256 + tokl; int bb = rp >> 11, t = rp & 2047;
                *(uint2*)(ws + OFF_VTL + l * SZ_VTL + ((size_t)((bb * 4 + hh) * 128 + v) * 2304 + t) * 2) = pk;
              }
            }
        }
      return;
    }
    const int pm = u.x, pn = u.y, seg = pn >> 1, ncol0 = (pn & 1) * 256;
    const int dcol0 = ((seg < 7) ? seg : seg - 1) * 512 + ncol0;
    u16* proj = (u16*)(ws + OFF_PROJ);
    const bool lat = (pm >= 32);
    if (seg == 5 || seg == 6) {
      float* xch = (float*)(lds + G8_STAGE_BYTES);
#pragma unroll
      for (int ai = 0; ai < 2; ++ai)
#pragma unroll
        for (int m = 0; m < 4; ++m)
#pragma unroll
          for (int bj = 0; bj < 2; ++bj) {
            float ss = 0.f;
#pragma unroll
            for (int n = 0; n < 2; ++n)
#pragma unroll
              for (int e = 0; e < 4; ++e) { float bfv = bf2f(f2bf(acc[ai][bj][m][n][e])); ss += bfv * bfv; }
            ss += __shfl_xor(ss, 16); ss += __shfl_xor(ss, 32);
            if (fq == 0) xch[((ai * 128 + wr * 64 + m * 16 + fr) * 2 + bj) * 4 + wc] = ss;
          }
      asm volatile("s_waitcnt lgkmcnt(0)" ::: "memory");
      __builtin_amdgcn_s_barrier();
      asm volatile("" ::: "memory");
      const float* gsel = (seg == 5) ? qng : kng;
      float gv[2][4];
#pragma unroll
      for (int n = 0; n < 2; ++n)
#pragma unroll
        for (int e = 0; e < 4; ++e) gv[n][e] = gsel[l * 64 + 32 * (wc & 1) + 16 * n + 4 * fq + e];
#pragma unroll
      for (int ai = 0; ai < 2; ++ai)
#pragma unroll
        for (int m = 0; m < 4; ++m) {
          const int rl = ai * 128 + wr * 64 + m * 16 + fr;
          const int grow = pm * 256 + rl;
#pragma unroll
          for (int bj = 0; bj < 2; ++bj) {
            const float2 pr = *(const float2*)&xch[(rl * 2 + bj) * 4 + (wc & 2)];
            const float tot = pr.x + pr.y;
            const float rinv = rsqrtf(tot * (1.f / 64.f) + EPSV);
            float x[2][4];
#pragma unroll
            for (int n = 0; n < 2; ++n)
#pragma unroll
              for (int e = 0; e < 4; ++e) x[n][e] = bf2f(f2bf(acc[ai][bj][m][n][e])) * rinv * gv[n][e];
            const int colt = ncol0 + bj * 128 + wc * 32;
            if (seg == 6 && !lat) {
              float* o = out + OCK + ((size_t)((pm * 2 + l) * 256 + rl)) * 512 + colt + 4 * fq;
              *(float4*)o = make_float4(x[0][0], x[0][1], x[0][2], x[0][3]);
              *(float4*)(o + 16) = make_float4(x[1][0], x[1][1], x[1][2], x[1][3]);
            }
            if (lat) {
              const int t = (grow - NCTX) & 2047;
              const float2* rt = (const float2*)(ws + OFF_ROPE) + t * 32 + ((wc & 1) ? 16 : 0) + 4 * fq;
#pragma unroll
              for (int e = 0; e < 4; ++e) {
                float2 cs = rt[e];
                float x1 = x[0][e], x2 = x[1][e];
                x[0][e] = x1 * cs.x - x2 * cs.y;
                x[1][e] = x1 * cs.y + x2 * cs.x;
              }
            }
            if (seg == 5) {
#pragma unroll
              for (int n = 0; n < 2; ++n)
#pragma unroll
                for (int e = 0; e < 4; ++e) x[n][e] *= 0.125f;
            }
            u16* dp = proj + (size_t)grow * LDP + dcol0 + bj * 128 + wc * 32 + 4 * fq;
            *(uint2*)dp = make_uint2(pack2(x[0][0], x[0][1]), pack2(x[0][2], x[0][3]));
            *(uint2*)(dp + 16) = make_uint2(pack2(x[1][0], x[1][1]), pack2(x[1][2], x[1][3]));
          }
        }
      return;
    }
    const bool dosilu = (seg == 0 || seg == 4 || seg == 8 || seg == 10);
    const bool dolf = (seg == 1 || seg == 2);
    const int dir = (seg == 2) ? 1 : 0;
#define P2_STORE16(A0, A1) *(uint4*)(proj + (size_t)grow * LDP + dcol0 + bj * 128 + wc * 32 + 8 * fq) = make_uint4(pack2(A0[0], A0[1]), pack2(A0[2], A0[3]), pack2(A1[0], A1[1]), pack2(A1[2], A1[3]))
    if (dosilu) {
#pragma unroll
      for (int ai = 0; ai < 2; ++ai)
#pragma unroll
        for (int m = 0; m < 4; ++m) {
          const int grow = pm * 256 + ai * 128 + wr * 64 + m * 16 + fr;
#pragma unroll
          for (int bj = 0; bj < 2; ++bj) {
            f32x4 a0 = acc[ai][bj][m][0], a1 = acc[ai][bj][m][1];
#pragma unroll
            for (int e = 0; e < 4; ++e) { a0[e] = siluf(a0[e]); a1[e] = siluf(a1[e]); }
            P2_STORE16(a0, a1);
          }
        }
    } else if (dolf) {
#pragma unroll
      for (int bj = 0; bj < 2; ++bj) {
        float lbv[2][4];
#pragma unroll
        for (int n = 0; n < 2; ++n)
#pragma unroll
          for (int e = 0; e < 4; ++e) {
            int j = ncol0 + bj * 128 + wc * 32 + 8 * fq + 4 * n + e;
            lbv[n][e] = (l == 0) ? 0.f : sigmf(hlb[(1 * 2 + dir) * 512 + j] - hlb[(0 * 2 + dir) * 512 + j]);
          }
#pragma unroll
        for (int ai = 0; ai < 2; ++ai)
#pragma unroll
          for (int m = 0; m < 4; ++m) {
            const int grow = pm * 256 + ai * 128 + wr * 64 + m * 16 + fr;
            f32x4 a0 = acc[ai][bj][m][0], a1 = acc[ai][bj][m][1];
#pragma unroll
            for (int e = 0; e < 4; ++e) { a0[e] = logf_gate(a0[e], lbv[0][e]); a1[e] = logf_gate(a1[e], lbv[1][e]); }
            P2_STORE16(a0, a1);
          }
      }
    } else {
#pragma unroll
      for (int ai = 0; ai < 2; ++ai)
#pragma unroll
        for (int m = 0; m < 4; ++m) {
          const int grow = pm * 256 + ai * 128 + wr * 64 + m * 16 + fr;
#pragma unroll
          for (int bj = 0; bj < 2; ++bj) {
            f32x4 a0 = acc[ai][bj][m][0], a1 = acc[ai][bj][m][1];
            P2_STORE16(a0, a1);
          }
        }
    }
  }
};
__device__ __forceinline__ void p2_left_item(const Params& p, int l, int L, char* lds) {
  P2Sched S0; S0.H = p.ws + OFF_H; S0.W = p.ws + OFF_WIN; S0.G = 0x40000000; S0.c = 0;
  OneUnit S;
  {
    const int r = L - 960; const int vq = r / 48, mt = r % 48;
    S.u.a = S0.W + (size_t)(3584 + vq * 256) * 2048; S.u.b = S0.H + (size_t)mt * 256 * 2048; S.u.x = vq; S.u.y = mt | 0x100;
    S.u.lda = 1024; S.u.ldb = 1024; S.u.nt = 16;
  }
  P2Epi E; E.pin = nullptr; E.out = p.out; E.ws = p.ws; E.l = l; E.hlb = p.in[11]; E.qng = p.in[13]; E.kng = p.in[14]; E.skip = false;
  gemm_phase((LAS unsigned char*)lds, S, E);
}
__device__ __forceinline__ void p2_phase(const Params& p, int l, char* lds, bool skip = false) {
  if (STAGGER_US && ((blockIdx.x >> 3) & 1)) stagger_us(STAGGER_US);
  P2Sched S; S.H = p.ws + OFF_H; S.W = p.ws + OFF_WIN; S.G = gridDim.x; S.c = blockIdx.x;
  P2Epi E; E.pin = nullptr; E.out = p.out; E.ws = p.ws; E.l = l; E.hlb = p.in[11]; E.qng = p.in[13]; E.kng = p.in[14]; E.skip = skip;
  gemm_phase((LAS unsigned char*)lds, S, E);
}

struct HgrnLds {
  float tot[4][128];
  float dk[128];
  float osum[16][132];
  u16 qt[16][136];
  u16 kt[16][136];
  u16 khT[128][20];
  u16 vT[128][20];
  u16 zt[16][136];
  u16 obuf[256][136];
};

#define LBAR() do { asm volatile("s_waitcnt lgkmcnt(0)" ::: "memory"); __builtin_amdgcn_s_barrier(); asm volatile("" ::: "memory"); } while (0)
__device__ __forceinline__ void hgrn_pass(const Params& p, int l, int row0, int ntok, int h, int dir, f32x4 (&S)[8],
                                          const bool do_out, const bool second, float& gsum, HgrnLds& L, const bool dry = false) {
  const int tid = otid(), lane = tid & 63, wid = tid >> 6, c16 = lane & 15, g = lane >> 4;
  const int kk = tid & 127, tq = tid >> 7;
  const u16* proj = (const u16*)(p.ws + OFF_PROJ);
  u16* projw = (u16*)(p.ws + OFF_PROJ);
  const int nch = ntok >> 4;
  float4 gg = make_float4(0.f, 0.f, 0.f, 0.f);
  if (second) gg = *(const float4*)(p.in[12] + l * 512 + h * 128 + 4 * (tid & 31));
  u16 lfA[4], qA[4], vA[4], zA[4], lfB[4], qB[4], vB[4], zB[4];
#define HG_LD(c_, LF, QQ, VV, ZZ)                                                    \
  {                                                                                  \
    _Pragma("unroll") for (int i = 0; i < 4; ++i) {                                  \
      int s_ = (c_) * 16 + 4 * tq + i;                                               \
      int tl_ = dir ? (ntok - 1 - s_) : s_;                                          \
      const u16* rp_ = proj + (size_t)(row0 + tl_) * LDP + h * 128 + kk;             \
      LF[i] = rp_[PLF + dir * 512];                                                  \
      VV[i] = rp_[PIA];                                                              \
      QQ[i] = do_out ? rp_[PQA] : (u16)0;                                            \
      ZZ[i] = second ? rp_[PZA] : (u16)0;                                            \
    }                                                                                \
  }
  HG_LD(0, lfA, qA, vA, zA);
  HG_LD(1, lfB, qB, vB, zB);
  auto body = [&](const int c, u16 (&LF)[4], u16 (&QQ)[4], u16 (&VV)[4], u16 (&ZZ)[4]) __attribute__((always_inline)) {
    float lf[4], G[4], qv[4];
    u16 vv[4], zz[4];
#pragma unroll
    for (int i = 0; i < 4; ++i) { lf[i] = bf2f(LF[i]); qv[i] = bf2f(QQ[i]); vv[i] = VV[i]; zz[i] = ZZ[i]; }
    G[0] = lf[0]; G[1] = G[0] + lf[1]; G[2] = G[1] + lf[2]; G[3] = G[2] + lf[3];
    L.tot[tq][kk] = G[3];
    LBAR();
    if (c + 2 < nch) HG_LD(c + 2, LF, QQ, VV, ZZ);
    float t0 = L.tot[0][kk], t1 = L.tot[1][kk], t2 = L.tot[2][kk], t3 = L.tot[3][kk];
    float off = (tq > 0 ? t0 : 0.f) + (tq > 1 ? t1 : 0.f) + (tq > 2 ? t2 : 0.f);
    float gend = t0 + t1 + t2 + t3;
    float kh[4];
#pragma unroll
    for (int i = 0; i < 4; ++i) {
      float Gi = G[i] + off;
      float kv = neg_expm1(lf[i]);
      int s = 4 * tq + i;
      if (do_out) {
        L.qt[s][kk] = f2bf(qv[i] * fexp(Gi));
        L.kt[s][kk] = f2bf(kv * fexp(fminf(-Gi, 80.f)));
      }
      if (second) L.zt[s][kk] = zz[i];
      kh[i] = kv * fexp(gend - Gi);
    }
    *(uint2*)&L.khT[kk][4 * tq] = make_uint2(pack2(kh[0], kh[1]), pack2(kh[2], kh[3]));
    *(uint2*)&L.vT[kk][4 * tq] = make_uint2((uint32_t)vv[0] | ((uint32_t)vv[1] << 16), (uint32_t)vv[2] | ((uint32_t)vv[3] << 16));
    if (tq == 0) { L.dk[kk] = fexp(gend); gsum += gend; }
    LBAR();
    Frag bv;
    bv.h[0] = *(const uint2*)&L.vT[16 * wid + c16][4 * g];
    bv.h[1] = make_uint2(0u, 0u);
    f32x4 o = f32x4{0.f, 0.f, 0.f, 0.f};
    if (do_out) {
      f32x4 at = f32x4{0.f, 0.f, 0.f, 0.f};
#pragma unroll
      for (int ks = 0; ks < 4; ++ks) {
        Frag a, b;
        a.q = *(const uint4*)&L.kt[c16][32 * ks + 8 * g];
        b.q = *(const uint4*)&L.qt[c16][32 * ks + 8 * g];
        at = MFMA(a.v, b.v, at);
      }
      Frag pa;
#pragma unroll
      for (int r = 0; r < 4; ++r) at[r] = (4 * g + r <= c16) ? at[r] : 0.f;
      pa.w[0] = pack2(at[0], at[1]); pa.w[1] = pack2(at[2], at[3]); pa.w[2] = 0u; pa.w[3] = 0u;
      o = MFMA(pa.v, bv.v, o);
#pragma unroll
      for (int st = 0; st < 4; ++st) {
        Frag a, b;
        a.h[0] = *(const uint2*)&L.qt[c16][32 * st + 4 * g];
        a.h[1] = *(const uint2*)&L.qt[c16][32 * st + 16 + 4 * g];
        b.w[0] = pack2(S[2 * st][0], S[2 * st][1]); b.w[1] = pack2(S[2 * st][2], S[2 * st][3]);
        b.w[2] = pack2(S[2 * st + 1][0], S[2 * st + 1][1]); b.w[3] = pack2(S[2 * st + 1][2], S[2 * st + 1][3]);
        o = MFMA(a.v, b.v, o);
      }
    }
#pragma unroll
    for (int k8 = 0; k8 < 8; ++k8) {
      float4 d = *(const float4*)&L.dk[16 * k8 + 4 * g];
      f32x4 s0 = S[k8];
      s0[0] *= d.x; s0[1] *= d.y; s0[2] *= d.z; s0[3] *= d.w;
      Frag a;
      a.h[0] = *(const uint2*)&L.khT[16 * k8 + c16][4 * g];
      a.h[1] = make_uint2(0u, 0u);
      S[k8] = MFMA(a.v, bv.v, s0);
    }
    if (do_out) {
      const int vcol = 16 * wid + c16;
      if (!second) {
#pragma unroll
        for (int r = 0; r < 4; ++r) {
          int s = c * 16 + 4 * g + r;
          int tl = dir ? (ntok - 1 - s) : s;
          L.obuf[tl][vcol] = f2bf(o[r]);
        }
      } else {
#pragma unroll
        for (int r = 0; r < 4; ++r) {
          int s = c * 16 + 4 * g + r;
          int tl = dir ? (ntok - 1 - s) : s;
          L.osum[4 * g + r][vcol] = o[r] + bf2f(L.obuf[tl][vcol]);
        }
        LBAR();
        {
          int sl = tid >> 5, vq = tid & 31;
          int s = c * 16 + sl;
          int tl = dir ? (ntok - 1 - s) : s;
          float4 ov = *(const float4*)&L.osum[sl][4 * vq];
          float ss = ov.x * ov.x + ov.y * ov.y + ov.z * ov.z + ov.w * ov.w;
#pragma unroll
          for (int m = 1; m <= 16; m <<= 1) ss += __shfl_xor(ss, m);
          float rinv = rsqrtf(ss * (1.f / 128.f) + EPSV);
          u16* rp = projw + (size_t)(row0 + tl) * LDP + h * 128 + 4 * vq;
          uint2 z = *(const uint2*)&L.zt[sl][4 * vq];
          float y0 = ov.x * rinv * gg.x * lo2f(z.x), y1 = ov.y * rinv * gg.y * hi2f(z.x);
          float y2 = ov.z * rinv * gg.z * lo2f(z.y), y3 = ov.w * rinv * gg.w * hi2f(z.y);
          if (!dry) *(uint2*)(rp + PQA) = make_uint2(pack2(y0, y1), pack2(y2, y3));
        }
      }
    }
  };
  for (int c = 0; c < nch; c += 2) {
    body(c, lfA, qA, vA, zA);
    body(c + 1, lfB, qB, vB, zB);
  }
  __syncthreads();
}

__device__ __forceinline__ void hgrn_load_state(const float* m, f32x4 (&S)[8]) {
  const int tid_ = otid(); const int lane = tid_ & 63, wid = tid_ >> 6, c16 = lane & 15, g = lane >> 4;
#pragma unroll
  for (int k8 = 0; k8 < 8; ++k8)
#pragma unroll
    for (int r = 0; r < 4; ++r) S[k8][r] = m[(16 * k8 + 4 * g + r) * 128 + 16 * wid + c16];
}
__device__ __forceinline__ void hgrn_store_state(float* m, const f32x4 (&S)[8]) {
  const int tid_ = otid(); const int lane = tid_ & 63, wid = tid_ >> 6, c16 = lane & 15, g = lane >> 4;
#pragma unroll
  for (int k8 = 0; k8 < 8; ++k8)
#pragma unroll
    for (int r = 0; r < 4; ++r) m[(16 * k8 + 4 * g + r) * 128 + 16 * wid + c16] = S[k8][r];
}
__device__ __forceinline__ void hgrn_advance(const float* U, const float* D, f32x4 (&S)[8]) {
  const int tid_ = otid(); const int lane = tid_ & 63, wid = tid_ >> 6, c16 = lane & 15, g = lane >> 4;
#pragma unroll
  for (int k8 = 0; k8 < 8; ++k8)
#pragma unroll
    for (int r = 0; r < 4; ++r) {
      int k = 16 * k8 + 4 * g + r;
      S[k8][r] = D[k] * S[k8][r] + U[k * 128 + 16 * wid + c16];
    }
}

__device__ __forceinline__ void hgrn_ctx_item(const Params& p, int l, int item, char* lds, const bool dry = false) {
  HgrnLds& L = *(HgrnLds*)lds;
  const int b = item >> 2, h = item & 3;
  f32x4 S[8];
  float gsum = 0.f;
#pragma unroll
  for (int i = 0; i < 8; ++i) S[i] = f32x4{0.f, 0.f, 0.f, 0.f};
  hgrn_pass(p, l, b * 256, 256, h, 0, S, true, false, gsum, L, dry);
  if (!dry) hgrn_store_state(p.out + OST + ((size_t)(((b * 2 + l) * 2 + 0) * 4 + h)) * 16384, S);
#pragma unroll
  for (int i = 0; i < 8; ++i) S[i] = f32x4{0.f, 0.f, 0.f, 0.f};
  hgrn_pass(p, l, b * 256, 256, h, 1, S, true, true, gsum, L, dry);
  if (!dry) hgrn_store_state(p.out + OST + ((size_t)(((b * 2 + l) * 2 + 1) * 4 + h)) * 16384, S);
}
__device__ __forceinline__ void hgrn_lat1_item(const Params& p, int l, int item, char* lds) {
  HgrnLds& L = *(HgrnLds*)lds;
  const int seg = item & 15, dir = (item >> 4) & 1, h = (item >> 5) & 3, b = item >> 7;
  f32x4 S[8];
  float gsum = 0.f;
#pragma unroll
  for (int i = 0; i < 8; ++i) S[i] = f32x4{0.f, 0.f, 0.f, 0.f};
  hgrn_pass(p, l, NCTX + b * 2048 + seg * 128, 128, h, dir, S, false, false, gsum, L);
  float* SU = (float*)(p.ws + OFF_SEGU);
  float* SD = (float*)(p.ws + OFF_SEGD);
  {
    const int tq_ = otid(); const int lane_ = tq_ & 63, wid_ = tq_ >> 6, c16_ = lane_ & 15, g_ = lane_ >> 4;
    float* m_ = SU + (size_t)item * 16384;
#pragma unroll
    for (int k8 = 0; k8 < 8; ++k8)
#pragma unroll
      for (int r = 0; r < 4; ++r) __hip_atomic_store(m_ + (16 * k8 + 4 * g_ + r) * 128 + 16 * wid_ + c16_, S[k8][r], __ATOMIC_RELAXED, __HIP_MEMORY_SCOPE_AGENT);
  }
  const int t_ = otid();
  if (t_ < 128) __hip_atomic_store(SD + item * 128 + t_, fexp(gsum), __ATOMIC_RELAXED, __HIP_MEMORY_SCOPE_AGENT);
  volatile int* flag = (volatile int*)(lds + LDS_TILE + 32);
  asm volatile("s_waitcnt vmcnt(0)" ::: "memory");
  __syncthreads();
  if (t_ == 0) {
    unsigned* tk = (unsigned*)(p.ws + OFF_CNT) + 8 + l * 32 + (item >> 4);
    const unsigned old = __hip_atomic_fetch_add(tk, 1u, __ATOMIC_RELAXED, __HIP_MEMORY_SCOPE_AGENT);
    const int last = (old == 15u) ? 1 : 0;
    if (last) { __builtin_amdgcn_fence(__ATOMIC_ACQUIRE, "agent"); asm volatile("s_waitcnt vmcnt(0)" ::: "memory"); }
    *flag = last;
  }
  __syncthreads();
  if (*flag) {
    const int base = (item >> 4) * 16;
    hgrn_load_state(p.in[5] + ((size_t)(((b * 2 + l) * 2 + dir) * 4 + h)) * 16384, S);
    const int lane = t_ & 63, wid = t_ >> 6, c16 = lane & 15, g = lane >> 4;
    float un[8][4]; float4 dn[8];
    {
      const int sg0 = dir ? 15 : 0;
      const float* U0 = SU + (size_t)(base + sg0) * 16384; const float* D0 = SD + (base + sg0) * 128;
#pragma unroll
      for (int k8 = 0; k8 < 8; ++k8) {
        dn[k8] = *(const float4*)(D0 + 16 * k8 + 4 * g);
#pragma unroll
        for (int r = 0; r < 4; ++r) un[k8][r] = U0[(16 * k8 + 4 * g + r) * 128 + 16 * wid + c16];
      }
    }
#pragma unroll 1
    for (int i = 0; i < 16; ++i) {
      const int sg = dir ? (15 - i) : i;
      float* U = SU + (size_t)(base + sg) * 16384;
      float uc[8][4]; float4 dc[8];
#pragma unroll
      for (int k8 = 0; k8 < 8; ++k8) { dc[k8] = dn[k8];
#pragma unroll
        for (int r = 0; r < 4; ++r) uc[k8][r] = un[k8][r]; }
      if (i + 1 < 16) {
        const int sgn = dir ? (14 - i) : (i + 1);
        const float* Un = SU + (size_t)(base + sgn) * 16384; const float* Dn = SD + (base + sgn) * 128;
#pragma unroll
        for (int k8 = 0; k8 < 8; ++k8) {
          dn[k8] = *(const float4*)(Dn + 16 * k8 + 4 * g);
#pragma unroll
          for (int r = 0; r < 4; ++r) un[k8][r] = Un[(16 * k8 + 4 * g + r) * 128 + 16 * wid + c16];
        }
      }
#pragma unroll
      for (int k8 = 0; k8 < 8; ++k8) {
        const float dd[4] = {dc[k8].x, dc[k8].y, dc[k8].z, dc[k8].w};
#pragma unroll
        for (int r = 0; r < 4; ++r) {
          const int idx = (16 * k8 + 4 * g + r) * 128 + 16 * wid + c16;
          U[idx] = S[k8][r];
          S[k8][r] = dd[r] * S[k8][r] + uc[k8][r];
        }
      }
    }
  }
  __syncthreads();
}
__device__ __forceinline__ void hgrn_lat2_item(const Params& p, int l, int item, char* lds, const bool dry = false) {
  HgrnLds& L = *(HgrnLds*)lds;
  const int seg = item & 15, h = (item >> 4) & 3, b = item >> 6;
  const float* SU = (const float*)(p.ws + OFF_SEGU);
  const float* SD = (const float*)(p.ws + OFF_SEGD);
  f32x4 S[8];
  float gsum = 0.f;
  hgrn_load_state(SU + (size_t)(((b * 4 + h) * 2 + 0) * 16 + seg) * 16384, S);
  hgrn_pass(p, l, NCTX + b * 2048 + seg * 128, 128, h, 0, S, true, false, gsum, L, dry);
  hgrn_load_state(SU + (size_t)(((b * 4 + h) * 2 + 1) * 16 + seg) * 16384, S);
  hgrn_pass(p, l, NCTX + b * 2048 + seg * 128, 128, h, 1, S, true, true, gsum, L, dry);
}

__device__ __forceinline__ void attn_item(const Params& p, int l, int item, const bool lat, char* lds, const bool dry = false) {
  const int tid = otid(), lane = tid & 63, wid = tid >> 6, c16 = lane & 15, g = lane >> 4;
  char* ws = p.ws;
  u16* proj = (u16*)(ws + OFF_PROJ);
  int b, h, qb, nkeys, rowbase;
  const u16* Vt; int ldv;
  if (!lat) { qb = item & 1; h = (item >> 1) & 3; b = item >> 3; nkeys = 256; rowbase = b * 256; Vt = (const u16*)(ws + OFF_VTC) + (size_t)((b * 4 + h) * 128) * 256; ldv = 256; }
  else { qb = item & 15; h = (item >> 4) & 3; b = item >> 6; nkeys = 2304; rowbase = NCTX + b * 2048; Vt = (const u16*)(ws + OFF_VTL + l * SZ_VTL) + (size_t)((b * 4 + h) * 128) * 2304; ldv = 2304; }
  const u16* Kc = (const u16*)(ws + OFF_KC) + (size_t)((l * 2 + b) * 256) * 512 + h * 128;
  u16* Ks = (u16*)lds;
  u16* Vs = Ks + 64 * 144;
  float lam_init = 0.8f - 0.6f * expf(-0.3f * (float)l);
  float lam;
  {
    const float* lp = p.in[15] + l * 256;
    float a = lp[lane] * lp[64 + lane], c = lp[128 + lane] * lp[192 + lane];
#pragma unroll
    for (int o = 32; o >= 1; o >>= 1) { a += __shfl_xor(a, o); c += __shfl_xor(c, o); }
    lam = expf(a) - expf(c) + lam_init;
  }
  const int qrow = rowbase + qb * 128 + wid * 16 + c16;
  Frag qf[2][2];
#pragma unroll
  for (int m = 0; m < 2; ++m)
#pragma unroll
    for (int ks = 0; ks < 2; ++ks) qf[m][ks].q = *(const uint4*)(proj + (size_t)qrow * LDP + PQB + h * 128 + m * 64 + ks * 32 + g * 8);
  f32x4 O[2][8];
#pragma unroll
  for (int m = 0; m < 2; ++m)
#pragma unroll
    for (int v = 0; v < 8; ++v) O[m][v] = f32x4{0.f, 0.f, 0.f, 0.f};
  float mrun[2] = {-1e30f, -1e30f}, lsum[2] = {0.f, 0.f};
  uint4 kr0, kr1, vr0, vr1;
#define ATT_LD(kt_)                                                                                           \
  {                                                                                                           \
    const int key0 = (kt_) * 64;                                                                              \
    const bool fromproj = (!lat) || (key0 < 2048);                                                            \
    {                                                                                                         \
      int q = tid; int key = q >> 4, cc = q & 15;                                                             \
      const u16* src = fromproj ? proj + (size_t)(rowbase + key0 + key) * LDP + PKB + h * 128 + cc * 8        \
                                : Kc + (size_t)(key0 - 2048 + key) * 512 + cc * 8;                            \
      kr0 = *(const uint4*)src;                                                                               \
      int v = q >> 3, c8 = q & 7;                                                                             \
      vr0 = *(const uint4*)(Vt + (size_t)v * ldv + key0 + c8 * 8);                                            \
    }                                                                                                         \
    {                                                                                                         \
      int q = tid + 512; int key = q >> 4, cc = q & 15;                                                       \
      const u16* src = fromproj ? proj + (size_t)(rowbase + key0 + key) * LDP + PKB + h * 128 + cc * 8        \
                                : Kc + (size_t)(key0 - 2048 + key) * 512 + cc * 8;                            \
      kr1 = *(const uint4*)src;                                                                               \
      int v = q >> 3, c8 = q & 7;                                                                             \
      vr1 = *(const uint4*)(Vt + (size_t)v * ldv + key0 + c8 * 8);                                            \
    }                                                                                                         \
  }
#define ATT_ST()                                                                                              \
  {                                                                                                           \
    { int q = tid; int key = q >> 4, cc = q & 15; *(uint4*)(Ks + key * 144 + cc * 8) = kr0;                   \
      int v = q >> 3, c8 = q & 7; *(uint4*)(Vs + v * 72 + c8 * 8) = vr0; }                                    \
    { int q = tid + 512; int key = q >> 4, cc = q & 15; *(uint4*)(Ks + key * 144 + cc * 8) = kr1;             \
      int v = q >> 3, c8 = q & 7; *(uint4*)(Vs + v * 72 + c8 * 8) = vr1; }                                    \
  }
  const int nkt = nkeys >> 6;
  ATT_LD(0);
  for (int kt = 0; kt < nkt; ++kt) {
    LBAR();
    ATT_ST();
    LBAR();
    if (kt + 1 < nkt) ATT_LD(kt + 1);
    Frag pf[2][2];
#pragma unroll
    for (int m = 0; m < 2; ++m) {
      f32x4 s[4];
#pragma unroll
      for (int k4 = 0; k4 < 4; ++k4) {
        s[k4] = f32x4{0.f, 0.f, 0.f, 0.f};
#pragma unroll
        for (int ks = 0; ks < 2; ++ks) {
          Frag a;
          a.q = *(const uint4*)(Ks + (16 * k4 + c16) * 144 + m * 64 + ks * 32 + g * 8);
          s[k4] = MFMA(a.v, qf[m][ks].v, s[k4]);
        }
      }
      float mx = -1e30f;
#pragma unroll
      for (int k4 = 0; k4 < 4; ++k4)
#pragma unroll
        for (int r = 0; r < 4; ++r) mx = fmaxf(mx, s[k4][r]);
      mx = fmaxf(mx, __shfl_xor(mx, 16));
      mx = fmaxf(mx, __shfl_xor(mx, 32));
      if (__any(mx - mrun[m] > 8.0f)) {
        const float mnew = fmaxf(mrun[m], mx);
        const float alpha = fexp(mrun[m] - mnew);
        mrun[m] = mnew;
        lsum[m] *= alpha;
#pragma unroll
        for (int v = 0; v < 8; ++v) { O[m][v][0] *= alpha; O[m][v][1] *= alpha; O[m][v][2] *= alpha; O[m][v][3] *= alpha; }
      }
      const float mneg = -mrun[m] * 1.4426950408889634f;
      float ps = 0.f;
#pragma unroll
      for (int k4 = 0; k4 < 4; ++k4)
#pragma unroll
        for (int r = 0; r < 4; ++r) { s[k4][r] = __builtin_amdgcn_exp2f(fmaf(s[k4][r], 1.4426950408889634f, mneg)); ps += s[k4][r]; }
      lsum[m] += ps;
#pragma unroll
      for (int sp = 0; sp < 2; ++sp) {
        pf[m][sp].w[0] = pack2(s[2 * sp][0], s[2 * sp][1]); pf[m][sp].w[1] = pack2(s[2 * sp][2], s[2 * sp][3]);
        pf[m][sp].w[2] = pack2(s[2 * sp + 1][0], s[2 * sp + 1][1]); pf[m][sp].w[3] = pack2(s[2 * sp + 1][2], s[2 * sp + 1][3]);
      }
    }
#pragma unroll
    for (int v = 0; v < 8; ++v)
#pragma unroll
      for (int sp = 0; sp < 2; ++sp) {
        Frag a;
        a.h[0] = *(const uint2*)(Vs + (16 * v + c16) * 72 + 32 * sp + 4 * g);
        a.h[1] = *(const uint2*)(Vs + (16 * v + c16) * 72 + 32 * sp + 16 + 4 * g);
        O[0][v] = MFMA(a.v, pf[0][sp].v, O[0][v]);
        O[1][v] = MFMA(a.v, pf[1][sp].v, O[1][v]);
      }
  }
  float l0 = lsum[0], l1 = lsum[1];
  l0 += __shfl_xor(l0, 16); l0 += __shfl_xor(l0, 32);
  l1 += __shfl_xor(l1, 16); l1 += __shfl_xor(l1, 32);
  const float i0 = 1.f / l0, i1 = lam / l1;
  float ss = 0.f;
#pragma unroll
  for (int v = 0; v < 8; ++v)
#pragma unroll
    for (int r = 0; r < 4; ++r) { float o = O[0][v][r] * i0 - O[1][v][r] * i1; O[0][v][r] = o; ss += o * o; }
  ss += __shfl_xor(ss, 16); ss += __shfl_xor(ss, 32);
  const float rinv = rsqrtf(ss * (1.f / 128.f) + EPSV) * (1.f - lam_init);
  u16* rp = proj + (size_t)qrow * LDP + h * 128;
#pragma unroll
  for (int v = 0; v < 8; ++v) {
    int vc = 16 * v + 4 * g;
    float4 sg = *(const float4*)(p.in[16] + l * 128 + vc);
    uint2 z = *(const uint2*)(rp + PZB + vc);
    float y0 = O[0][v][0] * rinv * sg.x * lo2f(z.x), y1 = O[0][v][1] * rinv * sg.y * hi2f(z.x);
    float y2 = O[0][v][2] * rinv * sg.z * lo2f(z.y), y3 = O[0][v][3] * rinv * sg.w * hi2f(z.y);
    if (!dry) *(uint2*)(rp + PQB + vc) = make_uint2(pack2(y0, y1), pack2(y2, y3));
  }
  __syncthreads();
}

__device__ __forceinline__ void f1_item(const Params& p, int item, char* lds) {
  const int tid = otid(), lane = tid & 63, wid = tid >> 6, wr = wid >> 2, wc = wid & 3, fr = lane & 15, fq = lane >> 4;
  char* ws = p.ws;
  const int jh = item & 1, gq = (item >> 1) & 3, mt = item >> 3;
  f32x4 acc[4][4];
  gemm_kloop<128>((const u16*)(ws + OFF_B1) + jh * 128 * 128, 128, (const u16*)(ws + OFF_PROJ) + (size_t)(mt * 256) * LDP + PUC + gq * 128, LDP, 128, acc, lds);
#pragma unroll
  for (int a = 0; a < 4; ++a)
#pragma unroll
    for (int b = 0; b < 4; ++b) {
      int tokl = wc * 64 + a * 16 + 4 * fq;
      int jj = wr * 64 + b * 16 + fr;
      uint2 pk = make_uint2(pack2(acc[a][b][0], acc[a][b][1]), pack2(acc[a][b][2], acc[a][b][3]));
      if (mt < 32) {
        *(uint2*)(ws + OFF_PTC + ((size_t)((mt * 4 + gq) * 128 + jj) * 512 + jh * 256 + tokl) * 2) = pk;
      } else {
        int rp = (mt - 32) * 256 + tokl; int bb = rp >> 11, t = rp & 2047;
        *(uint2*)(ws + OFF_PTL + ((size_t)((bb * 4 + gq) * 128 + jj) * 4096 + jh * 2048 + t) * 2) = pk;
      }
    }
}

struct F2Epi {
  char* ws; float scl; int rowbase_mul;
  bool lat;
  __device__ __forceinline__ void operator()(f32x4 (&acc)[2][2][4][2], const Unit& u, int wr, int wc, int fr, int fq, LAS unsigned char* lds) const {
    u16* proj = (u16*)(ws + OFF_PROJ);
#pragma unroll
    for (int ai = 0; ai < 2; ++ai)
#pragma unroll
      for (int mh = 0; mh < 2; ++mh) {
        uint2 zv[2][2][2];
#pragma unroll
        for (int mm = 0; mm < 2; ++mm)
#pragma unroll
          for (int bj = 0; bj < 2; ++bj)
#pragma unroll
            for (int n = 0; n < 2; ++n) {
              const int tp = u.x * 256 + ai * 128 + wr * 64 + (mh * 2 + mm) * 16 + fr;
              const int nn = u.y * 256 + bj * 128 + wc * 32 + n * 16 + 4 * fq;
              const int bb = nn >> 9, col = nn & 511;
              const u16* rp = proj + (size_t)(lat ? (NCTX + bb * 2048 + tp) : (bb * 256 + tp)) * LDP;
              zv[mm][bj][n] = *(const uint2*)(rp + PZC + col);
            }
#pragma unroll
        for (int mm = 0; mm < 2; ++mm)
#pragma unroll
          for (int bj = 0; bj < 2; ++bj)
#pragma unroll
            for (int n = 0; n < 2; ++n) {
              const int m = mh * 2 + mm;
              const int tp = u.x * 256 + ai * 128 + wr * 64 + m * 16 + fr;
              const int nn = u.y * 256 + bj * 128 + wc * 32 + n * 16 + 4 * fq;
              const int bb = nn >> 9, col = nn & 511;
              u16* rp = proj + (size_t)(lat ? (NCTX + bb * 2048 + tp) : (bb * 256 + tp)) * LDP;
              const uint2 z = zv[mm][bj][n];
              f32x4 a4 = acc[ai][bj][m][n];
              *(uint2*)(rp + PUC + col) = make_uint2(pack2(a4[0] * scl * lo2f(z.x), a4[1] * scl * hi2f(z.x)),
                                                     pack2(a4[2] * scl * lo2f(z.y), a4[3] * scl * hi2f(z.y)));
            }
      }
  }
};
__device__ __forceinline__ void f2c_item(const Params& p, int item, char* lds) {
  OneUnit S; S.u.a = p.ws + OFF_DC; S.u.b = p.ws + OFF_PTC + (size_t)item * 256 * 1024; S.u.x = 0; S.u.y = item; S.u.lda = 512; S.u.ldb = 512; S.u.nt = 8;
  F2Epi E; E.ws = p.ws; E.scl = 0.005524271728019903f; E.lat = false; E.rowbase_mul = 0;
  gemm_phase((LAS unsigned char*)lds, S, E);
}
struct F2HalfEpi {
  uint2* part;
  __device__ __forceinline__ void operator()(f32x4 (&acc)[2][2][4][2], const Unit& u, int wr, int wc, int fr, int fq, LAS unsigned char* lds) const {
    const int tid = wr * 256 + wc * 64 + fq * 16 + fr;
#pragma unroll
    for (int ai = 0; ai < 2; ++ai)
#pragma unroll
      for (int bj = 0; bj < 2; ++bj)
#pragma unroll
        for (int m = 0; m < 4; ++m)
#pragma unroll
          for (int n = 0; n < 2; ++n) {
            f32x4 a4 = acc[ai][bj][m][n];
            __hip_atomic_store((unsigned long long*)(part + (((ai * 2 + bj) * 4 + m) * 2 + n) * 512 + tid), (unsigned long long)pack2(a4[0], a4[1]) | ((unsigned long long)pack2(a4[2], a4[3]) << 32), __ATOMIC_RELAXED, __HIP_MEMORY_SCOPE_AGENT);
          }
  }
};
__device__ __forceinline__ void f2l_item(const Params& p, int l, int item, char* lds) {
  char* ws = p.ws;
  const int tile = item >> 1, half = item & 1, mt = tile >> 2, nt = tile & 3;
  uint2* pbase = (uint2*)(ws + OFF_F2P);
  {
    OneUnit S; S.u.a = ws + OFF_DL + ((size_t)mt * 256 * 4096 + half * 2048) * 2; S.u.b = ws + OFF_PTL + ((size_t)nt * 256 * 4096 + half * 2048) * 2;
    S.u.x = mt; S.u.y = nt; S.u.lda = 4096; S.u.ldb = 4096; S.u.nt = 32;
    F2HalfEpi E; E.part = pbase + (size_t)(tile * 2 + half) * (32 * 512);
    gemm_phase((LAS unsigned char*)lds, S, E);
  }
  const int t_ = otid();
  volatile int* flag = (volatile int*)(lds + LDS_TILE + 32);
  asm volatile("s_waitcnt vmcnt(0)" ::: "memory");
  __syncthreads();
  if (t_ == 0) {
    unsigned* tk = (unsigned*)(ws + OFF_CNT) + 72 + l * 32 + tile;
    const unsigned old = __hip_atomic_fetch_add(tk, 1u, __ATOMIC_RELAXED, __HIP_MEMORY_SCOPE_AGENT);
    const int last = (old == 1u) ? 1 : 0;
    if (last) { __builtin_amdgcn_fence(__ATOMIC_ACQUIRE, "agent"); asm volatile("s_waitcnt vmcnt(0)" ::: "memory"); }
    *flag = last;
  }
  __syncthreads();
  if (*flag) {
    const int lane = t_ & 63, wid = t_ >> 6, wr = wid >> 2, wc = wid & 3, fr = lane & 15, fq = lane >> 4;
    const uint2* p0 = pbase + (size_t)(tile * 2 + 0) * (32 * 512);
    const uint2* p1 = pbase + (size_t)(tile * 2 + 1) * (32 * 512);
    u16* proj = (u16*)(ws + OFF_PROJ);
    const float scl = 1.f / 512.f;
#pragma unroll
    for (int ai = 0; ai < 2; ++ai)
#pragma unroll
      for (int mh = 0; mh < 2; ++mh) {
        uint2 zv[2][2][2], av[2][2][2], bv2[2][2][2];
#pragma unroll
        for (int mm = 0; mm < 2; ++mm)
#pragma unroll
          for (int bj = 0; bj < 2; ++bj)
#pragma unroll
            for (int n = 0; n < 2; ++n) {
              const int m = mh * 2 + mm;
              const int tp = mt * 256 + ai * 128 + wr * 64 + m * 16 + fr;
              const int nn = nt * 256 + bj * 128 + wc * 32 + n * 16 + 4 * fq;
              const int bb = nn >> 9, col = nn & 511;
              const u16* rp = proj + (size_t)(NCTX + bb * 2048 + tp) * LDP;
              zv[mm][bj][n] = *(const uint2*)(rp + PZC + col);
              const int idx = (((ai * 2 + bj) * 4 + m) * 2 + n) * 512 + t_;
              av[mm][bj][n] = p0[idx]; bv2[mm][bj][n] = p1[idx];
            }
#pragma unroll
        for (int mm = 0; mm < 2; ++mm)
#pragma unroll
          for (int bj = 0; bj < 2; ++bj)
#pragma unroll
            for (int n = 0; n < 2; ++n) {
              const int m = mh * 2 + mm;
              const int tp = mt * 256 + ai * 128 + wr * 64 + m * 16 + fr;
              const int nn = nt * 256 + bj * 128 + wc * 32 + n * 16 + 4 * fq;
              const int bb = nn >> 9, col = nn & 511;
              u16* rp = proj + (size_t)(NCTX + bb * 2048 + tp) * LDP;
              const uint2 z = zv[mm][bj][n], a = av[mm][bj][n], c = bv2[mm][bj][n];
              const float y0 = (lo2f(a.x) + lo2f(c.x)) * scl * lo2f(z.x), y1 = (hi2f(a.x) + hi2f(c.x)) * scl * hi2f(z.x);
              const float y2 = (lo2f(a.y) + lo2f(c.y)) * scl * lo2f(z.y), y3 = (hi2f(a.y) + hi2f(c.y)) * scl * hi2f(z.y);
              *(uint2*)(rp + PUC + col) = make_uint2(pack2(y0, y1), pack2(y2, y3));
            }
      }
  }
  __syncthreads();
}

__device__ __forceinline__ bool xcd_tile(int bid, int& pm, int& pn) {
  const int x = bid & 7, j = bid >> 3;
  if (j >= 24) return false;
  pm = 6 * x + (j >> 2); pn = j & 3;
  return true;
}
struct P5Sched {
  char* ws; int x, j;
  __device__ __forceinline__ bool next(int i, Unit& u) const {
    if (j < 24) {
      if (i >= 5) return false;
      const int pm = 6 * x + (j >> 2), pn = j & 3;
      const int jj = (i < 4) ? (i >> 1) : 2;
      if (i == 0 || i == 2) {
        u.a = ws + OFF_H + (size_t)pm * 256 * 2048; u.b = ws + OFF_WIN + (size_t)(5632 + jj * 1024 + pn * 256) * 2048;
        u.lda = 1024; u.ldb = 1024; u.nt = 16; u.x = pm; u.y = pn | (jj << 8);
      } else {
        const int yc = (jj == 0) ? PQA : ((jj == 1) ? PQB : PUC);
        u.a = ws + OFF_PROJ + ((size_t)pm * 256 * LDP + yc) * 2; u.b = ws + OFF_WBR + ((size_t)jj * 1024 * 512 + (size_t)pn * 256 * 512) * 2;
        u.lda = LDP; u.ldb = 512; u.nt = 8; u.x = pm; u.y = pn | (jj << 8) | ((i == 4) ? 0x2000 : 0x1000);
      }
      return true;
    }
    if (i >= 3) return false;
    const int tj = 3 * (j - 24) + i;
    const int pm = 6 * x + (tj >> 2), pn = tj & 3;
    u.a = ws + OFF_H + (size_t)pm * 256 * 2048; u.b = ws + OFF_WIN + (size_t)(5632 + 2 * 1024 + pn * 256) * 2048;
    u.lda = 1024; u.ldb = 1024; u.nt = 16; u.x = pm; u.y = pn | (2 << 8) | 0x3000;
    return true;
  }
};
struct P5Epi {
  char* ws; u16* mg; unsigned* flags; bool skip;
  __device__ __forceinline__ void operator()(f32x4 (&acc)[2][2][4][2], const Unit& u, int wr, int wc, int fr, int fq, LAS unsigned char* lds) const {
    if (skip) return;
    { const int t_ = otid(); const int w_ = t_ >> 6; wr = w_ >> 2; wc = w_ & 3; fr = t_ & 15; fq = (t_ & 63) >> 4; }
    const int tid = wr * 256 + wc * 64 + fq * 16 + fr;
    const int type = (u.y >> 12) & 3, j = (u.y >> 8) & 3, pn = u.y & 0xff, pm = u.x;
    const int tile = pm * 4 + pn;
    uint2* gs = (uint2*)(ws + OFF_SEGU) + (size_t)tile * (32 * 512);
    u16* g2p = (u16*)(ws + OFF_PROJ) + (size_t)pm * 256 * LDP + PLF + pn * 256;
    if (type == 0) {
#pragma unroll
      for (int ai = 0; ai < 2; ++ai)
#pragma unroll
        for (int bj = 0; bj < 2; ++bj)
#pragma unroll
          for (int m = 0; m < 4; ++m)
#pragma unroll
            for (int n = 0; n < 2; ++n) {
              f32x4 a4 = acc[ai][bj][m][n];
              gs[(((ai * 2 + bj) * 4 + m) * 2 + n) * 512 + tid] = make_uint2(pack2(sigmf(a4[0]), sigmf(a4[1])), pack2(sigmf(a4[2]), sigmf(a4[3])));
            }
      return;
    }
    if (type == 3) {
#pragma unroll
      for (int ai = 0; ai < 2; ++ai)
#pragma unroll
        for (int bj = 0; bj < 2; ++bj)
#pragma unroll
          for (int m = 0; m < 4; ++m)
#pragma unroll
            for (int n = 0; n < 2; ++n) {
              f32x4 a4 = acc[ai][bj][m][n];
              const int row = ai * 128 + wr * 64 + m * 16 + fr, col = bj * 128 + wc * 32 + n * 16 + 4 * fq;
              const unsigned long long v = (unsigned long long)pack2(sigmf(a4[0]), sigmf(a4[1])) | ((unsigned long long)pack2(sigmf(a4[2]), sigmf(a4[3])) << 32);
              __hip_atomic_store((unsigned long long*)(g2p + (size_t)row * LDP + col), v, __ATOMIC_RELAXED, __HIP_MEMORY_SCOPE_AGENT);
            }
      asm volatile("s_waitcnt vmcnt(0)" ::: "memory");
      if ((fq * 16 + fr) == 0) __hip_atomic_fetch_add(flags + tile, 1u, __ATOMIC_RELAXED, __HIP_MEMORY_SCOPE_AGENT);
      return;
    }
    if (type == 2) {
      if (tid == 0) {
        unsigned sp = 0;
        while (__hip_atomic_load(flags + tile, __ATOMIC_RELAXED, __HIP_MEMORY_SCOPE_AGENT) < 8u) { __builtin_amdgcn_s_sleep(2); if (++sp > (1u << 22)) break; }
        __builtin_amdgcn_fence(__ATOMIC_ACQUIRE, "agent");
        asm volatile("s_waitcnt vmcnt(0)" ::: "memory");
      }
      asm volatile("" ::: "memory");
      __builtin_amdgcn_s_barrier();
      asm volatile("" ::: "memory");
    }
#pragma unroll
    for (int ai = 0; ai < 2; ++ai)
#pragma unroll
      for (int mh = 0; mh < 2; ++mh) {
        uint2 gv[2][2][2], pv[2][2][2];
#pragma unroll
        for (int mm = 0; mm < 2; ++mm)
#pragma unroll
          for (int bj = 0; bj < 2; ++bj)
#pragma unroll
            for (int n = 0; n < 2; ++n) {
              const int m = mh * 2 + mm;
              const int rl = ai * 128 + wr * 64 + m * 16 + fr, cl = bj * 128 + wc * 32 + n * 16 + 4 * fq;
              const int row = pm * 256 + rl, col = pn * 256 + cl;
              const uint2* gptr = (type == 2) ? (const uint2*)(g2p + (size_t)rl * LDP + cl) : (const uint2*)(gs + (((ai * 2 + bj) * 4 + m) * 2 + n) * 512 + tid);
              gv[mm][bj][n] = *gptr;
              pv[mm][bj][n] = (j > 0) ? *(const uint2*)(mg + (size_t)row * 1024 + col) : make_uint2(0u, 0u);
            }
#pragma unroll
        for (int mm = 0; mm < 2; ++mm)
#pragma unroll
          for (int bj = 0; bj < 2; ++bj)
#pragma unroll
            for (int n = 0; n < 2; ++n) {
              const int m = mh * 2 + mm;
              const int row = pm * 256 + ai * 128 + wr * 64 + m * 16 + fr;
              const int col = pn * 256 + bj * 128 + wc * 32 + n * 16 + 4 * fq;
              f32x4 a4 = acc[ai][bj][m][n];
              const uint2 g2 = gv[mm][bj][n], p2 = pv[mm][bj][n];
              float t0 = lo2f(g2.x) * a4[0] + lo2f(p2.x), t1 = hi2f(g2.x) * a4[1] + hi2f(p2.x);
              float t2 = lo2f(g2.y) * a4[2] + lo2f(p2.y), t3 = hi2f(g2.y) * a4[3] + hi2f(p2.y);
              *(uint2*)(mg + (size_t)row * 1024 + col) = make_uint2(pack2(t0, t1), pack2(t2, t3));
            }
      }
  }
};
__device__ __forceinline__ void p5_phase(const Params& p, int l, char* lds, bool skip = false) {
  P5Sched S; S.ws = p.ws; S.x = blockIdx.x & 7; S.j = blockIdx.x >> 3;
  if (S.j >= 32) return;
  P5Epi E; E.ws = p.ws; E.mg = (u16*)(p.ws + OFF_MRG); E.flags = (unsigned*)(p.ws + OFF_CNT) + 136 + l * 192; E.skip = skip;
  gemm_phase((LAS unsigned char*)lds, S, E);
}

struct P6Epi {
  const float* xp0; const float* xs0; float* outp; const float* modp; int l;
  __device__ __forceinline__ void operator()(f32x4 (&acc)[2][2][4][2], const Unit& u, int wr, int wc, int fr, int fq, LAS unsigned char* lds) const {
    const int m0 = u.x * 256;
    const int ci = (m0 < NCTX) ? 0 : 1 + ((m0 - NCTX) >> 11);
    const float* xbase = (l == 0) ? ((m0 < NCTX) ? xp0 : xs0 - (size_t)NCTX * 1024) : outp;
    float4 gt[2][2];
#pragma unroll
    for (int bj = 0; bj < 2; ++bj)
#pragma unroll
      for (int n = 0; n < 2; ++n) gt[bj][n] = *(const float4*)(modp + (l * 3 + ci) * 3072 + 2048 + u.y * 256 + bj * 128 + wc * 32 + n * 16 + 4 * fq);
#pragma unroll
    for (int ai = 0; ai < 2; ++ai)
#pragma unroll
      for (int mh = 0; mh < 2; ++mh) {
        float4 xv[2][2][2];
#pragma unroll
        for (int mm = 0; mm < 2; ++mm)
#pragma unroll
          for (int bj = 0; bj < 2; ++bj)
#pragma unroll
            for (int n = 0; n < 2; ++n) {
              const int r = m0 + ai * 128 + wr * 64 + (mh * 2 + mm) * 16 + fr;
              const int col = u.y * 256 + bj * 128 + wc * 32 + n * 16 + 4 * fq;
              xv[mm][bj][n] = *(const float4*)(xbase + (size_t)r * 1024 + col);
            }
#pragma unroll
        for (int mm = 0; mm < 2; ++mm)
#pragma unroll
          for (int bj = 0; bj < 2; ++bj)
#pragma unroll
            for (int n = 0; n < 2; ++n) {
              const int m = mh * 2 + mm;
              const int r = m0 + ai * 128 + wr * 64 + m * 16 + fr;
              const int col = u.y * 256 + bj * 128 + wc * 32 + n * 16 + 4 * fq;
              f32x4 a4 = acc[ai][bj][m][n];
              const float4 x4 = xv[mm][bj][n], g4 = gt[bj][n];
              *(float4*)(outp + (size_t)r * 1024 + col) = make_float4(x4.x + g4.x * a4[0], x4.y + g4.y * a4[1], x4.z + g4.z * a4[2], x4.w + g4.w * a4[3]);
            }
      }
  }
};
__device__ __forceinline__ void p6_phase(const Params& p, int l, char* lds) {
  char* ws = p.ws;
  int pm, pn;
  if (!xcd_tile(blockIdx.x, pm, pn)) return;
  OneUnit S; S.u.a = ws + OFF_MRG + (size_t)pm * 256 * 2048; S.u.b = ws + OFF_WO + (size_t)pn * 256 * 2048; S.u.x = pm; S.u.y = pn;
  S.u.lda = 1024; S.u.ldb = 1024; S.u.nt = 16; S.reps = ((DUP_MASK & 512) && l == 0) ? 5 : 1;
  P6Epi E; E.xp0 = p.in[0]; E.xs0 = p.in[1]; E.outp = p.out; E.modp = (const float*)(ws + OFF_MOD); E.l = l;
  gemm_phase((LAS unsigned char*)lds, S, E);
}

#define XB_TMO      128
#define XB_XCNT(j)  (256  + 64 * (j))
#define XB_XSUB(j)  (1280 + 64 * (j))
#define XB_XGEN(j)  (2304 + 64 * (j))
#define XB_TOP      3328
#define XB_TOPGEN   3392
#define XCD_BAR_WORDS 3456
#define XB_SPIN_CAP (1u << 18)
struct XcdBarrier { unsigned* bar; unsigned x; volatile LAS unsigned* st; };
__device__ __forceinline__ unsigned xb_ld(unsigned* p) { return __hip_atomic_load(p, __ATOMIC_RELAXED, __HIP_MEMORY_SCOPE_AGENT); }
__device__ __forceinline__ unsigned xb_add(unsigned* p, unsigned v) { return __hip_atomic_fetch_add(p, v, __ATOMIC_RELAXED, __HIP_MEMORY_SCOPE_AGENT); }
__device__ __forceinline__ unsigned xb_xcc_id() { return (unsigned)__builtin_amdgcn_s_getreg((3 << 11) | 20) & 0xFu; }
#define XB_SPIN(cond, bar) do { unsigned _sp = 0; while (cond) { __builtin_amdgcn_s_sleep(1); \
    if ((++_sp & 255u) == 0u) { if (xb_ld(&(bar)[XB_TMO])) break; if (_sp > XB_SPIN_CAP) { atomicAdd(&(bar)[XB_TMO], 1u); break; } } } } while (0)
__device__ __forceinline__ XcdBarrier xcd_barrier_post(unsigned* bar, volatile LAS unsigned* st) {
  XcdBarrier b; b.bar = bar; b.x = xb_xcc_id(); b.st = st;
  if (threadIdx.x == 0) (void)xb_add(&bar[XB_XCNT(b.x)], 1u);
  return b;
}
__device__ __forceinline__ void xcd_barrier_complete(unsigned* bar, unsigned x, unsigned& nloc, unsigned& nx) {
  const unsigned G = gridDim.x * gridDim.y * gridDim.z;
  unsigned sum, cnt, mine, sp = 0u;
  for (;;) {
    sum = 0u; cnt = 0u; mine = 0u;
#pragma unroll
    for (unsigned j = 0; j < 16; ++j) { const unsigned c = xb_ld(&bar[XB_XCNT(j)]); sum += c; cnt += (c > 0u) ? 1u : 0u; mine = (j == x) ? c : mine; }
    if (sum == G) break;
    __builtin_amdgcn_s_sleep(1);
    if ((++sp & 255u) == 0u) { if (xb_ld(&bar[XB_TMO])) break; if (sp > XB_SPIN_CAP) { atomicAdd(&bar[XB_TMO], 1u); break; } }
  }
  nloc = mine > 0u ? mine : 1u; nx = cnt > 0u ? cnt : 1u;
}
__device__ __forceinline__ void xcd_barrier(const XcdBarrier& b) {
  asm volatile("s_waitcnt vmcnt(0)" ::: "memory");
  __syncthreads();
  if (threadIdx.x == 0) {
    unsigned* bar = b.bar;
    __builtin_amdgcn_s_waitcnt(0);
    unsigned nloc = b.st[0], nx = b.st[1];
    if (nloc == 0u) { xcd_barrier_complete(bar, b.x, nloc, nx); b.st[0] = nloc; b.st[1] = nx; }
    const unsigned old = xb_add(&bar[XB_XSUB(b.x)], 1u);
    const unsigned gen = old / nloc;
    if (old + 1u == (gen + 1u) * nloc) {
      __builtin_amdgcn_fence(__ATOMIC_RELEASE, "agent");
      asm volatile("s_waitcnt vmcnt(0)" ::: "memory");
      const unsigned og = xb_add(&bar[XB_TOP], 1u);
      const unsigned tg = og / nx;
      if (og + 1u == (tg + 1u) * nx) xb_add(&bar[XB_TOPGEN], 1u);
      else XB_SPIN(xb_ld(&bar[XB_TOPGEN]) == tg, bar);
      __builtin_amdgcn_fence(__ATOMIC_ACQUIRE, "agent");
      xb_add(&bar[XB_XGEN(b.x)], 1u);
      asm volatile("s_waitcnt vmcnt(0)" ::: "memory");
    } else {
      XB_SPIN(xb_ld(&bar[XB_XGEN(b.x)]) == gen, bar);
      __builtin_amdgcn_fence(__ATOMIC_ACQUIRE, "agent");
      asm volatile("s_waitcnt vmcnt(0)" ::: "memory");
    }
  }
  __syncthreads();
}

#define PARGS const float* a0, const float* a1, const float* a2, const float* a3, const float* a4, const float* a5, const float* a6, \
  const float* a7, const float* a8, const float* a9, const float* a10, const float* a11, const float* a12, const float* a13, \
  const float* a14, const float* a15, const float* a16, const float* a17, const float* a18, const float* a19, const float* a20, \
  float* aout, char* aws
#define PFILL Params p; p.in[0]=a0;p.in[1]=a1;p.in[2]=a2;p.in[3]=a3;p.in[4]=a4;p.in[5]=a5;p.in[6]=a6;p.in[7]=a7;p.in[8]=a8;p.in[9]=a9;p.in[10]=a10; \
  p.in[11]=a11;p.in[12]=a12;p.in[13]=a13;p.in[14]=a14;p.in[15]=a15;p.in[16]=a16;p.in[17]=a17;p.in[18]=a18;p.in[19]=a19;p.in[20]=a20;p.out=aout;p.ws=aws;
__global__ void __launch_bounds__(512) fwd_megakernel(PARGS) {
  PFILL
  extern __shared__ __attribute__((aligned(16))) char lds[];
  volatile int& s_item = *(volatile int*)(lds + LDS_TILE);
  cg::grid_group grid = cg::this_grid();
  const int bid = blockIdx.x, G = gridDim.x, tid = threadIdx.x;
  int* cnt = (int*)(p.ws + OFF_CNT);
  volatile LAS unsigned* bst = (volatile LAS unsigned*)(LAS unsigned char*)(lds + LDS_TILE + 16);
  if (tid < 2) bst[tid] = 0u;
  __syncthreads();
  const XcdBarrier xb = xcd_barrier_post((unsigned*)(p.ws + OFF_BAR), bst);
  for (int rep = 0; rep < ((DUP_MASK & 1) ? 2 : 1); ++rep) {
  {
    for (int it = bid; it < 384; it += G) p0_mod16(p, it, lds);
    float2* tab = (float2*)lds;
    for (int m = tid; m < 2048; m += 512) { float sn, cs; sincospif((float)m * (1.f / 1024.f), &sn, &cs); tab[m] = make_float2(cs, sn); }
    __syncthreads();
    for (int it = 224 + bid; it < 224 + 2048; it += G) p0_item(p, it, lds);
    __syncthreads();
    for (int it = 96 + bid; it < P0_ITEMS; it += G) { if (it >= 224 && it < 224 + 2048) continue; p0_item(p, it, lds); }
  }
  if (((const volatile float*)p.in[15])[0] > 1e30f) grid.sync();
  }
  for (int l = 0; l < 2; ++l) {
    {
      bool waited = (l != 0);
      for (int it = bid; it < P1_ITEMS; it += G) {
        if (!waited && it >= 2816) {
          if (tid == 0) {
            unsigned* mc = (unsigned*)(p.ws + OFF_CNT) + 6; unsigned sp = 0;
            while (__hip_atomic_load(mc, __ATOMIC_RELAXED, __HIP_MEMORY_SCOPE_AGENT) < 384u) { __builtin_amdgcn_s_sleep(2); if (++sp > (1u << 22)) break; }
            __builtin_amdgcn_fence(__ATOMIC_ACQUIRE, "agent");
            asm volatile("s_waitcnt vmcnt(0)" ::: "memory");
          }
          __syncthreads();
          waited = true;
        }
        p1_item(p, l, it, lds);
      }
      xcd_barrier(xb);
    }
    if (DUP_MASK & 1024) { const bool opq = (((const volatile float*)p.in[15])[0] < 1e30f); p2_phase(p, l, lds, opq); xcd_barrier(xb); }
    for (int rep = 0; rep < ((DUP_MASK & 4) ? 2 : 1); ++rep) {
    p2_phase(p, l, lds);
    xcd_barrier(xb);
    }
    for (;;) {
      __syncthreads();
      if (tid == 0) s_item = atomicAdd(&cnt[l * 2 + 0], 1);
      __syncthreads();
      int it = s_item;
      constexpr int D3 = (DUP_MASK & 16) ? 256 : 0;
      if (it >= D3 + 32 + 128 + 384 + 256) break;
      if (it >= 32 + 128 + 384 + 256) { hgrn_ctx_item(p, l, (it - 800) & 127, lds, true); continue; }
      if (it < 32) p2_left_item(p, l, 1024 + it, lds);
      else if (it < 160) hgrn_ctx_item(p, l, it - 32, lds);
      else if (it < 416) hgrn_lat1_item(p, l, it - 160, lds);
      else f1_item(p, it - 416, lds);
    }
    xcd_barrier(xb);
    for (;;) {
      __syncthreads();
      if (tid == 0) s_item = atomicAdd(&cnt[l * 2 + 1], 1);
      __syncthreads();
      int it = s_item;
      constexpr int D4a = (DUP_MASK & 32) ? 256 : 0, D4b = (DUP_MASK & 64) ? 256 : 0;
      if (it >= D4a + D4b + 640) break;
      if (it >= 640) { if (DUP_MASK & 32) attn_item(p, l, (it - 640) & 127, true, lds, true); else hgrn_lat2_item(p, l, (it - 640) & 127, lds, true); continue; }
      if (it < 128) attn_item(p, l, it, true, lds);
      else if (it < 192) f2l_item(p, l, it - 128, lds);
      else if (it < 320) hgrn_lat2_item(p, l, it - 192, lds);
      else if (it < 384) f2c_item(p, it - 320, lds);
      else attn_item(p, l, it - 384, false, lds);
    }
    xcd_barrier(xb);
    if (DUP_MASK & 2048) { const bool opq = (((const volatile float*)p.in[15])[0] < 1e30f); p5_phase(p, l, lds, opq); xcd_barrier(xb); }
    for (int rep = 0; rep < ((DUP_MASK & 8) ? 2 : 1); ++rep) {
    p5_phase(p, l, lds);
    xcd_barrier(xb);
    }
    for (int rep = 0; rep < (((DUP_MASK & 256) && l == 0) ? 5 : 1); ++rep) {
    p6_phase(p, l, lds);
    if (l == 0) xcd_barrier(xb);
    }
  }
}

extern "C" void kernel_launch(void* const* d_in, const int* in_sizes, int n_in,
                              void* d_out, int out_size, void* d_ws, size_t ws_size,
                              hipStream_t stream) {
  static int grid_blocks = 0;
  if (!grid_blocks) {
    int dev = 0, cus = 0;
    (void)hipGetDevice(&dev);
    (void)hipDeviceGetAttribute(&cus, hipDeviceAttributeMultiprocessorCount, dev);
    if (hipFuncSetAttribute((const void*)fwd_megakernel, hipFuncAttributeMaxDynamicSharedMemorySize, LDS_BYTES) != hipSuccess)
      fprintf(stderr, "hipFuncSetAttribute failed\n");
    grid_blocks = cus > 0 ? cus : 256;
    if (ws_size < WS_END) fprintf(stderr, "workspace too small: %zu < %zu\n", ws_size, (size_t)WS_END);
  }
  const void* ins[21];
  for (int i = 0; i < 21; ++i) ins[i] = d_in[i];
  void* outp = d_out; void* wsp = d_ws;
  void* args[23];
  for (int i = 0; i < 21; ++i) args[i] = (void*)&ins[i];
  args[21] = (void*)&outp; args[22] = (void*)&wsp;
  (void)hipMemsetAsync((char*)d_ws + OFF_CNT, 0, 4096 + 3456 * 4, stream);
  hipError_t e = hipLaunchCooperativeKernel((void*)fwd_megakernel, dim3(grid_blocks), dim3(512), args, LDS_BYTES, stream);
  if (e != hipSuccess) fprintf(stderr, "cooperative launch failed: %s (grid %d)\n", hipGetErrorString(e), grid_blocks);
}
```
